# Optimizing an MI355X kernel written in HIP

```python
import math
import jax, jax.numpy as jnp
from jax import lax
import numpy as np

D_MODEL = 1024
BATCH = 8
SEQ = 2048
DEPTH = 1
DEC_BATCH = 1
DEC_SEQ = 16384
PAST_LEN = 128

HYENA_WIDTH = 512
HYENA_ORDER = 2
SHORT_CONV = 3
FILTER_BANDS = 16
FILTER_EMB = 1 + 2 * FILTER_BANDS
FILTER_HIDDEN = 64
N_DIRECTIONS = 2
DECAY_FAST_PCT = 0.3
DECAY_SLOW_PCT = 1.5
DECAY_TARGET = 1e-2
DECAY_SHIFT = 0.05
N_HEADS = 8
N_KV_HEADS = 2
HEAD_DIM = 64
ATTN_WIDTH = N_HEADS * HEAD_DIM
KV_WIDTH = N_KV_HEADS * HEAD_DIM
WINDOW = 128
BLOCK = 128
ROPE_THETA = 10000.0
N_BRANCHES = 2
IN_WIDTH = 3 * HYENA_WIDTH + ATTN_WIDTH + 2 * KV_WIDTH + N_BRANCHES * D_MODEL
FFN_HIDDEN = -(-8 * D_MODEL // (3 * 256)) * 256
RMS_EPS = 1e-6
NEG_INF = -1e30

kernel_name = "hybrid_hyena_swa_sink_encoder"


def rmsnorm(x, w):
    xf = x.astype(jnp.float32)
    y = xf * lax.rsqrt(jnp.mean(xf * xf, axis=-1, keepdims=True) + RMS_EPS) * w.astype(jnp.float32)
    return y.astype(x.dtype)


def short_conv3(u, w, b):
    up = jnp.pad(u, ((0, 0), (1, 1), (0, 0)))
    return w[0] * up[:, :-2] + w[1] * up[:, 1:-1] + w[2] * up[:, 2:] + b


def hyena_filter_spectrum(L, w1, b1, w2, b2, w3, freq):
    f32 = jnp.float32
    pos = jnp.arange(L, dtype=f32)
    t = pos / (L - 1)
    bands = jnp.linspace(1e-4, FILTER_BANDS - 1, FILTER_BANDS, dtype=f32)
    ang = (2.0 * math.pi / L) * pos[:, None] * bands[None, :]
    z = jnp.concatenate([t[:, None], jnp.cos(ang), -jnp.sin(ang)], axis=-1)
    fr = freq.astype(f32)
    h = jnp.sin(fr * (z @ w1.astype(f32) + b1.astype(f32)))
    h = jnp.sin(fr * (h @ w2.astype(f32) + b2.astype(f32)))
    h = (h @ w3.astype(f32)).reshape(L, HYENA_ORDER, N_DIRECTIONS, HYENA_WIDTH)
    max_decay = math.log(DECAY_TARGET) / DECAY_FAST_PCT
    min_decay = math.log(DECAY_TARGET) / DECAY_SLOW_PCT
    deltas = jnp.linspace(min_decay, max_decay, HYENA_WIDTH, dtype=f32)
    window = jnp.exp(-t[:, None] * jnp.abs(deltas)[None, :]) + DECAY_SHIFT
    h = h * window[:, None, None, :]
    fwd, bwd = h[:, :, 0], h[:, :, 1]
    k = jnp.concatenate([fwd, jnp.zeros((1, HYENA_ORDER, HYENA_WIDTH), f32), jnp.flip(bwd[1:], axis=0)], axis=0)
    k = k / jnp.sum(jnp.abs(k), axis=0, keepdims=True)
    return jnp.fft.rfft(k, axis=0)


def fft_long_conv(u, spec):
    L = u.shape[1]
    U = jnp.fft.rfft(u, n=2 * L, axis=1)
    return jnp.fft.irfft(U * spec[None], n=2 * L, axis=1)[:, :L]


def hyena_mixer(u, conv_w, conv_b, spec, skip_bias):
    uc = short_conv3(u.astype(jnp.float32), conv_w.astype(jnp.float32), conv_b.astype(jnp.float32))
    x1, x2, v = jnp.split(uc, 3, axis=-1)
    sb = skip_bias.astype(jnp.float32)
    z = v
    for o, gate in enumerate((x1, x2)):
        z = gate * (fft_long_conv(z, spec[:, o]) + sb[o] * z)
    return z.astype(u.dtype)


def apply_rope(x):
    L = x.shape[1]
    inv = ROPE_THETA ** (-jnp.arange(0, HEAD_DIM, 2, dtype=jnp.float32) / HEAD_DIM)
    ang = jnp.arange(L, dtype=jnp.float32)[:, None] * inv[None, :]
    cos = jnp.cos(ang)[None, :, None, :]
    sin = jnp.sin(ang)[None, :, None, :]
    xf = x.astype(jnp.float32)
    a, b = xf[..., :HEAD_DIM // 2], xf[..., HEAD_DIM // 2:]
    return jnp.concatenate([a * cos - b * sin, b * cos + a * sin], axis=-1).astype(x.dtype)


def windowed_attention(q, k, v, sink):
    B, L = q.shape[:2]
    nb = L // BLOCK
    G = N_HEADS // N_KV_HEADS
    qb = q.reshape(B, nb, BLOCK, N_KV_HEADS, G, HEAD_DIM)

    def band(t):
        tp = jnp.pad(t, ((0, 0), (BLOCK, BLOCK), (0, 0), (0, 0))).reshape(B, nb + 2, BLOCK, N_KV_HEADS, HEAD_DIM)
        return jnp.concatenate([tp[:, :-2], tp[:, 1:-1], tp[:, 2:]], axis=2)

    kb, vb = band(k), band(v)
    s = jnp.einsum('bnqkgd,bnskd->bnkgqs', qb, kb, preferred_element_type=jnp.float32) * (HEAD_DIM ** -0.5)
    qi = jnp.arange(BLOCK)[:, None]
    si = jnp.arange(3 * BLOCK)[None, :]
    rel = si - BLOCK - qi
    kpos = (jnp.arange(nb)[:, None, None] - 1) * BLOCK + si[None]
    mask = (jnp.abs(rel) <= WINDOW)[None] & (kpos >= 0) & (kpos < L)
    s = jnp.where(mask[None, :, None, None], s, NEG_INF)
    sink_logit = jnp.broadcast_to(sink.astype(jnp.float32).reshape(1, 1, N_KV_HEADS, G, 1, 1), s.shape[:-1] + (1,))
    p = jax.nn.softmax(jnp.concatenate([s, sink_logit], axis=-1), axis=-1)[..., :-1]
    o = jnp.einsum('bnkgqs,bnskd->bnqkgd', p.astype(v.dtype), vb)
    return o.reshape(B, L, ATTN_WIDTH)


def encoder_layer(x, attn_norm_w, w_in, hyena_conv_w, hyena_conv_b, filt_w1, filt_b1, filt_w2, filt_b2,
                  filt_w3, filt_freq, hyena_bias, q_norm_w, k_norm_w, attn_sink, w_hy_out, w_at_out, w_o,
                  ffn_norm_w, w_gate, w_up, w_down):
    B, L, _ = x.shape
    h = rmsnorm(x, attn_norm_w)
    proj = h @ w_in
    c0 = 3 * HYENA_WIDTH
    c1 = c0 + ATTN_WIDTH
    c2 = c1 + KV_WIDTH
    c3 = c2 + KV_WIDTH
    u_hy = proj[..., :c0]
    q = proj[..., c0:c1].reshape(B, L, N_HEADS, HEAD_DIM)
    k = proj[..., c1:c2].reshape(B, L, N_KV_HEADS, HEAD_DIM)
    v = proj[..., c2:c3].reshape(B, L, N_KV_HEADS, HEAD_DIM)
    g_hy = proj[..., c3:c3 + D_MODEL]
    g_at = proj[..., c3 + D_MODEL:]
    spec = hyena_filter_spectrum(L, filt_w1, filt_b1, filt_w2, filt_b2, filt_w3, filt_freq)
    y_hy = hyena_mixer(u_hy, hyena_conv_w, hyena_conv_b, spec, hyena_bias)
    q = apply_rope(rmsnorm(q, q_norm_w))
    k = apply_rope(rmsnorm(k, k_norm_w))
    y_at = windowed_attention(q, k, v, attn_sink)
    merged = jax.nn.sigmoid(g_hy) * (y_hy @ w_hy_out) + jax.nn.sigmoid(g_at) * (y_at @ w_at_out)
    x = x + merged @ w_o
    f = rmsnorm(x, ffn_norm_w)
    x = x + (jax.nn.silu(f @ w_gate) * (f @ w_up)) @ w_down
    return x


def trunk(x, attn_norm_w, w_in, hyena_conv_w, hyena_conv_b, filt_w1, filt_b1, filt_w2, filt_b2, filt_w3,
          filt_freq, hyena_bias, q_norm_w, k_norm_w, attn_sink, w_hy_out, w_at_out, w_o, ffn_norm_w,
          w_gate, w_up, w_down):
    for l in range(DEPTH):
        x = encoder_layer(x, attn_norm_w[l], w_in[l], hyena_conv_w[l], hyena_conv_b[l], filt_w1[l], filt_b1[l],
                          filt_w2[l], filt_b2[l], filt_w3[l], filt_freq[l], hyena_bias[l], q_norm_w[l],
                          k_norm_w[l], attn_sink[l], w_hy_out[l], w_at_out[l], w_o[l], ffn_norm_w[l],
                          w_gate[l], w_up[l], w_down[l])
    return x


def setup_inputs(seed: int = 0) -> dict:
    key = jax.random.key(seed)
    ks = jax.random.split(key, 24)
    f32 = jnp.float32

    def nrm(k, shape, scale):
        return jax.random.normal(k, shape, f32) * scale

    return {
        'x_prompt': nrm(ks[0], (BATCH, SEQ, D_MODEL), 1.0),
        'x_sample': nrm(ks[1], (DEC_BATCH, DEC_SEQ, D_MODEL), 1.0),
        'attn_norm_w': 1.0 + nrm(ks[2], (DEPTH, D_MODEL), 0.01),
        'w_in': nrm(ks[3], (DEPTH, D_MODEL, IN_WIDTH), D_MODEL ** -0.5),
        'hyena_conv_w': nrm(ks[4], (DEPTH, SHORT_CONV, 3 * HYENA_WIDTH), SHORT_CONV ** -0.5),
        'hyena_conv_b': nrm(ks[5], (DEPTH, 3 * HYENA_WIDTH), 0.01),
        'filt_w1': nrm(ks[6], (DEPTH, FILTER_EMB, FILTER_HIDDEN), FILTER_EMB ** -0.5),
        'filt_b1': nrm(ks[7], (DEPTH, FILTER_HIDDEN), 0.1),
        'filt_w2': nrm(ks[8], (DEPTH, FILTER_HIDDEN, FILTER_HIDDEN), FILTER_HIDDEN ** -0.5),
        'filt_b2': nrm(ks[9], (DEPTH, FILTER_HIDDEN), 0.1),
        'filt_w3': nrm(ks[10], (DEPTH, FILTER_HIDDEN, HYENA_ORDER * N_DIRECTIONS * HYENA_WIDTH), FILTER_HIDDEN ** -0.5),
        'filt_freq': 1.0 + nrm(ks[11], (DEPTH, FILTER_HIDDEN), 0.01),
        'hyena_bias': nrm(ks[12], (DEPTH, HYENA_ORDER, HYENA_WIDTH), 1.0),
        'q_norm_w': 1.0 + nrm(ks[13], (DEPTH, HEAD_DIM), 0.01),
        'k_norm_w': 1.0 + nrm(ks[14], (DEPTH, HEAD_DIM), 0.01),
        'attn_sink': nrm(ks[15], (DEPTH, N_HEADS), 1.0),
        'w_hy_out': nrm(ks[16], (DEPTH, HYENA_WIDTH, D_MODEL), HYENA_WIDTH ** -0.5),
        'w_at_out': nrm(ks[17], (DEPTH, ATTN_WIDTH, D_MODEL), ATTN_WIDTH ** -0.5),
        'w_o': nrm(ks[18], (DEPTH, D_MODEL, D_MODEL), D_MODEL ** -0.5),
        'ffn_norm_w': 1.0 + nrm(ks[19], (DEPTH, D_MODEL), 0.01),
        'w_gate': nrm(ks[20], (DEPTH, D_MODEL, FFN_HIDDEN), D_MODEL ** -0.5),
        'w_up': nrm(ks[21], (DEPTH, D_MODEL, FFN_HIDDEN), D_MODEL ** -0.5),
        'w_down': nrm(ks[22], (DEPTH, FFN_HIDDEN, D_MODEL), FFN_HIDDEN ** -0.5),
    }


def reference(x_prompt, x_sample, attn_norm_w, w_in, hyena_conv_w, hyena_conv_b, filt_w1, filt_b1, filt_w2,
              filt_b2, filt_w3, filt_freq, hyena_bias, q_norm_w, k_norm_w, attn_sink, w_hy_out, w_at_out, w_o,
              ffn_norm_w, w_gate, w_up, w_down):
    y_prompt = trunk(x_prompt, attn_norm_w, w_in, hyena_conv_w, hyena_conv_b, filt_w1, filt_b1, filt_w2, filt_b2,
                     filt_w3, filt_freq, hyena_bias, q_norm_w, k_norm_w, attn_sink, w_hy_out, w_at_out, w_o,
                     ffn_norm_w, w_gate, w_up, w_down)
    y_sample = trunk(x_sample, attn_norm_w, w_in, hyena_conv_w, hyena_conv_b, filt_w1, filt_b1, filt_w2, filt_b2,
                     filt_w3, filt_freq, hyena_bias, q_norm_w, k_norm_w, attn_sink, w_hy_out, w_at_out, w_o,
                     ffn_norm_w, w_gate, w_up, w_down)
    return (y_prompt, y_sample)
```

```cpp
#include <hip/hip_runtime.h>
#include <cstdio>
#include <cstdint>
#include <cmath>

namespace pg8 {
#define PG8_LAS __attribute__((address_space(3)))
typedef unsigned short bf16_t;
typedef short bf16x8 __attribute__((ext_vector_type(8)));
typedef float f32x4 __attribute__((ext_vector_type(4)));
typedef unsigned u32x4 __attribute__((ext_vector_type(4)));
constexpr int BM = 256, BK = 64, HALF = 128, HTB = HALF * BK * 2  , STAGE_BYTES = 8 * HTB, NXCD = 8, WGM = 8;

__host__ __device__ __forceinline__ int lds_byte(int r, int c) { const int st = (r >> 4) * 2 + (c >> 5), rr = r & 15, cc = c & 31, ob = rr * 64 + cc * 2; return st * 1024 + (ob ^ (((ob >> 9) & 1) << 5)); }
__host__ __device__ __forceinline__ void stage_rc(int b, int& R, int& C) { const int st = b / 1024, sb = b % 1024, swz = sb ^ (((sb >> 9) & 1) << 5); R = (st >> 1) * 16 + swz / 64; C = (st & 1) * 32 + (swz % 64) / 2; }
__host__ __device__ __forceinline__ int perm32(int rho) { const int n = rho >> 4, i = rho & 15; return 8 * (i >> 2) + 4 * n + (i & 3); }

struct Unit { int pm, pn, sel; };
struct Gemm { const bf16_t* A; const bf16_t* Bt; const bf16_t* A1; const bf16_t* Bt1; int M, N, K; };

struct StaticOrder {
    int nM, nN, nwg, G, c;
    __host__ __device__ void init(int M, int N, int G_, int c_) { nM = M / BM; nN = N / BM; nwg = nM * nN; G = G_; c = c_; }
    __host__ __device__ bool next(int i, Unit& u) const {
        const long L = (long)i * G + c; if (L >= nwg) return false;
        int wgid = (int)L; { const int q = nwg / NXCD, r = nwg % NXCD, xcd = wgid % NXCD, off = wgid / NXCD; wgid = (xcd < r ? xcd * (q + 1) : r * (q + 1) + (xcd - r) * q) + off; }
        const int nig = WGM * nN, gid = wgid / nig, fm = gid * WGM, gsz = (nM - fm) < WGM ? (nM - fm) : WGM;
        u.pm = fm + ((wgid % nig) % gsz); u.pn = (wgid % nig) / gsz; u.sel = 0; return true;
    }
    __device__ __forceinline__ void a_ready(const Unit&) const {}
    __device__ __forceinline__ void done(const Unit&) const {}
};
struct TwoPartOrder {
    StaticOrder b;
    __device__ __forceinline__ bool next(int i, Unit& u) const { if (!b.next(i >> 1, u)) return false; u.sel = i & 1; return true; }
    __device__ __forceinline__ void a_ready(const Unit&) const {}
    __device__ __forceinline__ void done(const Unit&) const {}
};

__device__ __forceinline__ unsigned cvt_pk_bf16(float lo, float hi) { unsigned r; asm volatile("v_cvt_pk_bf16_f32 %0, %1, %2" : "=v"(r) : "v"(lo), "v"(hi)); return r; }
__device__ __forceinline__ u32x4 pack8(const f32x4 a, const f32x4 b) { u32x4 w; w.x = cvt_pk_bf16(a[0], a[1]); w.y = cvt_pk_bf16(a[2], a[3]); w.z = cvt_pk_bf16(b[0], b[1]); w.w = cvt_pk_bf16(b[2], b[3]); return w; }
__device__ __forceinline__ float bflo(unsigned w) { return __uint_as_float(w << 16); }
__device__ __forceinline__ float bfhi(unsigned w) { return __uint_as_float(w & 0xffff0000u); }
__device__ __forceinline__ void unpack8(const u32x4 w, f32x4& a, f32x4& b) { a = (f32x4){bflo(w.x), bfhi(w.x), bflo(w.y), bfhi(w.y)}; b = (f32x4){bflo(w.z), bfhi(w.z), bflo(w.w), bfhi(w.w)}; }
__device__ __forceinline__ float sigmoidf_(float v) { return 1.0f / (1.0f + __expf(-v)); }

constexpr float QSCALE = 0.125f * 1.4426950408889634f;

struct EpiUT {
    static constexpr bool PERM = true, AFTER_DRAIN = false;
    bf16_t* O; int ldc; const float* rstd;
    __device__ __forceinline__ bool keep(const Unit&) const { return false; }
    __device__ __forceinline__ void operator()(f32x4 (&acc)[2][2][4][2], const Unit& u, int wr, int wc, int fr, int fq) const {
        const int row0 = u.pm * BM + wr * 64 + fr, col0 = u.pn * BM + wc * 32 + 8 * fq;
        f32x4 rs[2][2];
#pragma unroll
        for (int bj = 0; bj < 2; ++bj)
#pragma unroll
            for (int n = 0; n < 2; ++n) rs[bj][n] = *(const f32x4*)(rstd + col0 + bj * HALF + 4 * n);
#pragma unroll
        for (int ai = 0; ai < 2; ++ai)
#pragma unroll
            for (int m = 0; m < 4; ++m) { bf16_t* rowp = O + (size_t)(row0 + ai * HALF + m * 16) * ldc + col0;
#pragma unroll
                for (int bj = 0; bj < 2; ++bj) *(u32x4*)(rowp + bj * HALF) = pack8(acc[ai][bj][m][0] * rs[bj][0], acc[ai][bj][m][1] * rs[bj][1]); }
    }
};

struct EpiProj {
    static constexpr bool PERM = true, AFTER_DRAIN = false;
    const float* rstd; const float* qw; const float* kw; const float* cs; const float* sn; bf16_t* q; bf16_t* k; bf16_t* v; bf16_t* sgh; bf16_t* sga;
    __device__ __forceinline__ bool keep(const Unit&) const { return false; }
    __device__ __forceinline__ void operator()(f32x4 (&acc)[2][2][4][2], const Unit& u, int wr, int wc, int fr, int fq) const {
        const int pn = u.pn;
        if (pn <= 2 && !(pn == 2 && wc >= 2)) {
            const float* w = (pn < 2) ? qw : kw; const float sc = (pn < 2) ? QSCALE : 1.0f;
            const f32x4 wl0 = *(const f32x4*)(w + 8 * fq), wl1 = *(const f32x4*)(w + 8 * fq + 4), wh0 = *(const f32x4*)(w + 32 + 8 * fq), wh1 = *(const f32x4*)(w + 32 + 8 * fq + 4);
#pragma unroll
            for (int ai = 0; ai < 2; ++ai)
#pragma unroll
                for (int m = 0; m < 4; ++m) {
                    const int row = u.pm * BM + ai * HALF + wr * 64 + m * 16 + fr; const float rs = rstd[row];
                    f32x4 a0 = acc[ai][0][m][0] * rs, a1 = acc[ai][0][m][1] * rs, b0 = acc[ai][1][m][0] * rs, b1 = acc[ai][1][m][1] * rs;
                    f32x4 sq = a0 * a0 + a1 * a1 + b0 * b0 + b1 * b1; float ss = (sq[0] + sq[1]) + (sq[2] + sq[3]);
                    ss += __shfl_xor(ss, 16); ss += __shfl_xor(ss, 32);
                    const float inv = 1.0f / sqrtf(ss * (1.0f / 64.0f) + 1e-6f);
                    const int pos = row < 16384 ? (row & 2047) : (row - 16384);
                    const f32x4 c0 = *(const f32x4*)(cs + pos * 32 + 8 * fq), c1 = *(const f32x4*)(cs + pos * 32 + 8 * fq + 4), s0 = *(const f32x4*)(sn + pos * 32 + 8 * fq), s1 = *(const f32x4*)(sn + pos * 32 + 8 * fq + 4);
                    a0 = a0 * inv * wl0; a1 = a1 * inv * wl1; b0 = b0 * inv * wh0; b1 = b1 * inv * wh1;
                    const f32x4 lo0 = (a0 * c0 - b0 * s0) * sc, lo1 = (a1 * c1 - b1 * s1) * sc, hi0 = (b0 * c0 + a0 * s0) * sc, hi1 = (b1 * c1 + a1 * s1) * sc;
                    bf16_t* dst = (pn < 2) ? q + (size_t)row * 512 + (4 * pn + wc) * 64 + 8 * fq : k + (size_t)row * 128 + wc * 64 + 8 * fq;
                    *(u32x4*)dst = pack8(lo0, lo1); *(u32x4*)(dst + 32) = pack8(hi0, hi1);
                }
        } else if (pn == 2) {
#pragma unroll
            for (int ai = 0; ai < 2; ++ai)
#pragma unroll
                for (int m = 0; m < 4; ++m) {
                    const int row = u.pm * BM + ai * HALF + wr * 64 + m * 16 + fr; const float rs = rstd[row];
                    bf16_t* dst = v + (size_t)row * 128 + (wc - 2) * 64 + 8 * fq;
                    *(u32x4*)dst = pack8(acc[ai][0][m][0] * rs, acc[ai][0][m][1] * rs); *(u32x4*)(dst + 32) = pack8(acc[ai][1][m][0] * rs, acc[ai][1][m][1] * rs);
                }
        } else {
            bf16_t* base = (pn < 7) ? sgh : sga; const int colb = (pn - ((pn < 7) ? 3 : 7)) * BM + wc * 32 + 8 * fq;
#pragma unroll
            for (int ai = 0; ai < 2; ++ai)
#pragma unroll
                for (int m = 0; m < 4; ++m) {
                    const int row = u.pm * BM + ai * HALF + wr * 64 + m * 16 + fr; const float rs = rstd[row];
#pragma unroll
                    for (int bj = 0; bj < 2; ++bj) { f32x4 g0 = acc[ai][bj][m][0] * rs, g1 = acc[ai][bj][m][1] * rs;
#pragma unroll
                        for (int e = 0; e < 4; ++e) { g0[e] = sigmoidf_(g0[e]); g1[e] = sigmoidf_(g1[e]); }
                        *(u32x4*)(base + (size_t)row * 1024 + colb + bj * HALF) = pack8(g0, g1); }
                }
        }
    }
};

struct EpiMerged {
    static constexpr bool PERM = true, AFTER_DRAIN = false;
    const bf16_t* sgh; const bf16_t* sga; bf16_t* out;
    __device__ __forceinline__ bool keep(const Unit& u) const { return u.sel == 0; }
    __device__ __forceinline__ void operator()(f32x4 (&acc)[2][2][4][2], const Unit& u, int wr, int wc, int fr, int fq) const {
#pragma unroll
        for (int ai = 0; ai < 2; ++ai)
#pragma unroll
            for (int m = 0; m < 4; ++m) {
                const size_t off = (size_t)(u.pm * BM + ai * HALF + wr * 64 + m * 16 + fr) * 1024 + u.pn * BM + wc * 32 + 8 * fq;
#pragma unroll
                for (int bj = 0; bj < 2; ++bj) {
                    f32x4 t0, t1; unpack8(*(const u32x4*)(sga + off + bj * HALF), t0, t1);
                    if (u.sel == 0) { f32x4 h0, h1; unpack8(*(const u32x4*)(sgh + off + bj * HALF), h0, h1);
                        acc[ai][bj][m][0] = acc[ai][bj][m][0] * (h0 / t0); acc[ai][bj][m][1] = acc[ai][bj][m][1] * (h1 / t1); }
                    else *(u32x4*)(out + off + bj * HALF) = pack8(acc[ai][bj][m][0] * t0, acc[ai][bj][m][1] * t1);
                }
            }
    }
};

struct EpiWo {
    static constexpr bool PERM = true, AFTER_DRAIN = false;
    const float* xp; const float* xs; float* x1; bf16_t* x1b; float* ssq;
    __device__ __forceinline__ bool keep(const Unit&) const { return false; }
    __device__ __forceinline__ void operator()(f32x4 (&acc)[2][2][4][2], const Unit& u, int wr, int wc, int fr, int fq) const {
        const float* xb = (u.pm < 64) ? xp : xs - (size_t)16384 * 1024;
#pragma unroll
        for (int ai = 0; ai < 2; ++ai)
#pragma unroll
            for (int m = 0; m < 4; ++m) {
                const int row = u.pm * BM + ai * HALF + wr * 64 + m * 16 + fr; const size_t off = (size_t)row * 1024 + u.pn * BM + wc * 32 + 8 * fq; float s = 0.f;
#pragma unroll
                for (int bj = 0; bj < 2; ++bj) {
                    const f32x4 v0 = *(const f32x4*)(xb + off + bj * HALF) + acc[ai][bj][m][0], v1 = *(const f32x4*)(xb + off + bj * HALF + 4) + acc[ai][bj][m][1];
                    *(f32x4*)(x1 + off + bj * HALF) = v0; *(f32x4*)(x1 + off + bj * HALF + 4) = v1; *(u32x4*)(x1b + off + bj * HALF) = pack8(v0, v1);
                    const f32x4 q = v0 * v0 + v1 * v1; s += (q[0] + q[1]) + (q[2] + q[3]); }
                s += __shfl_xor(s, 16); s += __shfl_xor(s, 32);
                if (fq == 0) ssq[(size_t)row * 16 + u.pn * 4 + wc] = s;
            }
    }
};

struct EpiFfn1 {
    static constexpr bool PERM = true, AFTER_DRAIN = false;
    const float* ssq; bf16_t* hid;
    __device__ __forceinline__ bool keep(const Unit&) const { return false; }
    __device__ __forceinline__ void operator()(f32x4 (&acc)[2][2][4][2], const Unit& u, int wr, int wc, int fr, int fq) const {
#pragma unroll
        for (int ai = 0; ai < 2; ++ai)
#pragma unroll
            for (int m = 0; m < 4; ++m) {
                const int row = u.pm * BM + ai * HALF + wr * 64 + m * 16 + fr;
                const f32x4 p = *(const f32x4*)(ssq + (size_t)row * 16 + 4 * fq); float t = (p[0] + p[1]) + (p[2] + p[3]);
                t += __shfl_xor(t, 16); t += __shfl_xor(t, 32);
                const float r = 1.0f / sqrtf(t * (1.0f / 1024.0f) + 1e-6f);
                f32x4 h0, h1;
#pragma unroll
                for (int e = 0; e < 4; ++e) { const float g0 = acc[ai][0][m][0][e] * r, g1 = acc[ai][0][m][1][e] * r;
                    h0[e] = g0 * sigmoidf_(g0) * (acc[ai][1][m][0][e] * r); h1[e] = g1 * sigmoidf_(g1) * (acc[ai][1][m][1][e] * r); }
                *(u32x4*)(hid + (size_t)row * 2816 + u.pn * HALF + wc * 32 + 8 * fq) = pack8(h0, h1);
            }
    }
};

struct EpiFfn2 {
    static constexpr bool PERM = true, AFTER_DRAIN = false;
    float* out;
    __device__ __forceinline__ bool keep(const Unit&) const { return false; }
    __device__ __forceinline__ void operator()(f32x4 (&acc)[2][2][4][2], const Unit& u, int wr, int wc, int fr, int fq) const {
#pragma unroll
        for (int ai = 0; ai < 2; ++ai)
#pragma unroll
            for (int m = 0; m < 4; ++m) {
                float* p = out + (size_t)(u.pm * BM + ai * HALF + wr * 64 + m * 16 + fr) * 1024 + u.pn * BM + wc * 32 + 8 * fq;
#pragma unroll
                for (int bj = 0; bj < 2; ++bj) { const f32x4 v0 = *(const f32x4*)(p + bj * HALF) + acc[ai][bj][m][0], v1 = *(const f32x4*)(p + bj * HALF + 4) + acc[ai][bj][m][1];
                    *(f32x4*)(p + bj * HALF) = v0; *(f32x4*)(p + bj * HALF + 4) = v1; }
            }
    }
};

__device__ __forceinline__ void zero_acc(f32x4 (&acc)[2][2][4][2]) {
#pragma unroll
    for (int a = 0; a < 2; ++a)
#pragma unroll
        for (int b = 0; b < 2; ++b)
#pragma unroll
            for (int m = 0; m < 4; ++m)
#pragma unroll
                for (int n = 0; n < 2; ++n) acc[a][b][m][n] = (f32x4){0.f, 0.f, 0.f, 0.f};
}
template <class Epi, class Sched, bool ALIGN_EPI = false, bool SP2 = false>
__device__ __forceinline__ void gemm_phase(PG8_LAS unsigned char* lds, const Gemm g, const Sched& S, const Epi& E) {
    const int tid = threadIdx.x, wid = __builtin_amdgcn_readfirstlane(tid >> 6), lane = tid & 63, wr = wid >> 2, wc = wid & 3, fr = lane & 15, fq = lane >> 4;
    const int K = g.K, nt = K / BK;
    unsigned voffA[2], voffB[2];
#pragma unroll
    for (int i = 0; i < 2; ++i) { int R, C; stage_rc(tid * 16 + i * 8192, R, C); const int Rb = Epi::PERM ? ((R & ~31) + perm32(R & 31)) : R;
        voffA[i] = (unsigned)(R * K + C) * 2u; voffB[i] = (unsigned)(Rb * K + C) * 2u; }
    const size_t kstep = (size_t)(BK * 2);
    const size_t hstep = (size_t)HALF * K * 2;
    const size_t tstep = 2 * hstep;
    const unsigned ldsw = (unsigned)wid * 1024u;
    const int aoff = lds_byte(wr * 64 + fr, fq * 8), boff = lds_byte(wc * 32 + fr, fq * 8);
#define PG8_SA(b, h) (((b) * 2 + (h)) * HTB)
#define PG8_SB(b, h) ((4 + (b) * 2 + (h)) * HTB)
#define PG8_STAGE(bufoff, gbase, voff) do { _Pragma("unroll") for (int _i = 0; _i < 2; ++_i) \
        __builtin_amdgcn_global_load_lds((const unsigned*)((const char*)(gbase) + (voff)[_i]), (PG8_LAS unsigned*)(lds + (bufoff) + ldsw + _i * 8192), 16, 0, 0); } while (0)
#define PG8_LDA(dst, b, h) do { _Pragma("unroll") for (int m = 0; m < 4; ++m) _Pragma("unroll") for (int k = 0; k < 2; ++k) dst[m][k] = *(const PG8_LAS bf16x8*)(lds + PG8_SA(b, h) + aoff + m * 2048 + k * 1024); } while (0)
#define PG8_LDB(dst, b, h) do { _Pragma("unroll") for (int n = 0; n < 2; ++n) _Pragma("unroll") for (int k = 0; k < 2; ++k) dst[n][k] = *(const PG8_LAS bf16x8*)(lds + PG8_SB(b, h) + boff + n * 2048 + k * 1024); } while (0)
#define PG8_MMA(ai, bj, At, Bt) do { __builtin_amdgcn_s_setprio(1); _Pragma("unroll") for (int m = 0; m < 4; ++m) _Pragma("unroll") for (int n = 0; n < 2; ++n) _Pragma("unroll") for (int k = 0; k < 2; ++k) \
        acc[ai][bj][m][n] = __builtin_amdgcn_mfma_f32_16x16x32_bf16(Bt[n][k], At[m][k], acc[ai][bj][m][n], 0, 0, 0); __builtin_amdgcn_s_setprio(0); } while (0)
#define PG8_WAIT_V(n) asm volatile("s_waitcnt vmcnt(" #n ")" ::: "memory")
#define PG8_WAIT_L(n) asm volatile("s_waitcnt lgkmcnt(" #n ")" ::: "memory")
#define PG8_BAR __builtin_amdgcn_s_barrier()
#define PG8_SCHED __builtin_amdgcn_sched_barrier(0)
    Unit cur, nxt; int ui = 0;
    if (!S.next(0, cur)) return;
    f32x4 acc[2][2][4][2];
#pragma unroll
    for (int a = 0; a < 2; ++a)
#pragma unroll
        for (int b = 0; b < 2; ++b)
#pragma unroll
            for (int m = 0; m < 4; ++m)
#pragma unroll
                for (int n = 0; n < 2; ++n) acc[a][b][m][n] = (f32x4){0.f, 0.f, 0.f, 0.f};
    bf16x8 At[4][2], B0[2][2], B1[2][2];
    const char* cA = (const char*)(cur.sel ? g.A1 : g.A) + (size_t)cur.pm * tstep; const char* cB = (const char*)(cur.sel ? g.Bt1 : g.Bt) + (size_t)cur.pn * tstep;
    S.a_ready(cur);
    if constexpr (SP2) {
        PG8_STAGE(PG8_SB(0, 0), cB, voffB); PG8_STAGE(PG8_SB(0, 1), cB + hstep, voffB); PG8_STAGE(PG8_SA(0, 0), cA, voffA); PG8_STAGE(PG8_SA(0, 1), cA + hstep, voffA);
        if (wr == 1) PG8_BAR;
        PG8_WAIT_V(2); PG8_BAR;
        PG8_STAGE(PG8_SB(1, 0), cB + kstep, voffB); PG8_STAGE(PG8_SA(1, 0), cA + kstep, voffA); PG8_STAGE(PG8_SB(1, 1), cB + hstep + kstep, voffB);
        PG8_WAIT_V(6); PG8_BAR;
    } else {
        PG8_STAGE(PG8_SB(0, 0), cB, voffB); PG8_STAGE(PG8_SA(0, 0), cA, voffA); PG8_STAGE(PG8_SB(0, 1), cB + hstep, voffB); PG8_STAGE(PG8_SA(0, 1), cA + hstep, voffA);
        if (wr == 1) PG8_BAR;
        PG8_WAIT_V(4); PG8_BAR;
        PG8_STAGE(PG8_SB(1, 0), cB + kstep, voffB); PG8_STAGE(PG8_SA(1, 0), cA + kstep, voffA); PG8_STAGE(PG8_SB(1, 1), cB + hstep + kstep, voffB);
        PG8_WAIT_V(6); PG8_BAR;
    }
    for (;;) {
        const bool has_next = S.next(ui + 1, nxt);
        const char* nA = has_next ? (const char*)(nxt.sel ? g.A1 : g.A) + (size_t)nxt.pm * tstep : cA; const char* nB = has_next ? (const char*)(nxt.sel ? g.Bt1 : g.Bt) + (size_t)nxt.pn * tstep : cB;
        for (int t = 0; t < nt; t += 2) {
            const bool last = (t == nt - 2);
            const char* a1 = cA + (size_t)(t + 1) * kstep;
            const char* a2 = last ? nA : cA + (size_t)(t + 2) * kstep; const char* b2 = last ? nB : cB + (size_t)(t + 2) * kstep;
            const char* a3 = a2 + kstep; const char* b3 = b2 + kstep;
            if (last && has_next) S.a_ready(nxt);
            if constexpr (SP2) {
            PG8_LDB(B0, 0, 0); PG8_LDB(B1, 0, 1); PG8_SCHED; PG8_LDA(At, 0, 0); PG8_STAGE(PG8_SA(1, 1), a1 + hstep, voffA);
            PG8_WAIT_V(8); PG8_WAIT_L(0); PG8_BAR; PG8_MMA(0, 0, At, B0); PG8_MMA(0, 1, At, B1); PG8_BAR; PG8_SCHED;
            PG8_LDA(At, 0, 1); PG8_STAGE(PG8_SB(0, 0), b2, voffB); PG8_STAGE(PG8_SB(0, 1), b2 + hstep, voffB); PG8_STAGE(PG8_SA(0, 0), a2, voffA);
            PG8_WAIT_V(8); PG8_WAIT_L(0); PG8_BAR; PG8_MMA(1, 0, At, B0); PG8_MMA(1, 1, At, B1); PG8_BAR; PG8_SCHED;
            PG8_LDB(B0, 1, 0); PG8_LDB(B1, 1, 1); PG8_SCHED; PG8_LDA(At, 1, 0); PG8_STAGE(PG8_SA(0, 1), a2 + hstep, voffA);
            PG8_WAIT_V(8); PG8_WAIT_L(0); PG8_BAR; PG8_MMA(0, 0, At, B0); PG8_MMA(0, 1, At, B1); PG8_BAR; PG8_SCHED;
            PG8_LDA(At, 1, 1); PG8_STAGE(PG8_SB(1, 0), b3, voffB); PG8_STAGE(PG8_SB(1, 1), b3 + hstep, voffB); PG8_STAGE(PG8_SA(1, 0), a3, voffA);
            PG8_WAIT_V(8); PG8_WAIT_L(0); PG8_BAR; PG8_MMA(1, 0, At, B0); PG8_MMA(1, 1, At, B1); PG8_BAR; PG8_SCHED;
            } else {
            PG8_LDB(B0, 0, 0); PG8_SCHED; PG8_LDA(At, 0, 0); PG8_STAGE(PG8_SA(1, 1), a1 + hstep, voffA);
            PG8_WAIT_L(8); PG8_BAR; PG8_WAIT_L(0); PG8_MMA(0, 0, At, B0); PG8_BAR; PG8_SCHED;
            PG8_LDB(B1, 0, 1); PG8_STAGE(PG8_SB(0, 0), b2, voffB);
            PG8_BAR; PG8_WAIT_L(0); PG8_MMA(0, 1, At, B1); PG8_BAR;
            PG8_LDA(At, 0, 1); PG8_STAGE(PG8_SA(0, 0), a2, voffA);
            PG8_BAR; PG8_WAIT_L(0); PG8_MMA(1, 0, At, B0); PG8_BAR; PG8_SCHED;
            PG8_STAGE(PG8_SB(0, 1), b2 + hstep, voffB);
            PG8_WAIT_V(6); PG8_BAR; PG8_MMA(1, 1, At, B1); PG8_BAR;
            PG8_LDB(B0, 1, 0); PG8_SCHED; PG8_LDA(At, 1, 0); PG8_STAGE(PG8_SA(0, 1), a2 + hstep, voffA);
            PG8_WAIT_L(8); PG8_BAR; PG8_WAIT_L(0); PG8_MMA(0, 0, At, B0); PG8_BAR; PG8_SCHED;
            PG8_LDB(B1, 1, 1); PG8_STAGE(PG8_SB(1, 0), b3, voffB);
            PG8_BAR; PG8_WAIT_L(0); PG8_MMA(0, 1, At, B1); PG8_BAR;
            PG8_LDA(At, 1, 1); PG8_STAGE(PG8_SA(1, 0), a3, voffA);
            PG8_BAR; PG8_WAIT_L(0); PG8_MMA(1, 0, At, B0); PG8_BAR; PG8_SCHED;
            PG8_STAGE(PG8_SB(1, 1), b3 + hstep, voffB);
            PG8_WAIT_V(6); PG8_BAR; PG8_MMA(1, 1, At, B1); PG8_BAR;
            }
        }
        if constexpr (ALIGN_EPI) { if (wr == 0) PG8_BAR; }
        if constexpr (!Epi::AFTER_DRAIN) { E(acc, cur, wr, wc, fr, fq); S.done(cur); }
        if (!has_next) break;
        if (!E.keep(cur)) zero_acc(acc);
        cur = nxt; cA = nA; cB = nB; ++ui;
        if constexpr (ALIGN_EPI) { if (wr == 1) PG8_BAR; }
    }
    PG8_WAIT_V(0);
    if constexpr (!ALIGN_EPI) { if (wr == 0) PG8_BAR; }
    PG8_BAR;
    if constexpr (Epi::AFTER_DRAIN) { E.fused(acc, cur, wr, wc, fr, fq, lds, wid, lane); S.done(cur); }
#undef PG8_SA
#undef PG8_SB
#undef PG8_STAGE
#undef PG8_LDA
#undef PG8_LDB
#undef PG8_MMA
#undef PG8_WAIT_V
#undef PG8_WAIT_L
#undef PG8_BAR
#undef PG8_SCHED
}}

constexpr int NWAVES = 8;
constexpr int DM = 1024, MTOK = 32768, TP = 16384  , LP = 2048, LS = 16384;
constexpr int HW = 512, INW = 4352, FFN = 2816, NPROJ = INW - 3 * HW  ;
constexpr float RMS_EPS = 1e-6f;

constexpr size_t MiB = 1u << 20;
constexpr size_t WS_CTL = 0, CTL_ZERO_BYTES = 1 * MiB;
constexpr size_t WS_WINA = 1 * MiB;
constexpr size_t WS_WINB = 4 * MiB;
constexpr size_t WS_WHY = 10 * MiB;
constexpr size_t WS_WAT = 11 * MiB;
constexpr size_t WS_WO = 12 * MiB;
constexpr size_t WS_WGU = 14 * MiB;
constexpr size_t WS_WD = 25 * MiB;
constexpr size_t WS_XB = 32 * MiB;
constexpr size_t WS_YT = 32 * MiB;
constexpr size_t WS_YAT = 64 * MiB;
constexpr size_t WS_KREV_S = 96 * MiB;
constexpr size_t WS_KREV_P = 160 * MiB;
constexpr size_t WS_UT = 168 * MiB;
constexpr size_t WS_Q = 264 * MiB;
constexpr size_t WS_K = 296 * MiB;
constexpr size_t WS_V = 304 * MiB;
constexpr size_t WS_SGH = 312 * MiB;
constexpr size_t WS_SGA = 376 * MiB;
constexpr size_t WS_COS = 440 * MiB;
constexpr size_t WS_SIN = 442 * MiB;
constexpr size_t WS_RSTD = 444 * MiB;
constexpr size_t WS_SSQ = 445 * MiB;
constexpr size_t WS_FPART_S = 447 * MiB;
constexpr size_t WS_FPART_P = 449 * MiB;
constexpr size_t WS_YHY = 450 * MiB;
constexpr size_t WS_MERGED = 168 * MiB;
constexpr size_t WS_X1B = 232 * MiB;
constexpr size_t WS_HID = 32 * MiB;
constexpr size_t WS_END = 482 * MiB;
static_assert(WS_HID + (size_t)MTOK * FFN * 2 <= WS_X1B, "hid vs x1b");

constexpr int CW_TMO = 0, CW_CODE = 1;
constexpr int CW_BAR = 4096;

constexpr int RING_OFF = 0;
constexpr int LDS_BYTES = 147456;
constexpr int LDSCTL_OFF = LDS_BYTES - 512, MISC_OFF = LDSCTL_OFF + 320;

#define GAS __attribute__((address_space(1)))
#define LAS __attribute__((address_space(3)))
typedef unsigned short bf16;
typedef unsigned v4u __attribute__((ext_vector_type(4)));
typedef unsigned v2u __attribute__((ext_vector_type(2)));
typedef float f32x4 __attribute__((ext_vector_type(4)));
typedef float f32x16 __attribute__((ext_vector_type(16)));
typedef short bf16x8 __attribute__((ext_vector_type(8)));
typedef GAS unsigned gu32;
#define RLX_AGENT __ATOMIC_RELAXED, __HIP_MEMORY_SCOPE_AGENT
#define LDS_WAIT() asm volatile("s_waitcnt lgkmcnt(0)" ::: "memory")
#define VM_WAIT() asm volatile("s_waitcnt vmcnt(0)" ::: "memory")
__device__ __forceinline__ unsigned f2bf(float f) { unsigned u = __builtin_bit_cast(unsigned, f); return (u + 0x7fffu + ((u >> 16) & 1u)) >> 16; }
__device__ __forceinline__ unsigned pk2(float lo, float hi) { return f2bf(lo) | (f2bf(hi) << 16); }
__device__ __forceinline__ float bf2f(unsigned short b) { return __uint_as_float((unsigned)b << 16); }
__device__ __forceinline__ float wave_sum(float v) {
#pragma unroll
    for (int o = 1; o < 64; o <<= 1) v += __shfl_xor(v, o);
    return v;
}

#define XB_TMO      128
#define XB_XCNT(j)  (256  + 64 * (j))
#define XB_XSUB(j)  (1280 + 64 * (j))
#define XB_XGEN(j)  (2304 + 64 * (j))
#define XB_TOP      3328
#define XB_TOPGEN   3392
#define XCD_BAR_WORDS 3456
#define XB_SPIN_CAP (1u << 18)

__device__ __forceinline__ unsigned xb_ld(unsigned* p)              { return __hip_atomic_load(p, __ATOMIC_RELAXED, __HIP_MEMORY_SCOPE_AGENT); }
__device__ __forceinline__ unsigned xb_add(unsigned* p, unsigned v) { return __hip_atomic_fetch_add(p, v, __ATOMIC_RELAXED, __HIP_MEMORY_SCOPE_AGENT); }
__device__ __forceinline__ unsigned xb_xcc_id() { return (unsigned)__builtin_amdgcn_s_getreg((3 << 11) | 20) & 0xFu; }
#define XB_SPIN(cond, bar) do { unsigned _sp = 0; while (cond) { __builtin_amdgcn_s_sleep(1); \
    if ((++_sp & 255u) == 0u) { if (xb_ld(&(bar)[XB_TMO])) break; if (_sp > XB_SPIN_CAP) { atomicAdd(&(bar)[XB_TMO], 1u); break; } } } } while (0)

struct XcdBarrier { unsigned* bar; unsigned x; volatile LAS unsigned* st; };

__device__ __forceinline__ XcdBarrier xcd_barrier_post(unsigned* bar, volatile LAS unsigned* st) {
    XcdBarrier b; b.bar = bar; b.x = xb_xcc_id(); b.st = st;
    if (threadIdx.x == 0) (void)xb_add(&bar[XB_XCNT(b.x)], 1u);
    return b;
}
__device__ __forceinline__ void xcd_barrier_complete(unsigned* bar, unsigned x, unsigned& nloc, unsigned& nx) {
    const unsigned G = gridDim.x * gridDim.y * gridDim.z;
    unsigned sum, cnt, mine, sp = 0u;
    for (;;) {
        sum = 0u; cnt = 0u; mine = 0u;
#pragma unroll
        for (unsigned j = 0; j < 16; ++j) { const unsigned c = xb_ld(&bar[XB_XCNT(j)]); sum += c; cnt += (c > 0u) ? 1u : 0u; mine = (j == x) ? c : mine; }
        if (sum == G) break;
        __builtin_amdgcn_s_sleep(1);
        if ((++sp & 255u) == 0u) { if (xb_ld(&bar[XB_TMO])) break; if (sp > XB_SPIN_CAP) { atomicAdd(&bar[XB_TMO], 1u); break; } }
    }
    nloc = mine > 0u ? mine : 1u; nx = cnt > 0u ? cnt : 1u;
}
__device__ __forceinline__ void xcd_barrier(const XcdBarrier& b) {
    asm volatile("s_waitcnt vmcnt(0)" ::: "memory");
    __syncthreads();
    if (threadIdx.x == 0) {
        unsigned* bar = b.bar;
        __builtin_amdgcn_s_waitcnt(0);
        unsigned nloc = b.st[0], nx = b.st[1];
        if (nloc == 0u) { xcd_barrier_complete(bar, b.x, nloc, nx); b.st[0] = nloc; b.st[1] = nx; }
        const unsigned old = xb_add(&bar[XB_XSUB(b.x)], 1u);
        const unsigned gen = old / nloc;
        if (old + 1u == (gen + 1u) * nloc) {
            __builtin_amdgcn_fence(__ATOMIC_RELEASE, "agent");
            asm volatile("s_waitcnt vmcnt(0)" ::: "memory");
            const unsigned og = xb_add(&bar[XB_TOP], 1u);
            const unsigned tg = og / nx;
            if (og + 1u == (tg + 1u) * nx) xb_add(&bar[XB_TOPGEN], 1u);
            else XB_SPIN(xb_ld(&bar[XB_TOPGEN]) == tg, bar);
            __builtin_amdgcn_fence(__ATOMIC_ACQUIRE, "agent");
            xb_add(&bar[XB_XGEN(b.x)], 1u);
            asm volatile("s_waitcnt vmcnt(0)" ::: "memory");
        } else {
            XB_SPIN(xb_ld(&bar[XB_XGEN(b.x)]) == gen, bar);
            __builtin_amdgcn_fence(__ATOMIC_ACQUIRE, "agent");
            asm volatile("s_waitcnt vmcnt(0)" ::: "memory");
        }
    }
    __syncthreads();
}

struct Frame {
    LAS unsigned char* lds;
    volatile LAS unsigned* MISC;
    gu32* ctl;
    int tid, lane, wave;
    int vcu, G;
    unsigned char* ws;
};

__device__ __forceinline__ void p0_transpose_item(const float* W, int K, int N, bf16* WT, int dst_row0, const float* kscale, LAS float* scr, int k0, int n0, int lane) {
#pragma unroll 8
    for (int i = 0; i < 32; ++i) { const int kk = 2 * i + (lane >> 5); float v = W[(size_t)(k0 + kk) * N + n0 + (lane & 31)]; if (kscale) v *= kscale[k0 + kk]; scr[kk * 33 + (lane & 31)] = v; }
    LDS_WAIT(); asm volatile("" ::: "memory");
    const int c = lane & 7;
#pragma unroll
    for (int j = 0; j < 4; ++j) { const int n = (lane >> 3) + 8 * j; const LAS float* s = scr + (8 * c) * 33 + n;
        v4u o; o.x = pk2(s[0 * 33], s[1 * 33]); o.y = pk2(s[2 * 33], s[3 * 33]); o.z = pk2(s[4 * 33], s[5 * 33]); o.w = pk2(s[6 * 33], s[7 * 33]);
        *(GAS v4u*)(WT + (size_t)(dst_row0 + n) * K + k0 + 8 * c) = o; }
    LDS_WAIT(); asm volatile("" ::: "memory");
}
__device__ __forceinline__ int map_projB(int n0) {
    if (n0 < 2048) { const int t = n0 - 1536, hq = t >> 6, hf = (t >> 5) & 1; return 256 * (hq >> 2) + 128 * hf + 32 * (hq & 3); }
    if (n0 < 2176) { const int t = n0 - 2048, kh = t >> 6, hf = (t >> 5) & 1; return 512 + 128 * hf + 32 * kh; }
    if (n0 < 2304) { const int t = n0 - 2176, vh = t >> 6, hf = (t >> 5) & 1; return 512 + 128 * hf + 32 * (2 + vh); }
    return 768 + (n0 - 2304);
}
__device__ __forceinline__ void p0_row(const float* xrow, bf16* orow, float* rstd_out, int lane) {
    const GAS f32x4* xr = (const GAS f32x4*)xrow + lane;
    f32x4 v[4]; float s = 0.f;
#pragma unroll
    for (int j = 0; j < 4; ++j) { v[j] = xr[64 * j]; s += (v[j].x * v[j].x + v[j].y * v[j].y) + (v[j].z * v[j].z + v[j].w * v[j].w); }
    s = wave_sum(s);
    if (lane == 0) *rstd_out = 1.0f / sqrtf(s * (1.0f / DM) + RMS_EPS);
    GAS unsigned long long* o8 = (GAS unsigned long long*)orow + lane;
#pragma unroll
    for (int j = 0; j < 4; ++j) o8[64 * j] = (unsigned long long)pk2(v[j].x, v[j].y) | ((unsigned long long)pk2(v[j].z, v[j].w) << 32);
}
__device__ __forceinline__ void p0_filter_item(const float* w1, const float* b1, const float* w2, const float* b2, const float* w3, const float* fr, bf16* krev, float* fpart,
                                               int g, int chunk, int quarter, LAS float* scr, int lane) {
    const int L = g ? LS : LP; const int p = chunk * 64 + lane;
    const float t = (float)p / (float)(L - 1);
    scr[lane] = t;
#pragma unroll
    for (int i = 0; i < 16; ++i) { const float band = 1e-4f + (float)i * ((15.0f - 1e-4f) / 15.0f); const float ang = (6.283185307179586f / (float)L) * (float)p * band;
        scr[(1 + i) * 64 + lane] = cosf(ang); scr[(17 + i) * 64 + lane] = -sinf(ang); }
    LDS_WAIT(); asm volatile("" ::: "memory");
    float h[64];
#pragma unroll
    for (int j = 0; j < 64; ++j) h[j] = b1[j];
    for (int i = 0; i < 33; ++i) { const float zv = scr[i * 64 + lane];
#pragma unroll
        for (int j = 0; j < 64; ++j) h[j] += zv * w1[i * 64 + j]; }
    LDS_WAIT(); asm volatile("" ::: "memory");
#pragma unroll
    for (int j = 0; j < 64; ++j) scr[j * 64 + lane] = h[j];
    LDS_WAIT(); asm volatile("" ::: "memory");
    for (int j = 0; j < 64; ++j) scr[j * 64 + lane] = sinf(fr[j] * scr[j * 64 + lane]);
    LDS_WAIT(); asm volatile("" ::: "memory");
#pragma unroll
    for (int j = 0; j < 64; ++j) h[j] = b2[j];
    for (int i = 0; i < 64; ++i) { const float hv = scr[i * 64 + lane];
#pragma unroll
        for (int j = 0; j < 64; ++j) h[j] += hv * w2[i * 64 + j]; }
    LDS_WAIT(); asm volatile("" ::: "memory");
#pragma unroll
    for (int j = 0; j < 64; ++j) scr[j * 64 + lane] = h[j];
    LDS_WAIT(); asm volatile("" ::: "memory");
    for (int j = 0; j < 64; ++j) scr[j * 64 + lane] = sinf(fr[j] * scr[j * 64 + lane]);
    LDS_WAIT(); asm volatile("" ::: "memory");
    const float dmin = -4.605170185988091f / 1.5f, dmax = -4.605170185988091f / 0.3f;
    for (int cgi = 0; cgi < 8; ++cgi) {
        const int col0 = (quarter * 8 + cgi) * 64;
#pragma unroll
        for (int j = 0; j < 64; ++j) h[j] = 0.f;
        for (int i = 0; i < 64; ++i) { const float hv = scr[i * 64 + lane];
#pragma unroll
            for (int j = 0; j < 64; ++j) h[j] += hv * w3[i * 2048 + col0 + j]; }
        const int o_ = col0 >> 10, dir = (col0 >> 9) & 1, cb = col0 & 511;
        const bool skip = (dir == 1) && (p == 0);
        const int m = dir ? (L - 1 + p) : (L - 1 - p);
        bf16* kr0 = krev + (size_t)(o_ * 512 + cb) * (2 * L);
#pragma unroll
        for (int j = 0; j < 64; ++j) {
            const float delta = fabsf(dmin + (float)(cb + j) * ((dmax - dmin) / 511.0f));
            const float kv = h[j] * (__expf(-t * delta) + 0.05f);
            const float s = wave_sum(skip ? 0.f : fabsf(kv));
            if (lane == 0) fpart[(size_t)chunk * 2048 + col0 + j] = s;
            bf16* kr = kr0 + (size_t)j * (2 * L);
            if (!skip) kr[m] = (bf16)f2bf(kv); else kr[2 * L - 1] = 0;
        }
    }
    LDS_WAIT(); asm volatile("" ::: "memory");
}

namespace hy {
constexpr int SLOTB = 272, Z_BYTES = 75776, F_OFF = 75776, F_BYTES = 65536, RED_OFF = F_OFF + F_BYTES;
__device__ __forceinline__ int slot_of(int g, int n) { return g ? (n + 31) : ((n >> 4) * 32 + 16 + (n & 15)); }
__device__ __forceinline__ int crow(int r, int hi) { return (r & 3) + 8 * (r >> 2) + 4 * hi; }

struct Params { const bf16* uT; const bf16* krev_s; const bf16* krev_p; const float* fpart_s; const float* fpart_p; const float* conv_w; const float* conv_b; const float* hbias; bf16* yT; };

__device__ __forceinline__ void conv3_chunk(const bf16* urow  , int g, int chunk, float w0, float w1, float w2, float b, float (&out)[8]) {
    const int tau0 = chunk * 8; const int L = g ? LS : LP; const int p0 = g ? tau0 : (tau0 & (LP - 1));
    const v4u raw = *(const GAS v4u*)(urow + tau0);
    float u[10];
    u[1] = pg8::bflo(raw.x); u[2] = pg8::bfhi(raw.x); u[3] = pg8::bflo(raw.y); u[4] = pg8::bfhi(raw.y); u[5] = pg8::bflo(raw.z); u[6] = pg8::bfhi(raw.z); u[7] = pg8::bflo(raw.w); u[8] = pg8::bfhi(raw.w);
    u[0] = (p0 > 0) ? bf2f(urow[tau0 - 1]) : 0.f;
    u[9] = (p0 + 8 < L) ? bf2f(urow[tau0 + 8]) : 0.f;
#pragma unroll
    for (int i = 0; i < 8; ++i) out[i] = w0 * u[i] + w1 * u[i + 1] + w2 * u[i + 2] + b;
}

__device__ __forceinline__ bf16x8 load_afrag(LAS const unsigned char* lds, int addr, int sh) {
    const LAS unsigned* p = (const LAS unsigned*)(lds + addr);
    const unsigned w0 = p[0], w1 = p[1], w2 = p[2], w3 = p[3], w4 = p[4];
    v4u f; f.x = __builtin_amdgcn_alignbit(w1, w0, sh); f.y = __builtin_amdgcn_alignbit(w2, w1, sh); f.z = __builtin_amdgcn_alignbit(w3, w2, sh); f.w = __builtin_amdgcn_alignbit(w4, w3, sh);
    return __builtin_bit_cast(bf16x8, f);
}

__device__ __forceinline__ void hyena_item(LAS unsigned char* lds, const Params& P, int g, int c, int tid) {
    const int lane = tid & 63, wave = __builtin_amdgcn_readfirstlane(tid >> 6), r = lane & 31, hi = lane >> 5, nt = wave & 3, half = wave >> 2;
    const int L = g ? LS : LP; const int T0 = g ? TP : 0;
    LAS float* red = (LAS float*)(lds + RED_OFF);
    float inv_norm0, inv_norm1;
    {
        const int nchunk = g ? 256 : 32; const float* fp = P.fpart_s + (g ? (size_t)0 : (size_t)((WS_FPART_P - WS_FPART_S) / 4));
        float s0 = 0.f, s1 = 0.f;
        for (int idx = tid; idx < nchunk * 2; idx += NWAVES * 64) { const int ch = idx >> 1, dir = idx & 1; s0 += fp[(size_t)ch * 2048 + dir * 512 + c]; s1 += fp[(size_t)ch * 2048 + 1024 + dir * 512 + c]; }
        s0 = wave_sum(s0); s1 = wave_sum(s1);
        if (lane == 0) { red[wave * 2] = s0; red[wave * 2 + 1] = s1; }
        for (int i = tid; i < Z_BYTES / 16; i += NWAVES * 64) *(LAS v4u*)(lds + i * 16) = (v4u){0u, 0u, 0u, 0u};
        LDS_WAIT(); __syncthreads();
        float t0 = 0.f, t1 = 0.f;
#pragma unroll
        for (int w = 0; w < NWAVES; ++w) { t0 += red[w * 2]; t1 += red[w * 2 + 1]; }
        inv_norm0 = 1.0f / t0; inv_norm1 = 1.0f / t1;
    }
    {
        const int ch = 2 * HW + c; const float w0 = P.conv_w[ch], w1 = P.conv_w[3 * HW + ch], w2 = P.conv_w[6 * HW + ch], b = P.conv_b[ch];
        const bf16* urow = P.uT + (size_t)ch * MTOK + T0;
        for (int it = 0; it < 4; ++it) { const int chunk = tid + it * 512; float o[8]; conv3_chunk(urow, g, chunk, w0, w1, w2, b, o);
            const int tau0 = chunk * 8; v4u pk; pk.x = pk2(o[0], o[1]); pk.y = pk2(o[2], o[3]); pk.z = pk2(o[4], o[5]); pk.w = pk2(o[6], o[7]);
            *(LAS v4u*)(lds + slot_of(g, tau0 >> 7) * SLOTB + (tau0 & 127) * 2) = pk; }
    }
    int d_hi, d_lo;
    if (g) { if (half == 0) { d_hi = 32 * nt + 31; d_lo = 32 * nt - 48; } else { d_hi = 32 * nt - 49; d_lo = 32 * nt - 127; } }
    else   { if (half == 0) { d_hi = 15; d_lo = 0; } else { d_hi = -1; d_lo = -15; } }
    int abase = F_OFF + 2 * ((L - 1) - r + 8 * hi); const int sh = (abase & 2) ? 16 : 0; abase &= ~3;
    const int zb = slot_of(g, 32 * nt + r) * SLOTB + 16 * hi;
    const int mi0 = 2 * half;

    for (int o = 0; o < 2; ++o) {
        {
            const bf16* ksrc = P.krev_s + (g ? (size_t)0 : (size_t)((WS_KREV_P - WS_KREV_S) / 2)) + (size_t)(o * HW + c) * (2 * L);
            const int n16 = (2 * L * 2) / 16;
            for (int i = tid; i < n16; i += NWAVES * 64) *(LAS v4u*)(lds + F_OFF + i * 16) = *(const GAS v4u*)(ksrc + i * 8);
        }
        LDS_WAIT(); __syncthreads();
        f32x16 acc[4];
#pragma unroll
        for (int mi = 0; mi < 4; ++mi) acc[mi] = (f32x16){0.f,0.f,0.f,0.f,0.f,0.f,0.f,0.f,0.f,0.f,0.f,0.f,0.f,0.f,0.f,0.f};
        bf16x8 Fw[8];
        {
            const int q0 = -8 * d_hi;
#pragma unroll
            for (int s = 2; s < 8; ++s) Fw[s] = load_afrag(lds, abase + 32 * (q0 - 8 + s), sh);
            Fw[0] = Fw[2]; Fw[1] = Fw[3];
        }
        for (int d = d_hi; d >= d_lo; --d) {
            const int aq = abase + 32 * (-8 * d), bq = zb - d * SLOTB;
#pragma unroll
            for (int jk = 0; jk < 8; ++jk) {
                Fw[jk] = load_afrag(lds, aq + 32 * jk, sh);
                const bf16x8 zf = *(const LAS bf16x8*)(lds + bq + 32 * jk);
#pragma unroll
                for (int mi = 0; mi < 4; ++mi) acc[mi] = __builtin_amdgcn_mfma_f32_32x32x16_bf16(Fw[(jk - 2 * mi) & 7], zf, acc[mi], 0, 0, 0);
            }
        }
        LDS_WAIT(); __syncthreads();
        {
            LAS float* X = (LAS float*)(lds + F_OFF) + wave * 2048;
#pragma unroll
            for (int t = 0; t < 2; ++t)
#pragma unroll
                for (int rg = 0; rg < 16; ++rg) X[(t * 16 + rg) * 64 + lane] = (half == 0) ? acc[2 + t][rg] : acc[t][rg];
        }
        LDS_WAIT(); __syncthreads();
        f32x16 fin[2];
        {
            const LAS float* X = (const LAS float*)(lds + F_OFF) + (wave ^ 4) * 2048;
#pragma unroll
            for (int t = 0; t < 2; ++t)
#pragma unroll
                for (int rg = 0; rg < 16; ++rg) fin[t][rg] = ((half == 0) ? acc[t][rg] : acc[2 + t][rg]) + X[(t * 16 + rg) * 64 + lane];
        }
        LDS_WAIT(); __syncthreads();
        {
            const int ch = o * HW + c; const float w0 = P.conv_w[ch], w1 = P.conv_w[3 * HW + ch], w2 = P.conv_w[6 * HW + ch], b = P.conv_b[ch];
            const bf16* urow = P.uT + (size_t)ch * MTOK + T0;
            for (int it = 0; it < 4; ++it) { const int chunk = tid + it * 512; float v[8]; conv3_chunk(urow, g, chunk, w0, w1, w2, b, v);
                LAS f32x4* dst = (LAS f32x4*)(lds + F_OFF + chunk * 32); dst[0] = (f32x4){v[0], v[1], v[2], v[3]}; dst[1] = (f32x4){v[4], v[5], v[6], v[7]}; }
        }
        LDS_WAIT(); __syncthreads();
        {
            const float sb = P.hbias[o * HW + c], inr = o ? inv_norm1 : inv_norm0;
            const LAS float* G = (const LAS float*)(lds + F_OFF);
            const int n = 32 * nt + r; LAS bf16* zs = (LAS bf16*)(lds + slot_of(g, n) * SLOTB);
#pragma unroll
            for (int t = 0; t < 2; ++t)
#pragma unroll
                for (int rg = 0; rg < 16; ++rg) { const int i = 32 * (mi0 + t) + crow(rg, hi);
                    const float zo = bf2f(zs[i]); const float val = G[128 * n + i] * (inr * fin[t][rg] + sb * zo); zs[i] = (bf16)f2bf(val); }
        }
        LDS_WAIT(); __syncthreads();
    }
    {
        bf16* yrow = P.yT + (size_t)c * MTOK + T0;
        for (int it = 0; it < 4; ++it) { const int chunk = tid + it * 512, tau0 = chunk * 8;
            *(GAS v4u*)(yrow + tau0) = *(const LAS v4u*)(lds + slot_of(g, tau0 >> 7) * SLOTB + (tau0 & 127) * 2); }
    }
    LDS_WAIT(); __syncthreads();
}
}

namespace at {
constexpr int KROW = 144, VROW = 776, K_OFF = 0, V_OFF = 384 * KROW  , END_OFF = V_OFF + 64 * VROW;
__device__ __forceinline__ int crow(int r, int hi) { return (r & 3) + 8 * (r >> 2) + 4 * hi; }
struct Params { const bf16* q; const bf16* k; const bf16* v; const float* sink; bf16* yat; };

__device__ __forceinline__ void attn_item(LAS unsigned char* lds, const Params& P, int blk, int gk, int tid) {
    const int lane = tid & 63, wave = __builtin_amdgcn_readfirstlane(tid >> 6), r = lane & 31, hi = lane >> 5;
    const int m0 = blk * 128; const int s_lo = (blk < 128) ? (m0 & ~(LP - 1)) : TP, s_hi = (blk < 128) ? s_lo + LP : MTOK; const int kw0 = m0 - 128;
    for (int it = 0; it < 6; ++it) {
        const int idx = tid + it * 512, key = idx >> 3, chn = idx & 7, tok = kw0 + key; const bool ok = (tok >= s_lo) && (tok < s_hi);
        v4u kv = (v4u){0u, 0u, 0u, 0u}, vv = (v4u){0u, 0u, 0u, 0u};
        if (ok) { kv = *(const GAS v4u*)(P.k + (size_t)tok * 128 + gk * 64 + chn * 8); vv = *(const GAS v4u*)(P.v + (size_t)tok * 128 + gk * 64 + chn * 8); }
        *(LAS v4u*)(lds + K_OFF + key * KROW + chn * 16) = kv;
        LAS bf16* vt = (LAS bf16*)(lds + V_OFF + (chn * 8) * VROW + key * 2);
        vt[0 * (VROW / 2)] = (bf16)(vv.x & 0xffffu); vt[1 * (VROW / 2)] = (bf16)(vv.x >> 16); vt[2 * (VROW / 2)] = (bf16)(vv.y & 0xffffu); vt[3 * (VROW / 2)] = (bf16)(vv.y >> 16);
        vt[4 * (VROW / 2)] = (bf16)(vv.z & 0xffffu); vt[5 * (VROW / 2)] = (bf16)(vv.z >> 16); vt[6 * (VROW / 2)] = (bf16)(vv.w & 0xffffu); vt[7 * (VROW / 2)] = (bf16)(vv.w >> 16);
    }
    LDS_WAIT(); __syncthreads();
    const int hq = 4 * gk + (wave & 3), qh = wave >> 2;
    const int klo = (s_lo - kw0) > 0 ? (s_lo - kw0) : 0, khi = (s_hi - kw0) < 384 ? (s_hi - kw0) : 384;
    const float sinkl = P.sink[hq] * 1.4426950408889634f;
    for (int qq = 0; qq < 2; ++qq) {
        const int qt = 2 * qh + qq, q0 = 32 * qt; const size_t qrow = (size_t)(m0 + q0 + r);
        bf16x8 qf[4];
#pragma unroll
        for (int ks = 0; ks < 4; ++ks) qf[ks] = *(const GAS bf16x8*)(P.q + qrow * 512 + hq * 64 + 16 * ks + 8 * hi);
        float m_run = sinkl, l_run = (hi == 0) ? 1.0f : 0.0f;
        f32x16 o0 = (f32x16){0.f,0.f,0.f,0.f,0.f,0.f,0.f,0.f,0.f,0.f,0.f,0.f,0.f,0.f,0.f,0.f}, o1 = o0;
        const int lo_r = (q0 + r) > klo ? (q0 + r) : klo, hi_r = (q0 + r + 256) < (khi - 1) ? (q0 + r + 256) : (khi - 1);
        for (int kt = qt; kt <= qt + 8; ++kt) {
            const int kb = 32 * kt;
            f32x16 s = (f32x16){0.f,0.f,0.f,0.f,0.f,0.f,0.f,0.f,0.f,0.f,0.f,0.f,0.f,0.f,0.f,0.f};
#pragma unroll
            for (int ks = 0; ks < 4; ++ks) { const bf16x8 kf = *(const LAS bf16x8*)(lds + K_OFF + (kb + r) * KROW + 32 * ks + 16 * hi);
                s = __builtin_amdgcn_mfma_f32_32x32x16_bf16(kf, qf[ks], s, 0, 0, 0); }
            float tmax = -1e30f;
#pragma unroll
            for (int rg = 0; rg < 16; ++rg) { const int kj = kb + crow(rg, hi); const float sv = (kj >= lo_r && kj <= hi_r) ? s[rg] : -1e30f; s[rg] = sv; tmax = fmaxf(tmax, sv); }
            tmax = fmaxf(tmax, __shfl_xor(tmax, 32));
            const float mnew = fmaxf(m_run, tmax); const float alpha = __builtin_amdgcn_exp2f(m_run - mnew); m_run = mnew;
            float psum = 0.f;
#pragma unroll
            for (int rg = 0; rg < 16; ++rg) { const float p = __builtin_amdgcn_exp2f(s[rg] - mnew); s[rg] = p; psum += p; }
            l_run = l_run * alpha + psum;
#pragma unroll
            for (int rg = 0; rg < 16; ++rg) { o0[rg] *= alpha; o1[rg] *= alpha; }
            v4u pa, pb;
            pa.x = pk2(s[0], s[1]); pa.y = pk2(s[2], s[3]); pa.z = pk2(s[4], s[5]); pa.w = pk2(s[6], s[7]);
            pb.x = pk2(s[8], s[9]); pb.y = pk2(s[10], s[11]); pb.z = pk2(s[12], s[13]); pb.w = pk2(s[14], s[15]);
            const bf16x8 pf0 = __builtin_bit_cast(bf16x8, pa), pf1 = __builtin_bit_cast(bf16x8, pb);
#pragma unroll
            for (int dt = 0; dt < 2; ++dt) {
                const LAS unsigned char* vb = lds + V_OFF + (32 * dt + r) * VROW + (kb + 4 * hi) * 2;
                v4u va, vc;
                { const v2u x0 = *(const LAS v2u*)(vb), x1 = *(const LAS v2u*)(vb + 16); va = (v4u){x0.x, x0.y, x1.x, x1.y}; }
                { const v2u x0 = *(const LAS v2u*)(vb + 32), x1 = *(const LAS v2u*)(vb + 48); vc = (v4u){x0.x, x0.y, x1.x, x1.y}; }
                if (dt == 0) { o0 = __builtin_amdgcn_mfma_f32_32x32x16_bf16(__builtin_bit_cast(bf16x8, va), pf0, o0, 0, 0, 0); o0 = __builtin_amdgcn_mfma_f32_32x32x16_bf16(__builtin_bit_cast(bf16x8, vc), pf1, o0, 0, 0, 0); }
                else         { o1 = __builtin_amdgcn_mfma_f32_32x32x16_bf16(__builtin_bit_cast(bf16x8, va), pf0, o1, 0, 0, 0); o1 = __builtin_amdgcn_mfma_f32_32x32x16_bf16(__builtin_bit_cast(bf16x8, vc), pf1, o1, 0, 0, 0); }
            }
        }
        l_run += __shfl_xor(l_run, 32);
        const float inv = 1.0f / l_run;
        bf16* yrow = P.yat + qrow * 512 + hq * 64;
#pragma unroll
        for (int g4 = 0; g4 < 4; ++g4) {
            v2u w0, w1;
            w0.x = pk2(o0[4 * g4] * inv, o0[4 * g4 + 1] * inv); w0.y = pk2(o0[4 * g4 + 2] * inv, o0[4 * g4 + 3] * inv);
            w1.x = pk2(o1[4 * g4] * inv, o1[4 * g4 + 1] * inv); w1.y = pk2(o1[4 * g4 + 2] * inv, o1[4 * g4 + 3] * inv);
            *(GAS v2u*)(yrow + 8 * g4 + 4 * hi) = w0; *(GAS v2u*)(yrow + 32 + 8 * g4 + 4 * hi) = w1;
        }
    }
    LDS_WAIT(); __syncthreads();
}
}

__device__ __forceinline__ void transpose_y_tile(LAS unsigned char* lds, const bf16* yT, bf16* yhy, int tile, int tid) {
    const int c0 = (tile & 7) * 64, t0 = (tile >> 3) * 64;
    LAS bf16* T = (LAS bf16*)lds;
    { const int ch = tid >> 3, k8 = tid & 7; *(LAS v4u*)(T + ch * 72 + k8 * 8) = *(const GAS v4u*)(yT + (size_t)(c0 + ch) * MTOK + t0 + k8 * 8); }
    LDS_WAIT(); __syncthreads();
    { const int tk = tid >> 3, c8 = tid & 7; unsigned short e[8];
#pragma unroll
      for (int j = 0; j < 8; ++j) e[j] = T[(c8 * 8 + j) * 72 + tk];
      v4u o; o.x = e[0] | ((unsigned)e[1] << 16); o.y = e[2] | ((unsigned)e[3] << 16); o.z = e[4] | ((unsigned)e[5] << 16); o.w = e[6] | ((unsigned)e[7] << 16);
      *(GAS v4u*)(yhy + (size_t)(t0 + tk) * 512 + c0 + c8 * 8) = o; }
    LDS_WAIT(); __syncthreads();
}

#ifndef MK_SPLIT
#define MK_SPLIT 0
#endif
constexpr int N_PHASES = 8;
struct Args { const float* in[23]; float* out; unsigned char* ws; int ph_lo, ph_hi; };

__global__ void __launch_bounds__(NWAVES * 64, 2) enc_fwd(Args args) {
    extern __shared__ __attribute__((aligned(16))) unsigned char lds_raw[];
    Frame F;
    F.lds = (LAS unsigned char*)lds_raw;
    F.MISC = (volatile LAS unsigned*)(F.lds + MISC_OFF);
    F.tid = threadIdx.x; F.lane = F.tid & 63; F.wave = __builtin_amdgcn_readfirstlane(F.tid >> 6);
    F.G = gridDim.x; { const int bx = blockIdx.x; F.vcu = (F.G % 8 == 0) ? (bx % 8) * (F.G / 8) + bx / 8 : bx; }
    F.ws = args.ws; F.ctl = (gu32*)(args.ws + WS_CTL);
    unsigned char* const ws = args.ws;
    for (int u = F.tid; u < (LDS_BYTES - LDSCTL_OFF) / 4; u += NWAVES * 64) ((LAS unsigned*)(F.lds + LDSCTL_OFF))[u] = 0u;
    __syncthreads();
    const int lo = args.ph_lo, hi = args.ph_hi;
    XcdBarrier bar; bar.bar = (unsigned*)(F.ctl + CW_BAR); bar.x = 0; bar.st = nullptr;
    if (hi - lo > 1) bar = xcd_barrier_post((unsigned*)(F.ctl + CW_BAR), F.MISC + 8);
#define IN(k) (lo <= (k) && (k) < hi)
#define SEAM(k) do { if (IN(k) && IN((k) + 1)) xcd_barrier(bar); } while (0)

    const float* const xp = args.in[0]; const float* const xs = args.in[1];
    bf16* const WINA = (bf16*)(ws + WS_WINA); bf16* const WINB = (bf16*)(ws + WS_WINB); bf16* const WHY = (bf16*)(ws + WS_WHY); bf16* const WAT = (bf16*)(ws + WS_WAT);
    bf16* const WO = (bf16*)(ws + WS_WO); bf16* const WGU = (bf16*)(ws + WS_WGU); bf16* const WD = (bf16*)(ws + WS_WD);
    bf16* const XB = (bf16*)(ws + WS_XB); bf16* const YT = (bf16*)(ws + WS_YT); bf16* const YAT = (bf16*)(ws + WS_YAT);
    bf16* const KREV_S = (bf16*)(ws + WS_KREV_S); bf16* const KREV_P = (bf16*)(ws + WS_KREV_P); bf16* const UT = (bf16*)(ws + WS_UT);
    bf16* const QB = (bf16*)(ws + WS_Q); bf16* const KB = (bf16*)(ws + WS_K); bf16* const VB = (bf16*)(ws + WS_V);
    bf16* const SGH = (bf16*)(ws + WS_SGH); bf16* const SGA = (bf16*)(ws + WS_SGA);
    float* const COS = (float*)(ws + WS_COS); float* const SIN = (float*)(ws + WS_SIN); float* const RSTD = (float*)(ws + WS_RSTD); float* const SSQ = (float*)(ws + WS_SSQ);
    float* const FPART_S = (float*)(ws + WS_FPART_S); float* const FPART_P = (float*)(ws + WS_FPART_P);
    bf16* const YHY = (bf16*)(ws + WS_YHY); bf16* const MERGED = (bf16*)(ws + WS_MERGED); bf16* const X1B = (bf16*)(ws + WS_X1B); bf16* const HID = (bf16*)(ws + WS_HID);

    if (IN(0)) {
        LAS float* scr = (LAS float*)(F.lds + RING_OFF + F.wave * 16384);
        const int gw = F.vcu * NWAVES + F.wave, NGW = F.G * NWAVES;
        for (int it = gw; it < 288 * 4; it += NGW) {
            const int quarter = it & 3, ca = it >> 2, g = (ca < 256) ? 1 : 0, chunk = g ? ca : ca - 256;
            p0_filter_item(args.in[6], args.in[7], args.in[8], args.in[9], args.in[10], args.in[11], g ? KREV_S : KREV_P, g ? FPART_S : FPART_P, g, chunk, quarter, scr, F.lane);
        }
        constexpr int I_IN = 16 * 136, I_HY = 8 * 32, I_O = 16 * 32, I_G = 16 * 88, I_D = 44 * 32;
        constexpr int NITEMS = I_IN + 2 * I_HY + I_O + 2 * I_G + I_D;
        for (int it = gw; it < NITEMS; it += NGW) {
            int rr = it;
            if (rr < I_IN) { const int kb = rr / 136, nb = rr % 136, n0 = 32 * nb;
                if (n0 < 3 * HW) p0_transpose_item(args.in[3], DM, INW, WINA, n0, args.in[2], scr, 64 * kb, n0, F.lane);
                else p0_transpose_item(args.in[3], DM, INW, WINB, map_projB(n0), args.in[2], scr, 64 * kb, n0, F.lane);
                continue; } rr -= I_IN;
            if (rr < I_HY) { p0_transpose_item(args.in[16], HW, DM, WHY, 32 * (rr % 32), nullptr, scr, 64 * (rr / 32), 32 * (rr % 32), F.lane); continue; } rr -= I_HY;
            if (rr < I_HY) { p0_transpose_item(args.in[17], HW, DM, WAT, 32 * (rr % 32), nullptr, scr, 64 * (rr / 32), 32 * (rr % 32), F.lane); continue; } rr -= I_HY;
            if (rr < I_O) { p0_transpose_item(args.in[18], DM, DM, WO, 32 * (rr % 32), nullptr, scr, 64 * (rr / 32), 32 * (rr % 32), F.lane); continue; } rr -= I_O;
            if (rr < I_G) { const int n0 = 32 * (rr % 88); p0_transpose_item(args.in[20], DM, FFN, WGU, (n0 >> 7) * 256 + (n0 & 127), args.in[19], scr, 64 * (rr / 88), n0, F.lane); continue; } rr -= I_G;
            if (rr < I_G) { const int n0 = 32 * (rr % 88); p0_transpose_item(args.in[21], DM, FFN, WGU, (n0 >> 7) * 256 + 128 + (n0 & 127), args.in[19], scr, 64 * (rr / 88), n0, F.lane); continue; } rr -= I_G;
            p0_transpose_item(args.in[22], FFN, DM, WD, 32 * (rr % 32), nullptr, scr, 64 * (rr / 32), 32 * (rr % 32), F.lane);
        }
        for (int m = gw; m < MTOK; m += NGW) p0_row((m < TP) ? xp + (size_t)m * DM : xs + (size_t)(m - TP) * DM, XB + (size_t)m * DM, RSTD + m, F.lane);
        for (int idx = F.vcu * (NWAVES * 64) + F.tid; idx < LS * 32; idx += F.G * NWAVES * 64) {
            const int pos = idx >> 5, i = idx & 31; const double inv = exp2(-(double)i * (13.287712379549449 / 32.0)); const double ang = (double)pos * inv;
            COS[idx] = (float)cos(ang); SIN[idx] = (float)sin(ang);
        }
    }
    SEAM(0);

    if (IN(1)) {
        {
            pg8::Gemm g{WINA, XB, nullptr, nullptr, 3 * HW, MTOK, DM}; pg8::StaticOrder S; S.init(3 * HW, MTOK, F.G, (int)blockIdx.x);
            pg8::EpiUT E{UT, MTOK, RSTD};
            pg8::gemm_phase<pg8::EpiUT, pg8::StaticOrder, true, true>(F.lds + RING_OFF, g, S, E);
        }
        {
            pg8::Gemm g{XB, WINB, nullptr, nullptr, MTOK, NPROJ, DM}; pg8::StaticOrder S; S.init(MTOK, NPROJ, F.G, (int)blockIdx.x);
            pg8::EpiProj E{RSTD, args.in[13], args.in[14], COS, SIN, QB, KB, VB, SGH, SGA};
            pg8::gemm_phase<pg8::EpiProj, pg8::StaticOrder, true, true>(F.lds + RING_OFF, g, S, E);
        }
    }
    SEAM(1);

    if (IN(2)) {
        const hy::Params HP{UT, KREV_S, KREV_P, FPART_S, FPART_P, args.in[4], args.in[5], args.in[12], YT};
        for (int it = F.vcu; it < 2 * HW; it += F.G) hy::hyena_item(F.lds, HP, (it < HW) ? 1 : 0, it & (HW - 1), F.tid);
        const at::Params AP{QB, KB, VB, args.in[15], YAT};
        for (int it = F.vcu; it < 512; it += F.G) at::attn_item(F.lds, AP, it >> 1, it & 1, F.tid);
    }
    SEAM(2);

    if (IN(3)) {
        for (int t = F.vcu; t < 8 * 512; t += F.G) transpose_y_tile(F.lds, YT, YHY, t, F.tid);
    }
    SEAM(3);

    if (IN(4)) {
        pg8::Gemm g{YHY, WHY, YAT, WAT, MTOK, DM, HW}; pg8::TwoPartOrder S; S.b.init(MTOK, DM, F.G, (int)blockIdx.x);
        pg8::EpiMerged E{SGH, SGA, MERGED};
        pg8::gemm_phase<pg8::EpiMerged, pg8::TwoPartOrder, false, true>(F.lds + RING_OFF, g, S, E);
    }
    SEAM(4);

    if (IN(5)) {
        pg8::Gemm g{MERGED, WO, nullptr, nullptr, MTOK, DM, DM}; pg8::StaticOrder S; S.init(MTOK, DM, F.G, (int)blockIdx.x);
        pg8::EpiWo E{xp, xs, args.out, X1B, SSQ};
        pg8::gemm_phase<pg8::EpiWo, pg8::StaticOrder, true, true>(F.lds + RING_OFF, g, S, E);
    }
    SEAM(5);

    if (IN(6)) {
        pg8::Gemm g{X1B, WGU, nullptr, nullptr, MTOK, 2 * FFN, DM}; pg8::StaticOrder S; S.init(MTOK, 2 * FFN, F.G, (int)blockIdx.x);
        pg8::EpiFfn1 E{SSQ, HID};
        pg8::gemm_phase<pg8::EpiFfn1, pg8::StaticOrder, true, true>(F.lds + RING_OFF, g, S, E);
    }
    SEAM(6);

    if (IN(7)) {
        pg8::Gemm g{HID, WD, nullptr, nullptr, MTOK, DM, FFN}; pg8::StaticOrder S; S.init(MTOK, DM, F.G, (int)blockIdx.x);
        pg8::EpiFfn2 E{args.out};
        pg8::gemm_phase<pg8::EpiFfn2, pg8::StaticOrder, true, true>(F.lds + RING_OFF, g, S, E);
    }
#undef IN
#undef SEAM
}

extern "C" void kernel_launch(void* const* d_in, const int* in_sizes, int n_in, void* d_out, int out_size, void* d_ws, size_t ws_size, hipStream_t stream) {
    static int grid = 0;
    if (grid == 0) {
        if (n_in != 23 || out_size != MTOK * DM || ws_size < WS_END) { fprintf(stderr, "kernel_launch: unexpected problem shape (n_in %d, out %d, ws %zu); nothing launched\n", n_in, out_size, ws_size); grid = -1; return; }
        int dev = 0, cus = 0, per_cu = 0;
        if (hipGetDevice(&dev) != hipSuccess || hipDeviceGetAttribute(&cus, hipDeviceAttributeMultiprocessorCount, dev) != hipSuccess) { fprintf(stderr, "kernel_launch: device query failed\n"); grid = -1; return; }
        if (hipFuncSetAttribute((const void*)enc_fwd, hipFuncAttributeMaxDynamicSharedMemorySize, LDS_BYTES) != hipSuccess) { fprintf(stderr, "kernel_launch: hipFuncSetAttribute failed\n"); grid = -1; return; }
        if (hipOccupancyMaxActiveBlocksPerMultiprocessor(&per_cu, (const void*)enc_fwd, NWAVES * 64, LDS_BYTES) != hipSuccess || per_cu < 1)
            fprintf(stderr, "kernel_launch: note: occupancy query reports %d workgroups per CU\n", per_cu);
        (void)hipGetLastError();
        grid = cus;
    }
    if (grid < 0) return;
    if (hipMemsetAsync((char*)d_ws + WS_CTL, 0, CTL_ZERO_BYTES, stream) != hipSuccess) { fprintf(stderr, "kernel_launch: memset failed\n"); return; }
    Args a{};
    for (int i = 0; i < 23; ++i) a.in[i] = (const float*)d_in[i];
    a.out = (float*)d_out; a.ws = (unsigned char*)d_ws;
#if MK_SPLIT
    for (int p = 0; p < N_PHASES; ++p) { a.ph_lo = p; a.ph_hi = p + 1; hipLaunchKernelGGL(enc_fwd, dim3(grid), dim3(NWAVES * 64), LDS_BYTES, stream, a); }
#else
    a.ph_lo = 0; a.ph_hi = N_PHASES;
    hipLaunchKernelGGL(enc_fwd, dim3(grid), dim3(NWAVES * 64), LDS_BYTES, stream, a);
#endif
    const hipError_t le = hipPeekAtLastError();
    if (le != hipSuccess) fprintf(stderr, "kernel_launch: launch failed: %s\n", hipGetErrorName(le));
}
```

```cpp
#include <hip/hip_runtime.h>
#include <cstdio>
#include <cstdint>
#include <cmath>
#ifndef PROBE
#define PROBE 0
#endif

namespace pg8 {
#define PG8_LAS __attribute__((address_space(3)))
typedef unsigned short bf16_t;
typedef short bf16x8 __attribute__((ext_vector_type(8)));
typedef float f32x4 __attribute__((ext_vector_type(4)));
typedef unsigned u32x4 __attribute__((ext_vector_type(4)));
constexpr int BM = 256, BK = 64, HALF = 128, HTB = HALF * BK * 2  , STAGE_BYTES = 8 * HTB, NXCD = 8, WGM = 8;

__host__ __device__ __forceinline__ int lds_byte(int r, int c) { const int st = (r >> 4) * 2 + (c >> 5), rr = r & 15, cc = c & 31, ob = rr * 64 + cc * 2; return st * 1024 + (ob ^ (((ob >> 9) & 1) << 5)); }
__host__ __device__ __forceinline__ void stage_rc(int b, int& R, int& C) { const int st = b / 1024, sb = b % 1024, swz = sb ^ (((sb >> 9) & 1) << 5); R = (st >> 1) * 16 + swz / 64; C = (st & 1) * 32 + (swz % 64) / 2; }
__host__ __device__ __forceinline__ int perm32(int rho) { const int n = rho >> 4, i = rho & 15; return 8 * (i >> 2) + 4 * n + (i & 3); }

struct Unit { int pm, pn, sel; };
struct Gemm { const bf16_t* A; const bf16_t* Bt; const bf16_t* A1; const bf16_t* Bt1; int M, N, K; };

struct StaticOrder {
    int nM, nN, nwg, G, c;
    __host__ __device__ __forceinline__ void init(int M, int N, int G_, int c_) { nM = M / BM; nN = N / BM; nwg = nM * nN; G = G_; c = c_; }
    __host__ __device__ __forceinline__ bool next(int i, Unit& u) const {
        const long L = (long)i * G + c; if (L >= nwg) return false;
        int wgid = (int)L; { const int q = nwg / NXCD, r = nwg % NXCD, xcd = wgid % NXCD, off = wgid / NXCD; wgid = (xcd < r ? xcd * (q + 1) : r * (q + 1) + (xcd - r) * q) + off; }
        const int nig = WGM * nN, gid = wgid / nig, fm = gid * WGM, gsz = (nM - fm) < WGM ? (nM - fm) : WGM;
        u.pm = fm + ((wgid % nig) % gsz); u.pn = (wgid % nig) / gsz; u.sel = 0; return true;
    }
    __device__ __forceinline__ void a_ready(const Unit&) const {}
    __device__ __forceinline__ void done(const Unit&) const {}
};
struct TwoPartOrder {
    StaticOrder b;
    __device__ __forceinline__ bool next(int i, Unit& u) const { if (!b.next(i >> 1, u)) return false; u.sel = i & 1; return true; }
    __device__ __forceinline__ void a_ready(const Unit&) const {}
    __device__ __forceinline__ void done(const Unit&) const {}
};

__device__ __forceinline__ unsigned cvt_pk_bf16(float lo, float hi) { unsigned r; asm volatile("v_cvt_pk_bf16_f32 %0, %1, %2" : "=v"(r) : "v"(lo), "v"(hi)); return r; }
__device__ __forceinline__ u32x4 pack8(const f32x4 a, const f32x4 b) { u32x4 w; w.x = cvt_pk_bf16(a[0], a[1]); w.y = cvt_pk_bf16(a[2], a[3]); w.z = cvt_pk_bf16(b[0], b[1]); w.w = cvt_pk_bf16(b[2], b[3]); return w; }
__device__ __forceinline__ float bflo(unsigned w) { return __uint_as_float(w << 16); }
__device__ __forceinline__ float bfhi(unsigned w) { return __uint_as_float(w & 0xffff0000u); }
__device__ __forceinline__ void unpack8(const u32x4 w, f32x4& a, f32x4& b) { a = (f32x4){bflo(w.x), bfhi(w.x), bflo(w.y), bfhi(w.y)}; b = (f32x4){bflo(w.z), bfhi(w.z), bflo(w.w), bfhi(w.w)}; }
__device__ __forceinline__ float sigmoidf_(float v) { return 1.0f / (1.0f + __expf(-v)); }

constexpr float QSCALE = 0.125f * 1.4426950408889634f;

struct EpiUT {
    static constexpr bool PERM = true, AFTER_DRAIN = false;
    bf16_t* O; int ldc; const float* rstd;
    __device__ __forceinline__ bool keep(const Unit&) const { return false; }
    __device__ __forceinline__ void operator()(f32x4 (&acc)[2][2][4][2], const Unit& u, int wr, int wc, int fr, int fq) const {
        const int row0 = u.pm * BM + wr * 64 + fr, col0 = u.pn * BM + wc * 32 + 8 * fq;
        f32x4 rs[2][2];
#pragma unroll
        for (int bj = 0; bj < 2; ++bj)
#pragma unroll
            for (int n = 0; n < 2; ++n) rs[bj][n] = *(const f32x4*)(rstd + col0 + bj * HALF + 4 * n);
#pragma unroll
        for (int ai = 0; ai < 2; ++ai)
#pragma unroll
            for (int m = 0; m < 4; ++m) { bf16_t* rowp = O + (size_t)(row0 + ai * HALF + m * 16) * ldc + col0;
#pragma unroll
                for (int bj = 0; bj < 2; ++bj) *(u32x4*)(rowp + bj * HALF) = pack8(acc[ai][bj][m][0] * rs[bj][0], acc[ai][bj][m][1] * rs[bj][1]); }
    }
};

struct EpiProj {
    static constexpr bool PERM = true, AFTER_DRAIN = false;
    const float* rstd; const float* qw; const float* kw; const float* cs; const float* sn; bf16_t* q; bf16_t* k; bf16_t* v; bf16_t* sgh; bf16_t* sga;
    __device__ __forceinline__ bool keep(const Unit&) const { return false; }
    __device__ __forceinline__ void operator()(f32x4 (&acc)[2][2][4][2], const Unit& u, int wr, int wc, int fr, int fq) const {
        const int pn = u.pn;
        if (pn <= 2 && !(pn == 2 && wc >= 2)) {
            const float* w = (pn < 2) ? qw : kw; const float sc = (pn < 2) ? QSCALE : 1.0f;
            const f32x4 wl0 = *(const f32x4*)(w + 8 * fq), wl1 = *(const f32x4*)(w + 8 * fq + 4), wh0 = *(const f32x4*)(w + 32 + 8 * fq), wh1 = *(const f32x4*)(w + 32 + 8 * fq + 4);
#pragma unroll
            for (int ai = 0; ai < 2; ++ai)
#pragma unroll
                for (int m = 0; m < 4; ++m) {
                    const int row = u.pm * BM + ai * HALF + wr * 64 + m * 16 + fr; const float rs = rstd[row];
                    f32x4 a0 = acc[ai][0][m][0] * rs, a1 = acc[ai][0][m][1] * rs, b0 = acc[ai][1][m][0] * rs, b1 = acc[ai][1][m][1] * rs;
                    f32x4 sq = a0 * a0 + a1 * a1 + b0 * b0 + b1 * b1; float ss = (sq[0] + sq[1]) + (sq[2] + sq[3]);
                    ss += __shfl_xor(ss, 16); ss += __shfl_xor(ss, 32);
                    const float inv = 1.0f / sqrtf(ss * (1.0f / 64.0f) + 1e-6f);
                    const int pos = row < 16384 ? (row & 2047) : (row - 16384);
                    const f32x4 c0 = *(const f32x4*)(cs + pos * 32 + 8 * fq), c1 = *(const f32x4*)(cs + pos * 32 + 8 * fq + 4), s0 = *(const f32x4*)(sn + pos * 32 + 8 * fq), s1 = *(const f32x4*)(sn + pos * 32 + 8 * fq + 4);
                    a0 = a0 * inv * wl0; a1 = a1 * inv * wl1; b0 = b0 * inv * wh0; b1 = b1 * inv * wh1;
                    const f32x4 lo0 = (a0 * c0 - b0 * s0) * sc, lo1 = (a1 * c1 - b1 * s1) * sc, hi0 = (b0 * c0 + a0 * s0) * sc, hi1 = (b1 * c1 + a1 * s1) * sc;
                    bf16_t* dst = (pn < 2) ? q + (size_t)row * 512 + (4 * pn + wc) * 64 + 8 * fq : k + (size_t)row * 128 + wc * 64 + 8 * fq;
                    *(u32x4*)dst = pack8(lo0, lo1); *(u32x4*)(dst + 32) = pack8(hi0, hi1);
                }
        } else if (pn == 2) {
#pragma unroll
            for (int ai = 0; ai < 2; ++ai)
#pragma unroll
                for (int m = 0; m < 4; ++m) {
                    const int row = u.pm * BM + ai * HALF + wr * 64 + m * 16 + fr; const float rs = rstd[row];
                    bf16_t* dst = v + (size_t)row * 128 + (wc - 2) * 64 + 8 * fq;
                    *(u32x4*)dst = pack8(acc[ai][0][m][0] * rs, acc[ai][0][m][1] * rs); *(u32x4*)(dst + 32) = pack8(acc[ai][1][m][0] * rs, acc[ai][1][m][1] * rs);
                }
        } else {
            bf16_t* base = (pn < 7) ? sgh : sga; const int colb = (pn - ((pn < 7) ? 3 : 7)) * BM + wc * 32 + 8 * fq;
#pragma unroll
            for (int ai = 0; ai < 2; ++ai)
#pragma unroll
                for (int m = 0; m < 4; ++m) {
                    const int row = u.pm * BM + ai * HALF + wr * 64 + m * 16 + fr; const float rs = rstd[row];
#pragma unroll
                    for (int bj = 0; bj < 2; ++bj) { f32x4 g0 = acc[ai][bj][m][0] * rs, g1 = acc[ai][bj][m][1] * rs;
#pragma unroll
                        for (int e = 0; e < 4; ++e) { g0[e] = sigmoidf_(g0[e]); g1[e] = sigmoidf_(g1[e]); }
                        *(u32x4*)(base + (size_t)row * 1024 + colb + bj * HALF) = pack8(g0, g1); }
                }
        }
    }
};

struct EpiMerged {
    static constexpr bool PERM = true, AFTER_DRAIN = false;
    const bf16_t* sgh; const bf16_t* sga; bf16_t* out;
    __device__ __forceinline__ bool keep(const Unit& u) const { return u.sel == 0; }
    __device__ __forceinline__ void operator()(f32x4 (&acc)[2][2][4][2], const Unit& u, int wr, int wc, int fr, int fq) const {
#pragma unroll
        for (int ai = 0; ai < 2; ++ai)
#pragma unroll
            for (int m = 0; m < 4; ++m) {
                const size_t off = (size_t)(u.pm * BM + ai * HALF + wr * 64 + m * 16 + fr) * 1024 + u.pn * BM + wc * 32 + 8 * fq;
#pragma unroll
                for (int bj = 0; bj < 2; ++bj) {
                    f32x4 t0, t1; unpack8(*(const u32x4*)(sga + off + bj * HALF), t0, t1);
                    if (u.sel == 0) { f32x4 h0, h1; unpack8(*(const u32x4*)(sgh + off + bj * HALF), h0, h1);
                        acc[ai][bj][m][0] = acc[ai][bj][m][0] * (h0 / t0); acc[ai][bj][m][1] = acc[ai][bj][m][1] * (h1 / t1); }
                    else *(u32x4*)(out + off + bj * HALF) = pack8(acc[ai][bj][m][0] * t0, acc[ai][bj][m][1] * t1);
                }
            }
    }
};

struct EpiWo {
    static constexpr bool PERM = true, AFTER_DRAIN = false;
    const float* xp; const float* xs; float* x1; bf16_t* x1b; float* ssq;
    __device__ __forceinline__ bool keep(const Unit&) const { return false; }
    __device__ __forceinline__ void operator()(f32x4 (&acc)[2][2][4][2], const Unit& u, int wr, int wc, int fr, int fq) const {
        const float* xb = (u.pm < 64) ? xp : xs - (size_t)16384 * 1024;
#pragma unroll
        for (int ai = 0; ai < 2; ++ai)
#pragma unroll
            for (int m = 0; m < 4; ++m) {
                const int row = u.pm * BM + ai * HALF + wr * 64 + m * 16 + fr; const size_t off = (size_t)row * 1024 + u.pn * BM + wc * 32 + 8 * fq; float s = 0.f;
#pragma unroll
                for (int bj = 0; bj < 2; ++bj) {
                    const f32x4 v0 = *(const f32x4*)(xb + off + bj * HALF) + acc[ai][bj][m][0], v1 = *(const f32x4*)(xb + off + bj * HALF + 4) + acc[ai][bj][m][1];
                    *(f32x4*)(x1 + off + bj * HALF) = v0; *(f32x4*)(x1 + off + bj * HALF + 4) = v1; *(u32x4*)(x1b + off + bj * HALF) = pack8(v0, v1);
                    const f32x4 q = v0 * v0 + v1 * v1; s += (q[0] + q[1]) + (q[2] + q[3]); }
                s += __shfl_xor(s, 16); s += __shfl_xor(s, 32);
                if (fq == 0) ssq[(size_t)row * 16 + u.pn * 4 + wc] = s;
            }
    }
};

struct EpiFfn1 {
    static constexpr bool PERM = true, AFTER_DRAIN = false;
    const float* ssq; bf16_t* hid;
    __device__ __forceinline__ bool keep(const Unit&) const { return false; }
    __device__ __forceinline__ void operator()(f32x4 (&acc)[2][2][4][2], const Unit& u, int wr, int wc, int fr, int fq) const {
#pragma unroll
        for (int ai = 0; ai < 2; ++ai)
#pragma unroll
            for (int m = 0; m < 4; ++m) {
                const int row = u.pm * BM + ai * HALF + wr * 64 + m * 16 + fr;
                const f32x4 p = *(const f32x4*)(ssq + (size_t)row * 16 + 4 * fq); float t = (p[0] + p[1]) + (p[2] + p[3]);
                t += __shfl_xor(t, 16); t += __shfl_xor(t, 32);
                const float r = 1.0f / sqrtf(t * (1.0f / 1024.0f) + 1e-6f);
                f32x4 h0, h1;
#pragma unroll
                for (int e = 0; e < 4; ++e) { const float g0 = acc[ai][0][m][0][e] * r, g1 = acc[ai][0][m][1][e] * r;
                    h0[e] = g0 * sigmoidf_(g0) * (acc[ai][1][m][0][e] * r); h1[e] = g1 * sigmoidf_(g1) * (acc[ai][1][m][1][e] * r); }
                *(u32x4*)(hid + (size_t)row * 2816 + u.pn * HALF + wc * 32 + 8 * fq) = pack8(h0, h1);
            }
    }
};

struct EpiFfn2 {
    static constexpr bool PERM = true, AFTER_DRAIN = false;
    float* out;
    __device__ __forceinline__ bool keep(const Unit&) const { return false; }
    __device__ __forceinline__ void operator()(f32x4 (&acc)[2][2][4][2], const Unit& u, int wr, int wc, int fr, int fq) const {
#pragma unroll
        for (int ai = 0; ai < 2; ++ai)
#pragma unroll
            for (int m = 0; m < 4; ++m) {
                float* p = out + (size_t)(u.pm * BM + ai * HALF + wr * 64 + m * 16 + fr) * 1024 + u.pn * BM + wc * 32 + 8 * fq;
#pragma unroll
                for (int bj = 0; bj < 2; ++bj) { const f32x4 v0 = *(const f32x4*)(p + bj * HALF) + acc[ai][bj][m][0], v1 = *(const f32x4*)(p + bj * HALF + 4) + acc[ai][bj][m][1];
                    *(f32x4*)(p + bj * HALF) = v0; *(f32x4*)(p + bj * HALF + 4) = v1; }
            }
    }
};

__device__ __forceinline__ void zero_acc(f32x4 (&acc)[2][2][4][2]) {
#pragma unroll
    for (int a = 0; a < 2; ++a)
#pragma unroll
        for (int b = 0; b < 2; ++b)
#pragma unroll
            for (int m = 0; m < 4; ++m)
#pragma unroll
                for (int n = 0; n < 2; ++n) acc[a][b][m][n] = (f32x4){0.f, 0.f, 0.f, 0.f};
}
template <class Epi, class Sched, bool ALIGN_EPI = false, bool SP2 = false>
__device__ __forceinline__ void gemm_phase(PG8_LAS unsigned char* lds, const Gemm g, const Sched& S, const Epi& E) {
    const int tid = threadIdx.x, wid = __builtin_amdgcn_readfirstlane(tid >> 6), lane = tid & 63, wr = wid >> 2, wc = wid & 3, fr = lane & 15, fq = lane >> 4;
    const int K = g.K, nt = K / BK;
    unsigned voffA[2], voffB[2];
#pragma unroll
    for (int i = 0; i < 2; ++i) { int R, C; stage_rc(tid * 16 + i * 8192, R, C); const int Rb = Epi::PERM ? ((R & ~31) + perm32(R & 31)) : R;
        voffA[i] = (unsigned)(R * K + C) * 2u; voffB[i] = (unsigned)(Rb * K + C) * 2u; }
    const size_t kstep = (size_t)(BK * 2);
    const size_t hstep = (size_t)HALF * K * 2;
    const size_t tstep = 2 * hstep;
    const unsigned ldsw = (unsigned)wid * 1024u;
    const int aoff = lds_byte(wr * 64 + fr, fq * 8), boff = lds_byte(wc * 32 + fr, fq * 8);
#define PG8_SA(b, h) (((b) * 2 + (h)) * HTB)
#define PG8_SB(b, h) ((4 + (b) * 2 + (h)) * HTB)
#define PG8_STAGE(bufoff, gbase, voff) do { _Pragma("unroll") for (int _i = 0; _i < 2; ++_i) \
        __builtin_amdgcn_global_load_lds((const unsigned*)((const char*)(gbase) + (voff)[_i]), (PG8_LAS unsigned*)(lds + (bufoff) + ldsw + _i * 8192), 16, 0, 0); } while (0)
#define PG8_LDA(dst, b, h) do { _Pragma("unroll") for (int m = 0; m < 4; ++m) _Pragma("unroll") for (int k = 0; k < 2; ++k) dst[m][k] = *(const PG8_LAS bf16x8*)(lds + PG8_SA(b, h) + aoff + m * 2048 + k * 1024); } while (0)
#define PG8_LDB(dst, b, h) do { _Pragma("unroll") for (int n = 0; n < 2; ++n) _Pragma("unroll") for (int k = 0; k < 2; ++k) dst[n][k] = *(const PG8_LAS bf16x8*)(lds + PG8_SB(b, h) + boff + n * 2048 + k * 1024); } while (0)
#define PG8_MMA(ai, bj, At, Bt) do { __builtin_amdgcn_s_setprio(1); _Pragma("unroll") for (int m = 0; m < 4; ++m) _Pragma("unroll") for (int n = 0; n < 2; ++n) _Pragma("unroll") for (int k = 0; k < 2; ++k) \
        acc[ai][bj][m][n] = __builtin_amdgcn_mfma_f32_16x16x32_bf16(Bt[n][k], At[m][k], acc[ai][bj][m][n], 0, 0, 0); __builtin_amdgcn_s_setprio(0); } while (0)
#define PG8_WAIT_V(n) asm volatile("s_waitcnt vmcnt(" #n ")" ::: "memory")
#define PG8_WAIT_L(n) asm volatile("s_waitcnt lgkmcnt(" #n ")" ::: "memory")
#define PG8_BAR __builtin_amdgcn_s_barrier()
#define PG8_SCHED __builtin_amdgcn_sched_barrier(0)
    Unit cur, nxt; int ui = 0;
    if (!S.next(0, cur)) return;
    f32x4 acc[2][2][4][2];
#pragma unroll
    for (int a = 0; a < 2; ++a)
#pragma unroll
        for (int b = 0; b < 2; ++b)
#pragma unroll
            for (int m = 0; m < 4; ++m)
#pragma unroll
                for (int n = 0; n < 2; ++n) acc[a][b][m][n] = (f32x4){0.f, 0.f, 0.f, 0.f};
    bf16x8 At[4][2], B0[2][2], B1[2][2];
    const char* cA = (const char*)(cur.sel ? g.A1 : g.A) + (size_t)cur.pm * tstep; const char* cB = (const char*)(cur.sel ? g.Bt1 : g.Bt) + (size_t)cur.pn * tstep;
    S.a_ready(cur);
    if constexpr (SP2) {
        PG8_STAGE(PG8_SB(0, 0), cB, voffB); PG8_STAGE(PG8_SB(0, 1), cB + hstep, voffB); PG8_STAGE(PG8_SA(0, 0), cA, voffA); PG8_STAGE(PG8_SA(0, 1), cA + hstep, voffA);
        if (wr == 1) PG8_BAR;
        PG8_WAIT_V(2); PG8_BAR;
        PG8_STAGE(PG8_SB(1, 0), cB + kstep, voffB); PG8_STAGE(PG8_SA(1, 0), cA + kstep, voffA); PG8_STAGE(PG8_SB(1, 1), cB + hstep + kstep, voffB);
        PG8_WAIT_V(6); PG8_BAR;
    } else {
        PG8_STAGE(PG8_SB(0, 0), cB, voffB); PG8_STAGE(PG8_SA(0, 0), cA, voffA); PG8_STAGE(PG8_SB(0, 1), cB + hstep, voffB); PG8_STAGE(PG8_SA(0, 1), cA + hstep, voffA);
        if (wr == 1) PG8_BAR;
        PG8_WAIT_V(4); PG8_BAR;
        PG8_STAGE(PG8_SB(1, 0), cB + kstep, voffB); PG8_STAGE(PG8_SA(1, 0), cA + kstep, voffA); PG8_STAGE(PG8_SB(1, 1), cB + hstep + kstep, voffB);
        PG8_WAIT_V(6); PG8_BAR;
    }
    for (;;) {
        const bool has_next = S.next(ui + 1, nxt);
        const char* nA = has_next ? (const char*)(nxt.sel ? g.A1 : g.A) + (size_t)nxt.pm * tstep : cA; const char* nB = has_next ? (const char*)(nxt.sel ? g.Bt1 : g.Bt) + (size_t)nxt.pn * tstep : cB;
        for (int t = 0; t < nt; t += 2) {
            const bool last = (t == nt - 2);
            const char* a1 = cA + (size_t)(t + 1) * kstep;
            const char* a2 = last ? nA : cA + (size_t)(t + 2) * kstep; const char* b2 = last ? nB : cB + (size_t)(t + 2) * kstep;
            const char* a3 = a2 + kstep; const char* b3 = b2 + kstep;
            if (last && has_next) S.a_ready(nxt);
            if constexpr (SP2) {
            PG8_LDB(B0, 0, 0); PG8_LDB(B1, 0, 1); PG8_SCHED; PG8_LDA(At, 0, 0); PG8_STAGE(PG8_SA(1, 1), a1 + hstep, voffA);
            PG8_WAIT_V(8); PG8_WAIT_L(0); PG8_BAR; PG8_MMA(0, 0, At, B0); PG8_MMA(0, 1, At, B1); PG8_BAR; PG8_SCHED;
            PG8_LDA(At, 0, 1); PG8_STAGE(PG8_SB(0, 0), b2, voffB); PG8_STAGE(PG8_SB(0, 1), b2 + hstep, voffB); PG8_STAGE(PG8_SA(0, 0), a2, voffA);
            PG8_WAIT_V(8); PG8_WAIT_L(0); PG8_BAR; PG8_MMA(1, 0, At, B0); PG8_MMA(1, 1, At, B1); PG8_BAR; PG8_SCHED;
            PG8_LDB(B0, 1, 0); PG8_LDB(B1, 1, 1); PG8_SCHED; PG8_LDA(At, 1, 0); PG8_STAGE(PG8_SA(0, 1), a2 + hstep, voffA);
            PG8_WAIT_V(8); PG8_WAIT_L(0); PG8_BAR; PG8_MMA(0, 0, At, B0); PG8_MMA(0, 1, At, B1); PG8_BAR; PG8_SCHED;
            PG8_LDA(At, 1, 1); PG8_STAGE(PG8_SB(1, 0), b3, voffB); PG8_STAGE(PG8_SB(1, 1), b3 + hstep, voffB); PG8_STAGE(PG8_SA(1, 0), a3, voffA);
            PG8_WAIT_V(8); PG8_WAIT_L(0); PG8_BAR; PG8_MMA(1, 0, At, B0); PG8_MMA(1, 1, At, B1); PG8_BAR; PG8_SCHED;
            } else {
            PG8_LDB(B0, 0, 0); PG8_SCHED; PG8_LDA(At, 0, 0); PG8_STAGE(PG8_SA(1, 1), a1 + hstep, voffA);
            PG8_WAIT_L(8); PG8_BAR; PG8_WAIT_L(0); PG8_MMA(0, 0, At, B0); PG8_BAR; PG8_SCHED;
            PG8_LDB(B1, 0, 1); PG8_STAGE(PG8_SB(0, 0), b2, voffB);
            PG8_BAR; PG8_WAIT_L(0); PG8_MMA(0, 1, At, B1); PG8_BAR;
            PG8_LDA(At, 0, 1); PG8_STAGE(PG8_SA(0, 0), a2, voffA);
            PG8_BAR; PG8_WAIT_L(0); PG8_MMA(1, 0, At, B0); PG8_BAR; PG8_SCHED;
            PG8_STAGE(PG8_SB(0, 1), b2 + hstep, voffB);
            PG8_WAIT_V(6); PG8_BAR; PG8_MMA(1, 1, At, B1); PG8_BAR;
            PG8_LDB(B0, 1, 0); PG8_SCHED; PG8_LDA(At, 1, 0); PG8_STAGE(PG8_SA(0, 1), a2 + hstep, voffA);
            PG8_WAIT_L(8); PG8_BAR; PG8_WAIT_L(0); PG8_MMA(0, 0, At, B0); PG8_BAR; PG8_SCHED;
            PG8_LDB(B1, 1, 1); PG8_STAGE(PG8_SB(1, 0), b3, voffB);
            PG8_BAR; PG8_WAIT_L(0); PG8_MMA(0, 1, At, B1); PG8_BAR;
            PG8_LDA(At, 1, 1); PG8_STAGE(PG8_SA(1, 0), a3, voffA);
            PG8_BAR; PG8_WAIT_L(0); PG8_MMA(1, 0, At, B0); PG8_BAR; PG8_SCHED;
            PG8_STAGE(PG8_SB(1, 1), b3 + hstep, voffB);
            PG8_WAIT_V(6); PG8_BAR; PG8_MMA(1, 1, At, B1); PG8_BAR;
            }
        }
        if constexpr (ALIGN_EPI) { if (wr == 0) PG8_BAR; }
        if constexpr (!Epi::AFTER_DRAIN) { E(acc, cur, wr, wc, fr, fq); S.done(cur); }
        if (!has_next) break;
        if (!E.keep(cur)) zero_acc(acc);
        cur = nxt; cA = nA; cB = nB; ++ui;
        if constexpr (ALIGN_EPI) { if (wr == 1) PG8_BAR; }
    }
    PG8_WAIT_V(0);
    if constexpr (!ALIGN_EPI) { if (wr == 0) PG8_BAR; }
    PG8_BAR;
    if constexpr (Epi::AFTER_DRAIN) { E.fused(acc, cur, wr, wc, fr, fq, lds, wid, lane); S.done(cur); }
#undef PG8_SA
#undef PG8_SB
#undef PG8_STAGE
#undef PG8_LDA
#undef PG8_LDB
#undef PG8_MMA
#undef PG8_WAIT_V
#undef PG8_WAIT_L
#undef PG8_BAR
#undef PG8_SCHED
}}

constexpr int NWAVES = 8;
constexpr int DM = 1024, MTOK = 32768, TP = 16384  , LP = 2048, LS = 16384;
constexpr int HW = 512, INW = 4352, FFN = 2816, NPROJ = INW - 3 * HW  ;
constexpr float RMS_EPS = 1e-6f;

constexpr size_t MiB = 1u << 20;
constexpr size_t WS_CTL = 0, CTL_ZERO_BYTES = 1 * MiB;
constexpr size_t WS_WINA = 1 * MiB;
constexpr size_t WS_WINB = 4 * MiB;
constexpr size_t WS_WHY = 10 * MiB;
constexpr size_t WS_WAT = 11 * MiB;
constexpr size_t WS_WO = 12 * MiB;
constexpr size_t WS_WGU = 14 * MiB;
constexpr size_t WS_WD = 25 * MiB;
constexpr size_t WS_W3T = 31 * MiB;
constexpr size_t WS_XB = 32 * MiB;
constexpr size_t WS_YT = 32 * MiB;
constexpr size_t WS_YAT = 64 * MiB;
constexpr size_t WS_KREV_S = 96 * MiB;
constexpr size_t WS_KREV_P = 160 * MiB;
constexpr size_t WS_UT = 168 * MiB;
constexpr size_t WS_Q = 264 * MiB;
constexpr size_t WS_K = 296 * MiB;
constexpr size_t WS_V = 304 * MiB;
constexpr size_t WS_SGH = 312 * MiB;
constexpr size_t WS_SGA = 376 * MiB;
constexpr size_t WS_COS = 440 * MiB;
constexpr size_t WS_SIN = 442 * MiB;
constexpr size_t WS_RSTD = 444 * MiB;
constexpr size_t WS_SSQ = 445 * MiB;
constexpr size_t WS_FPART_S = 447 * MiB;
constexpr size_t WS_FPART_P = 449 * MiB;
constexpr size_t WS_YHY = 450 * MiB;
constexpr size_t WS_MERGED = 168 * MiB;
constexpr size_t WS_X1B = 232 * MiB;
constexpr size_t WS_HID = 32 * MiB;
constexpr size_t WS_END = 482 * MiB;
static_assert(WS_HID + (size_t)MTOK * FFN * 2 <= WS_X1B, "hid vs x1b");

constexpr int CW_TMO = 0, CW_CODE = 1;
constexpr int CW_BAR = 4096;

constexpr int RING_OFF = 0;
constexpr int LDS_BYTES = 147456;
constexpr int LDSCTL_OFF = LDS_BYTES - 512, MISC_OFF = LDSCTL_OFF + 320;

#define GAS __attribute__((address_space(1)))
#define LAS __attribute__((address_space(3)))
typedef unsigned short bf16;
typedef unsigned v4u __attribute__((ext_vector_type(4)));
typedef unsigned v2u __attribute__((ext_vector_type(2)));
typedef float f32x4 __attribute__((ext_vector_type(4)));
typedef float f32x16 __attribute__((ext_vector_type(16)));
typedef short bf16x8 __attribute__((ext_vector_type(8)));
typedef GAS unsigned gu32;
#define RLX_AGENT __ATOMIC_RELAXED, __HIP_MEMORY_SCOPE_AGENT
#define LDS_WAIT() asm volatile("s_waitcnt lgkmcnt(0)" ::: "memory")
#define VM_WAIT() asm volatile("s_waitcnt vmcnt(0)" ::: "memory")
__device__ __forceinline__ unsigned f2bf(float f) { unsigned u = __builtin_bit_cast(unsigned, f); return (u + 0x7fffu + ((u >> 16) & 1u)) >> 16; }
__device__ __forceinline__ unsigned pk2(float lo, float hi) { return f2bf(lo) | (f2bf(hi) << 16); }
__device__ __forceinline__ float bf2f(unsigned short b) { return __uint_as_float((unsigned)b << 16); }
__device__ __forceinline__ float wave_sum(float v) {
#pragma unroll
    for (int o = 1; o < 64; o <<= 1) v += __shfl_xor(v, o);
    return v;
}

#define XB_TMO      128
#define XB_XCNT(j)  (256  + 64 * (j))
#define XB_XSUB(j)  (1280 + 64 * (j))
#define XB_XGEN(j)  (2304 + 64 * (j))
#define XB_TOP      3328
#define XB_TOPGEN   3392
#define XCD_BAR_WORDS 3456
#define XB_SPIN_CAP (1u << 18)

__device__ __forceinline__ unsigned xb_ld(unsigned* p)              { return __hip_atomic_load(p, __ATOMIC_RELAXED, __HIP_MEMORY_SCOPE_AGENT); }
__device__ __forceinline__ unsigned xb_add(unsigned* p, unsigned v) { return __hip_atomic_fetch_add(p, v, __ATOMIC_RELAXED, __HIP_MEMORY_SCOPE_AGENT); }
__device__ __forceinline__ unsigned xb_xcc_id() { return (unsigned)__builtin_amdgcn_s_getreg((3 << 11) | 20) & 0xFu; }
#define XB_SPIN(cond, bar) do { unsigned _sp = 0; while (cond) { __builtin_amdgcn_s_sleep(1); \
    if ((++_sp & 255u) == 0u) { if (xb_ld(&(bar)[XB_TMO])) break; if (_sp > XB_SPIN_CAP) { atomicAdd(&(bar)[XB_TMO], 1u); break; } } } } while (0)

struct XcdBarrier { unsigned* bar; unsigned x; volatile LAS unsigned* st; };

__device__ __forceinline__ XcdBarrier xcd_barrier_post(unsigned* bar, volatile LAS unsigned* st) {
    XcdBarrier b; b.bar = bar; b.x = xb_xcc_id(); b.st = st;
    if (threadIdx.x == 0) (void)xb_add(&bar[XB_XCNT(b.x)], 1u);
    return b;
}
__device__ __forceinline__ void xcd_barrier_complete(unsigned* bar, unsigned x, unsigned& nloc, unsigned& nx) {
    const unsigned G = gridDim.x * gridDim.y * gridDim.z;
    unsigned sum, cnt, mine, sp = 0u;
    for (;;) {
        sum = 0u; cnt = 0u; mine = 0u;
#pragma unroll
        for (unsigned j = 0; j < 16; ++j) { const unsigned c = xb_ld(&bar[XB_XCNT(j)]); sum += c; cnt += (c > 0u) ? 1u : 0u; mine = (j == x) ? c : mine; }
        if (sum == G) break;
        __builtin_amdgcn_s_sleep(1);
        if ((++sp & 255u) == 0u) { if (xb_ld(&bar[XB_TMO])) break; if (sp > XB_SPIN_CAP) { atomicAdd(&bar[XB_TMO], 1u); break; } }
    }
    nloc = mine > 0u ? mine : 1u; nx = cnt > 0u ? cnt : 1u;
}
__device__ __forceinline__ void xcd_barrier(const XcdBarrier& b) {
    asm volatile("s_waitcnt vmcnt(0)" ::: "memory");
    __syncthreads();
    if (threadIdx.x == 0) {
        unsigned* bar = b.bar;
        __builtin_amdgcn_s_waitcnt(0);
        unsigned nloc = b.st[0], nx = b.st[1];
        if (nloc == 0u) { xcd_barrier_complete(bar, b.x, nloc, nx); b.st[0] = nloc; b.st[1] = nx; }
        const unsigned old = xb_add(&bar[XB_XSUB(b.x)], 1u);
        const unsigned gen = old / nloc;
        if (old + 1u == (gen + 1u) * nloc) {
            __builtin_amdgcn_fence(__ATOMIC_RELEASE, "agent");
            asm volatile("s_waitcnt vmcnt(0)" ::: "memory");
            const unsigned og = xb_add(&bar[XB_TOP], 1u);
            const unsigned tg = og / nx;
            if (og + 1u == (tg + 1u) * nx) xb_add(&bar[XB_TOPGEN], 1u);
            else XB_SPIN(xb_ld(&bar[XB_TOPGEN]) == tg, bar);
            __builtin_amdgcn_fence(__ATOMIC_ACQUIRE, "agent");
            xb_add(&bar[XB_XGEN(b.x)], 1u);
            asm volatile("s_waitcnt vmcnt(0)" ::: "memory");
        } else {
            XB_SPIN(xb_ld(&bar[XB_XGEN(b.x)]) == gen, bar);
            __builtin_amdgcn_fence(__ATOMIC_ACQUIRE, "agent");
            asm volatile("s_waitcnt vmcnt(0)" ::: "memory");
        }
    }
    __syncthreads();
}

struct Frame {
    LAS unsigned char* lds;
    volatile LAS unsigned* MISC;
    gu32* ctl;
    int tid, lane, wave;
    int vcu, G;
    unsigned char* ws;
};

__device__ __forceinline__ void p0_transpose_item(const float* W, int K, int N, bf16* WT, int dst_row0, const float* kscale, LAS float* scr, int k0, int n0, int lane) {
#pragma unroll 8
    for (int i = 0; i < 32; ++i) { const int kk = 2 * i + (lane >> 5); float v = W[(size_t)(k0 + kk) * N + n0 + (lane & 31)]; if (kscale) v *= kscale[k0 + kk]; scr[kk * 33 + (lane & 31)] = v; }
    LDS_WAIT(); asm volatile("" ::: "memory");
    const int c = lane & 7;
#pragma unroll
    for (int j = 0; j < 4; ++j) { const int n = (lane >> 3) + 8 * j; const LAS float* s = scr + (8 * c) * 33 + n;
        v4u o; o.x = pk2(s[0 * 33], s[1 * 33]); o.y = pk2(s[2 * 33], s[3 * 33]); o.z = pk2(s[4 * 33], s[5 * 33]); o.w = pk2(s[6 * 33], s[7 * 33]);
        *(GAS v4u*)(WT + (size_t)(dst_row0 + n) * K + k0 + 8 * c) = o; }
    LDS_WAIT(); asm volatile("" ::: "memory");
}
__device__ __forceinline__ int map_projB(int n0) {
    if (n0 < 2048) { const int t = n0 - 1536, hq = t >> 6, hf = (t >> 5) & 1; return 256 * (hq >> 2) + 128 * hf + 32 * (hq & 3); }
    if (n0 < 2176) { const int t = n0 - 2048, kh = t >> 6, hf = (t >> 5) & 1; return 512 + 128 * hf + 32 * kh; }
    if (n0 < 2304) { const int t = n0 - 2176, vh = t >> 6, hf = (t >> 5) & 1; return 512 + 128 * hf + 32 * (2 + vh); }
    return 768 + (n0 - 2304);
}
__device__ __forceinline__ void p0_row(const float* xrow, bf16* orow, float* rstd_out, int lane) {
    const GAS f32x4* xr = (const GAS f32x4*)xrow + lane;
    f32x4 v[4]; float s = 0.f;
#pragma unroll
    for (int j = 0; j < 4; ++j) { v[j] = xr[64 * j]; s += (v[j].x * v[j].x + v[j].y * v[j].y) + (v[j].z * v[j].z + v[j].w * v[j].w); }
    s = wave_sum(s);
    if (lane == 0) *rstd_out = 1.0f / sqrtf(s * (1.0f / DM) + RMS_EPS);
    GAS unsigned long long* o8 = (GAS unsigned long long*)orow + lane;
#pragma unroll
    for (int j = 0; j < 4; ++j) o8[64 * j] = (unsigned long long)pk2(v[j].x, v[j].y) | ((unsigned long long)pk2(v[j].z, v[j].w) << 32);
}
constexpr int FW_W1 = 0, FW_W2 = 33 * 64 * 4, FW_B1 = FW_W2 + 64 * 64 * 4, FW_B2 = FW_B1 + 256, FW_FR = FW_B2 + 256, FW_END = FW_FR + 256, FT_PITCH = 144, FT_BYTES = 32 * FT_PITCH;
__device__ __forceinline__ void filter_stage_weights(LAS unsigned char* lds, const float* w1, const float* b1, const float* w2, const float* b2, const float* fr, int tid) {
    LAS float* W1 = (LAS float*)(lds + FW_W1); LAS float* W2 = (LAS float*)(lds + FW_W2);
    for (int i = tid; i < 33 * 64; i += NWAVES * 64) W1[i] = w1[i];
    for (int i = tid; i < 64 * 64; i += NWAVES * 64) W2[i] = w2[i];
    if (tid < 64) { ((LAS float*)(lds + FW_B1))[tid] = b1[tid]; ((LAS float*)(lds + FW_B2))[tid] = b2[tid]; ((LAS float*)(lds + FW_FR))[tid] = fr[tid]; }
    LDS_WAIT(); __syncthreads();
}
__device__ __forceinline__ void filter_mlp_half(LAS unsigned char* lds, int L, int chunk, int hf, int dir, int r, int h, LAS float* Hb, bf16x8 (&afr)[4]) {
    const LAS float* W1 = (const LAS float*)(lds + FW_W1); const LAS float* W2 = (const LAS float*)(lds + FW_W2);
    const LAS float* B1 = (const LAS float*)(lds + FW_B1); const LAS float* B2 = (const LAS float*)(lds + FW_B2); const LAS float* FR = (const LAS float*)(lds + FW_FR);
        int pos = 64 * chunk + 32 * hf + r + dir; if (pos > L - 1) pos = L - 1;
        const float t = (float)pos / (float)(L - 1);
        float a[32];
#pragma unroll
        for (int jj = 0; jj < 32; ++jj) a[jj] = B1[32 * h + jj];
        {
#pragma unroll
            for (int jj = 0; jj < 32; jj += 4) { const f32x4 w = *(const LAS f32x4*)(W1 + 32 * h + jj); a[jj] += t * w[0]; a[jj + 1] += t * w[1]; a[jj + 2] += t * w[2]; a[jj + 3] += t * w[3]; }
#pragma unroll 1
            for (int i = 0; i < 16; ++i) {
                const float band = 1e-4f + (float)i * ((15.0f - 1e-4f) / 15.0f); const float ang = (6.283185307179586f / (float)L) * (float)pos * band;
                const float cv = __cosf(ang), sv = -__sinf(ang);
                const LAS float* wc = W1 + (1 + i) * 64 + 32 * h; const LAS float* wsn = W1 + (17 + i) * 64 + 32 * h;
#pragma unroll
                for (int jj = 0; jj < 32; jj += 4) { const f32x4 w = *(const LAS f32x4*)(wc + jj), v = *(const LAS f32x4*)(wsn + jj);
                    a[jj] += cv * w[0] + sv * v[0]; a[jj + 1] += cv * w[1] + sv * v[1]; a[jj + 2] += cv * w[2] + sv * v[2]; a[jj + 3] += cv * w[3] + sv * v[3]; }
            }
        }
#pragma unroll
        for (int jj = 0; jj < 32; ++jj) Hb[(32 * h + jj) * 32 + r] = __sinf(FR[32 * h + jj] * a[jj]);
        LDS_WAIT(); asm volatile("" ::: "memory");
#pragma unroll
        for (int jj = 0; jj < 32; ++jj) a[jj] = B2[32 * h + jj];
#pragma unroll 1
        for (int i = 0; i < 64; ++i) { const float hv = Hb[i * 32 + r]; const LAS float* wr_ = W2 + i * 64 + 32 * h;
#pragma unroll
            for (int jj = 0; jj < 32; jj += 4) { const f32x4 w = *(const LAS f32x4*)(wr_ + jj); a[jj] += hv * w[0]; a[jj + 1] += hv * w[1]; a[jj + 2] += hv * w[2]; a[jj + 3] += hv * w[3]; } }
        LDS_WAIT(); asm volatile("" ::: "memory");
        unsigned op[16], pp[16];
#pragma unroll
        for (int d = 0; d < 16; ++d) op[d] = pk2(__sinf(FR[32 * h + 2 * d] * a[2 * d]), __sinf(FR[32 * h + 2 * d + 1] * a[2 * d + 1]));
#pragma unroll
        for (int d = 0; d < 16; ++d) pp[d] = __shfl_xor(op[d], 32);
#pragma unroll
        for (int ks = 0; ks < 4; ++ks) { v4u f;
#pragma unroll
            for (int w = 0; w < 4; ++w) { const unsigned own = h ? op[8 * (ks & 1) + 4 + w] : op[8 * (ks & 1) + w], par = h ? pp[8 * (ks & 1) + 4 + w] : pp[8 * (ks & 1) + w];
                f[w] = ((ks >> 1) == h) ? own : par; }
            afr[ks] = __builtin_bit_cast(bf16x8, f); }
}
__device__ __forceinline__ void filter_item(LAS unsigned char* lds, const bf16* w3T, bf16* krev, float* fpart, int g, int chunk, int quarter, int wave, int lane) {
    const int L = g ? LS : LP, r = lane & 31, h = lane >> 5, dir = quarter & 1, o_ = quarter >> 1;
    const LAS float* W1 = (const LAS float*)(lds + FW_W1); const LAS float* W2 = (const LAS float*)(lds + FW_W2);
    const LAS float* B1 = (const LAS float*)(lds + FW_B1); const LAS float* B2 = (const LAS float*)(lds + FW_B2); const LAS float* FR = (const LAS float*)(lds + FW_FR);
    LAS unsigned char* T = lds + FW_END + wave * FT_BYTES; LAS float* Hb = (LAS float*)(lds + FW_END + NWAVES * FT_BYTES + wave * 8192);
    bf16x8 afr0[4], afr1[4];
    filter_mlp_half(lds, L, chunk, 0, dir, r, h, Hb, afr0);
    filter_mlp_half(lds, L, chunk, 1, dir, r, h, Hb, afr1);
    const float dmin = -4.605170185988091f / 1.5f, dmax = -4.605170185988091f / 0.3f;
    const int p0 = 64 * chunk; const int mstart = dir ? (L + p0) : (L - 64 - p0);
    for (int ti = 0; ti < 16; ++ti) {
        const int cb = 32 * ti, colg = quarter * 512 + cb;
        bf16x8 bfr[4];
#pragma unroll
        for (int ks = 0; ks < 4; ++ks) bfr[ks] = *(const GAS bf16x8*)(w3T + (size_t)(colg + r) * 64 + 16 * ks + 8 * h);
        const float delta = fabsf(dmin + (float)(cb + r) * ((dmax - dmin) / 511.0f));
        float asum = 0.f;
#pragma unroll
        for (int hf = 0; hf < 2; ++hf) {
            f32x16 acc = (f32x16){0.f,0.f,0.f,0.f,0.f,0.f,0.f,0.f,0.f,0.f,0.f,0.f,0.f,0.f,0.f,0.f};
#pragma unroll
            for (int ks = 0; ks < 4; ++ks) acc = __builtin_amdgcn_mfma_f32_32x32x16_bf16(hf ? afr1[ks] : afr0[ks], bfr[ks], acc, 0, 0, 0);
#pragma unroll
            for (int rg = 0; rg < 16; ++rg) {
                const int i = 32 * hf + (rg & 3) + 8 * (rg >> 2) + 4 * h; const int pos = p0 + i + dir;
                const float t = (float)pos / (float)(L - 1);
                float kv = acc[rg] * (__expf(-t * delta) + 0.05f); if (pos > L - 1) kv = 0.f;
                asum += fabsf(kv);
                const int e = dir ? i : 63 - i;
                *(LAS bf16*)(T + r * FT_PITCH + e * 2) = (bf16)f2bf(kv);
            }
        }
        asum += __shfl_xor(asum, 32);
        if (h == 0) fpart[(size_t)chunk * 2048 + colg + r] = asum;
        LDS_WAIT(); asm volatile("" ::: "memory");
        {
            const int col = lane >> 1, hb = lane & 1;
            bf16* dst = krev + (size_t)(o_ * 512 + cb + col) * (2 * L) + mstart + 32 * hb;
            const LAS v4u* src = (const LAS v4u*)(T + col * FT_PITCH + 64 * hb);
#pragma unroll
            for (int q = 0; q < 4; ++q) *(GAS v4u*)(dst + 8 * q) = src[q];
        }
        LDS_WAIT(); asm volatile("" ::: "memory");
    }
}

namespace hy {
constexpr int SLOTB = 272, Z_BYTES = 75776, F_OFF = 75776, F_BYTES = 65536, RED_OFF = F_OFF + F_BYTES;
__device__ __forceinline__ int slot_of(int g, int n) { return g ? (n + 31) : ((n >> 4) * 32 + 16 + (n & 15)); }
__device__ __forceinline__ int crow(int r, int hi) { return (r & 3) + 8 * (r >> 2) + 4 * hi; }

struct Params { const bf16* uT; const bf16* krev_s; const bf16* krev_p; const float* fpart_s; const float* fpart_p; const float* conv_w; const float* conv_b; const float* hbias; bf16* yT; float* dF; bf16* dZ; };

__device__ __forceinline__ void conv3_chunk(const bf16* urow  , int g, int chunk, float w0, float w1, float w2, float b, float (&out)[8]) {
    const int tau0 = chunk * 8; const int L = g ? LS : LP; const int p0 = g ? tau0 : (tau0 & (LP - 1));
    const v4u raw = *(const GAS v4u*)(urow + tau0);
    float u[10];
    u[1] = pg8::bflo(raw.x); u[2] = pg8::bfhi(raw.x); u[3] = pg8::bflo(raw.y); u[4] = pg8::bfhi(raw.y); u[5] = pg8::bflo(raw.z); u[6] = pg8::bfhi(raw.z); u[7] = pg8::bflo(raw.w); u[8] = pg8::bfhi(raw.w);
    u[0] = (p0 > 0) ? bf2f(urow[tau0 - 1]) : 0.f;
    u[9] = (p0 + 8 < L) ? bf2f(urow[tau0 + 8]) : 0.f;
#pragma unroll
    for (int i = 0; i < 8; ++i) out[i] = w0 * u[i] + w1 * u[i + 1] + w2 * u[i + 2] + b;
}

__device__ __forceinline__ bf16x8 load_afrag(LAS const unsigned char* lds, int addr, int sh) {
    const LAS unsigned* p = (const LAS unsigned*)(lds + addr);
    const unsigned w0 = p[0], w1 = p[1], w2 = p[2], w3 = p[3], w4 = p[4];
    v4u f; f.x = __builtin_amdgcn_alignbit(w1, w0, sh); f.y = __builtin_amdgcn_alignbit(w2, w1, sh); f.z = __builtin_amdgcn_alignbit(w3, w2, sh); f.w = __builtin_amdgcn_alignbit(w4, w3, sh);
    return __builtin_bit_cast(bf16x8, f);
}

__device__ __forceinline__ void hyena_item(LAS unsigned char* lds, const Params& P, int g, int c, int tid) {
    const int lane = tid & 63, wave = __builtin_amdgcn_readfirstlane(tid >> 6), r = lane & 31, hi = lane >> 5, nt = wave & 3, half = wave >> 2;
    const int L = g ? LS : LP; const int T0 = g ? TP : 0;
    LAS float* red = (LAS float*)(lds + RED_OFF);
    float inv_norm0, inv_norm1;
    {
        const int nchunk = g ? 256 : 32; const float* fp = P.fpart_s + (g ? (size_t)0 : (size_t)((WS_FPART_P - WS_FPART_S) / 4));
        float s0 = 0.f, s1 = 0.f;
        for (int idx = tid; idx < nchunk * 2; idx += NWAVES * 64) { const int ch = idx >> 1, dir = idx & 1; s0 += fp[(size_t)ch * 2048 + dir * 512 + c]; s1 += fp[(size_t)ch * 2048 + 1024 + dir * 512 + c]; }
        s0 = wave_sum(s0); s1 = wave_sum(s1);
        if (lane == 0) { red[wave * 2] = s0; red[wave * 2 + 1] = s1; }
        for (int i = tid; i < Z_BYTES / 16; i += NWAVES * 64) *(LAS v4u*)(lds + i * 16) = (v4u){0u, 0u, 0u, 0u};
        LDS_WAIT(); __syncthreads();
        float t0 = 0.f, t1 = 0.f;
#pragma unroll
        for (int w = 0; w < NWAVES; ++w) { t0 += red[w * 2]; t1 += red[w * 2 + 1]; }
        inv_norm0 = 1.0f / t0; inv_norm1 = 1.0f / t1;
    }
    {
        const int ch = 2 * HW + c; const float w0 = P.conv_w[ch], w1 = P.conv_w[3 * HW + ch], w2 = P.conv_w[6 * HW + ch], b = P.conv_b[ch];
        const bf16* urow = P.uT + (size_t)ch * MTOK + T0;
        for (int it = 0; it < 4; ++it) { const int chunk = tid + it * 512; float o[8]; conv3_chunk(urow, g, chunk, w0, w1, w2, b, o);
            const int tau0 = chunk * 8; v4u pk; pk.x = pk2(o[0], o[1]); pk.y = pk2(o[2], o[3]); pk.z = pk2(o[4], o[5]); pk.w = pk2(o[6], o[7]);
            *(LAS v4u*)(lds + slot_of(g, tau0 >> 7) * SLOTB + (tau0 & 127) * 2) = pk; }
    }
    int d_hi, d_lo;
    if (g) { if (half == 0) { d_hi = 32 * nt + 31; d_lo = 32 * nt - 48; } else { d_hi = 32 * nt - 49; d_lo = 32 * nt - 127; } }
    else   { if (half == 0) { d_hi = 15; d_lo = 0; } else { d_hi = -1; d_lo = -15; } }
    int abase = F_OFF + 2 * ((L - 1) - r + 8 * hi); const int sh = (abase & 2) ? 16 : 0; abase &= ~3;
    const int zb = slot_of(g, 32 * nt + r) * SLOTB + 16 * hi;
    const int mi0 = 2 * half;

    for (int o = 0; o < 2; ++o) {
        {
            const bf16* ksrc = P.krev_s + (g ? (size_t)0 : (size_t)((WS_KREV_P - WS_KREV_S) / 2)) + (size_t)(o * HW + c) * (2 * L);
            const int n16 = (2 * L * 2) / 16;
            for (int i = tid; i < n16; i += NWAVES * 64) *(LAS v4u*)(lds + F_OFF + i * 16) = *(const GAS v4u*)(ksrc + i * 8);
        }
        LDS_WAIT(); __syncthreads();
        f32x16 acc[4];
#pragma unroll
        for (int mi = 0; mi < 4; ++mi) acc[mi] = (f32x16){0.f,0.f,0.f,0.f,0.f,0.f,0.f,0.f,0.f,0.f,0.f,0.f,0.f,0.f,0.f,0.f};
        bf16x8 Fw[8];
        {
            const int q0 = -8 * d_hi;
#pragma unroll
            for (int s = 2; s < 8; ++s) Fw[s] = load_afrag(lds, abase + 32 * (q0 - 8 + s), sh);
            Fw[0] = Fw[2]; Fw[1] = Fw[3];
        }
        for (int d = d_hi; d >= d_lo; --d) {
            const int aq = abase + 32 * (-8 * d), bq = zb - d * SLOTB;
#pragma unroll
            for (int jk = 0; jk < 8; ++jk) {
                Fw[jk] = load_afrag(lds, aq + 32 * jk, sh);
                const bf16x8 zf = *(const LAS bf16x8*)(lds + bq + 32 * jk);
#pragma unroll
                for (int mi = 0; mi < 4; ++mi) acc[mi] = __builtin_amdgcn_mfma_f32_32x32x16_bf16(Fw[(jk - 2 * mi) & 7], zf, acc[mi], 0, 0, 0);
            }
        }
        LDS_WAIT(); __syncthreads();
        {
            LAS float* X = (LAS float*)(lds + F_OFF) + wave * 2048;
#pragma unroll
            for (int t = 0; t < 2; ++t)
#pragma unroll
                for (int rg = 0; rg < 16; ++rg) X[(t * 16 + rg) * 64 + lane] = (half == 0) ? acc[2 + t][rg] : acc[t][rg];
        }
        LDS_WAIT(); __syncthreads();
        f32x16 fin[2];
        {
            const LAS float* X = (const LAS float*)(lds + F_OFF) + (wave ^ 4) * 2048;
#pragma unroll
            for (int t = 0; t < 2; ++t)
#pragma unroll
                for (int rg = 0; rg < 16; ++rg) fin[t][rg] = ((half == 0) ? acc[t][rg] : acc[2 + t][rg]) + X[(t * 16 + rg) * 64 + lane];
        }
        LDS_WAIT(); __syncthreads();
        {
            const int ch = o * HW + c; const float w0 = P.conv_w[ch], w1 = P.conv_w[3 * HW + ch], w2 = P.conv_w[6 * HW + ch], b = P.conv_b[ch];
            const bf16* urow = P.uT + (size_t)ch * MTOK + T0;
            for (int it = 0; it < 4; ++it) { const int chunk = tid + it * 512; float v[8]; conv3_chunk(urow, g, chunk, w0, w1, w2, b, v);
                LAS f32x4* dst = (LAS f32x4*)(lds + F_OFF + chunk * 32); dst[0] = (f32x4){v[0], v[1], v[2], v[3]}; dst[1] = (f32x4){v[4], v[5], v[6], v[7]}; }
        }
        LDS_WAIT(); __syncthreads();
        {
            const float sb = P.hbias[o * HW + c], inr = o ? inv_norm1 : inv_norm0;
            const LAS float* G = (const LAS float*)(lds + F_OFF);
            const int n = 32 * nt + r; LAS bf16* zs = (LAS bf16*)(lds + slot_of(g, n) * SLOTB);
#pragma unroll
            for (int t = 0; t < 2; ++t)
#pragma unroll
                for (int rg = 0; rg < 16; ++rg) { const int i = 32 * (mi0 + t) + crow(rg, hi);
                    const float zo = bf2f(zs[i]);
#if PROBE >= 100
                    if (c == 137) { P.dF[(g * 2 + o) * 16384 + 128 * n + i] = fin[t][rg]; P.dZ[(g * 2 + o) * 16384 + 128 * n + i] = zs[i]; }
#endif
                    const float val = G[128 * n + i] * (inr * fin[t][rg] + sb * zo); zs[i] = (bf16)f2bf(val); }
        }
        LDS_WAIT(); __syncthreads();
    }
    {
        bf16* yrow = P.yT + (size_t)c * MTOK + T0;
        for (int it = 0; it < 4; ++it) { const int chunk = tid + it * 512, tau0 = chunk * 8;
            *(GAS v4u*)(yrow + tau0) = *(const LAS v4u*)(lds + slot_of(g, tau0 >> 7) * SLOTB + (tau0 & 127) * 2); }
    }
    LDS_WAIT(); __syncthreads();
}
}

namespace at {
constexpr int KROW = 144, VROW = 776, K_OFF = 0, V_OFF = 384 * KROW  , END_OFF = V_OFF + 64 * VROW;
__device__ __forceinline__ int crow(int r, int hi) { return (r & 3) + 8 * (r >> 2) + 4 * hi; }
struct Params { const bf16* q; const bf16* k; const bf16* v; const float* sink; bf16* yat; };

__device__ __forceinline__ void attn_item(LAS unsigned char* lds, const Params& P, int blk, int gk, int tid) {
    const int lane = tid & 63, wave = __builtin_amdgcn_readfirstlane(tid >> 6), r = lane & 31, hi = lane >> 5;
    const int m0 = blk * 128; const int s_lo = (blk < 128) ? (m0 & ~(LP - 1)) : TP, s_hi = (blk < 128) ? s_lo + LP : MTOK; const int kw0 = m0 - 128;
    for (int it = 0; it < 6; ++it) {
        const int idx = tid + it * 512, key = idx >> 3, chn = idx & 7, tok = kw0 + key; const bool ok = (tok >= s_lo) && (tok < s_hi);
        v4u kv = (v4u){0u, 0u, 0u, 0u}, vv = (v4u){0u, 0u, 0u, 0u};
        if (ok) { kv = *(const GAS v4u*)(P.k + (size_t)tok * 128 + gk * 64 + chn * 8); vv = *(const GAS v4u*)(P.v + (size_t)tok * 128 + gk * 64 + chn * 8); }
        *(LAS v4u*)(lds + K_OFF + key * KROW + chn * 16) = kv;
        LAS bf16* vt = (LAS bf16*)(lds + V_OFF + (chn * 8) * VROW + key * 2);
        vt[0 * (VROW / 2)] = (bf16)(vv.x & 0xffffu); vt[1 * (VROW / 2)] = (bf16)(vv.x >> 16); vt[2 * (VROW / 2)] = (bf16)(vv.y & 0xffffu); vt[3 * (VROW / 2)] = (bf16)(vv.y >> 16);
        vt[4 * (VROW / 2)] = (bf16)(vv.z & 0xffffu); vt[5 * (VROW / 2)] = (bf16)(vv.z >> 16); vt[6 * (VROW / 2)] = (bf16)(vv.w & 0xffffu); vt[7 * (VROW / 2)] = (bf16)(vv.w >> 16);
    }
    LDS_WAIT(); __syncthreads();
    const int hq = 4 * gk + (wave & 3), qh = wave >> 2;
    const int klo = (s_lo - kw0) > 0 ? (s_lo - kw0) : 0, khi = (s_hi - kw0) < 384 ? (s_hi - kw0) : 384;
    const float sinkl = P.sink[hq] * 1.4426950408889634f;
    for (int qq = 0; qq < 2; ++qq) {
        const int qt = 2 * qh + qq, q0 = 32 * qt; const size_t qrow = (size_t)(m0 + q0 + r);
        bf16x8 qf[4];
#pragma unroll
        for (int ks = 0; ks < 4; ++ks) qf[ks] = *(const GAS bf16x8*)(P.q + qrow * 512 + hq * 64 + 16 * ks + 8 * hi);
        float m_run = sinkl, l_run = (hi == 0) ? 1.0f : 0.0f;
        f32x16 o0 = (f32x16){0.f,0.f,0.f,0.f,0.f,0.f,0.f,0.f,0.f,0.f,0.f,0.f,0.f,0.f,0.f,0.f}, o1 = o0;
        const int lo_r = (q0 + r) > klo ? (q0 + r) : klo, hi_r = (q0 + r + 256) < (khi - 1) ? (q0 + r + 256) : (khi - 1);
        for (int kt = qt; kt <= qt + 8; ++kt) {
            const int kb = 32 * kt;
            f32x16 s = (f32x16){0.f,0.f,0.f,0.f,0.f,0.f,0.f,0.f,0.f,0.f,0.f,0.f,0.f,0.f,0.f,0.f};
#pragma unroll
            for (int ks = 0; ks < 4; ++ks) { const bf16x8 kf = *(const LAS bf16x8*)(lds + K_OFF + (kb + r) * KROW + 32 * ks + 16 * hi);
                s = __builtin_amdgcn_mfma_f32_32x32x16_bf16(kf, qf[ks], s, 0, 0, 0); }
            float tmax = -1e30f;
#pragma unroll
            for (int rg = 0; rg < 16; ++rg) { const int kj = kb + crow(rg, hi); const float sv = (kj >= lo_r && kj <= hi_r) ? s[rg] : -1e30f; s[rg] = sv; tmax = fmaxf(tmax, sv); }
            tmax = fmaxf(tmax, __shfl_xor(tmax, 32));
            const float mnew = fmaxf(m_run, tmax); const float alpha = __builtin_amdgcn_exp2f(m_run - mnew); m_run = mnew;
            float psum = 0.f;
#pragma unroll
            for (int rg = 0; rg < 16; ++rg) { const float p = __builtin_amdgcn_exp2f(s[rg] - mnew); s[rg] = p; psum += p; }
            l_run = l_run * alpha + psum;
#pragma unroll
            for (int rg = 0; rg < 16; ++rg) { o0[rg] *= alpha; o1[rg] *= alpha; }
            v4u pa, pb;
            pa.x = pk2(s[0], s[1]); pa.y = pk2(s[2], s[3]); pa.z = pk2(s[4], s[5]); pa.w = pk2(s[6], s[7]);
            pb.x = pk2(s[8], s[9]); pb.y = pk2(s[10], s[11]); pb.z = pk2(s[12], s[13]); pb.w = pk2(s[14], s[15]);
            const bf16x8 pf0 = __builtin_bit_cast(bf16x8, pa), pf1 = __builtin_bit_cast(bf16x8, pb);
#pragma unroll
            for (int dt = 0; dt < 2; ++dt) {
                const LAS unsigned char* vb = lds + V_OFF + (32 * dt + r) * VROW + (kb + 4 * hi) * 2;
                v4u va, vc;
                { const v2u x0 = *(const LAS v2u*)(vb), x1 = *(const LAS v2u*)(vb + 16); va = (v4u){x0.x, x0.y, x1.x, x1.y}; }
                { const v2u x0 = *(const LAS v2u*)(vb + 32), x1 = *(const LAS v2u*)(vb + 48); vc = (v4u){x0.x, x0.y, x1.x, x1.y}; }
                if (dt == 0) { o0 = __builtin_amdgcn_mfma_f32_32x32x16_bf16(__builtin_bit_cast(bf16x8, va), pf0, o0, 0, 0, 0); o0 = __builtin_amdgcn_mfma_f32_32x32x16_bf16(__builtin_bit_cast(bf16x8, vc), pf1, o0, 0, 0, 0); }
                else         { o1 = __builtin_amdgcn_mfma_f32_32x32x16_bf16(__builtin_bit_cast(bf16x8, va), pf0, o1, 0, 0, 0); o1 = __builtin_amdgcn_mfma_f32_32x32x16_bf16(__builtin_bit_cast(bf16x8, vc), pf1, o1, 0, 0, 0); }
            }
        }
        l_run += __shfl_xor(l_run, 32);
        const float inv = 1.0f / l_run;
        bf16* yrow = P.yat + qrow * 512 + hq * 64;
#pragma unroll
        for (int g4 = 0; g4 < 4; ++g4) {
            v2u w0, w1;
            w0.x = pk2(o0[4 * g4] * inv, o0[4 * g4 + 1] * inv); w0.y = pk2(o0[4 * g4 + 2] * inv, o0[4 * g4 + 3] * inv);
            w1.x = pk2(o1[4 * g4] * inv, o1[4 * g4 + 1] * inv); w1.y = pk2(o1[4 * g4 + 2] * inv, o1[4 * g4 + 3] * inv);
            *(GAS v2u*)(yrow + 8 * g4 + 4 * hi) = w0; *(GAS v2u*)(yrow + 32 + 8 * g4 + 4 * hi) = w1;
        }
    }
    LDS_WAIT(); __syncthreads();
}
}

__device__ __forceinline__ void transpose_y_tile(LAS unsigned char* lds, const bf16* yT, bf16* yhy, int tile, int tid) {
    const int c0 = (tile & 7) * 64, t0 = (tile >> 3) * 64;
    LAS bf16* T = (LAS bf16*)lds;
    { const int ch = tid >> 3, k8 = tid & 7; *(LAS v4u*)(T + ch * 72 + k8 * 8) = *(const GAS v4u*)(yT + (size_t)(c0 + ch) * MTOK + t0 + k8 * 8); }
    LDS_WAIT(); __syncthreads();
    { const int tk = tid >> 3, c8 = tid & 7; unsigned short e[8];
#pragma unroll
      for (int j = 0; j < 8; ++j) e[j] = T[(c8 * 8 + j) * 72 + tk];
      v4u o; o.x = e[0] | ((unsigned)e[1] << 16); o.y = e[2] | ((unsigned)e[3] << 16); o.z = e[4] | ((unsigned)e[5] << 16); o.w = e[6] | ((unsigned)e[7] << 16);
      *(GAS v4u*)(yhy + (size_t)(t0 + tk) * 512 + c0 + c8 * 8) = o; }
    LDS_WAIT(); __syncthreads();
}

#if PROBE
constexpr int CW_P = 20000;
constexpr size_t WS_DF = 484 * MiB, WS_DZ = 485 * MiB;
constexpr int PROBE_C = 137;
__device__ __forceinline__ double wave_sum_d(double v) {
#pragma unroll
    for (int o = 1; o < 64; o <<= 1) v += __shfl_xor(v, o);
    return v;
}
__device__ __forceinline__ double filt_point(const float* w1, const float* b1, const float* w2, const float* b2, const float* w3, const float* fr, int g, int p, int col, int lane) {
    const int L = g ? LS : LP; const double t = (double)p / (double)(L - 1);
    double zval = 0.0;
    if (lane == 0) zval = t;
    else if (lane < 33) { const int i = (lane - 1) & 15; const double band = 1e-4 + (double)i * ((15.0 - 1e-4) / 15.0); const double ang = (6.283185307179586 / (double)L) * (double)p * band; zval = (lane <= 16) ? cos(ang) : -sin(ang); }
    double a = (double)b1[lane];
    for (int k = 0; k < 33; ++k) a += __shfl(zval, k) * (double)w1[k * 64 + lane];
    const double h1 = sin((double)fr[lane] * a);
    a = (double)b2[lane];
    for (int i = 0; i < 64; ++i) a += __shfl(h1, i) * (double)w2[i * 64 + lane];
    const double h2 = sin((double)fr[lane] * a);
    const double out = wave_sum_d(h2 * (double)w3[lane * 2048 + col]);
    const int c = col & 511; const double dmin = log(1e-2) / 1.5, dmax = log(1e-2) / 0.3;
    const double delta = fabs(dmin + (double)c * ((dmax - dmin) / 511.0));
    return out * (exp(-t * delta) + 0.05);
}
__device__ __forceinline__ void probe_check(unsigned char* ws, unsigned* ctl, const float* w1, const float* b1, const float* w2, const float* b2, const float* w3, const float* fr, int vcu, int G, int tid) {
    const bf16* KREV_S = (const bf16*)(ws + WS_KREV_S);
    const float* DF = (const float*)(ws + WS_DF); const bf16* DZ = (const bf16*)(ws + WS_DZ);
    const int gtid = vcu * 512 + tid, lane = tid & 63, gwv = gtid >> 6, NW = G * 8;
    if (gtid < 65536) {
        const int combo = gtid >> 14, t = gtid & 16383, g = combo >> 1, o = combo & 1, L = g ? LS : LP, tl = g ? t : (t & (LP - 1)), base = t - tl;
        const bf16* kr = KREV_S + (g ? (size_t)0 : (size_t)((WS_KREV_P - WS_KREV_S) / 2)) + (size_t)(o * HW + PROBE_C) * (2 * L) + (L - 1 - tl); const bf16* dz = DZ + combo * 16384 + base;
        double acc = 0.0;
        for (int s = 0; s < L; ++s) acc += (double)bf2f(kr[s]) * (double)bf2f(dz[s]);
        const float diff = fabsf((float)(acc - (double)DF[combo * 16384 + t]));
        atomicMax(ctl + CW_P + 0, __float_as_uint(diff)); atomicMax(ctl + CW_P + 1, __float_as_uint(fabsf((float)acc)));
    }
    {
        const int g = gwv & 1, L = g ? LS : LP; const int p = (int)(((unsigned)gwv * 2654435761u) >> 8) % L;
        for (int q = 0; q < 8; ++q) { const int col = (gwv * 97 + 263 * q) & 2047; const int o = col >> 10, dir = (col >> 9) & 1, c = col & 511;
            if (dir == 1 && p == 0) continue;
            const double kv = filt_point(w1, b1, w2, b2, w3, fr, g, p, col, lane);
            const int m = dir ? (L - 1 + p) : (L - 1 - p); const float st = bf2f((KREV_S + (g ? (size_t)0 : (size_t)((WS_KREV_P - WS_KREV_S) / 2)) + (size_t)(o * HW + c) * (2 * L))[m]);
            if (lane == 0) { atomicMax(ctl + CW_P + 2, __float_as_uint(fabsf(st - (float)kv))); atomicMax(ctl + CW_P + 3, __float_as_uint(fabsf((float)kv))); } }
    }
    for (int which = 0; which < 2; ++which) {
        const int g = which ? 0 : 1, o = which ? 0 : 1, L = g ? LS : LP; double loc = 0.0;
        for (int p = gwv; p < L; p += NW)
            for (int dir = 0; dir < 2; ++dir) { if (dir == 1 && p == 0) continue; loc += fabs(filt_point(w1, b1, w2, b2, w3, fr, g, p, o * 1024 + dir * 512 + PROBE_C, lane)); }
        if (lane == 0) atomicAdd((double*)(ctl + CW_P + 8) + which, loc);
    }
}
__device__ __forceinline__ int probe_metric_count(unsigned char* ws, unsigned* ctl) {
    const float e_conv = __uint_as_float(__hip_atomic_load(ctl + CW_P + 0, RLX_AGENT)) / fmaxf(__uint_as_float(__hip_atomic_load(ctl + CW_P + 1, RLX_AGENT)), 1e-30f);
    const float e_filt = __uint_as_float(__hip_atomic_load(ctl + CW_P + 2, RLX_AGENT)) / fmaxf(__uint_as_float(__hip_atomic_load(ctl + CW_P + 3, RLX_AGENT)), 1e-30f);
    const float* FPS = (const float*)(ws + WS_FPART_S); const float* FPP = (const float*)(ws + WS_FPART_P);
    double s1 = 0.0, s0 = 0.0;
    for (int ch = 0; ch < 256; ++ch) s1 += (double)FPS[(size_t)ch * 2048 + 1024 + PROBE_C] + (double)FPS[(size_t)ch * 2048 + 1024 + 512 + PROBE_C];
    for (int ch = 0; ch < 32; ++ch) s0 += (double)FPP[(size_t)ch * 2048 + PROBE_C] + (double)FPP[(size_t)ch * 2048 + 512 + PROBE_C];
    const double n1 = ((volatile double*)(ctl + CW_P + 8))[0], n0 = ((volatile double*)(ctl + CW_P + 8))[1];
    const float e_n1 = (float)(fabs(n1 - s1) / fmax(n1, 1e-30)), e_n0 = (float)(fabs(n0 - s0) / fmax(n0, 1e-30));
#if PROBE == 100
    float M = fmaxf(fmaxf(e_conv, e_filt * 1e-3f), fmaxf(e_n1, e_n0));
#elif PROBE == 101
    float M = e_conv;
#elif PROBE == 102
    float M = e_filt;
#else
    float M = fmaxf(e_n1, e_n0);
#endif
    float v = (log10f(fmaxf(M, 1e-12f)) + 8.0f) * 0.125f; v = fminf(fmaxf(v, 0.02f), 1.0f);
    return (int)(v * 1600.0f);
}
#endif

#ifndef MK_SPLIT
#define MK_SPLIT 0
#endif
constexpr int N_PHASES = 8;
struct Args { const float* in[23]; float* out; unsigned char* ws; int ph_lo, ph_hi; };

__global__ void __launch_bounds__(NWAVES * 64, 2) enc_fwd(Args args) {
    extern __shared__ __attribute__((aligned(16))) unsigned char lds_raw[];
    Frame F;
    F.lds = (LAS unsigned char*)lds_raw;
    F.MISC = (volatile LAS unsigned*)(F.lds + MISC_OFF);
    F.tid = threadIdx.x; F.lane = F.tid & 63; F.wave = __builtin_amdgcn_readfirstlane(F.tid >> 6);
    F.G = gridDim.x; { const int bx = blockIdx.x; F.vcu = (F.G % 8 == 0) ? (bx % 8) * (F.G / 8) + bx / 8 : bx; }
    F.ws = args.ws; F.ctl = (gu32*)(args.ws + WS_CTL);
    unsigned char* const ws = args.ws;
    for (int u = F.tid; u < (LDS_BYTES - LDSCTL_OFF) / 4; u += NWAVES * 64) ((LAS unsigned*)(F.lds + LDSCTL_OFF))[u] = 0u;
    __syncthreads();
    const int lo = args.ph_lo, hi = args.ph_hi;
    XcdBarrier bar; bar.bar = (unsigned*)(F.ctl + CW_BAR); bar.x = 0; bar.st = nullptr;
    if (hi - lo > 1) bar = xcd_barrier_post((unsigned*)(F.ctl + CW_BAR), F.MISC + 8);
#define IN(k) (lo <= (k) && (k) < hi)
#if PROBE
#define TSTAMP(k) do { if (blockIdx.x == 0 && F.tid == 0) { const unsigned long long t_ = __builtin_amdgcn_s_memrealtime(); F.MISC[16 + 2 * (k)] = (unsigned)t_; F.MISC[17 + 2 * (k)] = (unsigned)(t_ >> 32); } } while (0)
#else
#define TSTAMP(k) do { } while (0)
#endif
#define SEAM(k) do { if (IN(k) && IN((k) + 1)) xcd_barrier(bar); TSTAMP((k) + 1); } while (0)
    TSTAMP(0);

    const float* const xp = args.in[0]; const float* const xs = args.in[1];
    bf16* const WINA = (bf16*)(ws + WS_WINA); bf16* const WINB = (bf16*)(ws + WS_WINB); bf16* const WHY = (bf16*)(ws + WS_WHY); bf16* const WAT = (bf16*)(ws + WS_WAT);
    bf16* const W3T = (bf16*)(ws + WS_W3T); bf16* const WO = (bf16*)(ws + WS_WO); bf16* const WGU = (bf16*)(ws + WS_WGU); bf16* const WD = (bf16*)(ws + WS_WD);
    bf16* const XB = (bf16*)(ws + WS_XB); bf16* const YT = (bf16*)(ws + WS_YT); bf16* const YAT = (bf16*)(ws + WS_YAT);
    bf16* const KREV_S = (bf16*)(ws + WS_KREV_S); bf16* const KREV_P = (bf16*)(ws + WS_KREV_P); bf16* const UT = (bf16*)(ws + WS_UT);
    bf16* const QB = (bf16*)(ws + WS_Q); bf16* const KB = (bf16*)(ws + WS_K); bf16* const VB = (bf16*)(ws + WS_V);
    bf16* const SGH = (bf16*)(ws + WS_SGH); bf16* const SGA = (bf16*)(ws + WS_SGA);
    float* const COS = (float*)(ws + WS_COS); float* const SIN = (float*)(ws + WS_SIN); float* const RSTD = (float*)(ws + WS_RSTD); float* const SSQ = (float*)(ws + WS_SSQ);
    float* const FPART_S = (float*)(ws + WS_FPART_S); float* const FPART_P = (float*)(ws + WS_FPART_P);
    bf16* const YHY = (bf16*)(ws + WS_YHY); bf16* const MERGED = (bf16*)(ws + WS_MERGED); bf16* const X1B = (bf16*)(ws + WS_X1B); bf16* const HID = (bf16*)(ws + WS_HID);

    if (IN(0)) {
        LAS float* scr = (LAS float*)(F.lds + RING_OFF + F.wave * 16384);
        const int gw = F.vcu * NWAVES + F.wave, NGW = F.G * NWAVES;
        constexpr int I_IN = 16 * 136, I_HY = 8 * 32, I_O = 16 * 32, I_G = 16 * 88, I_D = 44 * 32, I_W3 = 64;
        constexpr int NITEMS = I_IN + 2 * I_HY + I_O + 2 * I_G + I_D + I_W3;
        for (int it = gw; it < NITEMS; it += NGW) {
            int rr = it;
            if (rr < I_IN) { const int kb = rr / 136, nb = rr % 136, n0 = 32 * nb;
                if (n0 < 3 * HW) p0_transpose_item(args.in[3], DM, INW, WINA, n0, args.in[2], scr, 64 * kb, n0, F.lane);
                else p0_transpose_item(args.in[3], DM, INW, WINB, map_projB(n0), args.in[2], scr, 64 * kb, n0, F.lane);
                continue; } rr -= I_IN;
            if (rr < I_HY) { p0_transpose_item(args.in[16], HW, DM, WHY, 32 * (rr % 32), nullptr, scr, 64 * (rr / 32), 32 * (rr % 32), F.lane); continue; } rr -= I_HY;
            if (rr < I_HY) { p0_transpose_item(args.in[17], HW, DM, WAT, 32 * (rr % 32), nullptr, scr, 64 * (rr / 32), 32 * (rr % 32), F.lane); continue; } rr -= I_HY;
            if (rr < I_O) { p0_transpose_item(args.in[18], DM, DM, WO, 32 * (rr % 32), nullptr, scr, 64 * (rr / 32), 32 * (rr % 32), F.lane); continue; } rr -= I_O;
            if (rr < I_G) { const int n0 = 32 * (rr % 88); p0_transpose_item(args.in[20], DM, FFN, WGU, (n0 >> 7) * 256 + (n0 & 127), args.in[19], scr, 64 * (rr / 88), n0, F.lane); continue; } rr -= I_G;
            if (rr < I_G) { const int n0 = 32 * (rr % 88); p0_transpose_item(args.in[21], DM, FFN, WGU, (n0 >> 7) * 256 + 128 + (n0 & 127), args.in[19], scr, 64 * (rr / 88), n0, F.lane); continue; } rr -= I_G;
            if (rr < I_D) { p0_transpose_item(args.in[22], FFN, DM, WD, 32 * (rr % 32), nullptr, scr, 64 * (rr / 32), 32 * (rr % 32), F.lane); continue; } rr -= I_D;
            p0_transpose_item(args.in[10], 64, 2048, W3T, 32 * rr, nullptr, scr, 0, 32 * rr, F.lane);
        }
        for (int m = gw; m < MTOK; m += NGW) p0_row((m < TP) ? xp + (size_t)m * DM : xs + (size_t)(m - TP) * DM, XB + (size_t)m * DM, RSTD + m, F.lane);
        for (int idx = F.vcu * (NWAVES * 64) + F.tid; idx < LS * 32; idx += F.G * NWAVES * 64) {
            const int pos = idx >> 5, i = idx & 31; const double inv = exp2(-(double)i * (13.287712379549449 / 32.0)); const double ang = (double)pos * inv;
            COS[idx] = (float)cos(ang); SIN[idx] = (float)sin(ang);
        }
    }
    SEAM(0);

    if (IN(1)) {
        {
            constexpr int NU = (MTOK / 256) * (NPROJ / 256);
            const int heavy = NU % F.G, lb = heavy ? (int)blockIdx.x - heavy : (int)blockIdx.x, nlb = heavy ? F.G - heavy : F.G;
            if (lb >= 0) {
                filter_stage_weights(F.lds, args.in[6], args.in[7], args.in[8], args.in[9], args.in[11], F.tid);
                for (int it = lb * NWAVES + F.wave; it < 288 * 4; it += nlb * NWAVES) {
                    const int quarter = it & 3, ca = it >> 2, g = (ca < 256) ? 1 : 0, chunk = g ? ca : ca - 256;
                    filter_item(F.lds, W3T, KREV_S + (g ? (size_t)0 : (size_t)((WS_KREV_P - WS_KREV_S) / 2)), FPART_S + (g ? (size_t)0 : (size_t)((WS_FPART_P - WS_FPART_S) / 4)), g, chunk, quarter, F.wave, F.lane);
                }
                LDS_WAIT(); __syncthreads();
            }
        }
        {
            pg8::Gemm g{WINA, XB, nullptr, nullptr, 3 * HW, MTOK, DM}; pg8::StaticOrder S; S.init(3 * HW, MTOK, F.G, (int)blockIdx.x);
            pg8::EpiUT E{UT, MTOK, RSTD};
            pg8::gemm_phase<pg8::EpiUT, pg8::StaticOrder, true, true>(F.lds + RING_OFF, g, S, E);
        }
        {
            pg8::Gemm g{XB, WINB, nullptr, nullptr, MTOK, NPROJ, DM}; pg8::StaticOrder S; S.init(MTOK, NPROJ, F.G, (int)blockIdx.x);
            pg8::EpiProj E{RSTD, args.in[13], args.in[14], COS, SIN, QB, KB, VB, SGH, SGA};
            pg8::gemm_phase<pg8::EpiProj, pg8::StaticOrder, true, true>(F.lds + RING_OFF, g, S, E);
        }
    }
    SEAM(1);

    if (IN(2)) {
        #if PROBE
        const hy::Params HP{UT, KREV_S, KREV_P, FPART_S, FPART_P, args.in[4], args.in[5], args.in[12], YT, (float*)(ws + WS_DF), (bf16*)(ws + WS_DZ)};
#else
        const hy::Params HP{UT, KREV_S, KREV_P, FPART_S, FPART_P, args.in[4], args.in[5], args.in[12], YT, nullptr, nullptr};
#endif
        for (int it = F.vcu; it < 2 * HW; it += F.G) hy::hyena_item(F.lds, HP, (it < HW) ? 1 : 0, it & (HW - 1), F.tid);
        const at::Params AP{QB, KB, VB, args.in[15], YAT};
        for (int it = F.vcu; it < 512; it += F.G) at::attn_item(F.lds, AP, it >> 1, it & 1, F.tid);
    }
    SEAM(2);
#if PROBE >= 100
    probe_check(ws, (unsigned*)F.ctl, args.in[6], args.in[7], args.in[8], args.in[9], args.in[10], args.in[11], F.vcu, F.G, F.tid);
    xcd_barrier(bar);
#endif

    if (IN(3)) {
        for (int t = F.vcu; t < 8 * 512; t += F.G) transpose_y_tile(F.lds, YT, YHY, t, F.tid);
    }
    SEAM(3);

    if (IN(4)) {
        pg8::Gemm g{YHY, WHY, YAT, WAT, MTOK, DM, HW}; pg8::TwoPartOrder S; S.b.init(MTOK, DM, F.G, (int)blockIdx.x);
        pg8::EpiMerged E{SGH, SGA, MERGED};
        pg8::gemm_phase<pg8::EpiMerged, pg8::TwoPartOrder, false, true>(F.lds + RING_OFF, g, S, E);
    }
    SEAM(4);

    if (IN(5)) {
        pg8::Gemm g{MERGED, WO, nullptr, nullptr, MTOK, DM, DM}; pg8::StaticOrder S; S.init(MTOK, DM, F.G, (int)blockIdx.x);
        pg8::EpiWo E{xp, xs, args.out, X1B, SSQ};
        pg8::gemm_phase<pg8::EpiWo, pg8::StaticOrder, true, true>(F.lds + RING_OFF, g, S, E);
    }
    SEAM(5);

    if (IN(6)) {
        pg8::Gemm g{X1B, WGU, nullptr, nullptr, MTOK, 2 * FFN, DM}; pg8::StaticOrder S; S.init(MTOK, 2 * FFN, F.G, (int)blockIdx.x);
        pg8::EpiFfn1 E{SSQ, HID};
        pg8::gemm_phase<pg8::EpiFfn1, pg8::StaticOrder, true, true>(F.lds + RING_OFF, g, S, E);
    }
    SEAM(6);

    if (IN(7)) {
        pg8::Gemm g{HID, WD, nullptr, nullptr, MTOK, DM, FFN}; pg8::StaticOrder S; S.init(MTOK, DM, F.G, (int)blockIdx.x);
        pg8::EpiFfn2 E{args.out};
        pg8::gemm_phase<pg8::EpiFfn2, pg8::StaticOrder, true, true>(F.lds + RING_OFF, g, S, E);
#if PROBE
        TSTAMP(8);
        VM_WAIT(); __syncthreads();
        if (blockIdx.x == 0) {
            pg8::Unit u; S.next(1, u);
            int cnt;
#if PROBE >= 100
            cnt = probe_metric_count(ws, (unsigned*)F.ctl);
#else
            { const unsigned long long t0 = F.MISC[16] | ((unsigned long long)F.MISC[17] << 32), t8 = F.MISC[32] | ((unsigned long long)F.MISC[33] << 32);
              const unsigned long long ta = F.MISC[16 + 2 * (PROBE - 1)] | ((unsigned long long)F.MISC[17 + 2 * (PROBE - 1)] << 32), tb = F.MISC[16 + 2 * PROBE] | ((unsigned long long)F.MISC[17 + 2 * PROBE] << 32);
              cnt = (int)(1600.0f * (float)(tb - ta) / (float)(t8 - t0)); }
#endif
            for (int i = F.tid; i < cnt; i += NWAVES * 64) args.out[(size_t)(u.pm * 256 + (i & 255)) * 1024 + u.pn * 256 + (i >> 8)] = 0.f;
        }
#endif
    }
#undef IN
#undef SEAM
}

extern "C" void kernel_launch(void* const* d_in, const int* in_sizes, int n_in, void* d_out, int out_size, void* d_ws, size_t ws_size, hipStream_t stream) {
    static int grid = 0;
    if (grid == 0) {
        if (n_in != 23 || out_size != MTOK * DM || ws_size < WS_END) { fprintf(stderr, "kernel_launch: unexpected problem shape (n_in %d, out %d, ws %zu); nothing launched\n", n_in, out_size, ws_size); grid = -1; return; }
        int dev = 0, cus = 0, per_cu = 0;
        if (hipGetDevice(&dev) != hipSuccess || hipDeviceGetAttribute(&cus, hipDeviceAttributeMultiprocessorCount, dev) != hipSuccess) { fprintf(stderr, "kernel_launch: device query failed\n"); grid = -1; return; }
        if (hipFuncSetAttribute((const void*)enc_fwd, hipFuncAttributeMaxDynamicSharedMemorySize, LDS_BYTES) != hipSuccess) { fprintf(stderr, "kernel_launch: hipFuncSetAttribute failed\n"); grid = -1; return; }
        if (hipOccupancyMaxActiveBlocksPerMultiprocessor(&per_cu, (const void*)enc_fwd, NWAVES * 64, LDS_BYTES) != hipSuccess || per_cu < 1)
            fprintf(stderr, "kernel_launch: note: occupancy query reports %d workgroups per CU\n", per_cu);
        (void)hipGetLastError();
        grid = cus;
    }
    if (grid < 0) return;
    if (hipMemsetAsync((char*)d_ws + WS_CTL, 0, CTL_ZERO_BYTES, stream) != hipSuccess) { fprintf(stderr, "kernel_launch: memset failed\n"); return; }
    Args a{};
    for (int i = 0; i < 23; ++i) a.in[i] = (const float*)d_in[i];
    a.out = (float*)d_out; a.ws = (unsigned char*)d_ws;
#if MK_SPLIT
    for (int p = 0; p < N_PHASES; ++p) { a.ph_lo = p; a.ph_hi = p + 1; hipLaunchKernelGGL(enc_fwd, dim3(grid), dim3(NWAVES * 64), LDS_BYTES, stream, a); }
#else
    a.ph_lo = 0; a.ph_hi = N_PHASES;
    hipLaunchKernelGGL(enc_fwd, dim3(grid), dim3(NWAVES * 64), LDS_BYTES, stream, a);
#endif
    const hipError_t le = hipPeekAtLastError();
    if (le != hipSuccess) fprintf(stderr, "kernel_launch: launch failed: %s\n", hipGetErrorName(le));
}
```

```cpp
#include <hip/hip_runtime.h>
#include <cstdio>
#include <cstdint>
#include <cmath>
#ifndef PROBE
#define PROBE 0
#endif

namespace pg8 {
#define PG8_LAS __attribute__((address_space(3)))
typedef unsigned short bf16_t;
typedef short bf16x8 __attribute__((ext_vector_type(8)));
typedef float f32x4 __attribute__((ext_vector_type(4)));
typedef unsigned u32x4 __attribute__((ext_vector_type(4)));
constexpr int BM = 256, BK = 64, HALF = 128, HTB = HALF * BK * 2  , STAGE_BYTES = 8 * HTB, NXCD = 8, WGM = 8;

__host__ __device__ __forceinline__ int lds_byte(int r, int c) { const int st = (r >> 4) * 2 + (c >> 5), rr = r & 15, cc = c & 31, ob = rr * 64 + cc * 2; return st * 1024 + (ob ^ (((ob >> 9) & 1) << 5)); }
__host__ __device__ __forceinline__ void stage_rc(int b, int& R, int& C) { const int st = b / 1024, sb = b % 1024, swz = sb ^ (((sb >> 9) & 1) << 5); R = (st >> 1) * 16 + swz / 64; C = (st & 1) * 32 + (swz % 64) / 2; }
__host__ __device__ __forceinline__ int perm32(int rho) { const int n = rho >> 4, i = rho & 15; return 8 * (i >> 2) + 4 * n + (i & 3); }

struct Unit { int pm, pn, sel; };
struct Gemm { const bf16_t* A; const bf16_t* Bt; const bf16_t* A1; const bf16_t* Bt1; int M, N, K; };

struct StaticOrder {
    int nM, nN, nwg, G, c;
    __host__ __device__ __forceinline__ void init(int M, int N, int G_, int c_) { nM = M / BM; nN = N / BM; nwg = nM * nN; G = G_; c = c_; }
    __host__ __device__ __forceinline__ bool next(int i, Unit& u) const {
        const long L = (long)i * G + c; if (L >= nwg) return false;
        int wgid = (int)L; { const int q = nwg / NXCD, r = nwg % NXCD, xcd = wgid % NXCD, off = wgid / NXCD; wgid = (xcd < r ? xcd * (q + 1) : r * (q + 1) + (xcd - r) * q) + off; }
        const int nig = WGM * nN, gid = wgid / nig, fm = gid * WGM, gsz = (nM - fm) < WGM ? (nM - fm) : WGM;
        u.pm = fm + ((wgid % nig) % gsz); u.pn = (wgid % nig) / gsz; u.sel = 0; return true;
    }
    __device__ __forceinline__ void a_ready(const Unit&) const {}
    __device__ __forceinline__ void done(const Unit&) const {}
};
struct TwoPartOrder {
    StaticOrder b;
    __device__ __forceinline__ bool next(int i, Unit& u) const { if (!b.next(i >> 1, u)) return false; u.sel = i & 1; return true; }
    __device__ __forceinline__ void a_ready(const Unit&) const {}
    __device__ __forceinline__ void done(const Unit&) const {}
};

__device__ __forceinline__ unsigned cvt_pk_bf16(float lo, float hi) { unsigned r; asm volatile("v_cvt_pk_bf16_f32 %0, %1, %2" : "=v"(r) : "v"(lo), "v"(hi)); return r; }
__device__ __forceinline__ u32x4 pack8(const f32x4 a, const f32x4 b) { u32x4 w; w.x = cvt_pk_bf16(a[0], a[1]); w.y = cvt_pk_bf16(a[2], a[3]); w.z = cvt_pk_bf16(b[0], b[1]); w.w = cvt_pk_bf16(b[2], b[3]); return w; }
__device__ __forceinline__ float bflo(unsigned w) { return __uint_as_float(w << 16); }
__device__ __forceinline__ float bfhi(unsigned w) { return __uint_as_float(w & 0xffff0000u); }
__device__ __forceinline__ void unpack8(const u32x4 w, f32x4& a, f32x4& b) { a = (f32x4){bflo(w.x), bfhi(w.x), bflo(w.y), bfhi(w.y)}; b = (f32x4){bflo(w.z), bfhi(w.z), bflo(w.w), bfhi(w.w)}; }
__device__ __forceinline__ float sigmoidf_(float v) { return 1.0f / (1.0f + __expf(-v)); }

constexpr float QSCALE = 0.125f * 1.4426950408889634f;

struct EpiUT {
    static constexpr bool PERM = true, AFTER_DRAIN = false;
    bf16_t* O; int ldc; const float* rstd;
    __device__ __forceinline__ bool keep(const Unit&) const { return false; }
    __device__ __forceinline__ void operator()(f32x4 (&acc)[2][2][4][2], const Unit& u, int wr, int wc, int fr, int fq) const {
        const int row0 = u.pm * BM + wr * 64 + fr, col0 = u.pn * BM + wc * 32 + 8 * fq;
        f32x4 rs[2][2];
#pragma unroll
        for (int bj = 0; bj < 2; ++bj)
#pragma unroll
            for (int n = 0; n < 2; ++n) rs[bj][n] = *(const f32x4*)(rstd + col0 + bj * HALF + 4 * n);
#pragma unroll
        for (int ai = 0; ai < 2; ++ai)
#pragma unroll
            for (int m = 0; m < 4; ++m) { bf16_t* rowp = O + (size_t)(row0 + ai * HALF + m * 16) * ldc + col0;
#pragma unroll
                for (int bj = 0; bj < 2; ++bj) *(u32x4*)(rowp + bj * HALF) = pack8(acc[ai][bj][m][0] * rs[bj][0], acc[ai][bj][m][1] * rs[bj][1]); }
    }
};

struct EpiProj {
    static constexpr bool PERM = true, AFTER_DRAIN = false;
    const float* rstd; const float* qw; const float* kw; const float* cs; const float* sn; bf16_t* q; bf16_t* k; bf16_t* v; bf16_t* sgh; bf16_t* sga;
    __device__ __forceinline__ bool keep(const Unit&) const { return false; }
    __device__ __forceinline__ void operator()(f32x4 (&acc)[2][2][4][2], const Unit& u, int wr, int wc, int fr, int fq) const {
        const int pn = u.pn;
        if (pn <= 2 && !(pn == 2 && wc >= 2)) {
            const float* w = (pn < 2) ? qw : kw; const float sc = (pn < 2) ? QSCALE : 1.0f;
            const f32x4 wl0 = *(const f32x4*)(w + 8 * fq), wl1 = *(const f32x4*)(w + 8 * fq + 4), wh0 = *(const f32x4*)(w + 32 + 8 * fq), wh1 = *(const f32x4*)(w + 32 + 8 * fq + 4);
#pragma unroll
            for (int ai = 0; ai < 2; ++ai)
#pragma unroll
                for (int m = 0; m < 4; ++m) {
                    const int row = u.pm * BM + ai * HALF + wr * 64 + m * 16 + fr; const float rs = rstd[row];
                    f32x4 a0 = acc[ai][0][m][0] * rs, a1 = acc[ai][0][m][1] * rs, b0 = acc[ai][1][m][0] * rs, b1 = acc[ai][1][m][1] * rs;
                    f32x4 sq = a0 * a0 + a1 * a1 + b0 * b0 + b1 * b1; float ss = (sq[0] + sq[1]) + (sq[2] + sq[3]);
                    ss += __shfl_xor(ss, 16); ss += __shfl_xor(ss, 32);
                    const float inv = 1.0f / sqrtf(ss * (1.0f / 64.0f) + 1e-6f);
                    const int pos = row < 16384 ? (row & 2047) : (row - 16384);
                    const f32x4 c0 = *(const f32x4*)(cs + pos * 32 + 8 * fq), c1 = *(const f32x4*)(cs + pos * 32 + 8 * fq + 4), s0 = *(const f32x4*)(sn + pos * 32 + 8 * fq), s1 = *(const f32x4*)(sn + pos * 32 + 8 * fq + 4);
                    a0 = a0 * inv * wl0; a1 = a1 * inv * wl1; b0 = b0 * inv * wh0; b1 = b1 * inv * wh1;
                    const f32x4 lo0 = (a0 * c0 - b0 * s0) * sc, lo1 = (a1 * c1 - b1 * s1) * sc, hi0 = (b0 * c0 + a0 * s0) * sc, hi1 = (b1 * c1 + a1 * s1) * sc;
                    bf16_t* dst = (pn < 2) ? q + (size_t)row * 512 + (4 * pn + wc) * 64 + 8 * fq : k + (size_t)row * 128 + wc * 64 + 8 * fq;
                    *(u32x4*)dst = pack8(lo0, lo1); *(u32x4*)(dst + 32) = pack8(hi0, hi1);
                }
        } else if (pn == 2) {
#pragma unroll
            for (int ai = 0; ai < 2; ++ai)
#pragma unroll
                for (int m = 0; m < 4; ++m) {
                    const int row = u.pm * BM + ai * HALF + wr * 64 + m * 16 + fr; const float rs = rstd[row];
                    bf16_t* dst = v + (size_t)row * 128 + (wc - 2) * 64 + 8 * fq;
                    *(u32x4*)dst = pack8(acc[ai][0][m][0] * rs, acc[ai][0][m][1] * rs); *(u32x4*)(dst + 32) = pack8(acc[ai][1][m][0] * rs, acc[ai][1][m][1] * rs);
                }
        } else {
            bf16_t* base = (pn < 7) ? sgh : sga; const int colb = (pn - ((pn < 7) ? 3 : 7)) * BM + wc * 32 + 8 * fq;
#pragma unroll
            for (int ai = 0; ai < 2; ++ai)
#pragma unroll
                for (int m = 0; m < 4; ++m) {
                    const int row = u.pm * BM + ai * HALF + wr * 64 + m * 16 + fr; const float rs = rstd[row];
#pragma unroll
                    for (int bj = 0; bj < 2; ++bj) { f32x4 g0 = acc[ai][bj][m][0] * rs, g1 = acc[ai][bj][m][1] * rs;
#pragma unroll
                        for (int e = 0; e < 4; ++e) { g0[e] = sigmoidf_(g0[e]); g1[e] = sigmoidf_(g1[e]); }
                        *(u32x4*)(base + (size_t)row * 1024 + colb + bj * HALF) = pack8(g0, g1); }
                }
        }
    }
};

struct EpiMerged {
    static constexpr bool PERM = true, AFTER_DRAIN = false;
    const bf16_t* sgh; const bf16_t* sga; bf16_t* out;
    __device__ __forceinline__ bool keep(const Unit& u) const { return u.sel == 0; }
    __device__ __forceinline__ void operator()(f32x4 (&acc)[2][2][4][2], const Unit& u, int wr, int wc, int fr, int fq) const {
#pragma unroll
        for (int ai = 0; ai < 2; ++ai)
#pragma unroll
            for (int m = 0; m < 4; ++m) {
                const size_t off = (size_t)(u.pm * BM + ai * HALF + wr * 64 + m * 16 + fr) * 1024 + u.pn * BM + wc * 32 + 8 * fq;
#pragma unroll
                for (int bj = 0; bj < 2; ++bj) {
                    f32x4 t0, t1; unpack8(*(const u32x4*)(sga + off + bj * HALF), t0, t1);
                    if (u.sel == 0) { f32x4 h0, h1; unpack8(*(const u32x4*)(sgh + off + bj * HALF), h0, h1);
                        f32x4 q0, q1;
#pragma unroll
                        for (int e = 0; e < 4; ++e) { q0[e] = h0[e] * __builtin_amdgcn_rcpf(t0[e]); q1[e] = h1[e] * __builtin_amdgcn_rcpf(t1[e]); }
                        acc[ai][bj][m][0] = acc[ai][bj][m][0] * q0; acc[ai][bj][m][1] = acc[ai][bj][m][1] * q1; }
                    else *(u32x4*)(out + off + bj * HALF) = pack8(acc[ai][bj][m][0] * t0, acc[ai][bj][m][1] * t1);
                }
            }
    }
};

struct EpiWo {
    static constexpr bool PERM = true, AFTER_DRAIN = false;
    const float* xp; const float* xs; bf16_t* x1b; float* ssq;
    __device__ __forceinline__ bool keep(const Unit&) const { return false; }
    __device__ __forceinline__ void operator()(f32x4 (&acc)[2][2][4][2], const Unit& u, int wr, int wc, int fr, int fq) const {
        const float* xb = (u.pm < 64) ? xp : xs - (size_t)16384 * 1024;
#pragma unroll
        for (int ai = 0; ai < 2; ++ai)
#pragma unroll
            for (int m = 0; m < 4; ++m) {
                const int row = u.pm * BM + ai * HALF + wr * 64 + m * 16 + fr; const size_t off = (size_t)row * 1024 + u.pn * BM + wc * 32 + 8 * fq; float s = 0.f;
#pragma unroll
                for (int bj = 0; bj < 2; ++bj) {
                    const f32x4 v0 = *(const f32x4*)(xb + off + bj * HALF) + acc[ai][bj][m][0], v1 = *(const f32x4*)(xb + off + bj * HALF + 4) + acc[ai][bj][m][1];
                    *(u32x4*)(x1b + off + bj * HALF) = pack8(v0, v1);
                    const f32x4 q = v0 * v0 + v1 * v1; s += (q[0] + q[1]) + (q[2] + q[3]); }
                s += __shfl_xor(s, 16); s += __shfl_xor(s, 32);
                if (fq == 0) ssq[(size_t)row * 16 + u.pn * 4 + wc] = s;
            }
    }
};

struct EpiFfn1 {
    static constexpr bool PERM = true, AFTER_DRAIN = false;
    const float* ssq; bf16_t* hid;
    __device__ __forceinline__ bool keep(const Unit&) const { return false; }
    __device__ __forceinline__ void operator()(f32x4 (&acc)[2][2][4][2], const Unit& u, int wr, int wc, int fr, int fq) const {
#pragma unroll
        for (int ai = 0; ai < 2; ++ai)
#pragma unroll
            for (int m = 0; m < 4; ++m) {
                const int row = u.pm * BM + ai * HALF + wr * 64 + m * 16 + fr;
                const f32x4 p = *(const f32x4*)(ssq + (size_t)row * 16 + 4 * fq); float t = (p[0] + p[1]) + (p[2] + p[3]);
                t += __shfl_xor(t, 16); t += __shfl_xor(t, 32);
                const float r = 1.0f / sqrtf(t * (1.0f / 1024.0f) + 1e-6f);
                f32x4 h0, h1;
#pragma unroll
                for (int e = 0; e < 4; ++e) { const float g0 = acc[ai][0][m][0][e] * r, g1 = acc[ai][0][m][1][e] * r;
                    h0[e] = g0 * sigmoidf_(g0) * (acc[ai][1][m][0][e] * r); h1[e] = g1 * sigmoidf_(g1) * (acc[ai][1][m][1][e] * r); }
                *(u32x4*)(hid + (size_t)row * 2816 + u.pn * HALF + wc * 32 + 8 * fq) = pack8(h0, h1);
            }
    }
};

struct EpiFfn2 {
    static constexpr bool PERM = true, AFTER_DRAIN = false;
    const bf16_t* x1b; float* out;
    __device__ __forceinline__ bool keep(const Unit&) const { return false; }
    __device__ __forceinline__ void operator()(f32x4 (&acc)[2][2][4][2], const Unit& u, int wr, int wc, int fr, int fq) const {
#pragma unroll
        for (int ai = 0; ai < 2; ++ai)
#pragma unroll
            for (int m = 0; m < 4; ++m) {
                const size_t off = (size_t)(u.pm * BM + ai * HALF + wr * 64 + m * 16 + fr) * 1024 + u.pn * BM + wc * 32 + 8 * fq; float* p = out + off;
#pragma unroll
                for (int bj = 0; bj < 2; ++bj) { f32x4 r0, r1; unpack8(*(const u32x4*)(x1b + off + bj * HALF), r0, r1);
                    *(f32x4*)(p + bj * HALF) = r0 + acc[ai][bj][m][0]; *(f32x4*)(p + bj * HALF + 4) = r1 + acc[ai][bj][m][1]; }
            }
    }
};

__device__ __forceinline__ void zero_acc(f32x4 (&acc)[2][2][4][2]) {
#pragma unroll
    for (int a = 0; a < 2; ++a)
#pragma unroll
        for (int b = 0; b < 2; ++b)
#pragma unroll
            for (int m = 0; m < 4; ++m)
#pragma unroll
                for (int n = 0; n < 2; ++n) acc[a][b][m][n] = (f32x4){0.f, 0.f, 0.f, 0.f};
}
template <class Epi, class Sched, bool ALIGN_EPI = false, bool SP2 = false>
__device__ __forceinline__ void gemm_phase(PG8_LAS unsigned char* lds, const Gemm g, const Sched& S, const Epi& E) {
    int tid = threadIdx.x; asm volatile("" : "+v"(tid));
    const int wid = __builtin_amdgcn_readfirstlane(tid >> 6), lane = tid & 63, wr = wid >> 2, wc = wid & 3, fr = lane & 15, fq = lane >> 4;
    const int K = g.K, nt = K / BK;
    unsigned voffA[2], voffB[2];
#pragma unroll
    for (int i = 0; i < 2; ++i) { int R, C; stage_rc(tid * 16 + i * 8192, R, C); const int Rb = Epi::PERM ? ((R & ~31) + perm32(R & 31)) : R;
        voffA[i] = (unsigned)(R * K + C) * 2u; voffB[i] = (unsigned)(Rb * K + C) * 2u; }
    const size_t kstep = (size_t)(BK * 2);
    const size_t hstep = (size_t)HALF * K * 2;
    const size_t tstep = 2 * hstep;
    const unsigned ldsw = (unsigned)wid * 1024u;
    const int aoff = lds_byte(wr * 64 + fr, fq * 8), boff = lds_byte(wc * 32 + fr, fq * 8);
#define PG8_SA(b, h) (((b) * 2 + (h)) * HTB)
#define PG8_SB(b, h) ((4 + (b) * 2 + (h)) * HTB)
#define PG8_STAGE(bufoff, gbase, voff) do { _Pragma("unroll") for (int _i = 0; _i < 2; ++_i) \
        __builtin_amdgcn_global_load_lds((const unsigned*)((const char*)(gbase) + (voff)[_i]), (PG8_LAS unsigned*)(lds + (bufoff) + ldsw + _i * 8192), 16, 0, 0); } while (0)
#define PG8_LDA(dst, b, h) do { _Pragma("unroll") for (int m = 0; m < 4; ++m) _Pragma("unroll") for (int k = 0; k < 2; ++k) dst[m][k] = *(const PG8_LAS bf16x8*)(lds + PG8_SA(b, h) + aoff + m * 2048 + k * 1024); } while (0)
#define PG8_LDB(dst, b, h) do { _Pragma("unroll") for (int n = 0; n < 2; ++n) _Pragma("unroll") for (int k = 0; k < 2; ++k) dst[n][k] = *(const PG8_LAS bf16x8*)(lds + PG8_SB(b, h) + boff + n * 2048 + k * 1024); } while (0)
#define PG8_MMA(ai, bj, At, Bt) do { __builtin_amdgcn_s_setprio(1); _Pragma("unroll") for (int m = 0; m < 4; ++m) _Pragma("unroll") for (int n = 0; n < 2; ++n) _Pragma("unroll") for (int k = 0; k < 2; ++k) \
        acc[ai][bj][m][n] = __builtin_amdgcn_mfma_f32_16x16x32_bf16(Bt[n][k], At[m][k], acc[ai][bj][m][n], 0, 0, 0); __builtin_amdgcn_s_setprio(0); } while (0)
#define PG8_WAIT_V(n) asm volatile("s_waitcnt vmcnt(" #n ")" ::: "memory")
#define PG8_WAIT_L(n) asm volatile("s_waitcnt lgkmcnt(" #n ")" ::: "memory")
#define PG8_BAR __builtin_amdgcn_s_barrier()
#define PG8_SCHED __builtin_amdgcn_sched_barrier(0)
    Unit cur, nxt; int ui = 0;
    if (!S.next(0, cur)) return;
    f32x4 acc[2][2][4][2];
#pragma unroll
    for (int a = 0; a < 2; ++a)
#pragma unroll
        for (int b = 0; b < 2; ++b)
#pragma unroll
            for (int m = 0; m < 4; ++m)
#pragma unroll
                for (int n = 0; n < 2; ++n) acc[a][b][m][n] = (f32x4){0.f, 0.f, 0.f, 0.f};
    bf16x8 At[4][2], B0[2][2], B1[2][2];
    const char* cA = (const char*)(cur.sel ? g.A1 : g.A) + (size_t)cur.pm * tstep; const char* cB = (const char*)(cur.sel ? g.Bt1 : g.Bt) + (size_t)cur.pn * tstep;
    S.a_ready(cur);
    if constexpr (SP2) {
        PG8_STAGE(PG8_SB(0, 0), cB, voffB); PG8_STAGE(PG8_SB(0, 1), cB + hstep, voffB); PG8_STAGE(PG8_SA(0, 0), cA, voffA); PG8_STAGE(PG8_SA(0, 1), cA + hstep, voffA);
        if (wr == 1) PG8_BAR;
        PG8_WAIT_V(2); PG8_BAR;
        PG8_STAGE(PG8_SB(1, 0), cB + kstep, voffB); PG8_STAGE(PG8_SA(1, 0), cA + kstep, voffA); PG8_STAGE(PG8_SB(1, 1), cB + hstep + kstep, voffB);
        PG8_WAIT_V(6); PG8_BAR;
    } else {
        PG8_STAGE(PG8_SB(0, 0), cB, voffB); PG8_STAGE(PG8_SA(0, 0), cA, voffA); PG8_STAGE(PG8_SB(0, 1), cB + hstep, voffB); PG8_STAGE(PG8_SA(0, 1), cA + hstep, voffA);
        if (wr == 1) PG8_BAR;
        PG8_WAIT_V(4); PG8_BAR;
        PG8_STAGE(PG8_SB(1, 0), cB + kstep, voffB); PG8_STAGE(PG8_SA(1, 0), cA + kstep, voffA); PG8_STAGE(PG8_SB(1, 1), cB + hstep + kstep, voffB);
        PG8_WAIT_V(6); PG8_BAR;
    }
    for (;;) {
        const bool has_next = S.next(ui + 1, nxt);
        const char* nA = has_next ? (const char*)(nxt.sel ? g.A1 : g.A) + (size_t)nxt.pm * tstep : cA; const char* nB = has_next ? (const char*)(nxt.sel ? g.Bt1 : g.Bt) + (size_t)nxt.pn * tstep : cB;
        for (int t = 0; t < nt; t += 2) {
            const bool last = (t == nt - 2);
            const char* a1 = cA + (size_t)(t + 1) * kstep;
            const char* a2 = last ? nA : cA + (size_t)(t + 2) * kstep; const char* b2 = last ? nB : cB + (size_t)(t + 2) * kstep;
            const char* a3 = a2 + kstep; const char* b3 = b2 + kstep;
            if (last && has_next) S.a_ready(nxt);
            if constexpr (SP2) {
            PG8_LDB(B0, 0, 0); PG8_LDB(B1, 0, 1); PG8_SCHED; PG8_LDA(At, 0, 0); PG8_STAGE(PG8_SA(1, 1), a1 + hstep, voffA);
            PG8_WAIT_V(8); PG8_WAIT_L(0); PG8_BAR; PG8_MMA(0, 0, At, B0); PG8_MMA(0, 1, At, B1); PG8_BAR; PG8_SCHED;
            PG8_LDA(At, 0, 1); PG8_STAGE(PG8_SB(0, 0), b2, voffB); PG8_STAGE(PG8_SB(0, 1), b2 + hstep, voffB); PG8_STAGE(PG8_SA(0, 0), a2, voffA);
            PG8_WAIT_V(8); PG8_WAIT_L(0); PG8_BAR; PG8_MMA(1, 0, At, B0); PG8_MMA(1, 1, At, B1); PG8_BAR; PG8_SCHED;
            PG8_LDB(B0, 1, 0); PG8_LDB(B1, 1, 1); PG8_SCHED; PG8_LDA(At, 1, 0); PG8_STAGE(PG8_SA(0, 1), a2 + hstep, voffA);
            PG8_WAIT_V(8); PG8_WAIT_L(0); PG8_BAR; PG8_MMA(0, 0, At, B0); PG8_MMA(0, 1, At, B1); PG8_BAR; PG8_SCHED;
            PG8_LDA(At, 1, 1); PG8_STAGE(PG8_SB(1, 0), b3, voffB); PG8_STAGE(PG8_SB(1, 1), b3 + hstep, voffB); PG8_STAGE(PG8_SA(1, 0), a3, voffA);
            PG8_WAIT_V(8); PG8_WAIT_L(0); PG8_BAR; PG8_MMA(1, 0, At, B0); PG8_MMA(1, 1, At, B1); PG8_BAR; PG8_SCHED;
            } else {
            PG8_LDB(B0, 0, 0); PG8_SCHED; PG8_LDA(At, 0, 0); PG8_STAGE(PG8_SA(1, 1), a1 + hstep, voffA);
            PG8_WAIT_L(8); PG8_BAR; PG8_WAIT_L(0); PG8_MMA(0, 0, At, B0); PG8_BAR; PG8_SCHED;
            PG8_LDB(B1, 0, 1); PG8_STAGE(PG8_SB(0, 0), b2, voffB);
            PG8_BAR; PG8_WAIT_L(0); PG8_MMA(0, 1, At, B1); PG8_BAR;
            PG8_LDA(At, 0, 1); PG8_STAGE(PG8_SA(0, 0), a2, voffA);
            PG8_BAR; PG8_WAIT_L(0); PG8_MMA(1, 0, At, B0); PG8_BAR; PG8_SCHED;
            PG8_STAGE(PG8_SB(0, 1), b2 + hstep, voffB);
            PG8_WAIT_V(6); PG8_BAR; PG8_MMA(1, 1, At, B1); PG8_BAR;
            PG8_LDB(B0, 1, 0); PG8_SCHED; PG8_LDA(At, 1, 0); PG8_STAGE(PG8_SA(0, 1), a2 + hstep, voffA);
            PG8_WAIT_L(8); PG8_BAR; PG8_WAIT_L(0); PG8_MMA(0, 0, At, B0); PG8_BAR; PG8_SCHED;
            PG8_LDB(B1, 1, 1); PG8_STAGE(PG8_SB(1, 0), b3, voffB);
            PG8_BAR; PG8_WAIT_L(0); PG8_MMA(0, 1, At, B1); PG8_BAR;
            PG8_LDA(At, 1, 1); PG8_STAGE(PG8_SA(1, 0), a3, voffA);
            PG8_BAR; PG8_WAIT_L(0); PG8_MMA(1, 0, At, B0); PG8_BAR; PG8_SCHED;
            PG8_STAGE(PG8_SB(1, 1), b3 + hstep, voffB);
            PG8_WAIT_V(6); PG8_BAR; PG8_MMA(1, 1, At, B1); PG8_BAR;
            }
        }
        if constexpr (ALIGN_EPI) { if (wr == 0) PG8_BAR; }
        if constexpr (!Epi::AFTER_DRAIN) { E(acc, cur, wr, wc, fr, fq); S.done(cur); }
        if (!has_next) break;
        if (!E.keep(cur)) zero_acc(acc);
        cur = nxt; cA = nA; cB = nB; ++ui;
        if constexpr (ALIGN_EPI) { if (wr == 1) PG8_BAR; }
    }
    PG8_WAIT_V(0);
    if constexpr (!ALIGN_EPI) { if (wr == 0) PG8_BAR; }
    PG8_BAR;
    if constexpr (Epi::AFTER_DRAIN) { E.fused(acc, cur, wr, wc, fr, fq, lds, wid, lane); S.done(cur); }
#undef PG8_SA
#undef PG8_SB
#undef PG8_STAGE
#undef PG8_LDA
#undef PG8_LDB
#undef PG8_MMA
#undef PG8_WAIT_V
#undef PG8_WAIT_L
#undef PG8_BAR
#undef PG8_SCHED
}}

constexpr int NWAVES = 8;
constexpr int DM = 1024, MTOK = 32768, TP = 16384  , LP = 2048, LS = 16384;
constexpr int HW = 512, INW = 4352, FFN = 2816, NPROJ = INW - 3 * HW  ;
constexpr float RMS_EPS = 1e-6f;

constexpr size_t MiB = 1u << 20;
constexpr size_t WS_CTL = 0, CTL_ZERO_BYTES = 1 * MiB;
constexpr size_t WS_WINA = 1 * MiB;
constexpr size_t WS_WINB = 4 * MiB;
constexpr size_t WS_WHY = 10 * MiB;
constexpr size_t WS_WAT = 11 * MiB;
constexpr size_t WS_WO = 12 * MiB;
constexpr size_t WS_WGU = 14 * MiB;
constexpr size_t WS_WD = 25 * MiB;
constexpr size_t WS_W3T = 31 * MiB;
constexpr size_t WS_XB = 32 * MiB;
constexpr size_t WS_YT = 32 * MiB;
constexpr size_t WS_YAT = 64 * MiB;
constexpr size_t WS_KREV_S = 96 * MiB;
constexpr size_t WS_KREV_P = 160 * MiB;
constexpr size_t WS_UT = 168 * MiB;
constexpr size_t WS_Q = 264 * MiB;
constexpr size_t WS_K = 296 * MiB;
constexpr size_t WS_V = 304 * MiB;
constexpr size_t WS_SGH = 312 * MiB;
constexpr size_t WS_SGA = 376 * MiB;
constexpr size_t WS_COS = 440 * MiB;
constexpr size_t WS_SIN = 442 * MiB;
constexpr size_t WS_RSTD = 444 * MiB;
constexpr size_t WS_SSQ = 445 * MiB;
constexpr size_t WS_FPART_S = 447 * MiB;
constexpr size_t WS_FPART_P = 449 * MiB;
constexpr size_t WS_YHY = 450 * MiB;
constexpr size_t WS_MERGED = 168 * MiB;
constexpr size_t WS_X1B = 232 * MiB;
constexpr size_t WS_HID = 32 * MiB;
constexpr size_t WS_END = 482 * MiB;
static_assert(WS_HID + (size_t)MTOK * FFN * 2 <= WS_X1B, "hid vs x1b");

constexpr int CW_TMO = 0, CW_CODE = 1;
constexpr int CW_BAR = 4096;

constexpr int RING_OFF = 0;
constexpr int LDS_BYTES = 147456;
constexpr int LDSCTL_OFF = LDS_BYTES - 512, MISC_OFF = LDSCTL_OFF + 320;

#define GAS __attribute__((address_space(1)))
#define LAS __attribute__((address_space(3)))
typedef unsigned short bf16;
typedef unsigned v4u __attribute__((ext_vector_type(4)));
typedef unsigned v2u __attribute__((ext_vector_type(2)));
typedef float f32x4 __attribute__((ext_vector_type(4)));
typedef float f32x16 __attribute__((ext_vector_type(16)));
typedef short bf16x8 __attribute__((ext_vector_type(8)));
typedef GAS unsigned gu32;
#define RLX_AGENT __ATOMIC_RELAXED, __HIP_MEMORY_SCOPE_AGENT
#define LDS_WAIT() asm volatile("s_waitcnt lgkmcnt(0)" ::: "memory")
#define VM_WAIT() asm volatile("s_waitcnt vmcnt(0)" ::: "memory")
__device__ __forceinline__ unsigned f2bf(float f) { unsigned u = __builtin_bit_cast(unsigned, f); return (u + 0x7fffu + ((u >> 16) & 1u)) >> 16; }
__device__ __forceinline__ unsigned pk2(float lo, float hi) { return f2bf(lo) | (f2bf(hi) << 16); }
__device__ __forceinline__ float bf2f(unsigned short b) { return __uint_as_float((unsigned)b << 16); }
__device__ __forceinline__ float wave_sum(float v) {
#pragma unroll
    for (int o = 1; o < 64; o <<= 1) v += __shfl_xor(v, o);
    return v;
}

#define XB_TMO      128
#define XB_XCNT(j)  (256  + 64 * (j))
#define XB_XSUB(j)  (1280 + 64 * (j))
#define XB_XGEN(j)  (2304 + 64 * (j))
#define XB_TOP      3328
#define XB_TOPGEN   3392
#define XCD_BAR_WORDS 3456
#define XB_SPIN_CAP (1u << 18)

__device__ __forceinline__ unsigned xb_ld(unsigned* p)              { return __hip_atomic_load(p, __ATOMIC_RELAXED, __HIP_MEMORY_SCOPE_AGENT); }
__device__ __forceinline__ unsigned xb_add(unsigned* p, unsigned v) { return __hip_atomic_fetch_add(p, v, __ATOMIC_RELAXED, __HIP_MEMORY_SCOPE_AGENT); }
__device__ __forceinline__ unsigned xb_xcc_id() { return (unsigned)__builtin_amdgcn_s_getreg((3 << 11) | 20) & 0xFu; }
#define XB_SPIN(cond, bar) do { unsigned _sp = 0; while (cond) { __builtin_amdgcn_s_sleep(1); \
    if ((++_sp & 255u) == 0u) { if (xb_ld(&(bar)[XB_TMO])) break; if (_sp > XB_SPIN_CAP) { atomicAdd(&(bar)[XB_TMO], 1u); break; } } } } while (0)

struct XcdBarrier { unsigned* bar; unsigned x; volatile LAS unsigned* st; };

__device__ __forceinline__ XcdBarrier xcd_barrier_post(unsigned* bar, volatile LAS unsigned* st) {
    XcdBarrier b; b.bar = bar; b.x = xb_xcc_id(); b.st = st;
    if (threadIdx.x == 0) (void)xb_add(&bar[XB_XCNT(b.x)], 1u);
    return b;
}
__device__ __forceinline__ void xcd_barrier_complete(unsigned* bar, unsigned x, unsigned& nloc, unsigned& nx) {
    const unsigned G = gridDim.x * gridDim.y * gridDim.z;
    unsigned sum, cnt, mine, sp = 0u;
    for (;;) {
        sum = 0u; cnt = 0u; mine = 0u;
#pragma unroll
        for (unsigned j = 0; j < 16; ++j) { const unsigned c = xb_ld(&bar[XB_XCNT(j)]); sum += c; cnt += (c > 0u) ? 1u : 0u; mine = (j == x) ? c : mine; }
        if (sum == G) break;
        __builtin_amdgcn_s_sleep(1);
        if ((++sp & 255u) == 0u) { if (xb_ld(&bar[XB_TMO])) break; if (sp > XB_SPIN_CAP) { atomicAdd(&bar[XB_TMO], 1u); break; } }
    }
    nloc = mine > 0u ? mine : 1u; nx = cnt > 0u ? cnt : 1u;
}
__device__ __forceinline__ void xcd_barrier(const XcdBarrier& b) {
    asm volatile("s_waitcnt vmcnt(0)" ::: "memory");
    __syncthreads();
    if (threadIdx.x == 0) {
        unsigned* bar = b.bar;
        __builtin_amdgcn_s_waitcnt(0);
        unsigned nloc = b.st[0], nx = b.st[1];
        if (nloc == 0u) { xcd_barrier_complete(bar, b.x, nloc, nx); b.st[0] = nloc; b.st[1] = nx; }
        const unsigned old = xb_add(&bar[XB_XSUB(b.x)], 1u);
        const unsigned gen = old / nloc;
        if (old + 1u == (gen + 1u) * nloc) {
            __builtin_amdgcn_fence(__ATOMIC_RELEASE, "agent");
            asm volatile("s_waitcnt vmcnt(0)" ::: "memory");
            const unsigned og = xb_add(&bar[XB_TOP], 1u);
            const unsigned tg = og / nx;
            if (og + 1u == (tg + 1u) * nx) xb_add(&bar[XB_TOPGEN], 1u);
            else XB_SPIN(xb_ld(&bar[XB_TOPGEN]) == tg, bar);
            __builtin_amdgcn_fence(__ATOMIC_ACQUIRE, "agent");
            xb_add(&bar[XB_XGEN(b.x)], 1u);
            asm volatile("s_waitcnt vmcnt(0)" ::: "memory");
        } else {
            XB_SPIN(xb_ld(&bar[XB_XGEN(b.x)]) == gen, bar);
            __builtin_amdgcn_fence(__ATOMIC_ACQUIRE, "agent");
            asm volatile("s_waitcnt vmcnt(0)" ::: "memory");
        }
    }
    __syncthreads();
}

struct Frame {
    LAS unsigned char* lds;
    volatile LAS unsigned* MISC;
    gu32* ctl;
    int tid, lane, wave;
    int vcu, G;
    unsigned char* ws;
};

__device__ __forceinline__ void p0_transpose_item(const float* W, int K, int N, bf16* WT, int dst_row0, const float* kscale, LAS float* scr, int k0, int n0, int lane) {
#pragma unroll 8
    for (int i = 0; i < 32; ++i) { const int kk = 2 * i + (lane >> 5); float v = W[(size_t)(k0 + kk) * N + n0 + (lane & 31)]; if (kscale) v *= kscale[k0 + kk]; scr[kk * 33 + (lane & 31)] = v; }
    LDS_WAIT(); asm volatile("" ::: "memory");
    const int c = lane & 7;
#pragma unroll
    for (int j = 0; j < 4; ++j) { const int n = (lane >> 3) + 8 * j; const LAS float* s = scr + (8 * c) * 33 + n;
        v4u o; o.x = pk2(s[0 * 33], s[1 * 33]); o.y = pk2(s[2 * 33], s[3 * 33]); o.z = pk2(s[4 * 33], s[5 * 33]); o.w = pk2(s[6 * 33], s[7 * 33]);
        *(GAS v4u*)(WT + (size_t)(dst_row0 + n) * K + k0 + 8 * c) = o; }
    LDS_WAIT(); asm volatile("" ::: "memory");
}
__device__ __forceinline__ int map_projB(int n0) {
    if (n0 < 2048) { const int t = n0 - 1536, hq = t >> 6, hf = (t >> 5) & 1; return 256 * (hq >> 2) + 128 * hf + 32 * (hq & 3); }
    if (n0 < 2176) { const int t = n0 - 2048, kh = t >> 6, hf = (t >> 5) & 1; return 512 + 128 * hf + 32 * kh; }
    if (n0 < 2304) { const int t = n0 - 2176, vh = t >> 6, hf = (t >> 5) & 1; return 512 + 128 * hf + 32 * (2 + vh); }
    return 768 + (n0 - 2304);
}
__device__ __forceinline__ void p0_row(const float* xrow, bf16* orow, float* rstd_out, int lane) {
    const GAS f32x4* xr = (const GAS f32x4*)xrow + lane;
    f32x4 v[4]; float s = 0.f;
#pragma unroll
    for (int j = 0; j < 4; ++j) { v[j] = xr[64 * j]; s += (v[j].x * v[j].x + v[j].y * v[j].y) + (v[j].z * v[j].z + v[j].w * v[j].w); }
    s = wave_sum(s);
    if (lane == 0) *rstd_out = 1.0f / sqrtf(s * (1.0f / DM) + RMS_EPS);
    GAS unsigned long long* o8 = (GAS unsigned long long*)orow + lane;
#pragma unroll
    for (int j = 0; j < 4; ++j) o8[64 * j] = (unsigned long long)pk2(v[j].x, v[j].y) | ((unsigned long long)pk2(v[j].z, v[j].w) << 32);
}
constexpr int FW_W1 = 0, FW_W2 = 33 * 64 * 4, FW_B1 = FW_W2 + 64 * 64 * 4, FW_B2 = FW_B1 + 256, FW_FR = FW_B2 + 256, FW_END = FW_FR + 256, FT_PITCH = 144, FT_BYTES = 32 * FT_PITCH;
__device__ __forceinline__ void filter_stage_weights(LAS unsigned char* lds, const float* w1, const float* b1, const float* w2, const float* b2, const float* fr, int tid) {
    LAS float* W1 = (LAS float*)(lds + FW_W1); LAS float* W2 = (LAS float*)(lds + FW_W2);
    for (int i = tid; i < 33 * 64; i += NWAVES * 64) W1[i] = w1[i];
    for (int i = tid; i < 64 * 64; i += NWAVES * 64) W2[i] = w2[i];
    if (tid < 64) { ((LAS float*)(lds + FW_B1))[tid] = b1[tid]; ((LAS float*)(lds + FW_B2))[tid] = b2[tid]; ((LAS float*)(lds + FW_FR))[tid] = fr[tid]; }
    LDS_WAIT(); __syncthreads();
}
__device__ __forceinline__ void filter_mlp_half(LAS unsigned char* lds, int L, int chunk, int hf, int dir, int r, int h, LAS float* Hb, bf16x8 (&afr)[4]) {
    const LAS float* W1 = (const LAS float*)(lds + FW_W1); const LAS float* W2 = (const LAS float*)(lds + FW_W2);
    const LAS float* B1 = (const LAS float*)(lds + FW_B1); const LAS float* B2 = (const LAS float*)(lds + FW_B2); const LAS float* FR = (const LAS float*)(lds + FW_FR);
        int pos = 64 * chunk + 32 * hf + r + dir; if (pos > L - 1) pos = L - 1;
        const float t = (float)pos / (float)(L - 1);
        float a[32];
#pragma unroll
        for (int jj = 0; jj < 32; ++jj) a[jj] = B1[32 * h + jj];
        {
#pragma unroll
            for (int jj = 0; jj < 32; jj += 4) { const f32x4 w = *(const LAS f32x4*)(W1 + 32 * h + jj); a[jj] += t * w[0]; a[jj + 1] += t * w[1]; a[jj + 2] += t * w[2]; a[jj + 3] += t * w[3]; }
#pragma unroll 1
            for (int i = 0; i < 16; ++i) {
                const float band = 1e-4f + (float)i * ((15.0f - 1e-4f) / 15.0f); const float ang = (6.283185307179586f / (float)L) * (float)pos * band;
                const float cv = __cosf(ang), sv = -__sinf(ang);
                const LAS float* wc = W1 + (1 + i) * 64 + 32 * h; const LAS float* wsn = W1 + (17 + i) * 64 + 32 * h;
#pragma unroll
                for (int jj = 0; jj < 32; jj += 4) { const f32x4 w = *(const LAS f32x4*)(wc + jj), v = *(const LAS f32x4*)(wsn + jj);
                    a[jj] += cv * w[0] + sv * v[0]; a[jj + 1] += cv * w[1] + sv * v[1]; a[jj + 2] += cv * w[2] + sv * v[2]; a[jj + 3] += cv * w[3] + sv * v[3]; }
            }
        }
#pragma unroll
        for (int jj = 0; jj < 32; ++jj) Hb[(32 * h + jj) * 32 + r] = __sinf(FR[32 * h + jj] * a[jj]);
        LDS_WAIT(); asm volatile("" ::: "memory");
#pragma unroll
        for (int jj = 0; jj < 32; ++jj) a[jj] = B2[32 * h + jj];
#pragma unroll 1
        for (int i = 0; i < 64; ++i) { const float hv = Hb[i * 32 + r]; const LAS float* wr_ = W2 + i * 64 + 32 * h;
#pragma unroll
            for (int jj = 0; jj < 32; jj += 4) { const f32x4 w = *(const LAS f32x4*)(wr_ + jj); a[jj] += hv * w[0]; a[jj + 1] += hv * w[1]; a[jj + 2] += hv * w[2]; a[jj + 3] += hv * w[3]; } }
        LDS_WAIT(); asm volatile("" ::: "memory");
        unsigned op[16], pp[16];
#pragma unroll
        for (int d = 0; d < 16; ++d) op[d] = pk2(__sinf(FR[32 * h + 2 * d] * a[2 * d]), __sinf(FR[32 * h + 2 * d + 1] * a[2 * d + 1]));
#pragma unroll
        for (int d = 0; d < 16; ++d) pp[d] = __shfl_xor(op[d], 32);
#pragma unroll
        for (int ks = 0; ks < 4; ++ks) { v4u f;
#pragma unroll
            for (int w = 0; w < 4; ++w) { const unsigned own = h ? op[8 * (ks & 1) + 4 + w] : op[8 * (ks & 1) + w], par = h ? pp[8 * (ks & 1) + 4 + w] : pp[8 * (ks & 1) + w];
                f[w] = ((ks >> 1) == h) ? own : par; }
            afr[ks] = __builtin_bit_cast(bf16x8, f); }
}
__device__ __forceinline__ void filter_item(LAS unsigned char* lds, const bf16* w3T, bf16* krev, float* fpart, int g, int chunk, int quarter, int wave, int lane_) {
    int lane = lane_; asm volatile("" : "+v"(lane));
    const int L = g ? LS : LP, r = lane & 31, h = lane >> 5, dir = quarter & 1, o_ = quarter >> 1;
    const LAS float* W1 = (const LAS float*)(lds + FW_W1); const LAS float* W2 = (const LAS float*)(lds + FW_W2);
    const LAS float* B1 = (const LAS float*)(lds + FW_B1); const LAS float* B2 = (const LAS float*)(lds + FW_B2); const LAS float* FR = (const LAS float*)(lds + FW_FR);
    LAS unsigned char* T = lds + FW_END + wave * FT_BYTES; LAS float* Hb = (LAS float*)(lds + FW_END + NWAVES * FT_BYTES + wave * 8192);
    bf16x8 afr0[4], afr1[4];
    filter_mlp_half(lds, L, chunk, 0, dir, r, h, Hb, afr0);
    filter_mlp_half(lds, L, chunk, 1, dir, r, h, Hb, afr1);
    const float dmin = -4.605170185988091f / 1.5f, dmax = -4.605170185988091f / 0.3f;
    const int p0 = 64 * chunk; const int mstart = dir ? (L + p0) : (L - 64 - p0);
    for (int ti = 0; ti < 16; ++ti) {
        const int cb = 32 * ti, colg = quarter * 512 + cb;
        bf16x8 bfr[4];
#pragma unroll
        for (int ks = 0; ks < 4; ++ks) bfr[ks] = *(const GAS bf16x8*)(w3T + (size_t)(colg + r) * 64 + 16 * ks + 8 * h);
        const float delta = fabsf(dmin + (float)(cb + r) * ((dmax - dmin) / 511.0f));
        float asum = 0.f;
#pragma unroll
        for (int hf = 0; hf < 2; ++hf) {
            f32x16 acc = (f32x16){0.f,0.f,0.f,0.f,0.f,0.f,0.f,0.f,0.f,0.f,0.f,0.f,0.f,0.f,0.f,0.f};
#pragma unroll
            for (int ks = 0; ks < 4; ++ks) acc = __builtin_amdgcn_mfma_f32_32x32x16_bf16(hf ? afr1[ks] : afr0[ks], bfr[ks], acc, 0, 0, 0);
#pragma unroll
            for (int rg = 0; rg < 16; ++rg) {
                const int i = 32 * hf + (rg & 3) + 8 * (rg >> 2) + 4 * h; const int pos = p0 + i + dir;
                const float t = (float)pos / (float)(L - 1);
                float kv = acc[rg] * (__expf(-t * delta) + 0.05f); if (pos > L - 1) kv = 0.f;
                asum += fabsf(kv);
                const int e = dir ? i : 63 - i;
                *(LAS bf16*)(T + r * FT_PITCH + e * 2) = (bf16)f2bf(kv);
            }
        }
        asum += __shfl_xor(asum, 32);
        if (h == 0) fpart[(size_t)chunk * 2048 + colg + r] = asum;
        LDS_WAIT(); asm volatile("" ::: "memory");
        {
            const int col = lane >> 1, hb = lane & 1;
            bf16* dst = krev + (size_t)(o_ * 512 + cb + col) * (2 * L) + mstart + 32 * hb;
            const LAS v4u* src = (const LAS v4u*)(T + col * FT_PITCH + 64 * hb);
#pragma unroll
            for (int q = 0; q < 4; ++q) *(GAS v4u*)(dst + 8 * q) = src[q];
        }
        LDS_WAIT(); asm volatile("" ::: "memory");
    }
}

namespace hy {
constexpr int SLOTB = 272, Z_BYTES = 75776, F_OFF = 75776, F_BYTES = 65536, RED_OFF = F_OFF + F_BYTES;
__device__ __forceinline__ int slot_of(int g, int n) { return g ? (n + 31) : ((n >> 4) * 32 + 16 + (n & 15)); }
__device__ __forceinline__ int crow(int r, int hi) { return (r & 3) + 8 * (r >> 2) + 4 * hi; }

struct Params { const bf16* uT; const bf16* krev_s; const bf16* krev_p; const float* fpart_s; const float* fpart_p; const float* conv_w; const float* conv_b; const float* hbias; bf16* yT; float* dF; bf16* dZ; };

__device__ __forceinline__ void conv3_chunk(const bf16* urow  , int g, int chunk, float w0, float w1, float w2, float b, float (&out)[8]) {
    const int tau0 = chunk * 8; const int L = g ? LS : LP; const int p0 = g ? tau0 : (tau0 & (LP - 1));
    const v4u raw = *(const GAS v4u*)(urow + tau0);
    float u[10];
    u[1] = pg8::bflo(raw.x); u[2] = pg8::bfhi(raw.x); u[3] = pg8::bflo(raw.y); u[4] = pg8::bfhi(raw.y); u[5] = pg8::bflo(raw.z); u[6] = pg8::bfhi(raw.z); u[7] = pg8::bflo(raw.w); u[8] = pg8::bfhi(raw.w);
    u[0] = (p0 > 0) ? bf2f(urow[tau0 - 1]) : 0.f;
    u[9] = (p0 + 8 < L) ? bf2f(urow[tau0 + 8]) : 0.f;
#pragma unroll
    for (int i = 0; i < 8; ++i) out[i] = w0 * u[i] + w1 * u[i + 1] + w2 * u[i + 2] + b;
}

__device__ __forceinline__ bf16x8 load_afrag(LAS const unsigned char* lds, int addr, int sh) {
    const LAS unsigned* p = (const LAS unsigned*)(lds + addr);
    const unsigned w0 = p[0], w1 = p[1], w2 = p[2], w3 = p[3], w4 = p[4];
    v4u f; f.x = __builtin_amdgcn_alignbit(w1, w0, sh); f.y = __builtin_amdgcn_alignbit(w2, w1, sh); f.z = __builtin_amdgcn_alignbit(w3, w2, sh); f.w = __builtin_amdgcn_alignbit(w4, w3, sh);
    return __builtin_bit_cast(bf16x8, f);
}

__device__ __forceinline__ void hyena_item(LAS unsigned char* lds, const Params& P, int g, int c, int tid_) {
    int tid = tid_; asm volatile("" : "+v"(tid));
    const int lane = tid & 63, wave = __builtin_amdgcn_readfirstlane(tid >> 6), r = lane & 31, hi = lane >> 5, nt = wave & 3, half = wave >> 2;
    const int L = g ? LS : LP; const int T0 = g ? TP : 0;
    LAS float* red = (LAS float*)(lds + RED_OFF);
    float inv_norm0, inv_norm1;
    {
        const int nchunk = g ? 256 : 32; const float* fp = P.fpart_s + (g ? (size_t)0 : (size_t)((WS_FPART_P - WS_FPART_S) / 4));
        float s0 = 0.f, s1 = 0.f;
        for (int idx = tid; idx < nchunk * 2; idx += NWAVES * 64) { const int ch = idx >> 1, dir = idx & 1; s0 += fp[(size_t)ch * 2048 + dir * 512 + c]; s1 += fp[(size_t)ch * 2048 + 1024 + dir * 512 + c]; }
        s0 = wave_sum(s0); s1 = wave_sum(s1);
        if (lane == 0) { red[wave * 2] = s0; red[wave * 2 + 1] = s1; }
        for (int i = tid; i < Z_BYTES / 16; i += NWAVES * 64) *(LAS v4u*)(lds + i * 16) = (v4u){0u, 0u, 0u, 0u};
        LDS_WAIT(); __syncthreads();
        float t0 = 0.f, t1 = 0.f;
#pragma unroll
        for (int w = 0; w < NWAVES; ++w) { t0 += red[w * 2]; t1 += red[w * 2 + 1]; }
        inv_norm0 = 1.0f / t0; inv_norm1 = 1.0f / t1;
    }
    {
        const int ch = 2 * HW + c; const float w0 = P.conv_w[ch], w1 = P.conv_w[3 * HW + ch], w2 = P.conv_w[6 * HW + ch], b = P.conv_b[ch];
        const bf16* urow = P.uT + (size_t)ch * MTOK + T0;
        for (int it = 0; it < 4; ++it) { const int chunk = tid + it * 512; float o[8]; conv3_chunk(urow, g, chunk, w0, w1, w2, b, o);
            const int tau0 = chunk * 8; v4u pk; pk.x = pk2(o[0], o[1]); pk.y = pk2(o[2], o[3]); pk.z = pk2(o[4], o[5]); pk.w = pk2(o[6], o[7]);
            *(LAS v4u*)(lds + slot_of(g, tau0 >> 7) * SLOTB + (tau0 & 127) * 2) = pk; }
    }
    int d_hi, d_lo;
    if (g) { if (half == 0) { d_hi = 32 * nt + 31; d_lo = 32 * nt - 48; } else { d_hi = 32 * nt - 49; d_lo = 32 * nt - 127; } }
    else   { if (half == 0) { d_hi = 15; d_lo = 0; } else { d_hi = -1; d_lo = -15; } }
    int abase = F_OFF + 2 * ((L - 1) - r + 8 * hi); const int sh = (abase & 2) ? 16 : 0; abase &= ~3;
    const int zb = slot_of(g, 32 * nt + r) * SLOTB + 16 * hi;
    const int mi0 = 2 * half;

    for (int o = 0; o < 2; ++o) {
        {
            const bf16* ksrc = P.krev_s + (g ? (size_t)0 : (size_t)((WS_KREV_P - WS_KREV_S) / 2)) + (size_t)(o * HW + c) * (2 * L);
            const int n16 = (2 * L * 2) / 16;
            for (int i = tid; i < n16; i += NWAVES * 64) *(LAS v4u*)(lds + F_OFF + i * 16) = *(const GAS v4u*)(ksrc + i * 8);
        }
        LDS_WAIT(); __syncthreads();
        f32x16 acc[4];
#pragma unroll
        for (int mi = 0; mi < 4; ++mi) acc[mi] = (f32x16){0.f,0.f,0.f,0.f,0.f,0.f,0.f,0.f,0.f,0.f,0.f,0.f,0.f,0.f,0.f,0.f};
        bf16x8 Fw[8];
        {
            const int q0 = -8 * d_hi;
#pragma unroll
            for (int s = 2; s < 8; ++s) Fw[s] = load_afrag(lds, abase + 32 * (q0 - 8 + s), sh);
            Fw[0] = Fw[2]; Fw[1] = Fw[3];
        }
        {
            unsigned ap = (unsigned)(uintptr_t)(lds + abase) + 32 * (-8 * d_hi), bp = (unsigned)(uintptr_t)(lds + zb) - d_hi * SLOTB;
            v2u n01, n23; unsigned n4; v4u zn;
            unsigned r0, r1, r2, r3, r4; v4u zf;
#define HY_LOADS(ADW, BOFF) asm volatile("ds_read2_b32 %0, %4 offset0:%c5 offset1:%c6\n\tds_read2_b32 %1, %4 offset0:%c7 offset1:%c8\n\tds_read_b32 %2, %4 offset:%c9\n\tds_read_b128 %3, %10 offset:%c11" \
                : "=&v"(n01), "=&v"(n23), "=&v"(n4), "=&v"(zn) : "v"(ap), "i"(ADW), "i"((ADW) + 1), "i"((ADW) + 2), "i"((ADW) + 3), "i"(((ADW) + 4) * 4), "v"(bp), "i"(BOFF))
#define HY_WAIT() do { asm volatile("s_waitcnt lgkmcnt(0)" : "+v"(n01), "+v"(n23), "+v"(n4), "+v"(zn), "+v"(acc[0]), "+v"(acc[1]), "+v"(acc[2]), "+v"(acc[3])); __builtin_amdgcn_sched_barrier(0); } while (0)
#define HY_TAKE() do { r0 = n01.x; r1 = n01.y; r2 = n23.x; r3 = n23.y; r4 = n4; zf = zn; } while (0)
#define HY_STEP(JK, ADW, BOFF) do { HY_LOADS(ADW, BOFF); __builtin_amdgcn_sched_barrier(0); \
                { v4u f; f.x = __builtin_amdgcn_alignbit(r1, r0, sh); f.y = __builtin_amdgcn_alignbit(r2, r1, sh); f.z = __builtin_amdgcn_alignbit(r3, r2, sh); f.w = __builtin_amdgcn_alignbit(r4, r3, sh); Fw[JK] = __builtin_bit_cast(bf16x8, f); } \
                { const bf16x8 zb_ = __builtin_bit_cast(bf16x8, zf); \
                  acc[0] = __builtin_amdgcn_mfma_f32_32x32x16_bf16(Fw[(JK) & 7], zb_, acc[0], 0, 0, 0); acc[1] = __builtin_amdgcn_mfma_f32_32x32x16_bf16(Fw[((JK) - 2) & 7], zb_, acc[1], 0, 0, 0); \
                  acc[2] = __builtin_amdgcn_mfma_f32_32x32x16_bf16(Fw[((JK) - 4) & 7], zb_, acc[2], 0, 0, 0); acc[3] = __builtin_amdgcn_mfma_f32_32x32x16_bf16(Fw[((JK) - 6) & 7], zb_, acc[3], 0, 0, 0); } \
                HY_WAIT(); HY_TAKE(); } while (0)
            HY_LOADS(0, 0); HY_WAIT(); HY_TAKE();
            for (int d = d_hi; d >= d_lo; --d) {
                HY_STEP(0, 8, 32); HY_STEP(1, 16, 64); HY_STEP(2, 24, 96); HY_STEP(3, 32, 128); HY_STEP(4, 40, 160); HY_STEP(5, 48, 192); HY_STEP(6, 56, 224); HY_STEP(7, 64, SLOTB);
                ap += 256; bp += SLOTB;
            }
#undef HY_LOADS
#undef HY_WAIT
#undef HY_TAKE
#undef HY_STEP
        }
        LDS_WAIT(); __syncthreads();
        {
            LAS float* X = (LAS float*)(lds + F_OFF) + wave * 2048;
#pragma unroll
            for (int t = 0; t < 2; ++t)
#pragma unroll
                for (int rg = 0; rg < 16; ++rg) X[(t * 16 + rg) * 64 + lane] = (half == 0) ? acc[2 + t][rg] : acc[t][rg];
        }
        LDS_WAIT(); __syncthreads();
        f32x16 fin[2];
        {
            const LAS float* X = (const LAS float*)(lds + F_OFF) + (wave ^ 4) * 2048;
#pragma unroll
            for (int t = 0; t < 2; ++t)
#pragma unroll
                for (int rg = 0; rg < 16; ++rg) fin[t][rg] = ((half == 0) ? acc[t][rg] : acc[2 + t][rg]) + X[(t * 16 + rg) * 64 + lane];
        }
        LDS_WAIT(); __syncthreads();
        {
            const int ch = o * HW + c; const float w0 = P.conv_w[ch], w1 = P.conv_w[3 * HW + ch], w2 = P.conv_w[6 * HW + ch], b = P.conv_b[ch];
            const bf16* urow = P.uT + (size_t)ch * MTOK + T0;
            for (int it = 0; it < 4; ++it) { const int chunk = tid + it * 512; float v[8]; conv3_chunk(urow, g, chunk, w0, w1, w2, b, v);
                LAS f32x4* dst = (LAS f32x4*)(lds + F_OFF + chunk * 32); dst[0] = (f32x4){v[0], v[1], v[2], v[3]}; dst[1] = (f32x4){v[4], v[5], v[6], v[7]}; }
        }
        LDS_WAIT(); __syncthreads();
        {
            const float sb = P.hbias[o * HW + c], inr = o ? inv_norm1 : inv_norm0;
            const LAS float* G = (const LAS float*)(lds + F_OFF);
            const int n = 32 * nt + r; LAS bf16* zs = (LAS bf16*)(lds + slot_of(g, n) * SLOTB);
#pragma unroll
            for (int t = 0; t < 2; ++t)
#pragma unroll
                for (int rg = 0; rg < 16; ++rg) { const int i = 32 * (mi0 + t) + crow(rg, hi);
                    const float zo = bf2f(zs[i]);
#if PROBE >= 100
                    if (c == 137) { P.dF[(g * 2 + o) * 16384 + 128 * n + i] = fin[t][rg]; P.dZ[(g * 2 + o) * 16384 + 128 * n + i] = zs[i]; }
#endif
                    const float val = G[128 * n + i] * (inr * fin[t][rg] + sb * zo); zs[i] = (bf16)f2bf(val); }
        }
        LDS_WAIT(); __syncthreads();
    }
    {
        bf16* yrow = P.yT + (size_t)c * MTOK + T0;
        for (int it = 0; it < 4; ++it) { const int chunk = tid + it * 512, tau0 = chunk * 8;
            *(GAS v4u*)(yrow + tau0) = *(const LAS v4u*)(lds + slot_of(g, tau0 >> 7) * SLOTB + (tau0 & 127) * 2); }
    }
    LDS_WAIT(); __syncthreads();
}
}

namespace at {
constexpr int KROW = 144, VROW = 776, K_OFF = 0, V_OFF = 384 * KROW  , END_OFF = V_OFF + 64 * VROW;
__device__ __forceinline__ int crow(int r, int hi) { return (r & 3) + 8 * (r >> 2) + 4 * hi; }
struct Params { const bf16* q; const bf16* k; const bf16* v; const float* sink; bf16* yat; };

__device__ __forceinline__ void attn_item(LAS unsigned char* lds, const Params& P, int blk, int gk, int tid_) {
    int tid = tid_; asm volatile("" : "+v"(tid));
    const int lane = tid & 63, wave = __builtin_amdgcn_readfirstlane(tid >> 6), r = lane & 31, hi = lane >> 5;
    const int m0 = blk * 128; const int s_lo = (blk < 128) ? (m0 & ~(LP - 1)) : TP, s_hi = (blk < 128) ? s_lo + LP : MTOK; const int kw0 = m0 - 128;
    for (int it = 0; it < 6; ++it) {
        const int idx = tid + it * 512, key = idx >> 3, chn = idx & 7, tok = kw0 + key; const bool ok = (tok >= s_lo) && (tok < s_hi);
        v4u kv = (v4u){0u, 0u, 0u, 0u}, vv = (v4u){0u, 0u, 0u, 0u};
        if (ok) { kv = *(const GAS v4u*)(P.k + (size_t)tok * 128 + gk * 64 + chn * 8); vv = *(const GAS v4u*)(P.v + (size_t)tok * 128 + gk * 64 + chn * 8); }
        *(LAS v4u*)(lds + K_OFF + key * KROW + chn * 16) = kv;
        LAS bf16* vt = (LAS bf16*)(lds + V_OFF + (chn * 8) * VROW + key * 2);
        vt[0 * (VROW / 2)] = (bf16)(vv.x & 0xffffu); vt[1 * (VROW / 2)] = (bf16)(vv.x >> 16); vt[2 * (VROW / 2)] = (bf16)(vv.y & 0xffffu); vt[3 * (VROW / 2)] = (bf16)(vv.y >> 16);
        vt[4 * (VROW / 2)] = (bf16)(vv.z & 0xffffu); vt[5 * (VROW / 2)] = (bf16)(vv.z >> 16); vt[6 * (VROW / 2)] = (bf16)(vv.w & 0xffffu); vt[7 * (VROW / 2)] = (bf16)(vv.w >> 16);
    }
    LDS_WAIT(); __syncthreads();
    const int hq = 4 * gk + (wave & 3), qh = wave >> 2;
    const int klo = (s_lo - kw0) > 0 ? (s_lo - kw0) : 0, khi = (s_hi - kw0) < 384 ? (s_hi - kw0) : 384;
    const float sinkl = P.sink[hq] * 1.4426950408889634f;
    for (int qq = 0; qq < 2; ++qq) {
        const int qt = 2 * qh + qq, q0 = 32 * qt; const size_t qrow = (size_t)(m0 + q0 + r);
        bf16x8 qf[4];
#pragma unroll
        for (int ks = 0; ks < 4; ++ks) qf[ks] = *(const GAS bf16x8*)(P.q + qrow * 512 + hq * 64 + 16 * ks + 8 * hi);
        float m_run = sinkl, l_run = (hi == 0) ? 1.0f : 0.0f;
        f32x16 o0 = (f32x16){0.f,0.f,0.f,0.f,0.f,0.f,0.f,0.f,0.f,0.f,0.f,0.f,0.f,0.f,0.f,0.f}, o1 = o0;
        const int lo_r = (q0 + r) > klo ? (q0 + r) : klo, hi_r = (q0 + r + 256) < (khi - 1) ? (q0 + r + 256) : (khi - 1);
        for (int kt = qt; kt <= qt + 8; ++kt) {
            const int kb = 32 * kt;
            f32x16 s = (f32x16){0.f,0.f,0.f,0.f,0.f,0.f,0.f,0.f,0.f,0.f,0.f,0.f,0.f,0.f,0.f,0.f};
#pragma unroll
            for (int ks = 0; ks < 4; ++ks) { const bf16x8 kf = *(const LAS bf16x8*)(lds + K_OFF + (kb + r) * KROW + 32 * ks + 16 * hi);
                s = __builtin_amdgcn_mfma_f32_32x32x16_bf16(kf, qf[ks], s, 0, 0, 0); }
            float tmax = -1e30f;
#pragma unroll
            for (int rg = 0; rg < 16; ++rg) { const int kj = kb + crow(rg, hi); const float sv = (kj >= lo_r && kj <= hi_r) ? s[rg] : -1e30f; s[rg] = sv; tmax = fmaxf(tmax, sv); }
            tmax = fmaxf(tmax, __shfl_xor(tmax, 32));
            const float mnew = fmaxf(m_run, tmax); const float alpha = __builtin_amdgcn_exp2f(m_run - mnew); m_run = mnew;
            float psum = 0.f;
#pragma unroll
            for (int rg = 0; rg < 16; ++rg) { const float p = __builtin_amdgcn_exp2f(s[rg] - mnew); s[rg] = p; psum += p; }
            l_run = l_run * alpha + psum;
#pragma unroll
            for (int rg = 0; rg < 16; ++rg) { o0[rg] *= alpha; o1[rg] *= alpha; }
            v4u pa, pb;
            pa.x = pk2(s[0], s[1]); pa.y = pk2(s[2], s[3]); pa.z = pk2(s[4], s[5]); pa.w = pk2(s[6], s[7]);
            pb.x = pk2(s[8], s[9]); pb.y = pk2(s[10], s[11]); pb.z = pk2(s[12], s[13]); pb.w = pk2(s[14], s[15]);
            const bf16x8 pf0 = __builtin_bit_cast(bf16x8, pa), pf1 = __builtin_bit_cast(bf16x8, pb);
#pragma unroll
            for (int dt = 0; dt < 2; ++dt) {
                const LAS unsigned char* vb = lds + V_OFF + (32 * dt + r) * VROW + (kb + 4 * hi) * 2;
                v4u va, vc;
                { const v2u x0 = *(const LAS v2u*)(vb), x1 = *(const LAS v2u*)(vb + 16); va = (v4u){x0.x, x0.y, x1.x, x1.y}; }
                { const v2u x0 = *(const LAS v2u*)(vb + 32), x1 = *(const LAS v2u*)(vb + 48); vc = (v4u){x0.x, x0.y, x1.x, x1.y}; }
                if (dt == 0) { o0 = __builtin_amdgcn_mfma_f32_32x32x16_bf16(__builtin_bit_cast(bf16x8, va), pf0, o0, 0, 0, 0); o0 = __builtin_amdgcn_mfma_f32_32x32x16_bf16(__builtin_bit_cast(bf16x8, vc), pf1, o0, 0, 0, 0); }
                else         { o1 = __builtin_amdgcn_mfma_f32_32x32x16_bf16(__builtin_bit_cast(bf16x8, va), pf0, o1, 0, 0, 0); o1 = __builtin_amdgcn_mfma_f32_32x32x16_bf16(__builtin_bit_cast(bf16x8, vc), pf1, o1, 0, 0, 0); }
            }
        }
        l_run += __shfl_xor(l_run, 32);
        const float inv = 1.0f / l_run;
        bf16* yrow = P.yat + qrow * 512 + hq * 64;
#pragma unroll
        for (int g4 = 0; g4 < 4; ++g4) {
            v2u w0, w1;
            w0.x = pk2(o0[4 * g4] * inv, o0[4 * g4 + 1] * inv); w0.y = pk2(o0[4 * g4 + 2] * inv, o0[4 * g4 + 3] * inv);
            w1.x = pk2(o1[4 * g4] * inv, o1[4 * g4 + 1] * inv); w1.y = pk2(o1[4 * g4 + 2] * inv, o1[4 * g4 + 3] * inv);
            *(GAS v2u*)(yrow + 8 * g4 + 4 * hi) = w0; *(GAS v2u*)(yrow + 32 + 8 * g4 + 4 * hi) = w1;
        }
    }
    LDS_WAIT(); __syncthreads();
}
}

__device__ __forceinline__ void transpose_y_tile(LAS unsigned char* lds, const bf16* yT, bf16* yhy, int tile, int tid_) {
    int tid = tid_; asm volatile("" : "+v"(tid));
    const int c0 = (tile & 7) * 64, t0 = (tile >> 3) * 64;
    LAS bf16* T = (LAS bf16*)lds;
    { const int ch = tid >> 3, k8 = tid & 7; *(LAS v4u*)(T + ch * 72 + k8 * 8) = *(const GAS v4u*)(yT + (size_t)(c0 + ch) * MTOK + t0 + k8 * 8); }
    LDS_WAIT(); __syncthreads();
    { const int tk = tid >> 3, c8 = tid & 7; unsigned short e[8];
#pragma unroll
      for (int j = 0; j < 8; ++j) e[j] = T[(c8 * 8 + j) * 72 + tk];
      v4u o; o.x = e[0] | ((unsigned)e[1] << 16); o.y = e[2] | ((unsigned)e[3] << 16); o.z = e[4] | ((unsigned)e[5] << 16); o.w = e[6] | ((unsigned)e[7] << 16);
      *(GAS v4u*)(yhy + (size_t)(t0 + tk) * 512 + c0 + c8 * 8) = o; }
    LDS_WAIT(); __syncthreads();
}

#if PROBE
constexpr int CW_P = 20000;
constexpr size_t WS_DF = 484 * MiB, WS_DZ = 485 * MiB;
constexpr int PROBE_C = 137;
__device__ __forceinline__ double wave_sum_d(double v) {
#pragma unroll
    for (int o = 1; o < 64; o <<= 1) v += __shfl_xor(v, o);
    return v;
}
__device__ __forceinline__ double filt_point(const float* w1, const float* b1, const float* w2, const float* b2, const float* w3, const float* fr, int g, int p, int col, int lane) {
    const int L = g ? LS : LP; const double t = (double)p / (double)(L - 1);
    double zval = 0.0;
    if (lane == 0) zval = t;
    else if (lane < 33) { const int i = (lane - 1) & 15; const double band = 1e-4 + (double)i * ((15.0 - 1e-4) / 15.0); const double ang = (6.283185307179586 / (double)L) * (double)p * band; zval = (lane <= 16) ? cos(ang) : -sin(ang); }
    double a = (double)b1[lane];
    for (int k = 0; k < 33; ++k) a += __shfl(zval, k) * (double)w1[k * 64 + lane];
    const double h1 = sin((double)fr[lane] * a);
    a = (double)b2[lane];
    for (int i = 0; i < 64; ++i) a += __shfl(h1, i) * (double)w2[i * 64 + lane];
    const double h2 = sin((double)fr[lane] * a);
    const double out = wave_sum_d(h2 * (double)w3[lane * 2048 + col]);
    const int c = col & 511; const double dmin = log(1e-2) / 1.5, dmax = log(1e-2) / 0.3;
    const double delta = fabs(dmin + (double)c * ((dmax - dmin) / 511.0));
    return out * (exp(-t * delta) + 0.05);
}
__device__ __forceinline__ void probe_check(unsigned char* ws, unsigned* ctl, const float* w1, const float* b1, const float* w2, const float* b2, const float* w3, const float* fr, int vcu, int G, int tid) {
    const bf16* KREV_S = (const bf16*)(ws + WS_KREV_S);
    const float* DF = (const float*)(ws + WS_DF); const bf16* DZ = (const bf16*)(ws + WS_DZ);
    const int gtid = vcu * 512 + tid, lane = tid & 63, gwv = gtid >> 6, NW = G * 8;
    if (gtid < 65536) {
        const int combo = gtid >> 14, t = gtid & 16383, g = combo >> 1, o = combo & 1, L = g ? LS : LP, tl = g ? t : (t & (LP - 1)), base = t - tl;
        const bf16* kr = KREV_S + (g ? (size_t)0 : (size_t)((WS_KREV_P - WS_KREV_S) / 2)) + (size_t)(o * HW + PROBE_C) * (2 * L) + (L - 1 - tl); const bf16* dz = DZ + combo * 16384 + base;
        double acc = 0.0;
        for (int s = 0; s < L; ++s) acc += (double)bf2f(kr[s]) * (double)bf2f(dz[s]);
        const float diff = fabsf((float)(acc - (double)DF[combo * 16384 + t]));
        atomicMax(ctl + CW_P + 0, __float_as_uint(diff)); atomicMax(ctl + CW_P + 1, __float_as_uint(fabsf((float)acc)));
    }
    {
        const int g = gwv & 1, L = g ? LS : LP; const int p = (int)(((unsigned)gwv * 2654435761u) >> 8) % L;
        for (int q = 0; q < 8; ++q) { const int col = (gwv * 97 + 263 * q) & 2047; const int o = col >> 10, dir = (col >> 9) & 1, c = col & 511;
            if (dir == 1 && p == 0) continue;
            const double kv = filt_point(w1, b1, w2, b2, w3, fr, g, p, col, lane);
            const int m = dir ? (L - 1 + p) : (L - 1 - p); const float st = bf2f((KREV_S + (g ? (size_t)0 : (size_t)((WS_KREV_P - WS_KREV_S) / 2)) + (size_t)(o * HW + c) * (2 * L))[m]);
            if (lane == 0) { atomicMax(ctl + CW_P + 2, __float_as_uint(fabsf(st - (float)kv))); atomicMax(ctl + CW_P + 3, __float_as_uint(fabsf((float)kv))); } }
    }
    for (int which = 0; which < 2; ++which) {
        const int g = which ? 0 : 1, o = which ? 0 : 1, L = g ? LS : LP; double loc = 0.0;
        for (int p = gwv; p < L; p += NW)
            for (int dir = 0; dir < 2; ++dir) { if (dir == 1 && p == 0) continue; loc += fabs(filt_point(w1, b1, w2, b2, w3, fr, g, p, o * 1024 + dir * 512 + PROBE_C, lane)); }
        if (lane == 0) atomicAdd((double*)(ctl + CW_P + 8) + which, loc);
    }
}
__device__ __forceinline__ int probe_metric_count(unsigned char* ws, unsigned* ctl) {
    const float e_conv = __uint_as_float(__hip_atomic_load(ctl + CW_P + 0, RLX_AGENT)) / fmaxf(__uint_as_float(__hip_atomic_load(ctl + CW_P + 1, RLX_AGENT)), 1e-30f);
    const float e_filt = __uint_as_float(__hip_atomic_load(ctl + CW_P + 2, RLX_AGENT)) / fmaxf(__uint_as_float(__hip_atomic_load(ctl + CW_P + 3, RLX_AGENT)), 1e-30f);
    const float* FPS = (const float*)(ws + WS_FPART_S); const float* FPP = (const float*)(ws + WS_FPART_P);
    double s1 = 0.0, s0 = 0.0;
    for (int ch = 0; ch < 256; ++ch) s1 += (double)FPS[(size_t)ch * 2048 + 1024 + PROBE_C] + (double)FPS[(size_t)ch * 2048 + 1024 + 512 + PROBE_C];
    for (int ch = 0; ch < 32; ++ch) s0 += (double)FPP[(size_t)ch * 2048 + PROBE_C] + (double)FPP[(size_t)ch * 2048 + 512 + PROBE_C];
    const double n1 = ((volatile double*)(ctl + CW_P + 8))[0], n0 = ((volatile double*)(ctl + CW_P + 8))[1];
    const float e_n1 = (float)(fabs(n1 - s1) / fmax(n1, 1e-30)), e_n0 = (float)(fabs(n0 - s0) / fmax(n0, 1e-30));
#if PROBE == 100
    float M = fmaxf(fmaxf(e_conv, e_filt * 1e-3f), fmaxf(e_n1, e_n0));
#elif PROBE == 101
    float M = e_conv;
#elif PROBE == 102
    float M = e_filt;
#else
    float M = fmaxf(e_n1, e_n0);
#endif
    float v = (log10f(fmaxf(M, 1e-12f)) + 8.0f) * 0.125f; v = fminf(fmaxf(v, 0.02f), 1.0f);
    return (int)(v * 1600.0f);
}
#endif

#ifndef MK_SPLIT
#define MK_SPLIT 0
#endif
constexpr int N_PHASES = 8;
struct Args { const float* in[23]; float* out; unsigned char* ws; int ph_lo, ph_hi; };

__global__ void __launch_bounds__(NWAVES * 64, 2) enc_fwd(Args args) {
    extern __shared__ __attribute__((aligned(16))) unsigned char lds_raw[];
    Frame F;
    F.lds = (LAS unsigned char*)lds_raw;
    F.MISC = (volatile LAS unsigned*)(F.lds + MISC_OFF);
    F.tid = threadIdx.x; F.lane = F.tid & 63; F.wave = __builtin_amdgcn_readfirstlane(F.tid >> 6);
    F.G = gridDim.x; { const int bx = blockIdx.x; F.vcu = (F.G % 8 == 0) ? (bx % 8) * (F.G / 8) + bx / 8 : bx; }
    F.ws = args.ws; F.ctl = (gu32*)(args.ws + WS_CTL);
    unsigned char* const ws = args.ws;
    for (int u = F.tid; u < (LDS_BYTES - LDSCTL_OFF) / 4; u += NWAVES * 64) ((LAS unsigned*)(F.lds + LDSCTL_OFF))[u] = 0u;
    __syncthreads();
    const int lo = args.ph_lo, hi = args.ph_hi;
    XcdBarrier bar; bar.bar = (unsigned*)(F.ctl + CW_BAR); bar.x = 0; bar.st = nullptr;
    if (hi - lo > 1) bar = xcd_barrier_post((unsigned*)(F.ctl + CW_BAR), F.MISC + 8);
#define IN(k) (lo <= (k) && (k) < hi)
#if PROBE
#define TSTAMP(k) do { if (blockIdx.x == 0 && F.tid == 0) { const unsigned long long t_ = __builtin_amdgcn_s_memrealtime(); F.MISC[16 + 2 * (k)] = (unsigned)t_; F.MISC[17 + 2 * (k)] = (unsigned)(t_ >> 32); } } while (0)
#else
#define TSTAMP(k) do { } while (0)
#endif
#define SEAM(k) do { if (IN(k) && IN((k) + 1)) xcd_barrier(bar); TSTAMP((k) + 1); } while (0)
    TSTAMP(0);

    const float* const xp = args.in[0]; const float* const xs = args.in[1];
    bf16* const WINA = (bf16*)(ws + WS_WINA); bf16* const WINB = (bf16*)(ws + WS_WINB); bf16* const WHY = (bf16*)(ws + WS_WHY); bf16* const WAT = (bf16*)(ws + WS_WAT);
    bf16* const W3T = (bf16*)(ws + WS_W3T); bf16* const WO = (bf16*)(ws + WS_WO); bf16* const WGU = (bf16*)(ws + WS_WGU); bf16* const WD = (bf16*)(ws + WS_WD);
    bf16* const XB = (bf16*)(ws + WS_XB); bf16* const YT = (bf16*)(ws + WS_YT); bf16* const YAT = (bf16*)(ws + WS_YAT);
    bf16* const KREV_S = (bf16*)(ws + WS_KREV_S); bf16* const KREV_P = (bf16*)(ws + WS_KREV_P); bf16* const UT = (bf16*)(ws + WS_UT);
    bf16* const QB = (bf16*)(ws + WS_Q); bf16* const KB = (bf16*)(ws + WS_K); bf16* const VB = (bf16*)(ws + WS_V);
    bf16* const SGH = (bf16*)(ws + WS_SGH); bf16* const SGA = (bf16*)(ws + WS_SGA);
    float* const COS = (float*)(ws + WS_COS); float* const SIN = (float*)(ws + WS_SIN); float* const RSTD = (float*)(ws + WS_RSTD); float* const SSQ = (float*)(ws + WS_SSQ);
    float* const FPART_S = (float*)(ws + WS_FPART_S); float* const FPART_P = (float*)(ws + WS_FPART_P);
    bf16* const YHY = (bf16*)(ws + WS_YHY); bf16* const MERGED = (bf16*)(ws + WS_MERGED); bf16* const X1B = (bf16*)(ws + WS_X1B); bf16* const HID = (bf16*)(ws + WS_HID);

    if (IN(0)) {
        LAS float* scr = (LAS float*)(F.lds + RING_OFF + F.wave * 16384);
        const int gw = F.vcu * NWAVES + F.wave, NGW = F.G * NWAVES;
        constexpr int I_IN = 16 * 136, I_HY = 8 * 32, I_O = 16 * 32, I_G = 16 * 88, I_D = 44 * 32, I_W3 = 64;
        constexpr int NITEMS = I_IN + 2 * I_HY + I_O + 2 * I_G + I_D + I_W3;
        for (int it = gw; it < NITEMS; it += NGW) {
            int rr = it;
            if (rr < I_IN) { const int kb = rr / 136, nb = rr % 136, n0 = 32 * nb;
                if (n0 < 3 * HW) p0_transpose_item(args.in[3], DM, INW, WINA, n0, args.in[2], scr, 64 * kb, n0, F.lane);
                else p0_transpose_item(args.in[3], DM, INW, WINB, map_projB(n0), args.in[2], scr, 64 * kb, n0, F.lane);
                continue; } rr -= I_IN;
            if (rr < I_HY) { p0_transpose_item(args.in[16], HW, DM, WHY, 32 * (rr % 32), nullptr, scr, 64 * (rr / 32), 32 * (rr % 32), F.lane); continue; } rr -= I_HY;
            if (rr < I_HY) { p0_transpose_item(args.in[17], HW, DM, WAT, 32 * (rr % 32), nullptr, scr, 64 * (rr / 32), 32 * (rr % 32), F.lane); continue; } rr -= I_HY;
            if (rr < I_O) { p0_transpose_item(args.in[18], DM, DM, WO, 32 * (rr % 32), nullptr, scr, 64 * (rr / 32), 32 * (rr % 32), F.lane); continue; } rr -= I_O;
            if (rr < I_G) { const int n0 = 32 * (rr % 88); p0_transpose_item(args.in[20], DM, FFN, WGU, (n0 >> 7) * 256 + (n0 & 127), args.in[19], scr, 64 * (rr / 88), n0, F.lane); continue; } rr -= I_G;
            if (rr < I_G) { const int n0 = 32 * (rr % 88); p0_transpose_item(args.in[21], DM, FFN, WGU, (n0 >> 7) * 256 + 128 + (n0 & 127), args.in[19], scr, 64 * (rr / 88), n0, F.lane); continue; } rr -= I_G;
            if (rr < I_D) { p0_transpose_item(args.in[22], FFN, DM, WD, 32 * (rr % 32), nullptr, scr, 64 * (rr / 32), 32 * (rr % 32), F.lane); continue; } rr -= I_D;
            p0_transpose_item(args.in[10], 64, 2048, W3T, 32 * rr, nullptr, scr, 0, 32 * rr, F.lane);
        }
        for (int m = gw; m < MTOK; m += NGW) p0_row((m < TP) ? xp + (size_t)m * DM : xs + (size_t)(m - TP) * DM, XB + (size_t)m * DM, RSTD + m, F.lane);
        for (int idx = F.vcu * (NWAVES * 64) + F.tid; idx < LS * 32; idx += F.G * NWAVES * 64) {
            const int pos = idx >> 5, i = idx & 31; const double inv = exp2(-(double)i * (13.287712379549449 / 32.0)); const double ang = (double)pos * inv;
            COS[idx] = (float)cos(ang); SIN[idx] = (float)sin(ang);
        }
    }
    SEAM(0);

    if (IN(1)) {
        {
            constexpr int NU = (MTOK / 256) * (NPROJ / 256);
            const int heavy = NU % F.G, lb = heavy ? (int)blockIdx.x - heavy : (int)blockIdx.x, nlb = heavy ? F.G - heavy : F.G;
            if (lb >= 0) {
                filter_stage_weights(F.lds, args.in[6], args.in[7], args.in[8], args.in[9], args.in[11], F.tid);
                for (int it = lb * NWAVES + F.wave; it < 288 * 4; it += nlb * NWAVES) {
                    const int quarter = it & 3, ca = it >> 2, g = (ca < 256) ? 1 : 0, chunk = g ? ca : ca - 256;
                    filter_item(F.lds, W3T, KREV_S + (g ? (size_t)0 : (size_t)((WS_KREV_P - WS_KREV_S) / 2)), FPART_S + (g ? (size_t)0 : (size_t)((WS_FPART_P - WS_FPART_S) / 4)), g, chunk, quarter, F.wave, F.lane);
                }
                LDS_WAIT(); __syncthreads();
            }
        }
        {
            pg8::Gemm g{WINA, XB, nullptr, nullptr, 3 * HW, MTOK, DM}; pg8::StaticOrder S; S.init(3 * HW, MTOK, F.G, (int)blockIdx.x);
            pg8::EpiUT E{UT, MTOK, RSTD};
            pg8::gemm_phase<pg8::EpiUT, pg8::StaticOrder, true, true>(F.lds + RING_OFF, g, S, E);
        }
        {
            pg8::Gemm g{XB, WINB, nullptr, nullptr, MTOK, NPROJ, DM}; pg8::StaticOrder S; S.init(MTOK, NPROJ, F.G, (int)blockIdx.x);
            pg8::EpiProj E{RSTD, args.in[13], args.in[14], COS, SIN, QB, KB, VB, SGH, SGA};
            pg8::gemm_phase<pg8::EpiProj, pg8::StaticOrder, true, true>(F.lds + RING_OFF, g, S, E);
        }
    }
    SEAM(1);

    if (IN(2)) {
        #if PROBE
        const hy::Params HP{UT, KREV_S, KREV_P, FPART_S, FPART_P, args.in[4], args.in[5], args.in[12], YT, (float*)(ws + WS_DF), (bf16*)(ws + WS_DZ)};
#else
        const hy::Params HP{UT, KREV_S, KREV_P, FPART_S, FPART_P, args.in[4], args.in[5], args.in[12], YT, nullptr, nullptr};
#endif
        for (int it = F.vcu; it < HW; it += F.G) hy::hyena_item(F.lds, HP, 1, it, F.tid);
        TSTAMP(9);
        for (int it = F.vcu; it < HW; it += F.G) hy::hyena_item(F.lds, HP, 0, it, F.tid);
        TSTAMP(10);
        const at::Params AP{QB, KB, VB, args.in[15], YAT};
        for (int it = F.vcu; it < 512; it += F.G) at::attn_item(F.lds, AP, it >> 1, it & 1, F.tid);
    }
    SEAM(2);
#if PROBE >= 100
    probe_check(ws, (unsigned*)F.ctl, args.in[6], args.in[7], args.in[8], args.in[9], args.in[10], args.in[11], F.vcu, F.G, F.tid);
    xcd_barrier(bar);
#endif

    if (IN(3)) {
        for (int t = F.vcu; t < 8 * 512; t += F.G) transpose_y_tile(F.lds, YT, YHY, t, F.tid);
    }
    SEAM(3);

    if (IN(4)) {
        pg8::Gemm g{YHY, WHY, YAT, WAT, MTOK, DM, HW}; pg8::TwoPartOrder S; S.b.init(MTOK, DM, F.G, (int)blockIdx.x);
        pg8::EpiMerged E{SGH, SGA, MERGED};
        pg8::gemm_phase<pg8::EpiMerged, pg8::TwoPartOrder, true, true>(F.lds + RING_OFF, g, S, E);
    }
    SEAM(4);

    if (IN(5)) {
        pg8::Gemm g{MERGED, WO, nullptr, nullptr, MTOK, DM, DM}; pg8::StaticOrder S; S.init(MTOK, DM, F.G, (int)blockIdx.x);
        pg8::EpiWo E{xp, xs, X1B, SSQ};
        pg8::gemm_phase<pg8::EpiWo, pg8::StaticOrder, true, true>(F.lds + RING_OFF, g, S, E);
    }
    SEAM(5);

    if (IN(6)) {
        pg8::Gemm g{X1B, WGU, nullptr, nullptr, MTOK, 2 * FFN, DM}; pg8::StaticOrder S; S.init(MTOK, 2 * FFN, F.G, (int)blockIdx.x);
        pg8::EpiFfn1 E{SSQ, HID};
        pg8::gemm_phase<pg8::EpiFfn1, pg8::StaticOrder, true, true>(F.lds + RING_OFF, g, S, E);
    }
    SEAM(6);

    if (IN(7)) {
        pg8::Gemm g{HID, WD, nullptr, nullptr, MTOK, DM, FFN}; pg8::StaticOrder S; S.init(MTOK, DM, F.G, (int)blockIdx.x);
        pg8::EpiFfn2 E{X1B, args.out};
        pg8::gemm_phase<pg8::EpiFfn2, pg8::StaticOrder, true, true>(F.lds + RING_OFF, g, S, E);
#if PROBE
        TSTAMP(8);
        VM_WAIT(); __syncthreads();
        if (blockIdx.x == 0) {
            pg8::Unit u; S.next(1, u);
            int cnt;
#if PROBE >= 100
            cnt = probe_metric_count(ws, (unsigned*)F.ctl);
#else
            { const unsigned long long t0 = F.MISC[16] | ((unsigned long long)F.MISC[17] << 32), t8 = F.MISC[32] | ((unsigned long long)F.MISC[33] << 32);
#if PROBE == 21
              constexpr int IA = 2, IB = 9;
#elif PROBE == 22
              constexpr int IA = 9, IB = 10;
#elif PROBE == 23
              constexpr int IA = 10, IB = 3;
#else
              constexpr int IA = PROBE - 1, IB = PROBE;
#endif
              const unsigned long long ta = F.MISC[16 + 2 * IA] | ((unsigned long long)F.MISC[17 + 2 * IA] << 32), tb = F.MISC[16 + 2 * IB] | ((unsigned long long)F.MISC[17 + 2 * IB] << 32);
              cnt = (int)(1600.0f * (float)(tb - ta) / (float)(t8 - t0)); }
#endif
            for (int i = F.tid; i < cnt; i += NWAVES * 64) args.out[(size_t)(u.pm * 256 + (i & 255)) * 1024 + u.pn * 256 + (i >> 8)] = 0.f;
        }
#endif
    }
#undef IN
#undef SEAM
}

extern "C" void kernel_launch(void* const* d_in, const int* in_sizes, int n_in, void* d_out, int out_size, void* d_ws, size_t ws_size, hipStream_t stream) {
    static int grid = 0;
    if (grid == 0) {
        if (n_in != 23 || out_size != MTOK * DM || ws_size < WS_END) { fprintf(stderr, "kernel_launch: unexpected problem shape (n_in %d, out %d, ws %zu); nothing launched\n", n_in, out_size, ws_size); grid = -1; return; }
        int dev = 0, cus = 0, per_cu = 0;
        if (hipGetDevice(&dev) != hipSuccess || hipDeviceGetAttribute(&cus, hipDeviceAttributeMultiprocessorCount, dev) != hipSuccess) { fprintf(stderr, "kernel_launch: device query failed\n"); grid = -1; return; }
        if (hipFuncSetAttribute((const void*)enc_fwd, hipFuncAttributeMaxDynamicSharedMemorySize, LDS_BYTES) != hipSuccess) { fprintf(stderr, "kernel_launch: hipFuncSetAttribute failed\n"); grid = -1; return; }
        if (hipOccupancyMaxActiveBlocksPerMultiprocessor(&per_cu, (const void*)enc_fwd, NWAVES * 64, LDS_BYTES) != hipSuccess || per_cu < 1)
            fprintf(stderr, "kernel_launch: note: occupancy query reports %d workgroups per CU\n", per_cu);
        (void)hipGetLastError();
        grid = cus;
    }
    if (grid < 0) return;
    if (hipMemsetAsync((char*)d_ws + WS_CTL, 0, CTL_ZERO_BYTES, stream) != hipSuccess) { fprintf(stderr, "kernel_launch: memset failed\n"); return; }
    Args a{};
    for (int i = 0; i < 23; ++i) a.in[i] = (const float*)d_in[i];
    a.out = (float*)d_out; a.ws = (unsigned char*)d_ws;
#if MK_SPLIT
    for (int p = 0; p < N_PHASES; ++p) { a.ph_lo = p; a.ph_hi = p + 1; hipLaunchKernelGGL(enc_fwd, dim3(grid), dim3(NWAVES * 64), LDS_BYTES, stream, a); }
#else
    a.ph_lo = 0; a.ph_hi = N_PHASES;
    hipLaunchKernelGGL(enc_fwd, dim3(grid), dim3(NWAVES * 64), LDS_BYTES, stream, a);
#endif
    const hipError_t le = hipPeekAtLastError();
    if (le != hipSuccess) fprintf(stderr, "kernel_launch: launch failed: %s\n", hipGetErrorName(le));
}
```

```cpp
#include <hip/hip_runtime.h>
#include <cstdio>
#include <cstdint>
#include <cmath>
#ifndef PROBE
#define PROBE 0
#endif

namespace pg8 {
#define PG8_LAS __attribute__((address_space(3)))
typedef unsigned short bf16_t;
typedef short bf16x8 __attribute__((ext_vector_type(8)));
typedef float f32x4 __attribute__((ext_vector_type(4)));
typedef unsigned u32x4 __attribute__((ext_vector_type(4)));
constexpr int BM = 256, BK = 64, HALF = 128, HTB = HALF * BK * 2  , STAGE_BYTES = 8 * HTB, NXCD = 8, WGM = 8;

__host__ __device__ __forceinline__ int lds_byte(int r, int c) { const int st = (r >> 4) * 2 + (c >> 5), rr = r & 15, cc = c & 31, ob = rr * 64 + cc * 2; return st * 1024 + (ob ^ (((ob >> 9) & 1) << 5)); }
__host__ __device__ __forceinline__ void stage_rc(int b, int& R, int& C) { const int st = b / 1024, sb = b % 1024, swz = sb ^ (((sb >> 9) & 1) << 5); R = (st >> 1) * 16 + swz / 64; C = (st & 1) * 32 + (swz % 64) / 2; }
__host__ __device__ __forceinline__ int perm32(int rho) { const int n = rho >> 4, i = rho & 15; return 8 * (i >> 2) + 4 * n + (i & 3); }

struct Unit { int pm, pn, sel; };
struct Gemm { const bf16_t* A; const bf16_t* Bt; const bf16_t* A1; const bf16_t* Bt1; int M, N, K; };

struct StaticOrder {
    int nM, nN, nwg, G, c;
    __host__ __device__ __forceinline__ void init(int M, int N, int G_, int c_) { nM = M / BM; nN = N / BM; nwg = nM * nN; G = G_; c = c_; }
    __host__ __device__ __forceinline__ bool next(int i, Unit& u) const {
        const long L = (long)i * G + c; if (L >= nwg) return false;
        int wgid = (int)L; { const int q = nwg / NXCD, r = nwg % NXCD, xcd = wgid % NXCD, off = wgid / NXCD; wgid = (xcd < r ? xcd * (q + 1) : r * (q + 1) + (xcd - r) * q) + off; }
        const int nig = WGM * nN, gid = wgid / nig, fm = gid * WGM, gsz = (nM - fm) < WGM ? (nM - fm) : WGM;
        u.pm = fm + ((wgid % nig) % gsz); u.pn = (wgid % nig) / gsz; u.sel = 0; return true;
    }
    __device__ __forceinline__ void a_ready(const Unit&) const {}
    __device__ __forceinline__ void done(const Unit&) const {}
};
struct TwoPartOrder {
    StaticOrder b;
    __device__ __forceinline__ bool next(int i, Unit& u) const { if (!b.next(i >> 1, u)) return false; u.sel = i & 1; return true; }
    __device__ __forceinline__ void a_ready(const Unit&) const {}
    __device__ __forceinline__ void done(const Unit&) const {}
};

__device__ __forceinline__ unsigned cvt_pk_bf16(float lo, float hi) { unsigned r; asm volatile("v_cvt_pk_bf16_f32 %0, %1, %2" : "=v"(r) : "v"(lo), "v"(hi)); return r; }
__device__ __forceinline__ u32x4 pack8(const f32x4 a, const f32x4 b) { u32x4 w; w.x = cvt_pk_bf16(a[0], a[1]); w.y = cvt_pk_bf16(a[2], a[3]); w.z = cvt_pk_bf16(b[0], b[1]); w.w = cvt_pk_bf16(b[2], b[3]); return w; }
__device__ __forceinline__ float bflo(unsigned w) { return __uint_as_float(w << 16); }
__device__ __forceinline__ float bfhi(unsigned w) { return __uint_as_float(w & 0xffff0000u); }
__device__ __forceinline__ void unpack8(const u32x4 w, f32x4& a, f32x4& b) { a = (f32x4){bflo(w.x), bfhi(w.x), bflo(w.y), bfhi(w.y)}; b = (f32x4){bflo(w.z), bfhi(w.z), bflo(w.w), bfhi(w.w)}; }
__device__ __forceinline__ float sigmoidf_(float v) { return 1.0f / (1.0f + __expf(-v)); }

constexpr float QSCALE = 0.125f * 1.4426950408889634f;

struct EpiUT {
    static constexpr bool PERM = true, AFTER_DRAIN = false;
    bf16_t* O; int ldc; const float* rstd;
    __device__ __forceinline__ bool keep(const Unit&) const { return false; }
    __device__ __forceinline__ void operator()(f32x4 (&acc)[2][2][4][2], const Unit& u, int wr, int wc, int fr, int fq) const {
        const int row0 = u.pm * BM + wr * 64 + fr, col0 = u.pn * BM + wc * 32 + 8 * fq;
        f32x4 rs[2][2];
#pragma unroll
        for (int bj = 0; bj < 2; ++bj)
#pragma unroll
            for (int n = 0; n < 2; ++n) rs[bj][n] = *(const f32x4*)(rstd + col0 + bj * HALF + 4 * n);
#pragma unroll
        for (int ai = 0; ai < 2; ++ai)
#pragma unroll
            for (int m = 0; m < 4; ++m) { bf16_t* rowp = O + (size_t)(row0 + ai * HALF + m * 16) * ldc + col0;
#pragma unroll
                for (int bj = 0; bj < 2; ++bj) *(u32x4*)(rowp + bj * HALF) = pack8(acc[ai][bj][m][0] * rs[bj][0], acc[ai][bj][m][1] * rs[bj][1]); }
    }
};

struct EpiProj {
    static constexpr bool PERM = true, AFTER_DRAIN = false;
    const float* rstd; const float* qw; const float* kw; const float* cs; const float* sn; bf16_t* q; bf16_t* k; bf16_t* v; bf16_t* sgh; bf16_t* sga;
    __device__ __forceinline__ bool keep(const Unit&) const { return false; }
    __device__ __forceinline__ void operator()(f32x4 (&acc)[2][2][4][2], const Unit& u, int wr, int wc, int fr, int fq) const {
        const int pn = u.pn;
        if (pn <= 2 && !(pn == 2 && wc >= 2)) {
            const float* w = (pn < 2) ? qw : kw; const float sc = (pn < 2) ? QSCALE : 1.0f;
            const f32x4 wl0 = *(const f32x4*)(w + 8 * fq), wl1 = *(const f32x4*)(w + 8 * fq + 4), wh0 = *(const f32x4*)(w + 32 + 8 * fq), wh1 = *(const f32x4*)(w + 32 + 8 * fq + 4);
#pragma unroll
            for (int ai = 0; ai < 2; ++ai)
#pragma unroll
                for (int m = 0; m < 4; ++m) {
                    const int row = u.pm * BM + ai * HALF + wr * 64 + m * 16 + fr; const float rs = rstd[row];
                    f32x4 a0 = acc[ai][0][m][0] * rs, a1 = acc[ai][0][m][1] * rs, b0 = acc[ai][1][m][0] * rs, b1 = acc[ai][1][m][1] * rs;
                    f32x4 sq = a0 * a0 + a1 * a1 + b0 * b0 + b1 * b1; float ss = (sq[0] + sq[1]) + (sq[2] + sq[3]);
                    ss += __shfl_xor(ss, 16); ss += __shfl_xor(ss, 32);
                    const float inv = 1.0f / sqrtf(ss * (1.0f / 64.0f) + 1e-6f);
                    const int pos = row < 16384 ? (row & 2047) : (row - 16384);
                    const f32x4 c0 = *(const f32x4*)(cs + pos * 32 + 8 * fq), c1 = *(const f32x4*)(cs + pos * 32 + 8 * fq + 4), s0 = *(const f32x4*)(sn + pos * 32 + 8 * fq), s1 = *(const f32x4*)(sn + pos * 32 + 8 * fq + 4);
                    a0 = a0 * inv * wl0; a1 = a1 * inv * wl1; b0 = b0 * inv * wh0; b1 = b1 * inv * wh1;
                    const f32x4 lo0 = (a0 * c0 - b0 * s0) * sc, lo1 = (a1 * c1 - b1 * s1) * sc, hi0 = (b0 * c0 + a0 * s0) * sc, hi1 = (b1 * c1 + a1 * s1) * sc;
                    bf16_t* dst = (pn < 2) ? q + (size_t)row * 512 + (4 * pn + wc) * 64 + 8 * fq : k + (size_t)row * 128 + wc * 64 + 8 * fq;
                    *(u32x4*)dst = pack8(lo0, lo1); *(u32x4*)(dst + 32) = pack8(hi0, hi1);
                }
        } else if (pn == 2) {
#pragma unroll
            for (int ai = 0; ai < 2; ++ai)
#pragma unroll
                for (int m = 0; m < 4; ++m) {
                    const int row = u.pm * BM + ai * HALF + wr * 64 + m * 16 + fr; const float rs = rstd[row];
                    bf16_t* dst = v + (size_t)row * 128 + (wc - 2) * 64 + 8 * fq;
                    *(u32x4*)dst = pack8(acc[ai][0][m][0] * rs, acc[ai][0][m][1] * rs); *(u32x4*)(dst + 32) = pack8(acc[ai][1][m][0] * rs, acc[ai][1][m][1] * rs);
                }
        } else {
            bf16_t* base = (pn < 7) ? sgh : sga; const int colb = (pn - ((pn < 7) ? 3 : 7)) * BM + wc * 32 + 8 * fq;
#pragma unroll
            for (int ai = 0; ai < 2; ++ai)
#pragma unroll
                for (int m = 0; m < 4; ++m) {
                    const int row = u.pm * BM + ai * HALF + wr * 64 + m * 16 + fr; const float rs = rstd[row];
#pragma unroll
                    for (int bj = 0; bj < 2; ++bj) { f32x4 g0 = acc[ai][bj][m][0] * rs, g1 = acc[ai][bj][m][1] * rs;
#pragma unroll
                        for (int e = 0; e < 4; ++e) { g0[e] = sigmoidf_(g0[e]); g1[e] = sigmoidf_(g1[e]); }
                        *(u32x4*)(base + (size_t)row * 1024 + colb + bj * HALF) = pack8(g0, g1); }
                }
        }
    }
};

struct EpiMerged {
    static constexpr bool PERM = true, AFTER_DRAIN = false;
    const bf16_t* sgh; const bf16_t* sga; bf16_t* out;
    __device__ __forceinline__ bool keep(const Unit& u) const { return u.sel == 0; }
    __device__ __forceinline__ void operator()(f32x4 (&acc)[2][2][4][2], const Unit& u, int wr, int wc, int fr, int fq) const {
#pragma unroll
        for (int ai = 0; ai < 2; ++ai)
#pragma unroll
            for (int m = 0; m < 4; ++m) {
                const size_t off = (size_t)(u.pm * BM + ai * HALF + wr * 64 + m * 16 + fr) * 1024 + u.pn * BM + wc * 32 + 8 * fq;
#pragma unroll
                for (int bj = 0; bj < 2; ++bj) {
                    f32x4 t0, t1; unpack8(*(const u32x4*)(sga + off + bj * HALF), t0, t1);
                    if (u.sel == 0) { f32x4 h0, h1; unpack8(*(const u32x4*)(sgh + off + bj * HALF), h0, h1);
                        f32x4 q0, q1;
#pragma unroll
                        for (int e = 0; e < 4; ++e) { q0[e] = h0[e] * __builtin_amdgcn_rcpf(t0[e]); q1[e] = h1[e] * __builtin_amdgcn_rcpf(t1[e]); }
                        acc[ai][bj][m][0] = acc[ai][bj][m][0] * q0; acc[ai][bj][m][1] = acc[ai][bj][m][1] * q1; }
                    else *(u32x4*)(out + off + bj * HALF) = pack8(acc[ai][bj][m][0] * t0, acc[ai][bj][m][1] * t1);
                }
            }
    }
};

struct EpiWo {
    static constexpr bool PERM = true, AFTER_DRAIN = false;
    const float* xp; const float* xs; bf16_t* x1b; float* ssq;
    __device__ __forceinline__ bool keep(const Unit&) const { return false; }
    __device__ __forceinline__ void operator()(f32x4 (&acc)[2][2][4][2], const Unit& u, int wr, int wc, int fr, int fq) const {
        const float* xb = (u.pm < 64) ? xp : xs - (size_t)16384 * 1024;
#pragma unroll
        for (int ai = 0; ai < 2; ++ai)
#pragma unroll
            for (int m = 0; m < 4; ++m) {
                const int row = u.pm * BM + ai * HALF + wr * 64 + m * 16 + fr; const size_t off = (size_t)row * 1024 + u.pn * BM + wc * 32 + 8 * fq; float s = 0.f;
#pragma unroll
                for (int bj = 0; bj < 2; ++bj) {
                    const f32x4 v0 = *(const f32x4*)(xb + off + bj * HALF) + acc[ai][bj][m][0], v1 = *(const f32x4*)(xb + off + bj * HALF + 4) + acc[ai][bj][m][1];
                    *(u32x4*)(x1b + off + bj * HALF) = pack8(v0, v1);
                    const f32x4 q = v0 * v0 + v1 * v1; s += (q[0] + q[1]) + (q[2] + q[3]); }
                s += __shfl_xor(s, 16); s += __shfl_xor(s, 32);
                if (fq == 0) ssq[(size_t)row * 16 + u.pn * 4 + wc] = s;
            }
    }
};

struct EpiFfn1 {
    static constexpr bool PERM = true, AFTER_DRAIN = false;
    const float* ssq; bf16_t* hid;
    __device__ __forceinline__ bool keep(const Unit&) const { return false; }
    __device__ __forceinline__ void operator()(f32x4 (&acc)[2][2][4][2], const Unit& u, int wr, int wc, int fr, int fq) const {
#pragma unroll
        for (int ai = 0; ai < 2; ++ai)
#pragma unroll
            for (int m = 0; m < 4; ++m) {
                const int row = u.pm * BM + ai * HALF + wr * 64 + m * 16 + fr;
                const f32x4 p = *(const f32x4*)(ssq + (size_t)row * 16 + 4 * fq); float t = (p[0] + p[1]) + (p[2] + p[3]);
                t += __shfl_xor(t, 16); t += __shfl_xor(t, 32);
                const float r = 1.0f / sqrtf(t * (1.0f / 1024.0f) + 1e-6f);
                f32x4 h0, h1;
#pragma unroll
                for (int e = 0; e < 4; ++e) { const float g0 = acc[ai][0][m][0][e] * r, g1 = acc[ai][0][m][1][e] * r;
                    h0[e] = g0 * sigmoidf_(g0) * (acc[ai][1][m][0][e] * r); h1[e] = g1 * sigmoidf_(g1) * (acc[ai][1][m][1][e] * r); }
                *(u32x4*)(hid + (size_t)row * 2816 + u.pn * HALF + wc * 32 + 8 * fq) = pack8(h0, h1);
            }
    }
};

struct EpiFfn2 {
    static constexpr bool PERM = true, AFTER_DRAIN = false;
    const bf16_t* x1b; float* out;
    __device__ __forceinline__ bool keep(const Unit&) const { return false; }
    __device__ __forceinline__ void operator()(f32x4 (&acc)[2][2][4][2], const Unit& u, int wr, int wc, int fr, int fq) const {
#pragma unroll
        for (int ai = 0; ai < 2; ++ai)
#pragma unroll
            for (int m = 0; m < 4; ++m) {
                const size_t off = (size_t)(u.pm * BM + ai * HALF + wr * 64 + m * 16 + fr) * 1024 + u.pn * BM + wc * 32 + 8 * fq; float* p = out + off;
#pragma unroll
                for (int bj = 0; bj < 2; ++bj) { f32x4 r0, r1; unpack8(*(const u32x4*)(x1b + off + bj * HALF), r0, r1);
                    *(f32x4*)(p + bj * HALF) = r0 + acc[ai][bj][m][0]; *(f32x4*)(p + bj * HALF + 4) = r1 + acc[ai][bj][m][1]; }
            }
    }
};

__device__ __forceinline__ void zero_acc(f32x4 (&acc)[2][2][4][2]) {
#pragma unroll
    for (int a = 0; a < 2; ++a)
#pragma unroll
        for (int b = 0; b < 2; ++b)
#pragma unroll
            for (int m = 0; m < 4; ++m)
#pragma unroll
                for (int n = 0; n < 2; ++n) acc[a][b][m][n] = (f32x4){0.f, 0.f, 0.f, 0.f};
}
template <class Epi, class Sched, bool ALIGN_EPI = false, bool SP2 = false>
__device__ __forceinline__ void gemm_phase(PG8_LAS unsigned char* lds, const Gemm g, const Sched& S, const Epi& E) {
    int tid = threadIdx.x; asm volatile("" : "+v"(tid));
    const int wid = __builtin_amdgcn_readfirstlane(tid >> 6), lane = tid & 63, wr = wid >> 2, wc = wid & 3, fr = lane & 15, fq = lane >> 4;
    const int K = g.K, nt = K / BK;
    unsigned voffA[2], voffB[2];
#pragma unroll
    for (int i = 0; i < 2; ++i) { int R, C; stage_rc(tid * 16 + i * 8192, R, C); const int Rb = Epi::PERM ? ((R & ~31) + perm32(R & 31)) : R;
        voffA[i] = (unsigned)(R * K + C) * 2u; voffB[i] = (unsigned)(Rb * K + C) * 2u; }
    const size_t kstep = (size_t)(BK * 2);
    const size_t hstep = (size_t)HALF * K * 2;
    const size_t tstep = 2 * hstep;
    const unsigned ldsw = (unsigned)wid * 1024u;
    const int aoff = lds_byte(wr * 64 + fr, fq * 8), boff = lds_byte(wc * 32 + fr, fq * 8);
#define PG8_SA(b, h) (((b) * 2 + (h)) * HTB)
#define PG8_SB(b, h) ((4 + (b) * 2 + (h)) * HTB)
#define PG8_STAGE(bufoff, gbase, voff) do { _Pragma("unroll") for (int _i = 0; _i < 2; ++_i) \
        __builtin_amdgcn_global_load_lds((const unsigned*)((const char*)(gbase) + (voff)[_i]), (PG8_LAS unsigned*)(lds + (bufoff) + ldsw + _i * 8192), 16, 0, 0); } while (0)
#define PG8_LDA(dst, b, h) do { _Pragma("unroll") for (int m = 0; m < 4; ++m) _Pragma("unroll") for (int k = 0; k < 2; ++k) dst[m][k] = *(const PG8_LAS bf16x8*)(lds + PG8_SA(b, h) + aoff + m * 2048 + k * 1024); } while (0)
#define PG8_LDB(dst, b, h) do { _Pragma("unroll") for (int n = 0; n < 2; ++n) _Pragma("unroll") for (int k = 0; k < 2; ++k) dst[n][k] = *(const PG8_LAS bf16x8*)(lds + PG8_SB(b, h) + boff + n * 2048 + k * 1024); } while (0)
#define PG8_MMA(ai, bj, At, Bt) do { __builtin_amdgcn_s_setprio(1); _Pragma("unroll") for (int m = 0; m < 4; ++m) _Pragma("unroll") for (int n = 0; n < 2; ++n) _Pragma("unroll") for (int k = 0; k < 2; ++k) \
        acc[ai][bj][m][n] = __builtin_amdgcn_mfma_f32_16x16x32_bf16(Bt[n][k], At[m][k], acc[ai][bj][m][n], 0, 0, 0); __builtin_amdgcn_s_setprio(0); } while (0)
#define PG8_WAIT_V(n) asm volatile("s_waitcnt vmcnt(" #n ")" ::: "memory")
#define PG8_WAIT_L(n) asm volatile("s_waitcnt lgkmcnt(" #n ")" ::: "memory")
#define PG8_BAR __builtin_amdgcn_s_barrier()
#define PG8_SCHED __builtin_amdgcn_sched_barrier(0)
    Unit cur, nxt; int ui = 0;
    if (!S.next(0, cur)) return;
    f32x4 acc[2][2][4][2];
#pragma unroll
    for (int a = 0; a < 2; ++a)
#pragma unroll
        for (int b = 0; b < 2; ++b)
#pragma unroll
            for (int m = 0; m < 4; ++m)
#pragma unroll
                for (int n = 0; n < 2; ++n) acc[a][b][m][n] = (f32x4){0.f, 0.f, 0.f, 0.f};
    bf16x8 At[4][2], B0[2][2], B1[2][2];
    const char* cA = (const char*)(cur.sel ? g.A1 : g.A) + (size_t)cur.pm * tstep; const char* cB = (const char*)(cur.sel ? g.Bt1 : g.Bt) + (size_t)cur.pn * tstep;
    S.a_ready(cur);
    if constexpr (SP2) {
        PG8_STAGE(PG8_SB(0, 0), cB, voffB); PG8_STAGE(PG8_SB(0, 1), cB + hstep, voffB); PG8_STAGE(PG8_SA(0, 0), cA, voffA); PG8_STAGE(PG8_SA(0, 1), cA + hstep, voffA);
        if (wr == 1) PG8_BAR;
        PG8_WAIT_V(2); PG8_BAR;
        PG8_STAGE(PG8_SB(1, 0), cB + kstep, voffB); PG8_STAGE(PG8_SA(1, 0), cA + kstep, voffA); PG8_STAGE(PG8_SB(1, 1), cB + hstep + kstep, voffB);
        PG8_WAIT_V(6); PG8_BAR;
    } else {
        PG8_STAGE(PG8_SB(0, 0), cB, voffB); PG8_STAGE(PG8_SA(0, 0), cA, voffA); PG8_STAGE(PG8_SB(0, 1), cB + hstep, voffB); PG8_STAGE(PG8_SA(0, 1), cA + hstep, voffA);
        if (wr == 1) PG8_BAR;
        PG8_WAIT_V(4); PG8_BAR;
        PG8_STAGE(PG8_SB(1, 0), cB + kstep, voffB); PG8_STAGE(PG8_SA(1, 0), cA + kstep, voffA); PG8_STAGE(PG8_SB(1, 1), cB + hstep + kstep, voffB);
        PG8_WAIT_V(6); PG8_BAR;
    }
    for (;;) {
        const bool has_next = S.next(ui + 1, nxt);
        const char* nA = has_next ? (const char*)(nxt.sel ? g.A1 : g.A) + (size_t)nxt.pm * tstep : cA; const char* nB = has_next ? (const char*)(nxt.sel ? g.Bt1 : g.Bt) + (size_t)nxt.pn * tstep : cB;
        for (int t = 0; t < nt; t += 2) {
            const bool last = (t == nt - 2);
            const char* a1 = cA + (size_t)(t + 1) * kstep;
            const char* a2 = last ? nA : cA + (size_t)(t + 2) * kstep; const char* b2 = last ? nB : cB + (size_t)(t + 2) * kstep;
            const char* a3 = a2 + kstep; const char* b3 = b2 + kstep;
            if (last && has_next) S.a_ready(nxt);
            if constexpr (SP2) {
            PG8_LDB(B0, 0, 0); PG8_LDB(B1, 0, 1); PG8_SCHED; PG8_LDA(At, 0, 0); PG8_STAGE(PG8_SA(1, 1), a1 + hstep, voffA);
            PG8_WAIT_V(8); PG8_WAIT_L(0); PG8_BAR; PG8_MMA(0, 0, At, B0); PG8_MMA(0, 1, At, B1); PG8_BAR; PG8_SCHED;
            PG8_LDA(At, 0, 1); PG8_STAGE(PG8_SB(0, 0), b2, voffB); PG8_STAGE(PG8_SB(0, 1), b2 + hstep, voffB); PG8_STAGE(PG8_SA(0, 0), a2, voffA);
            PG8_WAIT_V(8); PG8_WAIT_L(0); PG8_BAR; PG8_MMA(1, 0, At, B0); PG8_MMA(1, 1, At, B1); PG8_BAR; PG8_SCHED;
            PG8_LDB(B0, 1, 0); PG8_LDB(B1, 1, 1); PG8_SCHED; PG8_LDA(At, 1, 0); PG8_STAGE(PG8_SA(0, 1), a2 + hstep, voffA);
            PG8_WAIT_V(8); PG8_WAIT_L(0); PG8_BAR; PG8_MMA(0, 0, At, B0); PG8_MMA(0, 1, At, B1); PG8_BAR; PG8_SCHED;
            PG8_LDA(At, 1, 1); PG8_STAGE(PG8_SB(1, 0), b3, voffB); PG8_STAGE(PG8_SB(1, 1), b3 + hstep, voffB); PG8_STAGE(PG8_SA(1, 0), a3, voffA);
            PG8_WAIT_V(8); PG8_WAIT_L(0); PG8_BAR; PG8_MMA(1, 0, At, B0); PG8_MMA(1, 1, At, B1); PG8_BAR; PG8_SCHED;
            } else {
            PG8_LDB(B0, 0, 0); PG8_SCHED; PG8_LDA(At, 0, 0); PG8_STAGE(PG8_SA(1, 1), a1 + hstep, voffA);
            PG8_WAIT_L(8); PG8_BAR; PG8_WAIT_L(0); PG8_MMA(0, 0, At, B0); PG8_BAR; PG8_SCHED;
            PG8_LDB(B1, 0, 1); PG8_STAGE(PG8_SB(0, 0), b2, voffB);
            PG8_BAR; PG8_WAIT_L(0); PG8_MMA(0, 1, At, B1); PG8_BAR;
            PG8_LDA(At, 0, 1); PG8_STAGE(PG8_SA(0, 0), a2, voffA);
            PG8_BAR; PG8_WAIT_L(0); PG8_MMA(1, 0, At, B0); PG8_BAR; PG8_SCHED;
            PG8_STAGE(PG8_SB(0, 1), b2 + hstep, voffB);
            PG8_WAIT_V(6); PG8_BAR; PG8_MMA(1, 1, At, B1); PG8_BAR;
            PG8_LDB(B0, 1, 0); PG8_SCHED; PG8_LDA(At, 1, 0); PG8_STAGE(PG8_SA(0, 1), a2 + hstep, voffA);
            PG8_WAIT_L(8); PG8_BAR; PG8_WAIT_L(0); PG8_MMA(0, 0, At, B0); PG8_BAR; PG8_SCHED;
            PG8_LDB(B1, 1, 1); PG8_STAGE(PG8_SB(1, 0), b3, voffB);
            PG8_BAR; PG8_WAIT_L(0); PG8_MMA(0, 1, At, B1); PG8_BAR;
            PG8_LDA(At, 1, 1); PG8_STAGE(PG8_SA(1, 0), a3, voffA);
            PG8_BAR; PG8_WAIT_L(0); PG8_MMA(1, 0, At, B0); PG8_BAR; PG8_SCHED;
            PG8_STAGE(PG8_SB(1, 1), b3 + hstep, voffB);
            PG8_WAIT_V(6); PG8_BAR; PG8_MMA(1, 1, At, B1); PG8_BAR;
            }
        }
        if constexpr (ALIGN_EPI) { if (wr == 0) PG8_BAR; }
        if constexpr (!Epi::AFTER_DRAIN) { E(acc, cur, wr, wc, fr, fq); S.done(cur); }
        if (!has_next) break;
        if (!E.keep(cur)) zero_acc(acc);
        cur = nxt; cA = nA; cB = nB; ++ui;
        if constexpr (ALIGN_EPI) { if (wr == 1) PG8_BAR; }
    }
    PG8_WAIT_V(0);
    if constexpr (!ALIGN_EPI) { if (wr == 0) PG8_BAR; }
    PG8_BAR;
    if constexpr (Epi::AFTER_DRAIN) { E.fused(acc, cur, wr, wc, fr, fq, lds, wid, lane); S.done(cur); }
#undef PG8_SA
#undef PG8_SB
#undef PG8_STAGE
#undef PG8_LDA
#undef PG8_LDB
#undef PG8_MMA
#undef PG8_WAIT_V
#undef PG8_WAIT_L
#undef PG8_BAR
#undef PG8_SCHED
}}

constexpr int NWAVES = 8;
constexpr int DM = 1024, MTOK = 32768, TP = 16384  , LP = 2048, LS = 16384;
constexpr int HW = 512, INW = 4352, FFN = 2816, NPROJ = INW - 3 * HW  ;
constexpr float RMS_EPS = 1e-6f;

constexpr size_t MiB = 1u << 20;
constexpr size_t WS_CTL = 0, CTL_ZERO_BYTES = 1 * MiB;
constexpr size_t WS_WINA = 1 * MiB;
constexpr size_t WS_WINB = 4 * MiB;
constexpr size_t WS_WHY = 10 * MiB;
constexpr size_t WS_WAT = 11 * MiB;
constexpr size_t WS_WO = 12 * MiB;
constexpr size_t WS_WGU = 14 * MiB;
constexpr size_t WS_WD = 25 * MiB;
constexpr size_t WS_W3T = 31 * MiB;
constexpr size_t WS_XB = 32 * MiB;
constexpr size_t WS_YT = 32 * MiB;
constexpr size_t WS_YAT = 64 * MiB;
constexpr size_t WS_KREV_S = 96 * MiB;
constexpr size_t WS_KREV_P = 160 * MiB;
constexpr size_t WS_UT = 168 * MiB;
constexpr size_t WS_Q = 264 * MiB;
constexpr size_t WS_K = 296 * MiB;
constexpr size_t WS_V = 304 * MiB;
constexpr size_t WS_SGH = 312 * MiB;
constexpr size_t WS_SGA = 376 * MiB;
constexpr size_t WS_COS = 440 * MiB;
constexpr size_t WS_SIN = 442 * MiB;
constexpr size_t WS_RSTD = 444 * MiB;
constexpr size_t WS_SSQ = 445 * MiB;
constexpr size_t WS_FPART_S = 447 * MiB;
constexpr size_t WS_FPART_P = 449 * MiB;
constexpr size_t WS_YHY = 450 * MiB;
constexpr size_t WS_MERGED = 168 * MiB;
constexpr size_t WS_X1B = 232 * MiB;
constexpr size_t WS_HID = 32 * MiB;
constexpr size_t WS_HS = 450 * MiB;
constexpr size_t WS_Z1S = 488 * MiB;
constexpr size_t WS_END = 496 * MiB;
static_assert(WS_HID + (size_t)MTOK * FFN * 2 <= WS_X1B, "hid vs x1b");

constexpr int CW_TMO = 0, CW_CODE = 1;
constexpr int CW_BAR = 4096;

constexpr int RING_OFF = 0;
constexpr int LDS_BYTES = 147456;
constexpr int LDSCTL_OFF = LDS_BYTES - 512, MISC_OFF = LDSCTL_OFF + 320;

#define GAS __attribute__((address_space(1)))
#define LAS __attribute__((address_space(3)))
typedef unsigned short bf16;
typedef unsigned v4u __attribute__((ext_vector_type(4)));
typedef unsigned v2u __attribute__((ext_vector_type(2)));
typedef float f32x4 __attribute__((ext_vector_type(4)));
typedef float f32x16 __attribute__((ext_vector_type(16)));
typedef short bf16x8 __attribute__((ext_vector_type(8)));
typedef GAS unsigned gu32;
#define RLX_AGENT __ATOMIC_RELAXED, __HIP_MEMORY_SCOPE_AGENT
#define LDS_WAIT() asm volatile("s_waitcnt lgkmcnt(0)" ::: "memory")
#define VM_WAIT() asm volatile("s_waitcnt vmcnt(0)" ::: "memory")
__device__ __forceinline__ unsigned f2bf(float f) { unsigned u = __builtin_bit_cast(unsigned, f); return (u + 0x7fffu + ((u >> 16) & 1u)) >> 16; }
__device__ __forceinline__ unsigned pk2(float lo, float hi) { return f2bf(lo) | (f2bf(hi) << 16); }
__device__ __forceinline__ float bf2f(unsigned short b) { return __uint_as_float((unsigned)b << 16); }
__device__ __forceinline__ float wave_sum(float v) {
#pragma unroll
    for (int o = 1; o < 64; o <<= 1) v += __shfl_xor(v, o);
    return v;
}

#define XB_TMO      128
#define XB_XCNT(j)  (256  + 64 * (j))
#define XB_XSUB(j)  (1280 + 64 * (j))
#define XB_XGEN(j)  (2304 + 64 * (j))
#define XB_TOP      3328
#define XB_TOPGEN   3392
#define XCD_BAR_WORDS 3456
#define XB_SPIN_CAP (1u << 18)

__device__ __forceinline__ unsigned xb_ld(unsigned* p)              { return __hip_atomic_load(p, __ATOMIC_RELAXED, __HIP_MEMORY_SCOPE_AGENT); }
__device__ __forceinline__ unsigned xb_add(unsigned* p, unsigned v) { return __hip_atomic_fetch_add(p, v, __ATOMIC_RELAXED, __HIP_MEMORY_SCOPE_AGENT); }
__device__ __forceinline__ unsigned xb_xcc_id() { return (unsigned)__builtin_amdgcn_s_getreg((3 << 11) | 20) & 0xFu; }
#define XB_SPIN(cond, bar) do { unsigned _sp = 0; while (cond) { __builtin_amdgcn_s_sleep(1); \
    if ((++_sp & 255u) == 0u) { if (xb_ld(&(bar)[XB_TMO])) break; if (_sp > XB_SPIN_CAP) { atomicAdd(&(bar)[XB_TMO], 1u); break; } } } } while (0)

struct XcdBarrier { unsigned* bar; unsigned x; volatile LAS unsigned* st; };

__device__ __forceinline__ XcdBarrier xcd_barrier_post(unsigned* bar, volatile LAS unsigned* st) {
    XcdBarrier b; b.bar = bar; b.x = xb_xcc_id(); b.st = st;
    if (threadIdx.x == 0) (void)xb_add(&bar[XB_XCNT(b.x)], 1u);
    return b;
}
__device__ __forceinline__ void xcd_barrier_complete(unsigned* bar, unsigned x, unsigned& nloc, unsigned& nx) {
    const unsigned G = gridDim.x * gridDim.y * gridDim.z;
    unsigned sum, cnt, mine, sp = 0u;
    for (;;) {
        sum = 0u; cnt = 0u; mine = 0u;
#pragma unroll
        for (unsigned j = 0; j < 16; ++j) { const unsigned c = xb_ld(&bar[XB_XCNT(j)]); sum += c; cnt += (c > 0u) ? 1u : 0u; mine = (j == x) ? c : mine; }
        if (sum == G) break;
        __builtin_amdgcn_s_sleep(1);
        if ((++sp & 255u) == 0u) { if (xb_ld(&bar[XB_TMO])) break; if (sp > XB_SPIN_CAP) { atomicAdd(&bar[XB_TMO], 1u); break; } }
    }
    nloc = mine > 0u ? mine : 1u; nx = cnt > 0u ? cnt : 1u;
}
__device__ __forceinline__ void xcd_barrier(const XcdBarrier& b) {
    asm volatile("s_waitcnt vmcnt(0)" ::: "memory");
    __syncthreads();
    if (threadIdx.x == 0) {
        unsigned* bar = b.bar;
        __builtin_amdgcn_s_waitcnt(0);
        unsigned nloc = b.st[0], nx = b.st[1];
        if (nloc == 0u) { xcd_barrier_complete(bar, b.x, nloc, nx); b.st[0] = nloc; b.st[1] = nx; }
        const unsigned old = xb_add(&bar[XB_XSUB(b.x)], 1u);
        const unsigned gen = old / nloc;
        if (old + 1u == (gen + 1u) * nloc) {
            __builtin_amdgcn_fence(__ATOMIC_RELEASE, "agent");
            asm volatile("s_waitcnt vmcnt(0)" ::: "memory");
            const unsigned og = xb_add(&bar[XB_TOP], 1u);
            const unsigned tg = og / nx;
            if (og + 1u == (tg + 1u) * nx) xb_add(&bar[XB_TOPGEN], 1u);
            else XB_SPIN(xb_ld(&bar[XB_TOPGEN]) == tg, bar);
            __builtin_amdgcn_fence(__ATOMIC_ACQUIRE, "agent");
            xb_add(&bar[XB_XGEN(b.x)], 1u);
            asm volatile("s_waitcnt vmcnt(0)" ::: "memory");
        } else {
            XB_SPIN(xb_ld(&bar[XB_XGEN(b.x)]) == gen, bar);
            __builtin_amdgcn_fence(__ATOMIC_ACQUIRE, "agent");
            asm volatile("s_waitcnt vmcnt(0)" ::: "memory");
        }
    }
    __syncthreads();
}

struct Frame {
    LAS unsigned char* lds;
    volatile LAS unsigned* MISC;
    gu32* ctl;
    int tid, lane, wave;
    int vcu, G;
    unsigned char* ws;
};

__device__ __forceinline__ void p0_transpose_item(const float* W, int K, int N, bf16* WT, int dst_row0, const float* kscale, LAS float* scr, int k0, int n0, int lane) {
#pragma unroll 8
    for (int i = 0; i < 32; ++i) { const int kk = 2 * i + (lane >> 5); float v = W[(size_t)(k0 + kk) * N + n0 + (lane & 31)]; if (kscale) v *= kscale[k0 + kk]; scr[kk * 33 + (lane & 31)] = v; }
    LDS_WAIT(); asm volatile("" ::: "memory");
    const int c = lane & 7;
#pragma unroll
    for (int j = 0; j < 4; ++j) { const int n = (lane >> 3) + 8 * j; const LAS float* s = scr + (8 * c) * 33 + n;
        v4u o; o.x = pk2(s[0 * 33], s[1 * 33]); o.y = pk2(s[2 * 33], s[3 * 33]); o.z = pk2(s[4 * 33], s[5 * 33]); o.w = pk2(s[6 * 33], s[7 * 33]);
        *(GAS v4u*)(WT + (size_t)(dst_row0 + n) * K + k0 + 8 * c) = o; }
    LDS_WAIT(); asm volatile("" ::: "memory");
}
__device__ __forceinline__ int map_projB(int n0) {
    if (n0 < 2048) { const int t = n0 - 1536, hq = t >> 6, hf = (t >> 5) & 1; return 256 * (hq >> 2) + 128 * hf + 32 * (hq & 3); }
    if (n0 < 2176) { const int t = n0 - 2048, kh = t >> 6, hf = (t >> 5) & 1; return 512 + 128 * hf + 32 * kh; }
    if (n0 < 2304) { const int t = n0 - 2176, vh = t >> 6, hf = (t >> 5) & 1; return 512 + 128 * hf + 32 * (2 + vh); }
    return 768 + (n0 - 2304);
}
__device__ __forceinline__ void p0_row(const float* xrow, bf16* orow, float* rstd_out, int lane) {
    const GAS f32x4* xr = (const GAS f32x4*)xrow + lane;
    f32x4 v[4]; float s = 0.f;
#pragma unroll
    for (int j = 0; j < 4; ++j) { v[j] = xr[64 * j]; s += (v[j].x * v[j].x + v[j].y * v[j].y) + (v[j].z * v[j].z + v[j].w * v[j].w); }
    s = wave_sum(s);
    if (lane == 0) *rstd_out = 1.0f / sqrtf(s * (1.0f / DM) + RMS_EPS);
    GAS unsigned long long* o8 = (GAS unsigned long long*)orow + lane;
#pragma unroll
    for (int j = 0; j < 4; ++j) o8[64 * j] = (unsigned long long)pk2(v[j].x, v[j].y) | ((unsigned long long)pk2(v[j].z, v[j].w) << 32);
}
constexpr int FW_W1 = 0, FW_W2 = 33 * 64 * 4, FW_B1 = FW_W2 + 64 * 64 * 4, FW_B2 = FW_B1 + 256, FW_FR = FW_B2 + 256, FW_END = FW_FR + 256, FT_PITCH = 144, FT_BYTES = 32 * FT_PITCH;
__device__ __forceinline__ void filter_stage_weights(LAS unsigned char* lds, const float* w1, const float* b1, const float* w2, const float* b2, const float* fr, int tid) {
    LAS float* W1 = (LAS float*)(lds + FW_W1); LAS float* W2 = (LAS float*)(lds + FW_W2);
    for (int i = tid; i < 33 * 64; i += NWAVES * 64) W1[i] = w1[i];
    for (int i = tid; i < 64 * 64; i += NWAVES * 64) W2[i] = w2[i];
    if (tid < 64) { ((LAS float*)(lds + FW_B1))[tid] = b1[tid]; ((LAS float*)(lds + FW_B2))[tid] = b2[tid]; ((LAS float*)(lds + FW_FR))[tid] = fr[tid]; }
    LDS_WAIT(); __syncthreads();
}
__device__ __forceinline__ void filter_mlp_half(LAS unsigned char* lds, int L, int chunk, int hf, int dir, int r, int h, LAS float* Hb, bf16x8 (&afr)[4]) {
    const LAS float* W1 = (const LAS float*)(lds + FW_W1); const LAS float* W2 = (const LAS float*)(lds + FW_W2);
    const LAS float* B1 = (const LAS float*)(lds + FW_B1); const LAS float* B2 = (const LAS float*)(lds + FW_B2); const LAS float* FR = (const LAS float*)(lds + FW_FR);
        int pos = 64 * chunk + 32 * hf + r + dir; if (pos > L - 1) pos = L - 1;
        const float t = (float)pos / (float)(L - 1);
        float a[32];
#pragma unroll
        for (int jj = 0; jj < 32; ++jj) a[jj] = B1[32 * h + jj];
        {
#pragma unroll
            for (int jj = 0; jj < 32; jj += 4) { const f32x4 w = *(const LAS f32x4*)(W1 + 32 * h + jj); a[jj] += t * w[0]; a[jj + 1] += t * w[1]; a[jj + 2] += t * w[2]; a[jj + 3] += t * w[3]; }
#pragma unroll 1
            for (int i = 0; i < 16; ++i) {
                const float band = 1e-4f + (float)i * ((15.0f - 1e-4f) / 15.0f); const float ang = (6.283185307179586f / (float)L) * (float)pos * band;
                const float cv = __cosf(ang), sv = -__sinf(ang);
                const LAS float* wc = W1 + (1 + i) * 64 + 32 * h; const LAS float* wsn = W1 + (17 + i) * 64 + 32 * h;
#pragma unroll
                for (int jj = 0; jj < 32; jj += 4) { const f32x4 w = *(const LAS f32x4*)(wc + jj), v = *(const LAS f32x4*)(wsn + jj);
                    a[jj] += cv * w[0] + sv * v[0]; a[jj + 1] += cv * w[1] + sv * v[1]; a[jj + 2] += cv * w[2] + sv * v[2]; a[jj + 3] += cv * w[3] + sv * v[3]; }
            }
        }
#pragma unroll
        for (int jj = 0; jj < 32; ++jj) Hb[(32 * h + jj) * 32 + r] = __sinf(FR[32 * h + jj] * a[jj]);
        LDS_WAIT(); asm volatile("" ::: "memory");
#pragma unroll
        for (int jj = 0; jj < 32; ++jj) a[jj] = B2[32 * h + jj];
#pragma unroll 1
        for (int i = 0; i < 64; ++i) { const float hv = Hb[i * 32 + r]; const LAS float* wr_ = W2 + i * 64 + 32 * h;
#pragma unroll
            for (int jj = 0; jj < 32; jj += 4) { const f32x4 w = *(const LAS f32x4*)(wr_ + jj); a[jj] += hv * w[0]; a[jj + 1] += hv * w[1]; a[jj + 2] += hv * w[2]; a[jj + 3] += hv * w[3]; } }
        LDS_WAIT(); asm volatile("" ::: "memory");
        unsigned op[16], pp[16];
#pragma unroll
        for (int d = 0; d < 16; ++d) op[d] = pk2(__sinf(FR[32 * h + 2 * d] * a[2 * d]), __sinf(FR[32 * h + 2 * d + 1] * a[2 * d + 1]));
#pragma unroll
        for (int d = 0; d < 16; ++d) pp[d] = __shfl_xor(op[d], 32);
#pragma unroll
        for (int ks = 0; ks < 4; ++ks) { v4u f;
#pragma unroll
            for (int w = 0; w < 4; ++w) { const unsigned own = h ? op[8 * (ks & 1) + 4 + w] : op[8 * (ks & 1) + w], par = h ? pp[8 * (ks & 1) + 4 + w] : pp[8 * (ks & 1) + w];
                f[w] = ((ks >> 1) == h) ? own : par; }
            afr[ks] = __builtin_bit_cast(bf16x8, f); }
}
__device__ __forceinline__ void filter_item(LAS unsigned char* lds, const bf16* w3T, bf16* krev, float* fpart, int g, int chunk, int quarter, int wave, int lane_) {
    int lane = lane_; asm volatile("" : "+v"(lane));
    const int L = g ? LS : LP, r = lane & 31, h = lane >> 5, dir = quarter & 1, o_ = quarter >> 1;
    const LAS float* W1 = (const LAS float*)(lds + FW_W1); const LAS float* W2 = (const LAS float*)(lds + FW_W2);
    const LAS float* B1 = (const LAS float*)(lds + FW_B1); const LAS float* B2 = (const LAS float*)(lds + FW_B2); const LAS float* FR = (const LAS float*)(lds + FW_FR);
    LAS unsigned char* T = lds + FW_END + wave * FT_BYTES; LAS float* Hb = (LAS float*)(lds + FW_END + NWAVES * FT_BYTES + wave * 8192);
    bf16x8 afr0[4], afr1[4];
    filter_mlp_half(lds, L, chunk, 0, dir, r, h, Hb, afr0);
    filter_mlp_half(lds, L, chunk, 1, dir, r, h, Hb, afr1);
    const float dmin = -4.605170185988091f / 1.5f, dmax = -4.605170185988091f / 0.3f;
    const int p0 = 64 * chunk; const int mstart = g ? (dir ? (2 * L - p0 - 64) : p0) : (dir ? (L + p0) : (L - 64 - p0));
    for (int ti = 0; ti < 16; ++ti) {
        const int cb = 32 * ti, colg = quarter * 512 + cb;
        bf16x8 bfr[4];
#pragma unroll
        for (int ks = 0; ks < 4; ++ks) bfr[ks] = *(const GAS bf16x8*)(w3T + (size_t)(colg + r) * 64 + 16 * ks + 8 * h);
        const float delta = fabsf(dmin + (float)(cb + r) * ((dmax - dmin) / 511.0f));
        float asum = 0.f;
#pragma unroll
        for (int hf = 0; hf < 2; ++hf) {
            f32x16 acc = (f32x16){0.f,0.f,0.f,0.f,0.f,0.f,0.f,0.f,0.f,0.f,0.f,0.f,0.f,0.f,0.f,0.f};
#pragma unroll
            for (int ks = 0; ks < 4; ++ks) acc = __builtin_amdgcn_mfma_f32_32x32x16_bf16(hf ? afr1[ks] : afr0[ks], bfr[ks], acc, 0, 0, 0);
#pragma unroll
            for (int rg = 0; rg < 16; ++rg) {
                const int i = 32 * hf + (rg & 3) + 8 * (rg >> 2) + 4 * h; const int pos = p0 + i + dir;
                const float t = (float)pos / (float)(L - 1);
                float kv = acc[rg] * (__expf(-t * delta) + 0.05f); if (pos > L - 1) kv = 0.f;
                asum += fabsf(kv);
                const int e = ((dir != 0) != (g != 0)) ? i : 63 - i;
                *(LAS bf16*)(T + r * FT_PITCH + e * 2) = (bf16)f2bf(kv);
            }
        }
        asum += __shfl_xor(asum, 32);
        if (h == 0) fpart[(size_t)chunk * 2048 + colg + r] = asum;
        LDS_WAIT(); asm volatile("" ::: "memory");
        {
            const int col = lane >> 1, hb = lane & 1;
            bf16* dst = krev + (size_t)(o_ * 512 + cb + col) * (2 * L) + mstart + 32 * hb;
            const LAS v4u* src = (const LAS v4u*)(T + col * FT_PITCH + 64 * hb);
#pragma unroll
            for (int q = 0; q < 4; ++q) *(GAS v4u*)(dst + 8 * q) = src[q];
        }
        LDS_WAIT(); asm volatile("" ::: "memory");
    }
}

namespace hy {
constexpr int SLOTB = 272, Z_BYTES = 75776, F_OFF = 75776, F_BYTES = 65536, RED_OFF = F_OFF + F_BYTES;
__device__ __forceinline__ int slot_of(int g, int n) { return g ? (n + 31) : ((n >> 4) * 32 + 16 + (n & 15)); }
__device__ __forceinline__ int crow(int r, int hi) { return (r & 3) + 8 * (r >> 2) + 4 * hi; }

struct Params { const bf16* uT; const bf16* krev_s; const bf16* krev_p; const float* fpart_s; const float* fpart_p; const float* conv_w; const float* conv_b; const float* hbias; bf16* yT; float* dF; bf16* dZ; };

__device__ __forceinline__ void conv3_chunk(const bf16* urow  , int g, int chunk, float w0, float w1, float w2, float b, float (&out)[8]) {
    const int tau0 = chunk * 8; const int L = g ? LS : LP; const int p0 = g ? tau0 : (tau0 & (LP - 1));
    const v4u raw = *(const GAS v4u*)(urow + tau0);
    float u[10];
    u[1] = pg8::bflo(raw.x); u[2] = pg8::bfhi(raw.x); u[3] = pg8::bflo(raw.y); u[4] = pg8::bfhi(raw.y); u[5] = pg8::bflo(raw.z); u[6] = pg8::bfhi(raw.z); u[7] = pg8::bflo(raw.w); u[8] = pg8::bfhi(raw.w);
    u[0] = (p0 > 0) ? bf2f(urow[tau0 - 1]) : 0.f;
    u[9] = (p0 + 8 < L) ? bf2f(urow[tau0 + 8]) : 0.f;
#pragma unroll
    for (int i = 0; i < 8; ++i) out[i] = w0 * u[i] + w1 * u[i + 1] + w2 * u[i + 2] + b;
}

__device__ __forceinline__ bf16x8 load_afrag(LAS const unsigned char* lds, int addr, int sh) {
    const LAS unsigned* p = (const LAS unsigned*)(lds + addr);
    const unsigned w0 = p[0], w1 = p[1], w2 = p[2], w3 = p[3], w4 = p[4];
    v4u f; f.x = __builtin_amdgcn_alignbit(w1, w0, sh); f.y = __builtin_amdgcn_alignbit(w2, w1, sh); f.z = __builtin_amdgcn_alignbit(w3, w2, sh); f.w = __builtin_amdgcn_alignbit(w4, w3, sh);
    return __builtin_bit_cast(bf16x8, f);
}

__device__ __forceinline__ void hyena_item(LAS unsigned char* lds, const Params& P, int g, int c, int tid_) {
    int tid = tid_; asm volatile("" : "+v"(tid));
    const int lane = tid & 63, wave = __builtin_amdgcn_readfirstlane(tid >> 6), r = lane & 31, hi = lane >> 5, nt = wave & 3, half = wave >> 2;
    const int L = g ? LS : LP; const int T0 = g ? TP : 0;
    LAS float* red = (LAS float*)(lds + RED_OFF);
    float inv_norm0, inv_norm1;
    {
        const int nchunk = g ? 256 : 32; const float* fp = P.fpart_s + (g ? (size_t)0 : (size_t)((WS_FPART_P - WS_FPART_S) / 4));
        float s0 = 0.f, s1 = 0.f;
        for (int idx = tid; idx < nchunk * 2; idx += NWAVES * 64) { const int ch = idx >> 1, dir = idx & 1; s0 += fp[(size_t)ch * 2048 + dir * 512 + c]; s1 += fp[(size_t)ch * 2048 + 1024 + dir * 512 + c]; }
        s0 = wave_sum(s0); s1 = wave_sum(s1);
        if (lane == 0) { red[wave * 2] = s0; red[wave * 2 + 1] = s1; }
        for (int i = tid; i < Z_BYTES / 16; i += NWAVES * 64) *(LAS v4u*)(lds + i * 16) = (v4u){0u, 0u, 0u, 0u};
        LDS_WAIT(); __syncthreads();
        float t0 = 0.f, t1 = 0.f;
#pragma unroll
        for (int w = 0; w < NWAVES; ++w) { t0 += red[w * 2]; t1 += red[w * 2 + 1]; }
        inv_norm0 = 1.0f / t0; inv_norm1 = 1.0f / t1;
    }
    {
        const int ch = 2 * HW + c; const float w0 = P.conv_w[ch], w1 = P.conv_w[3 * HW + ch], w2 = P.conv_w[6 * HW + ch], b = P.conv_b[ch];
        const bf16* urow = P.uT + (size_t)ch * MTOK + T0;
        for (int it = 0; it < 4; ++it) { const int chunk = tid + it * 512; float o[8]; conv3_chunk(urow, g, chunk, w0, w1, w2, b, o);
            const int tau0 = chunk * 8; v4u pk; pk.x = pk2(o[0], o[1]); pk.y = pk2(o[2], o[3]); pk.z = pk2(o[4], o[5]); pk.w = pk2(o[6], o[7]);
            *(LAS v4u*)(lds + slot_of(g, tau0 >> 7) * SLOTB + (tau0 & 127) * 2) = pk; }
    }
    int d_hi, d_lo;
    if (g) { if (half == 0) { d_hi = 32 * nt + 31; d_lo = 32 * nt - 48; } else { d_hi = 32 * nt - 49; d_lo = 32 * nt - 127; } }
    else   { if (half == 0) { d_hi = 15; d_lo = 0; } else { d_hi = -1; d_lo = -15; } }
    int abase = F_OFF + 2 * ((L - 1) - r + 8 * hi); const int sh = (abase & 2) ? 16 : 0; abase &= ~3;
    const int zb = slot_of(g, 32 * nt + r) * SLOTB + 16 * hi;
    const int mi0 = 2 * half;

    for (int o = 0; o < 2; ++o) {
        {
            const bf16* ksrc = P.krev_s + (g ? (size_t)0 : (size_t)((WS_KREV_P - WS_KREV_S) / 2)) + (size_t)(o * HW + c) * (2 * L);
            const int n16 = (2 * L * 2) / 16;
            for (int i = tid; i < n16; i += NWAVES * 64) *(LAS v4u*)(lds + F_OFF + i * 16) = *(const GAS v4u*)(ksrc + i * 8);
        }
        LDS_WAIT(); __syncthreads();
        f32x16 acc[4];
#pragma unroll
        for (int mi = 0; mi < 4; ++mi) acc[mi] = (f32x16){0.f,0.f,0.f,0.f,0.f,0.f,0.f,0.f,0.f,0.f,0.f,0.f,0.f,0.f,0.f,0.f};
        bf16x8 Fw[8];
        {
            const int q0 = -8 * d_hi;
#pragma unroll
            for (int s = 2; s < 8; ++s) Fw[s] = load_afrag(lds, abase + 32 * (q0 - 8 + s), sh);
            Fw[0] = Fw[2]; Fw[1] = Fw[3];
        }
        {
            unsigned ap = (unsigned)(uintptr_t)(lds + abase) + 32 * (-8 * d_hi), bp = (unsigned)(uintptr_t)(lds + zb) - d_hi * SLOTB;
            v2u n01, n23; unsigned n4; v4u zn;
            unsigned r0, r1, r2, r3, r4; v4u zf;
#define HY_LOADS(ADW, BOFF) asm volatile("ds_read2_b32 %0, %4 offset0:%c5 offset1:%c6\n\tds_read2_b32 %1, %4 offset0:%c7 offset1:%c8\n\tds_read_b32 %2, %4 offset:%c9\n\tds_read_b128 %3, %10 offset:%c11" \
                : "=&v"(n01), "=&v"(n23), "=&v"(n4), "=&v"(zn) : "v"(ap), "i"(ADW), "i"((ADW) + 1), "i"((ADW) + 2), "i"((ADW) + 3), "i"(((ADW) + 4) * 4), "v"(bp), "i"(BOFF))
#define HY_WAIT() do { asm volatile("s_waitcnt lgkmcnt(0)" : "+v"(n01), "+v"(n23), "+v"(n4), "+v"(zn), "+v"(acc[0]), "+v"(acc[1]), "+v"(acc[2]), "+v"(acc[3])); __builtin_amdgcn_sched_barrier(0); } while (0)
#define HY_TAKE() do { r0 = n01.x; r1 = n01.y; r2 = n23.x; r3 = n23.y; r4 = n4; zf = zn; } while (0)
#define HY_STEP(JK, ADW, BOFF) do { HY_LOADS(ADW, BOFF); __builtin_amdgcn_sched_barrier(0); \
                { v4u f; f.x = __builtin_amdgcn_alignbit(r1, r0, sh); f.y = __builtin_amdgcn_alignbit(r2, r1, sh); f.z = __builtin_amdgcn_alignbit(r3, r2, sh); f.w = __builtin_amdgcn_alignbit(r4, r3, sh); Fw[JK] = __builtin_bit_cast(bf16x8, f); } \
                { const bf16x8 zb_ = __builtin_bit_cast(bf16x8, zf); \
                  acc[0] = __builtin_amdgcn_mfma_f32_32x32x16_bf16(Fw[(JK) & 7], zb_, acc[0], 0, 0, 0); acc[1] = __builtin_amdgcn_mfma_f32_32x32x16_bf16(Fw[((JK) - 2) & 7], zb_, acc[1], 0, 0, 0); \
                  acc[2] = __builtin_amdgcn_mfma_f32_32x32x16_bf16(Fw[((JK) - 4) & 7], zb_, acc[2], 0, 0, 0); acc[3] = __builtin_amdgcn_mfma_f32_32x32x16_bf16(Fw[((JK) - 6) & 7], zb_, acc[3], 0, 0, 0); } \
                HY_WAIT(); HY_TAKE(); } while (0)
            HY_LOADS(0, 0); HY_WAIT(); HY_TAKE();
            for (int d = d_hi; d >= d_lo; --d) {
                HY_STEP(0, 8, 32); HY_STEP(1, 16, 64); HY_STEP(2, 24, 96); HY_STEP(3, 32, 128); HY_STEP(4, 40, 160); HY_STEP(5, 48, 192); HY_STEP(6, 56, 224); HY_STEP(7, 64, SLOTB);
                ap += 256; bp += SLOTB;
            }
#undef HY_LOADS
#undef HY_WAIT
#undef HY_TAKE
#undef HY_STEP
        }
        LDS_WAIT(); __syncthreads();
        {
            LAS float* X = (LAS float*)(lds + F_OFF) + wave * 2048;
#pragma unroll
            for (int t = 0; t < 2; ++t)
#pragma unroll
                for (int rg = 0; rg < 16; ++rg) X[(t * 16 + rg) * 64 + lane] = (half == 0) ? acc[2 + t][rg] : acc[t][rg];
        }
        LDS_WAIT(); __syncthreads();
        f32x16 fin[2];
        {
            const LAS float* X = (const LAS float*)(lds + F_OFF) + (wave ^ 4) * 2048;
#pragma unroll
            for (int t = 0; t < 2; ++t)
#pragma unroll
                for (int rg = 0; rg < 16; ++rg) fin[t][rg] = ((half == 0) ? acc[t][rg] : acc[2 + t][rg]) + X[(t * 16 + rg) * 64 + lane];
        }
        LDS_WAIT(); __syncthreads();
        {
            const int ch = o * HW + c; const float w0 = P.conv_w[ch], w1 = P.conv_w[3 * HW + ch], w2 = P.conv_w[6 * HW + ch], b = P.conv_b[ch];
            const bf16* urow = P.uT + (size_t)ch * MTOK + T0;
            for (int it = 0; it < 4; ++it) { const int chunk = tid + it * 512; float v[8]; conv3_chunk(urow, g, chunk, w0, w1, w2, b, v);
                LAS f32x4* dst = (LAS f32x4*)(lds + F_OFF + chunk * 32); dst[0] = (f32x4){v[0], v[1], v[2], v[3]}; dst[1] = (f32x4){v[4], v[5], v[6], v[7]}; }
        }
        LDS_WAIT(); __syncthreads();
        {
            const float sb = P.hbias[o * HW + c], inr = o ? inv_norm1 : inv_norm0;
            const LAS float* G = (const LAS float*)(lds + F_OFF);
            const int n = 32 * nt + r; LAS bf16* zs = (LAS bf16*)(lds + slot_of(g, n) * SLOTB);
#pragma unroll
            for (int t = 0; t < 2; ++t)
#pragma unroll
                for (int rg = 0; rg < 16; ++rg) { const int i = 32 * (mi0 + t) + crow(rg, hi);
                    const float zo = bf2f(zs[i]);
#if PROBE >= 100
                    if (c == 137) { P.dF[(g * 2 + o) * 16384 + 128 * n + i] = fin[t][rg]; P.dZ[(g * 2 + o) * 16384 + 128 * n + i] = zs[i]; }
#endif
                    const float val = G[128 * n + i] * (inr * fin[t][rg] + sb * zo); zs[i] = (bf16)f2bf(val); }
        }
        LDS_WAIT(); __syncthreads();
    }
    {
        bf16* yrow = P.yT + (size_t)c * MTOK + T0;
        for (int it = 0; it < 4; ++it) { const int chunk = tid + it * 512, tau0 = chunk * 8;
            *(GAS v4u*)(yrow + tau0) = *(const LAS v4u*)(lds + slot_of(g, tau0 >> 7) * SLOTB + (tau0 & 127) * 2); }
    }
    LDS_WAIT(); __syncthreads();
}
}

namespace fc {
constexpr int OST = 1032, PLANE_B = 32 * OST * 2  , RE_OFF = 0, IM_OFF = PLANE_B, RED_OFF = 2 * PLANE_B;
constexpr int NFFT = 32768;
enum { F1 = 0, F2 = 1, F3 = 2, I1 = 3, I2 = 4, I3 = 5 };
__device__ __forceinline__ int crow(int r, int hi) { return (r & 3) + 8 * (r >> 2) + 4 * hi; }
struct Params { const bf16* uT; const bf16* kc; const float* fpart_s; const float* conv_w; const float* conv_b; const float* hbias; bf16* yT; bf16* hs; bf16* z1s; float* dF; bf16* dZ; };
struct FMat { bf16x8 fr[2], fi[2], nfi[2]; };

__device__ __forceinline__ void make_fmat(FMat& M, int r, int h) {
#pragma unroll
    for (int ks = 0; ks < 2; ++ks) { v4u a, b, c;
#pragma unroll
        for (int w = 0; w < 4; ++w) { float cv[2], sv[2];
#pragma unroll
            for (int e = 0; e < 2; ++e) { const int aidx = 16 * ks + 8 * h + 2 * w + e; const float fr_ = (float)((aidx * r) & 31) * (1.0f / 32.0f); cv[e] = __builtin_amdgcn_cosf(fr_); sv[e] = __builtin_amdgcn_sinf(fr_); }
            a[w] = pk2(cv[0], cv[1]); b[w] = pk2(-sv[0], -sv[1]); c[w] = pk2(sv[0], sv[1]); }
        M.fr[ks] = __builtin_bit_cast(bf16x8, a); M.fi[ks] = __builtin_bit_cast(bf16x8, b); M.nfi[ks] = __builtin_bit_cast(bf16x8, c); }
}

template <int ST, bool REAL_IN, bool HALF_K>
__device__ __forceinline__ void stage(LAS unsigned char* lds, const FMat& M, int wave, int r_, int h_) {
    int r = r_, h = h_; asm volatile("" : "+v"(r), "+v"(h));
    constexpr bool INV = (ST >= I1);
    const f32x16 zero16 = (f32x16){0.f,0.f,0.f,0.f,0.f,0.f,0.f,0.f,0.f,0.f,0.f,0.f,0.f,0.f,0.f,0.f};
    unsigned res[4][16];
#pragma unroll
    for (int t = 0; t < 4; ++t) {
        const int f = 4 * wave + t;
        const int base = (ST == I2) ? (32 * f + OST * r) : (32 * r + OST * f);
        f32x16 ur = zero16, ui = zero16;
#pragma unroll
        for (int ks = 0; ks < (HALF_K ? 1 : 2); ++ks) {
            const bf16x8 xr = *(const LAS bf16x8*)(lds + RE_OFF + 2 * (base + 16 * ks + 8 * h));
            if (!INV) {
                ur = __builtin_amdgcn_mfma_f32_32x32x16_bf16(M.fr[ks], xr, ur, 0, 0, 0);
                ui = __builtin_amdgcn_mfma_f32_32x32x16_bf16(M.fi[ks], xr, ui, 0, 0, 0);
                if (!REAL_IN) { const bf16x8 xi = *(const LAS bf16x8*)(lds + IM_OFF + 2 * (base + 16 * ks + 8 * h));
                    ur = __builtin_amdgcn_mfma_f32_32x32x16_bf16(M.nfi[ks], xi, ur, 0, 0, 0);
                    ui = __builtin_amdgcn_mfma_f32_32x32x16_bf16(M.fr[ks], xi, ui, 0, 0, 0); }
            } else {
                const bf16x8 xi = *(const LAS bf16x8*)(lds + IM_OFF + 2 * (base + 16 * ks + 8 * h));
                ur = __builtin_amdgcn_mfma_f32_32x32x16_bf16(M.fr[ks], xr, ur, 0, 0, 0);
                ur = __builtin_amdgcn_mfma_f32_32x32x16_bf16(M.fi[ks], xi, ur, 0, 0, 0);
                if (ST != I3) { ui = __builtin_amdgcn_mfma_f32_32x32x16_bf16(M.fr[ks], xi, ui, 0, 0, 0);
                                ui = __builtin_amdgcn_mfma_f32_32x32x16_bf16(M.nfi[ks], xr, ui, 0, 0, 0); }
            }
        }
        if (ST == I3) {
#pragma unroll
            for (int rg = 0; rg < 8; ++rg) res[t][rg] = __float_as_uint(ur[rg]);
        } else {
            if (ST == F1 || ST == F2 || ST == I1 || ST == I2) {
#pragma unroll
                for (int rg = 0; rg < 16; ++rg) {
                    const int rho0 = (rg & 3) + 8 * (rg >> 2);
                    int e; float sc;
                    if (ST == F1) { const int m = 32 * r + f; e = m * rho0 + 4 * h * m; sc = 1.0f / 32768.0f; }
                    else if (ST == I2) { e = (32 * rho0 + 128 * h + f) * r; sc = 1.0f / 32768.0f; }
                    else { e = r * rho0 + 4 * h * r; sc = 1.0f / 1024.0f; }
                    const float fr_ = (float)e * sc; const float c = __builtin_amdgcn_cosf(fr_), s_ = __builtin_amdgcn_sinf(fr_);
                    const float s = INV ? s_ : -s_;
                    const float a = ur[rg], b = ui[rg];
                    ur[rg] = a * c - b * s; ui[rg] = a * s + b * c;
                }
            }
#pragma unroll
            for (int p = 0; p < 8; ++p) { res[t][p] = pk2(ur[2 * p], ur[2 * p + 1]); res[t][8 + p] = pk2(ui[2 * p], ui[2 * p + 1]); }
        }
        __builtin_amdgcn_sched_barrier(0);
    }
    LDS_WAIT(); __syncthreads();
#pragma unroll
    for (int t = 0; t < 4; ++t) {
        const int f = 4 * wave + t;
        if (ST == I3) {
            LAS float* Y = (LAS float*)(lds + IM_OFF);
#pragma unroll
            for (int rg = 0; rg < 8; ++rg) { const int rho = (rg & 3) + 8 * (rg >> 2) + 4 * h; Y[1024 * rho + 32 * r + f] = __uint_as_float(res[t][rg]); }
        } else if (ST == F3) {
#pragma unroll
            for (int g4 = 0; g4 < 4; ++g4) { const int pos = (8 * g4 + 4 * h) + 32 * r + OST * f;
                *(LAS v2u*)(lds + RE_OFF + 2 * pos) = (v2u){res[t][2 * g4], res[t][2 * g4 + 1]}; *(LAS v2u*)(lds + IM_OFF + 2 * pos) = (v2u){res[t][8 + 2 * g4], res[t][8 + 2 * g4 + 1]}; }
        } else {
#pragma unroll
            for (int rg = 0; rg < 16; ++rg) {
                const int rho = (rg & 3) + 8 * (rg >> 2) + 4 * h;
                const int pos = (ST == F1) ? (r + 32 * f + OST * rho) : (r + 32 * rho + OST * f);
                const unsigned wr_ = res[t][rg >> 1], wi_ = res[t][8 + (rg >> 1)];
                *(LAS bf16*)(lds + RE_OFF + 2 * pos) = (bf16)((rg & 1) ? (wr_ >> 16) : (wr_ & 0xffffu));
                *(LAS bf16*)(lds + IM_OFF + 2 * pos) = (bf16)((rg & 1) ? (wi_ >> 16) : (wi_ & 0xffffu));
            }
        }
    }
    LDS_WAIT(); __syncthreads();
}

__device__ __forceinline__ void self_visible(int tid) {
    VM_WAIT(); __syncthreads();
    if (tid == 0) { __builtin_amdgcn_fence(__ATOMIC_ACQUIRE, "agent"); VM_WAIT(); }
    __syncthreads();
}

__device__ __forceinline__ void item(LAS unsigned char* lds, const Params& P, int c, int tid_, int slot) {
    int tid = tid_; asm volatile("" : "+v"(tid));
    const int lane = tid & 63, wave = __builtin_amdgcn_readfirstlane(tid >> 6), r = lane & 31, h = lane >> 5;
    constexpr int L = LS, T0 = TP, g = 1;
    LAS float* red = (LAS float*)(lds + RED_OFF);
    bf16* hs = P.hs + (size_t)slot * (2 * PLANE_B / 2); bf16* z1s = P.z1s + (size_t)slot * L;
    float inv_norm0, inv_norm1;
    {
        float s0 = 0.f, s1 = 0.f;
        for (int idx = tid; idx < 512; idx += NWAVES * 64) { const int ch = idx >> 1, dir = idx & 1; s0 += P.fpart_s[(size_t)ch * 2048 + dir * 512 + c]; s1 += P.fpart_s[(size_t)ch * 2048 + 1024 + dir * 512 + c]; }
        s0 = wave_sum(s0); s1 = wave_sum(s1);
        if (lane == 0) { red[wave * 2] = s0; red[wave * 2 + 1] = s1; }
        LDS_WAIT(); __syncthreads();
        float t0 = 0.f, t1 = 0.f;
#pragma unroll
        for (int w = 0; w < NWAVES; ++w) { t0 += red[w * 2]; t1 += red[w * 2 + 1]; }
        inv_norm0 = 1.0f / t0; inv_norm1 = 1.0f / t1;
    }
    FMat M; make_fmat(M, r, h);
    for (int o = 0; o < 2; ++o) {
        asm volatile("" : "+v"(tid));
        {
            const bf16* ksrc = P.kc + (size_t)(o * HW + c) * NFFT;
            for (int it = 0; it < 8; ++it) { const int chunk = tid + it * 512, n = chunk * 8; const v4u raw = *(const GAS v4u*)(ksrc + n);
                const int pos0 = (n >> 10) + 32 * ((n >> 5) & 31) + OST * (n & 31); LAS bf16* d = (LAS bf16*)(lds + RE_OFF) + pos0;
                d[0 * OST] = (bf16)(raw.x & 0xffffu); d[1 * OST] = (bf16)(raw.x >> 16); d[2 * OST] = (bf16)(raw.y & 0xffffu); d[3 * OST] = (bf16)(raw.y >> 16);
                d[4 * OST] = (bf16)(raw.z & 0xffffu); d[5 * OST] = (bf16)(raw.z >> 16); d[6 * OST] = (bf16)(raw.w & 0xffffu); d[7 * OST] = (bf16)(raw.w >> 16); }
        }
        LDS_WAIT(); __syncthreads();
        stage<F1, true, false>(lds, M, wave, r, h); stage<F2, false, false>(lds, M, wave, r, h); stage<F3, false, false>(lds, M, wave, r, h);
        for (int i = tid; i < 2 * PLANE_B / 16; i += NWAVES * 64) *(GAS v4u*)((unsigned char*)hs + (size_t)i * 16) = *(const LAS v4u*)(lds + i * 16);
        self_visible(tid);
        {
            const int ch = 2 * HW + c; const float w0 = P.conv_w[ch], w1 = P.conv_w[3 * HW + ch], w2 = P.conv_w[6 * HW + ch], b = P.conv_b[ch];
            const bf16* urow = P.uT + (size_t)ch * MTOK + T0;
            for (int it = 0; it < 4; ++it) { const int chunk = tid + it * 512, n = chunk * 8; unsigned short e[8];
                if (o == 0) { float v[8]; hy::conv3_chunk(urow, g, chunk, w0, w1, w2, b, v);
#pragma unroll
                    for (int j = 0; j < 8; ++j) e[j] = (unsigned short)f2bf(v[j]); }
                else { const v4u raw = *(const GAS v4u*)(z1s + n); e[0] = raw.x & 0xffffu; e[1] = raw.x >> 16; e[2] = raw.y & 0xffffu; e[3] = raw.y >> 16; e[4] = raw.z & 0xffffu; e[5] = raw.z >> 16; e[6] = raw.w & 0xffffu; e[7] = raw.w >> 16; }
                const int pos0 = (n >> 10) + 32 * ((n >> 5) & 31) + OST * (n & 31); LAS bf16* d = (LAS bf16*)(lds + RE_OFF) + pos0;
#pragma unroll
                for (int j = 0; j < 8; ++j) d[j * OST] = e[j]; }
        }
        LDS_WAIT(); __syncthreads();
        stage<F1, true, true>(lds, M, wave, r, h); stage<F2, false, false>(lds, M, wave, r, h); stage<F3, false, false>(lds, M, wave, r, h);
        for (int i = tid; i < PLANE_B / 16; i += NWAVES * 64) {
            const v4u xr = *(const LAS v4u*)(lds + RE_OFF + i * 16), xi = *(const LAS v4u*)(lds + IM_OFF + i * 16);
            const v4u hr = *(const GAS v4u*)((const unsigned char*)hs + (size_t)i * 16), hi_ = *(const GAS v4u*)((const unsigned char*)hs + PLANE_B + (size_t)i * 16);
            v4u vr, vi;
#pragma unroll
            for (int w = 0; w < 4; ++w) {
                const float a0 = pg8::bflo(xr[w]), a1 = pg8::bfhi(xr[w]), b0 = pg8::bflo(xi[w]), b1 = pg8::bfhi(xi[w]);
                const float c0 = pg8::bflo(hr[w]) * (1.0f / 32768.0f), c1 = pg8::bfhi(hr[w]) * (1.0f / 32768.0f), d0 = pg8::bflo(hi_[w]) * (1.0f / 32768.0f), d1 = pg8::bfhi(hi_[w]) * (1.0f / 32768.0f);
                vr[w] = pk2(a0 * c0 - b0 * d0, a1 * c1 - b1 * d1); vi[w] = pk2(a0 * d0 + b0 * c0, a1 * d1 + b1 * c1);
            }
            *(LAS v4u*)(lds + RE_OFF + i * 16) = vr; *(LAS v4u*)(lds + IM_OFF + i * 16) = vi;
        }
        LDS_WAIT(); __syncthreads();
        stage<I1, false, false>(lds, M, wave, r, h); stage<I2, false, false>(lds, M, wave, r, h); stage<I3, false, false>(lds, M, wave, r, h);
        {
            const LAS float* Y = (const LAS float*)(lds + IM_OFF);
            const int chg = o * HW + c; const float g0 = P.conv_w[chg], g1 = P.conv_w[3 * HW + chg], g2 = P.conv_w[6 * HW + chg], gb = P.conv_b[chg];
            const int chv = 2 * HW + c; const float v0 = P.conv_w[chv], v1 = P.conv_w[3 * HW + chv], v2 = P.conv_w[6 * HW + chv], vb = P.conv_b[chv];
            const bf16* grow = P.uT + (size_t)chg * MTOK + T0; const bf16* vrow = P.uT + (size_t)chv * MTOK + T0;
            const float sb = P.hbias[o * HW + c], inr = o ? inv_norm1 : inv_norm0;
            bf16* dst = o ? (P.yT + (size_t)c * MTOK + T0) : z1s;
            for (int it = 0; it < 4; ++it) { const int chunk = tid + it * 512, n = chunk * 8; float gt[8], zo[8];
                hy::conv3_chunk(grow, g, chunk, g0, g1, g2, gb, gt);
                if (o == 0) { hy::conv3_chunk(vrow, g, chunk, v0, v1, v2, vb, zo);
#pragma unroll
                    for (int j = 0; j < 8; ++j) zo[j] = bf2f((unsigned short)f2bf(zo[j])); }
                else { const v4u raw = *(const GAS v4u*)(z1s + n); zo[0] = pg8::bflo(raw.x); zo[1] = pg8::bfhi(raw.x); zo[2] = pg8::bflo(raw.y); zo[3] = pg8::bfhi(raw.y); zo[4] = pg8::bflo(raw.z); zo[5] = pg8::bfhi(raw.z); zo[6] = pg8::bflo(raw.w); zo[7] = pg8::bfhi(raw.w); }
                const f32x4 y0 = *(const LAS f32x4*)(Y + n), y1 = *(const LAS f32x4*)(Y + n + 4);
                float val[8];
#pragma unroll
                for (int j = 0; j < 8; ++j) { const float yv = (j < 4) ? y0[j & 3] : y1[j & 3];
#if PROBE >= 100
                    if (c == 137) { P.dF[(2 + o) * 16384 + n + j] = yv; P.dZ[(2 + o) * 16384 + n + j] = (bf16)f2bf(zo[j]); }
#endif
                    val[j] = gt[j] * (inr * yv + sb * zo[j]); }
                v4u pk; pk.x = pk2(val[0], val[1]); pk.y = pk2(val[2], val[3]); pk.z = pk2(val[4], val[5]); pk.w = pk2(val[6], val[7]);
                *(GAS v4u*)(dst + n) = pk; }
        }
        self_visible(tid);
    }
}
}

namespace at {
constexpr int KROW = 144, VROW = 776, K_OFF = 0, V_OFF = 384 * KROW  , END_OFF = V_OFF + 64 * VROW;
__device__ __forceinline__ int crow(int r, int hi) { return (r & 3) + 8 * (r >> 2) + 4 * hi; }
struct Params { const bf16* q; const bf16* k; const bf16* v; const float* sink; bf16* yat; };

__device__ __forceinline__ void attn_item(LAS unsigned char* lds, const Params& P, int blk, int gk, int tid_) {
    int tid = tid_; asm volatile("" : "+v"(tid));
    const int lane = tid & 63, wave = __builtin_amdgcn_readfirstlane(tid >> 6), r = lane & 31, hi = lane >> 5;
    const int m0 = blk * 128; const int s_lo = (blk < 128) ? (m0 & ~(LP - 1)) : TP, s_hi = (blk < 128) ? s_lo + LP : MTOK; const int kw0 = m0 - 128;
    for (int it = 0; it < 6; ++it) {
        const int idx = tid + it * 512, key = idx >> 3, chn = idx & 7, tok = kw0 + key; const bool ok = (tok >= s_lo) && (tok < s_hi);
        v4u kv = (v4u){0u, 0u, 0u, 0u}, vv = (v4u){0u, 0u, 0u, 0u};
        if (ok) { kv = *(const GAS v4u*)(P.k + (size_t)tok * 128 + gk * 64 + chn * 8); vv = *(const GAS v4u*)(P.v + (size_t)tok * 128 + gk * 64 + chn * 8); }
        *(LAS v4u*)(lds + K_OFF + key * KROW + chn * 16) = kv;
        LAS bf16* vt = (LAS bf16*)(lds + V_OFF + (chn * 8) * VROW + key * 2);
        vt[0 * (VROW / 2)] = (bf16)(vv.x & 0xffffu); vt[1 * (VROW / 2)] = (bf16)(vv.x >> 16); vt[2 * (VROW / 2)] = (bf16)(vv.y & 0xffffu); vt[3 * (VROW / 2)] = (bf16)(vv.y >> 16);
        vt[4 * (VROW / 2)] = (bf16)(vv.z & 0xffffu); vt[5 * (VROW / 2)] = (bf16)(vv.z >> 16); vt[6 * (VROW / 2)] = (bf16)(vv.w & 0xffffu); vt[7 * (VROW / 2)] = (bf16)(vv.w >> 16);
    }
    LDS_WAIT(); __syncthreads();
    const int hq = 4 * gk + (wave & 3), qh = wave >> 2;
    const int klo = (s_lo - kw0) > 0 ? (s_lo - kw0) : 0, khi = (s_hi - kw0) < 384 ? (s_hi - kw0) : 384;
    const float sinkl = P.sink[hq] * 1.4426950408889634f;
    for (int qq = 0; qq < 2; ++qq) {
        const int qt = 2 * qh + qq, q0 = 32 * qt; const size_t qrow = (size_t)(m0 + q0 + r);
        bf16x8 qf[4];
#pragma unroll
        for (int ks = 0; ks < 4; ++ks) qf[ks] = *(const GAS bf16x8*)(P.q + qrow * 512 + hq * 64 + 16 * ks + 8 * hi);
        float m_run = sinkl, l_run = (hi == 0) ? 1.0f : 0.0f;
        f32x16 o0 = (f32x16){0.f,0.f,0.f,0.f,0.f,0.f,0.f,0.f,0.f,0.f,0.f,0.f,0.f,0.f,0.f,0.f}, o1 = o0;
        const int lo_r = (q0 + r) > klo ? (q0 + r) : klo, hi_r = (q0 + r + 256) < (khi - 1) ? (q0 + r + 256) : (khi - 1);
        for (int kt = qt; kt <= qt + 8; ++kt) {
            const int kb = 32 * kt;
            f32x16 s = (f32x16){0.f,0.f,0.f,0.f,0.f,0.f,0.f,0.f,0.f,0.f,0.f,0.f,0.f,0.f,0.f,0.f};
#pragma unroll
            for (int ks = 0; ks < 4; ++ks) { const bf16x8 kf = *(const LAS bf16x8*)(lds + K_OFF + (kb + r) * KROW + 32 * ks + 16 * hi);
                s = __builtin_amdgcn_mfma_f32_32x32x16_bf16(kf, qf[ks], s, 0, 0, 0); }
            float tmax = -1e30f;
#pragma unroll
            for (int rg = 0; rg < 16; ++rg) { const int kj = kb + crow(rg, hi); const float sv = (kj >= lo_r && kj <= hi_r) ? s[rg] : -1e30f; s[rg] = sv; tmax = fmaxf(tmax, sv); }
            tmax = fmaxf(tmax, __shfl_xor(tmax, 32));
            const float mnew = fmaxf(m_run, tmax); const float alpha = __builtin_amdgcn_exp2f(m_run - mnew); m_run = mnew;
            float psum = 0.f;
#pragma unroll
            for (int rg = 0; rg < 16; ++rg) { const float p = __builtin_amdgcn_exp2f(s[rg] - mnew); s[rg] = p; psum += p; }
            l_run = l_run * alpha + psum;
#pragma unroll
            for (int rg = 0; rg < 16; ++rg) { o0[rg] *= alpha; o1[rg] *= alpha; }
            v4u pa, pb;
            pa.x = pk2(s[0], s[1]); pa.y = pk2(s[2], s[3]); pa.z = pk2(s[4], s[5]); pa.w = pk2(s[6], s[7]);
            pb.x = pk2(s[8], s[9]); pb.y = pk2(s[10], s[11]); pb.z = pk2(s[12], s[13]); pb.w = pk2(s[14], s[15]);
            const bf16x8 pf0 = __builtin_bit_cast(bf16x8, pa), pf1 = __builtin_bit_cast(bf16x8, pb);
#pragma unroll
            for (int dt = 0; dt < 2; ++dt) {
                const LAS unsigned char* vb = lds + V_OFF + (32 * dt + r) * VROW + (kb + 4 * hi) * 2;
                v4u va, vc;
                { const v2u x0 = *(const LAS v2u*)(vb), x1 = *(const LAS v2u*)(vb + 16); va = (v4u){x0.x, x0.y, x1.x, x1.y}; }
                { const v2u x0 = *(const LAS v2u*)(vb + 32), x1 = *(const LAS v2u*)(vb + 48); vc = (v4u){x0.x, x0.y, x1.x, x1.y}; }
                if (dt == 0) { o0 = __builtin_amdgcn_mfma_f32_32x32x16_bf16(__builtin_bit_cast(bf16x8, va), pf0, o0, 0, 0, 0); o0 = __builtin_amdgcn_mfma_f32_32x32x16_bf16(__builtin_bit_cast(bf16x8, vc), pf1, o0, 0, 0, 0); }
                else         { o1 = __builtin_amdgcn_mfma_f32_32x32x16_bf16(__builtin_bit_cast(bf16x8, va), pf0, o1, 0, 0, 0); o1 = __builtin_amdgcn_mfma_f32_32x32x16_bf16(__builtin_bit_cast(bf16x8, vc), pf1, o1, 0, 0, 0); }
            }
        }
        l_run += __shfl_xor(l_run, 32);
        const float inv = 1.0f / l_run;
        bf16* yrow = P.yat + qrow * 512 + hq * 64;
#pragma unroll
        for (int g4 = 0; g4 < 4; ++g4) {
            v2u w0, w1;
            w0.x = pk2(o0[4 * g4] * inv, o0[4 * g4 + 1] * inv); w0.y = pk2(o0[4 * g4 + 2] * inv, o0[4 * g4 + 3] * inv);
            w1.x = pk2(o1[4 * g4] * inv, o1[4 * g4 + 1] * inv); w1.y = pk2(o1[4 * g4 + 2] * inv, o1[4 * g4 + 3] * inv);
            *(GAS v2u*)(yrow + 8 * g4 + 4 * hi) = w0; *(GAS v2u*)(yrow + 32 + 8 * g4 + 4 * hi) = w1;
        }
    }
    LDS_WAIT(); __syncthreads();
}
}

__device__ __forceinline__ void transpose_y_tile(LAS unsigned char* lds, const bf16* yT, bf16* yhy, int tile, int tid_) {
    int tid = tid_; asm volatile("" : "+v"(tid));
    const int c0 = (tile & 7) * 64, t0 = (tile >> 3) * 64;
    LAS bf16* T = (LAS bf16*)lds;
    { const int ch = tid >> 3, k8 = tid & 7; *(LAS v4u*)(T + ch * 72 + k8 * 8) = *(const GAS v4u*)(yT + (size_t)(c0 + ch) * MTOK + t0 + k8 * 8); }
    LDS_WAIT(); __syncthreads();
    { const int tk = tid >> 3, c8 = tid & 7; unsigned short e[8];
#pragma unroll
      for (int j = 0; j < 8; ++j) e[j] = T[(c8 * 8 + j) * 72 + tk];
      v4u o; o.x = e[0] | ((unsigned)e[1] << 16); o.y = e[2] | ((unsigned)e[3] << 16); o.z = e[4] | ((unsigned)e[5] << 16); o.w = e[6] | ((unsigned)e[7] << 16);
      *(GAS v4u*)(yhy + (size_t)(t0 + tk) * 512 + c0 + c8 * 8) = o; }
    LDS_WAIT(); __syncthreads();
}

#if PROBE
constexpr int CW_P = 20000;
constexpr size_t WS_DF = 484 * MiB, WS_DZ = 485 * MiB;
constexpr int PROBE_C = 137;
__device__ __forceinline__ double wave_sum_d(double v) {
#pragma unroll
    for (int o = 1; o < 64; o <<= 1) v += __shfl_xor(v, o);
    return v;
}
__device__ __forceinline__ double filt_point(const float* w1, const float* b1, const float* w2, const float* b2, const float* w3, const float* fr, int g, int p, int col, int lane) {
    const int L = g ? LS : LP; const double t = (double)p / (double)(L - 1);
    double zval = 0.0;
    if (lane == 0) zval = t;
    else if (lane < 33) { const int i = (lane - 1) & 15; const double band = 1e-4 + (double)i * ((15.0 - 1e-4) / 15.0); const double ang = (6.283185307179586 / (double)L) * (double)p * band; zval = (lane <= 16) ? cos(ang) : -sin(ang); }
    double a = (double)b1[lane];
    for (int k = 0; k < 33; ++k) a += __shfl(zval, k) * (double)w1[k * 64 + lane];
    const double h1 = sin((double)fr[lane] * a);
    a = (double)b2[lane];
    for (int i = 0; i < 64; ++i) a += __shfl(h1, i) * (double)w2[i * 64 + lane];
    const double h2 = sin((double)fr[lane] * a);
    const double out = wave_sum_d(h2 * (double)w3[lane * 2048 + col]);
    const int c = col & 511; const double dmin = log(1e-2) / 1.5, dmax = log(1e-2) / 0.3;
    const double delta = fabs(dmin + (double)c * ((dmax - dmin) / 511.0));
    return out * (exp(-t * delta) + 0.05);
}
__device__ __forceinline__ void probe_check(unsigned char* ws, unsigned* ctl, const float* w1, const float* b1, const float* w2, const float* b2, const float* w3, const float* fr, int vcu, int G, int tid) {
    const bf16* KREV_S = (const bf16*)(ws + WS_KREV_S);
    const float* DF = (const float*)(ws + WS_DF); const bf16* DZ = (const bf16*)(ws + WS_DZ);
    const int gtid = vcu * 512 + tid, lane = tid & 63, gwv = gtid >> 6, NW = G * 8;
    if (gtid < 65536) {
        const int combo = gtid >> 14, t = gtid & 16383, g = combo >> 1, o = combo & 1, L = g ? LS : LP, tl = g ? t : (t & (LP - 1)), base = t - tl;
        const bf16* kb = KREV_S + (g ? (size_t)0 : (size_t)((WS_KREV_P - WS_KREV_S) / 2)) + (size_t)(o * HW + PROBE_C) * (2 * L); const bf16* dz = DZ + combo * 16384 + base;
        double acc = 0.0;
        if (g) { for (int s = 0; s < L; ++s) { int j = tl - s; if (j < 0) j += 2 * L; acc += (double)bf2f(kb[j]) * (double)bf2f(dz[s]); } }
        else   { const bf16* kr = kb + (L - 1 - tl); for (int s = 0; s < L; ++s) acc += (double)bf2f(kr[s]) * (double)bf2f(dz[s]); }
        const float diff = fabsf((float)(acc - (double)DF[combo * 16384 + t]));
        atomicMax(ctl + CW_P + 0, __float_as_uint(diff)); atomicMax(ctl + CW_P + 1, __float_as_uint(fabsf((float)acc)));
    }
    {
        const int g = gwv & 1, L = g ? LS : LP; const int p = (int)(((unsigned)gwv * 2654435761u) >> 8) % L;
        for (int q = 0; q < 8; ++q) { const int col = (gwv * 97 + 263 * q) & 2047; const int o = col >> 10, dir = (col >> 9) & 1, c = col & 511;
            if (dir == 1 && p == 0) continue;
            const double kv = filt_point(w1, b1, w2, b2, w3, fr, g, p, col, lane);
            const int m = g ? (dir ? (2 * L - p) : p) : (dir ? (L - 1 + p) : (L - 1 - p)); const float st = bf2f((KREV_S + (g ? (size_t)0 : (size_t)((WS_KREV_P - WS_KREV_S) / 2)) + (size_t)(o * HW + c) * (2 * L))[m]);
            if (lane == 0) { atomicMax(ctl + CW_P + 2, __float_as_uint(fabsf(st - (float)kv))); atomicMax(ctl + CW_P + 3, __float_as_uint(fabsf((float)kv))); } }
    }
    for (int which = 0; which < 2; ++which) {
        const int g = which ? 0 : 1, o = which ? 0 : 1, L = g ? LS : LP; double loc = 0.0;
        for (int p = gwv; p < L; p += NW)
            for (int dir = 0; dir < 2; ++dir) { if (dir == 1 && p == 0) continue; loc += fabs(filt_point(w1, b1, w2, b2, w3, fr, g, p, o * 1024 + dir * 512 + PROBE_C, lane)); }
        if (lane == 0) atomicAdd((double*)(ctl + CW_P + 8) + which, loc);
    }
}
__device__ __forceinline__ int probe_metric_count(unsigned char* ws, unsigned* ctl) {
    const float e_conv = __uint_as_float(__hip_atomic_load(ctl + CW_P + 0, RLX_AGENT)) / fmaxf(__uint_as_float(__hip_atomic_load(ctl + CW_P + 1, RLX_AGENT)), 1e-30f);
    const float e_filt = __uint_as_float(__hip_atomic_load(ctl + CW_P + 2, RLX_AGENT)) / fmaxf(__uint_as_float(__hip_atomic_load(ctl + CW_P + 3, RLX_AGENT)), 1e-30f);
    const float* FPS = (const float*)(ws + WS_FPART_S); const float* FPP = (const float*)(ws + WS_FPART_P);
    double s1 = 0.0, s0 = 0.0;
    for (int ch = 0; ch < 256; ++ch) s1 += (double)FPS[(size_t)ch * 2048 + 1024 + PROBE_C] + (double)FPS[(size_t)ch * 2048 + 1024 + 512 + PROBE_C];
    for (int ch = 0; ch < 32; ++ch) s0 += (double)FPP[(size_t)ch * 2048 + PROBE_C] + (double)FPP[(size_t)ch * 2048 + 512 + PROBE_C];
    const double n1 = ((volatile double*)(ctl + CW_P + 8))[0], n0 = ((volatile double*)(ctl + CW_P + 8))[1];
    const float e_n1 = (float)(fabs(n1 - s1) / fmax(n1, 1e-30)), e_n0 = (float)(fabs(n0 - s0) / fmax(n0, 1e-30));
#if PROBE == 100
    float M = fmaxf(fmaxf(e_conv, e_filt * 1e-3f), fmaxf(e_n1, e_n0));
#elif PROBE == 101
    float M = e_conv;
#elif PROBE == 102
    float M = e_filt;
#else
    float M = fmaxf(e_n1, e_n0);
#endif
    float v = (log10f(fmaxf(M, 1e-12f)) + 8.0f) * 0.125f; v = fminf(fmaxf(v, 0.02f), 1.0f);
    return (int)(v * 1600.0f);
}
#endif

#ifndef MK_SPLIT
#define MK_SPLIT 0
#endif
constexpr int N_PHASES = 8;
struct Args { const float* in[23]; float* out; unsigned char* ws; int ph_lo, ph_hi; };

__global__ void __launch_bounds__(NWAVES * 64, 2) enc_fwd(Args args) {
    extern __shared__ __attribute__((aligned(16))) unsigned char lds_raw[];
    Frame F;
    F.lds = (LAS unsigned char*)lds_raw;
    F.MISC = (volatile LAS unsigned*)(F.lds + MISC_OFF);
    F.tid = threadIdx.x; F.lane = F.tid & 63; F.wave = __builtin_amdgcn_readfirstlane(F.tid >> 6);
    F.G = gridDim.x; { const int bx = blockIdx.x; F.vcu = (F.G % 8 == 0) ? (bx % 8) * (F.G / 8) + bx / 8 : bx; }
    F.ws = args.ws; F.ctl = (gu32*)(args.ws + WS_CTL);
    unsigned char* const ws = args.ws;
    for (int u = F.tid; u < (LDS_BYTES - LDSCTL_OFF) / 4; u += NWAVES * 64) ((LAS unsigned*)(F.lds + LDSCTL_OFF))[u] = 0u;
    __syncthreads();
    const int lo = args.ph_lo, hi = args.ph_hi;
    XcdBarrier bar; bar.bar = (unsigned*)(F.ctl + CW_BAR); bar.x = 0; bar.st = nullptr;
    if (hi - lo > 1) bar = xcd_barrier_post((unsigned*)(F.ctl + CW_BAR), F.MISC + 8);
#define IN(k) (lo <= (k) && (k) < hi)
#if PROBE
#define TSTAMP(k) do { if (blockIdx.x == 0 && F.tid == 0) { const unsigned long long t_ = __builtin_amdgcn_s_memrealtime(); F.MISC[16 + 2 * (k)] = (unsigned)t_; F.MISC[17 + 2 * (k)] = (unsigned)(t_ >> 32); } } while (0)
#else
#define TSTAMP(k) do { } while (0)
#endif
#define SEAM(k) do { if (IN(k) && IN((k) + 1)) xcd_barrier(bar); TSTAMP((k) + 1); } while (0)
    TSTAMP(0);

    const float* const xp = args.in[0]; const float* const xs = args.in[1];
    bf16* const WINA = (bf16*)(ws + WS_WINA); bf16* const WINB = (bf16*)(ws + WS_WINB); bf16* const WHY = (bf16*)(ws + WS_WHY); bf16* const WAT = (bf16*)(ws + WS_WAT);
    bf16* const W3T = (bf16*)(ws + WS_W3T); bf16* const WO = (bf16*)(ws + WS_WO); bf16* const WGU = (bf16*)(ws + WS_WGU); bf16* const WD = (bf16*)(ws + WS_WD);
    bf16* const XB = (bf16*)(ws + WS_XB); bf16* const YT = (bf16*)(ws + WS_YT); bf16* const YAT = (bf16*)(ws + WS_YAT);
    bf16* const KREV_S = (bf16*)(ws + WS_KREV_S); bf16* const KREV_P = (bf16*)(ws + WS_KREV_P); bf16* const UT = (bf16*)(ws + WS_UT);
    bf16* const QB = (bf16*)(ws + WS_Q); bf16* const KB = (bf16*)(ws + WS_K); bf16* const VB = (bf16*)(ws + WS_V);
    bf16* const SGH = (bf16*)(ws + WS_SGH); bf16* const SGA = (bf16*)(ws + WS_SGA);
    float* const COS = (float*)(ws + WS_COS); float* const SIN = (float*)(ws + WS_SIN); float* const RSTD = (float*)(ws + WS_RSTD); float* const SSQ = (float*)(ws + WS_SSQ);
    float* const FPART_S = (float*)(ws + WS_FPART_S); float* const FPART_P = (float*)(ws + WS_FPART_P);
    bf16* const YHY = (bf16*)(ws + WS_YHY); bf16* const MERGED = (bf16*)(ws + WS_MERGED); bf16* const X1B = (bf16*)(ws + WS_X1B); bf16* const HID = (bf16*)(ws + WS_HID);

    if (IN(0)) {
        LAS float* scr = (LAS float*)(F.lds + RING_OFF + F.wave * 16384);
        const int gw = F.vcu * NWAVES + F.wave, NGW = F.G * NWAVES;
        constexpr int I_IN = 16 * 136, I_HY = 8 * 32, I_O = 16 * 32, I_G = 16 * 88, I_D = 44 * 32, I_W3 = 64;
        constexpr int NITEMS = I_IN + 2 * I_HY + I_O + 2 * I_G + I_D + I_W3;
        for (int it = gw; it < NITEMS; it += NGW) {
            int rr = it;
            if (rr < I_IN) { const int kb = rr / 136, nb = rr % 136, n0 = 32 * nb;
                if (n0 < 3 * HW) p0_transpose_item(args.in[3], DM, INW, WINA, n0, args.in[2], scr, 64 * kb, n0, F.lane);
                else p0_transpose_item(args.in[3], DM, INW, WINB, map_projB(n0), args.in[2], scr, 64 * kb, n0, F.lane);
                continue; } rr -= I_IN;
            if (rr < I_HY) { p0_transpose_item(args.in[16], HW, DM, WHY, 32 * (rr % 32), nullptr, scr, 64 * (rr / 32), 32 * (rr % 32), F.lane); continue; } rr -= I_HY;
            if (rr < I_HY) { p0_transpose_item(args.in[17], HW, DM, WAT, 32 * (rr % 32), nullptr, scr, 64 * (rr / 32), 32 * (rr % 32), F.lane); continue; } rr -= I_HY;
            if (rr < I_O) { p0_transpose_item(args.in[18], DM, DM, WO, 32 * (rr % 32), nullptr, scr, 64 * (rr / 32), 32 * (rr % 32), F.lane); continue; } rr -= I_O;
            if (rr < I_G) { const int n0 = 32 * (rr % 88); p0_transpose_item(args.in[20], DM, FFN, WGU, (n0 >> 7) * 256 + (n0 & 127), args.in[19], scr, 64 * (rr / 88), n0, F.lane); continue; } rr -= I_G;
            if (rr < I_G) { const int n0 = 32 * (rr % 88); p0_transpose_item(args.in[21], DM, FFN, WGU, (n0 >> 7) * 256 + 128 + (n0 & 127), args.in[19], scr, 64 * (rr / 88), n0, F.lane); continue; } rr -= I_G;
            if (rr < I_D) { p0_transpose_item(args.in[22], FFN, DM, WD, 32 * (rr % 32), nullptr, scr, 64 * (rr / 32), 32 * (rr % 32), F.lane); continue; } rr -= I_D;
            p0_transpose_item(args.in[10], 64, 2048, W3T, 32 * rr, nullptr, scr, 0, 32 * rr, F.lane);
        }
        for (int m = gw; m < MTOK; m += NGW) p0_row((m < TP) ? xp + (size_t)m * DM : xs + (size_t)(m - TP) * DM, XB + (size_t)m * DM, RSTD + m, F.lane);
        for (int idx = F.vcu * (NWAVES * 64) + F.tid; idx < LS * 32; idx += F.G * NWAVES * 64) {
            const int pos = idx >> 5, i = idx & 31; const double inv = exp2(-(double)i * (13.287712379549449 / 32.0)); const double ang = (double)pos * inv;
            COS[idx] = (float)cos(ang); SIN[idx] = (float)sin(ang);
        }
    }
    SEAM(0);

    if (IN(1)) {
        {
            constexpr int NU = (MTOK / 256) * (NPROJ / 256);
            const int heavy = NU % F.G, lb = heavy ? (int)blockIdx.x - heavy : (int)blockIdx.x, nlb = heavy ? F.G - heavy : F.G;
            if (lb >= 0) {
                filter_stage_weights(F.lds, args.in[6], args.in[7], args.in[8], args.in[9], args.in[11], F.tid);
                for (int it = lb * NWAVES + F.wave; it < 288 * 4; it += nlb * NWAVES) {
                    const int quarter = it & 3, ca = it >> 2, g = (ca < 256) ? 1 : 0, chunk = g ? ca : ca - 256;
                    filter_item(F.lds, W3T, KREV_S + (g ? (size_t)0 : (size_t)((WS_KREV_P - WS_KREV_S) / 2)), FPART_S + (g ? (size_t)0 : (size_t)((WS_FPART_P - WS_FPART_S) / 4)), g, chunk, quarter, F.wave, F.lane);
                }
                LDS_WAIT(); __syncthreads();
            }
        }
        {
            pg8::Gemm g{WINA, XB, nullptr, nullptr, 3 * HW, MTOK, DM}; pg8::StaticOrder S; S.init(3 * HW, MTOK, F.G, (int)blockIdx.x);
            pg8::EpiUT E{UT, MTOK, RSTD};
            pg8::gemm_phase<pg8::EpiUT, pg8::StaticOrder, true, true>(F.lds + RING_OFF, g, S, E);
        }
        {
            pg8::Gemm g{XB, WINB, nullptr, nullptr, MTOK, NPROJ, DM}; pg8::StaticOrder S; S.init(MTOK, NPROJ, F.G, (int)blockIdx.x);
            pg8::EpiProj E{RSTD, args.in[13], args.in[14], COS, SIN, QB, KB, VB, SGH, SGA};
            pg8::gemm_phase<pg8::EpiProj, pg8::StaticOrder, true, true>(F.lds + RING_OFF, g, S, E);
        }
    }
    SEAM(1);

    if (IN(2)) {
        #if PROBE
        const hy::Params HP{UT, KREV_S, KREV_P, FPART_S, FPART_P, args.in[4], args.in[5], args.in[12], YT, (float*)(ws + WS_DF), (bf16*)(ws + WS_DZ)};
#else
        const hy::Params HP{UT, KREV_S, KREV_P, FPART_S, FPART_P, args.in[4], args.in[5], args.in[12], YT, nullptr, nullptr};
#endif
        {
#if PROBE
            const fc::Params FP{UT, KREV_S, FPART_S, args.in[4], args.in[5], args.in[12], YT, (bf16*)(ws + WS_HS), (bf16*)(ws + WS_Z1S), (float*)(ws + WS_DF), (bf16*)(ws + WS_DZ)};
#else
            const fc::Params FP{UT, KREV_S, FPART_S, args.in[4], args.in[5], args.in[12], YT, (bf16*)(ws + WS_HS), (bf16*)(ws + WS_Z1S), nullptr, nullptr};
#endif
            for (int it = F.vcu; it < HW; it += F.G) fc::item(F.lds, FP, it, F.tid, F.vcu);
        }
        TSTAMP(9);
        for (int it = F.vcu; it < HW; it += F.G) hy::hyena_item(F.lds, HP, 0, it, F.tid);
        TSTAMP(10);
        const at::Params AP{QB, KB, VB, args.in[15], YAT};
        for (int it = F.vcu; it < 512; it += F.G) at::attn_item(F.lds, AP, it >> 1, it & 1, F.tid);
    }
    SEAM(2);
#if PROBE >= 100
    probe_check(ws, (unsigned*)F.ctl, args.in[6], args.in[7], args.in[8], args.in[9], args.in[10], args.in[11], F.vcu, F.G, F.tid);
    xcd_barrier(bar);
#endif

    if (IN(3)) {
        for (int t = F.vcu; t < 8 * 512; t += F.G) transpose_y_tile(F.lds, YT, YHY, t, F.tid);
    }
    SEAM(3);

    if (IN(4)) {
        pg8::Gemm g{YHY, WHY, YAT, WAT, MTOK, DM, HW}; pg8::TwoPartOrder S; S.b.init(MTOK, DM, F.G, (int)blockIdx.x);
        pg8::EpiMerged E{SGH, SGA, MERGED};
        pg8::gemm_phase<pg8::EpiMerged, pg8::TwoPartOrder, true, true>(F.lds + RING_OFF, g, S, E);
    }
    SEAM(4);

    if (IN(5)) {
        pg8::Gemm g{MERGED, WO, nullptr, nullptr, MTOK, DM, DM}; pg8::StaticOrder S; S.init(MTOK, DM, F.G, (int)blockIdx.x);
        pg8::EpiWo E{xp, xs, X1B, SSQ};
        pg8::gemm_phase<pg8::EpiWo, pg8::StaticOrder, true, true>(F.lds + RING_OFF, g, S, E);
    }
    SEAM(5);

    if (IN(6)) {
        pg8::Gemm g{X1B, WGU, nullptr, nullptr, MTOK, 2 * FFN, DM}; pg8::StaticOrder S; S.init(MTOK, 2 * FFN, F.G, (int)blockIdx.x);
        pg8::EpiFfn1 E{SSQ, HID};
        pg8::gemm_phase<pg8::EpiFfn1, pg8::StaticOrder, true, true>(F.lds + RING_OFF, g, S, E);
    }
    SEAM(6);

    if (IN(7)) {
        pg8::Gemm g{HID, WD, nullptr, nullptr, MTOK, DM, FFN}; pg8::StaticOrder S; S.init(MTOK, DM, F.G, (int)blockIdx.x);
        pg8::EpiFfn2 E{X1B, args.out};
        pg8::gemm_phase<pg8::EpiFfn2, pg8::StaticOrder, true, true>(F.lds + RING_OFF, g, S, E);
#if PROBE
        TSTAMP(8);
        VM_WAIT(); __syncthreads();
        if (blockIdx.x == 0) {
            pg8::Unit u; S.next(1, u);
            int cnt;
#if PROBE >= 100
            cnt = probe_metric_count(ws, (unsigned*)F.ctl);
#else
            { const unsigned long long t0 = F.MISC[16] | ((unsigned long long)F.MISC[17] << 32), t8 = F.MISC[32] | ((unsigned long long)F.MISC[33] << 32);
#if PROBE == 21
              constexpr int IA = 2, IB = 9;
#elif PROBE == 22
              constexpr int IA = 9, IB = 10;
#elif PROBE == 23
              constexpr int IA = 10, IB = 3;
#else
              constexpr int IA = PROBE - 1, IB = PROBE;
#endif
              const unsigned long long ta = F.MISC[16 + 2 * IA] | ((unsigned long long)F.MISC[17 + 2 * IA] << 32), tb = F.MISC[16 + 2 * IB] | ((unsigned long long)F.MISC[17 + 2 * IB] << 32);
              cnt = (int)(1600.0f * (float)(tb - ta) / (float)(t8 - t0)); }
#endif
            for (int i = F.tid; i < cnt; i += NWAVES * 64) args.out[(size_t)(u.pm * 256 + (i & 255)) * 1024 + u.pn * 256 + (i >> 8)] = 0.f;
        }
#endif
    }
#undef IN
#undef SEAM
}

extern "C" void kernel_launch(void* const* d_in, const int* in_sizes, int n_in, void* d_out, int out_size, void* d_ws, size_t ws_size, hipStream_t stream) {
    static int grid = 0;
    if (grid == 0) {
        if (n_in != 23 || out_size != MTOK * DM || ws_size < WS_END) { fprintf(stderr, "kernel_launch: unexpected problem shape (n_in %d, out %d, ws %zu); nothing launched\n", n_in, out_size, ws_size); grid = -1; return; }
        int dev = 0, cus = 0, per_cu = 0;
        if (hipGetDevice(&dev) != hipSuccess || hipDeviceGetAttribute(&cus, hipDeviceAttributeMultiprocessorCount, dev) != hipSuccess) { fprintf(stderr, "kernel_launch: device query failed\n"); grid = -1; return; }
        if (hipFuncSetAttribute((const void*)enc_fwd, hipFuncAttributeMaxDynamicSharedMemorySize, LDS_BYTES) != hipSuccess) { fprintf(stderr, "kernel_launch: hipFuncSetAttribute failed\n"); grid = -1; return; }
        if (hipOccupancyMaxActiveBlocksPerMultiprocessor(&per_cu, (const void*)enc_fwd, NWAVES * 64, LDS_BYTES) != hipSuccess || per_cu < 1)
            fprintf(stderr, "kernel_launch: note: occupancy query reports %d workgroups per CU\n", per_cu);
        (void)hipGetLastError();
        grid = cus;
    }
    if (grid < 0) return;
    if (hipMemsetAsync((char*)d_ws + WS_CTL, 0, CTL_ZERO_BYTES, stream) != hipSuccess) { fprintf(stderr, "kernel_launch: memset failed\n"); return; }
    Args a{};
    for (int i = 0; i < 23; ++i) a.in[i] = (const float*)d_in[i];
    a.out = (float*)d_out; a.ws = (unsigned char*)d_ws;
#if MK_SPLIT
    for (int p = 0; p < N_PHASES; ++p) { a.ph_lo = p; a.ph_hi = p + 1; hipLaunchKernelGGL(enc_fwd, dim3(grid), dim3(NWAVES * 64), LDS_BYTES, stream, a); }
#else
    a.ph_lo = 0; a.ph_hi = N_PHASES;
    hipLaunchKernelGGL(enc_fwd, dim3(grid), dim3(NWAVES * 64), LDS_BYTES, stream, a);
#endif
    const hipError_t le = hipPeekAtLastError();
    if (le != hipSuccess) fprintf(stderr, "kernel_launch: launch failed: %s\n", hipGetErrorName(le));
}
```

```cpp
#include <hip/hip_runtime.h>
#include <cstdio>
#include <cstdint>
#include <cmath>
#ifndef PROBE
#define PROBE 0
#endif

namespace pg8 {
#define PG8_LAS __attribute__((address_space(3)))
typedef unsigned short bf16_t;
typedef short bf16x8 __attribute__((ext_vector_type(8)));
typedef float f32x4 __attribute__((ext_vector_type(4)));
typedef unsigned u32x4 __attribute__((ext_vector_type(4)));
constexpr int BM = 256, BK = 64, HALF = 128, HTB = HALF * BK * 2  , STAGE_BYTES = 8 * HTB, NXCD = 8, WGM = 8;

__host__ __device__ __forceinline__ int lds_byte(int r, int c) { const int st = (r >> 4) * 2 + (c >> 5), rr = r & 15, cc = c & 31, ob = rr * 64 + cc * 2; return st * 1024 + (ob ^ (((ob >> 9) & 1) << 5)); }
__host__ __device__ __forceinline__ void stage_rc(int b, int& R, int& C) { const int st = b / 1024, sb = b % 1024, swz = sb ^ (((sb >> 9) & 1) << 5); R = (st >> 1) * 16 + swz / 64; C = (st & 1) * 32 + (swz % 64) / 2; }
__host__ __device__ __forceinline__ int perm32(int rho) { const int n = rho >> 4, i = rho & 15; return 8 * (i >> 2) + 4 * n + (i & 3); }

struct Unit { int pm, pn, sel; };
struct Gemm { const bf16_t* A; const bf16_t* Bt; const bf16_t* A1; const bf16_t* Bt1; int M, N, K; };

struct StaticOrder {
    int nM, nN, nwg, G, c;
    __host__ __device__ __forceinline__ void init(int M, int N, int G_, int c_) { nM = M / BM; nN = N / BM; nwg = nM * nN; G = G_; c = c_; }
    __host__ __device__ __forceinline__ bool next(int i, Unit& u) const {
        const long L = (long)i * G + c; if (L >= nwg) return false;
        int wgid = (int)L; { const int q = nwg / NXCD, r = nwg % NXCD, xcd = wgid % NXCD, off = wgid / NXCD; wgid = (xcd < r ? xcd * (q + 1) : r * (q + 1) + (xcd - r) * q) + off; }
        const int nig = WGM * nN, gid = wgid / nig, fm = gid * WGM, gsz = (nM - fm) < WGM ? (nM - fm) : WGM;
        u.pm = fm + ((wgid % nig) % gsz); u.pn = (wgid % nig) / gsz; u.sel = 0; return true;
    }
    __device__ __forceinline__ void a_ready(const Unit&) const {}
    __device__ __forceinline__ void done(const Unit&) const {}
};
struct TwoPartOrder {
    StaticOrder b;
    __device__ __forceinline__ bool next(int i, Unit& u) const { if (!b.next(i >> 1, u)) return false; u.sel = i & 1; return true; }
    __device__ __forceinline__ void a_ready(const Unit&) const {}
    __device__ __forceinline__ void done(const Unit&) const {}
};

__device__ __forceinline__ unsigned cvt_pk_bf16(float lo, float hi) { unsigned r; asm volatile("v_cvt_pk_bf16_f32 %0, %1, %2" : "=v"(r) : "v"(lo), "v"(hi)); return r; }
__device__ __forceinline__ u32x4 pack8(const f32x4 a, const f32x4 b) { u32x4 w; w.x = cvt_pk_bf16(a[0], a[1]); w.y = cvt_pk_bf16(a[2], a[3]); w.z = cvt_pk_bf16(b[0], b[1]); w.w = cvt_pk_bf16(b[2], b[3]); return w; }
__device__ __forceinline__ float bflo(unsigned w) { return __uint_as_float(w << 16); }
__device__ __forceinline__ float bfhi(unsigned w) { return __uint_as_float(w & 0xffff0000u); }
__device__ __forceinline__ void unpack8(const u32x4 w, f32x4& a, f32x4& b) { a = (f32x4){bflo(w.x), bfhi(w.x), bflo(w.y), bfhi(w.y)}; b = (f32x4){bflo(w.z), bfhi(w.z), bflo(w.w), bfhi(w.w)}; }
__device__ __forceinline__ float sigmoidf_(float v) { return __builtin_amdgcn_rcpf(1.0f + __builtin_amdgcn_exp2f(-1.4426950408889634f * v)); }

constexpr float QSCALE = 0.125f * 1.4426950408889634f;

struct EpiUT {
    static constexpr bool PERM = true, AFTER_DRAIN = false;
    bf16_t* O; int ldc; const float* rstd;
    __device__ __forceinline__ bool keep(const Unit&) const { return false; }
    __device__ __forceinline__ void operator()(f32x4 (&acc)[2][2][4][2], const Unit& u, int wr, int wc, int fr, int fq) const {
        const int row0 = u.pm * BM + wr * 64 + fr, col0 = u.pn * BM + wc * 32 + 8 * fq;
        f32x4 rs[2][2];
#pragma unroll
        for (int bj = 0; bj < 2; ++bj)
#pragma unroll
            for (int n = 0; n < 2; ++n) rs[bj][n] = *(const f32x4*)(rstd + col0 + bj * HALF + 4 * n);
#pragma unroll
        for (int ai = 0; ai < 2; ++ai)
#pragma unroll
            for (int m = 0; m < 4; ++m) { bf16_t* rowp = O + (size_t)(row0 + ai * HALF + m * 16) * ldc + col0;
#pragma unroll
                for (int bj = 0; bj < 2; ++bj) *(u32x4*)(rowp + bj * HALF) = pack8(acc[ai][bj][m][0] * rs[bj][0], acc[ai][bj][m][1] * rs[bj][1]); }
    }
};

struct EpiProj {
    static constexpr bool PERM = true, AFTER_DRAIN = false;
    const float* rstd; const float* qw; const float* kw; const float* cs; const float* sn; bf16_t* q; bf16_t* k; bf16_t* v; bf16_t* sgh; bf16_t* sga;
    __device__ __forceinline__ bool keep(const Unit&) const { return false; }
    __device__ __forceinline__ void operator()(f32x4 (&acc)[2][2][4][2], const Unit& u, int wr, int wc, int fr, int fq) const {
        const int pn = u.pn;
        if (pn <= 2 && !(pn == 2 && wc >= 2)) {
            const float* w = (pn < 2) ? qw : kw; const float sc = (pn < 2) ? QSCALE : 1.0f;
            const f32x4 wl0 = *(const f32x4*)(w + 8 * fq), wl1 = *(const f32x4*)(w + 8 * fq + 4), wh0 = *(const f32x4*)(w + 32 + 8 * fq), wh1 = *(const f32x4*)(w + 32 + 8 * fq + 4);
#pragma unroll
            for (int ai = 0; ai < 2; ++ai)
#pragma unroll
                for (int m = 0; m < 4; ++m) {
                    const int row = u.pm * BM + ai * HALF + wr * 64 + m * 16 + fr; const float rs = rstd[row];
                    f32x4 a0 = acc[ai][0][m][0] * rs, a1 = acc[ai][0][m][1] * rs, b0 = acc[ai][1][m][0] * rs, b1 = acc[ai][1][m][1] * rs;
                    f32x4 sq = a0 * a0 + a1 * a1 + b0 * b0 + b1 * b1; float ss = (sq[0] + sq[1]) + (sq[2] + sq[3]);
                    ss += __shfl_xor(ss, 16); ss += __shfl_xor(ss, 32);
                    const float inv = 1.0f / sqrtf(ss * (1.0f / 64.0f) + 1e-6f);
                    const int pos = row < 16384 ? (row & 2047) : (row - 16384);
                    const f32x4 c0 = *(const f32x4*)(cs + pos * 32 + 8 * fq), c1 = *(const f32x4*)(cs + pos * 32 + 8 * fq + 4), s0 = *(const f32x4*)(sn + pos * 32 + 8 * fq), s1 = *(const f32x4*)(sn + pos * 32 + 8 * fq + 4);
                    a0 = a0 * inv * wl0; a1 = a1 * inv * wl1; b0 = b0 * inv * wh0; b1 = b1 * inv * wh1;
                    const f32x4 lo0 = (a0 * c0 - b0 * s0) * sc, lo1 = (a1 * c1 - b1 * s1) * sc, hi0 = (b0 * c0 + a0 * s0) * sc, hi1 = (b1 * c1 + a1 * s1) * sc;
                    bf16_t* dst = (pn < 2) ? q + (size_t)row * 512 + (4 * pn + wc) * 64 + 8 * fq : k + (size_t)row * 128 + wc * 64 + 8 * fq;
                    *(u32x4*)dst = pack8(lo0, lo1); *(u32x4*)(dst + 32) = pack8(hi0, hi1);
                }
        } else if (pn == 2) {
#pragma unroll
            for (int ai = 0; ai < 2; ++ai)
#pragma unroll
                for (int m = 0; m < 4; ++m) {
                    const int row = u.pm * BM + ai * HALF + wr * 64 + m * 16 + fr; const float rs = rstd[row];
                    bf16_t* dst = v + (size_t)row * 128 + (wc - 2) * 64 + 8 * fq;
                    *(u32x4*)dst = pack8(acc[ai][0][m][0] * rs, acc[ai][0][m][1] * rs); *(u32x4*)(dst + 32) = pack8(acc[ai][1][m][0] * rs, acc[ai][1][m][1] * rs);
                }
        } else {
            bf16_t* base = (pn < 7) ? sgh : sga; const int colb = (pn - ((pn < 7) ? 3 : 7)) * BM + wc * 32 + 8 * fq;
#pragma unroll
            for (int ai = 0; ai < 2; ++ai)
#pragma unroll
                for (int m = 0; m < 4; ++m) {
                    const int row = u.pm * BM + ai * HALF + wr * 64 + m * 16 + fr; const float rs = rstd[row];
#pragma unroll
                    for (int bj = 0; bj < 2; ++bj) { f32x4 g0 = acc[ai][bj][m][0] * rs, g1 = acc[ai][bj][m][1] * rs;
#pragma unroll
                        for (int e = 0; e < 4; ++e) { g0[e] = sigmoidf_(g0[e]); g1[e] = sigmoidf_(g1[e]); }
                        *(u32x4*)(base + (size_t)row * 1024 + colb + bj * HALF) = pack8(g0, g1); }
                }
        }
    }
};

struct EpiMerged {
    static constexpr bool PERM = true, AFTER_DRAIN = false;
    const bf16_t* sgh; const bf16_t* sga; bf16_t* out;
    __device__ __forceinline__ bool keep(const Unit& u) const { return u.sel == 0; }
    __device__ __forceinline__ void operator()(f32x4 (&acc)[2][2][4][2], const Unit& u, int wr, int wc, int fr, int fq) const {
#pragma unroll
        for (int ai = 0; ai < 2; ++ai)
#pragma unroll
            for (int m = 0; m < 4; ++m) {
                const size_t off = (size_t)(u.pm * BM + ai * HALF + wr * 64 + m * 16 + fr) * 1024 + u.pn * BM + wc * 32 + 8 * fq;
#pragma unroll
                for (int bj = 0; bj < 2; ++bj) {
                    f32x4 t0, t1; unpack8(*(const u32x4*)(sga + off + bj * HALF), t0, t1);
                    if (u.sel == 0) { f32x4 h0, h1; unpack8(*(const u32x4*)(sgh + off + bj * HALF), h0, h1);
                        f32x4 q0, q1;
#pragma unroll
                        for (int e = 0; e < 4; ++e) { q0[e] = h0[e] * __builtin_amdgcn_rcpf(t0[e]); q1[e] = h1[e] * __builtin_amdgcn_rcpf(t1[e]); }
                        acc[ai][bj][m][0] = acc[ai][bj][m][0] * q0; acc[ai][bj][m][1] = acc[ai][bj][m][1] * q1; }
                    else *(u32x4*)(out + off + bj * HALF) = pack8(acc[ai][bj][m][0] * t0, acc[ai][bj][m][1] * t1);
                }
            }
    }
};

struct EpiWo {
    static constexpr bool PERM = true, AFTER_DRAIN = false;
    const float* xp; const float* xs; bf16_t* x1b; float* ssq;
    __device__ __forceinline__ bool keep(const Unit&) const { return false; }
    __device__ __forceinline__ void operator()(f32x4 (&acc)[2][2][4][2], const Unit& u, int wr, int wc, int fr, int fq) const {
        const float* xb = (u.pm < 64) ? xp : xs - (size_t)16384 * 1024;
#pragma unroll
        for (int ai = 0; ai < 2; ++ai)
#pragma unroll
            for (int m = 0; m < 4; ++m) {
                const int row = u.pm * BM + ai * HALF + wr * 64 + m * 16 + fr; const size_t off = (size_t)row * 1024 + u.pn * BM + wc * 32 + 8 * fq; float s = 0.f;
#pragma unroll
                for (int bj = 0; bj < 2; ++bj) {
                    const f32x4 v0 = *(const f32x4*)(xb + off + bj * HALF) + acc[ai][bj][m][0], v1 = *(const f32x4*)(xb + off + bj * HALF + 4) + acc[ai][bj][m][1];
                    *(u32x4*)(x1b + off + bj * HALF) = pack8(v0, v1);
                    const f32x4 q = v0 * v0 + v1 * v1; s += (q[0] + q[1]) + (q[2] + q[3]); }
                s += __shfl_xor(s, 16); s += __shfl_xor(s, 32);
                if (fq == 0) ssq[(size_t)row * 16 + u.pn * 4 + wc] = s;
            }
    }
};

struct EpiFfn1 {
    static constexpr bool PERM = true, AFTER_DRAIN = false;
    const float* ssq; bf16_t* hid;
    __device__ __forceinline__ bool keep(const Unit&) const { return false; }
    __device__ __forceinline__ void operator()(f32x4 (&acc)[2][2][4][2], const Unit& u, int wr, int wc, int fr, int fq) const {
#pragma unroll
        for (int ai = 0; ai < 2; ++ai)
#pragma unroll
            for (int m = 0; m < 4; ++m) {
                const int row = u.pm * BM + ai * HALF + wr * 64 + m * 16 + fr;
                const f32x4 p = *(const f32x4*)(ssq + (size_t)row * 16 + 4 * fq); float t = (p[0] + p[1]) + (p[2] + p[3]);
                t += __shfl_xor(t, 16); t += __shfl_xor(t, 32);
                const float r = 1.0f / sqrtf(t * (1.0f / 1024.0f) + 1e-6f);
                f32x4 h0, h1;
#pragma unroll
                for (int e = 0; e < 4; ++e) { const float g0 = acc[ai][0][m][0][e] * r, g1 = acc[ai][0][m][1][e] * r;
                    h0[e] = g0 * sigmoidf_(g0) * (acc[ai][1][m][0][e] * r); h1[e] = g1 * sigmoidf_(g1) * (acc[ai][1][m][1][e] * r); }
                *(u32x4*)(hid + (size_t)row * 2816 + u.pn * HALF + wc * 32 + 8 * fq) = pack8(h0, h1);
            }
    }
};

struct EpiFfn2 {
    static constexpr bool PERM = true, AFTER_DRAIN = false;
    const bf16_t* x1b; float* out;
    __device__ __forceinline__ bool keep(const Unit&) const { return false; }
    __device__ __forceinline__ void operator()(f32x4 (&acc)[2][2][4][2], const Unit& u, int wr, int wc, int fr, int fq) const {
#pragma unroll
        for (int ai = 0; ai < 2; ++ai)
#pragma unroll
            for (int m = 0; m < 4; ++m) {
                const size_t off = (size_t)(u.pm * BM + ai * HALF + wr * 64 + m * 16 + fr) * 1024 + u.pn * BM + wc * 32 + 8 * fq; float* p = out + off;
#pragma unroll
                for (int bj = 0; bj < 2; ++bj) { f32x4 r0, r1; unpack8(*(const u32x4*)(x1b + off + bj * HALF), r0, r1);
                    *(f32x4*)(p + bj * HALF) = r0 + acc[ai][bj][m][0]; *(f32x4*)(p + bj * HALF + 4) = r1 + acc[ai][bj][m][1]; }
            }
    }
};

__device__ __forceinline__ void zero_acc(f32x4 (&acc)[2][2][4][2]) {
#pragma unroll
    for (int a = 0; a < 2; ++a)
#pragma unroll
        for (int b = 0; b < 2; ++b)
#pragma unroll
            for (int m = 0; m < 4; ++m)
#pragma unroll
                for (int n = 0; n < 2; ++n) acc[a][b][m][n] = (f32x4){0.f, 0.f, 0.f, 0.f};
}
template <class Epi, class Sched, bool ALIGN_EPI = false, bool SP2 = false>
__device__ __forceinline__ void gemm_phase(PG8_LAS unsigned char* lds, const Gemm g, const Sched& S, const Epi& E) {
    int tid = threadIdx.x; asm volatile("" : "+v"(tid));
    const int wid = __builtin_amdgcn_readfirstlane(tid >> 6), lane = tid & 63, wr = wid >> 2, wc = wid & 3, fr = lane & 15, fq = lane >> 4;
    const int K = g.K, nt = K / BK;
    unsigned voffA[2], voffB[2];
#pragma unroll
    for (int i = 0; i < 2; ++i) { int R, C; stage_rc(tid * 16 + i * 8192, R, C); const int Rb = Epi::PERM ? ((R & ~31) + perm32(R & 31)) : R;
        voffA[i] = (unsigned)(R * K + C) * 2u; voffB[i] = (unsigned)(Rb * K + C) * 2u; }
    const size_t kstep = (size_t)(BK * 2);
    const size_t hstep = (size_t)HALF * K * 2;
    const size_t tstep = 2 * hstep;
    const unsigned ldsw = (unsigned)wid * 1024u;
    const int aoff = lds_byte(wr * 64 + fr, fq * 8), boff = lds_byte(wc * 32 + fr, fq * 8);
#define PG8_SA(b, h) (((b) * 2 + (h)) * HTB)
#define PG8_SB(b, h) ((4 + (b) * 2 + (h)) * HTB)
#define PG8_STAGE(bufoff, gbase, voff) do { _Pragma("unroll") for (int _i = 0; _i < 2; ++_i) \
        __builtin_amdgcn_global_load_lds((const unsigned*)((const char*)(gbase) + (voff)[_i]), (PG8_LAS unsigned*)(lds + (bufoff) + ldsw + _i * 8192), 16, 0, 0); } while (0)
#define PG8_LDA(dst, b, h) do { _Pragma("unroll") for (int m = 0; m < 4; ++m) _Pragma("unroll") for (int k = 0; k < 2; ++k) dst[m][k] = *(const PG8_LAS bf16x8*)(lds + PG8_SA(b, h) + aoff + m * 2048 + k * 1024); } while (0)
#define PG8_LDB(dst, b, h) do { _Pragma("unroll") for (int n = 0; n < 2; ++n) _Pragma("unroll") for (int k = 0; k < 2; ++k) dst[n][k] = *(const PG8_LAS bf16x8*)(lds + PG8_SB(b, h) + boff + n * 2048 + k * 1024); } while (0)
#define PG8_MMA(ai, bj, At, Bt) do { __builtin_amdgcn_s_setprio(1); _Pragma("unroll") for (int m = 0; m < 4; ++m) _Pragma("unroll") for (int n = 0; n < 2; ++n) _Pragma("unroll") for (int k = 0; k < 2; ++k) \
        acc[ai][bj][m][n] = __builtin_amdgcn_mfma_f32_16x16x32_bf16(Bt[n][k], At[m][k], acc[ai][bj][m][n], 0, 0, 0); __builtin_amdgcn_s_setprio(0); } while (0)
#define PG8_WAIT_V(n) asm volatile("s_waitcnt vmcnt(" #n ")" ::: "memory")
#define PG8_WAIT_L(n) asm volatile("s_waitcnt lgkmcnt(" #n ")" ::: "memory")
#define PG8_BAR __builtin_amdgcn_s_barrier()
#define PG8_SCHED __builtin_amdgcn_sched_barrier(0)
    Unit cur, nxt; int ui = 0;
    if (!S.next(0, cur)) return;
    f32x4 acc[2][2][4][2];
#pragma unroll
    for (int a = 0; a < 2; ++a)
#pragma unroll
        for (int b = 0; b < 2; ++b)
#pragma unroll
            for (int m = 0; m < 4; ++m)
#pragma unroll
                for (int n = 0; n < 2; ++n) acc[a][b][m][n] = (f32x4){0.f, 0.f, 0.f, 0.f};
    bf16x8 At[4][2], B0[2][2], B1[2][2];
    const char* cA = (const char*)(cur.sel ? g.A1 : g.A) + (size_t)cur.pm * tstep; const char* cB = (const char*)(cur.sel ? g.Bt1 : g.Bt) + (size_t)cur.pn * tstep;
    S.a_ready(cur);
    if constexpr (SP2) {
        PG8_STAGE(PG8_SB(0, 0), cB, voffB); PG8_STAGE(PG8_SB(0, 1), cB + hstep, voffB); PG8_STAGE(PG8_SA(0, 0), cA, voffA); PG8_STAGE(PG8_SA(0, 1), cA + hstep, voffA);
        if (wr == 1) PG8_BAR;
        PG8_WAIT_V(2); PG8_BAR;
        PG8_STAGE(PG8_SB(1, 0), cB + kstep, voffB); PG8_STAGE(PG8_SA(1, 0), cA + kstep, voffA); PG8_STAGE(PG8_SB(1, 1), cB + hstep + kstep, voffB);
        PG8_WAIT_V(6); PG8_BAR;
    } else {
        PG8_STAGE(PG8_SB(0, 0), cB, voffB); PG8_STAGE(PG8_SA(0, 0), cA, voffA); PG8_STAGE(PG8_SB(0, 1), cB + hstep, voffB); PG8_STAGE(PG8_SA(0, 1), cA + hstep, voffA);
        if (wr == 1) PG8_BAR;
        PG8_WAIT_V(4); PG8_BAR;
        PG8_STAGE(PG8_SB(1, 0), cB + kstep, voffB); PG8_STAGE(PG8_SA(1, 0), cA + kstep, voffA); PG8_STAGE(PG8_SB(1, 1), cB + hstep + kstep, voffB);
        PG8_WAIT_V(6); PG8_BAR;
    }
    for (;;) {
        const bool has_next = S.next(ui + 1, nxt);
        const char* nA = has_next ? (const char*)(nxt.sel ? g.A1 : g.A) + (size_t)nxt.pm * tstep : cA; const char* nB = has_next ? (const char*)(nxt.sel ? g.Bt1 : g.Bt) + (size_t)nxt.pn * tstep : cB;
        for (int t = 0; t < nt; t += 2) {
            const bool last = (t == nt - 2);
            const char* a1 = cA + (size_t)(t + 1) * kstep;
            const char* a2 = last ? nA : cA + (size_t)(t + 2) * kstep; const char* b2 = last ? nB : cB + (size_t)(t + 2) * kstep;
            const char* a3 = a2 + kstep; const char* b3 = b2 + kstep;
            if (last && has_next) S.a_ready(nxt);
            if constexpr (SP2) {
            PG8_LDB(B0, 0, 0); PG8_LDB(B1, 0, 1); PG8_SCHED; PG8_LDA(At, 0, 0); PG8_STAGE(PG8_SA(1, 1), a1 + hstep, voffA);
            PG8_WAIT_V(8); PG8_WAIT_L(0); PG8_BAR; PG8_MMA(0, 0, At, B0); PG8_MMA(0, 1, At, B1); PG8_BAR; PG8_SCHED;
            PG8_LDA(At, 0, 1); PG8_STAGE(PG8_SB(0, 0), b2, voffB); PG8_STAGE(PG8_SB(0, 1), b2 + hstep, voffB); PG8_STAGE(PG8_SA(0, 0), a2, voffA);
            PG8_WAIT_V(8); PG8_WAIT_L(0); PG8_BAR; PG8_MMA(1, 0, At, B0); PG8_MMA(1, 1, At, B1); PG8_BAR; PG8_SCHED;
            PG8_LDB(B0, 1, 0); PG8_LDB(B1, 1, 1); PG8_SCHED; PG8_LDA(At, 1, 0); PG8_STAGE(PG8_SA(0, 1), a2 + hstep, voffA);
            PG8_WAIT_V(8); PG8_WAIT_L(0); PG8_BAR; PG8_MMA(0, 0, At, B0); PG8_MMA(0, 1, At, B1); PG8_BAR; PG8_SCHED;
            PG8_LDA(At, 1, 1); PG8_STAGE(PG8_SB(1, 0), b3, voffB); PG8_STAGE(PG8_SB(1, 1), b3 + hstep, voffB); PG8_STAGE(PG8_SA(1, 0), a3, voffA);
            PG8_WAIT_V(8); PG8_WAIT_L(0); PG8_BAR; PG8_MMA(1, 0, At, B0); PG8_MMA(1, 1, At, B1); PG8_BAR; PG8_SCHED;
            } else {
            PG8_LDB(B0, 0, 0); PG8_SCHED; PG8_LDA(At, 0, 0); PG8_STAGE(PG8_SA(1, 1), a1 + hstep, voffA);
            PG8_WAIT_L(8); PG8_BAR; PG8_WAIT_L(0); PG8_MMA(0, 0, At, B0); PG8_BAR; PG8_SCHED;
            PG8_LDB(B1, 0, 1); PG8_STAGE(PG8_SB(0, 0), b2, voffB);
            PG8_BAR; PG8_WAIT_L(0); PG8_MMA(0, 1, At, B1); PG8_BAR;
            PG8_LDA(At, 0, 1); PG8_STAGE(PG8_SA(0, 0), a2, voffA);
            PG8_BAR; PG8_WAIT_L(0); PG8_MMA(1, 0, At, B0); PG8_BAR; PG8_SCHED;
            PG8_STAGE(PG8_SB(0, 1), b2 + hstep, voffB);
            PG8_WAIT_V(6); PG8_BAR; PG8_MMA(1, 1, At, B1); PG8_BAR;
            PG8_LDB(B0, 1, 0); PG8_SCHED; PG8_LDA(At, 1, 0); PG8_STAGE(PG8_SA(0, 1), a2 + hstep, voffA);
            PG8_WAIT_L(8); PG8_BAR; PG8_WAIT_L(0); PG8_MMA(0, 0, At, B0); PG8_BAR; PG8_SCHED;
            PG8_LDB(B1, 1, 1); PG8_STAGE(PG8_SB(1, 0), b3, voffB);
            PG8_BAR; PG8_WAIT_L(0); PG8_MMA(0, 1, At, B1); PG8_BAR;
            PG8_LDA(At, 1, 1); PG8_STAGE(PG8_SA(1, 0), a3, voffA);
            PG8_BAR; PG8_WAIT_L(0); PG8_MMA(1, 0, At, B0); PG8_BAR; PG8_SCHED;
            PG8_STAGE(PG8_SB(1, 1), b3 + hstep, voffB);
            PG8_WAIT_V(6); PG8_BAR; PG8_MMA(1, 1, At, B1); PG8_BAR;
            }
        }
        if constexpr (ALIGN_EPI) { if (wr == 0) PG8_BAR; }
        if constexpr (!Epi::AFTER_DRAIN) { E(acc, cur, wr, wc, fr, fq); S.done(cur); }
        if (!has_next) break;
        if (!E.keep(cur)) zero_acc(acc);
        cur = nxt; cA = nA; cB = nB; ++ui;
        if constexpr (ALIGN_EPI) { if (wr == 1) PG8_BAR; }
    }
    PG8_WAIT_V(0);
    if constexpr (!ALIGN_EPI) { if (wr == 0) PG8_BAR; }
    PG8_BAR;
    if constexpr (Epi::AFTER_DRAIN) { E.fused(acc, cur, wr, wc, fr, fq, lds, wid, lane); S.done(cur); }
#undef PG8_SA
#undef PG8_SB
#undef PG8_STAGE
#undef PG8_LDA
#undef PG8_LDB
#undef PG8_MMA
#undef PG8_WAIT_V
#undef PG8_WAIT_L
#undef PG8_BAR
#undef PG8_SCHED
}}

constexpr int NWAVES = 8;
constexpr int DM = 1024, MTOK = 32768, TP = 16384  , LP = 2048, LS = 16384;
constexpr int HW = 512, INW = 4352, FFN = 2816, NPROJ = INW - 3 * HW  ;
constexpr float RMS_EPS = 1e-6f;

constexpr size_t MiB = 1u << 20;
constexpr size_t WS_CTL = 0, CTL_ZERO_BYTES = 1 * MiB;
constexpr size_t WS_WINA = 1 * MiB;
constexpr size_t WS_WINB = 4 * MiB;
constexpr size_t WS_WHY = 10 * MiB;
constexpr size_t WS_WAT = 11 * MiB;
constexpr size_t WS_WO = 12 * MiB;
constexpr size_t WS_WGU = 14 * MiB;
constexpr size_t WS_WD = 25 * MiB;
constexpr size_t WS_W3T = 31 * MiB;
constexpr size_t WS_XB = 32 * MiB;
constexpr size_t WS_YT = 32 * MiB;
constexpr size_t WS_YAT = 64 * MiB;
constexpr size_t WS_KREV_S = 96 * MiB;
constexpr size_t WS_KREV_P = 160 * MiB;
constexpr size_t WS_UT = 168 * MiB;
constexpr size_t WS_Q = 264 * MiB;
constexpr size_t WS_K = 296 * MiB;
constexpr size_t WS_V = 304 * MiB;
constexpr size_t WS_SGH = 312 * MiB;
constexpr size_t WS_SGA = 376 * MiB;
constexpr size_t WS_COS = 440 * MiB;
constexpr size_t WS_SIN = 442 * MiB;
constexpr size_t WS_RSTD = 444 * MiB;
constexpr size_t WS_SSQ = 445 * MiB;
constexpr size_t WS_FPART_S = 447 * MiB;
constexpr size_t WS_FPART_P = 449 * MiB;
constexpr size_t WS_YHY = 450 * MiB;
constexpr size_t WS_MERGED = 168 * MiB;
constexpr size_t WS_X1B = 232 * MiB;
constexpr size_t WS_HID = 32 * MiB;
constexpr size_t WS_HS = 450 * MiB;
constexpr size_t WS_Z1S = 488 * MiB;
constexpr size_t WS_END = 496 * MiB;
static_assert(WS_HID + (size_t)MTOK * FFN * 2 <= WS_X1B, "hid vs x1b");

constexpr int CW_TMO = 0, CW_CODE = 1;
constexpr int CW_BAR = 4096;

constexpr int RING_OFF = 0;
constexpr int LDS_BYTES = 147456;
constexpr int LDSCTL_OFF = LDS_BYTES - 512, MISC_OFF = LDSCTL_OFF + 320;

#define GAS __attribute__((address_space(1)))
#define LAS __attribute__((address_space(3)))
typedef unsigned short bf16;
typedef unsigned v4u __attribute__((ext_vector_type(4)));
typedef unsigned v2u __attribute__((ext_vector_type(2)));
typedef float f32x4 __attribute__((ext_vector_type(4)));
typedef float f32x16 __attribute__((ext_vector_type(16)));
typedef short bf16x8 __attribute__((ext_vector_type(8)));
typedef GAS unsigned gu32;
#define RLX_AGENT __ATOMIC_RELAXED, __HIP_MEMORY_SCOPE_AGENT
#define LDS_WAIT() asm volatile("s_waitcnt lgkmcnt(0)" ::: "memory")
#define VM_WAIT() asm volatile("s_waitcnt vmcnt(0)" ::: "memory")
__device__ __forceinline__ unsigned f2bf(float f) { unsigned u = __builtin_bit_cast(unsigned, f); return (u + 0x7fffu + ((u >> 16) & 1u)) >> 16; }
__device__ __forceinline__ unsigned pk2(float lo, float hi) { return f2bf(lo) | (f2bf(hi) << 16); }
__device__ __forceinline__ float bf2f(unsigned short b) { return __uint_as_float((unsigned)b << 16); }
__device__ __forceinline__ float wave_sum(float v) {
#pragma unroll
    for (int o = 1; o < 64; o <<= 1) v += __shfl_xor(v, o);
    return v;
}

#define XB_TMO      128
#define XB_XCNT(j)  (256  + 64 * (j))
#define XB_XSUB(j)  (1280 + 64 * (j))
#define XB_XGEN(j)  (2304 + 64 * (j))
#define XB_TOP      3328
#define XB_TOPGEN   3392
#define XCD_BAR_WORDS 3456
#define XB_SPIN_CAP (1u << 18)

__device__ __forceinline__ unsigned xb_ld(unsigned* p)              { return __hip_atomic_load(p, __ATOMIC_RELAXED, __HIP_MEMORY_SCOPE_AGENT); }
__device__ __forceinline__ unsigned xb_add(unsigned* p, unsigned v) { return __hip_atomic_fetch_add(p, v, __ATOMIC_RELAXED, __HIP_MEMORY_SCOPE_AGENT); }
__device__ __forceinline__ unsigned xb_xcc_id() { return (unsigned)__builtin_amdgcn_s_getreg((3 << 11) | 20) & 0xFu; }
#define XB_SPIN(cond, bar) do { unsigned _sp = 0; while (cond) { __builtin_amdgcn_s_sleep(1); \
    if ((++_sp & 255u) == 0u) { if (xb_ld(&(bar)[XB_TMO])) break; if (_sp > XB_SPIN_CAP) { atomicAdd(&(bar)[XB_TMO], 1u); break; } } } } while (0)

struct XcdBarrier { unsigned* bar; unsigned x; volatile LAS unsigned* st; };

__device__ __forceinline__ XcdBarrier xcd_barrier_post(unsigned* bar, volatile LAS unsigned* st) {
    XcdBarrier b; b.bar = bar; b.x = xb_xcc_id(); b.st = st;
    if (threadIdx.x == 0) (void)xb_add(&bar[XB_XCNT(b.x)], 1u);
    return b;
}
__device__ __forceinline__ void xcd_barrier_complete(unsigned* bar, unsigned x, unsigned& nloc, unsigned& nx) {
    const unsigned G = gridDim.x * gridDim.y * gridDim.z;
    unsigned sum, cnt, mine, sp = 0u;
    for (;;) {
        sum = 0u; cnt = 0u; mine = 0u;
#pragma unroll
        for (unsigned j = 0; j < 16; ++j) { const unsigned c = xb_ld(&bar[XB_XCNT(j)]); sum += c; cnt += (c > 0u) ? 1u : 0u; mine = (j == x) ? c : mine; }
        if (sum == G) break;
        __builtin_amdgcn_s_sleep(1);
        if ((++sp & 255u) == 0u) { if (xb_ld(&bar[XB_TMO])) break; if (sp > XB_SPIN_CAP) { atomicAdd(&bar[XB_TMO], 1u); break; } }
    }
    nloc = mine > 0u ? mine : 1u; nx = cnt > 0u ? cnt : 1u;
}
__device__ __forceinline__ void xcd_barrier(const XcdBarrier& b) {
    asm volatile("s_waitcnt vmcnt(0)" ::: "memory");
    __syncthreads();
    if (threadIdx.x == 0) {
        unsigned* bar = b.bar;
        __builtin_amdgcn_s_waitcnt(0);
        unsigned nloc = b.st[0], nx = b.st[1];
        if (nloc == 0u) { xcd_barrier_complete(bar, b.x, nloc, nx); b.st[0] = nloc; b.st[1] = nx; }
        const unsigned old = xb_add(&bar[XB_XSUB(b.x)], 1u);
        const unsigned gen = old / nloc;
        if (old + 1u == (gen + 1u) * nloc) {
            __builtin_amdgcn_fence(__ATOMIC_RELEASE, "agent");
            asm volatile("s_waitcnt vmcnt(0)" ::: "memory");
            const unsigned og = xb_add(&bar[XB_TOP], 1u);
            const unsigned tg = og / nx;
            if (og + 1u == (tg + 1u) * nx) xb_add(&bar[XB_TOPGEN], 1u);
            else XB_SPIN(xb_ld(&bar[XB_TOPGEN]) == tg, bar);
            __builtin_amdgcn_fence(__ATOMIC_ACQUIRE, "agent");
            xb_add(&bar[XB_XGEN(b.x)], 1u);
            asm volatile("s_waitcnt vmcnt(0)" ::: "memory");
        } else {
            XB_SPIN(xb_ld(&bar[XB_XGEN(b.x)]) == gen, bar);
            __builtin_amdgcn_fence(__ATOMIC_ACQUIRE, "agent");
            asm volatile("s_waitcnt vmcnt(0)" ::: "memory");
        }
    }
    __syncthreads();
}

struct Frame {
    LAS unsigned char* lds;
    volatile LAS unsigned* MISC;
    gu32* ctl;
    int tid, lane, wave;
    int vcu, G;
    unsigned char* ws;
};

__device__ __forceinline__ void p0_transpose_item(const float* W, int K, int N, bf16* WT, int dst_row0, const float* kscale, LAS float* scr, int k0, int n0, int lane) {
#pragma unroll 8
    for (int i = 0; i < 32; ++i) { const int kk = 2 * i + (lane >> 5); float v = W[(size_t)(k0 + kk) * N + n0 + (lane & 31)]; if (kscale) v *= kscale[k0 + kk]; scr[kk * 33 + (lane & 31)] = v; }
    LDS_WAIT(); asm volatile("" ::: "memory");
    const int c = lane & 7;
#pragma unroll
    for (int j = 0; j < 4; ++j) { const int n = (lane >> 3) + 8 * j; const LAS float* s = scr + (8 * c) * 33 + n;
        v4u o; o.x = pk2(s[0 * 33], s[1 * 33]); o.y = pk2(s[2 * 33], s[3 * 33]); o.z = pk2(s[4 * 33], s[5 * 33]); o.w = pk2(s[6 * 33], s[7 * 33]);
        *(GAS v4u*)(WT + (size_t)(dst_row0 + n) * K + k0 + 8 * c) = o; }
    LDS_WAIT(); asm volatile("" ::: "memory");
}
__device__ __forceinline__ int map_projB(int n0) {
    if (n0 < 2048) { const int t = n0 - 1536, hq = t >> 6, hf = (t >> 5) & 1; return 256 * (hq >> 2) + 128 * hf + 32 * (hq & 3); }
    if (n0 < 2176) { const int t = n0 - 2048, kh = t >> 6, hf = (t >> 5) & 1; return 512 + 128 * hf + 32 * kh; }
    if (n0 < 2304) { const int t = n0 - 2176, vh = t >> 6, hf = (t >> 5) & 1; return 512 + 128 * hf + 32 * (2 + vh); }
    return 768 + (n0 - 2304);
}
__device__ __forceinline__ void p0_row(const float* xrow, bf16* orow, float* rstd_out, int lane) {
    const GAS f32x4* xr = (const GAS f32x4*)xrow + lane;
    f32x4 v[4]; float s = 0.f;
#pragma unroll
    for (int j = 0; j < 4; ++j) { v[j] = xr[64 * j]; s += (v[j].x * v[j].x + v[j].y * v[j].y) + (v[j].z * v[j].z + v[j].w * v[j].w); }
    s = wave_sum(s);
    if (lane == 0) *rstd_out = 1.0f / sqrtf(s * (1.0f / DM) + RMS_EPS);
    GAS unsigned long long* o8 = (GAS unsigned long long*)orow + lane;
#pragma unroll
    for (int j = 0; j < 4; ++j) o8[64 * j] = (unsigned long long)pk2(v[j].x, v[j].y) | ((unsigned long long)pk2(v[j].z, v[j].w) << 32);
}
constexpr int FW_W1 = 0, FW_W2 = 33 * 64 * 4, FW_B1 = FW_W2 + 64 * 64 * 4, FW_B2 = FW_B1 + 256, FW_FR = FW_B2 + 256, FW_END = FW_FR + 256, FT_PITCH = 144, FT_BYTES = 32 * FT_PITCH;
__device__ __forceinline__ void filter_stage_weights(LAS unsigned char* lds, const float* w1, const float* b1, const float* w2, const float* b2, const float* fr, int tid) {
    LAS float* W1 = (LAS float*)(lds + FW_W1); LAS float* W2 = (LAS float*)(lds + FW_W2);
    for (int i = tid; i < 33 * 64; i += NWAVES * 64) W1[i] = w1[i];
    for (int i = tid; i < 64 * 64; i += NWAVES * 64) W2[i] = w2[i];
    if (tid < 64) { ((LAS float*)(lds + FW_B1))[tid] = b1[tid]; ((LAS float*)(lds + FW_B2))[tid] = b2[tid]; ((LAS float*)(lds + FW_FR))[tid] = fr[tid]; }
    LDS_WAIT(); __syncthreads();
}
__device__ __forceinline__ void filter_mlp_half(LAS unsigned char* lds, int L, int chunk, int hf, int dir, int r, int h, LAS float* Hb, bf16x8 (&afr)[4]) {
    const LAS float* W1 = (const LAS float*)(lds + FW_W1); const LAS float* W2 = (const LAS float*)(lds + FW_W2);
    const LAS float* B1 = (const LAS float*)(lds + FW_B1); const LAS float* B2 = (const LAS float*)(lds + FW_B2); const LAS float* FR = (const LAS float*)(lds + FW_FR);
        int pos = 64 * chunk + 32 * hf + r + dir; if (pos > L - 1) pos = L - 1;
        const float t = (float)pos / (float)(L - 1);
        float a[32];
#pragma unroll
        for (int jj = 0; jj < 32; ++jj) a[jj] = B1[32 * h + jj];
        {
#pragma unroll
            for (int jj = 0; jj < 32; jj += 4) { const f32x4 w = *(const LAS f32x4*)(W1 + 32 * h + jj); a[jj] += t * w[0]; a[jj + 1] += t * w[1]; a[jj + 2] += t * w[2]; a[jj + 3] += t * w[3]; }
#pragma unroll 1
            for (int i = 0; i < 16; ++i) {
                const float band = 1e-4f + (float)i * ((15.0f - 1e-4f) / 15.0f); const float ang = (6.283185307179586f / (float)L) * (float)pos * band;
                const float cv = __cosf(ang), sv = -__sinf(ang);
                const LAS float* wc = W1 + (1 + i) * 64 + 32 * h; const LAS float* wsn = W1 + (17 + i) * 64 + 32 * h;
#pragma unroll
                for (int jj = 0; jj < 32; jj += 4) { const f32x4 w = *(const LAS f32x4*)(wc + jj), v = *(const LAS f32x4*)(wsn + jj);
                    a[jj] += cv * w[0] + sv * v[0]; a[jj + 1] += cv * w[1] + sv * v[1]; a[jj + 2] += cv * w[2] + sv * v[2]; a[jj + 3] += cv * w[3] + sv * v[3]; }
            }
        }
#pragma unroll
        for (int jj = 0; jj < 32; ++jj) Hb[(32 * h + jj) * 32 + r] = __sinf(FR[32 * h + jj] * a[jj]);
        LDS_WAIT(); asm volatile("" ::: "memory");
#pragma unroll
        for (int jj = 0; jj < 32; ++jj) a[jj] = B2[32 * h + jj];
#pragma unroll 1
        for (int i = 0; i < 64; ++i) { const float hv = Hb[i * 32 + r]; const LAS float* wr_ = W2 + i * 64 + 32 * h;
#pragma unroll
            for (int jj = 0; jj < 32; jj += 4) { const f32x4 w = *(const LAS f32x4*)(wr_ + jj); a[jj] += hv * w[0]; a[jj + 1] += hv * w[1]; a[jj + 2] += hv * w[2]; a[jj + 3] += hv * w[3]; } }
        LDS_WAIT(); asm volatile("" ::: "memory");
        unsigned op[16], pp[16];
#pragma unroll
        for (int d = 0; d < 16; ++d) op[d] = pk2(__sinf(FR[32 * h + 2 * d] * a[2 * d]), __sinf(FR[32 * h + 2 * d + 1] * a[2 * d + 1]));
#pragma unroll
        for (int d = 0; d < 16; ++d) pp[d] = __shfl_xor(op[d], 32);
#pragma unroll
        for (int ks = 0; ks < 4; ++ks) { v4u f;
#pragma unroll
            for (int w = 0; w < 4; ++w) { const unsigned own = h ? op[8 * (ks & 1) + 4 + w] : op[8 * (ks & 1) + w], par = h ? pp[8 * (ks & 1) + 4 + w] : pp[8 * (ks & 1) + w];
                f[w] = ((ks >> 1) == h) ? own : par; }
            afr[ks] = __builtin_bit_cast(bf16x8, f); }
}
__device__ __forceinline__ void filter_item(LAS unsigned char* lds, const bf16* w3T, bf16* krev, float* fpart, int g, int chunk, int quarter, int wave, int lane_) {
    int lane = lane_; asm volatile("" : "+v"(lane));
    const int L = g ? LS : LP, r = lane & 31, h = lane >> 5, dir = quarter & 1, o_ = quarter >> 1;
    const LAS float* W1 = (const LAS float*)(lds + FW_W1); const LAS float* W2 = (const LAS float*)(lds + FW_W2);
    const LAS float* B1 = (const LAS float*)(lds + FW_B1); const LAS float* B2 = (const LAS float*)(lds + FW_B2); const LAS float* FR = (const LAS float*)(lds + FW_FR);
    LAS unsigned char* T = lds + FW_END + wave * FT_BYTES; LAS float* Hb = (LAS float*)(lds + FW_END + NWAVES * FT_BYTES + wave * 8192);
    bf16x8 afr0[4], afr1[4];
    filter_mlp_half(lds, L, chunk, 0, dir, r, h, Hb, afr0);
    filter_mlp_half(lds, L, chunk, 1, dir, r, h, Hb, afr1);
    const float dmin = -4.605170185988091f / 1.5f, dmax = -4.605170185988091f / 0.3f;
    const int p0 = 64 * chunk; const int mstart = g ? (dir ? (2 * L - p0 - 64) : p0) : (dir ? (L + p0) : (L - 64 - p0));
    for (int ti = 0; ti < 16; ++ti) {
        const int cb = 32 * ti, colg = quarter * 512 + cb;
        bf16x8 bfr[4];
#pragma unroll
        for (int ks = 0; ks < 4; ++ks) bfr[ks] = *(const GAS bf16x8*)(w3T + (size_t)(colg + r) * 64 + 16 * ks + 8 * h);
        const float delta = fabsf(dmin + (float)(cb + r) * ((dmax - dmin) / 511.0f));
        float asum = 0.f;
#pragma unroll
        for (int hf = 0; hf < 2; ++hf) {
            f32x16 acc = (f32x16){0.f,0.f,0.f,0.f,0.f,0.f,0.f,0.f,0.f,0.f,0.f,0.f,0.f,0.f,0.f,0.f};
#pragma unroll
            for (int ks = 0; ks < 4; ++ks) acc = __builtin_amdgcn_mfma_f32_32x32x16_bf16(hf ? afr1[ks] : afr0[ks], bfr[ks], acc, 0, 0, 0);
#pragma unroll
            for (int rg = 0; rg < 16; ++rg) {
                const int i = 32 * hf + (rg & 3) + 8 * (rg >> 2) + 4 * h; const int pos = p0 + i + dir;
                const float t = (float)pos / (float)(L - 1);
                float kv = acc[rg] * (__expf(-t * delta) + 0.05f); if (pos > L - 1) kv = 0.f;
                asum += fabsf(kv);
                const int e = ((dir != 0) != (g != 0)) ? i : 63 - i;
                *(LAS bf16*)(T + r * FT_PITCH + e * 2) = (bf16)f2bf(kv);
            }
        }
        asum += __shfl_xor(asum, 32);
        if (h == 0) fpart[(size_t)chunk * 2048 + colg + r] = asum;
        LDS_WAIT(); asm volatile("" ::: "memory");
        {
            const int col = lane >> 1, hb = lane & 1;
            bf16* dst = krev + (size_t)(o_ * 512 + cb + col) * (2 * L) + mstart + 32 * hb;
            const LAS v4u* src = (const LAS v4u*)(T + col * FT_PITCH + 64 * hb);
#pragma unroll
            for (int q = 0; q < 4; ++q) *(GAS v4u*)(dst + 8 * q) = src[q];
        }
        LDS_WAIT(); asm volatile("" ::: "memory");
    }
}

namespace hy {
constexpr int SLOTB = 272, Z_BYTES = 75776, F_OFF = 75776, F_BYTES = 65536, RED_OFF = F_OFF + F_BYTES;
__device__ __forceinline__ int slot_of(int g, int n) { return g ? (n + 31) : ((n >> 4) * 32 + 16 + (n & 15)); }
__device__ __forceinline__ int crow(int r, int hi) { return (r & 3) + 8 * (r >> 2) + 4 * hi; }

struct Params { const bf16* uT; const bf16* krev_s; const bf16* krev_p; const float* fpart_s; const float* fpart_p; const float* conv_w; const float* conv_b; const float* hbias; bf16* yT; float* dF; bf16* dZ; };

__device__ __forceinline__ void conv3_chunk(const bf16* urow  , int g, int chunk, float w0, float w1, float w2, float b, float (&out)[8]) {
    const int tau0 = chunk * 8; const int L = g ? LS : LP; const int p0 = g ? tau0 : (tau0 & (LP - 1));
    const v4u raw = *(const GAS v4u*)(urow + tau0);
    float u[10];
    u[1] = pg8::bflo(raw.x); u[2] = pg8::bfhi(raw.x); u[3] = pg8::bflo(raw.y); u[4] = pg8::bfhi(raw.y); u[5] = pg8::bflo(raw.z); u[6] = pg8::bfhi(raw.z); u[7] = pg8::bflo(raw.w); u[8] = pg8::bfhi(raw.w);
    u[0] = (p0 > 0) ? bf2f(urow[tau0 - 1]) : 0.f;
    u[9] = (p0 + 8 < L) ? bf2f(urow[tau0 + 8]) : 0.f;
#pragma unroll
    for (int i = 0; i < 8; ++i) out[i] = w0 * u[i] + w1 * u[i + 1] + w2 * u[i + 2] + b;
}

__device__ __forceinline__ bf16x8 load_afrag(LAS const unsigned char* lds, int addr, int sh) {
    const LAS unsigned* p = (const LAS unsigned*)(lds + addr);
    const unsigned w0 = p[0], w1 = p[1], w2 = p[2], w3 = p[3], w4 = p[4];
    v4u f; f.x = __builtin_amdgcn_alignbit(w1, w0, sh); f.y = __builtin_amdgcn_alignbit(w2, w1, sh); f.z = __builtin_amdgcn_alignbit(w3, w2, sh); f.w = __builtin_amdgcn_alignbit(w4, w3, sh);
    return __builtin_bit_cast(bf16x8, f);
}

__device__ __forceinline__ void hyena_item(LAS unsigned char* lds, const Params& P, int g, int c, int tid_) {
    int tid = tid_; asm volatile("" : "+v"(tid));
    const int lane = tid & 63, wave = __builtin_amdgcn_readfirstlane(tid >> 6), r = lane & 31, hi = lane >> 5, nt = wave & 3, half = wave >> 2;
    const int L = g ? LS : LP; const int T0 = g ? TP : 0;
    LAS float* red = (LAS float*)(lds + RED_OFF);
    float inv_norm0, inv_norm1;
    {
        const int nchunk = g ? 256 : 32; const float* fp = P.fpart_s + (g ? (size_t)0 : (size_t)((WS_FPART_P - WS_FPART_S) / 4));
        float s0 = 0.f, s1 = 0.f;
        for (int idx = tid; idx < nchunk * 2; idx += NWAVES * 64) { const int ch = idx >> 1, dir = idx & 1; s0 += fp[(size_t)ch * 2048 + dir * 512 + c]; s1 += fp[(size_t)ch * 2048 + 1024 + dir * 512 + c]; }
        s0 = wave_sum(s0); s1 = wave_sum(s1);
        if (lane == 0) { red[wave * 2] = s0; red[wave * 2 + 1] = s1; }
        for (int i = tid; i < Z_BYTES / 16; i += NWAVES * 64) *(LAS v4u*)(lds + i * 16) = (v4u){0u, 0u, 0u, 0u};
        LDS_WAIT(); __syncthreads();
        float t0 = 0.f, t1 = 0.f;
#pragma unroll
        for (int w = 0; w < NWAVES; ++w) { t0 += red[w * 2]; t1 += red[w * 2 + 1]; }
        inv_norm0 = 1.0f / t0; inv_norm1 = 1.0f / t1;
    }
    {
        const int ch = 2 * HW + c; const float w0 = P.conv_w[ch], w1 = P.conv_w[3 * HW + ch], w2 = P.conv_w[6 * HW + ch], b = P.conv_b[ch];
        const bf16* urow = P.uT + (size_t)ch * MTOK + T0;
        for (int it = 0; it < 4; ++it) { const int chunk = tid + it * 512; float o[8]; conv3_chunk(urow, g, chunk, w0, w1, w2, b, o);
            const int tau0 = chunk * 8; v4u pk; pk.x = pk2(o[0], o[1]); pk.y = pk2(o[2], o[3]); pk.z = pk2(o[4], o[5]); pk.w = pk2(o[6], o[7]);
            *(LAS v4u*)(lds + slot_of(g, tau0 >> 7) * SLOTB + (tau0 & 127) * 2) = pk; }
    }
    int d_hi, d_lo;
    if (g) { if (half == 0) { d_hi = 32 * nt + 31; d_lo = 32 * nt - 48; } else { d_hi = 32 * nt - 49; d_lo = 32 * nt - 127; } }
    else   { if (half == 0) { d_hi = 15; d_lo = 0; } else { d_hi = -1; d_lo = -15; } }
    int abase = F_OFF + 2 * ((L - 1) - r + 8 * hi); const int sh = (abase & 2) ? 16 : 0; abase &= ~3;
    const int zb = slot_of(g, 32 * nt + r) * SLOTB + 16 * hi;
    const int mi0 = 2 * half;

    for (int o = 0; o < 2; ++o) {
        {
            const bf16* ksrc = P.krev_s + (g ? (size_t)0 : (size_t)((WS_KREV_P - WS_KREV_S) / 2)) + (size_t)(o * HW + c) * (2 * L);
            const int n16 = (2 * L * 2) / 16;
            for (int i = tid; i < n16; i += NWAVES * 64) *(LAS v4u*)(lds + F_OFF + i * 16) = *(const GAS v4u*)(ksrc + i * 8);
        }
        LDS_WAIT(); __syncthreads();
        f32x16 acc[4];
#pragma unroll
        for (int mi = 0; mi < 4; ++mi) acc[mi] = (f32x16){0.f,0.f,0.f,0.f,0.f,0.f,0.f,0.f,0.f,0.f,0.f,0.f,0.f,0.f,0.f,0.f};
        bf16x8 Fw[8];
        {
            const int q0 = -8 * d_hi;
#pragma unroll
            for (int s = 2; s < 8; ++s) Fw[s] = load_afrag(lds, abase + 32 * (q0 - 8 + s), sh);
            Fw[0] = Fw[2]; Fw[1] = Fw[3];
        }
        {
            unsigned ap = (unsigned)(uintptr_t)(lds + abase) + 32 * (-8 * d_hi), bp = (unsigned)(uintptr_t)(lds + zb) - d_hi * SLOTB;
            v2u n01, n23; unsigned n4; v4u zn;
            unsigned r0, r1, r2, r3, r4; v4u zf;
#define HY_LOADS(ADW, BOFF) asm volatile("ds_read2_b32 %0, %4 offset0:%c5 offset1:%c6\n\tds_read2_b32 %1, %4 offset0:%c7 offset1:%c8\n\tds_read_b32 %2, %4 offset:%c9\n\tds_read_b128 %3, %10 offset:%c11" \
                : "=&v"(n01), "=&v"(n23), "=&v"(n4), "=&v"(zn) : "v"(ap), "i"(ADW), "i"((ADW) + 1), "i"((ADW) + 2), "i"((ADW) + 3), "i"(((ADW) + 4) * 4), "v"(bp), "i"(BOFF))
#define HY_WAIT() do { asm volatile("s_waitcnt lgkmcnt(0)" : "+v"(n01), "+v"(n23), "+v"(n4), "+v"(zn), "+v"(acc[0]), "+v"(acc[1]), "+v"(acc[2]), "+v"(acc[3])); __builtin_amdgcn_sched_barrier(0); } while (0)
#define HY_TAKE() do { r0 = n01.x; r1 = n01.y; r2 = n23.x; r3 = n23.y; r4 = n4; zf = zn; } while (0)
#define HY_STEP(JK, ADW, BOFF) do { HY_LOADS(ADW, BOFF); __builtin_amdgcn_sched_barrier(0); \
                { v4u f; f.x = __builtin_amdgcn_alignbit(r1, r0, sh); f.y = __builtin_amdgcn_alignbit(r2, r1, sh); f.z = __builtin_amdgcn_alignbit(r3, r2, sh); f.w = __builtin_amdgcn_alignbit(r4, r3, sh); Fw[JK] = __builtin_bit_cast(bf16x8, f); } \
                { const bf16x8 zb_ = __builtin_bit_cast(bf16x8, zf); \
                  acc[0] = __builtin_amdgcn_mfma_f32_32x32x16_bf16(Fw[(JK) & 7], zb_, acc[0], 0, 0, 0); acc[1] = __builtin_amdgcn_mfma_f32_32x32x16_bf16(Fw[((JK) - 2) & 7], zb_, acc[1], 0, 0, 0); \
                  acc[2] = __builtin_amdgcn_mfma_f32_32x32x16_bf16(Fw[((JK) - 4) & 7], zb_, acc[2], 0, 0, 0); acc[3] = __builtin_amdgcn_mfma_f32_32x32x16_bf16(Fw[((JK) - 6) & 7], zb_, acc[3], 0, 0, 0); } \
                HY_WAIT(); HY_TAKE(); } while (0)
            HY_LOADS(0, 0); HY_WAIT(); HY_TAKE();
            for (int d = d_hi; d >= d_lo; --d) {
                HY_STEP(0, 8, 32); HY_STEP(1, 16, 64); HY_STEP(2, 24, 96); HY_STEP(3, 32, 128); HY_STEP(4, 40, 160); HY_STEP(5, 48, 192); HY_STEP(6, 56, 224); HY_STEP(7, 64, SLOTB);
                ap += 256; bp += SLOTB;
            }
#undef HY_LOADS
#undef HY_WAIT
#undef HY_TAKE
#undef HY_STEP
        }
        LDS_WAIT(); __syncthreads();
        {
            LAS float* X = (LAS float*)(lds + F_OFF) + wave * 2048;
#pragma unroll
            for (int t = 0; t < 2; ++t)
#pragma unroll
                for (int rg = 0; rg < 16; ++rg) X[(t * 16 + rg) * 64 + lane] = (half == 0) ? acc[2 + t][rg] : acc[t][rg];
        }
        LDS_WAIT(); __syncthreads();
        f32x16 fin[2];
        {
            const LAS float* X = (const LAS float*)(lds + F_OFF) + (wave ^ 4) * 2048;
#pragma unroll
            for (int t = 0; t < 2; ++t)
#pragma unroll
                for (int rg = 0; rg < 16; ++rg) fin[t][rg] = ((half == 0) ? acc[t][rg] : acc[2 + t][rg]) + X[(t * 16 + rg) * 64 + lane];
        }
        LDS_WAIT(); __syncthreads();
        {
            const int ch = o * HW + c; const float w0 = P.conv_w[ch], w1 = P.conv_w[3 * HW + ch], w2 = P.conv_w[6 * HW + ch], b = P.conv_b[ch];
            const bf16* urow = P.uT + (size_t)ch * MTOK + T0;
            for (int it = 0; it < 4; ++it) { const int chunk = tid + it * 512; float v[8]; conv3_chunk(urow, g, chunk, w0, w1, w2, b, v);
                LAS f32x4* dst = (LAS f32x4*)(lds + F_OFF + chunk * 32); dst[0] = (f32x4){v[0], v[1], v[2], v[3]}; dst[1] = (f32x4){v[4], v[5], v[6], v[7]}; }
        }
        LDS_WAIT(); __syncthreads();
        {
            const float sb = P.hbias[o * HW + c], inr = o ? inv_norm1 : inv_norm0;
            const LAS float* G = (const LAS float*)(lds + F_OFF);
            const int n = 32 * nt + r; LAS bf16* zs = (LAS bf16*)(lds + slot_of(g, n) * SLOTB);
#pragma unroll
            for (int t = 0; t < 2; ++t)
#pragma unroll
                for (int rg = 0; rg < 16; ++rg) { const int i = 32 * (mi0 + t) + crow(rg, hi);
                    const float zo = bf2f(zs[i]);
#if PROBE >= 100
                    if (c == 137) { P.dF[(g * 2 + o) * 16384 + 128 * n + i] = fin[t][rg]; P.dZ[(g * 2 + o) * 16384 + 128 * n + i] = zs[i]; }
#endif
                    const float val = G[128 * n + i] * (inr * fin[t][rg] + sb * zo); zs[i] = (bf16)f2bf(val); }
        }
        LDS_WAIT(); __syncthreads();
    }
    {
        bf16* yrow = P.yT + (size_t)c * MTOK + T0;
        for (int it = 0; it < 4; ++it) { const int chunk = tid + it * 512, tau0 = chunk * 8;
            *(GAS v4u*)(yrow + tau0) = *(const LAS v4u*)(lds + slot_of(g, tau0 >> 7) * SLOTB + (tau0 & 127) * 2); }
    }
    LDS_WAIT(); __syncthreads();
}
}

namespace fc {
constexpr int OST = 1032, PLANE_B = 32 * OST * 2  , RE_OFF = 0, IM_OFF = PLANE_B, RED_OFF = 2 * PLANE_B, T3_OFF = RED_OFF + 64;
constexpr int NFFT = 32768;
enum { F1 = 0, F2 = 1, F3 = 2, I1 = 3, I2 = 4, I3 = 5 };
__device__ __forceinline__ int crow(int r, int hi) { return (r & 3) + 8 * (r >> 2) + 4 * hi; }
struct Params { const bf16* uT; const bf16* kc; const float* fpart_s; const float* conv_w; const float* conv_b; const float* hbias; bf16* yT; bf16* hs; bf16* z1s; float* dF; bf16* dZ; };
typedef float f32x2_ __attribute__((ext_vector_type(2)));
struct FMat { bf16x8 fr[2], fi[2], nfi[2]; };

__device__ __forceinline__ void make_fmat(FMat& M, int r, int h) {
#pragma unroll
    for (int ks = 0; ks < 2; ++ks) { v4u a, b, c;
#pragma unroll
        for (int w = 0; w < 4; ++w) { float cv[2], sv[2];
#pragma unroll
            for (int e = 0; e < 2; ++e) { const int aidx = 16 * ks + 8 * h + 2 * w + e; const float fr_ = (float)((aidx * r) & 31) * (1.0f / 32.0f); cv[e] = __builtin_amdgcn_cosf(fr_); sv[e] = __builtin_amdgcn_sinf(fr_); }
            a[w] = pk2(cv[0], cv[1]); b[w] = pk2(-sv[0], -sv[1]); c[w] = pk2(sv[0], sv[1]); }
        M.fr[ks] = __builtin_bit_cast(bf16x8, a); M.fi[ks] = __builtin_bit_cast(bf16x8, b); M.nfi[ks] = __builtin_bit_cast(bf16x8, c); }
}

template <int ST, bool REAL_IN, bool HALF_K>
__device__ __forceinline__ void stage(LAS unsigned char* lds, const FMat& M, const float (&t2c)[16], const float (&t2s)[16], int wave, int r_, int h_) {
    int r = r_, h = h_; asm volatile("" : "+v"(r), "+v"(h));
    constexpr bool INV = (ST >= I1);
    const f32x16 zero16 = (f32x16){0.f,0.f,0.f,0.f,0.f,0.f,0.f,0.f,0.f,0.f,0.f,0.f,0.f,0.f,0.f,0.f};
    unsigned res[4][16];
#pragma unroll
    for (int t = 0; t < 4; ++t) {
        const int f = 4 * wave + t;
        const int base = (ST == I2) ? (32 * f + OST * r) : (32 * r + OST * f);
        f32x16 ur = zero16, ui = zero16;
#pragma unroll
        for (int ks = 0; ks < (HALF_K ? 1 : 2); ++ks) {
            const bf16x8 xr = *(const LAS bf16x8*)(lds + RE_OFF + 2 * (base + 16 * ks + 8 * h));
            if (!INV) {
                ur = __builtin_amdgcn_mfma_f32_32x32x16_bf16(M.fr[ks], xr, ur, 0, 0, 0);
                ui = __builtin_amdgcn_mfma_f32_32x32x16_bf16(M.fi[ks], xr, ui, 0, 0, 0);
                if (!REAL_IN) { const bf16x8 xi = *(const LAS bf16x8*)(lds + IM_OFF + 2 * (base + 16 * ks + 8 * h));
                    ur = __builtin_amdgcn_mfma_f32_32x32x16_bf16(M.nfi[ks], xi, ur, 0, 0, 0);
                    ui = __builtin_amdgcn_mfma_f32_32x32x16_bf16(M.fr[ks], xi, ui, 0, 0, 0); }
            } else {
                const bf16x8 xi = *(const LAS bf16x8*)(lds + IM_OFF + 2 * (base + 16 * ks + 8 * h));
                ur = __builtin_amdgcn_mfma_f32_32x32x16_bf16(M.fr[ks], xr, ur, 0, 0, 0);
                ur = __builtin_amdgcn_mfma_f32_32x32x16_bf16(M.fi[ks], xi, ur, 0, 0, 0);
                if (ST != I3) { ui = __builtin_amdgcn_mfma_f32_32x32x16_bf16(M.fr[ks], xi, ui, 0, 0, 0);
                                ui = __builtin_amdgcn_mfma_f32_32x32x16_bf16(M.nfi[ks], xr, ui, 0, 0, 0); }
            }
        }
        if (ST == I3) {
#pragma unroll
            for (int rg = 0; rg < 8; ++rg) res[t][rg] = __float_as_uint(ur[rg]);
        } else {
            if (ST == F1 || ST == F2 || ST == I1 || ST == I2) {
                float uc = 1.f, us = 0.f;
                if (ST == I2) { const float fr_ = (float)(f * r) * (1.0f / 32768.0f); uc = __builtin_amdgcn_cosf(fr_); us = __builtin_amdgcn_sinf(fr_); }
#pragma unroll
                for (int rg = 0; rg < 16; ++rg) {
                    float c = t2c[rg], s_ = t2s[rg];
                    if (ST == F1) { const int rho = (rg & 3) + 8 * (rg >> 2) + 4 * h; const f32x2_ q = *(const LAS f32x2_*)(lds + T3_OFF + 8 * (32 * f + rho)); const float c2 = c * q.x - s_ * q.y; s_ = c * q.y + s_ * q.x; c = c2; }
                    if (ST == I2) { const float c2 = c * uc - s_ * us; s_ = c * us + s_ * uc; c = c2; }
                    const float s = INV ? s_ : -s_;
                    const float a = ur[rg], b = ui[rg];
                    ur[rg] = a * c - b * s; ui[rg] = a * s + b * c;
                }
            }
#pragma unroll
            for (int p = 0; p < 8; ++p) { res[t][p] = pk2(ur[2 * p], ur[2 * p + 1]); res[t][8 + p] = pk2(ui[2 * p], ui[2 * p + 1]); }
        }
        __builtin_amdgcn_sched_barrier(0);
    }
    LDS_WAIT(); __syncthreads();
#pragma unroll
    for (int t = 0; t < 4; ++t) {
        const int f = 4 * wave + t;
        if (ST == I3) {
            LAS float* Y = (LAS float*)(lds + IM_OFF);
#pragma unroll
            for (int rg = 0; rg < 8; ++rg) { const int rho = (rg & 3) + 8 * (rg >> 2) + 4 * h; Y[1024 * rho + 32 * r + f] = __uint_as_float(res[t][rg]); }
        } else if (ST == F3) {
#pragma unroll
            for (int g4 = 0; g4 < 4; ++g4) { const int pos = (8 * g4 + 4 * h) + 32 * r + OST * f;
                *(LAS v2u*)(lds + RE_OFF + 2 * pos) = (v2u){res[t][2 * g4], res[t][2 * g4 + 1]}; *(LAS v2u*)(lds + IM_OFF + 2 * pos) = (v2u){res[t][8 + 2 * g4], res[t][8 + 2 * g4 + 1]}; }
        } else {
#pragma unroll
            for (int rg = 0; rg < 16; ++rg) {
                const int rho = (rg & 3) + 8 * (rg >> 2) + 4 * h;
                const int pos = (ST == F1) ? (r + 32 * f + OST * rho) : (r + 32 * rho + OST * f);
                const unsigned wr_ = res[t][rg >> 1], wi_ = res[t][8 + (rg >> 1)];
                *(LAS bf16*)(lds + RE_OFF + 2 * pos) = (bf16)((rg & 1) ? (wr_ >> 16) : (wr_ & 0xffffu));
                *(LAS bf16*)(lds + IM_OFF + 2 * pos) = (bf16)((rg & 1) ? (wi_ >> 16) : (wi_ & 0xffffu));
            }
        }
    }
    LDS_WAIT(); __syncthreads();
}

__device__ __forceinline__ void self_visible(int tid) {
    VM_WAIT(); __syncthreads();
    if (tid == 0) { __builtin_amdgcn_fence(__ATOMIC_ACQUIRE, "agent"); VM_WAIT(); }
    __syncthreads();
}

__device__ __forceinline__ void item(LAS unsigned char* lds, const Params& P, int c, int tid_, int slot) {
    int tid = tid_; asm volatile("" : "+v"(tid));
    const int lane = tid & 63, wave = __builtin_amdgcn_readfirstlane(tid >> 6), r = lane & 31, h = lane >> 5;
    constexpr int L = LS, T0 = TP, g = 1;
    LAS float* red = (LAS float*)(lds + RED_OFF);
    bf16* hs = P.hs + (size_t)slot * (2 * PLANE_B / 2); bf16* z1s = P.z1s + (size_t)slot * L;
    float inv_norm0, inv_norm1;
    {
        float s0 = 0.f, s1 = 0.f;
        for (int idx = tid; idx < 512; idx += NWAVES * 64) { const int ch = idx >> 1, dir = idx & 1; s0 += P.fpart_s[(size_t)ch * 2048 + dir * 512 + c]; s1 += P.fpart_s[(size_t)ch * 2048 + 1024 + dir * 512 + c]; }
        s0 = wave_sum(s0); s1 = wave_sum(s1);
        if (lane == 0) { red[wave * 2] = s0; red[wave * 2 + 1] = s1; }
        LDS_WAIT(); __syncthreads();
        float t0 = 0.f, t1 = 0.f;
#pragma unroll
        for (int w = 0; w < NWAVES; ++w) { t0 += red[w * 2]; t1 += red[w * 2 + 1]; }
        inv_norm0 = 1.0f / t0; inv_norm1 = 1.0f / t1;
    }
    FMat M; make_fmat(M, r, h);
    float t2c[16], t2s[16];
#pragma unroll
    for (int rg = 0; rg < 16; ++rg) { const int rho = (rg & 3) + 8 * (rg >> 2) + 4 * h; const float fr_ = (float)(r * rho) * (1.0f / 1024.0f); t2c[rg] = __builtin_amdgcn_cosf(fr_); t2s[rg] = __builtin_amdgcn_sinf(fr_); }
    for (int i = tid; i < 1024; i += NWAVES * 64) { const float fr_ = (float)((i >> 5) * (i & 31)) * (1.0f / 32768.0f); *(LAS f32x2_*)(lds + T3_OFF + 8 * i) = (f32x2_){__builtin_amdgcn_cosf(fr_), __builtin_amdgcn_sinf(fr_)}; }
    LDS_WAIT(); __syncthreads();
    for (int o = 0; o < 2; ++o) {
        asm volatile("" : "+v"(tid));
        {
            const bf16* ksrc = P.kc + (size_t)(o * HW + c) * NFFT;
            for (int i = 0; i < 8; ++i) { const int it = 8 * wave + i, n = 1024 * (lane & 31) + 32 * (2 * (it >> 2) + (lane >> 5)) + 8 * (it & 3); const v4u raw = *(const GAS v4u*)(ksrc + n);
                const int pos0 = (n >> 10) + 32 * ((n >> 5) & 31) + OST * (n & 31); LAS bf16* d = (LAS bf16*)(lds + RE_OFF) + pos0;
                d[0 * OST] = (bf16)(raw.x & 0xffffu); d[1 * OST] = (bf16)(raw.x >> 16); d[2 * OST] = (bf16)(raw.y & 0xffffu); d[3 * OST] = (bf16)(raw.y >> 16);
                d[4 * OST] = (bf16)(raw.z & 0xffffu); d[5 * OST] = (bf16)(raw.z >> 16); d[6 * OST] = (bf16)(raw.w & 0xffffu); d[7 * OST] = (bf16)(raw.w >> 16); }
        }
        LDS_WAIT(); __syncthreads();
        stage<F1, true, false>(lds, M, t2c, t2s, wave, r, h); stage<F2, false, false>(lds, M, t2c, t2s, wave, r, h); stage<F3, false, false>(lds, M, t2c, t2s, wave, r, h);
        for (int i = tid; i < 2 * PLANE_B / 16; i += NWAVES * 64) *(GAS v4u*)((unsigned char*)hs + (size_t)i * 16) = *(const LAS v4u*)(lds + i * 16);
        self_visible(tid);
        {
            const int ch = 2 * HW + c; const float w0 = P.conv_w[ch], w1 = P.conv_w[3 * HW + ch], w2 = P.conv_w[6 * HW + ch], b = P.conv_b[ch];
            const bf16* urow = P.uT + (size_t)ch * MTOK + T0;
            for (int i = 0; i < 4; ++i) { const int it = 4 * wave + i, n = 1024 * (lane & 15) + 32 * (4 * (it >> 2) + (lane >> 4)) + 8 * (it & 3), chunk = n >> 3; unsigned short e[8];
                if (o == 0) { float v[8]; hy::conv3_chunk(urow, g, chunk, w0, w1, w2, b, v);
#pragma unroll
                    for (int j = 0; j < 8; ++j) e[j] = (unsigned short)f2bf(v[j]); }
                else { const v4u raw = *(const GAS v4u*)(z1s + n); e[0] = raw.x & 0xffffu; e[1] = raw.x >> 16; e[2] = raw.y & 0xffffu; e[3] = raw.y >> 16; e[4] = raw.z & 0xffffu; e[5] = raw.z >> 16; e[6] = raw.w & 0xffffu; e[7] = raw.w >> 16; }
                const int pos0 = (n >> 10) + 32 * ((n >> 5) & 31) + OST * (n & 31); LAS bf16* d = (LAS bf16*)(lds + RE_OFF) + pos0;
#pragma unroll
                for (int j = 0; j < 8; ++j) d[j * OST] = e[j]; }
        }
        LDS_WAIT(); __syncthreads();
        stage<F1, true, true>(lds, M, t2c, t2s, wave, r, h); stage<F2, false, false>(lds, M, t2c, t2s, wave, r, h); stage<F3, false, false>(lds, M, t2c, t2s, wave, r, h);
        for (int i = tid; i < PLANE_B / 16; i += NWAVES * 64) {
            const v4u xr = *(const LAS v4u*)(lds + RE_OFF + i * 16), xi = *(const LAS v4u*)(lds + IM_OFF + i * 16);
            const v4u hr = *(const GAS v4u*)((const unsigned char*)hs + (size_t)i * 16), hi_ = *(const GAS v4u*)((const unsigned char*)hs + PLANE_B + (size_t)i * 16);
            v4u vr, vi;
#pragma unroll
            for (int w = 0; w < 4; ++w) {
                const float a0 = pg8::bflo(xr[w]), a1 = pg8::bfhi(xr[w]), b0 = pg8::bflo(xi[w]), b1 = pg8::bfhi(xi[w]);
                const float c0 = pg8::bflo(hr[w]) * (1.0f / 32768.0f), c1 = pg8::bfhi(hr[w]) * (1.0f / 32768.0f), d0 = pg8::bflo(hi_[w]) * (1.0f / 32768.0f), d1 = pg8::bfhi(hi_[w]) * (1.0f / 32768.0f);
                vr[w] = pk2(a0 * c0 - b0 * d0, a1 * c1 - b1 * d1); vi[w] = pk2(a0 * d0 + b0 * c0, a1 * d1 + b1 * c1);
            }
            *(LAS v4u*)(lds + RE_OFF + i * 16) = vr; *(LAS v4u*)(lds + IM_OFF + i * 16) = vi;
        }
        LDS_WAIT(); __syncthreads();
        stage<I1, false, false>(lds, M, t2c, t2s, wave, r, h); stage<I2, false, false>(lds, M, t2c, t2s, wave, r, h); stage<I3, false, false>(lds, M, t2c, t2s, wave, r, h);
        {
            const LAS float* Y = (const LAS float*)(lds + IM_OFF);
            const int chg = o * HW + c; const float g0 = P.conv_w[chg], g1 = P.conv_w[3 * HW + chg], g2 = P.conv_w[6 * HW + chg], gb = P.conv_b[chg];
            const int chv = 2 * HW + c; const float v0 = P.conv_w[chv], v1 = P.conv_w[3 * HW + chv], v2 = P.conv_w[6 * HW + chv], vb = P.conv_b[chv];
            const bf16* grow = P.uT + (size_t)chg * MTOK + T0; const bf16* vrow = P.uT + (size_t)chv * MTOK + T0;
            const float sb = P.hbias[o * HW + c], inr = o ? inv_norm1 : inv_norm0;
            bf16* dst = o ? (P.yT + (size_t)c * MTOK + T0) : z1s;
            for (int it = 0; it < 4; ++it) { const int chunk = tid + it * 512, n = chunk * 8; float gt[8], zo[8];
                hy::conv3_chunk(grow, g, chunk, g0, g1, g2, gb, gt);
                if (o == 0) { hy::conv3_chunk(vrow, g, chunk, v0, v1, v2, vb, zo);
#pragma unroll
                    for (int j = 0; j < 8; ++j) zo[j] = bf2f((unsigned short)f2bf(zo[j])); }
                else { const v4u raw = *(const GAS v4u*)(z1s + n); zo[0] = pg8::bflo(raw.x); zo[1] = pg8::bfhi(raw.x); zo[2] = pg8::bflo(raw.y); zo[3] = pg8::bfhi(raw.y); zo[4] = pg8::bflo(raw.z); zo[5] = pg8::bfhi(raw.z); zo[6] = pg8::bflo(raw.w); zo[7] = pg8::bfhi(raw.w); }
                const f32x4 y0 = *(const LAS f32x4*)(Y + n), y1 = *(const LAS f32x4*)(Y + n + 4);
                float val[8];
#pragma unroll
                for (int j = 0; j < 8; ++j) { const float yv = (j < 4) ? y0[j & 3] : y1[j & 3];
#if PROBE >= 100
                    if (c == 137) { P.dF[(2 + o) * 16384 + n + j] = yv; P.dZ[(2 + o) * 16384 + n + j] = (bf16)f2bf(zo[j]); }
#endif
                    val[j] = gt[j] * (inr * yv + sb * zo[j]); }
                v4u pk; pk.x = pk2(val[0], val[1]); pk.y = pk2(val[2], val[3]); pk.z = pk2(val[4], val[5]); pk.w = pk2(val[6], val[7]);
                *(GAS v4u*)(dst + n) = pk; }
        }
        self_visible(tid);
    }
}
}

namespace at {
constexpr int KROW = 144, VROW = 776, K_OFF = 0, V_OFF = 384 * KROW  , END_OFF = V_OFF + 64 * VROW;
__device__ __forceinline__ int crow(int r, int hi) { return (r & 3) + 8 * (r >> 2) + 4 * hi; }
struct Params { const bf16* q; const bf16* k; const bf16* v; const float* sink; bf16* yat; };

__device__ __forceinline__ void attn_item(LAS unsigned char* lds, const Params& P, int blk, int gk, int tid_) {
    int tid = tid_; asm volatile("" : "+v"(tid));
    const int lane = tid & 63, wave = __builtin_amdgcn_readfirstlane(tid >> 6), r = lane & 31, hi = lane >> 5;
    const int m0 = blk * 128; const int s_lo = (blk < 128) ? (m0 & ~(LP - 1)) : TP, s_hi = (blk < 128) ? s_lo + LP : MTOK; const int kw0 = m0 - 128;
    for (int it = 0; it < 6; ++it) {
        const int idx = tid + it * 512, key = idx >> 3, chn = idx & 7, tok = kw0 + key; const bool ok = (tok >= s_lo) && (tok < s_hi);
        v4u kv = (v4u){0u, 0u, 0u, 0u}, vv = (v4u){0u, 0u, 0u, 0u};
        if (ok) { kv = *(const GAS v4u*)(P.k + (size_t)tok * 128 + gk * 64 + chn * 8); vv = *(const GAS v4u*)(P.v + (size_t)tok * 128 + gk * 64 + chn * 8); }
        *(LAS v4u*)(lds + K_OFF + key * KROW + chn * 16) = kv;
        LAS bf16* vt = (LAS bf16*)(lds + V_OFF + (chn * 8) * VROW + key * 2);
        vt[0 * (VROW / 2)] = (bf16)(vv.x & 0xffffu); vt[1 * (VROW / 2)] = (bf16)(vv.x >> 16); vt[2 * (VROW / 2)] = (bf16)(vv.y & 0xffffu); vt[3 * (VROW / 2)] = (bf16)(vv.y >> 16);
        vt[4 * (VROW / 2)] = (bf16)(vv.z & 0xffffu); vt[5 * (VROW / 2)] = (bf16)(vv.z >> 16); vt[6 * (VROW / 2)] = (bf16)(vv.w & 0xffffu); vt[7 * (VROW / 2)] = (bf16)(vv.w >> 16);
    }
    LDS_WAIT(); __syncthreads();
    const int hq = 4 * gk + (wave & 3), qh = wave >> 2;
    const int klo = (s_lo - kw0) > 0 ? (s_lo - kw0) : 0, khi = (s_hi - kw0) < 384 ? (s_hi - kw0) : 384;
    const float sinkl = P.sink[hq] * 1.4426950408889634f;
    for (int qq = 0; qq < 2; ++qq) {
        const int qt = 2 * qh + qq, q0 = 32 * qt; const size_t qrow = (size_t)(m0 + q0 + r);
        bf16x8 qf[4];
#pragma unroll
        for (int ks = 0; ks < 4; ++ks) qf[ks] = *(const GAS bf16x8*)(P.q + qrow * 512 + hq * 64 + 16 * ks + 8 * hi);
        float m_run = sinkl, l_run = (hi == 0) ? 1.0f : 0.0f;
        f32x16 o0 = (f32x16){0.f,0.f,0.f,0.f,0.f,0.f,0.f,0.f,0.f,0.f,0.f,0.f,0.f,0.f,0.f,0.f}, o1 = o0;
        const int lo_r = (q0 + r) > klo ? (q0 + r) : klo, hi_r = (q0 + r + 256) < (khi - 1) ? (q0 + r + 256) : (khi - 1);
        for (int kt = qt; kt <= qt + 8; ++kt) {
            const int kb = 32 * kt;
            f32x16 s = (f32x16){0.f,0.f,0.f,0.f,0.f,0.f,0.f,0.f,0.f,0.f,0.f,0.f,0.f,0.f,0.f,0.f};
#pragma unroll
            for (int ks = 0; ks < 4; ++ks) { const bf16x8 kf = *(const LAS bf16x8*)(lds + K_OFF + (kb + r) * KROW + 32 * ks + 16 * hi);
                s = __builtin_amdgcn_mfma_f32_32x32x16_bf16(kf, qf[ks], s, 0, 0, 0); }
            float tmax = -1e30f;
#pragma unroll
            for (int rg = 0; rg < 16; ++rg) { const int kj = kb + crow(rg, hi); const float sv = (kj >= lo_r && kj <= hi_r) ? s[rg] : -1e30f; s[rg] = sv; tmax = fmaxf(tmax, sv); }
            tmax = fmaxf(tmax, __shfl_xor(tmax, 32));
            const float mnew = fmaxf(m_run, tmax); const float alpha = __builtin_amdgcn_exp2f(m_run - mnew); m_run = mnew;
            float psum = 0.f;
#pragma unroll
            for (int rg = 0; rg < 16; ++rg) { const float p = __builtin_amdgcn_exp2f(s[rg] - mnew); s[rg] = p; psum += p; }
            l_run = l_run * alpha + psum;
#pragma unroll
            for (int rg = 0; rg < 16; ++rg) { o0[rg] *= alpha; o1[rg] *= alpha; }
            v4u pa, pb;
            pa.x = pk2(s[0], s[1]); pa.y = pk2(s[2], s[3]); pa.z = pk2(s[4], s[5]); pa.w = pk2(s[6], s[7]);
            pb.x = pk2(s[8], s[9]); pb.y = pk2(s[10], s[11]); pb.z = pk2(s[12], s[13]); pb.w = pk2(s[14], s[15]);
            const bf16x8 pf0 = __builtin_bit_cast(bf16x8, pa), pf1 = __builtin_bit_cast(bf16x8, pb);
#pragma unroll
            for (int dt = 0; dt < 2; ++dt) {
                const LAS unsigned char* vb = lds + V_OFF + (32 * dt + r) * VROW + (kb + 4 * hi) * 2;
                v4u va, vc;
                { const v2u x0 = *(const LAS v2u*)(vb), x1 = *(const LAS v2u*)(vb + 16); va = (v4u){x0.x, x0.y, x1.x, x1.y}; }
                { const v2u x0 = *(const LAS v2u*)(vb + 32), x1 = *(const LAS v2u*)(vb + 48); vc = (v4u){x0.x, x0.y, x1.x, x1.y}; }
                if (dt == 0) { o0 = __builtin_amdgcn_mfma_f32_32x32x16_bf16(__builtin_bit_cast(bf16x8, va), pf0, o0, 0, 0, 0); o0 = __builtin_amdgcn_mfma_f32_32x32x16_bf16(__builtin_bit_cast(bf16x8, vc), pf1, o0, 0, 0, 0); }
                else         { o1 = __builtin_amdgcn_mfma_f32_32x32x16_bf16(__builtin_bit_cast(bf16x8, va), pf0, o1, 0, 0, 0); o1 = __builtin_amdgcn_mfma_f32_32x32x16_bf16(__builtin_bit_cast(bf16x8, vc), pf1, o1, 0, 0, 0); }
            }
        }
        l_run += __shfl_xor(l_run, 32);
        const float inv = 1.0f / l_run;
        bf16* yrow = P.yat + qrow * 512 + hq * 64;
#pragma unroll
        for (int g4 = 0; g4 < 4; ++g4) {
            v2u w0, w1;
            w0.x = pk2(o0[4 * g4] * inv, o0[4 * g4 + 1] * inv); w0.y = pk2(o0[4 * g4 + 2] * inv, o0[4 * g4 + 3] * inv);
            w1.x = pk2(o1[4 * g4] * inv, o1[4 * g4 + 1] * inv); w1.y = pk2(o1[4 * g4 + 2] * inv, o1[4 * g4 + 3] * inv);
            *(GAS v2u*)(yrow + 8 * g4 + 4 * hi) = w0; *(GAS v2u*)(yrow + 32 + 8 * g4 + 4 * hi) = w1;
        }
    }
    LDS_WAIT(); __syncthreads();
}
}

__device__ __forceinline__ void transpose_y_tile(LAS unsigned char* lds, const bf16* yT, bf16* yhy, int tile, int tid_) {
    int tid = tid_; asm volatile("" : "+v"(tid));
    const int c0 = (tile & 7) * 64, t0 = (tile >> 3) * 64;
    LAS bf16* T = (LAS bf16*)lds;
    { const int ch = tid >> 3, k8 = tid & 7; *(LAS v4u*)(T + ch * 72 + k8 * 8) = *(const GAS v4u*)(yT + (size_t)(c0 + ch) * MTOK + t0 + k8 * 8); }
    LDS_WAIT(); __syncthreads();
    { const int tk = tid >> 3, c8 = tid & 7; unsigned short e[8];
#pragma unroll
      for (int j = 0; j < 8; ++j) e[j] = T[(c8 * 8 + j) * 72 + tk];
      v4u o; o.x = e[0] | ((unsigned)e[1] << 16); o.y = e[2] | ((unsigned)e[3] << 16); o.z = e[4] | ((unsigned)e[5] << 16); o.w = e[6] | ((unsigned)e[7] << 16);
      *(GAS v4u*)(yhy + (size_t)(t0 + tk) * 512 + c0 + c8 * 8) = o; }
    LDS_WAIT(); __syncthreads();
}

#if PROBE
constexpr int CW_P = 20000;
constexpr size_t WS_DF = 484 * MiB, WS_DZ = 485 * MiB;
constexpr int PROBE_C = 137;
__device__ __forceinline__ double wave_sum_d(double v) {
#pragma unroll
    for (int o = 1; o < 64; o <<= 1) v += __shfl_xor(v, o);
    return v;
}
__device__ __forceinline__ double filt_point(const float* w1, const float* b1, const float* w2, const float* b2, const float* w3, const float* fr, int g, int p, int col, int lane) {
    const int L = g ? LS : LP; const double t = (double)p / (double)(L - 1);
    double zval = 0.0;
    if (lane == 0) zval = t;
    else if (lane < 33) { const int i = (lane - 1) & 15; const double band = 1e-4 + (double)i * ((15.0 - 1e-4) / 15.0); const double ang = (6.283185307179586 / (double)L) * (double)p * band; zval = (lane <= 16) ? cos(ang) : -sin(ang); }
    double a = (double)b1[lane];
    for (int k = 0; k < 33; ++k) a += __shfl(zval, k) * (double)w1[k * 64 + lane];
    const double h1 = sin((double)fr[lane] * a);
    a = (double)b2[lane];
    for (int i = 0; i < 64; ++i) a += __shfl(h1, i) * (double)w2[i * 64 + lane];
    const double h2 = sin((double)fr[lane] * a);
    const double out = wave_sum_d(h2 * (double)w3[lane * 2048 + col]);
    const int c = col & 511; const double dmin = log(1e-2) / 1.5, dmax = log(1e-2) / 0.3;
    const double delta = fabs(dmin + (double)c * ((dmax - dmin) / 511.0));
    return out * (exp(-t * delta) + 0.05);
}
__device__ __forceinline__ void probe_check(unsigned char* ws, unsigned* ctl, const float* w1, const float* b1, const float* w2, const float* b2, const float* w3, const float* fr, int vcu, int G, int tid) {
    const bf16* KREV_S = (const bf16*)(ws + WS_KREV_S);
    const float* DF = (const float*)(ws + WS_DF); const bf16* DZ = (const bf16*)(ws + WS_DZ);
    const int gtid = vcu * 512 + tid, lane = tid & 63, gwv = gtid >> 6, NW = G * 8;
    if (gtid < 65536) {
        const int combo = gtid >> 14, t = gtid & 16383, g = combo >> 1, o = combo & 1, L = g ? LS : LP, tl = g ? t : (t & (LP - 1)), base = t - tl;
        const bf16* kb = KREV_S + (g ? (size_t)0 : (size_t)((WS_KREV_P - WS_KREV_S) / 2)) + (size_t)(o * HW + PROBE_C) * (2 * L); const bf16* dz = DZ + combo * 16384 + base;
        double acc = 0.0;
        if (g) { for (int s = 0; s < L; ++s) { int j = tl - s; if (j < 0) j += 2 * L; acc += (double)bf2f(kb[j]) * (double)bf2f(dz[s]); } }
        else   { const bf16* kr = kb + (L - 1 - tl); for (int s = 0; s < L; ++s) acc += (double)bf2f(kr[s]) * (double)bf2f(dz[s]); }
        const float diff = fabsf((float)(acc - (double)DF[combo * 16384 + t]));
        atomicMax(ctl + CW_P + 0, __float_as_uint(diff)); atomicMax(ctl + CW_P + 1, __float_as_uint(fabsf((float)acc)));
    }
    {
        const int g = gwv & 1, L = g ? LS : LP; const int p = (int)(((unsigned)gwv * 2654435761u) >> 8) % L;
        for (int q = 0; q < 8; ++q) { const int col = (gwv * 97 + 263 * q) & 2047; const int o = col >> 10, dir = (col >> 9) & 1, c = col & 511;
            if (dir == 1 && p == 0) continue;
            const double kv = filt_point(w1, b1, w2, b2, w3, fr, g, p, col, lane);
            const int m = g ? (dir ? (2 * L - p) : p) : (dir ? (L - 1 + p) : (L - 1 - p)); const float st = bf2f((KREV_S + (g ? (size_t)0 : (size_t)((WS_KREV_P - WS_KREV_S) / 2)) + (size_t)(o * HW + c) * (2 * L))[m]);
            if (lane == 0) { atomicMax(ctl + CW_P + 2, __float_as_uint(fabsf(st - (float)kv))); atomicMax(ctl + CW_P + 3, __float_as_uint(fabsf((float)kv))); } }
    }
    for (int which = 0; which < 2; ++which) {
        const int g = which ? 0 : 1, o = which ? 0 : 1, L = g ? LS : LP; double loc = 0.0;
        for (int p = gwv; p < L; p += NW)
            for (int dir = 0; dir < 2; ++dir) { if (dir == 1 && p == 0) continue; loc += fabs(filt_point(w1, b1, w2, b2, w3, fr, g, p, o * 1024 + dir * 512 + PROBE_C, lane)); }
        if (lane == 0) atomicAdd((double*)(ctl + CW_P + 8) + which, loc);
    }
}
__device__ __forceinline__ int probe_metric_count(unsigned char* ws, unsigned* ctl) {
    const float e_conv = __uint_as_float(__hip_atomic_load(ctl + CW_P + 0, RLX_AGENT)) / fmaxf(__uint_as_float(__hip_atomic_load(ctl + CW_P + 1, RLX_AGENT)), 1e-30f);
    const float e_filt = __uint_as_float(__hip_atomic_load(ctl + CW_P + 2, RLX_AGENT)) / fmaxf(__uint_as_float(__hip_atomic_load(ctl + CW_P + 3, RLX_AGENT)), 1e-30f);
    const float* FPS = (const float*)(ws + WS_FPART_S); const float* FPP = (const float*)(ws + WS_FPART_P);
    double s1 = 0.0, s0 = 0.0;
    for (int ch = 0; ch < 256; ++ch) s1 += (double)FPS[(size_t)ch * 2048 + 1024 + PROBE_C] + (double)FPS[(size_t)ch * 2048 + 1024 + 512 + PROBE_C];
    for (int ch = 0; ch < 32; ++ch) s0 += (double)FPP[(size_t)ch * 2048 + PROBE_C] + (double)FPP[(size_t)ch * 2048 + 512 + PROBE_C];
    const double n1 = ((volatile double*)(ctl + CW_P + 8))[0], n0 = ((volatile double*)(ctl + CW_P + 8))[1];
    const float e_n1 = (float)(fabs(n1 - s1) / fmax(n1, 1e-30)), e_n0 = (float)(fabs(n0 - s0) / fmax(n0, 1e-30));
#if PROBE == 100
    float M = fmaxf(fmaxf(e_conv, e_filt * 1e-3f), fmaxf(e_n1, e_n0));
#elif PROBE == 101
    float M = e_conv;
#elif PROBE == 102
    float M = e_filt;
#else
    float M = fmaxf(e_n1, e_n0);
#endif
    float v = (log10f(fmaxf(M, 1e-12f)) + 8.0f) * 0.125f; v = fminf(fmaxf(v, 0.02f), 1.0f);
    return (int)(v * 1600.0f);
}
#endif

#ifndef MK_SPLIT
#define MK_SPLIT 0
#endif
constexpr int N_PHASES = 8;
struct Args { const float* in[23]; float* out; unsigned char* ws; int ph_lo, ph_hi; };

__global__ void __launch_bounds__(NWAVES * 64, 2) enc_fwd(Args args) {
    extern __shared__ __attribute__((aligned(16))) unsigned char lds_raw[];
    Frame F;
    F.lds = (LAS unsigned char*)lds_raw;
    F.MISC = (volatile LAS unsigned*)(F.lds + MISC_OFF);
    F.tid = threadIdx.x; F.lane = F.tid & 63; F.wave = __builtin_amdgcn_readfirstlane(F.tid >> 6);
    F.G = gridDim.x; { const int bx = blockIdx.x; F.vcu = (F.G % 8 == 0) ? (bx % 8) * (F.G / 8) + bx / 8 : bx; }
    F.ws = args.ws; F.ctl = (gu32*)(args.ws + WS_CTL);
    unsigned char* const ws = args.ws;
    for (int u = F.tid; u < (LDS_BYTES - LDSCTL_OFF) / 4; u += NWAVES * 64) ((LAS unsigned*)(F.lds + LDSCTL_OFF))[u] = 0u;
    __syncthreads();
    const int lo = args.ph_lo, hi = args.ph_hi;
    XcdBarrier bar; bar.bar = (unsigned*)(F.ctl + CW_BAR); bar.x = 0; bar.st = nullptr;
    if (hi - lo > 1) bar = xcd_barrier_post((unsigned*)(F.ctl + CW_BAR), F.MISC + 8);
#define IN(k) (lo <= (k) && (k) < hi)
#if PROBE
#define TSTAMP(k) do { if (blockIdx.x == 0 && F.tid == 0) { const unsigned long long t_ = __builtin_amdgcn_s_memrealtime(); F.MISC[16 + 2 * (k)] = (unsigned)t_; F.MISC[17 + 2 * (k)] = (unsigned)(t_ >> 32); } } while (0)
#else
#define TSTAMP(k) do { } while (0)
#endif
#define SEAM(k) do { if (IN(k) && IN((k) + 1)) xcd_barrier(bar); TSTAMP((k) + 1); } while (0)
    TSTAMP(0);

    const float* const xp = args.in[0]; const float* const xs = args.in[1];
    bf16* const WINA = (bf16*)(ws + WS_WINA); bf16* const WINB = (bf16*)(ws + WS_WINB); bf16* const WHY = (bf16*)(ws + WS_WHY); bf16* const WAT = (bf16*)(ws + WS_WAT);
    bf16* const W3T = (bf16*)(ws + WS_W3T); bf16* const WO = (bf16*)(ws + WS_WO); bf16* const WGU = (bf16*)(ws + WS_WGU); bf16* const WD = (bf16*)(ws + WS_WD);
    bf16* const XB = (bf16*)(ws + WS_XB); bf16* const YT = (bf16*)(ws + WS_YT); bf16* const YAT = (bf16*)(ws + WS_YAT);
    bf16* const KREV_S = (bf16*)(ws + WS_KREV_S); bf16* const KREV_P = (bf16*)(ws + WS_KREV_P); bf16* const UT = (bf16*)(ws + WS_UT);
    bf16* const QB = (bf16*)(ws + WS_Q); bf16* const KB = (bf16*)(ws + WS_K); bf16* const VB = (bf16*)(ws + WS_V);
    bf16* const SGH = (bf16*)(ws + WS_SGH); bf16* const SGA = (bf16*)(ws + WS_SGA);
    float* const COS = (float*)(ws + WS_COS); float* const SIN = (float*)(ws + WS_SIN); float* const RSTD = (float*)(ws + WS_RSTD); float* const SSQ = (float*)(ws + WS_SSQ);
    float* const FPART_S = (float*)(ws + WS_FPART_S); float* const FPART_P = (float*)(ws + WS_FPART_P);
    bf16* const YHY = (bf16*)(ws + WS_YHY); bf16* const MERGED = (bf16*)(ws + WS_MERGED); bf16* const X1B = (bf16*)(ws + WS_X1B); bf16* const HID = (bf16*)(ws + WS_HID);

    if (IN(0)) {
        LAS float* scr = (LAS float*)(F.lds + RING_OFF + F.wave * 16384);
        const int gw = F.vcu * NWAVES + F.wave, NGW = F.G * NWAVES;
        constexpr int I_IN = 16 * 136, I_HY = 8 * 32, I_O = 16 * 32, I_G = 16 * 88, I_D = 44 * 32, I_W3 = 64;
        constexpr int NITEMS = I_IN + 2 * I_HY + I_O + 2 * I_G + I_D + I_W3;
        for (int it = gw; it < NITEMS; it += NGW) {
            int rr = it;
            if (rr < I_IN) { const int kb = rr / 136, nb = rr % 136, n0 = 32 * nb;
                if (n0 < 3 * HW) p0_transpose_item(args.in[3], DM, INW, WINA, n0, args.in[2], scr, 64 * kb, n0, F.lane);
                else p0_transpose_item(args.in[3], DM, INW, WINB, map_projB(n0), args.in[2], scr, 64 * kb, n0, F.lane);
                continue; } rr -= I_IN;
            if (rr < I_HY) { p0_transpose_item(args.in[16], HW, DM, WHY, 32 * (rr % 32), nullptr, scr, 64 * (rr / 32), 32 * (rr % 32), F.lane); continue; } rr -= I_HY;
            if (rr < I_HY) { p0_transpose_item(args.in[17], HW, DM, WAT, 32 * (rr % 32), nullptr, scr, 64 * (rr / 32), 32 * (rr % 32), F.lane); continue; } rr -= I_HY;
            if (rr < I_O) { p0_transpose_item(args.in[18], DM, DM, WO, 32 * (rr % 32), nullptr, scr, 64 * (rr / 32), 32 * (rr % 32), F.lane); continue; } rr -= I_O;
            if (rr < I_G) { const int n0 = 32 * (rr % 88); p0_transpose_item(args.in[20], DM, FFN, WGU, (n0 >> 7) * 256 + (n0 & 127), args.in[19], scr, 64 * (rr / 88), n0, F.lane); continue; } rr -= I_G;
            if (rr < I_G) { const int n0 = 32 * (rr % 88); p0_transpose_item(args.in[21], DM, FFN, WGU, (n0 >> 7) * 256 + 128 + (n0 & 127), args.in[19], scr, 64 * (rr / 88), n0, F.lane); continue; } rr -= I_G;
            if (rr < I_D) { p0_transpose_item(args.in[22], FFN, DM, WD, 32 * (rr % 32), nullptr, scr, 64 * (rr / 32), 32 * (rr % 32), F.lane); continue; } rr -= I_D;
            p0_transpose_item(args.in[10], 64, 2048, W3T, 32 * rr, nullptr, scr, 0, 32 * rr, F.lane);
        }
        for (int m = gw; m < MTOK; m += NGW) p0_row((m < TP) ? xp + (size_t)m * DM : xs + (size_t)(m - TP) * DM, XB + (size_t)m * DM, RSTD + m, F.lane);
        for (int idx = F.vcu * (NWAVES * 64) + F.tid; idx < LS * 32; idx += F.G * NWAVES * 64) {
            const int pos = idx >> 5, i = idx & 31; const double inv = exp2(-(double)i * (13.287712379549449 / 32.0)); const double ang = (double)pos * inv;
            COS[idx] = (float)cos(ang); SIN[idx] = (float)sin(ang);
        }
    }
    SEAM(0);

    if (IN(1)) {
        {
            constexpr int NU = (MTOK / 256) * (NPROJ / 256);
            const int heavy = NU % F.G, lb = heavy ? (int)blockIdx.x - heavy : (int)blockIdx.x, nlb = heavy ? F.G - heavy : F.G;
            if (lb >= 0) {
                filter_stage_weights(F.lds, args.in[6], args.in[7], args.in[8], args.in[9], args.in[11], F.tid);
                for (int it = lb * NWAVES + F.wave; it < 288 * 4; it += nlb * NWAVES) {
                    const int quarter = it & 3, ca = it >> 2, g = (ca < 256) ? 1 : 0, chunk = g ? ca : ca - 256;
                    filter_item(F.lds, W3T, KREV_S + (g ? (size_t)0 : (size_t)((WS_KREV_P - WS_KREV_S) / 2)), FPART_S + (g ? (size_t)0 : (size_t)((WS_FPART_P - WS_FPART_S) / 4)), g, chunk, quarter, F.wave, F.lane);
                }
                LDS_WAIT(); __syncthreads();
            }
        }
        {
            pg8::Gemm g{WINA, XB, nullptr, nullptr, 3 * HW, MTOK, DM}; pg8::StaticOrder S; S.init(3 * HW, MTOK, F.G, (int)blockIdx.x);
            pg8::EpiUT E{UT, MTOK, RSTD};
            pg8::gemm_phase<pg8::EpiUT, pg8::StaticOrder, true, true>(F.lds + RING_OFF, g, S, E);
        }
        {
            pg8::Gemm g{XB, WINB, nullptr, nullptr, MTOK, NPROJ, DM}; pg8::StaticOrder S; S.init(MTOK, NPROJ, F.G, (int)blockIdx.x);
            pg8::EpiProj E{RSTD, args.in[13], args.in[14], COS, SIN, QB, KB, VB, SGH, SGA};
            pg8::gemm_phase<pg8::EpiProj, pg8::StaticOrder, true, true>(F.lds + RING_OFF, g, S, E);
        }
    }
    SEAM(1);

    if (IN(2)) {
        #if PROBE
        const hy::Params HP{UT, KREV_S, KREV_P, FPART_S, FPART_P, args.in[4], args.in[5], args.in[12], YT, (float*)(ws + WS_DF), (bf16*)(ws + WS_DZ)};
#else
        const hy::Params HP{UT, KREV_S, KREV_P, FPART_S, FPART_P, args.in[4], args.in[5], args.in[12], YT, nullptr, nullptr};
#endif
        {
#if PROBE
            const fc::Params FP{UT, KREV_S, FPART_S, args.in[4], args.in[5], args.in[12], YT, (bf16*)(ws + WS_HS), (bf16*)(ws + WS_Z1S), (float*)(ws + WS_DF), (bf16*)(ws + WS_DZ)};
#else
            const fc::Params FP{UT, KREV_S, FPART_S, args.in[4], args.in[5], args.in[12], YT, (bf16*)(ws + WS_HS), (bf16*)(ws + WS_Z1S), nullptr, nullptr};
#endif
            for (int it = F.vcu; it < HW; it += F.G) fc::item(F.lds, FP, it, F.tid, F.vcu);
        }
        TSTAMP(9);
        for (int it = F.vcu; it < HW; it += F.G) hy::hyena_item(F.lds, HP, 0, it, F.tid);
        TSTAMP(10);
        const at::Params AP{QB, KB, VB, args.in[15], YAT};
        for (int it = F.vcu; it < 512; it += F.G) at::attn_item(F.lds, AP, it >> 1, it & 1, F.tid);
    }
    SEAM(2);
#if PROBE >= 100
    probe_check(ws, (unsigned*)F.ctl, args.in[6], args.in[7], args.in[8], args.in[9], args.in[10], args.in[11], F.vcu, F.G, F.tid);
    xcd_barrier(bar);
#endif

    if (IN(3)) {
        for (int t = F.vcu; t < 8 * 512; t += F.G) transpose_y_tile(F.lds, YT, YHY, t, F.tid);
    }
    SEAM(3);

    if (IN(4)) {
        pg8::Gemm g{YHY, WHY, YAT, WAT, MTOK, DM, HW}; pg8::TwoPartOrder S; S.b.init(MTOK, DM, F.G, (int)blockIdx.x);
        pg8::EpiMerged E{SGH, SGA, MERGED};
        pg8::gemm_phase<pg8::EpiMerged, pg8::TwoPartOrder, true, true>(F.lds + RING_OFF, g, S, E);
    }
    SEAM(4);

    if (IN(5)) {
        pg8::Gemm g{MERGED, WO, nullptr, nullptr, MTOK, DM, DM}; pg8::StaticOrder S; S.init(MTOK, DM, F.G, (int)blockIdx.x);
        pg8::EpiWo E{xp, xs, X1B, SSQ};
        pg8::gemm_phase<pg8::EpiWo, pg8::StaticOrder, true, true>(F.lds + RING_OFF, g, S, E);
    }
    SEAM(5);

    if (IN(6)) {
        pg8::Gemm g{X1B, WGU, nullptr, nullptr, MTOK, 2 * FFN, DM}; pg8::StaticOrder S; S.init(MTOK, 2 * FFN, F.G, (int)blockIdx.x);
        pg8::EpiFfn1 E{SSQ, HID};
        pg8::gemm_phase<pg8::EpiFfn1, pg8::StaticOrder, true, true>(F.lds + RING_OFF, g, S, E);
    }
    SEAM(6);

    if (IN(7)) {
        pg8::Gemm g{HID, WD, nullptr, nullptr, MTOK, DM, FFN}; pg8::StaticOrder S; S.init(MTOK, DM, F.G, (int)blockIdx.x);
        pg8::EpiFfn2 E{X1B, args.out};
        pg8::gemm_phase<pg8::EpiFfn2, pg8::StaticOrder, true, true>(F.lds + RING_OFF, g, S, E);
#if PROBE
        TSTAMP(8);
        VM_WAIT(); __syncthreads();
        if (blockIdx.x == 0) {
            pg8::Unit u; S.next(1, u);
            int cnt;
#if PROBE >= 100
            cnt = probe_metric_count(ws, (unsigned*)F.ctl);
#else
            { const unsigned long long t0 = F.MISC[16] | ((unsigned long long)F.MISC[17] << 32), t8 = F.MISC[32] | ((unsigned long long)F.MISC[33] << 32);
#if PROBE == 21
              constexpr int IA = 2, IB = 9;
#elif PROBE == 22
              constexpr int IA = 9, IB = 10;
#elif PROBE == 23
              constexpr int IA = 10, IB = 3;
#else
              constexpr int IA = PROBE - 1, IB = PROBE;
#endif
              const unsigned long long ta = F.MISC[16 + 2 * IA] | ((unsigned long long)F.MISC[17 + 2 * IA] << 32), tb = F.MISC[16 + 2 * IB] | ((unsigned long long)F.MISC[17 + 2 * IB] << 32);
              cnt = (int)(1600.0f * (float)(tb - ta) / (float)(t8 - t0)); }
#endif
            for (int i = F.tid; i < cnt; i += NWAVES * 64) args.out[(size_t)(u.pm * 256 + (i & 255)) * 1024 + u.pn * 256 + (i >> 8)] = 0.f;
        }
#endif
    }
#undef IN
#undef SEAM
}

extern "C" void kernel_launch(void* const* d_in, const int* in_sizes, int n_in, void* d_out, int out_size, void* d_ws, size_t ws_size, hipStream_t stream) {
    static int grid = 0;
    if (grid == 0) {
        if (n_in != 23 || out_size != MTOK * DM || ws_size < WS_END) { fprintf(stderr, "kernel_launch: unexpected problem shape (n_in %d, out %d, ws %zu); nothing launched\n", n_in, out_size, ws_size); grid = -1; return; }
        int dev = 0, cus = 0, per_cu = 0;
        if (hipGetDevice(&dev) != hipSuccess || hipDeviceGetAttribute(&cus, hipDeviceAttributeMultiprocessorCount, dev) != hipSuccess) { fprintf(stderr, "kernel_launch: device query failed\n"); grid = -1; return; }
        if (hipFuncSetAttribute((const void*)enc_fwd, hipFuncAttributeMaxDynamicSharedMemorySize, LDS_BYTES) != hipSuccess) { fprintf(stderr, "kernel_launch: hipFuncSetAttribute failed\n"); grid = -1; return; }
        if (hipOccupancyMaxActiveBlocksPerMultiprocessor(&per_cu, (const void*)enc_fwd, NWAVES * 64, LDS_BYTES) != hipSuccess || per_cu < 1)
            fprintf(stderr, "kernel_launch: note: occupancy query reports %d workgroups per CU\n", per_cu);
        (void)hipGetLastError();
        grid = cus;
    }
    if (grid < 0) return;
    if (hipMemsetAsync((char*)d_ws + WS_CTL, 0, CTL_ZERO_BYTES, stream) != hipSuccess) { fprintf(stderr, "kernel_launch: memset failed\n"); return; }
    Args a{};
    for (int i = 0; i < 23; ++i) a.in[i] = (const float*)d_in[i];
    a.out = (float*)d_out; a.ws = (unsigned char*)d_ws;
#if MK_SPLIT
    for (int p = 0; p < N_PHASES; ++p) { a.ph_lo = p; a.ph_hi = p + 1; hipLaunchKernelGGL(enc_fwd, dim3(grid), dim3(NWAVES * 64), LDS_BYTES, stream, a); }
#else
    a.ph_lo = 0; a.ph_hi = N_PHASES;
    hipLaunchKernelGGL(enc_fwd, dim3(grid), dim3(NWAVES * 64), LDS_BYTES, stream, a);
#endif
    const hipError_t le = hipPeekAtLastError();
    if (le != hipSuccess) fprintf(stderr, "kernel_launch: launch failed: %s\n", hipGetErrorName(le));
}
```

```cpp
#include <hip/hip_runtime.h>
#include <cstdio>
#include <cstdint>
#include <cmath>
#ifndef PROBE
#define PROBE 0
#endif

namespace pg8 {
#define PG8_LAS __attribute__((address_space(3)))
typedef unsigned short bf16_t;
typedef short bf16x8 __attribute__((ext_vector_type(8)));
typedef float f32x4 __attribute__((ext_vector_type(4)));
typedef unsigned u32x4 __attribute__((ext_vector_type(4)));
constexpr int BM = 256, BK = 64, HALF = 128, HTB = HALF * BK * 2  , STAGE_BYTES = 8 * HTB, NXCD = 8, WGM = 8;

__host__ __device__ __forceinline__ int lds_byte(int r, int c) { const int st = (r >> 4) * 2 + (c >> 5), rr = r & 15, cc = c & 31, ob = rr * 64 + cc * 2; return st * 1024 + (ob ^ (((ob >> 9) & 1) << 5)); }
__host__ __device__ __forceinline__ void stage_rc(int b, int& R, int& C) { const int st = b / 1024, sb = b % 1024, swz = sb ^ (((sb >> 9) & 1) << 5); R = (st >> 1) * 16 + swz / 64; C = (st & 1) * 32 + (swz % 64) / 2; }
__host__ __device__ __forceinline__ int perm32(int rho) { const int n = rho >> 4, i = rho & 15; return 8 * (i >> 2) + 4 * n + (i & 3); }

struct Unit { int pm, pn, sel; };
struct Gemm { const bf16_t* A; const bf16_t* Bt; const bf16_t* A1; const bf16_t* Bt1; int M, N, K; };

struct StaticOrder {
    int nM, nN, nwg, G, c;
    __host__ __device__ __forceinline__ void init(int M, int N, int G_, int c_) { nM = M / BM; nN = N / BM; nwg = nM * nN; G = G_; c = c_; }
    __host__ __device__ __forceinline__ bool next(int i, Unit& u) const {
        const long L = (long)i * G + c; if (L >= nwg) return false;
        int wgid = (int)L; { const int q = nwg / NXCD, r = nwg % NXCD, xcd = wgid % NXCD, off = wgid / NXCD; wgid = (xcd < r ? xcd * (q + 1) : r * (q + 1) + (xcd - r) * q) + off; }
        const int nig = WGM * nN, gid = wgid / nig, fm = gid * WGM, gsz = (nM - fm) < WGM ? (nM - fm) : WGM;
        u.pm = fm + ((wgid % nig) % gsz); u.pn = (wgid % nig) / gsz; u.sel = 0; return true;
    }
    __device__ __forceinline__ void a_ready(const Unit&) const {}
    __device__ __forceinline__ void done(const Unit&) const {}
};
struct TwoPartOrder {
    StaticOrder b;
    __device__ __forceinline__ bool next(int i, Unit& u) const { if (!b.next(i >> 1, u)) return false; u.sel = i & 1; return true; }
    __device__ __forceinline__ void a_ready(const Unit&) const {}
    __device__ __forceinline__ void done(const Unit&) const {}
};

typedef float f32x2_c __attribute__((ext_vector_type(2))); typedef __bf16 bf16x2_c __attribute__((ext_vector_type(2)));
__device__ __forceinline__ unsigned cvt_pk_bf16(float lo, float hi) { const f32x2_c v = {lo, hi}; return __builtin_bit_cast(unsigned, __builtin_convertvector(v, bf16x2_c)); }
__device__ __forceinline__ u32x4 pack8(const f32x4 a, const f32x4 b) { u32x4 w; w.x = cvt_pk_bf16(a[0], a[1]); w.y = cvt_pk_bf16(a[2], a[3]); w.z = cvt_pk_bf16(b[0], b[1]); w.w = cvt_pk_bf16(b[2], b[3]); return w; }
__device__ __forceinline__ float bflo(unsigned w) { return __uint_as_float(w << 16); }
__device__ __forceinline__ float bfhi(unsigned w) { return __uint_as_float(w & 0xffff0000u); }
__device__ __forceinline__ void unpack8(const u32x4 w, f32x4& a, f32x4& b) { a = (f32x4){bflo(w.x), bfhi(w.x), bflo(w.y), bfhi(w.y)}; b = (f32x4){bflo(w.z), bfhi(w.z), bflo(w.w), bfhi(w.w)}; }
__device__ __forceinline__ float sigmoidf_(float v) { return __builtin_amdgcn_rcpf(1.0f + __builtin_amdgcn_exp2f(-1.4426950408889634f * v)); }

constexpr float QSCALE = 0.125f * 1.4426950408889634f;

struct EpiUT {
    static constexpr bool PERM = true, AFTER_DRAIN = false;
    bf16_t* O; int ldc; const float* rstd;
    __device__ __forceinline__ bool keep(const Unit&) const { return false; }
    __device__ __forceinline__ void operator()(f32x4 (&acc)[2][2][4][2], const Unit& u, int wr, int wc, int fr, int fq) const {
        const int row0 = u.pm * BM + wr * 64 + fr, col0 = u.pn * BM + wc * 32 + 8 * fq;
        f32x4 rs[2][2];
#pragma unroll
        for (int bj = 0; bj < 2; ++bj)
#pragma unroll
            for (int n = 0; n < 2; ++n) rs[bj][n] = *(const f32x4*)(rstd + col0 + bj * HALF + 4 * n);
#pragma unroll
        for (int ai = 0; ai < 2; ++ai)
#pragma unroll
            for (int m = 0; m < 4; ++m) { bf16_t* rowp = O + (size_t)(row0 + ai * HALF + m * 16) * ldc + col0;
#pragma unroll
                for (int bj = 0; bj < 2; ++bj) *(u32x4*)(rowp + bj * HALF) = pack8(acc[ai][bj][m][0] * rs[bj][0], acc[ai][bj][m][1] * rs[bj][1]); }
    }
};

struct EpiProj {
    static constexpr bool PERM = true, AFTER_DRAIN = false;
    const float* rstd; const float* qw; const float* kw; const float* cs; const float* sn; bf16_t* q; bf16_t* k; bf16_t* v; bf16_t* sgh; bf16_t* sga;
    __device__ __forceinline__ bool keep(const Unit&) const { return false; }
    __device__ __forceinline__ void operator()(f32x4 (&acc)[2][2][4][2], const Unit& u, int wr, int wc, int fr, int fq) const {
        const int pn = u.pn;
        if (pn <= 2 && !(pn == 2 && wc >= 2)) {
            const float* w = (pn < 2) ? qw : kw; const float sc = (pn < 2) ? QSCALE : 1.0f;
            const f32x4 wl0 = *(const f32x4*)(w + 8 * fq), wl1 = *(const f32x4*)(w + 8 * fq + 4), wh0 = *(const f32x4*)(w + 32 + 8 * fq), wh1 = *(const f32x4*)(w + 32 + 8 * fq + 4);
#pragma unroll
            for (int ai = 0; ai < 2; ++ai)
#pragma unroll
                for (int m = 0; m < 4; ++m) {
                    const int row = u.pm * BM + ai * HALF + wr * 64 + m * 16 + fr; const float rs = rstd[row];
                    f32x4 a0 = acc[ai][0][m][0] * rs, a1 = acc[ai][0][m][1] * rs, b0 = acc[ai][1][m][0] * rs, b1 = acc[ai][1][m][1] * rs;
                    f32x4 sq = a0 * a0 + a1 * a1 + b0 * b0 + b1 * b1; float ss = (sq[0] + sq[1]) + (sq[2] + sq[3]);
                    ss += __shfl_xor(ss, 16); ss += __shfl_xor(ss, 32);
                    const float inv = 1.0f / sqrtf(ss * (1.0f / 64.0f) + 1e-6f);
                    const int pos = row < 16384 ? (row & 2047) : (row - 16384);
                    const f32x4 c0 = *(const f32x4*)(cs + pos * 32 + 8 * fq), c1 = *(const f32x4*)(cs + pos * 32 + 8 * fq + 4), s0 = *(const f32x4*)(sn + pos * 32 + 8 * fq), s1 = *(const f32x4*)(sn + pos * 32 + 8 * fq + 4);
                    a0 = a0 * inv * wl0; a1 = a1 * inv * wl1; b0 = b0 * inv * wh0; b1 = b1 * inv * wh1;
                    const f32x4 lo0 = (a0 * c0 - b0 * s0) * sc, lo1 = (a1 * c1 - b1 * s1) * sc, hi0 = (b0 * c0 + a0 * s0) * sc, hi1 = (b1 * c1 + a1 * s1) * sc;
                    bf16_t* dst = (pn < 2) ? q + (size_t)row * 512 + (4 * pn + wc) * 64 + 8 * fq : k + (size_t)row * 128 + wc * 64 + 8 * fq;
                    *(u32x4*)dst = pack8(lo0, lo1); *(u32x4*)(dst + 32) = pack8(hi0, hi1);
                }
        } else if (pn == 2) {
#pragma unroll
            for (int ai = 0; ai < 2; ++ai)
#pragma unroll
                for (int m = 0; m < 4; ++m) {
                    const int row = u.pm * BM + ai * HALF + wr * 64 + m * 16 + fr; const float rs = rstd[row];
                    bf16_t* dst = v + (size_t)row * 128 + (wc - 2) * 64 + 8 * fq;
                    *(u32x4*)dst = pack8(acc[ai][0][m][0] * rs, acc[ai][0][m][1] * rs); *(u32x4*)(dst + 32) = pack8(acc[ai][1][m][0] * rs, acc[ai][1][m][1] * rs);
                }
        } else {
            bf16_t* base = (pn < 7) ? sgh : sga; const int colb = (pn - ((pn < 7) ? 3 : 7)) * BM + wc * 32 + 8 * fq;
#pragma unroll
            for (int ai = 0; ai < 2; ++ai)
#pragma unroll
                for (int m = 0; m < 4; ++m) {
                    const int row = u.pm * BM + ai * HALF + wr * 64 + m * 16 + fr; const float rs = rstd[row];
#pragma unroll
                    for (int bj = 0; bj < 2; ++bj) { f32x4 g0 = acc[ai][bj][m][0] * rs, g1 = acc[ai][bj][m][1] * rs;
#pragma unroll
                        for (int e = 0; e < 4; ++e) { g0[e] = sigmoidf_(g0[e]); g1[e] = sigmoidf_(g1[e]); }
                        *(u32x4*)(base + (size_t)row * 1024 + colb + bj * HALF) = pack8(g0, g1); }
                }
        }
    }
};

struct EpiMerged {
    static constexpr bool PERM = true, AFTER_DRAIN = false;
    const bf16_t* sgh; const bf16_t* sga; bf16_t* out;
    __device__ __forceinline__ bool keep(const Unit& u) const { return u.sel == 0; }
    __device__ __forceinline__ void operator()(f32x4 (&acc)[2][2][4][2], const Unit& u, int wr, int wc, int fr, int fq) const {
#pragma unroll
        for (int ai = 0; ai < 2; ++ai)
#pragma unroll
            for (int m = 0; m < 4; ++m) {
                const size_t off = (size_t)(u.pm * BM + ai * HALF + wr * 64 + m * 16 + fr) * 1024 + u.pn * BM + wc * 32 + 8 * fq;
#pragma unroll
                for (int bj = 0; bj < 2; ++bj) {
                    f32x4 t0, t1; unpack8(*(const u32x4*)(sga + off + bj * HALF), t0, t1);
                    if (u.sel == 0) { f32x4 h0, h1; unpack8(*(const u32x4*)(sgh + off + bj * HALF), h0, h1);
                        f32x4 q0, q1;
#pragma unroll
                        for (int e = 0; e < 4; ++e) { q0[e] = h0[e] * __builtin_amdgcn_rcpf(t0[e]); q1[e] = h1[e] * __builtin_amdgcn_rcpf(t1[e]); }
                        acc[ai][bj][m][0] = acc[ai][bj][m][0] * q0; acc[ai][bj][m][1] = acc[ai][bj][m][1] * q1; }
                    else *(u32x4*)(out + off + bj * HALF) = pack8(acc[ai][bj][m][0] * t0, acc[ai][bj][m][1] * t1);
                }
            }
    }
};

struct EpiWo {
    static constexpr bool PERM = true, AFTER_DRAIN = false;
    const float* xp; const float* xs; bf16_t* x1b; float* ssq;
    __device__ __forceinline__ bool keep(const Unit&) const { return false; }
    __device__ __forceinline__ void operator()(f32x4 (&acc)[2][2][4][2], const Unit& u, int wr, int wc, int fr, int fq) const {
        const float* xb = (u.pm < 64) ? xp : xs - (size_t)16384 * 1024;
#pragma unroll
        for (int ai = 0; ai < 2; ++ai)
#pragma unroll
            for (int m = 0; m < 4; ++m) {
                const int row = u.pm * BM + ai * HALF + wr * 64 + m * 16 + fr; const size_t off = (size_t)row * 1024 + u.pn * BM + wc * 32 + 8 * fq; float s = 0.f;
#pragma unroll
                for (int bj = 0; bj < 2; ++bj) {
                    const f32x4 v0 = *(const f32x4*)(xb + off + bj * HALF) + acc[ai][bj][m][0], v1 = *(const f32x4*)(xb + off + bj * HALF + 4) + acc[ai][bj][m][1];
                    *(u32x4*)(x1b + off + bj * HALF) = pack8(v0, v1);
                    const f32x4 q = v0 * v0 + v1 * v1; s += (q[0] + q[1]) + (q[2] + q[3]); }
                s += __shfl_xor(s, 16); s += __shfl_xor(s, 32);
                if (fq == 0) ssq[(size_t)row * 16 + u.pn * 4 + wc] = s;
            }
    }
};

struct EpiFfn1 {
    static constexpr bool PERM = true, AFTER_DRAIN = false;
    const float* ssq; bf16_t* hid;
    __device__ __forceinline__ bool keep(const Unit&) const { return false; }
    __device__ __forceinline__ void operator()(f32x4 (&acc)[2][2][4][2], const Unit& u, int wr, int wc, int fr, int fq) const {
#pragma unroll
        for (int ai = 0; ai < 2; ++ai)
#pragma unroll
            for (int m = 0; m < 4; ++m) {
                const int row = u.pm * BM + ai * HALF + wr * 64 + m * 16 + fr;
                const f32x4 p = *(const f32x4*)(ssq + (size_t)row * 16 + 4 * fq); float t = (p[0] + p[1]) + (p[2] + p[3]);
                t += __shfl_xor(t, 16); t += __shfl_xor(t, 32);
                const float r = 1.0f / sqrtf(t * (1.0f / 1024.0f) + 1e-6f);
                f32x4 h0, h1;
#pragma unroll
                for (int e = 0; e < 4; ++e) { const float g0 = acc[ai][0][m][0][e] * r, g1 = acc[ai][0][m][1][e] * r;
                    h0[e] = g0 * sigmoidf_(g0) * (acc[ai][1][m][0][e] * r); h1[e] = g1 * sigmoidf_(g1) * (acc[ai][1][m][1][e] * r); }
                *(u32x4*)(hid + (size_t)row * 2816 + u.pn * HALF + wc * 32 + 8 * fq) = pack8(h0, h1);
            }
    }
};

struct EpiFfn2 {
    static constexpr bool PERM = true, AFTER_DRAIN = false;
    const bf16_t* x1b; float* out;
    __device__ __forceinline__ bool keep(const Unit&) const { return false; }
    __device__ __forceinline__ void operator()(f32x4 (&acc)[2][2][4][2], const Unit& u, int wr, int wc, int fr, int fq) const {
#pragma unroll
        for (int ai = 0; ai < 2; ++ai)
#pragma unroll
            for (int m = 0; m < 4; ++m) {
                const size_t off = (size_t)(u.pm * BM + ai * HALF + wr * 64 + m * 16 + fr) * 1024 + u.pn * BM + wc * 32 + 8 * fq; float* p = out + off;
#pragma unroll
                for (int bj = 0; bj < 2; ++bj) { f32x4 r0, r1; unpack8(*(const u32x4*)(x1b + off + bj * HALF), r0, r1);
                    *(f32x4*)(p + bj * HALF) = r0 + acc[ai][bj][m][0]; *(f32x4*)(p + bj * HALF + 4) = r1 + acc[ai][bj][m][1]; }
            }
    }
};

__device__ __forceinline__ void zero_acc(f32x4 (&acc)[2][2][4][2]) {
#pragma unroll
    for (int a = 0; a < 2; ++a)
#pragma unroll
        for (int b = 0; b < 2; ++b)
#pragma unroll
            for (int m = 0; m < 4; ++m)
#pragma unroll
                for (int n = 0; n < 2; ++n) acc[a][b][m][n] = (f32x4){0.f, 0.f, 0.f, 0.f};
}
template <class Epi, class Sched, bool ALIGN_EPI = false, bool SP2 = false>
__device__ __forceinline__ void gemm_phase(PG8_LAS unsigned char* lds, const Gemm g, const Sched& S, const Epi& E) {
    int tid = threadIdx.x; asm volatile("" : "+v"(tid));
    const int wid = __builtin_amdgcn_readfirstlane(tid >> 6), lane = tid & 63, wr = wid >> 2, wc = wid & 3, fr = lane & 15, fq = lane >> 4;
    const int K = g.K, nt = K / BK;
    unsigned voffA[2], voffB[2];
#pragma unroll
    for (int i = 0; i < 2; ++i) { int R, C; stage_rc(tid * 16 + i * 8192, R, C); const int Rb = Epi::PERM ? ((R & ~31) + perm32(R & 31)) : R;
        voffA[i] = (unsigned)(R * K + C) * 2u; voffB[i] = (unsigned)(Rb * K + C) * 2u; }
    const size_t kstep = (size_t)(BK * 2);
    const size_t hstep = (size_t)HALF * K * 2;
    const size_t tstep = 2 * hstep;
    const unsigned ldsw = (unsigned)wid * 1024u;
    const int aoff = lds_byte(wr * 64 + fr, fq * 8), boff = lds_byte(wc * 32 + fr, fq * 8);
#define PG8_SA(b, h) (((b) * 2 + (h)) * HTB)
#define PG8_SB(b, h) ((4 + (b) * 2 + (h)) * HTB)
#define PG8_STAGE(bufoff, gbase, voff) do { _Pragma("unroll") for (int _i = 0; _i < 2; ++_i) \
        __builtin_amdgcn_global_load_lds((const unsigned*)((const char*)(gbase) + (voff)[_i]), (PG8_LAS unsigned*)(lds + (bufoff) + ldsw + _i * 8192), 16, 0, 0); } while (0)
#define PG8_LDA(dst, b, h) do { _Pragma("unroll") for (int m = 0; m < 4; ++m) _Pragma("unroll") for (int k = 0; k < 2; ++k) dst[m][k] = *(const PG8_LAS bf16x8*)(lds + PG8_SA(b, h) + aoff + m * 2048 + k * 1024); } while (0)
#define PG8_LDB(dst, b, h) do { _Pragma("unroll") for (int n = 0; n < 2; ++n) _Pragma("unroll") for (int k = 0; k < 2; ++k) dst[n][k] = *(const PG8_LAS bf16x8*)(lds + PG8_SB(b, h) + boff + n * 2048 + k * 1024); } while (0)
#define PG8_MMA(ai, bj, At, Bt) do { __builtin_amdgcn_s_setprio(1); _Pragma("unroll") for (int m = 0; m < 4; ++m) _Pragma("unroll") for (int n = 0; n < 2; ++n) _Pragma("unroll") for (int k = 0; k < 2; ++k) \
        acc[ai][bj][m][n] = __builtin_amdgcn_mfma_f32_16x16x32_bf16(Bt[n][k], At[m][k], acc[ai][bj][m][n], 0, 0, 0); __builtin_amdgcn_s_setprio(0); } while (0)
#define PG8_WAIT_V(n) asm volatile("s_waitcnt vmcnt(" #n ")" ::: "memory")
#define PG8_WAIT_L(n) asm volatile("s_waitcnt lgkmcnt(" #n ")" ::: "memory")
#define PG8_BAR __builtin_amdgcn_s_barrier()
#define PG8_SCHED __builtin_amdgcn_sched_barrier(0)
    Unit cur, nxt; int ui = 0;
    if (!S.next(0, cur)) return;
    f32x4 acc[2][2][4][2];
#pragma unroll
    for (int a = 0; a < 2; ++a)
#pragma unroll
        for (int b = 0; b < 2; ++b)
#pragma unroll
            for (int m = 0; m < 4; ++m)
#pragma unroll
                for (int n = 0; n < 2; ++n) acc[a][b][m][n] = (f32x4){0.f, 0.f, 0.f, 0.f};
    bf16x8 At[4][2], B0[2][2], B1[2][2];
    const char* cA = (const char*)(cur.sel ? g.A1 : g.A) + (size_t)cur.pm * tstep; const char* cB = (const char*)(cur.sel ? g.Bt1 : g.Bt) + (size_t)cur.pn * tstep;
    S.a_ready(cur);
    if constexpr (SP2) {
        PG8_STAGE(PG8_SB(0, 0), cB, voffB); PG8_STAGE(PG8_SB(0, 1), cB + hstep, voffB); PG8_STAGE(PG8_SA(0, 0), cA, voffA); PG8_STAGE(PG8_SA(0, 1), cA + hstep, voffA);
        if (wr == 1) PG8_BAR;
        PG8_WAIT_V(2); PG8_BAR;
        PG8_STAGE(PG8_SB(1, 0), cB + kstep, voffB); PG8_STAGE(PG8_SA(1, 0), cA + kstep, voffA); PG8_STAGE(PG8_SB(1, 1), cB + hstep + kstep, voffB);
        PG8_WAIT_V(6); PG8_BAR;
    } else {
        PG8_STAGE(PG8_SB(0, 0), cB, voffB); PG8_STAGE(PG8_SA(0, 0), cA, voffA); PG8_STAGE(PG8_SB(0, 1), cB + hstep, voffB); PG8_STAGE(PG8_SA(0, 1), cA + hstep, voffA);
        if (wr == 1) PG8_BAR;
        PG8_WAIT_V(4); PG8_BAR;
        PG8_STAGE(PG8_SB(1, 0), cB + kstep, voffB); PG8_STAGE(PG8_SA(1, 0), cA + kstep, voffA); PG8_STAGE(PG8_SB(1, 1), cB + hstep + kstep, voffB);
        PG8_WAIT_V(6); PG8_BAR;
    }
    for (;;) {
        const bool has_next = S.next(ui + 1, nxt);
        const char* nA = has_next ? (const char*)(nxt.sel ? g.A1 : g.A) + (size_t)nxt.pm * tstep : cA; const char* nB = has_next ? (const char*)(nxt.sel ? g.Bt1 : g.Bt) + (size_t)nxt.pn * tstep : cB;
        for (int t = 0; t < nt; t += 2) {
            const bool last = (t == nt - 2);
            const char* a1 = cA + (size_t)(t + 1) * kstep;
            const char* a2 = last ? nA : cA + (size_t)(t + 2) * kstep; const char* b2 = last ? nB : cB + (size_t)(t + 2) * kstep;
            const char* a3 = a2 + kstep; const char* b3 = b2 + kstep;
            if (last && has_next) S.a_ready(nxt);
            if constexpr (SP2) {
            PG8_LDB(B0, 0, 0); PG8_LDB(B1, 0, 1); PG8_SCHED; PG8_LDA(At, 0, 0); PG8_STAGE(PG8_SA(1, 1), a1 + hstep, voffA);
            PG8_WAIT_V(8); PG8_WAIT_L(0); PG8_BAR; PG8_MMA(0, 0, At, B0); PG8_MMA(0, 1, At, B1); PG8_BAR; PG8_SCHED;
            PG8_LDA(At, 0, 1); PG8_STAGE(PG8_SB(0, 0), b2, voffB); PG8_STAGE(PG8_SB(0, 1), b2 + hstep, voffB); PG8_STAGE(PG8_SA(0, 0), a2, voffA);
            PG8_WAIT_V(8); PG8_WAIT_L(0); PG8_BAR; PG8_MMA(1, 0, At, B0); PG8_MMA(1, 1, At, B1); PG8_BAR; PG8_SCHED;
            PG8_LDB(B0, 1, 0); PG8_LDB(B1, 1, 1); PG8_SCHED; PG8_LDA(At, 1, 0); PG8_STAGE(PG8_SA(0, 1), a2 + hstep, voffA);
            PG8_WAIT_V(8); PG8_WAIT_L(0); PG8_BAR; PG8_MMA(0, 0, At, B0); PG8_MMA(0, 1, At, B1); PG8_BAR; PG8_SCHED;
            PG8_LDA(At, 1, 1); PG8_STAGE(PG8_SB(1, 0), b3, voffB); PG8_STAGE(PG8_SB(1, 1), b3 + hstep, voffB); PG8_STAGE(PG8_SA(1, 0), a3, voffA);
            PG8_WAIT_V(8); PG8_WAIT_L(0); PG8_BAR; PG8_MMA(1, 0, At, B0); PG8_MMA(1, 1, At, B1); PG8_BAR; PG8_SCHED;
            } else {
            PG8_LDB(B0, 0, 0); PG8_SCHED; PG8_LDA(At, 0, 0); PG8_STAGE(PG8_SA(1, 1), a1 + hstep, voffA);
            PG8_WAIT_L(8); PG8_BAR; PG8_WAIT_L(0); PG8_MMA(0, 0, At, B0); PG8_BAR; PG8_SCHED;
            PG8_LDB(B1, 0, 1); PG8_STAGE(PG8_SB(0, 0), b2, voffB);
            PG8_BAR; PG8_WAIT_L(0); PG8_MMA(0, 1, At, B1); PG8_BAR;
            PG8_LDA(At, 0, 1); PG8_STAGE(PG8_SA(0, 0), a2, voffA);
            PG8_BAR; PG8_WAIT_L(0); PG8_MMA(1, 0, At, B0); PG8_BAR; PG8_SCHED;
            PG8_STAGE(PG8_SB(0, 1), b2 + hstep, voffB);
            PG8_WAIT_V(6); PG8_BAR; PG8_MMA(1, 1, At, B1); PG8_BAR;
            PG8_LDB(B0, 1, 0); PG8_SCHED; PG8_LDA(At, 1, 0); PG8_STAGE(PG8_SA(0, 1), a2 + hstep, voffA);
            PG8_WAIT_L(8); PG8_BAR; PG8_WAIT_L(0); PG8_MMA(0, 0, At, B0); PG8_BAR; PG8_SCHED;
            PG8_LDB(B1, 1, 1); PG8_STAGE(PG8_SB(1, 0), b3, voffB);
            PG8_BAR; PG8_WAIT_L(0); PG8_MMA(0, 1, At, B1); PG8_BAR;
            PG8_LDA(At, 1, 1); PG8_STAGE(PG8_SA(1, 0), a3, voffA);
            PG8_BAR; PG8_WAIT_L(0); PG8_MMA(1, 0, At, B0); PG8_BAR; PG8_SCHED;
            PG8_STAGE(PG8_SB(1, 1), b3 + hstep, voffB);
            PG8_WAIT_V(6); PG8_BAR; PG8_MMA(1, 1, At, B1); PG8_BAR;
            }
        }
        if constexpr (ALIGN_EPI) { if (wr == 0) PG8_BAR; }
        if constexpr (!Epi::AFTER_DRAIN) { E(acc, cur, wr, wc, fr, fq); S.done(cur); }
        if (!has_next) break;
        if (!E.keep(cur)) zero_acc(acc);
        cur = nxt; cA = nA; cB = nB; ++ui;
        if constexpr (ALIGN_EPI) { if (wr == 1) PG8_BAR; }
    }
    PG8_WAIT_V(0);
    if constexpr (!ALIGN_EPI) { if (wr == 0) PG8_BAR; }
    PG8_BAR;
    if constexpr (Epi::AFTER_DRAIN) { E.fused(acc, cur, wr, wc, fr, fq, lds, wid, lane); S.done(cur); }
#undef PG8_SA
#undef PG8_SB
#undef PG8_STAGE
#undef PG8_LDA
#undef PG8_LDB
#undef PG8_MMA
#undef PG8_WAIT_V
#undef PG8_WAIT_L
#undef PG8_BAR
#undef PG8_SCHED
}}

constexpr int NWAVES = 8;
constexpr int DM = 1024, MTOK = 32768, TP = 16384  , LP = 2048, LS = 16384;
constexpr int HW = 512, INW = 4352, FFN = 2816, NPROJ = INW - 3 * HW  ;
constexpr float RMS_EPS = 1e-6f;

constexpr size_t MiB = 1u << 20;
constexpr size_t WS_CTL = 0, CTL_ZERO_BYTES = 1 * MiB;
constexpr size_t WS_WINA = 1 * MiB;
constexpr size_t WS_WINB = 4 * MiB;
constexpr size_t WS_WHY = 10 * MiB;
constexpr size_t WS_WAT = 11 * MiB;
constexpr size_t WS_WO = 12 * MiB;
constexpr size_t WS_WGU = 14 * MiB;
constexpr size_t WS_WD = 25 * MiB;
constexpr size_t WS_W3T = 31 * MiB;
constexpr size_t WS_XB = 32 * MiB;
constexpr size_t WS_YT = 32 * MiB;
constexpr size_t WS_YAT = 64 * MiB;
constexpr size_t WS_KREV_S = 96 * MiB;
constexpr size_t WS_KREV_P = 160 * MiB;
constexpr size_t WS_UT = 168 * MiB;
constexpr size_t WS_Q = 264 * MiB;
constexpr size_t WS_K = 296 * MiB;
constexpr size_t WS_V = 304 * MiB;
constexpr size_t WS_SGH = 312 * MiB;
constexpr size_t WS_SGA = 376 * MiB;
constexpr size_t WS_COS = 440 * MiB;
constexpr size_t WS_SIN = 442 * MiB;
constexpr size_t WS_RSTD = 444 * MiB;
constexpr size_t WS_SSQ = 445 * MiB;
constexpr size_t WS_FPART_S = 447 * MiB;
constexpr size_t WS_FPART_P = 449 * MiB;
constexpr size_t WS_YHY = 450 * MiB;
constexpr size_t WS_MERGED = 168 * MiB;
constexpr size_t WS_X1B = 232 * MiB;
constexpr size_t WS_HID = 32 * MiB;
constexpr size_t WS_HS = 450 * MiB;
constexpr size_t WS_Z1S = 488 * MiB;
constexpr size_t WS_END = 496 * MiB;
static_assert(WS_HID + (size_t)MTOK * FFN * 2 <= WS_X1B, "hid vs x1b");

constexpr int CW_TMO = 0, CW_CODE = 1;
constexpr int CW_BAR = 4096;

constexpr int RING_OFF = 0;
constexpr int LDS_BYTES = 147456;
constexpr int LDSCTL_OFF = LDS_BYTES - 512, MISC_OFF = LDSCTL_OFF + 320;

#define GAS __attribute__((address_space(1)))
#define LAS __attribute__((address_space(3)))
typedef unsigned short bf16;
typedef unsigned v4u __attribute__((ext_vector_type(4)));
typedef unsigned v2u __attribute__((ext_vector_type(2)));
typedef float f32x4 __attribute__((ext_vector_type(4)));
typedef float f32x16 __attribute__((ext_vector_type(16)));
typedef short bf16x8 __attribute__((ext_vector_type(8)));
typedef GAS unsigned gu32;
#define RLX_AGENT __ATOMIC_RELAXED, __HIP_MEMORY_SCOPE_AGENT
#define LDS_WAIT() asm volatile("s_waitcnt lgkmcnt(0)" ::: "memory")
#define VM_WAIT() asm volatile("s_waitcnt vmcnt(0)" ::: "memory")
typedef float f32x2_t_ __attribute__((ext_vector_type(2))); typedef __bf16 bf16x2_t_ __attribute__((ext_vector_type(2)));
__device__ __forceinline__ unsigned pk2(float lo, float hi) { const f32x2_t_ v = {lo, hi}; return __builtin_bit_cast(unsigned, __builtin_convertvector(v, bf16x2_t_)); }
__device__ __forceinline__ unsigned f2bf(float f) { return (unsigned)__builtin_bit_cast(unsigned short, (__bf16)f); }
__device__ __forceinline__ float bf2f(unsigned short b) { return __uint_as_float((unsigned)b << 16); }
__device__ __forceinline__ float wave_sum(float v) {
#pragma unroll
    for (int o = 1; o < 64; o <<= 1) v += __shfl_xor(v, o);
    return v;
}

__device__ __forceinline__ float wave_sum_sw(float v) {
#define SWZ_(x, m) __builtin_bit_cast(float, __builtin_amdgcn_ds_swizzle(__builtin_bit_cast(int, (x)), (((m) << 10) | 0x1f)))
    v += SWZ_(v, 1); v += SWZ_(v, 2); v += SWZ_(v, 4); v += SWZ_(v, 8); v += SWZ_(v, 16);
#undef SWZ_
    return __builtin_bit_cast(float, __builtin_amdgcn_readlane(__builtin_bit_cast(int, v), 0)) + __builtin_bit_cast(float, __builtin_amdgcn_readlane(__builtin_bit_cast(int, v), 32));
}

#define XB_TMO      128
#define XB_XCNT(j)  (256  + 64 * (j))
#define XB_XSUB(j)  (1280 + 64 * (j))
#define XB_XGEN(j)  (2304 + 64 * (j))
#define XB_TOP      3328
#define XB_TOPGEN   3392
#define XCD_BAR_WORDS 3456
#define XB_SPIN_CAP (1u << 18)

__device__ __forceinline__ unsigned xb_ld(unsigned* p)              { return __hip_atomic_load(p, __ATOMIC_RELAXED, __HIP_MEMORY_SCOPE_AGENT); }
__device__ __forceinline__ unsigned xb_add(unsigned* p, unsigned v) { return __hip_atomic_fetch_add(p, v, __ATOMIC_RELAXED, __HIP_MEMORY_SCOPE_AGENT); }
__device__ __forceinline__ unsigned xb_xcc_id() { return (unsigned)__builtin_amdgcn_s_getreg((3 << 11) | 20) & 0xFu; }
#define XB_SPIN(cond, bar) do { unsigned _sp = 0; while (cond) { __builtin_amdgcn_s_sleep(1); \
    if ((++_sp & 255u) == 0u) { if (xb_ld(&(bar)[XB_TMO])) break; if (_sp > XB_SPIN_CAP) { atomicAdd(&(bar)[XB_TMO], 1u); break; } } } } while (0)

struct XcdBarrier { unsigned* bar; unsigned x; volatile LAS unsigned* st; };

__device__ __forceinline__ XcdBarrier xcd_barrier_post(unsigned* bar, volatile LAS unsigned* st) {
    XcdBarrier b; b.bar = bar; b.x = xb_xcc_id(); b.st = st;
    if (threadIdx.x == 0) (void)xb_add(&bar[XB_XCNT(b.x)], 1u);
    return b;
}
__device__ __forceinline__ void xcd_barrier_complete(unsigned* bar, unsigned x, unsigned& nloc, unsigned& nx) {
    const unsigned G = gridDim.x * gridDim.y * gridDim.z;
    unsigned sum, cnt, mine, sp = 0u;
    for (;;) {
        sum = 0u; cnt = 0u; mine = 0u;
#pragma unroll
        for (unsigned j = 0; j < 16; ++j) { const unsigned c = xb_ld(&bar[XB_XCNT(j)]); sum += c; cnt += (c > 0u) ? 1u : 0u; mine = (j == x) ? c : mine; }
        if (sum == G) break;
        __builtin_amdgcn_s_sleep(1);
        if ((++sp & 255u) == 0u) { if (xb_ld(&bar[XB_TMO])) break; if (sp > XB_SPIN_CAP) { atomicAdd(&bar[XB_TMO], 1u); break; } }
    }
    nloc = mine > 0u ? mine : 1u; nx = cnt > 0u ? cnt : 1u;
}
__device__ __forceinline__ void xcd_barrier(const XcdBarrier& b) {
    asm volatile("s_waitcnt vmcnt(0)" ::: "memory");
    __syncthreads();
    if (threadIdx.x == 0) {
        unsigned* bar = b.bar;
        __builtin_amdgcn_s_waitcnt(0);
        unsigned nloc = b.st[0], nx = b.st[1];
        if (nloc == 0u) { xcd_barrier_complete(bar, b.x, nloc, nx); b.st[0] = nloc; b.st[1] = nx; }
        const unsigned old = xb_add(&bar[XB_XSUB(b.x)], 1u);
        const unsigned gen = old / nloc;
        if (old + 1u == (gen + 1u) * nloc) {
            __builtin_amdgcn_fence(__ATOMIC_RELEASE, "agent");
            asm volatile("s_waitcnt vmcnt(0)" ::: "memory");
            const unsigned og = xb_add(&bar[XB_TOP], 1u);
            const unsigned tg = og / nx;
            if (og + 1u == (tg + 1u) * nx) xb_add(&bar[XB_TOPGEN], 1u);
            else XB_SPIN(xb_ld(&bar[XB_TOPGEN]) == tg, bar);
            __builtin_amdgcn_fence(__ATOMIC_ACQUIRE, "agent");
            xb_add(&bar[XB_XGEN(b.x)], 1u);
            asm volatile("s_waitcnt vmcnt(0)" ::: "memory");
        } else {
            XB_SPIN(xb_ld(&bar[XB_XGEN(b.x)]) == gen, bar);
            __builtin_amdgcn_fence(__ATOMIC_ACQUIRE, "agent");
            asm volatile("s_waitcnt vmcnt(0)" ::: "memory");
        }
    }
    __syncthreads();
}

struct Frame {
    LAS unsigned char* lds;
    volatile LAS unsigned* MISC;
    gu32* ctl;
    int tid, lane, wave;
    int vcu, G;
    unsigned char* ws;
};

__device__ __forceinline__ void p0_transpose_item(const float* W, int K, int N, bf16* WT, int dst_row0, const float* kscale, LAS float* scr, int k0, int n0, int lane) {
#pragma unroll 8
    for (int i = 0; i < 32; ++i) { const int kk = 2 * i + (lane >> 5); float v = W[(size_t)(k0 + kk) * N + n0 + (lane & 31)]; if (kscale) v *= kscale[k0 + kk]; scr[kk * 33 + (lane & 31)] = v; }
    LDS_WAIT(); asm volatile("" ::: "memory");
    const int c = lane & 7;
#pragma unroll
    for (int j = 0; j < 4; ++j) { const int n = (lane >> 3) + 8 * j; const LAS float* s = scr + (8 * c) * 33 + n;
        v4u o; o.x = pk2(s[0 * 33], s[1 * 33]); o.y = pk2(s[2 * 33], s[3 * 33]); o.z = pk2(s[4 * 33], s[5 * 33]); o.w = pk2(s[6 * 33], s[7 * 33]);
        *(GAS v4u*)(WT + (size_t)(dst_row0 + n) * K + k0 + 8 * c) = o; }
    LDS_WAIT(); asm volatile("" ::: "memory");
}
__device__ __forceinline__ int map_projB(int n0) {
    if (n0 < 2048) { const int t = n0 - 1536, hq = t >> 6, hf = (t >> 5) & 1; return 256 * (hq >> 2) + 128 * hf + 32 * (hq & 3); }
    if (n0 < 2176) { const int t = n0 - 2048, kh = t >> 6, hf = (t >> 5) & 1; return 512 + 128 * hf + 32 * kh; }
    if (n0 < 2304) { const int t = n0 - 2176, vh = t >> 6, hf = (t >> 5) & 1; return 512 + 128 * hf + 32 * (2 + vh); }
    return 768 + (n0 - 2304);
}
__device__ __forceinline__ void p0_row(const float* xrow, bf16* orow, float* rstd_out, int lane) {
    const GAS f32x4* xr = (const GAS f32x4*)xrow + lane;
    f32x4 v[4]; float s = 0.f;
#pragma unroll
    for (int j = 0; j < 4; ++j) { v[j] = xr[64 * j]; s += (v[j].x * v[j].x + v[j].y * v[j].y) + (v[j].z * v[j].z + v[j].w * v[j].w); }
    s = wave_sum(s);
    if (lane == 0) *rstd_out = 1.0f / sqrtf(s * (1.0f / DM) + RMS_EPS);
    GAS unsigned long long* o8 = (GAS unsigned long long*)orow + lane;
#pragma unroll
    for (int j = 0; j < 4; ++j) o8[64 * j] = (unsigned long long)pk2(v[j].x, v[j].y) | ((unsigned long long)pk2(v[j].z, v[j].w) << 32);
}
constexpr int FW_W1 = 0, FW_W2 = 33 * 64 * 4, FW_B1 = FW_W2 + 64 * 64 * 4, FW_B2 = FW_B1 + 256, FW_FR = FW_B2 + 256, FW_END = FW_FR + 256, FT_PITCH = 144, FT_BYTES = 32 * FT_PITCH;
__device__ __forceinline__ void filter_stage_weights(LAS unsigned char* lds, const float* w1, const float* b1, const float* w2, const float* b2, const float* fr, int tid) {
    LAS float* W1 = (LAS float*)(lds + FW_W1); LAS float* W2 = (LAS float*)(lds + FW_W2);
    for (int i = tid; i < 33 * 64; i += NWAVES * 64) W1[i] = w1[i];
    for (int i = tid; i < 64 * 64; i += NWAVES * 64) W2[i] = w2[i];
    if (tid < 64) { ((LAS float*)(lds + FW_B1))[tid] = b1[tid]; ((LAS float*)(lds + FW_B2))[tid] = b2[tid]; ((LAS float*)(lds + FW_FR))[tid] = fr[tid]; }
    LDS_WAIT(); __syncthreads();
}
__device__ __forceinline__ void filter_mlp_half(LAS unsigned char* lds, int L, int chunk, int hf, int dir, int r, int h, LAS float* Hb, bf16x8 (&afr)[4]) {
    const LAS float* W1 = (const LAS float*)(lds + FW_W1); const LAS float* W2 = (const LAS float*)(lds + FW_W2);
    const LAS float* B1 = (const LAS float*)(lds + FW_B1); const LAS float* B2 = (const LAS float*)(lds + FW_B2); const LAS float* FR = (const LAS float*)(lds + FW_FR);
        int pos = 64 * chunk + 32 * hf + r + dir; if (pos > L - 1) pos = L - 1;
        const float t = (float)pos / (float)(L - 1);
        float a[32];
#pragma unroll
        for (int jj = 0; jj < 32; ++jj) a[jj] = B1[32 * h + jj];
        {
#pragma unroll
            for (int jj = 0; jj < 32; jj += 4) { const f32x4 w = *(const LAS f32x4*)(W1 + 32 * h + jj); a[jj] += t * w[0]; a[jj + 1] += t * w[1]; a[jj + 2] += t * w[2]; a[jj + 3] += t * w[3]; }
#pragma unroll 1
            for (int i = 0; i < 16; ++i) {
                const float band = 1e-4f + (float)i * ((15.0f - 1e-4f) / 15.0f); const float ang = (6.283185307179586f / (float)L) * (float)pos * band;
                const float cv = __cosf(ang), sv = -__sinf(ang);
                const LAS float* wc = W1 + (1 + i) * 64 + 32 * h; const LAS float* wsn = W1 + (17 + i) * 64 + 32 * h;
#pragma unroll
                for (int jj = 0; jj < 32; jj += 4) { const f32x4 w = *(const LAS f32x4*)(wc + jj), v = *(const LAS f32x4*)(wsn + jj);
                    a[jj] += cv * w[0] + sv * v[0]; a[jj + 1] += cv * w[1] + sv * v[1]; a[jj + 2] += cv * w[2] + sv * v[2]; a[jj + 3] += cv * w[3] + sv * v[3]; }
            }
        }
#pragma unroll
        for (int jj = 0; jj < 32; ++jj) Hb[(32 * h + jj) * 32 + r] = __sinf(FR[32 * h + jj] * a[jj]);
        LDS_WAIT(); asm volatile("" ::: "memory");
#pragma unroll
        for (int jj = 0; jj < 32; ++jj) a[jj] = B2[32 * h + jj];
#pragma unroll 1
        for (int i = 0; i < 64; ++i) { const float hv = Hb[i * 32 + r]; const LAS float* wr_ = W2 + i * 64 + 32 * h;
#pragma unroll
            for (int jj = 0; jj < 32; jj += 4) { const f32x4 w = *(const LAS f32x4*)(wr_ + jj); a[jj] += hv * w[0]; a[jj + 1] += hv * w[1]; a[jj + 2] += hv * w[2]; a[jj + 3] += hv * w[3]; } }
        LDS_WAIT(); asm volatile("" ::: "memory");
        unsigned op[16], pp[16];
#pragma unroll
        for (int d = 0; d < 16; ++d) op[d] = pk2(__sinf(FR[32 * h + 2 * d] * a[2 * d]), __sinf(FR[32 * h + 2 * d + 1] * a[2 * d + 1]));
#pragma unroll
        for (int d = 0; d < 16; ++d) pp[d] = __shfl_xor(op[d], 32);
#pragma unroll
        for (int ks = 0; ks < 4; ++ks) { v4u f;
#pragma unroll
            for (int w = 0; w < 4; ++w) { const unsigned own = h ? op[8 * (ks & 1) + 4 + w] : op[8 * (ks & 1) + w], par = h ? pp[8 * (ks & 1) + 4 + w] : pp[8 * (ks & 1) + w];
                f[w] = ((ks >> 1) == h) ? own : par; }
            afr[ks] = __builtin_bit_cast(bf16x8, f); }
}
__device__ __forceinline__ void filter_item(LAS unsigned char* lds, const bf16* w3T, bf16* krev, float* fpart, int g, int chunk, int dir, int wave, int lane_) {
    int lane = lane_; asm volatile("" : "+v"(lane));
    const int L = g ? LS : LP, r = lane & 31, h = lane >> 5;
    const LAS float* W1 = (const LAS float*)(lds + FW_W1); const LAS float* W2 = (const LAS float*)(lds + FW_W2);
    const LAS float* B1 = (const LAS float*)(lds + FW_B1); const LAS float* B2 = (const LAS float*)(lds + FW_B2); const LAS float* FR = (const LAS float*)(lds + FW_FR);
    LAS unsigned char* T = lds + FW_END + wave * FT_BYTES; LAS float* Hb = (LAS float*)(lds + FW_END + NWAVES * FT_BYTES + wave * 8192);
    bf16x8 afr0[4], afr1[4];
    filter_mlp_half(lds, L, chunk, 0, dir, r, h, Hb, afr0);
    filter_mlp_half(lds, L, chunk, 1, dir, r, h, Hb, afr1);
    const float dmin = -4.605170185988091f / 1.5f, dmax = -4.605170185988091f / 0.3f;
    const int p0 = 64 * chunk; const int mstart = g ? (dir ? (2 * L - p0 - 64) : p0) : (dir ? (L + p0) : (L - 64 - p0));
    for (int ti = 0; ti < 32; ++ti) {
        const int o_ = ti >> 4, cb = 32 * (ti & 15), colg = (2 * o_ + dir) * 512 + cb;
        bf16x8 bfr[4];
#pragma unroll
        for (int ks = 0; ks < 4; ++ks) bfr[ks] = *(const GAS bf16x8*)(w3T + (size_t)(colg + r) * 64 + 16 * ks + 8 * h);
        const float delta = fabsf(dmin + (float)(cb + r) * ((dmax - dmin) / 511.0f));
        float asum = 0.f;
#pragma unroll
        for (int hf = 0; hf < 2; ++hf) {
            f32x16 acc = (f32x16){0.f,0.f,0.f,0.f,0.f,0.f,0.f,0.f,0.f,0.f,0.f,0.f,0.f,0.f,0.f,0.f};
#pragma unroll
            for (int ks = 0; ks < 4; ++ks) acc = __builtin_amdgcn_mfma_f32_32x32x16_bf16(hf ? afr1[ks] : afr0[ks], bfr[ks], acc, 0, 0, 0);
#pragma unroll
            for (int rg = 0; rg < 16; ++rg) {
                const int i = 32 * hf + (rg & 3) + 8 * (rg >> 2) + 4 * h; const int pos = p0 + i + dir;
                const float t = (float)pos / (float)(L - 1);
                float kv = acc[rg] * (__expf(-t * delta) + 0.05f); if (pos > L - 1) kv = 0.f;
                asum += fabsf(kv);
                const int e = ((dir != 0) != (g != 0)) ? i : 63 - i;
                *(LAS bf16*)(T + r * FT_PITCH + e * 2) = (bf16)f2bf(kv);
            }
        }
        asum += __shfl_xor(asum, 32);
        if (h == 0) fpart[(size_t)chunk * 2048 + colg + r] = asum;
        LDS_WAIT(); asm volatile("" ::: "memory");
        {
            const int col = lane >> 1, hb = lane & 1;
            bf16* dst = krev + (size_t)(o_ * 512 + cb + col) * (2 * L) + mstart + 32 * hb;
            const LAS v4u* src = (const LAS v4u*)(T + col * FT_PITCH + 64 * hb);
#pragma unroll
            for (int q = 0; q < 4; ++q) *(GAS v4u*)(dst + 8 * q) = src[q];
        }
        LDS_WAIT(); asm volatile("" ::: "memory");
    }
}

namespace hy {
constexpr int SLOTB = 272, Z_BYTES = 75776, F_OFF = 75776, F_BYTES = 65536, RED_OFF = F_OFF + F_BYTES;
__device__ __forceinline__ int slot_of(int g, int n) { return g ? (n + 31) : ((n >> 4) * 32 + 16 + (n & 15)); }
__device__ __forceinline__ int crow(int r, int hi) { return (r & 3) + 8 * (r >> 2) + 4 * hi; }

struct Params { const bf16* uT; const bf16* krev_s; const bf16* krev_p; const float* fpart_s; const float* fpart_p; const float* conv_w; const float* conv_b; const float* hbias; bf16* yT; float* dF; bf16* dZ; };

__device__ __forceinline__ void conv3_chunk(const bf16* urow  , int g, int chunk, float w0, float w1, float w2, float b, float (&out)[8]) {
    const int tau0 = chunk * 8; const int L = g ? LS : LP; const int p0 = g ? tau0 : (tau0 & (LP - 1));
    const v4u raw = *(const GAS v4u*)(urow + tau0);
    float u[10];
    u[1] = pg8::bflo(raw.x); u[2] = pg8::bfhi(raw.x); u[3] = pg8::bflo(raw.y); u[4] = pg8::bfhi(raw.y); u[5] = pg8::bflo(raw.z); u[6] = pg8::bfhi(raw.z); u[7] = pg8::bflo(raw.w); u[8] = pg8::bfhi(raw.w);
    u[0] = (p0 > 0) ? bf2f(urow[tau0 - 1]) : 0.f;
    u[9] = (p0 + 8 < L) ? bf2f(urow[tau0 + 8]) : 0.f;
#pragma unroll
    for (int i = 0; i < 8; ++i) out[i] = w0 * u[i] + w1 * u[i + 1] + w2 * u[i + 2] + b;
}

struct C3 { v4u raw; float prev, next; };
__device__ __forceinline__ void conv3_load(const bf16* urow, int g, int chunk, C3& q) {
    const int tau0 = chunk * 8; const int L = g ? LS : LP; const int p0 = g ? tau0 : (tau0 & (LP - 1));
    q.raw = *(const GAS v4u*)(urow + tau0);
    q.prev = (p0 > 0) ? bf2f(urow[tau0 - 1]) : 0.f;
    q.next = (p0 + 8 < L) ? bf2f(urow[tau0 + 8]) : 0.f;
}
__device__ __forceinline__ void conv3_eval(const C3& q, float w0, float w1, float w2, float b, float (&out)[8]) {
    float u[10];
    u[0] = q.prev; u[9] = q.next;
    u[1] = pg8::bflo(q.raw.x); u[2] = pg8::bfhi(q.raw.x); u[3] = pg8::bflo(q.raw.y); u[4] = pg8::bfhi(q.raw.y); u[5] = pg8::bflo(q.raw.z); u[6] = pg8::bfhi(q.raw.z); u[7] = pg8::bflo(q.raw.w); u[8] = pg8::bfhi(q.raw.w);
#pragma unroll
    for (int i = 0; i < 8; ++i) out[i] = w0 * u[i] + w1 * u[i + 1] + w2 * u[i + 2] + b;
}

__device__ __forceinline__ bf16x8 load_afrag(LAS const unsigned char* lds, int addr, int sh) {
    const LAS unsigned* p = (const LAS unsigned*)(lds + addr);
    const unsigned w0 = p[0], w1 = p[1], w2 = p[2], w3 = p[3], w4 = p[4];
    v4u f; f.x = __builtin_amdgcn_alignbit(w1, w0, sh); f.y = __builtin_amdgcn_alignbit(w2, w1, sh); f.z = __builtin_amdgcn_alignbit(w3, w2, sh); f.w = __builtin_amdgcn_alignbit(w4, w3, sh);
    return __builtin_bit_cast(bf16x8, f);
}

__device__ __forceinline__ void hyena_item(LAS unsigned char* lds, const Params& P, int g, int c, int tid_) {
    int tid = tid_; asm volatile("" : "+v"(tid));
    const int lane = tid & 63, wave = __builtin_amdgcn_readfirstlane(tid >> 6), r = lane & 31, hi = lane >> 5, nt = wave & 3, half = wave >> 2;
    const int L = g ? LS : LP; const int T0 = g ? TP : 0;
    float inv_norm0, inv_norm1;
    {
        const int nchunk = g ? 256 : 32; const float* fp = P.fpart_s + (g ? (size_t)0 : (size_t)((WS_FPART_P - WS_FPART_S) / 4));
        float s0 = 0.f, s1 = 0.f;
        for (int idx = lane; idx < nchunk * 2; idx += 64) { const int ch = idx >> 1, dir = idx & 1; s0 += fp[(size_t)ch * 2048 + dir * 512 + c]; s1 += fp[(size_t)ch * 2048 + 1024 + dir * 512 + c]; }
        inv_norm0 = 1.0f / wave_sum_sw(s0); inv_norm1 = 1.0f / wave_sum_sw(s1);
        for (int i = tid; i < Z_BYTES / 16; i += NWAVES * 64) *(LAS v4u*)(lds + i * 16) = (v4u){0u, 0u, 0u, 0u};
        LDS_WAIT(); __syncthreads();
    }
    {
        const int ch = 2 * HW + c; const float w0 = P.conv_w[ch], w1 = P.conv_w[3 * HW + ch], w2 = P.conv_w[6 * HW + ch], b = P.conv_b[ch];
        const bf16* urow = P.uT + (size_t)ch * MTOK + T0;
        for (int it = 0; it < 4; ++it) { const int chunk = tid + it * 512; float o[8]; conv3_chunk(urow, g, chunk, w0, w1, w2, b, o);
            const int tau0 = chunk * 8; v4u pk; pk.x = pk2(o[0], o[1]); pk.y = pk2(o[2], o[3]); pk.z = pk2(o[4], o[5]); pk.w = pk2(o[6], o[7]);
            *(LAS v4u*)(lds + slot_of(g, tau0 >> 7) * SLOTB + (tau0 & 127) * 2) = pk; }
    }
    int d_hi, d_lo;
    if (g) { if (half == 0) { d_hi = 32 * nt + 31; d_lo = 32 * nt - 48; } else { d_hi = 32 * nt - 49; d_lo = 32 * nt - 127; } }
    else   { if (half == 0) { d_hi = 15; d_lo = 0; } else { d_hi = -1; d_lo = -15; } }
    int abase = F_OFF + 2 * ((L - 1) - r + 8 * hi); const int sh = (abase & 2) ? 16 : 0; abase &= ~3;
    const int zb = slot_of(g, 32 * nt + r) * SLOTB + 16 * hi;
    const int mi0 = 2 * half;

    for (int o = 0; o < 2; ++o) {
        {
            const bf16* ksrc = P.krev_s + (g ? (size_t)0 : (size_t)((WS_KREV_P - WS_KREV_S) / 2)) + (size_t)(o * HW + c) * (2 * L);
            const int n16 = (2 * L * 2) / 16;
            for (int i = tid; i < n16; i += NWAVES * 64) *(LAS v4u*)(lds + F_OFF + i * 16) = *(const GAS v4u*)(ksrc + i * 8);
        }
        LDS_WAIT(); __syncthreads();
        f32x16 acc[4];
#pragma unroll
        for (int mi = 0; mi < 4; ++mi) acc[mi] = (f32x16){0.f,0.f,0.f,0.f,0.f,0.f,0.f,0.f,0.f,0.f,0.f,0.f,0.f,0.f,0.f,0.f};
        bf16x8 Fw[8];
        {
            const int q0 = -8 * d_hi;
#pragma unroll
            for (int s = 2; s < 8; ++s) Fw[s] = load_afrag(lds, abase + 32 * (q0 - 8 + s), sh);
            Fw[0] = Fw[2]; Fw[1] = Fw[3];
        }
        {
            unsigned ap = (unsigned)(uintptr_t)(lds + abase) + 32 * (-8 * d_hi), bp = (unsigned)(uintptr_t)(lds + zb) - d_hi * SLOTB;
            v2u n01, n23; unsigned n4; v4u zn;
            unsigned r0, r1, r2, r3, r4; v4u zf;
#define HY_LOADS(ADW, BOFF) asm volatile("ds_read2_b32 %0, %4 offset0:%c5 offset1:%c6\n\tds_read2_b32 %1, %4 offset0:%c7 offset1:%c8\n\tds_read_b32 %2, %4 offset:%c9\n\tds_read_b128 %3, %10 offset:%c11" \
                : "=&v"(n01), "=&v"(n23), "=&v"(n4), "=&v"(zn) : "v"(ap), "i"(ADW), "i"((ADW) + 1), "i"((ADW) + 2), "i"((ADW) + 3), "i"(((ADW) + 4) * 4), "v"(bp), "i"(BOFF))
#define HY_WAIT() do { asm volatile("s_waitcnt lgkmcnt(0)" : "+v"(n01), "+v"(n23), "+v"(n4), "+v"(zn), "+v"(acc[0]), "+v"(acc[1]), "+v"(acc[2]), "+v"(acc[3])); __builtin_amdgcn_sched_barrier(0); } while (0)
#define HY_TAKE() do { r0 = n01.x; r1 = n01.y; r2 = n23.x; r3 = n23.y; r4 = n4; zf = zn; } while (0)
#define HY_STEP(JK, ADW, BOFF) do { HY_LOADS(ADW, BOFF); __builtin_amdgcn_sched_barrier(0); \
                { v4u f; f.x = __builtin_amdgcn_alignbit(r1, r0, sh); f.y = __builtin_amdgcn_alignbit(r2, r1, sh); f.z = __builtin_amdgcn_alignbit(r3, r2, sh); f.w = __builtin_amdgcn_alignbit(r4, r3, sh); Fw[JK] = __builtin_bit_cast(bf16x8, f); } \
                { const bf16x8 zb_ = __builtin_bit_cast(bf16x8, zf); \
                  acc[0] = __builtin_amdgcn_mfma_f32_32x32x16_bf16(Fw[(JK) & 7], zb_, acc[0], 0, 0, 0); acc[1] = __builtin_amdgcn_mfma_f32_32x32x16_bf16(Fw[((JK) - 2) & 7], zb_, acc[1], 0, 0, 0); \
                  acc[2] = __builtin_amdgcn_mfma_f32_32x32x16_bf16(Fw[((JK) - 4) & 7], zb_, acc[2], 0, 0, 0); acc[3] = __builtin_amdgcn_mfma_f32_32x32x16_bf16(Fw[((JK) - 6) & 7], zb_, acc[3], 0, 0, 0); } \
                HY_WAIT(); HY_TAKE(); } while (0)
            HY_LOADS(0, 0); HY_WAIT(); HY_TAKE();
            for (int d = d_hi; d >= d_lo; --d) {
                HY_STEP(0, 8, 32); HY_STEP(1, 16, 64); HY_STEP(2, 24, 96); HY_STEP(3, 32, 128); HY_STEP(4, 40, 160); HY_STEP(5, 48, 192); HY_STEP(6, 56, 224); HY_STEP(7, 64, SLOTB);
                ap += 256; bp += SLOTB;
            }
#undef HY_LOADS
#undef HY_WAIT
#undef HY_TAKE
#undef HY_STEP
        }
        LDS_WAIT(); __syncthreads();
        {
            LAS float* X = (LAS float*)(lds + F_OFF) + wave * 2048;
#pragma unroll
            for (int t = 0; t < 2; ++t)
#pragma unroll
                for (int rg = 0; rg < 16; ++rg) X[(t * 16 + rg) * 64 + lane] = (half == 0) ? acc[2 + t][rg] : acc[t][rg];
        }
        LDS_WAIT(); __syncthreads();
        f32x16 fin[2];
        {
            const LAS float* X = (const LAS float*)(lds + F_OFF) + (wave ^ 4) * 2048;
#pragma unroll
            for (int t = 0; t < 2; ++t)
#pragma unroll
                for (int rg = 0; rg < 16; ++rg) fin[t][rg] = ((half == 0) ? acc[t][rg] : acc[2 + t][rg]) + X[(t * 16 + rg) * 64 + lane];
        }
        LDS_WAIT(); __syncthreads();
        {
            const int ch = o * HW + c; const float w0 = P.conv_w[ch], w1 = P.conv_w[3 * HW + ch], w2 = P.conv_w[6 * HW + ch], b = P.conv_b[ch];
            const bf16* urow = P.uT + (size_t)ch * MTOK + T0;
            for (int it = 0; it < 4; ++it) { const int chunk = tid + it * 512; float v[8]; conv3_chunk(urow, g, chunk, w0, w1, w2, b, v);
                LAS f32x4* dst = (LAS f32x4*)(lds + F_OFF + chunk * 32); dst[0] = (f32x4){v[0], v[1], v[2], v[3]}; dst[1] = (f32x4){v[4], v[5], v[6], v[7]}; }
        }
        LDS_WAIT(); __syncthreads();
        {
            const float sb = P.hbias[o * HW + c], inr = o ? inv_norm1 : inv_norm0;
            const LAS float* G = (const LAS float*)(lds + F_OFF);
            const int n = 32 * nt + r; LAS bf16* zs = (LAS bf16*)(lds + slot_of(g, n) * SLOTB);
#pragma unroll
            for (int t = 0; t < 2; ++t)
#pragma unroll
                for (int rg = 0; rg < 16; ++rg) { const int i = 32 * (mi0 + t) + crow(rg, hi);
                    const float zo = bf2f(zs[i]);
#if PROBE >= 100
                    if (c == 137) { P.dF[(g * 2 + o) * 16384 + 128 * n + i] = fin[t][rg]; P.dZ[(g * 2 + o) * 16384 + 128 * n + i] = zs[i]; }
#endif
                    const float val = G[128 * n + i] * (inr * fin[t][rg] + sb * zo); zs[i] = (bf16)f2bf(val); }
        }
        LDS_WAIT(); __syncthreads();
    }
    {
        bf16* yrow = P.yT + (size_t)c * MTOK + T0;
        for (int it = 0; it < 4; ++it) { const int chunk = tid + it * 512, tau0 = chunk * 8;
            *(GAS v4u*)(yrow + tau0) = *(const LAS v4u*)(lds + slot_of(g, tau0 >> 7) * SLOTB + (tau0 & 127) * 2); }
    }
    LDS_WAIT(); __syncthreads();
}
}

namespace fc {
constexpr int OST = 1032, PLANE_B = 32 * OST * 2  , RE_OFF = 0, IM_OFF = PLANE_B, RED_OFF = 2 * PLANE_B, T3_OFF = RED_OFF + 64;
constexpr int NFFT = 32768;
enum { F1 = 0, F2 = 1, F3 = 2, I1 = 3, I2 = 4, I3 = 5 };
__device__ __forceinline__ int crow(int r, int hi) { return (r & 3) + 8 * (r >> 2) + 4 * hi; }
__device__ __forceinline__ int sw(int mid) { return 0; }
struct Params { const bf16* uT; const bf16* kc; const float* fpart_s; const float* conv_w; const float* conv_b; const float* hbias; bf16* yT; bf16* hs; bf16* z1s; float* dF; bf16* dZ; };
typedef float f32x2_ __attribute__((ext_vector_type(2)));
struct FMat { bf16x8 fr[2], fi[2], nfi[2]; };

__device__ __forceinline__ void make_fmat(FMat& M, int r, int h) {
#pragma unroll
    for (int ks = 0; ks < 2; ++ks) { v4u a, b, c;
#pragma unroll
        for (int w = 0; w < 4; ++w) { float cv[2], sv[2];
#pragma unroll
            for (int e = 0; e < 2; ++e) { const int aidx = 16 * ks + 8 * h + 2 * w + e; const float fr_ = (float)((aidx * r) & 31) * (1.0f / 32.0f); cv[e] = __builtin_amdgcn_cosf(fr_); sv[e] = __builtin_amdgcn_sinf(fr_); }
            a[w] = pk2(cv[0], cv[1]); b[w] = pk2(-sv[0], -sv[1]); c[w] = pk2(sv[0], sv[1]); }
        M.fr[ks] = __builtin_bit_cast(bf16x8, a); M.fi[ks] = __builtin_bit_cast(bf16x8, b); M.nfi[ks] = __builtin_bit_cast(bf16x8, c); }
}

template <int ST, bool REAL_IN, bool HALF_K>
__device__ __forceinline__ void stage(LAS unsigned char* lds, const FMat& M, int wave, int r_, int h_) {
    int r = r_, h = h_; asm volatile("" : "+v"(r), "+v"(h));
    float t2c[16], t2s[16];
    if (ST == F1 || ST == F2 || ST == I1 || ST == I2) {
#pragma unroll
        for (int rg = 0; rg < 16; ++rg) { const int rho = (rg & 3) + 8 * (rg >> 2) + 4 * h; const float fr_ = (float)(r * rho) * (1.0f / 1024.0f); t2c[rg] = __builtin_amdgcn_cosf(fr_); t2s[rg] = __builtin_amdgcn_sinf(fr_); }
    }
    constexpr bool INV = (ST >= I1);
    const f32x16 zero16 = (f32x16){0.f,0.f,0.f,0.f,0.f,0.f,0.f,0.f,0.f,0.f,0.f,0.f,0.f,0.f,0.f,0.f};
    unsigned res[4][16];
#pragma unroll
    for (int t = 0; t < 4; ++t) {
        const int f = 4 * wave + t;
        const int base = (ST == I2) ? (32 * f + OST * r) : (32 * r + OST * f); const int swr = (ST == I2) ? sw(f) : sw(r);
        f32x16 ur = zero16, ui = zero16;
#pragma unroll
        for (int ks = 0; ks < (HALF_K ? 1 : 2); ++ks) {
            const bf16x8 xr = *(const LAS bf16x8*)(lds + RE_OFF + 2 * (base + ((16 * ks + 8 * h) ^ swr)));
            if (!INV) {
                ur = __builtin_amdgcn_mfma_f32_32x32x16_bf16(M.fr[ks], xr, ur, 0, 0, 0);
                ui = __builtin_amdgcn_mfma_f32_32x32x16_bf16(M.fi[ks], xr, ui, 0, 0, 0);
                if (!REAL_IN) { const bf16x8 xi = *(const LAS bf16x8*)(lds + IM_OFF + 2 * (base + ((16 * ks + 8 * h) ^ swr)));
                    ur = __builtin_amdgcn_mfma_f32_32x32x16_bf16(M.nfi[ks], xi, ur, 0, 0, 0);
                    ui = __builtin_amdgcn_mfma_f32_32x32x16_bf16(M.fr[ks], xi, ui, 0, 0, 0); }
            } else {
                const bf16x8 xi = *(const LAS bf16x8*)(lds + IM_OFF + 2 * (base + ((16 * ks + 8 * h) ^ swr)));
                ur = __builtin_amdgcn_mfma_f32_32x32x16_bf16(M.fr[ks], xr, ur, 0, 0, 0);
                ur = __builtin_amdgcn_mfma_f32_32x32x16_bf16(M.fi[ks], xi, ur, 0, 0, 0);
                if (ST != I3) { ui = __builtin_amdgcn_mfma_f32_32x32x16_bf16(M.fr[ks], xi, ui, 0, 0, 0);
                                ui = __builtin_amdgcn_mfma_f32_32x32x16_bf16(M.nfi[ks], xr, ui, 0, 0, 0); }
            }
        }
        if (ST == I3) {
#pragma unroll
            for (int rg = 0; rg < 8; ++rg) res[t][rg] = __float_as_uint(ur[rg]);
        } else {
            if (ST == F1 || ST == F2 || ST == I1 || ST == I2) {
                float uc = 1.f, us = 0.f;
                if (ST == I2) { const float fr_ = (float)(f * r) * (1.0f / 32768.0f); uc = __builtin_amdgcn_cosf(fr_); us = __builtin_amdgcn_sinf(fr_); }
#pragma unroll
                for (int rg = 0; rg < 16; ++rg) {
                    float c = t2c[rg], s_ = t2s[rg];
                    if (ST == F1) { const int rho = (rg & 3) + 8 * (rg >> 2) + 4 * h; const f32x2_ q = *(const LAS f32x2_*)(lds + T3_OFF + 8 * (32 * f + rho)); const float c2 = c * q.x - s_ * q.y; s_ = c * q.y + s_ * q.x; c = c2; }
                    if (ST == I2) { const float c2 = c * uc - s_ * us; s_ = c * us + s_ * uc; c = c2; }
                    const float s = INV ? s_ : -s_;
                    const float a = ur[rg], b = ui[rg];
                    ur[rg] = a * c - b * s; ui[rg] = a * s + b * c;
                }
            }
#pragma unroll
            for (int p = 0; p < 8; ++p) { res[t][p] = pk2(ur[2 * p], ur[2 * p + 1]); res[t][8 + p] = pk2(ui[2 * p], ui[2 * p + 1]); }
        }
        __builtin_amdgcn_sched_barrier(0);
    }
    LDS_WAIT(); __syncthreads();
#pragma unroll
    for (int t = 0; t < 4; ++t) {
        const int f = 4 * wave + t;
        if (ST == I3) {
            LAS float* Y = (LAS float*)(lds + IM_OFF);
#pragma unroll
            for (int rg = 0; rg < 8; ++rg) { const int rho = (rg & 3) + 8 * (rg >> 2) + 4 * h; Y[1024 * rho + 32 * r + f] = __uint_as_float(res[t][rg]); }
        } else if (ST == F3) {
#pragma unroll
            for (int g4 = 0; g4 < 4; ++g4) { const int pos = ((8 * g4 + 4 * h) ^ sw(r)) + 32 * r + OST * f;
                *(LAS v2u*)(lds + RE_OFF + 2 * pos) = (v2u){res[t][2 * g4], res[t][2 * g4 + 1]}; *(LAS v2u*)(lds + IM_OFF + 2 * pos) = (v2u){res[t][8 + 2 * g4], res[t][8 + 2 * g4 + 1]}; }
        } else {
#pragma unroll
            for (int rg = 0; rg < 16; ++rg) {
                const int rho = (rg & 3) + 8 * (rg >> 2) + 4 * h;
                const int pos = (ST == F1) ? ((r ^ sw(f)) + 32 * f + OST * rho) : ((r ^ sw(rho)) + 32 * rho + OST * f);
                const unsigned wr_ = res[t][rg >> 1], wi_ = res[t][8 + (rg >> 1)];
                *(LAS bf16*)(lds + RE_OFF + 2 * pos) = (bf16)((rg & 1) ? (wr_ >> 16) : (wr_ & 0xffffu));
                *(LAS bf16*)(lds + IM_OFF + 2 * pos) = (bf16)((rg & 1) ? (wi_ >> 16) : (wi_ & 0xffffu));
            }
        }
    }
    LDS_WAIT(); __syncthreads();
}

__device__ __forceinline__ void self_visible(int tid) {
    VM_WAIT(); __syncthreads();
    if (tid == 0) { __builtin_amdgcn_fence(__ATOMIC_ACQUIRE, "agent"); VM_WAIT(); }
    __syncthreads();
}

__device__ __forceinline__ void item(LAS unsigned char* lds, const Params& P, int c, int tid_, int slot) {
    int tid = tid_; asm volatile("" : "+v"(tid));
    const int wave = __builtin_amdgcn_readfirstlane(tid >> 6);
    constexpr int L = LS, T0 = TP, g = 1;
    bf16* hs = P.hs + (size_t)slot * (2 * PLANE_B / 2); bf16* z1s = P.z1s + (size_t)slot * L;
    float inv_norm0, inv_norm1;
    {
        const int lane = tid & 63; float s0 = 0.f, s1 = 0.f;
        for (int idx = lane; idx < 512; idx += 64) { const int ch = idx >> 1, dir = idx & 1; s0 += P.fpart_s[(size_t)ch * 2048 + dir * 512 + c]; s1 += P.fpart_s[(size_t)ch * 2048 + 1024 + dir * 512 + c]; }
        inv_norm0 = 1.0f / wave_sum_sw(s0); inv_norm1 = 1.0f / wave_sum_sw(s1);
    }
    FMat M; { const int r = tid & 31, h = (tid >> 5) & 1; make_fmat(M, r, h); }
    for (int i = tid; i < 1024; i += NWAVES * 64) { const float fr_ = (float)((i >> 5) * (i & 31)) * (1.0f / 32768.0f); *(LAS f32x2_*)(lds + T3_OFF + 8 * i) = (f32x2_){__builtin_amdgcn_cosf(fr_), __builtin_amdgcn_sinf(fr_)}; }
    LDS_WAIT(); __syncthreads();
    for (int o = 0; o < 2; ++o) {
        asm volatile("" : "+v"(tid));
        const int lane = tid & 63, r = lane & 31, h = lane >> 5;
        {
            const bf16* ksrc = P.kc + (size_t)(o * HW + c) * NFFT;
            v4u raw[8];
#pragma unroll
            for (int i = 0; i < 8; ++i) { const int it = 8 * wave + i, n = 1024 * (lane & 31) + 32 * (2 * (it >> 2) + (lane >> 5)) + 8 * (it & 3); raw[i] = *(const GAS v4u*)(ksrc + n); }
#pragma unroll
            for (int i = 0; i < 8; ++i) { const int it = 8 * wave + i, n = 1024 * (lane & 31) + 32 * (2 * (it >> 2) + (lane >> 5)) + 8 * (it & 3);
                const int pos0 = ((n >> 10) ^ sw((n >> 5) & 31)) + 32 * ((n >> 5) & 31) + OST * (n & 31); LAS bf16* d = (LAS bf16*)(lds + RE_OFF) + pos0;
                d[0 * OST] = (bf16)(raw[i].x & 0xffffu); d[1 * OST] = (bf16)(raw[i].x >> 16); d[2 * OST] = (bf16)(raw[i].y & 0xffffu); d[3 * OST] = (bf16)(raw[i].y >> 16);
                d[4 * OST] = (bf16)(raw[i].z & 0xffffu); d[5 * OST] = (bf16)(raw[i].z >> 16); d[6 * OST] = (bf16)(raw[i].w & 0xffffu); d[7 * OST] = (bf16)(raw[i].w >> 16); }
        }
        LDS_WAIT(); __syncthreads();
        stage<F1, true, false>(lds, M, wave, r, h); stage<F2, false, false>(lds, M, wave, r, h); stage<F3, false, false>(lds, M, wave, r, h);
        for (int i = tid; i < 2 * PLANE_B / 16; i += NWAVES * 64) *(GAS v4u*)((unsigned char*)hs + (size_t)i * 16) = *(const LAS v4u*)(lds + i * 16);
        self_visible(tid);
        {
            const int ch = 2 * HW + c; const float w0 = P.conv_w[ch], w1 = P.conv_w[3 * HW + ch], w2 = P.conv_w[6 * HW + ch], b = P.conv_b[ch];
            const bf16* urow = P.uT + (size_t)ch * MTOK + T0;
            hy::C3 q3[4]; v4u rz[4];
#pragma unroll
            for (int i = 0; i < 4; ++i) { const int it = 4 * wave + i, n = 1024 * (lane & 15) + 32 * (4 * (it >> 2) + (lane >> 4)) + 8 * (it & 3);
                if (o == 0) hy::conv3_load(urow, g, n >> 3, q3[i]); else rz[i] = *(const GAS v4u*)(z1s + n); }
#pragma unroll
            for (int i = 0; i < 4; ++i) { const int it = 4 * wave + i, n = 1024 * (lane & 15) + 32 * (4 * (it >> 2) + (lane >> 4)) + 8 * (it & 3); unsigned e[4];
                if (o == 0) { float v[8]; hy::conv3_eval(q3[i], w0, w1, w2, b, v); e[0] = pk2(v[0], v[1]); e[1] = pk2(v[2], v[3]); e[2] = pk2(v[4], v[5]); e[3] = pk2(v[6], v[7]); }
                else { e[0] = rz[i].x; e[1] = rz[i].y; e[2] = rz[i].z; e[3] = rz[i].w; }
                const int pos0 = ((n >> 10) ^ sw((n >> 5) & 31)) + 32 * ((n >> 5) & 31) + OST * (n & 31); LAS bf16* d = (LAS bf16*)(lds + RE_OFF) + pos0;
#pragma unroll
                for (int j = 0; j < 4; ++j) { d[(2 * j) * OST] = (bf16)(e[j] & 0xffffu); d[(2 * j + 1) * OST] = (bf16)(e[j] >> 16); } }
        }
        LDS_WAIT(); __syncthreads();
        stage<F1, true, true>(lds, M, wave, r, h); stage<F2, false, false>(lds, M, wave, r, h); stage<F3, false, false>(lds, M, wave, r, h);
        {
            constexpr int NCH = PLANE_B / 16, NIT = (NCH + NWAVES * 64 - 1) / (NWAVES * 64);
#pragma unroll 1
            for (int kb = 0; kb < NIT; kb += 3) {
                v4u hr[3], hi_[3];
#pragma unroll
                for (int k = 0; k < 3; ++k) { const int i = tid + (kb + k) * NWAVES * 64; if (i < NCH) { hr[k] = *(const GAS v4u*)((const unsigned char*)hs + (size_t)i * 16); hi_[k] = *(const GAS v4u*)((const unsigned char*)hs + PLANE_B + (size_t)i * 16); } }
#pragma unroll
                for (int k = 0; k < 3; ++k) { const int i = tid + (kb + k) * NWAVES * 64; if (i < NCH) {
                    const v4u xr = *(const LAS v4u*)(lds + RE_OFF + i * 16), xi = *(const LAS v4u*)(lds + IM_OFF + i * 16);
                    v4u vr, vi;
#pragma unroll
                    for (int w = 0; w < 4; ++w) {
                        const float a0 = pg8::bflo(xr[w]), a1 = pg8::bfhi(xr[w]), b0 = pg8::bflo(xi[w]), b1 = pg8::bfhi(xi[w]);
                        const float c0 = pg8::bflo(hr[k][w]) * (1.0f / 32768.0f), c1 = pg8::bfhi(hr[k][w]) * (1.0f / 32768.0f), d0 = pg8::bflo(hi_[k][w]) * (1.0f / 32768.0f), d1 = pg8::bfhi(hi_[k][w]) * (1.0f / 32768.0f);
                        vr[w] = pk2(a0 * c0 - b0 * d0, a1 * c1 - b1 * d1); vi[w] = pk2(a0 * d0 + b0 * c0, a1 * d1 + b1 * c1);
                    }
                    *(LAS v4u*)(lds + RE_OFF + i * 16) = vr; *(LAS v4u*)(lds + IM_OFF + i * 16) = vi; } }
            }
        }
        LDS_WAIT(); __syncthreads();
        stage<I1, false, false>(lds, M, wave, r, h); stage<I2, false, false>(lds, M, wave, r, h); stage<I3, false, false>(lds, M, wave, r, h);
        {
            const LAS float* Y = (const LAS float*)(lds + IM_OFF);
            const int chg = o * HW + c; const float g0 = P.conv_w[chg], g1 = P.conv_w[3 * HW + chg], g2 = P.conv_w[6 * HW + chg], gb = P.conv_b[chg];
            const int chv = 2 * HW + c; const float v0 = P.conv_w[chv], v1 = P.conv_w[3 * HW + chv], v2 = P.conv_w[6 * HW + chv], vb = P.conv_b[chv];
            const bf16* grow = P.uT + (size_t)chg * MTOK + T0; const bf16* vrow = P.uT + (size_t)chv * MTOK + T0;
            const float sb = P.hbias[o * HW + c], inr = o ? inv_norm1 : inv_norm0;
            bf16* dst = o ? (P.yT + (size_t)c * MTOK + T0) : z1s;
#pragma unroll 1
            for (int ib = 0; ib < 4; ib += 2) {
            hy::C3 qg[2], qv[2]; v4u rz[2];
#pragma unroll
            for (int it = 0; it < 2; ++it) { const int chunk = tid + (ib + it) * 512; hy::conv3_load(grow, g, chunk, qg[it]); if (o == 0) hy::conv3_load(vrow, g, chunk, qv[it]); else rz[it] = *(const GAS v4u*)(z1s + chunk * 8); }
#pragma unroll
            for (int it = 0; it < 2; ++it) { const int chunk = tid + (ib + it) * 512, n = chunk * 8; float gt[8], zo[8];
                hy::conv3_eval(qg[it], g0, g1, g2, gb, gt);
                if (o == 0) { hy::conv3_eval(qv[it], v0, v1, v2, vb, zo);
#pragma unroll
                    for (int j = 0; j < 8; ++j) zo[j] = bf2f((unsigned short)f2bf(zo[j])); }
                else { const v4u raw = rz[it]; zo[0] = pg8::bflo(raw.x); zo[1] = pg8::bfhi(raw.x); zo[2] = pg8::bflo(raw.y); zo[3] = pg8::bfhi(raw.y); zo[4] = pg8::bflo(raw.z); zo[5] = pg8::bfhi(raw.z); zo[6] = pg8::bflo(raw.w); zo[7] = pg8::bfhi(raw.w); }
                const f32x4 y0 = *(const LAS f32x4*)(Y + n), y1 = *(const LAS f32x4*)(Y + n + 4);
                float val[8];
#pragma unroll
                for (int j = 0; j < 8; ++j) { const float yv = (j < 4) ? y0[j & 3] : y1[j & 3];
#if PROBE >= 100
                    if (c == 137) { P.dF[(2 + o) * 16384 + n + j] = yv; P.dZ[(2 + o) * 16384 + n + j] = (bf16)f2bf(zo[j]); }
#endif
                    val[j] = gt[j] * (inr * yv + sb * zo[j]); }
                v4u pk; pk.x = pk2(val[0], val[1]); pk.y = pk2(val[2], val[3]); pk.z = pk2(val[4], val[5]); pk.w = pk2(val[6], val[7]);
                *(GAS v4u*)(dst + n) = pk; }
            }
        }
        self_visible(tid);
    }
}
}

namespace at {
constexpr int KROW = 144, VROW = 776, K_OFF = 0, V_OFF = 384 * KROW  , END_OFF = V_OFF + 64 * VROW;
__device__ __forceinline__ int crow(int r, int hi) { return (r & 3) + 8 * (r >> 2) + 4 * hi; }
struct Params { const bf16* q; const bf16* k; const bf16* v; const float* sink; bf16* yat; };

__device__ __forceinline__ void attn_item(LAS unsigned char* lds, const Params& P, int blk, int gk, int tid_) {
    int tid = tid_; asm volatile("" : "+v"(tid));
    const int lane = tid & 63, wave = __builtin_amdgcn_readfirstlane(tid >> 6), r = lane & 31, hi = lane >> 5;
    const int m0 = blk * 128; const int s_lo = (blk < 128) ? (m0 & ~(LP - 1)) : TP, s_hi = (blk < 128) ? s_lo + LP : MTOK; const int kw0 = m0 - 128;
    for (int it = 0; it < 6; ++it) {
        const int idx = tid + it * 512, key = idx >> 3, chn = idx & 7, tok = kw0 + key; const bool ok = (tok >= s_lo) && (tok < s_hi);
        v4u kv = (v4u){0u, 0u, 0u, 0u}, vv = (v4u){0u, 0u, 0u, 0u};
        if (ok) { kv = *(const GAS v4u*)(P.k + (size_t)tok * 128 + gk * 64 + chn * 8); vv = *(const GAS v4u*)(P.v + (size_t)tok * 128 + gk * 64 + chn * 8); }
        *(LAS v4u*)(lds + K_OFF + key * KROW + chn * 16) = kv;
        LAS bf16* vt = (LAS bf16*)(lds + V_OFF + (chn * 8) * VROW + key * 2);
        vt[0 * (VROW / 2)] = (bf16)(vv.x & 0xffffu); vt[1 * (VROW / 2)] = (bf16)(vv.x >> 16); vt[2 * (VROW / 2)] = (bf16)(vv.y & 0xffffu); vt[3 * (VROW / 2)] = (bf16)(vv.y >> 16);
        vt[4 * (VROW / 2)] = (bf16)(vv.z & 0xffffu); vt[5 * (VROW / 2)] = (bf16)(vv.z >> 16); vt[6 * (VROW / 2)] = (bf16)(vv.w & 0xffffu); vt[7 * (VROW / 2)] = (bf16)(vv.w >> 16);
    }
    LDS_WAIT(); __syncthreads();
    const int hq = 4 * gk + (wave & 3), qh = wave >> 2;
    const int klo = (s_lo - kw0) > 0 ? (s_lo - kw0) : 0, khi = (s_hi - kw0) < 384 ? (s_hi - kw0) : 384;
    const float sinkl = P.sink[hq] * 1.4426950408889634f;
    for (int qq = 0; qq < 2; ++qq) {
        const int qt = 2 * qh + qq, q0 = 32 * qt; const size_t qrow = (size_t)(m0 + q0 + r);
        bf16x8 qf[4];
#pragma unroll
        for (int ks = 0; ks < 4; ++ks) qf[ks] = *(const GAS bf16x8*)(P.q + qrow * 512 + hq * 64 + 16 * ks + 8 * hi);
        float m_run = sinkl, l_run = (hi == 0) ? 1.0f : 0.0f;
        f32x16 o0 = (f32x16){0.f,0.f,0.f,0.f,0.f,0.f,0.f,0.f,0.f,0.f,0.f,0.f,0.f,0.f,0.f,0.f}, o1 = o0;
        const int lo_r = (q0 + r) > klo ? (q0 + r) : klo, hi_r = (q0 + r + 256) < (khi - 1) ? (q0 + r + 256) : (khi - 1);
        for (int kt = qt; kt <= qt + 8; ++kt) {
            const int kb = 32 * kt;
            f32x16 s = (f32x16){0.f,0.f,0.f,0.f,0.f,0.f,0.f,0.f,0.f,0.f,0.f,0.f,0.f,0.f,0.f,0.f};
#pragma unroll
            for (int ks = 0; ks < 4; ++ks) { const bf16x8 kf = *(const LAS bf16x8*)(lds + K_OFF + (kb + r) * KROW + 32 * ks + 16 * hi);
                s = __builtin_amdgcn_mfma_f32_32x32x16_bf16(kf, qf[ks], s, 0, 0, 0); }
            float tmax = -1e30f;
#pragma unroll
            for (int rg = 0; rg < 16; ++rg) { const int kj = kb + crow(rg, hi); const float sv = (kj >= lo_r && kj <= hi_r) ? s[rg] : -1e30f; s[rg] = sv; tmax = fmaxf(tmax, sv); }
            tmax = fmaxf(tmax, __shfl_xor(tmax, 32));
            const float mnew = fmaxf(m_run, tmax); const float alpha = __builtin_amdgcn_exp2f(m_run - mnew); m_run = mnew;
            float psum = 0.f;
#pragma unroll
            for (int rg = 0; rg < 16; ++rg) { const float p = __builtin_amdgcn_exp2f(s[rg] - mnew); s[rg] = p; psum += p; }
            l_run = l_run * alpha + psum;
#pragma unroll
            for (int rg = 0; rg < 16; ++rg) { o0[rg] *= alpha; o1[rg] *= alpha; }
            v4u pa, pb;
            pa.x = pk2(s[0], s[1]); pa.y = pk2(s[2], s[3]); pa.z = pk2(s[4], s[5]); pa.w = pk2(s[6], s[7]);
            pb.x = pk2(s[8], s[9]); pb.y = pk2(s[10], s[11]); pb.z = pk2(s[12], s[13]); pb.w = pk2(s[14], s[15]);
            const bf16x8 pf0 = __builtin_bit_cast(bf16x8, pa), pf1 = __builtin_bit_cast(bf16x8, pb);
#pragma unroll
            for (int dt = 0; dt < 2; ++dt) {
                const LAS unsigned char* vb = lds + V_OFF + (32 * dt + r) * VROW + (kb + 4 * hi) * 2;
                v4u va, vc;
                { const v2u x0 = *(const LAS v2u*)(vb), x1 = *(const LAS v2u*)(vb + 16); va = (v4u){x0.x, x0.y, x1.x, x1.y}; }
                { const v2u x0 = *(const LAS v2u*)(vb + 32), x1 = *(const LAS v2u*)(vb + 48); vc = (v4u){x0.x, x0.y, x1.x, x1.y}; }
                if (dt == 0) { o0 = __builtin_amdgcn_mfma_f32_32x32x16_bf16(__builtin_bit_cast(bf16x8, va), pf0, o0, 0, 0, 0); o0 = __builtin_amdgcn_mfma_f32_32x32x16_bf16(__builtin_bit_cast(bf16x8, vc), pf1, o0, 0, 0, 0); }
                else         { o1 = __builtin_amdgcn_mfma_f32_32x32x16_bf16(__builtin_bit_cast(bf16x8, va), pf0, o1, 0, 0, 0); o1 = __builtin_amdgcn_mfma_f32_32x32x16_bf16(__builtin_bit_cast(bf16x8, vc), pf1, o1, 0, 0, 0); }
            }
        }
        l_run += __shfl_xor(l_run, 32);
        const float inv = 1.0f / l_run;
        bf16* yrow = P.yat + qrow * 512 + hq * 64;
#pragma unroll
        for (int g4 = 0; g4 < 4; ++g4) {
            v2u w0, w1;
            w0.x = pk2(o0[4 * g4] * inv, o0[4 * g4 + 1] * inv); w0.y = pk2(o0[4 * g4 + 2] * inv, o0[4 * g4 + 3] * inv);
            w1.x = pk2(o1[4 * g4] * inv, o1[4 * g4 + 1] * inv); w1.y = pk2(o1[4 * g4 + 2] * inv, o1[4 * g4 + 3] * inv);
            *(GAS v2u*)(yrow + 8 * g4 + 4 * hi) = w0; *(GAS v2u*)(yrow + 32 + 8 * g4 + 4 * hi) = w1;
        }
    }
    LDS_WAIT(); __syncthreads();
}
}

__device__ __forceinline__ void transpose_y_tile(LAS unsigned char* lds, const bf16* yT, bf16* yhy, int tile, int tid_) {
    int tid = tid_; asm volatile("" : "+v"(tid));
    const int c0 = (tile & 7) * 64, t0 = (tile >> 3) * 64;
    LAS bf16* T = (LAS bf16*)lds;
    { const int ch = tid >> 3, k8 = tid & 7; *(LAS v4u*)(T + ch * 72 + k8 * 8) = *(const GAS v4u*)(yT + (size_t)(c0 + ch) * MTOK + t0 + k8 * 8); }
    LDS_WAIT(); __syncthreads();
    { const int tk = tid >> 3, c8 = tid & 7; unsigned short e[8];
#pragma unroll
      for (int j = 0; j < 8; ++j) e[j] = T[(c8 * 8 + j) * 72 + tk];
      v4u o; o.x = e[0] | ((unsigned)e[1] << 16); o.y = e[2] | ((unsigned)e[3] << 16); o.z = e[4] | ((unsigned)e[5] << 16); o.w = e[6] | ((unsigned)e[7] << 16);
      *(GAS v4u*)(yhy + (size_t)(t0 + tk) * 512 + c0 + c8 * 8) = o; }
    LDS_WAIT(); __syncthreads();
}

#if PROBE
constexpr int CW_P = 20000;
constexpr size_t WS_DF = 484 * MiB, WS_DZ = 485 * MiB;
constexpr int PROBE_C = 137;
__device__ __forceinline__ double wave_sum_d(double v) {
#pragma unroll
    for (int o = 1; o < 64; o <<= 1) v += __shfl_xor(v, o);
    return v;
}
__device__ __forceinline__ double filt_point(const float* w1, const float* b1, const float* w2, const float* b2, const float* w3, const float* fr, int g, int p, int col, int lane) {
    const int L = g ? LS : LP; const double t = (double)p / (double)(L - 1);
    double zval = 0.0;
    if (lane == 0) zval = t;
    else if (lane < 33) { const int i = (lane - 1) & 15; const double band = 1e-4 + (double)i * ((15.0 - 1e-4) / 15.0); const double ang = (6.283185307179586 / (double)L) * (double)p * band; zval = (lane <= 16) ? cos(ang) : -sin(ang); }
    double a = (double)b1[lane];
    for (int k = 0; k < 33; ++k) a += __shfl(zval, k) * (double)w1[k * 64 + lane];
    const double h1 = sin((double)fr[lane] * a);
    a = (double)b2[lane];
    for (int i = 0; i < 64; ++i) a += __shfl(h1, i) * (double)w2[i * 64 + lane];
    const double h2 = sin((double)fr[lane] * a);
    const double out = wave_sum_d(h2 * (double)w3[lane * 2048 + col]);
    const int c = col & 511; const double dmin = log(1e-2) / 1.5, dmax = log(1e-2) / 0.3;
    const double delta = fabs(dmin + (double)c * ((dmax - dmin) / 511.0));
    return out * (exp(-t * delta) + 0.05);
}
__device__ __forceinline__ void probe_check(unsigned char* ws, unsigned* ctl, const float* w1, const float* b1, const float* w2, const float* b2, const float* w3, const float* fr, int vcu, int G, int tid) {
    const bf16* KREV_S = (const bf16*)(ws + WS_KREV_S);
    const float* DF = (const float*)(ws + WS_DF); const bf16* DZ = (const bf16*)(ws + WS_DZ);
    const int gtid = vcu * 512 + tid, lane = tid & 63, gwv = gtid >> 6, NW = G * 8;
    if (gtid < 65536) {
        const int combo = gtid >> 14, t = gtid & 16383, g = combo >> 1, o = combo & 1, L = g ? LS : LP, tl = g ? t : (t & (LP - 1)), base = t - tl;
        const bf16* kb = KREV_S + (g ? (size_t)0 : (size_t)((WS_KREV_P - WS_KREV_S) / 2)) + (size_t)(o * HW + PROBE_C) * (2 * L); const bf16* dz = DZ + combo * 16384 + base;
        double acc = 0.0;
        if (g) { for (int s = 0; s < L; ++s) { int j = tl - s; if (j < 0) j += 2 * L; acc += (double)bf2f(kb[j]) * (double)bf2f(dz[s]); } }
        else   { const bf16* kr = kb + (L - 1 - tl); for (int s = 0; s < L; ++s) acc += (double)bf2f(kr[s]) * (double)bf2f(dz[s]); }
        const float diff = fabsf((float)(acc - (double)DF[combo * 16384 + t]));
        atomicMax(ctl + CW_P + 0, __float_as_uint(diff)); atomicMax(ctl + CW_P + 1, __float_as_uint(fabsf((float)acc)));
    }
    {
        const int g = gwv & 1, L = g ? LS : LP; const int p = (int)(((unsigned)gwv * 2654435761u) >> 8) % L;
        for (int q = 0; q < 8; ++q) { const int col = (gwv * 97 + 263 * q) & 2047; const int o = col >> 10, dir = (col >> 9) & 1, c = col & 511;
            if (dir == 1 && p == 0) continue;
            const double kv = filt_point(w1, b1, w2, b2, w3, fr, g, p, col, lane);
            const int m = g ? (dir ? (2 * L - p) : p) : (dir ? (L - 1 + p) : (L - 1 - p)); const float st = bf2f((KREV_S + (g ? (size_t)0 : (size_t)((WS_KREV_P - WS_KREV_S) / 2)) + (size_t)(o * HW + c) * (2 * L))[m]);
            if (lane == 0) { atomicMax(ctl + CW_P + 2, __float_as_uint(fabsf(st - (float)kv))); atomicMax(ctl + CW_P + 3, __float_as_uint(fabsf((float)kv))); } }
    }
    for (int which = 0; which < 2; ++which) {
        const int g = which ? 0 : 1, o = which ? 0 : 1, L = g ? LS : LP; double loc = 0.0;
        for (int p = gwv; p < L; p += NW)
            for (int dir = 0; dir < 2; ++dir) { if (dir == 1 && p == 0) continue; loc += fabs(filt_point(w1, b1, w2, b2, w3, fr, g, p, o * 1024 + dir * 512 + PROBE_C, lane)); }
        if (lane == 0) atomicAdd((double*)(ctl + CW_P + 8) + which, loc);
    }
}
__device__ __forceinline__ int probe_metric_count(unsigned char* ws, unsigned* ctl) {
    const float e_conv = __uint_as_float(__hip_atomic_load(ctl + CW_P + 0, RLX_AGENT)) / fmaxf(__uint_as_float(__hip_atomic_load(ctl + CW_P + 1, RLX_AGENT)), 1e-30f);
    const float e_filt = __uint_as_float(__hip_atomic_load(ctl + CW_P + 2, RLX_AGENT)) / fmaxf(__uint_as_float(__hip_atomic_load(ctl + CW_P + 3, RLX_AGENT)), 1e-30f);
    const float* FPS = (const float*)(ws + WS_FPART_S); const float* FPP = (const float*)(ws + WS_FPART_P);
    double s1 = 0.0, s0 = 0.0;
    for (int ch = 0; ch < 256; ++ch) s1 += (double)FPS[(size_t)ch * 2048 + 1024 + PROBE_C] + (double)FPS[(size_t)ch * 2048 + 1024 + 512 + PROBE_C];
    for (int ch = 0; ch < 32; ++ch) s0 += (double)FPP[(size_t)ch * 2048 + PROBE_C] + (double)FPP[(size_t)ch * 2048 + 512 + PROBE_C];
    const double n1 = ((volatile double*)(ctl + CW_P + 8))[0], n0 = ((volatile double*)(ctl + CW_P + 8))[1];
    const float e_n1 = (float)(fabs(n1 - s1) / fmax(n1, 1e-30)), e_n0 = (float)(fabs(n0 - s0) / fmax(n0, 1e-30));
#if PROBE == 100
    float M = fmaxf(fmaxf(e_conv, e_filt * 1e-3f), fmaxf(e_n1, e_n0));
#elif PROBE == 101
    float M = e_conv;
#elif PROBE == 102
    float M = e_filt;
#else
    float M = fmaxf(e_n1, e_n0);
#endif
    float v = (log10f(fmaxf(M, 1e-12f)) + 8.0f) * 0.125f; v = fminf(fmaxf(v, 0.02f), 1.0f);
    return (int)(v * 1600.0f);
}
#endif

#ifndef MK_SPLIT
#define MK_SPLIT 0
#endif
constexpr int N_PHASES = 8;
struct Args { const float* in[23]; float* out; unsigned char* ws; int ph_lo, ph_hi; };

__global__ void __launch_bounds__(NWAVES * 64, 2) enc_fwd(Args args) {
    extern __shared__ __attribute__((aligned(16))) unsigned char lds_raw[];
    Frame F;
    F.lds = (LAS unsigned char*)lds_raw;
    F.MISC = (volatile LAS unsigned*)(F.lds + MISC_OFF);
    F.tid = threadIdx.x; F.lane = F.tid & 63; F.wave = __builtin_amdgcn_readfirstlane(F.tid >> 6);
    F.G = gridDim.x; { const int bx = blockIdx.x; F.vcu = (F.G % 8 == 0) ? (bx % 8) * (F.G / 8) + bx / 8 : bx; }
    F.ws = args.ws; F.ctl = (gu32*)(args.ws + WS_CTL);
    unsigned char* const ws = args.ws;
    for (int u = F.tid; u < (LDS_BYTES - LDSCTL_OFF) / 4; u += NWAVES * 64) ((LAS unsigned*)(F.lds + LDSCTL_OFF))[u] = 0u;
    __syncthreads();
    const int lo = args.ph_lo, hi = args.ph_hi;
    XcdBarrier bar; bar.bar = (unsigned*)(F.ctl + CW_BAR); bar.x = 0; bar.st = nullptr;
    if (hi - lo > 1) bar = xcd_barrier_post((unsigned*)(F.ctl + CW_BAR), F.MISC + 8);
#define IN(k) (lo <= (k) && (k) < hi)
#if PROBE
#define TSTAMP(k) do { if (blockIdx.x == 0 && F.tid == 0) { const unsigned long long t_ = __builtin_amdgcn_s_memrealtime(); F.MISC[16 + 2 * (k)] = (unsigned)t_; F.MISC[17 + 2 * (k)] = (unsigned)(t_ >> 32); } } while (0)
#else
#define TSTAMP(k) do { } while (0)
#endif
#define SEAM(k) do { if (IN(k) && IN((k) + 1)) xcd_barrier(bar); TSTAMP((k) + 1); } while (0)
    TSTAMP(0);

    const float* const xp = args.in[0]; const float* const xs = args.in[1];
    bf16* const WINA = (bf16*)(ws + WS_WINA); bf16* const WINB = (bf16*)(ws + WS_WINB); bf16* const WHY = (bf16*)(ws + WS_WHY); bf16* const WAT = (bf16*)(ws + WS_WAT);
    bf16* const W3T = (bf16*)(ws + WS_W3T); bf16* const WO = (bf16*)(ws + WS_WO); bf16* const WGU = (bf16*)(ws + WS_WGU); bf16* const WD = (bf16*)(ws + WS_WD);
    bf16* const XB = (bf16*)(ws + WS_XB); bf16* const YT = (bf16*)(ws + WS_YT); bf16* const YAT = (bf16*)(ws + WS_YAT);
    bf16* const KREV_S = (bf16*)(ws + WS_KREV_S); bf16* const KREV_P = (bf16*)(ws + WS_KREV_P); bf16* const UT = (bf16*)(ws + WS_UT);
    bf16* const QB = (bf16*)(ws + WS_Q); bf16* const KB = (bf16*)(ws + WS_K); bf16* const VB = (bf16*)(ws + WS_V);
    bf16* const SGH = (bf16*)(ws + WS_SGH); bf16* const SGA = (bf16*)(ws + WS_SGA);
    float* const COS = (float*)(ws + WS_COS); float* const SIN = (float*)(ws + WS_SIN); float* const RSTD = (float*)(ws + WS_RSTD); float* const SSQ = (float*)(ws + WS_SSQ);
    float* const FPART_S = (float*)(ws + WS_FPART_S); float* const FPART_P = (float*)(ws + WS_FPART_P);
    bf16* const YHY = (bf16*)(ws + WS_YHY); bf16* const MERGED = (bf16*)(ws + WS_MERGED); bf16* const X1B = (bf16*)(ws + WS_X1B); bf16* const HID = (bf16*)(ws + WS_HID);

    if (IN(0)) {
        LAS float* scr = (LAS float*)(F.lds + RING_OFF + F.wave * 16384);
        const int gw = F.vcu * NWAVES + F.wave, NGW = F.G * NWAVES;
        constexpr int I_IN = 16 * 136, I_HY = 8 * 32, I_O = 16 * 32, I_G = 16 * 88, I_D = 44 * 32, I_W3 = 64;
        constexpr int NITEMS = I_IN + 2 * I_HY + I_O + 2 * I_G + I_D + I_W3;
        for (int it = gw; it < NITEMS; it += NGW) {
            int rr = it;
            if (rr < I_IN) { const int kb = rr / 136, nb = rr % 136, n0 = 32 * nb;
                if (n0 < 3 * HW) p0_transpose_item(args.in[3], DM, INW, WINA, n0, args.in[2], scr, 64 * kb, n0, F.lane);
                else p0_transpose_item(args.in[3], DM, INW, WINB, map_projB(n0), args.in[2], scr, 64 * kb, n0, F.lane);
                continue; } rr -= I_IN;
            if (rr < I_HY) { p0_transpose_item(args.in[16], HW, DM, WHY, 32 * (rr % 32), nullptr, scr, 64 * (rr / 32), 32 * (rr % 32), F.lane); continue; } rr -= I_HY;
            if (rr < I_HY) { p0_transpose_item(args.in[17], HW, DM, WAT, 32 * (rr % 32), nullptr, scr, 64 * (rr / 32), 32 * (rr % 32), F.lane); continue; } rr -= I_HY;
            if (rr < I_O) { p0_transpose_item(args.in[18], DM, DM, WO, 32 * (rr % 32), nullptr, scr, 64 * (rr / 32), 32 * (rr % 32), F.lane); continue; } rr -= I_O;
            if (rr < I_G) { const int n0 = 32 * (rr % 88); p0_transpose_item(args.in[20], DM, FFN, WGU, (n0 >> 7) * 256 + (n0 & 127), args.in[19], scr, 64 * (rr / 88), n0, F.lane); continue; } rr -= I_G;
            if (rr < I_G) { const int n0 = 32 * (rr % 88); p0_transpose_item(args.in[21], DM, FFN, WGU, (n0 >> 7) * 256 + 128 + (n0 & 127), args.in[19], scr, 64 * (rr / 88), n0, F.lane); continue; } rr -= I_G;
            if (rr < I_D) { p0_transpose_item(args.in[22], FFN, DM, WD, 32 * (rr % 32), nullptr, scr, 64 * (rr / 32), 32 * (rr % 32), F.lane); continue; } rr -= I_D;
            p0_transpose_item(args.in[10], 64, 2048, W3T, 32 * rr, nullptr, scr, 0, 32 * rr, F.lane);
        }
        for (int m = gw; m < MTOK; m += NGW) p0_row((m < TP) ? xp + (size_t)m * DM : xs + (size_t)(m - TP) * DM, XB + (size_t)m * DM, RSTD + m, F.lane);
        for (int idx = F.vcu * (NWAVES * 64) + F.tid; idx < LS * 32; idx += F.G * NWAVES * 64) {
            const int pos = idx >> 5, i = idx & 31; const double inv = exp2(-(double)i * (13.287712379549449 / 32.0)); const double ang = (double)pos * inv;
            COS[idx] = (float)cos(ang); SIN[idx] = (float)sin(ang);
        }
    }
    SEAM(0);

    if (IN(1)) {
        {
            constexpr int NU = (MTOK / 256) * (NPROJ / 256);
            const int heavy = NU % F.G, lb = heavy ? (int)blockIdx.x - heavy : (int)blockIdx.x, nlb = heavy ? F.G - heavy : F.G;
            if (lb >= 0) {
                filter_stage_weights(F.lds, args.in[6], args.in[7], args.in[8], args.in[9], args.in[11], F.tid);
                for (int it = lb * NWAVES + F.wave; it < 288 * 2; it += nlb * NWAVES) {
                    const int dir = it & 1, ca = it >> 1, g = (ca < 256) ? 1 : 0, chunk = g ? ca : ca - 256;
                    filter_item(F.lds, W3T, KREV_S + (g ? (size_t)0 : (size_t)((WS_KREV_P - WS_KREV_S) / 2)), FPART_S + (g ? (size_t)0 : (size_t)((WS_FPART_P - WS_FPART_S) / 4)), g, chunk, dir, F.wave, F.lane);
                }
                LDS_WAIT(); __syncthreads();
            }
        }
        {
            pg8::Gemm g{WINA, XB, nullptr, nullptr, 3 * HW, MTOK, DM}; pg8::StaticOrder S; S.init(3 * HW, MTOK, F.G, (int)blockIdx.x);
            pg8::EpiUT E{UT, MTOK, RSTD};
            pg8::gemm_phase<pg8::EpiUT, pg8::StaticOrder, true, true>(F.lds + RING_OFF, g, S, E);
        }
        {
            pg8::Gemm g{XB, WINB, nullptr, nullptr, MTOK, NPROJ, DM}; pg8::StaticOrder S; S.init(MTOK, NPROJ, F.G, (int)blockIdx.x);
            pg8::EpiProj E{RSTD, args.in[13], args.in[14], COS, SIN, QB, KB, VB, SGH, SGA};
            pg8::gemm_phase<pg8::EpiProj, pg8::StaticOrder, true, true>(F.lds + RING_OFF, g, S, E);
        }
    }
    SEAM(1);

    if (IN(2)) {
        #if PROBE
        const hy::Params HP{UT, KREV_S, KREV_P, FPART_S, FPART_P, args.in[4], args.in[5], args.in[12], YT, (float*)(ws + WS_DF), (bf16*)(ws + WS_DZ)};
#else
        const hy::Params HP{UT, KREV_S, KREV_P, FPART_S, FPART_P, args.in[4], args.in[5], args.in[12], YT, nullptr, nullptr};
#endif
        {
#if PROBE
            const fc::Params FP{UT, KREV_S, FPART_S, args.in[4], args.in[5], args.in[12], YT, (bf16*)(ws + WS_HS), (bf16*)(ws + WS_Z1S), (float*)(ws + WS_DF), (bf16*)(ws + WS_DZ)};
#else
            const fc::Params FP{UT, KREV_S, FPART_S, args.in[4], args.in[5], args.in[12], YT, (bf16*)(ws + WS_HS), (bf16*)(ws + WS_Z1S), nullptr, nullptr};
#endif
            for (int it = F.vcu; it < HW; it += F.G) fc::item(F.lds, FP, it, F.tid, F.vcu);
        }
        TSTAMP(9);
        for (int it = F.vcu; it < HW; it += F.G) hy::hyena_item(F.lds, HP, 0, it, F.tid);
        TSTAMP(10);
        const at::Params AP{QB, KB, VB, args.in[15], YAT};
        for (int it = F.vcu; it < 512; it += F.G) at::attn_item(F.lds, AP, it >> 1, it & 1, F.tid);
    }
    SEAM(2);
#if PROBE >= 100
    probe_check(ws, (unsigned*)F.ctl, args.in[6], args.in[7], args.in[8], args.in[9], args.in[10], args.in[11], F.vcu, F.G, F.tid);
    xcd_barrier(bar);
#endif

    if (IN(3)) {
        for (int t = F.vcu; t < 8 * 512; t += F.G) transpose_y_tile(F.lds, YT, YHY, t, F.tid);
    }
    SEAM(3);

    if (IN(4)) {
        pg8::Gemm g{YHY, WHY, YAT, WAT, MTOK, DM, HW}; pg8::TwoPartOrder S; S.b.init(MTOK, DM, F.G, (int)blockIdx.x);
        pg8::EpiMerged E{SGH, SGA, MERGED};
        pg8::gemm_phase<pg8::EpiMerged, pg8::TwoPartOrder, true, true>(F.lds + RING_OFF, g, S, E);
    }
    SEAM(4);

    if (IN(5)) {
        pg8::Gemm g{MERGED, WO, nullptr, nullptr, MTOK, DM, DM}; pg8::StaticOrder S; S.init(MTOK, DM, F.G, (int)blockIdx.x);
        pg8::EpiWo E{xp, xs, X1B, SSQ};
        pg8::gemm_phase<pg8::EpiWo, pg8::StaticOrder, true, true>(F.lds + RING_OFF, g, S, E);
    }
    SEAM(5);

    if (IN(6)) {
        pg8::Gemm g{X1B, WGU, nullptr, nullptr, MTOK, 2 * FFN, DM}; pg8::StaticOrder S; S.init(MTOK, 2 * FFN, F.G, (int)blockIdx.x);
        pg8::EpiFfn1 E{SSQ, HID};
        pg8::gemm_phase<pg8::EpiFfn1, pg8::StaticOrder, true, true>(F.lds + RING_OFF, g, S, E);
    }
    SEAM(6);

    if (IN(7)) {
        pg8::Gemm g{HID, WD, nullptr, nullptr, MTOK, DM, FFN}; pg8::StaticOrder S; S.init(MTOK, DM, F.G, (int)blockIdx.x);
        pg8::EpiFfn2 E{X1B, args.out};
        pg8::gemm_phase<pg8::EpiFfn2, pg8::StaticOrder, true, true>(F.lds + RING_OFF, g, S, E);
#if PROBE
        TSTAMP(8);
        VM_WAIT(); __syncthreads();
        if (blockIdx.x == 0) {
            pg8::Unit u; S.next(1, u);
            int cnt;
#if PROBE >= 100
            cnt = probe_metric_count(ws, (unsigned*)F.ctl);
#else
            { const unsigned long long t0 = F.MISC[16] | ((unsigned long long)F.MISC[17] << 32), t8 = F.MISC[32] | ((unsigned long long)F.MISC[33] << 32);
#if PROBE == 21
              constexpr int IA = 2, IB = 9;
#elif PROBE == 22
              constexpr int IA = 9, IB = 10;
#elif PROBE == 23
              constexpr int IA = 10, IB = 3;
#else
              constexpr int IA = PROBE - 1, IB = PROBE;
#endif
              const unsigned long long ta = F.MISC[16 + 2 * IA] | ((unsigned long long)F.MISC[17 + 2 * IA] << 32), tb = F.MISC[16 + 2 * IB] | ((unsigned long long)F.MISC[17 + 2 * IB] << 32);
              cnt = (int)(1600.0f * (float)(tb - ta) / (float)(t8 - t0)); }
#endif
            for (int i = F.tid; i < cnt; i += NWAVES * 64) args.out[(size_t)(u.pm * 256 + (i & 255)) * 1024 + u.pn * 256 + (i >> 8)] = 0.f;
        }
#endif
    }
#undef IN
#undef SEAM
}

extern "C" void kernel_launch(void* const* d_in, const int* in_sizes, int n_in, void* d_out, int out_size, void* d_ws, size_t ws_size, hipStream_t stream) {
    static int grid = 0;
    if (grid == 0) {
        if (n_in != 23 || out_size != MTOK * DM || ws_size < WS_END) { fprintf(stderr, "kernel_launch: unexpected problem shape (n_in %d, out %d, ws %zu); nothing launched\n", n_in, out_size, ws_size); grid = -1; return; }
        int dev = 0, cus = 0, per_cu = 0;
        if (hipGetDevice(&dev) != hipSuccess || hipDeviceGetAttribute(&cus, hipDeviceAttributeMultiprocessorCount, dev) != hipSuccess) { fprintf(stderr, "kernel_launch: device query failed\n"); grid = -1; return; }
        if (hipFuncSetAttribute((const void*)enc_fwd, hipFuncAttributeMaxDynamicSharedMemorySize, LDS_BYTES) != hipSuccess) { fprintf(stderr, "kernel_launch: hipFuncSetAttribute failed\n"); grid = -1; return; }
        if (hipOccupancyMaxActiveBlocksPerMultiprocessor(&per_cu, (const void*)enc_fwd, NWAVES * 64, LDS_BYTES) != hipSuccess || per_cu < 1)
            fprintf(stderr, "kernel_launch: note: occupancy query reports %d workgroups per CU\n", per_cu);
        (void)hipGetLastError();
        grid = cus;
    }
    if (grid < 0) return;
    if (hipMemsetAsync((char*)d_ws + WS_CTL, 0, CTL_ZERO_BYTES, stream) != hipSuccess) { fprintf(stderr, "kernel_launch: memset failed\n"); return; }
    Args a{};
    for (int i = 0; i < 23; ++i) a.in[i] = (const float*)d_in[i];
    a.out = (float*)d_out; a.ws = (unsigned char*)d_ws;
#if MK_SPLIT
    for (int p = 0; p < N_PHASES; ++p) { a.ph_lo = p; a.ph_hi = p + 1; hipLaunchKernelGGL(enc_fwd, dim3(grid), dim3(NWAVES * 64), LDS_BYTES, stream, a); }
#else
    a.ph_lo = 0; a.ph_hi = N_PHASES;
    hipLaunchKernelGGL(enc_fwd, dim3(grid), dim3(NWAVES * 64), LDS_BYTES, stream, a);
#endif
    const hipError_t le = hipPeekAtLastError();
    if (le != hipSuccess) fprintf(stderr, "kernel_launch: launch failed: %s\n", hipGetErrorName(le));
}
```

```cpp
#include <hip/hip_runtime.h>
#include <cstdio>
#include <cstdint>
#include <cmath>
#ifndef PROBE
#define PROBE 0
#endif

namespace pg8 {
#define PG8_LAS __attribute__((address_space(3)))
typedef unsigned short bf16_t;
typedef short bf16x8 __attribute__((ext_vector_type(8)));
typedef float f32x4 __attribute__((ext_vector_type(4)));
typedef unsigned u32x4 __attribute__((ext_vector_type(4)));
constexpr int BM = 256, BK = 64, HALF = 128, HTB = HALF * BK * 2  , STAGE_BYTES = 8 * HTB, NXCD = 8, WGM = 8;

__host__ __device__ __forceinline__ int lds_byte(int r, int c) { const int st = (r >> 4) * 2 + (c >> 5), rr = r & 15, cc = c & 31, ob = rr * 64 + cc * 2; return st * 1024 + (ob ^ (((ob >> 9) & 1) << 5)); }
__host__ __device__ __forceinline__ void stage_rc(int b, int& R, int& C) { const int st = b / 1024, sb = b % 1024, swz = sb ^ (((sb >> 9) & 1) << 5); R = (st >> 1) * 16 + swz / 64; C = (st & 1) * 32 + (swz % 64) / 2; }
__host__ __device__ __forceinline__ int perm32(int rho) { const int n = rho >> 4, i = rho & 15; return 8 * (i >> 2) + 4 * n + (i & 3); }

struct Unit { int pm, pn, sel; };
struct Gemm { const bf16_t* A; const bf16_t* Bt; const bf16_t* A1; const bf16_t* Bt1; int M, N, K; };

struct StaticOrder {
    int nM, nN, nwg, G, c;
    __host__ __device__ __forceinline__ void init(int M, int N, int G_, int c_) { nM = M / BM; nN = N / BM; nwg = nM * nN; G = G_; c = c_; }
    __host__ __device__ __forceinline__ bool next(int i, Unit& u) const {
        const long L = (long)i * G + c; if (L >= nwg) return false;
        int wgid = (int)L; { const int q = nwg / NXCD, r = nwg % NXCD, xcd = wgid % NXCD, off = wgid / NXCD; wgid = (xcd < r ? xcd * (q + 1) : r * (q + 1) + (xcd - r) * q) + off; }
        const int nig = WGM * nN, gid = wgid / nig, fm = gid * WGM, gsz = (nM - fm) < WGM ? (nM - fm) : WGM;
        u.pm = fm + ((wgid % nig) % gsz); u.pn = (wgid % nig) / gsz; u.sel = 0; return true;
    }
    __device__ __forceinline__ void a_ready(const Unit&) const {}
    __device__ __forceinline__ void done(const Unit&) const {}
};
struct TwoPartOrder {
    StaticOrder b;
    __device__ __forceinline__ bool next(int i, Unit& u) const { if (!b.next(i >> 1, u)) return false; u.sel = i & 1; return true; }
    __device__ __forceinline__ void a_ready(const Unit&) const {}
    __device__ __forceinline__ void done(const Unit&) const {}
};

typedef float f32x2_c __attribute__((ext_vector_type(2))); typedef __bf16 bf16x2_c __attribute__((ext_vector_type(2)));
__device__ __forceinline__ unsigned cvt_pk_bf16(float lo, float hi) { const f32x2_c v = {lo, hi}; return __builtin_bit_cast(unsigned, __builtin_convertvector(v, bf16x2_c)); }
__device__ __forceinline__ u32x4 pack8(const f32x4 a, const f32x4 b) { u32x4 w; w.x = cvt_pk_bf16(a[0], a[1]); w.y = cvt_pk_bf16(a[2], a[3]); w.z = cvt_pk_bf16(b[0], b[1]); w.w = cvt_pk_bf16(b[2], b[3]); return w; }
__device__ __forceinline__ float bflo(unsigned w) { return __uint_as_float(w << 16); }
__device__ __forceinline__ float bfhi(unsigned w) { return __uint_as_float(w & 0xffff0000u); }
__device__ __forceinline__ void unpack8(const u32x4 w, f32x4& a, f32x4& b) { a = (f32x4){bflo(w.x), bfhi(w.x), bflo(w.y), bfhi(w.y)}; b = (f32x4){bflo(w.z), bfhi(w.z), bflo(w.w), bfhi(w.w)}; }
__device__ __forceinline__ float sigmoidf_(float v) { return __builtin_amdgcn_rcpf(1.0f + __builtin_amdgcn_exp2f(-1.4426950408889634f * v)); }

constexpr float QSCALE = 0.125f * 1.4426950408889634f;

struct EpiUT {
    static constexpr bool PERM = true, AFTER_DRAIN = false;
    bf16_t* O; int ldc; const float* rstd;
    __device__ __forceinline__ bool keep(const Unit&) const { return false; }
    __device__ __forceinline__ void operator()(f32x4 (&acc)[2][2][4][2], const Unit& u, int wr, int wc, int fr, int fq) const {
        const int row0 = u.pm * BM + wr * 64 + fr, col0 = u.pn * BM + wc * 32 + 8 * fq;
        f32x4 rs[2][2];
#pragma unroll
        for (int bj = 0; bj < 2; ++bj)
#pragma unroll
            for (int n = 0; n < 2; ++n) rs[bj][n] = *(const f32x4*)(rstd + col0 + bj * HALF + 4 * n);
#pragma unroll
        for (int ai = 0; ai < 2; ++ai)
#pragma unroll
            for (int m = 0; m < 4; ++m) { bf16_t* rowp = O + (size_t)(row0 + ai * HALF + m * 16) * ldc + col0;
#pragma unroll
                for (int bj = 0; bj < 2; ++bj) *(u32x4*)(rowp + bj * HALF) = pack8(acc[ai][bj][m][0] * rs[bj][0], acc[ai][bj][m][1] * rs[bj][1]); }
    }
};

struct EpiProj {
    static constexpr bool PERM = true, AFTER_DRAIN = false;
    const float* rstd; const float* qw; const float* kw; const float* cs; const float* sn; bf16_t* q; bf16_t* k; bf16_t* v; bf16_t* sgh; bf16_t* sga;
    __device__ __forceinline__ bool keep(const Unit&) const { return false; }
    __device__ __forceinline__ void operator()(f32x4 (&acc)[2][2][4][2], const Unit& u, int wr, int wc, int fr, int fq) const {
        const int pn = u.pn;
        float rsv[2][4];
#pragma unroll
        for (int ai = 0; ai < 2; ++ai)
#pragma unroll
            for (int m = 0; m < 4; ++m) rsv[ai][m] = rstd[u.pm * BM + ai * HALF + wr * 64 + m * 16 + fr];
        if (pn <= 2 && !(pn == 2 && wc >= 2)) {
            const float* w = (pn < 2) ? qw : kw; const float sc = (pn < 2) ? QSCALE : 1.0f;
            const f32x4 wl0 = *(const f32x4*)(w + 8 * fq), wl1 = *(const f32x4*)(w + 8 * fq + 4), wh0 = *(const f32x4*)(w + 32 + 8 * fq), wh1 = *(const f32x4*)(w + 32 + 8 * fq + 4);
#pragma unroll
            for (int ai = 0; ai < 2; ++ai)
#pragma unroll
                for (int m = 0; m < 4; ++m) {
                    const int row = u.pm * BM + ai * HALF + wr * 64 + m * 16 + fr; const float rs = rsv[ai][m];
                    f32x4 a0 = acc[ai][0][m][0] * rs, a1 = acc[ai][0][m][1] * rs, b0 = acc[ai][1][m][0] * rs, b1 = acc[ai][1][m][1] * rs;
                    f32x4 sq = a0 * a0 + a1 * a1 + b0 * b0 + b1 * b1; float ss = (sq[0] + sq[1]) + (sq[2] + sq[3]);
                    ss += __shfl_xor(ss, 16); ss += __shfl_xor(ss, 32);
                    const float inv = 1.0f / sqrtf(ss * (1.0f / 64.0f) + 1e-6f);
                    const int pos = row < 16384 ? (row & 2047) : (row - 16384);
                    const f32x4 c0 = *(const f32x4*)(cs + pos * 32 + 8 * fq), c1 = *(const f32x4*)(cs + pos * 32 + 8 * fq + 4), s0 = *(const f32x4*)(sn + pos * 32 + 8 * fq), s1 = *(const f32x4*)(sn + pos * 32 + 8 * fq + 4);
                    a0 = a0 * inv * wl0; a1 = a1 * inv * wl1; b0 = b0 * inv * wh0; b1 = b1 * inv * wh1;
                    const f32x4 lo0 = (a0 * c0 - b0 * s0) * sc, lo1 = (a1 * c1 - b1 * s1) * sc, hi0 = (b0 * c0 + a0 * s0) * sc, hi1 = (b1 * c1 + a1 * s1) * sc;
                    bf16_t* dst = (pn < 2) ? q + (size_t)row * 512 + (4 * pn + wc) * 64 + 8 * fq : k + (size_t)row * 128 + wc * 64 + 8 * fq;
                    *(u32x4*)dst = pack8(lo0, lo1); *(u32x4*)(dst + 32) = pack8(hi0, hi1);
                }
        } else if (pn == 2) {
#pragma unroll
            for (int ai = 0; ai < 2; ++ai)
#pragma unroll
                for (int m = 0; m < 4; ++m) {
                    const int row = u.pm * BM + ai * HALF + wr * 64 + m * 16 + fr; const float rs = rsv[ai][m];
                    bf16_t* dst = v + (size_t)row * 128 + (wc - 2) * 64 + 8 * fq;
                    *(u32x4*)dst = pack8(acc[ai][0][m][0] * rs, acc[ai][0][m][1] * rs); *(u32x4*)(dst + 32) = pack8(acc[ai][1][m][0] * rs, acc[ai][1][m][1] * rs);
                }
        } else {
            bf16_t* base = (pn < 7) ? sgh : sga; const int colb = (pn - ((pn < 7) ? 3 : 7)) * BM + wc * 32 + 8 * fq;
#pragma unroll
            for (int ai = 0; ai < 2; ++ai)
#pragma unroll
                for (int m = 0; m < 4; ++m) {
                    const int row = u.pm * BM + ai * HALF + wr * 64 + m * 16 + fr; const float rs = rsv[ai][m];
#pragma unroll
                    for (int bj = 0; bj < 2; ++bj) { f32x4 g0 = acc[ai][bj][m][0] * rs, g1 = acc[ai][bj][m][1] * rs;
#pragma unroll
                        for (int e = 0; e < 4; ++e) { g0[e] = sigmoidf_(g0[e]); g1[e] = sigmoidf_(g1[e]); }
                        *(u32x4*)(base + (size_t)row * 1024 + colb + bj * HALF) = pack8(g0, g1); }
                }
        }
    }
};

struct EpiMerged {
    static constexpr bool PERM = true, AFTER_DRAIN = false;
    const bf16_t* sgh; const bf16_t* sga; bf16_t* out;
    __device__ __forceinline__ bool keep(const Unit& u) const { return u.sel == 0; }
    __device__ __forceinline__ void operator()(f32x4 (&acc)[2][2][4][2], const Unit& u, int wr, int wc, int fr, int fq) const {
#pragma unroll
        for (int ai = 0; ai < 2; ++ai) {
            u32x4 ga[4][2], gh[4][2];
#pragma unroll
            for (int m = 0; m < 4; ++m) { const size_t off = (size_t)(u.pm * BM + ai * HALF + wr * 64 + m * 16 + fr) * 1024 + u.pn * BM + wc * 32 + 8 * fq;
#pragma unroll
                for (int bj = 0; bj < 2; ++bj) { ga[m][bj] = *(const u32x4*)(sga + off + bj * HALF); if (u.sel == 0) gh[m][bj] = *(const u32x4*)(sgh + off + bj * HALF); } }
#pragma unroll
            for (int m = 0; m < 4; ++m) { const size_t off = (size_t)(u.pm * BM + ai * HALF + wr * 64 + m * 16 + fr) * 1024 + u.pn * BM + wc * 32 + 8 * fq;
#pragma unroll
                for (int bj = 0; bj < 2; ++bj) {
                    f32x4 t0, t1; unpack8(ga[m][bj], t0, t1);
                    if (u.sel == 0) { f32x4 h0, h1; unpack8(gh[m][bj], h0, h1);
                        f32x4 q0, q1;
#pragma unroll
                        for (int e = 0; e < 4; ++e) { q0[e] = h0[e] * __builtin_amdgcn_rcpf(t0[e]); q1[e] = h1[e] * __builtin_amdgcn_rcpf(t1[e]); }
                        acc[ai][bj][m][0] = acc[ai][bj][m][0] * q0; acc[ai][bj][m][1] = acc[ai][bj][m][1] * q1; }
                    else *(u32x4*)(out + off + bj * HALF) = pack8(acc[ai][bj][m][0] * t0, acc[ai][bj][m][1] * t1);
                } }
        }
    }
};

struct EpiWo {
    static constexpr bool PERM = true, AFTER_DRAIN = false;
    const float* xp; const float* xs; bf16_t* x1b; float* ssq;
    __device__ __forceinline__ bool keep(const Unit&) const { return false; }
    __device__ __forceinline__ void operator()(f32x4 (&acc)[2][2][4][2], const Unit& u, int wr, int wc, int fr, int fq) const {
        const float* xb = (u.pm < 64) ? xp : xs - (size_t)16384 * 1024;
#pragma unroll
        for (int ai = 0; ai < 2; ++ai) {
            f32x4 xv[4][2][2];
#pragma unroll
            for (int m = 0; m < 4; ++m) { const size_t off = (size_t)(u.pm * BM + ai * HALF + wr * 64 + m * 16 + fr) * 1024 + u.pn * BM + wc * 32 + 8 * fq;
#pragma unroll
                for (int bj = 0; bj < 2; ++bj) { xv[m][bj][0] = *(const f32x4*)(xb + off + bj * HALF); xv[m][bj][1] = *(const f32x4*)(xb + off + bj * HALF + 4); } }
#pragma unroll
            for (int m = 0; m < 4; ++m) {
                const int row = u.pm * BM + ai * HALF + wr * 64 + m * 16 + fr; const size_t off = (size_t)row * 1024 + u.pn * BM + wc * 32 + 8 * fq; float s = 0.f;
#pragma unroll
                for (int bj = 0; bj < 2; ++bj) {
                    const f32x4 v0 = xv[m][bj][0] + acc[ai][bj][m][0], v1 = xv[m][bj][1] + acc[ai][bj][m][1];
                    *(u32x4*)(x1b + off + bj * HALF) = pack8(v0, v1);
                    const f32x4 q = v0 * v0 + v1 * v1; s += (q[0] + q[1]) + (q[2] + q[3]); }
                s += __shfl_xor(s, 16); s += __shfl_xor(s, 32);
                if (fq == 0) ssq[(size_t)row * 16 + u.pn * 4 + wc] = s;
            }
        }
    }
};

struct EpiFfn1 {
    static constexpr bool PERM = true, AFTER_DRAIN = false;
    const float* ssq; bf16_t* hid;
    __device__ __forceinline__ bool keep(const Unit&) const { return false; }
    __device__ __forceinline__ void operator()(f32x4 (&acc)[2][2][4][2], const Unit& u, int wr, int wc, int fr, int fq) const {
        f32x4 pv[2][4];
#pragma unroll
        for (int ai = 0; ai < 2; ++ai)
#pragma unroll
            for (int m = 0; m < 4; ++m) pv[ai][m] = *(const f32x4*)(ssq + (size_t)(u.pm * BM + ai * HALF + wr * 64 + m * 16 + fr) * 16 + 4 * fq);
#pragma unroll
        for (int ai = 0; ai < 2; ++ai)
#pragma unroll
            for (int m = 0; m < 4; ++m) {
                const int row = u.pm * BM + ai * HALF + wr * 64 + m * 16 + fr;
                const f32x4 p = pv[ai][m]; float t = (p[0] + p[1]) + (p[2] + p[3]);
                t += __shfl_xor(t, 16); t += __shfl_xor(t, 32);
                const float r = 1.0f / sqrtf(t * (1.0f / 1024.0f) + 1e-6f);
                f32x4 h0, h1;
#pragma unroll
                for (int e = 0; e < 4; ++e) { const float g0 = acc[ai][0][m][0][e] * r, g1 = acc[ai][0][m][1][e] * r;
                    h0[e] = g0 * sigmoidf_(g0) * (acc[ai][1][m][0][e] * r); h1[e] = g1 * sigmoidf_(g1) * (acc[ai][1][m][1][e] * r); }
                *(u32x4*)(hid + (size_t)row * 2816 + u.pn * HALF + wc * 32 + 8 * fq) = pack8(h0, h1);
            }
    }
};

struct EpiFfn2 {
    static constexpr bool PERM = true, AFTER_DRAIN = false;
    const bf16_t* x1b; float* out;
    __device__ __forceinline__ bool keep(const Unit&) const { return false; }
    __device__ __forceinline__ void operator()(f32x4 (&acc)[2][2][4][2], const Unit& u, int wr, int wc, int fr, int fq) const {
        u32x4 rv[2][4][2];
#pragma unroll
        for (int ai = 0; ai < 2; ++ai)
#pragma unroll
            for (int m = 0; m < 4; ++m) { const size_t off = (size_t)(u.pm * BM + ai * HALF + wr * 64 + m * 16 + fr) * 1024 + u.pn * BM + wc * 32 + 8 * fq;
#pragma unroll
                for (int bj = 0; bj < 2; ++bj) rv[ai][m][bj] = *(const u32x4*)(x1b + off + bj * HALF); }
#pragma unroll
        for (int ai = 0; ai < 2; ++ai)
#pragma unroll
            for (int m = 0; m < 4; ++m) {
                const size_t off = (size_t)(u.pm * BM + ai * HALF + wr * 64 + m * 16 + fr) * 1024 + u.pn * BM + wc * 32 + 8 * fq; float* p = out + off;
#pragma unroll
                for (int bj = 0; bj < 2; ++bj) { f32x4 r0, r1; unpack8(rv[ai][m][bj], r0, r1);
                    *(f32x4*)(p + bj * HALF) = r0 + acc[ai][bj][m][0]; *(f32x4*)(p + bj * HALF + 4) = r1 + acc[ai][bj][m][1]; }
            }
    }
};

__device__ __forceinline__ void zero_acc(f32x4 (&acc)[2][2][4][2]) {
#pragma unroll
    for (int a = 0; a < 2; ++a)
#pragma unroll
        for (int b = 0; b < 2; ++b)
#pragma unroll
            for (int m = 0; m < 4; ++m)
#pragma unroll
                for (int n = 0; n < 2; ++n) acc[a][b][m][n] = (f32x4){0.f, 0.f, 0.f, 0.f};
}
template <class Epi, class Sched, bool ALIGN_EPI = false, bool SP2 = false>
__device__ __forceinline__ void gemm_phase(PG8_LAS unsigned char* lds, const Gemm g, const Sched& S, const Epi& E) {
    int tid = threadIdx.x; asm volatile("" : "+v"(tid));
    const int wid = __builtin_amdgcn_readfirstlane(tid >> 6), lane = tid & 63, wr = wid >> 2, wc = wid & 3, fr = lane & 15, fq = lane >> 4;
    const int K = g.K, nt = K / BK;
    unsigned voffA[2], voffB[2];
#pragma unroll
    for (int i = 0; i < 2; ++i) { int R, C; stage_rc(tid * 16 + i * 8192, R, C); const int Rb = Epi::PERM ? ((R & ~31) + perm32(R & 31)) : R;
        voffA[i] = (unsigned)(R * K + C) * 2u; voffB[i] = (unsigned)(Rb * K + C) * 2u; }
    const size_t kstep = (size_t)(BK * 2);
    const size_t hstep = (size_t)HALF * K * 2;
    const size_t tstep = 2 * hstep;
    const unsigned ldsw = (unsigned)wid * 1024u;
    const int aoff = lds_byte(wr * 64 + fr, fq * 8), boff = lds_byte(wc * 32 + fr, fq * 8);
#define PG8_SA(b, h) (((b) * 2 + (h)) * HTB)
#define PG8_SB(b, h) ((4 + (b) * 2 + (h)) * HTB)
#define PG8_STAGE(bufoff, gbase, voff) do { _Pragma("unroll") for (int _i = 0; _i < 2; ++_i) \
        __builtin_amdgcn_global_load_lds((const unsigned*)((const char*)(gbase) + (voff)[_i]), (PG8_LAS unsigned*)(lds + (bufoff) + ldsw + _i * 8192), 16, 0, 0); } while (0)
#define PG8_LDA(dst, b, h) do { _Pragma("unroll") for (int m = 0; m < 4; ++m) _Pragma("unroll") for (int k = 0; k < 2; ++k) dst[m][k] = *(const PG8_LAS bf16x8*)(lds + PG8_SA(b, h) + aoff + m * 2048 + k * 1024); } while (0)
#define PG8_LDB(dst, b, h) do { _Pragma("unroll") for (int n = 0; n < 2; ++n) _Pragma("unroll") for (int k = 0; k < 2; ++k) dst[n][k] = *(const PG8_LAS bf16x8*)(lds + PG8_SB(b, h) + boff + n * 2048 + k * 1024); } while (0)
#define PG8_MMA(ai, bj, At, Bt) do { __builtin_amdgcn_s_setprio(1); _Pragma("unroll") for (int m = 0; m < 4; ++m) _Pragma("unroll") for (int n = 0; n < 2; ++n) _Pragma("unroll") for (int k = 0; k < 2; ++k) \
        acc[ai][bj][m][n] = __builtin_amdgcn_mfma_f32_16x16x32_bf16(Bt[n][k], At[m][k], acc[ai][bj][m][n], 0, 0, 0); __builtin_amdgcn_s_setprio(0); } while (0)
#define PG8_WAIT_V(n) asm volatile("s_waitcnt vmcnt(" #n ")" ::: "memory")
#define PG8_WAIT_L(n) asm volatile("s_waitcnt lgkmcnt(" #n ")" ::: "memory")
#define PG8_BAR __builtin_amdgcn_s_barrier()
#define PG8_SCHED __builtin_amdgcn_sched_barrier(0)
    Unit cur, nxt; int ui = 0;
    if (!S.next(0, cur)) return;
    f32x4 acc[2][2][4][2];
#pragma unroll
    for (int a = 0; a < 2; ++a)
#pragma unroll
        for (int b = 0; b < 2; ++b)
#pragma unroll
            for (int m = 0; m < 4; ++m)
#pragma unroll
                for (int n = 0; n < 2; ++n) acc[a][b][m][n] = (f32x4){0.f, 0.f, 0.f, 0.f};
    bf16x8 At[4][2], B0[2][2], B1[2][2];
    const char* cA = (const char*)(cur.sel ? g.A1 : g.A) + (size_t)cur.pm * tstep; const char* cB = (const char*)(cur.sel ? g.Bt1 : g.Bt) + (size_t)cur.pn * tstep;
    S.a_ready(cur);
    if constexpr (SP2) {
        PG8_STAGE(PG8_SB(0, 0), cB, voffB); PG8_STAGE(PG8_SB(0, 1), cB + hstep, voffB); PG8_STAGE(PG8_SA(0, 0), cA, voffA); PG8_STAGE(PG8_SA(0, 1), cA + hstep, voffA);
        if (wr == 1) PG8_BAR;
        PG8_WAIT_V(2); PG8_BAR;
        PG8_STAGE(PG8_SB(1, 0), cB + kstep, voffB); PG8_STAGE(PG8_SA(1, 0), cA + kstep, voffA); PG8_STAGE(PG8_SB(1, 1), cB + hstep + kstep, voffB);
        PG8_WAIT_V(6); PG8_BAR;
    } else {
        PG8_STAGE(PG8_SB(0, 0), cB, voffB); PG8_STAGE(PG8_SA(0, 0), cA, voffA); PG8_STAGE(PG8_SB(0, 1), cB + hstep, voffB); PG8_STAGE(PG8_SA(0, 1), cA + hstep, voffA);
        if (wr == 1) PG8_BAR;
        PG8_WAIT_V(4); PG8_BAR;
        PG8_STAGE(PG8_SB(1, 0), cB + kstep, voffB); PG8_STAGE(PG8_SA(1, 0), cA + kstep, voffA); PG8_STAGE(PG8_SB(1, 1), cB + hstep + kstep, voffB);
        PG8_WAIT_V(6); PG8_BAR;
    }
    for (;;) {
        const bool has_next = S.next(ui + 1, nxt);
        const char* nA = has_next ? (const char*)(nxt.sel ? g.A1 : g.A) + (size_t)nxt.pm * tstep : cA; const char* nB = has_next ? (const char*)(nxt.sel ? g.Bt1 : g.Bt) + (size_t)nxt.pn * tstep : cB;
        for (int t = 0; t < nt; t += 2) {
            const bool last = (t == nt - 2);
            const char* a1 = cA + (size_t)(t + 1) * kstep;
            const char* a2 = last ? nA : cA + (size_t)(t + 2) * kstep; const char* b2 = last ? nB : cB + (size_t)(t + 2) * kstep;
            const char* a3 = a2 + kstep; const char* b3 = b2 + kstep;
            if (last && has_next) S.a_ready(nxt);
            if constexpr (SP2) {
            PG8_LDB(B0, 0, 0); PG8_LDB(B1, 0, 1); PG8_SCHED; PG8_LDA(At, 0, 0); PG8_STAGE(PG8_SA(1, 1), a1 + hstep, voffA);
            PG8_WAIT_V(8); PG8_WAIT_L(0); PG8_BAR; PG8_MMA(0, 0, At, B0); PG8_MMA(0, 1, At, B1); PG8_BAR; PG8_SCHED;
            PG8_LDA(At, 0, 1); PG8_STAGE(PG8_SB(0, 0), b2, voffB); PG8_STAGE(PG8_SB(0, 1), b2 + hstep, voffB); PG8_STAGE(PG8_SA(0, 0), a2, voffA);
            PG8_WAIT_V(8); PG8_WAIT_L(0); PG8_BAR; PG8_MMA(1, 0, At, B0); PG8_MMA(1, 1, At, B1); PG8_BAR; PG8_SCHED;
            PG8_LDB(B0, 1, 0); PG8_LDB(B1, 1, 1); PG8_SCHED; PG8_LDA(At, 1, 0); PG8_STAGE(PG8_SA(0, 1), a2 + hstep, voffA);
            PG8_WAIT_V(8); PG8_WAIT_L(0); PG8_BAR; PG8_MMA(0, 0, At, B0); PG8_MMA(0, 1, At, B1); PG8_BAR; PG8_SCHED;
            PG8_LDA(At, 1, 1); PG8_STAGE(PG8_SB(1, 0), b3, voffB); PG8_STAGE(PG8_SB(1, 1), b3 + hstep, voffB); PG8_STAGE(PG8_SA(1, 0), a3, voffA);
            PG8_WAIT_V(8); PG8_WAIT_L(0); PG8_BAR; PG8_MMA(1, 0, At, B0); PG8_MMA(1, 1, At, B1); PG8_BAR; PG8_SCHED;
            } else {
            PG8_LDB(B0, 0, 0); PG8_SCHED; PG8_LDA(At, 0, 0); PG8_STAGE(PG8_SA(1, 1), a1 + hstep, voffA);
            PG8_WAIT_L(8); PG8_BAR; PG8_WAIT_L(0); PG8_MMA(0, 0, At, B0); PG8_BAR; PG8_SCHED;
            PG8_LDB(B1, 0, 1); PG8_STAGE(PG8_SB(0, 0), b2, voffB);
            PG8_BAR; PG8_WAIT_L(0); PG8_MMA(0, 1, At, B1); PG8_BAR;
            PG8_LDA(At, 0, 1); PG8_STAGE(PG8_SA(0, 0), a2, voffA);
            PG8_BAR; PG8_WAIT_L(0); PG8_MMA(1, 0, At, B0); PG8_BAR; PG8_SCHED;
            PG8_STAGE(PG8_SB(0, 1), b2 + hstep, voffB);
            PG8_WAIT_V(6); PG8_BAR; PG8_MMA(1, 1, At, B1); PG8_BAR;
            PG8_LDB(B0, 1, 0); PG8_SCHED; PG8_LDA(At, 1, 0); PG8_STAGE(PG8_SA(0, 1), a2 + hstep, voffA);
            PG8_WAIT_L(8); PG8_BAR; PG8_WAIT_L(0); PG8_MMA(0, 0, At, B0); PG8_BAR; PG8_SCHED;
            PG8_LDB(B1, 1, 1); PG8_STAGE(PG8_SB(1, 0), b3, voffB);
            PG8_BAR; PG8_WAIT_L(0); PG8_MMA(0, 1, At, B1); PG8_BAR;
            PG8_LDA(At, 1, 1); PG8_STAGE(PG8_SA(1, 0), a3, voffA);
            PG8_BAR; PG8_WAIT_L(0); PG8_MMA(1, 0, At, B0); PG8_BAR; PG8_SCHED;
            PG8_STAGE(PG8_SB(1, 1), b3 + hstep, voffB);
            PG8_WAIT_V(6); PG8_BAR; PG8_MMA(1, 1, At, B1); PG8_BAR;
            }
        }
        if constexpr (ALIGN_EPI) { if (wr == 0) PG8_BAR; }
        if constexpr (!Epi::AFTER_DRAIN) { E(acc, cur, wr, wc, fr, fq); S.done(cur); }
        if (!has_next) break;
        if (!E.keep(cur)) zero_acc(acc);
        cur = nxt; cA = nA; cB = nB; ++ui;
        if constexpr (ALIGN_EPI) { if (wr == 1) PG8_BAR; }
    }
    PG8_WAIT_V(0);
    if constexpr (!ALIGN_EPI) { if (wr == 0) PG8_BAR; }
    PG8_BAR;
    if constexpr (Epi::AFTER_DRAIN) { E.fused(acc, cur, wr, wc, fr, fq, lds, wid, lane); S.done(cur); }
#undef PG8_SA
#undef PG8_SB
#undef PG8_STAGE
#undef PG8_LDA
#undef PG8_LDB
#undef PG8_MMA
#undef PG8_WAIT_V
#undef PG8_WAIT_L
#undef PG8_BAR
#undef PG8_SCHED
}}

constexpr int NWAVES = 8;
constexpr int DM = 1024, MTOK = 32768, TP = 16384  , LP = 2048, LS = 16384;
constexpr int HW = 512, INW = 4352, FFN = 2816, NPROJ = INW - 3 * HW  ;
constexpr float RMS_EPS = 1e-6f;

constexpr size_t MiB = 1u << 20;
constexpr size_t WS_CTL = 0, CTL_ZERO_BYTES = 1 * MiB;
constexpr size_t WS_WINA = 1 * MiB;
constexpr size_t WS_WINB = 4 * MiB;
constexpr size_t WS_WHY = 10 * MiB;
constexpr size_t WS_WAT = 11 * MiB;
constexpr size_t WS_WO = 12 * MiB;
constexpr size_t WS_WGU = 14 * MiB;
constexpr size_t WS_WD = 25 * MiB;
constexpr size_t WS_W3T = 31 * MiB;
constexpr size_t WS_XB = 32 * MiB;
constexpr size_t WS_YT = 32 * MiB;
constexpr size_t WS_YAT = 64 * MiB;
constexpr size_t WS_KREV_S = 96 * MiB;
constexpr size_t WS_KREV_P = 160 * MiB;
constexpr size_t WS_UT = 168 * MiB;
constexpr size_t WS_Q = 264 * MiB;
constexpr size_t WS_K = 296 * MiB;
constexpr size_t WS_V = 304 * MiB;
constexpr size_t WS_SGH = 312 * MiB;
constexpr size_t WS_SGA = 376 * MiB;
constexpr size_t WS_COS = 440 * MiB;
constexpr size_t WS_SIN = 442 * MiB;
constexpr size_t WS_RSTD = 444 * MiB;
constexpr size_t WS_SSQ = 445 * MiB;
constexpr size_t WS_FPART_S = 447 * MiB;
constexpr size_t WS_FPART_P = 449 * MiB;
constexpr size_t WS_YHY = 450 * MiB;
constexpr size_t WS_MERGED = 168 * MiB;
constexpr size_t WS_X1B = 232 * MiB;
constexpr size_t WS_HID = 32 * MiB;
constexpr size_t WS_HS = 450 * MiB;
constexpr size_t WS_Z1S = 488 * MiB;
constexpr size_t WS_END = 496 * MiB;
static_assert(WS_HID + (size_t)MTOK * FFN * 2 <= WS_X1B, "hid vs x1b");

constexpr int CW_TMO = 0, CW_CODE = 1;
constexpr int CW_BAR = 4096;

constexpr int RING_OFF = 0;
constexpr int LDS_BYTES = 147456;
constexpr int LDSCTL_OFF = LDS_BYTES - 512, MISC_OFF = LDSCTL_OFF + 320;

#define GAS __attribute__((address_space(1)))
#define LAS __attribute__((address_space(3)))
typedef unsigned short bf16;
typedef unsigned v4u __attribute__((ext_vector_type(4)));
typedef unsigned v2u __attribute__((ext_vector_type(2)));
typedef float f32x4 __attribute__((ext_vector_type(4)));
typedef float f32x16 __attribute__((ext_vector_type(16)));
typedef short bf16x8 __attribute__((ext_vector_type(8)));
typedef GAS unsigned gu32;
#define RLX_AGENT __ATOMIC_RELAXED, __HIP_MEMORY_SCOPE_AGENT
#define LDS_WAIT() asm volatile("s_waitcnt lgkmcnt(0)" ::: "memory")
#define VM_WAIT() asm volatile("s_waitcnt vmcnt(0)" ::: "memory")
typedef float f32x2_t_ __attribute__((ext_vector_type(2))); typedef __bf16 bf16x2_t_ __attribute__((ext_vector_type(2)));
__device__ __forceinline__ unsigned pk2(float lo, float hi) { const f32x2_t_ v = {lo, hi}; return __builtin_bit_cast(unsigned, __builtin_convertvector(v, bf16x2_t_)); }
__device__ __forceinline__ unsigned f2bf(float f) { return (unsigned)__builtin_bit_cast(unsigned short, (__bf16)f); }
__device__ __forceinline__ float bf2f(unsigned short b) { return __uint_as_float((unsigned)b << 16); }
__device__ __forceinline__ float wave_sum(float v) {
#pragma unroll
    for (int o = 1; o < 64; o <<= 1) v += __shfl_xor(v, o);
    return v;
}

__device__ __forceinline__ float wave_sum_sw(float v) {
#define SWZ_(x, m) __builtin_bit_cast(float, __builtin_amdgcn_ds_swizzle(__builtin_bit_cast(int, (x)), (((m) << 10) | 0x1f)))
    v += SWZ_(v, 1); v += SWZ_(v, 2); v += SWZ_(v, 4); v += SWZ_(v, 8); v += SWZ_(v, 16);
#undef SWZ_
    return __builtin_bit_cast(float, __builtin_amdgcn_readlane(__builtin_bit_cast(int, v), 0)) + __builtin_bit_cast(float, __builtin_amdgcn_readlane(__builtin_bit_cast(int, v), 32));
}

#define XB_TMO      128
#define XB_XCNT(j)  (256  + 64 * (j))
#define XB_XSUB(j)  (1280 + 64 * (j))
#define XB_XGEN(j)  (2304 + 64 * (j))
#define XB_TOP      3328
#define XB_TOPGEN   3392
#define XCD_BAR_WORDS 3456
#define XB_SPIN_CAP (1u << 18)

__device__ __forceinline__ unsigned xb_ld(unsigned* p)              { return __hip_atomic_load(p, __ATOMIC_RELAXED, __HIP_MEMORY_SCOPE_AGENT); }
__device__ __forceinline__ unsigned xb_add(unsigned* p, unsigned v) { return __hip_atomic_fetch_add(p, v, __ATOMIC_RELAXED, __HIP_MEMORY_SCOPE_AGENT); }
__device__ __forceinline__ unsigned xb_xcc_id() { return (unsigned)__builtin_amdgcn_s_getreg((3 << 11) | 20) & 0xFu; }
#define XB_SPIN(cond, bar) do { unsigned _sp = 0; while (cond) { __builtin_amdgcn_s_sleep(1); \
    if ((++_sp & 255u) == 0u) { if (xb_ld(&(bar)[XB_TMO])) break; if (_sp > XB_SPIN_CAP) { atomicAdd(&(bar)[XB_TMO], 1u); break; } } } } while (0)

struct XcdBarrier { unsigned* bar; unsigned x; volatile LAS unsigned* st; };

__device__ __forceinline__ XcdBarrier xcd_barrier_post(unsigned* bar, volatile LAS unsigned* st) {
    XcdBarrier b; b.bar = bar; b.x = xb_xcc_id(); b.st = st;
    if (threadIdx.x == 0) (void)xb_add(&bar[XB_XCNT(b.x)], 1u);
    return b;
}
__device__ __forceinline__ void xcd_barrier_complete(unsigned* bar, unsigned x, unsigned& nloc, unsigned& nx) {
    const unsigned G = gridDim.x * gridDim.y * gridDim.z;
    unsigned sum, cnt, mine, sp = 0u;
    for (;;) {
        sum = 0u; cnt = 0u; mine = 0u;
#pragma unroll
        for (unsigned j = 0; j < 16; ++j) { const unsigned c = xb_ld(&bar[XB_XCNT(j)]); sum += c; cnt += (c > 0u) ? 1u : 0u; mine = (j == x) ? c : mine; }
        if (sum == G) break;
        __builtin_amdgcn_s_sleep(1);
        if ((++sp & 255u) == 0u) { if (xb_ld(&bar[XB_TMO])) break; if (sp > XB_SPIN_CAP) { atomicAdd(&bar[XB_TMO], 1u); break; } }
    }
    nloc = mine > 0u ? mine : 1u; nx = cnt > 0u ? cnt : 1u;
}
__device__ __forceinline__ void xcd_barrier(const XcdBarrier& b) {
    asm volatile("s_waitcnt vmcnt(0)" ::: "memory");
    __syncthreads();
    if (threadIdx.x == 0) {
        unsigned* bar = b.bar;
        __builtin_amdgcn_s_waitcnt(0);
        unsigned nloc = b.st[0], nx = b.st[1];
        if (nloc == 0u) { xcd_barrier_complete(bar, b.x, nloc, nx); b.st[0] = nloc; b.st[1] = nx; }
        const unsigned old = xb_add(&bar[XB_XSUB(b.x)], 1u);
        const unsigned gen = old / nloc;
        if (old + 1u == (gen + 1u) * nloc) {
            __builtin_amdgcn_fence(__ATOMIC_RELEASE, "agent");
            asm volatile("s_waitcnt vmcnt(0)" ::: "memory");
            const unsigned og = xb_add(&bar[XB_TOP], 1u);
            const unsigned tg = og / nx;
            if (og + 1u == (tg + 1u) * nx) xb_add(&bar[XB_TOPGEN], 1u);
            else XB_SPIN(xb_ld(&bar[XB_TOPGEN]) == tg, bar);
            __builtin_amdgcn_fence(__ATOMIC_ACQUIRE, "agent");
            xb_add(&bar[XB_XGEN(b.x)], 1u);
            asm volatile("s_waitcnt vmcnt(0)" ::: "memory");
        } else {
            XB_SPIN(xb_ld(&bar[XB_XGEN(b.x)]) == gen, bar);
            __builtin_amdgcn_fence(__ATOMIC_ACQUIRE, "agent");
            asm volatile("s_waitcnt vmcnt(0)" ::: "memory");
        }
    }
    __syncthreads();
}

struct Frame {
    LAS unsigned char* lds;
    volatile LAS unsigned* MISC;
    gu32* ctl;
    int tid, lane, wave;
    int vcu, G;
    unsigned char* ws;
};

__device__ __forceinline__ void p0_transpose_item(const float* W, int K, int N, bf16* WT, int dst_row0, const float* kscale, LAS float* scr, int k0, int n0, int lane) {
#pragma unroll 8
    for (int i = 0; i < 32; ++i) { const int kk = 2 * i + (lane >> 5); float v = W[(size_t)(k0 + kk) * N + n0 + (lane & 31)]; if (kscale) v *= kscale[k0 + kk]; scr[kk * 33 + (lane & 31)] = v; }
    LDS_WAIT(); asm volatile("" ::: "memory");
    const int c = lane & 7;
#pragma unroll
    for (int j = 0; j < 4; ++j) { const int n = (lane >> 3) + 8 * j; const LAS float* s = scr + (8 * c) * 33 + n;
        v4u o; o.x = pk2(s[0 * 33], s[1 * 33]); o.y = pk2(s[2 * 33], s[3 * 33]); o.z = pk2(s[4 * 33], s[5 * 33]); o.w = pk2(s[6 * 33], s[7 * 33]);
        *(GAS v4u*)(WT + (size_t)(dst_row0 + n) * K + k0 + 8 * c) = o; }
    LDS_WAIT(); asm volatile("" ::: "memory");
}
__device__ __forceinline__ int map_projB(int n0) {
    if (n0 < 2048) { const int t = n0 - 1536, hq = t >> 6, hf = (t >> 5) & 1; return 256 * (hq >> 2) + 128 * hf + 32 * (hq & 3); }
    if (n0 < 2176) { const int t = n0 - 2048, kh = t >> 6, hf = (t >> 5) & 1; return 512 + 128 * hf + 32 * kh; }
    if (n0 < 2304) { const int t = n0 - 2176, vh = t >> 6, hf = (t >> 5) & 1; return 512 + 128 * hf + 32 * (2 + vh); }
    return 768 + (n0 - 2304);
}
__device__ __forceinline__ void p0_row(const float* xrow, bf16* orow, float* rstd_out, int lane) {
    const GAS f32x4* xr = (const GAS f32x4*)xrow + lane;
    f32x4 v[4]; float s = 0.f;
#pragma unroll
    for (int j = 0; j < 4; ++j) { v[j] = xr[64 * j]; s += (v[j].x * v[j].x + v[j].y * v[j].y) + (v[j].z * v[j].z + v[j].w * v[j].w); }
    s = wave_sum(s);
    if (lane == 0) *rstd_out = 1.0f / sqrtf(s * (1.0f / DM) + RMS_EPS);
    GAS unsigned long long* o8 = (GAS unsigned long long*)orow + lane;
#pragma unroll
    for (int j = 0; j < 4; ++j) o8[64 * j] = (unsigned long long)pk2(v[j].x, v[j].y) | ((unsigned long long)pk2(v[j].z, v[j].w) << 32);
}
constexpr int FW_W1 = 0, FW_W2 = 33 * 64 * 4, FW_B1 = FW_W2 + 64 * 64 * 4, FW_B2 = FW_B1 + 256, FW_FR = FW_B2 + 256, FW_END = FW_FR + 256, FT_PITCH = 144, FT_BYTES = 32 * FT_PITCH;
__device__ __forceinline__ void filter_stage_weights(LAS unsigned char* lds, const float* w1, const float* b1, const float* w2, const float* b2, const float* fr, int tid) {
    LAS float* W1 = (LAS float*)(lds + FW_W1); LAS float* W2 = (LAS float*)(lds + FW_W2);
    for (int i = tid; i < 33 * 64; i += NWAVES * 64) W1[i] = w1[i];
    for (int i = tid; i < 64 * 64; i += NWAVES * 64) W2[i] = w2[i];
    if (tid < 64) { ((LAS float*)(lds + FW_B1))[tid] = b1[tid]; ((LAS float*)(lds + FW_B2))[tid] = b2[tid]; ((LAS float*)(lds + FW_FR))[tid] = fr[tid]; }
    LDS_WAIT(); __syncthreads();
}
__device__ __forceinline__ void filter_mlp_half(LAS unsigned char* lds, int L, int chunk, int hf, int dir, int r, int h, LAS float* Hb, bf16x8 (&afr)[4]) {
    const LAS float* W1 = (const LAS float*)(lds + FW_W1); const LAS float* W2 = (const LAS float*)(lds + FW_W2);
    const LAS float* B1 = (const LAS float*)(lds + FW_B1); const LAS float* B2 = (const LAS float*)(lds + FW_B2); const LAS float* FR = (const LAS float*)(lds + FW_FR);
        int pos = 64 * chunk + 32 * hf + r + dir; if (pos > L - 1) pos = L - 1;
        const float t = (float)pos / (float)(L - 1);
        float a[32];
#pragma unroll
        for (int jj = 0; jj < 32; ++jj) a[jj] = B1[32 * h + jj];
        {
#pragma unroll
            for (int jj = 0; jj < 32; jj += 4) { const f32x4 w = *(const LAS f32x4*)(W1 + 32 * h + jj); a[jj] += t * w[0]; a[jj + 1] += t * w[1]; a[jj + 2] += t * w[2]; a[jj + 3] += t * w[3]; }
#pragma unroll 1
            for (int i = 0; i < 16; ++i) {
                const float band = 1e-4f + (float)i * ((15.0f - 1e-4f) / 15.0f); const float ang = (6.283185307179586f / (float)L) * (float)pos * band;
                const float cv = __cosf(ang), sv = -__sinf(ang);
                const LAS float* wc = W1 + (1 + i) * 64 + 32 * h; const LAS float* wsn = W1 + (17 + i) * 64 + 32 * h;
#pragma unroll
                for (int jj = 0; jj < 32; jj += 4) { const f32x4 w = *(const LAS f32x4*)(wc + jj), v = *(const LAS f32x4*)(wsn + jj);
                    a[jj] += cv * w[0] + sv * v[0]; a[jj + 1] += cv * w[1] + sv * v[1]; a[jj + 2] += cv * w[2] + sv * v[2]; a[jj + 3] += cv * w[3] + sv * v[3]; }
            }
        }
#pragma unroll
        for (int jj = 0; jj < 32; ++jj) Hb[(32 * h + jj) * 32 + r] = __sinf(FR[32 * h + jj] * a[jj]);
        LDS_WAIT(); asm volatile("" ::: "memory");
#pragma unroll
        for (int jj = 0; jj < 32; ++jj) a[jj] = B2[32 * h + jj];
#pragma unroll 1
        for (int i = 0; i < 64; ++i) { const float hv = Hb[i * 32 + r]; const LAS float* wr_ = W2 + i * 64 + 32 * h;
#pragma unroll
            for (int jj = 0; jj < 32; jj += 4) { const f32x4 w = *(const LAS f32x4*)(wr_ + jj); a[jj] += hv * w[0]; a[jj + 1] += hv * w[1]; a[jj + 2] += hv * w[2]; a[jj + 3] += hv * w[3]; } }
        LDS_WAIT(); asm volatile("" ::: "memory");
        unsigned op[16], pp[16];
#pragma unroll
        for (int d = 0; d < 16; ++d) op[d] = pk2(__sinf(FR[32 * h + 2 * d] * a[2 * d]), __sinf(FR[32 * h + 2 * d + 1] * a[2 * d + 1]));
#pragma unroll
        for (int d = 0; d < 16; ++d) pp[d] = __shfl_xor(op[d], 32);
#pragma unroll
        for (int ks = 0; ks < 4; ++ks) { v4u f;
#pragma unroll
            for (int w = 0; w < 4; ++w) { const unsigned own = h ? op[8 * (ks & 1) + 4 + w] : op[8 * (ks & 1) + w], par = h ? pp[8 * (ks & 1) + 4 + w] : pp[8 * (ks & 1) + w];
                f[w] = ((ks >> 1) == h) ? own : par; }
            afr[ks] = __builtin_bit_cast(bf16x8, f); }
}
__device__ __forceinline__ void filter_item(LAS unsigned char* lds, const bf16* w3T, bf16* krev, float* fpart, int g, int chunk, int dir, int wave, int lane_) {
    int lane = lane_; asm volatile("" : "+v"(lane));
    const int L = g ? LS : LP, r = lane & 31, h = lane >> 5;
    const LAS float* W1 = (const LAS float*)(lds + FW_W1); const LAS float* W2 = (const LAS float*)(lds + FW_W2);
    const LAS float* B1 = (const LAS float*)(lds + FW_B1); const LAS float* B2 = (const LAS float*)(lds + FW_B2); const LAS float* FR = (const LAS float*)(lds + FW_FR);
    LAS unsigned char* T = lds + FW_END + wave * FT_BYTES; LAS float* Hb = (LAS float*)(lds + FW_END + NWAVES * FT_BYTES + wave * 8192);
    bf16x8 afr0[4], afr1[4];
    filter_mlp_half(lds, L, chunk, 0, dir, r, h, Hb, afr0);
    filter_mlp_half(lds, L, chunk, 1, dir, r, h, Hb, afr1);
    const float dmin = -4.605170185988091f / 1.5f, dmax = -4.605170185988091f / 0.3f;
    const int p0 = 64 * chunk; const int mstart = g ? (dir ? (2 * L - p0 - 64) : p0) : (dir ? (L + p0) : (L - 64 - p0));
    for (int ti = 0; ti < 32; ++ti) {
        const int o_ = ti >> 4, cb = 32 * (ti & 15), colg = (2 * o_ + dir) * 512 + cb;
        bf16x8 bfr[4];
#pragma unroll
        for (int ks = 0; ks < 4; ++ks) bfr[ks] = *(const GAS bf16x8*)(w3T + (size_t)(colg + r) * 64 + 16 * ks + 8 * h);
        const float delta = fabsf(dmin + (float)(cb + r) * ((dmax - dmin) / 511.0f));
        float asum = 0.f;
#pragma unroll
        for (int hf = 0; hf < 2; ++hf) {
            f32x16 acc = (f32x16){0.f,0.f,0.f,0.f,0.f,0.f,0.f,0.f,0.f,0.f,0.f,0.f,0.f,0.f,0.f,0.f};
#pragma unroll
            for (int ks = 0; ks < 4; ++ks) acc = __builtin_amdgcn_mfma_f32_32x32x16_bf16(hf ? afr1[ks] : afr0[ks], bfr[ks], acc, 0, 0, 0);
#pragma unroll
            for (int rg = 0; rg < 16; ++rg) {
                const int i = 32 * hf + (rg & 3) + 8 * (rg >> 2) + 4 * h; const int pos = p0 + i + dir;
                const float t = (float)pos / (float)(L - 1);
                float kv = acc[rg] * (__expf(-t * delta) + 0.05f); if (pos > L - 1) kv = 0.f;
                asum += fabsf(kv);
                const int e = ((dir != 0) != (g != 0)) ? i : 63 - i;
                *(LAS bf16*)(T + r * FT_PITCH + e * 2) = (bf16)f2bf(kv);
            }
        }
        asum += __shfl_xor(asum, 32);
        if (h == 0) fpart[(size_t)chunk * 2048 + colg + r] = asum;
        LDS_WAIT(); asm volatile("" ::: "memory");
        {
            const int col = lane >> 1, hb = lane & 1;
            bf16* dst = krev + (size_t)(o_ * 512 + cb + col) * (2 * L) + mstart + 32 * hb;
            const LAS v4u* src = (const LAS v4u*)(T + col * FT_PITCH + 64 * hb);
#pragma unroll
            for (int q = 0; q < 4; ++q) *(GAS v4u*)(dst + 8 * q) = src[q];
        }
        LDS_WAIT(); asm volatile("" ::: "memory");
    }
}

namespace hy {
constexpr int SLOTB = 272, Z_BYTES = 75776, F_OFF = 75776, F_BYTES = 65536, RED_OFF = F_OFF + F_BYTES;
__device__ __forceinline__ int slot_of(int g, int n) { return g ? (n + 31) : ((n >> 4) * 32 + 16 + (n & 15)); }
__device__ __forceinline__ int crow(int r, int hi) { return (r & 3) + 8 * (r >> 2) + 4 * hi; }

struct Params { const bf16* uT; const bf16* krev_s; const bf16* krev_p; const float* fpart_s; const float* fpart_p; const float* conv_w; const float* conv_b; const float* hbias; bf16* yT; float* dF; bf16* dZ; };

__device__ __forceinline__ void conv3_chunk(const bf16* urow  , int g, int chunk, float w0, float w1, float w2, float b, float (&out)[8]) {
    const int tau0 = chunk * 8; const int L = g ? LS : LP; const int p0 = g ? tau0 : (tau0 & (LP - 1));
    const v4u raw = *(const GAS v4u*)(urow + tau0);
    float u[10];
    u[1] = pg8::bflo(raw.x); u[2] = pg8::bfhi(raw.x); u[3] = pg8::bflo(raw.y); u[4] = pg8::bfhi(raw.y); u[5] = pg8::bflo(raw.z); u[6] = pg8::bfhi(raw.z); u[7] = pg8::bflo(raw.w); u[8] = pg8::bfhi(raw.w);
    u[0] = (p0 > 0) ? bf2f(urow[tau0 - 1]) : 0.f;
    u[9] = (p0 + 8 < L) ? bf2f(urow[tau0 + 8]) : 0.f;
#pragma unroll
    for (int i = 0; i < 8; ++i) out[i] = w0 * u[i] + w1 * u[i + 1] + w2 * u[i + 2] + b;
}

struct C3 { v4u raw; float prev, next; };
__device__ __forceinline__ void conv3_load(const bf16* urow, int g, int chunk, C3& q) {
    const int tau0 = chunk * 8; const int L = g ? LS : LP; const int p0 = g ? tau0 : (tau0 & (LP - 1));
    q.raw = *(const GAS v4u*)(urow + tau0);
    q.prev = (p0 > 0) ? bf2f(urow[tau0 - 1]) : 0.f;
    q.next = (p0 + 8 < L) ? bf2f(urow[tau0 + 8]) : 0.f;
}
__device__ __forceinline__ void conv3_eval(const C3& q, float w0, float w1, float w2, float b, float (&out)[8]) {
    float u[10];
    u[0] = q.prev; u[9] = q.next;
    u[1] = pg8::bflo(q.raw.x); u[2] = pg8::bfhi(q.raw.x); u[3] = pg8::bflo(q.raw.y); u[4] = pg8::bfhi(q.raw.y); u[5] = pg8::bflo(q.raw.z); u[6] = pg8::bfhi(q.raw.z); u[7] = pg8::bflo(q.raw.w); u[8] = pg8::bfhi(q.raw.w);
#pragma unroll
    for (int i = 0; i < 8; ++i) out[i] = w0 * u[i] + w1 * u[i + 1] + w2 * u[i + 2] + b;
}

__device__ __forceinline__ bf16x8 load_afrag(LAS const unsigned char* lds, int addr, int sh) {
    const LAS unsigned* p = (const LAS unsigned*)(lds + addr);
    const unsigned w0 = p[0], w1 = p[1], w2 = p[2], w3 = p[3], w4 = p[4];
    v4u f; f.x = __builtin_amdgcn_alignbit(w1, w0, sh); f.y = __builtin_amdgcn_alignbit(w2, w1, sh); f.z = __builtin_amdgcn_alignbit(w3, w2, sh); f.w = __builtin_amdgcn_alignbit(w4, w3, sh);
    return __builtin_bit_cast(bf16x8, f);
}

__device__ __forceinline__ void hyena_item(LAS unsigned char* lds, const Params& P, int g, int c, int tid_) {
    int tid = tid_; asm volatile("" : "+v"(tid));
    const int lane = tid & 63, wave = __builtin_amdgcn_readfirstlane(tid >> 6), r = lane & 31, hi = lane >> 5, nt = wave & 3, half = wave >> 2;
    const int L = g ? LS : LP; const int T0 = g ? TP : 0;
    float inv_norm0, inv_norm1;
    {
        const int nchunk = g ? 256 : 32; const float* fp = P.fpart_s + (g ? (size_t)0 : (size_t)((WS_FPART_P - WS_FPART_S) / 4));
        float s0 = 0.f, s1 = 0.f;
        for (int idx = lane; idx < nchunk * 2; idx += 64) { const int ch = idx >> 1, dir = idx & 1; s0 += fp[(size_t)ch * 2048 + dir * 512 + c]; s1 += fp[(size_t)ch * 2048 + 1024 + dir * 512 + c]; }
        inv_norm0 = 1.0f / wave_sum_sw(s0); inv_norm1 = 1.0f / wave_sum_sw(s1);
        for (int i = tid; i < Z_BYTES / 16; i += NWAVES * 64) *(LAS v4u*)(lds + i * 16) = (v4u){0u, 0u, 0u, 0u};
        LDS_WAIT(); __syncthreads();
    }
    {
        const int ch = 2 * HW + c; const float w0 = P.conv_w[ch], w1 = P.conv_w[3 * HW + ch], w2 = P.conv_w[6 * HW + ch], b = P.conv_b[ch];
        const bf16* urow = P.uT + (size_t)ch * MTOK + T0;
        for (int it = 0; it < 4; ++it) { const int chunk = tid + it * 512; float o[8]; conv3_chunk(urow, g, chunk, w0, w1, w2, b, o);
            const int tau0 = chunk * 8; v4u pk; pk.x = pk2(o[0], o[1]); pk.y = pk2(o[2], o[3]); pk.z = pk2(o[4], o[5]); pk.w = pk2(o[6], o[7]);
            *(LAS v4u*)(lds + slot_of(g, tau0 >> 7) * SLOTB + (tau0 & 127) * 2) = pk; }
    }
    int d_hi, d_lo;
    if (g) { if (half == 0) { d_hi = 32 * nt + 31; d_lo = 32 * nt - 48; } else { d_hi = 32 * nt - 49; d_lo = 32 * nt - 127; } }
    else   { if (half == 0) { d_hi = 15; d_lo = 0; } else { d_hi = -1; d_lo = -15; } }
    int abase = F_OFF + 2 * ((L - 1) - r + 8 * hi); const int sh = (abase & 2) ? 16 : 0; abase &= ~3;
    const int zb = slot_of(g, 32 * nt + r) * SLOTB + 16 * hi;
    const int mi0 = 2 * half;

    for (int o = 0; o < 2; ++o) {
        {
            const bf16* ksrc = P.krev_s + (g ? (size_t)0 : (size_t)((WS_KREV_P - WS_KREV_S) / 2)) + (size_t)(o * HW + c) * (2 * L);
            const int n16 = (2 * L * 2) / 16;
            for (int i = tid; i < n16; i += NWAVES * 64) *(LAS v4u*)(lds + F_OFF + i * 16) = *(const GAS v4u*)(ksrc + i * 8);
        }
        LDS_WAIT(); __syncthreads();
        f32x16 acc[4];
#pragma unroll
        for (int mi = 0; mi < 4; ++mi) acc[mi] = (f32x16){0.f,0.f,0.f,0.f,0.f,0.f,0.f,0.f,0.f,0.f,0.f,0.f,0.f,0.f,0.f,0.f};
        bf16x8 Fw[8];
        {
            const int q0 = -8 * d_hi;
#pragma unroll
            for (int s = 2; s < 8; ++s) Fw[s] = load_afrag(lds, abase + 32 * (q0 - 8 + s), sh);
            Fw[0] = Fw[2]; Fw[1] = Fw[3];
        }
        {
            unsigned ap = (unsigned)(uintptr_t)(lds + abase) + 32 * (-8 * d_hi), bp = (unsigned)(uintptr_t)(lds + zb) - d_hi * SLOTB;
            v2u n01, n23; unsigned n4; v4u zn;
            unsigned r0, r1, r2, r3, r4; v4u zf;
#define HY_LOADS(ADW, BOFF) asm volatile("ds_read2_b32 %0, %4 offset0:%c5 offset1:%c6\n\tds_read2_b32 %1, %4 offset0:%c7 offset1:%c8\n\tds_read_b32 %2, %4 offset:%c9\n\tds_read_b128 %3, %10 offset:%c11" \
                : "=&v"(n01), "=&v"(n23), "=&v"(n4), "=&v"(zn) : "v"(ap), "i"(ADW), "i"((ADW) + 1), "i"((ADW) + 2), "i"((ADW) + 3), "i"(((ADW) + 4) * 4), "v"(bp), "i"(BOFF))
#define HY_WAIT() do { asm volatile("s_waitcnt lgkmcnt(0)" : "+v"(n01), "+v"(n23), "+v"(n4), "+v"(zn), "+v"(acc[0]), "+v"(acc[1]), "+v"(acc[2]), "+v"(acc[3])); __builtin_amdgcn_sched_barrier(0); } while (0)
#define HY_TAKE() do { r0 = n01.x; r1 = n01.y; r2 = n23.x; r3 = n23.y; r4 = n4; zf = zn; } while (0)
#define HY_STEP(JK, ADW, BOFF) do { HY_LOADS(ADW, BOFF); __builtin_amdgcn_sched_barrier(0); \
                { v4u f; f.x = __builtin_amdgcn_alignbit(r1, r0, sh); f.y = __builtin_amdgcn_alignbit(r2, r1, sh); f.z = __builtin_amdgcn_alignbit(r3, r2, sh); f.w = __builtin_amdgcn_alignbit(r4, r3, sh); Fw[JK] = __builtin_bit_cast(bf16x8, f); } \
                { const bf16x8 zb_ = __builtin_bit_cast(bf16x8, zf); \
                  acc[0] = __builtin_amdgcn_mfma_f32_32x32x16_bf16(Fw[(JK) & 7], zb_, acc[0], 0, 0, 0); acc[1] = __builtin_amdgcn_mfma_f32_32x32x16_bf16(Fw[((JK) - 2) & 7], zb_, acc[1], 0, 0, 0); \
                  acc[2] = __builtin_amdgcn_mfma_f32_32x32x16_bf16(Fw[((JK) - 4) & 7], zb_, acc[2], 0, 0, 0); acc[3] = __builtin_amdgcn_mfma_f32_32x32x16_bf16(Fw[((JK) - 6) & 7], zb_, acc[3], 0, 0, 0); } \
                HY_WAIT(); HY_TAKE(); } while (0)
            HY_LOADS(0, 0); HY_WAIT(); HY_TAKE();
            for (int d = d_hi; d >= d_lo; --d) {
                HY_STEP(0, 8, 32); HY_STEP(1, 16, 64); HY_STEP(2, 24, 96); HY_STEP(3, 32, 128); HY_STEP(4, 40, 160); HY_STEP(5, 48, 192); HY_STEP(6, 56, 224); HY_STEP(7, 64, SLOTB);
                ap += 256; bp += SLOTB;
            }
#undef HY_LOADS
#undef HY_WAIT
#undef HY_TAKE
#undef HY_STEP
        }
        LDS_WAIT(); __syncthreads();
        {
            LAS float* X = (LAS float*)(lds + F_OFF) + wave * 2048;
#pragma unroll
            for (int t = 0; t < 2; ++t)
#pragma unroll
                for (int rg = 0; rg < 16; ++rg) X[(t * 16 + rg) * 64 + lane] = (half == 0) ? acc[2 + t][rg] : acc[t][rg];
        }
        LDS_WAIT(); __syncthreads();
        f32x16 fin[2];
        {
            const LAS float* X = (const LAS float*)(lds + F_OFF) + (wave ^ 4) * 2048;
#pragma unroll
            for (int t = 0; t < 2; ++t)
#pragma unroll
                for (int rg = 0; rg < 16; ++rg) fin[t][rg] = ((half == 0) ? acc[t][rg] : acc[2 + t][rg]) + X[(t * 16 + rg) * 64 + lane];
        }
        LDS_WAIT(); __syncthreads();
        {
            const int ch = o * HW + c; const float w0 = P.conv_w[ch], w1 = P.conv_w[3 * HW + ch], w2 = P.conv_w[6 * HW + ch], b = P.conv_b[ch];
            const bf16* urow = P.uT + (size_t)ch * MTOK + T0;
            for (int it = 0; it < 4; ++it) { const int chunk = tid + it * 512; float v[8]; conv3_chunk(urow, g, chunk, w0, w1, w2, b, v);
                LAS f32x4* dst = (LAS f32x4*)(lds + F_OFF + chunk * 32); dst[0] = (f32x4){v[0], v[1], v[2], v[3]}; dst[1] = (f32x4){v[4], v[5], v[6], v[7]}; }
        }
        LDS_WAIT(); __syncthreads();
        {
            const float sb = P.hbias[o * HW + c], inr = o ? inv_norm1 : inv_norm0;
            const LAS float* G = (const LAS float*)(lds + F_OFF);
            const int n = 32 * nt + r; LAS bf16* zs = (LAS bf16*)(lds + slot_of(g, n) * SLOTB);
#pragma unroll
            for (int t = 0; t < 2; ++t)
#pragma unroll
                for (int rg = 0; rg < 16; ++rg) { const int i = 32 * (mi0 + t) + crow(rg, hi);
                    const float zo = bf2f(zs[i]);
#if PROBE >= 100
                    if (c == 137) { P.dF[(g * 2 + o) * 16384 + 128 * n + i] = fin[t][rg]; P.dZ[(g * 2 + o) * 16384 + 128 * n + i] = zs[i]; }
#endif
                    const float val = G[128 * n + i] * (inr * fin[t][rg] + sb * zo); zs[i] = (bf16)f2bf(val); }
        }
        LDS_WAIT(); __syncthreads();
    }
    {
        bf16* yrow = P.yT + (size_t)c * MTOK + T0;
        for (int it = 0; it < 4; ++it) { const int chunk = tid + it * 512, tau0 = chunk * 8;
            *(GAS v4u*)(yrow + tau0) = *(const LAS v4u*)(lds + slot_of(g, tau0 >> 7) * SLOTB + (tau0 & 127) * 2); }
    }
    LDS_WAIT(); __syncthreads();
}
}

namespace fc {
constexpr int OST = 1032, PLANE_B = 32 * OST * 2  , RE_OFF = 0, IM_OFF = PLANE_B, RED_OFF = 2 * PLANE_B, T3_OFF = RED_OFF + 64;
constexpr int NFFT = 32768;
enum { F1 = 0, F2 = 1, F3 = 2, I1 = 3, I2 = 4, I3 = 5 };
__device__ __forceinline__ int crow(int r, int hi) { return (r & 3) + 8 * (r >> 2) + 4 * hi; }
__device__ __forceinline__ int sw(int mid) { return 0; }
struct Params { const bf16* uT; const bf16* kc; const float* fpart_s; const float* conv_w; const float* conv_b; const float* hbias; bf16* yT; bf16* hs; bf16* z1s; float* dF; bf16* dZ; };
typedef float f32x2_ __attribute__((ext_vector_type(2)));
struct FMat { bf16x8 fr[2], fi[2], nfi[2]; };

__device__ __forceinline__ void make_fmat(FMat& M, int r, int h) {
#pragma unroll
    for (int ks = 0; ks < 2; ++ks) { v4u a, b, c;
#pragma unroll
        for (int w = 0; w < 4; ++w) { float cv[2], sv[2];
#pragma unroll
            for (int e = 0; e < 2; ++e) { const int aidx = 16 * ks + 8 * h + 2 * w + e; const float fr_ = (float)((aidx * r) & 31) * (1.0f / 32.0f); cv[e] = __builtin_amdgcn_cosf(fr_); sv[e] = __builtin_amdgcn_sinf(fr_); }
            a[w] = pk2(cv[0], cv[1]); b[w] = pk2(-sv[0], -sv[1]); c[w] = pk2(sv[0], sv[1]); }
        M.fr[ks] = __builtin_bit_cast(bf16x8, a); M.fi[ks] = __builtin_bit_cast(bf16x8, b); M.nfi[ks] = __builtin_bit_cast(bf16x8, c); }
}

template <int ST, bool REAL_IN, bool HALF_K>
__device__ __forceinline__ void stage(LAS unsigned char* lds, const FMat& M, int wave, int r_, int h_) {
    int r = r_, h = h_; asm volatile("" : "+v"(r), "+v"(h));
    float t2c[16], t2s[16];
    if (ST == F1 || ST == F2 || ST == I1 || ST == I2) {
#pragma unroll
        for (int rg = 0; rg < 16; ++rg) { const int rho = (rg & 3) + 8 * (rg >> 2) + 4 * h; const float fr_ = (float)(r * rho) * (1.0f / 1024.0f); t2c[rg] = __builtin_amdgcn_cosf(fr_); t2s[rg] = __builtin_amdgcn_sinf(fr_); }
    }
    constexpr bool INV = (ST >= I1);
    const f32x16 zero16 = (f32x16){0.f,0.f,0.f,0.f,0.f,0.f,0.f,0.f,0.f,0.f,0.f,0.f,0.f,0.f,0.f,0.f};
    unsigned res[4][16];
#pragma unroll
    for (int t = 0; t < 4; ++t) {
        const int f = 4 * wave + t;
        const int base = (ST == I2) ? (32 * f + OST * r) : (32 * r + OST * f); const int swr = (ST == I2) ? sw(f) : sw(r);
        f32x16 ur = zero16, ui = zero16;
#pragma unroll
        for (int ks = 0; ks < (HALF_K ? 1 : 2); ++ks) {
            const bf16x8 xr = *(const LAS bf16x8*)(lds + RE_OFF + 2 * (base + ((16 * ks + 8 * h) ^ swr)));
            if (!INV) {
                ur = __builtin_amdgcn_mfma_f32_32x32x16_bf16(M.fr[ks], xr, ur, 0, 0, 0);
                ui = __builtin_amdgcn_mfma_f32_32x32x16_bf16(M.fi[ks], xr, ui, 0, 0, 0);
                if (!REAL_IN) { const bf16x8 xi = *(const LAS bf16x8*)(lds + IM_OFF + 2 * (base + ((16 * ks + 8 * h) ^ swr)));
                    ur = __builtin_amdgcn_mfma_f32_32x32x16_bf16(M.nfi[ks], xi, ur, 0, 0, 0);
                    ui = __builtin_amdgcn_mfma_f32_32x32x16_bf16(M.fr[ks], xi, ui, 0, 0, 0); }
            } else {
                const bf16x8 xi = *(const LAS bf16x8*)(lds + IM_OFF + 2 * (base + ((16 * ks + 8 * h) ^ swr)));
                ur = __builtin_amdgcn_mfma_f32_32x32x16_bf16(M.fr[ks], xr, ur, 0, 0, 0);
                ur = __builtin_amdgcn_mfma_f32_32x32x16_bf16(M.fi[ks], xi, ur, 0, 0, 0);
                if (ST != I3) { ui = __builtin_amdgcn_mfma_f32_32x32x16_bf16(M.fr[ks], xi, ui, 0, 0, 0);
                                ui = __builtin_amdgcn_mfma_f32_32x32x16_bf16(M.nfi[ks], xr, ui, 0, 0, 0); }
            }
        }
        if (ST == I3) {
#pragma unroll
            for (int rg = 0; rg < 8; ++rg) res[t][rg] = __float_as_uint(ur[rg]);
        } else {
            if (ST == F1 || ST == F2 || ST == I1 || ST == I2) {
                float uc = 1.f, us = 0.f;
                if (ST == I2) { const float fr_ = (float)(f * r) * (1.0f / 32768.0f); uc = __builtin_amdgcn_cosf(fr_); us = __builtin_amdgcn_sinf(fr_); }
#pragma unroll
                for (int rg = 0; rg < 16; ++rg) {
                    float c = t2c[rg], s_ = t2s[rg];
                    if (ST == F1) { const int rho = (rg & 3) + 8 * (rg >> 2) + 4 * h; const f32x2_ q = *(const LAS f32x2_*)(lds + T3_OFF + 8 * (32 * f + rho)); const float c2 = c * q.x - s_ * q.y; s_ = c * q.y + s_ * q.x; c = c2; }
                    if (ST == I2) { const float c2 = c * uc - s_ * us; s_ = c * us + s_ * uc; c = c2; }
                    const float s = INV ? s_ : -s_;
                    const float a = ur[rg], b = ui[rg];
                    ur[rg] = a * c - b * s; ui[rg] = a * s + b * c;
                }
            }
#pragma unroll
            for (int p = 0; p < 8; ++p) { res[t][p] = pk2(ur[2 * p], ur[2 * p + 1]); res[t][8 + p] = pk2(ui[2 * p], ui[2 * p + 1]); }
        }
        __builtin_amdgcn_sched_barrier(0);
    }
    LDS_WAIT(); __syncthreads();
#pragma unroll
    for (int t = 0; t < 4; ++t) {
        const int f = 4 * wave + t;
        if (ST == I3) {
            LAS float* Y = (LAS float*)(lds + IM_OFF);
#pragma unroll
            for (int rg = 0; rg < 8; ++rg) { const int rho = (rg & 3) + 8 * (rg >> 2) + 4 * h; Y[1024 * rho + 32 * r + f] = __uint_as_float(res[t][rg]); }
        } else if (ST == F3) {
#pragma unroll
            for (int g4 = 0; g4 < 4; ++g4) { const int pos = ((8 * g4 + 4 * h) ^ sw(r)) + 32 * r + OST * f;
                *(LAS v2u*)(lds + RE_OFF + 2 * pos) = (v2u){res[t][2 * g4], res[t][2 * g4 + 1]}; *(LAS v2u*)(lds + IM_OFF + 2 * pos) = (v2u){res[t][8 + 2 * g4], res[t][8 + 2 * g4 + 1]}; }
        } else {
#pragma unroll
            for (int rg = 0; rg < 16; ++rg) {
                const int rho = (rg & 3) + 8 * (rg >> 2) + 4 * h;
                const int pos = (ST == F1) ? ((r ^ sw(f)) + 32 * f + OST * rho) : ((r ^ sw(rho)) + 32 * rho + OST * f);
                const unsigned wr_ = res[t][rg >> 1], wi_ = res[t][8 + (rg >> 1)];
                *(LAS bf16*)(lds + RE_OFF + 2 * pos) = (bf16)((rg & 1) ? (wr_ >> 16) : (wr_ & 0xffffu));
                *(LAS bf16*)(lds + IM_OFF + 2 * pos) = (bf16)((rg & 1) ? (wi_ >> 16) : (wi_ & 0xffffu));
            }
        }
    }
    LDS_WAIT(); __syncthreads();
}

__device__ __forceinline__ void self_visible(int tid) {
    VM_WAIT(); __syncthreads();
    if (tid == 0) { __builtin_amdgcn_fence(__ATOMIC_ACQUIRE, "agent"); VM_WAIT(); }
    __syncthreads();
}

__device__ __forceinline__ void item(LAS unsigned char* lds, const Params& P, int c, int tid_, int slot) {
    int tid = tid_; asm volatile("" : "+v"(tid));
    const int wave = __builtin_amdgcn_readfirstlane(tid >> 6);
    constexpr int L = LS, T0 = TP, g = 1;
    bf16* hs = P.hs + (size_t)slot * (2 * PLANE_B / 2); bf16* z1s = P.z1s + (size_t)slot * L;
    float inv_norm0, inv_norm1;
    {
        const int lane = tid & 63; float s0 = 0.f, s1 = 0.f;
        for (int idx = lane; idx < 512; idx += 64) { const int ch = idx >> 1, dir = idx & 1; s0 += P.fpart_s[(size_t)ch * 2048 + dir * 512 + c]; s1 += P.fpart_s[(size_t)ch * 2048 + 1024 + dir * 512 + c]; }
        inv_norm0 = 1.0f / wave_sum_sw(s0); inv_norm1 = 1.0f / wave_sum_sw(s1);
    }
    FMat M; { const int r = tid & 31, h = (tid >> 5) & 1; make_fmat(M, r, h); }
    for (int i = tid; i < 1024; i += NWAVES * 64) { const float fr_ = (float)((i >> 5) * (i & 31)) * (1.0f / 32768.0f); *(LAS f32x2_*)(lds + T3_OFF + 8 * i) = (f32x2_){__builtin_amdgcn_cosf(fr_), __builtin_amdgcn_sinf(fr_)}; }
    LDS_WAIT(); __syncthreads();
    for (int o = 0; o < 2; ++o) {
        asm volatile("" : "+v"(tid));
        const int lane = tid & 63, r = lane & 31, h = lane >> 5;
        {
            const bf16* ksrc = P.kc + (size_t)(o * HW + c) * NFFT;
            v4u raw[8];
#pragma unroll
            for (int i = 0; i < 8; ++i) { const int it = 8 * wave + i, n = 1024 * (lane & 31) + 32 * (2 * (it >> 2) + (lane >> 5)) + 8 * (it & 3); raw[i] = *(const GAS v4u*)(ksrc + n); }
#pragma unroll
            for (int i = 0; i < 8; ++i) { const int it = 8 * wave + i, n = 1024 * (lane & 31) + 32 * (2 * (it >> 2) + (lane >> 5)) + 8 * (it & 3);
                const int pos0 = ((n >> 10) ^ sw((n >> 5) & 31)) + 32 * ((n >> 5) & 31) + OST * (n & 31); LAS bf16* d = (LAS bf16*)(lds + RE_OFF) + pos0;
                d[0 * OST] = (bf16)(raw[i].x & 0xffffu); d[1 * OST] = (bf16)(raw[i].x >> 16); d[2 * OST] = (bf16)(raw[i].y & 0xffffu); d[3 * OST] = (bf16)(raw[i].y >> 16);
                d[4 * OST] = (bf16)(raw[i].z & 0xffffu); d[5 * OST] = (bf16)(raw[i].z >> 16); d[6 * OST] = (bf16)(raw[i].w & 0xffffu); d[7 * OST] = (bf16)(raw[i].w >> 16); }
        }
        LDS_WAIT(); __syncthreads();
        stage<F1, true, false>(lds, M, wave, r, h); stage<F2, false, false>(lds, M, wave, r, h); stage<F3, false, false>(lds, M, wave, r, h);
        for (int i = tid; i < 2 * PLANE_B / 16; i += NWAVES * 64) *(GAS v4u*)((unsigned char*)hs + (size_t)i * 16) = *(const LAS v4u*)(lds + i * 16);
        self_visible(tid);
        {
            const int ch = 2 * HW + c; const float w0 = P.conv_w[ch], w1 = P.conv_w[3 * HW + ch], w2 = P.conv_w[6 * HW + ch], b = P.conv_b[ch];
            const bf16* urow = P.uT + (size_t)ch * MTOK + T0;
            hy::C3 q3[4]; v4u rz[4];
#pragma unroll
            for (int i = 0; i < 4; ++i) { const int it = 4 * wave + i, n = 1024 * (lane & 15) + 32 * (4 * (it >> 2) + (lane >> 4)) + 8 * (it & 3);
                if (o == 0) hy::conv3_load(urow, g, n >> 3, q3[i]); else rz[i] = *(const GAS v4u*)(z1s + n); }
#pragma unroll
            for (int i = 0; i < 4; ++i) { const int it = 4 * wave + i, n = 1024 * (lane & 15) + 32 * (4 * (it >> 2) + (lane >> 4)) + 8 * (it & 3); unsigned e[4];
                if (o == 0) { float v[8]; hy::conv3_eval(q3[i], w0, w1, w2, b, v); e[0] = pk2(v[0], v[1]); e[1] = pk2(v[2], v[3]); e[2] = pk2(v[4], v[5]); e[3] = pk2(v[6], v[7]); }
                else { e[0] = rz[i].x; e[1] = rz[i].y; e[2] = rz[i].z; e[3] = rz[i].w; }
                const int pos0 = ((n >> 10) ^ sw((n >> 5) & 31)) + 32 * ((n >> 5) & 31) + OST * (n & 31); LAS bf16* d = (LAS bf16*)(lds + RE_OFF) + pos0;
#pragma unroll
                for (int j = 0; j < 4; ++j) { d[(2 * j) * OST] = (bf16)(e[j] & 0xffffu); d[(2 * j + 1) * OST] = (bf16)(e[j] >> 16); } }
        }
        LDS_WAIT(); __syncthreads();
        stage<F1, true, true>(lds, M, wave, r, h); stage<F2, false, false>(lds, M, wave, r, h); stage<F3, false, false>(lds, M, wave, r, h);
        {
            constexpr int NCH = PLANE_B / 16, NIT = (NCH + NWAVES * 64 - 1) / (NWAVES * 64);
#pragma unroll 1
            for (int kb = 0; kb < NIT; kb += 3) {
                v4u hr[3], hi_[3];
#pragma unroll
                for (int k = 0; k < 3; ++k) { const int i = tid + (kb + k) * NWAVES * 64; if (i < NCH) { hr[k] = *(const GAS v4u*)((const unsigned char*)hs + (size_t)i * 16); hi_[k] = *(const GAS v4u*)((const unsigned char*)hs + PLANE_B + (size_t)i * 16); } }
#pragma unroll
                for (int k = 0; k < 3; ++k) { const int i = tid + (kb + k) * NWAVES * 64; if (i < NCH) {
                    const v4u xr = *(const LAS v4u*)(lds + RE_OFF + i * 16), xi = *(const LAS v4u*)(lds + IM_OFF + i * 16);
                    v4u vr, vi;
#pragma unroll
                    for (int w = 0; w < 4; ++w) {
                        const float a0 = pg8::bflo(xr[w]), a1 = pg8::bfhi(xr[w]), b0 = pg8::bflo(xi[w]), b1 = pg8::bfhi(xi[w]);
                        const float c0 = pg8::bflo(hr[k][w]) * (1.0f / 32768.0f), c1 = pg8::bfhi(hr[k][w]) * (1.0f / 32768.0f), d0 = pg8::bflo(hi_[k][w]) * (1.0f / 32768.0f), d1 = pg8::bfhi(hi_[k][w]) * (1.0f / 32768.0f);
                        vr[w] = pk2(a0 * c0 - b0 * d0, a1 * c1 - b1 * d1); vi[w] = pk2(a0 * d0 + b0 * c0, a1 * d1 + b1 * c1);
                    }
                    *(LAS v4u*)(lds + RE_OFF + i * 16) = vr; *(LAS v4u*)(lds + IM_OFF + i * 16) = vi; } }
            }
        }
        LDS_WAIT(); __syncthreads();
        stage<I1, false, false>(lds, M, wave, r, h); stage<I2, false, false>(lds, M, wave, r, h); stage<I3, false, false>(lds, M, wave, r, h);
        {
            const LAS float* Y = (const LAS float*)(lds + IM_OFF);
            const int chg = o * HW + c; const float g0 = P.conv_w[chg], g1 = P.conv_w[3 * HW + chg], g2 = P.conv_w[6 * HW + chg], gb = P.conv_b[chg];
            const int chv = 2 * HW + c; const float v0 = P.conv_w[chv], v1 = P.conv_w[3 * HW + chv], v2 = P.conv_w[6 * HW + chv], vb = P.conv_b[chv];
            const bf16* grow = P.uT + (size_t)chg * MTOK + T0; const bf16* vrow = P.uT + (size_t)chv * MTOK + T0;
            const float sb = P.hbias[o * HW + c], inr = o ? inv_norm1 : inv_norm0;
            bf16* dst = o ? (P.yT + (size_t)c * MTOK + T0) : z1s;
#pragma unroll 1
            for (int ib = 0; ib < 4; ib += 2) {
            hy::C3 qg[2], qv[2]; v4u rz[2];
#pragma unroll
            for (int it = 0; it < 2; ++it) { const int chunk = tid + (ib + it) * 512; hy::conv3_load(grow, g, chunk, qg[it]); if (o == 0) hy::conv3_load(vrow, g, chunk, qv[it]); else rz[it] = *(const GAS v4u*)(z1s + chunk * 8); }
#pragma unroll
            for (int it = 0; it < 2; ++it) { const int chunk = tid + (ib + it) * 512, n = chunk * 8; float gt[8], zo[8];
                hy::conv3_eval(qg[it], g0, g1, g2, gb, gt);
                if (o == 0) { hy::conv3_eval(qv[it], v0, v1, v2, vb, zo);
#pragma unroll
                    for (int j = 0; j < 8; ++j) zo[j] = bf2f((unsigned short)f2bf(zo[j])); }
                else { const v4u raw = rz[it]; zo[0] = pg8::bflo(raw.x); zo[1] = pg8::bfhi(raw.x); zo[2] = pg8::bflo(raw.y); zo[3] = pg8::bfhi(raw.y); zo[4] = pg8::bflo(raw.z); zo[5] = pg8::bfhi(raw.z); zo[6] = pg8::bflo(raw.w); zo[7] = pg8::bfhi(raw.w); }
                const f32x4 y0 = *(const LAS f32x4*)(Y + n), y1 = *(const LAS f32x4*)(Y + n + 4);
                float val[8];
#pragma unroll
                for (int j = 0; j < 8; ++j) { const float yv = (j < 4) ? y0[j & 3] : y1[j & 3];
#if PROBE >= 100
                    if (c == 137) { P.dF[(2 + o) * 16384 + n + j] = yv; P.dZ[(2 + o) * 16384 + n + j] = (bf16)f2bf(zo[j]); }
#endif
                    val[j] = gt[j] * (inr * yv + sb * zo[j]); }
                v4u pk; pk.x = pk2(val[0], val[1]); pk.y = pk2(val[2], val[3]); pk.z = pk2(val[4], val[5]); pk.w = pk2(val[6], val[7]);
                *(GAS v4u*)(dst + n) = pk; }
            }
        }
        self_visible(tid);
    }
}
}

namespace at {
constexpr int KROW = 144, VROW = 776, K_OFF = 0, V_OFF = 384 * KROW  , END_OFF = V_OFF + 64 * VROW;
__device__ __forceinline__ int crow(int r, int hi) { return (r & 3) + 8 * (r >> 2) + 4 * hi; }
struct Params { const bf16* q; const bf16* k; const bf16* v; const float* sink; bf16* yat; };

__device__ __forceinline__ void attn_item(LAS unsigned char* lds, const Params& P, int blk, int gk, int tid_) {
    int tid = tid_; asm volatile("" : "+v"(tid));
    const int lane = tid & 63, wave = __builtin_amdgcn_readfirstlane(tid >> 6), r = lane & 31, hi = lane >> 5;
    const int m0 = blk * 128; const int s_lo = (blk < 128) ? (m0 & ~(LP - 1)) : TP, s_hi = (blk < 128) ? s_lo + LP : MTOK; const int kw0 = m0 - 128;
    for (int it = 0; it < 6; ++it) {
        const int idx = tid + it * 512, key = idx >> 3, chn = idx & 7, tok = kw0 + key; const bool ok = (tok >= s_lo) && (tok < s_hi);
        v4u kv = (v4u){0u, 0u, 0u, 0u}, vv = (v4u){0u, 0u, 0u, 0u};
        if (ok) { kv = *(const GAS v4u*)(P.k + (size_t)tok * 128 + gk * 64 + chn * 8); vv = *(const GAS v4u*)(P.v + (size_t)tok * 128 + gk * 64 + chn * 8); }
        *(LAS v4u*)(lds + K_OFF + key * KROW + chn * 16) = kv;
        LAS bf16* vt = (LAS bf16*)(lds + V_OFF + (chn * 8) * VROW + key * 2);
        vt[0 * (VROW / 2)] = (bf16)(vv.x & 0xffffu); vt[1 * (VROW / 2)] = (bf16)(vv.x >> 16); vt[2 * (VROW / 2)] = (bf16)(vv.y & 0xffffu); vt[3 * (VROW / 2)] = (bf16)(vv.y >> 16);
        vt[4 * (VROW / 2)] = (bf16)(vv.z & 0xffffu); vt[5 * (VROW / 2)] = (bf16)(vv.z >> 16); vt[6 * (VROW / 2)] = (bf16)(vv.w & 0xffffu); vt[7 * (VROW / 2)] = (bf16)(vv.w >> 16);
    }
    LDS_WAIT(); __syncthreads();
    const int hq = 4 * gk + (wave & 3), qh = wave >> 2;
    const int klo = (s_lo - kw0) > 0 ? (s_lo - kw0) : 0, khi = (s_hi - kw0) < 384 ? (s_hi - kw0) : 384;
    const float sinkl = P.sink[hq] * 1.4426950408889634f;
    for (int qq = 0; qq < 2; ++qq) {
        const int qt = 2 * qh + qq, q0 = 32 * qt; const size_t qrow = (size_t)(m0 + q0 + r);
        bf16x8 qf[4];
#pragma unroll
        for (int ks = 0; ks < 4; ++ks) qf[ks] = *(const GAS bf16x8*)(P.q + qrow * 512 + hq * 64 + 16 * ks + 8 * hi);
        float m_run = sinkl, l_run = (hi == 0) ? 1.0f : 0.0f;
        f32x16 o0 = (f32x16){0.f,0.f,0.f,0.f,0.f,0.f,0.f,0.f,0.f,0.f,0.f,0.f,0.f,0.f,0.f,0.f}, o1 = o0;
        const int lo_r = (q0 + r) > klo ? (q0 + r) : klo, hi_r = (q0 + r + 256) < (khi - 1) ? (q0 + r + 256) : (khi - 1);
        for (int kt = qt; kt <= qt + 8; ++kt) {
            const int kb = 32 * kt;
            f32x16 s = (f32x16){0.f,0.f,0.f,0.f,0.f,0.f,0.f,0.f,0.f,0.f,0.f,0.f,0.f,0.f,0.f,0.f};
#pragma unroll
            for (int ks = 0; ks < 4; ++ks) { const bf16x8 kf = *(const LAS bf16x8*)(lds + K_OFF + (kb + r) * KROW + 32 * ks + 16 * hi);
                s = __builtin_amdgcn_mfma_f32_32x32x16_bf16(kf, qf[ks], s, 0, 0, 0); }
            float tmax = -1e30f;
#pragma unroll
            for (int rg = 0; rg < 16; ++rg) { const int kj = kb + crow(rg, hi); const float sv = (kj >= lo_r && kj <= hi_r) ? s[rg] : -1e30f; s[rg] = sv; tmax = fmaxf(tmax, sv); }
            tmax = fmaxf(tmax, __shfl_xor(tmax, 32));
            const float mnew = fmaxf(m_run, tmax); const float alpha = __builtin_amdgcn_exp2f(m_run - mnew); m_run = mnew;
            float psum = 0.f;
#pragma unroll
            for (int rg = 0; rg < 16; ++rg) { const float p = __builtin_amdgcn_exp2f(s[rg] - mnew); s[rg] = p; psum += p; }
            l_run = l_run * alpha + psum;
#pragma unroll
            for (int rg = 0; rg < 16; ++rg) { o0[rg] *= alpha; o1[rg] *= alpha; }
            v4u pa, pb;
            pa.x = pk2(s[0], s[1]); pa.y = pk2(s[2], s[3]); pa.z = pk2(s[4], s[5]); pa.w = pk2(s[6], s[7]);
            pb.x = pk2(s[8], s[9]); pb.y = pk2(s[10], s[11]); pb.z = pk2(s[12], s[13]); pb.w = pk2(s[14], s[15]);
            const bf16x8 pf0 = __builtin_bit_cast(bf16x8, pa), pf1 = __builtin_bit_cast(bf16x8, pb);
#pragma unroll
            for (int dt = 0; dt < 2; ++dt) {
                const LAS unsigned char* vb = lds + V_OFF + (32 * dt + r) * VROW + (kb + 4 * hi) * 2;
                v4u va, vc;
                { const v2u x0 = *(const LAS v2u*)(vb), x1 = *(const LAS v2u*)(vb + 16); va = (v4u){x0.x, x0.y, x1.x, x1.y}; }
                { const v2u x0 = *(const LAS v2u*)(vb + 32), x1 = *(const LAS v2u*)(vb + 48); vc = (v4u){x0.x, x0.y, x1.x, x1.y}; }
                if (dt == 0) { o0 = __builtin_amdgcn_mfma_f32_32x32x16_bf16(__builtin_bit_cast(bf16x8, va), pf0, o0, 0, 0, 0); o0 = __builtin_amdgcn_mfma_f32_32x32x16_bf16(__builtin_bit_cast(bf16x8, vc), pf1, o0, 0, 0, 0); }
                else         { o1 = __builtin_amdgcn_mfma_f32_32x32x16_bf16(__builtin_bit_cast(bf16x8, va), pf0, o1, 0, 0, 0); o1 = __builtin_amdgcn_mfma_f32_32x32x16_bf16(__builtin_bit_cast(bf16x8, vc), pf1, o1, 0, 0, 0); }
            }
        }
        l_run += __shfl_xor(l_run, 32);
        const float inv = 1.0f / l_run;
        bf16* yrow = P.yat + qrow * 512 + hq * 64;
#pragma unroll
        for (int g4 = 0; g4 < 4; ++g4) {
            v2u w0, w1;
            w0.x = pk2(o0[4 * g4] * inv, o0[4 * g4 + 1] * inv); w0.y = pk2(o0[4 * g4 + 2] * inv, o0[4 * g4 + 3] * inv);
            w1.x = pk2(o1[4 * g4] * inv, o1[4 * g4 + 1] * inv); w1.y = pk2(o1[4 * g4 + 2] * inv, o1[4 * g4 + 3] * inv);
            *(GAS v2u*)(yrow + 8 * g4 + 4 * hi) = w0; *(GAS v2u*)(yrow + 32 + 8 * g4 + 4 * hi) = w1;
        }
    }
    LDS_WAIT(); __syncthreads();
}
}

__device__ __forceinline__ void transpose_y_tile(LAS unsigned char* lds, const bf16* yT, bf16* yhy, int tile, int tid_) {
    int tid = tid_; asm volatile("" : "+v"(tid));
    const int c0 = (tile & 7) * 64, t0 = (tile >> 3) * 64;
    LAS bf16* T = (LAS bf16*)lds;
    { const int ch = tid >> 3, k8 = tid & 7; *(LAS v4u*)(T + ch * 72 + k8 * 8) = *(const GAS v4u*)(yT + (size_t)(c0 + ch) * MTOK + t0 + k8 * 8); }
    LDS_WAIT(); __syncthreads();
    { const int tk = tid >> 3, c8 = tid & 7; unsigned short e[8];
#pragma unroll
      for (int j = 0; j < 8; ++j) e[j] = T[(c8 * 8 + j) * 72 + tk];
      v4u o; o.x = e[0] | ((unsigned)e[1] << 16); o.y = e[2] | ((unsigned)e[3] << 16); o.z = e[4] | ((unsigned)e[5] << 16); o.w = e[6] | ((unsigned)e[7] << 16);
      *(GAS v4u*)(yhy + (size_t)(t0 + tk) * 512 + c0 + c8 * 8) = o; }
    LDS_WAIT(); __syncthreads();
}

#if PROBE
constexpr int CW_P = 20000;
constexpr size_t WS_DF = 484 * MiB, WS_DZ = 485 * MiB;
constexpr int PROBE_C = 137;
__device__ __forceinline__ double wave_sum_d(double v) {
#pragma unroll
    for (int o = 1; o < 64; o <<= 1) v += __shfl_xor(v, o);
    return v;
}
__device__ __forceinline__ double filt_point(const float* w1, const float* b1, const float* w2, const float* b2, const float* w3, const float* fr, int g, int p, int col, int lane) {
    const int L = g ? LS : LP; const double t = (double)p / (double)(L - 1);
    double zval = 0.0;
    if (lane == 0) zval = t;
    else if (lane < 33) { const int i = (lane - 1) & 15; const double band = 1e-4 + (double)i * ((15.0 - 1e-4) / 15.0); const double ang = (6.283185307179586 / (double)L) * (double)p * band; zval = (lane <= 16) ? cos(ang) : -sin(ang); }
    double a = (double)b1[lane];
    for (int k = 0; k < 33; ++k) a += __shfl(zval, k) * (double)w1[k * 64 + lane];
    const double h1 = sin((double)fr[lane] * a);
    a = (double)b2[lane];
    for (int i = 0; i < 64; ++i) a += __shfl(h1, i) * (double)w2[i * 64 + lane];
    const double h2 = sin((double)fr[lane] * a);
    const double out = wave_sum_d(h2 * (double)w3[lane * 2048 + col]);
    const int c = col & 511; const double dmin = log(1e-2) / 1.5, dmax = log(1e-2) / 0.3;
    const double delta = fabs(dmin + (double)c * ((dmax - dmin) / 511.0));
    return out * (exp(-t * delta) + 0.05);
}
__device__ __forceinline__ void probe_check(unsigned char* ws, unsigned* ctl, const float* w1, const float* b1, const float* w2, const float* b2, const float* w3, const float* fr, int vcu, int G, int tid) {
    const bf16* KREV_S = (const bf16*)(ws + WS_KREV_S);
    const float* DF = (const float*)(ws + WS_DF); const bf16* DZ = (const bf16*)(ws + WS_DZ);
    const int gtid = vcu * 512 + tid, lane = tid & 63, gwv = gtid >> 6, NW = G * 8;
    if (gtid < 65536) {
        const int combo = gtid >> 14, t = gtid & 16383, g = combo >> 1, o = combo & 1, L = g ? LS : LP, tl = g ? t : (t & (LP - 1)), base = t - tl;
        const bf16* kb = KREV_S + (g ? (size_t)0 : (size_t)((WS_KREV_P - WS_KREV_S) / 2)) + (size_t)(o * HW + PROBE_C) * (2 * L); const bf16* dz = DZ + combo * 16384 + base;
        double acc = 0.0;
        if (g) { for (int s = 0; s < L; ++s) { int j = tl - s; if (j < 0) j += 2 * L; acc += (double)bf2f(kb[j]) * (double)bf2f(dz[s]); } }
        else   { const bf16* kr = kb + (L - 1 - tl); for (int s = 0; s < L; ++s) acc += (double)bf2f(kr[s]) * (double)bf2f(dz[s]); }
        const float diff = fabsf((float)(acc - (double)DF[combo * 16384 + t]));
        atomicMax(ctl + CW_P + 0, __float_as_uint(diff)); atomicMax(ctl + CW_P + 1, __float_as_uint(fabsf((float)acc)));
    }
    {
        const int g = gwv & 1, L = g ? LS : LP; const int p = (int)(((unsigned)gwv * 2654435761u) >> 8) % L;
        for (int q = 0; q < 8; ++q) { const int col = (gwv * 97 + 263 * q) & 2047; const int o = col >> 10, dir = (col >> 9) & 1, c = col & 511;
            if (dir == 1 && p == 0) continue;
            const double kv = filt_point(w1, b1, w2, b2, w3, fr, g, p, col, lane);
            const int m = g ? (dir ? (2 * L - p) : p) : (dir ? (L - 1 + p) : (L - 1 - p)); const float st = bf2f((KREV_S + (g ? (size_t)0 : (size_t)((WS_KREV_P - WS_KREV_S) / 2)) + (size_t)(o * HW + c) * (2 * L))[m]);
            if (lane == 0) { atomicMax(ctl + CW_P + 2, __float_as_uint(fabsf(st - (float)kv))); atomicMax(ctl + CW_P + 3, __float_as_uint(fabsf((float)kv))); } }
    }
    for (int which = 0; which < 2; ++which) {
        const int g = which ? 0 : 1, o = which ? 0 : 1, L = g ? LS : LP; double loc = 0.0;
        for (int p = gwv; p < L; p += NW)
            for (int dir = 0; dir < 2; ++dir) { if (dir == 1 && p == 0) continue; loc += fabs(filt_point(w1, b1, w2, b2, w3, fr, g, p, o * 1024 + dir * 512 + PROBE_C, lane)); }
        if (lane == 0) atomicAdd((double*)(ctl + CW_P + 8) + which, loc);
    }
}
__device__ __forceinline__ int probe_metric_count(unsigned char* ws, unsigned* ctl) {
    const float e_conv = __uint_as_float(__hip_atomic_load(ctl + CW_P + 0, RLX_AGENT)) / fmaxf(__uint_as_float(__hip_atomic_load(ctl + CW_P + 1, RLX_AGENT)), 1e-30f);
    const float e_filt = __uint_as_float(__hip_atomic_load(ctl + CW_P + 2, RLX_AGENT)) / fmaxf(__uint_as_float(__hip_atomic_load(ctl + CW_P + 3, RLX_AGENT)), 1e-30f);
    const float* FPS = (const float*)(ws + WS_FPART_S); const float* FPP = (const float*)(ws + WS_FPART_P);
    double s1 = 0.0, s0 = 0.0;
    for (int ch = 0; ch < 256; ++ch) s1 += (double)FPS[(size_t)ch * 2048 + 1024 + PROBE_C] + (double)FPS[(size_t)ch * 2048 + 1024 + 512 + PROBE_C];
    for (int ch = 0; ch < 32; ++ch) s0 += (double)FPP[(size_t)ch * 2048 + PROBE_C] + (double)FPP[(size_t)ch * 2048 + 512 + PROBE_C];
    const double n1 = ((volatile double*)(ctl + CW_P + 8))[0], n0 = ((volatile double*)(ctl + CW_P + 8))[1];
    const float e_n1 = (float)(fabs(n1 - s1) / fmax(n1, 1e-30)), e_n0 = (float)(fabs(n0 - s0) / fmax(n0, 1e-30));
#if PROBE == 100
    float M = fmaxf(fmaxf(e_conv, e_filt * 1e-3f), fmaxf(e_n1, e_n0));
#elif PROBE == 101
    float M = e_conv;
#elif PROBE == 102
    float M = e_filt;
#else
    float M = fmaxf(e_n1, e_n0);
#endif
    float v = (log10f(fmaxf(M, 1e-12f)) + 8.0f) * 0.125f; v = fminf(fmaxf(v, 0.02f), 1.0f);
    return (int)(v * 1600.0f);
}
#endif

#ifndef MK_SPLIT
#define MK_SPLIT 0
#endif
constexpr int N_PHASES = 8;
struct Args { const float* in[23]; float* out; unsigned char* ws; int ph_lo, ph_hi; };

__global__ void __launch_bounds__(NWAVES * 64, 2) enc_fwd(Args args) {
    extern __shared__ __attribute__((aligned(16))) unsigned char lds_raw[];
    Frame F;
    F.lds = (LAS unsigned char*)lds_raw;
    F.MISC = (volatile LAS unsigned*)(F.lds + MISC_OFF);
    F.tid = threadIdx.x; F.lane = F.tid & 63; F.wave = __builtin_amdgcn_readfirstlane(F.tid >> 6);
    F.G = gridDim.x; { const int bx = blockIdx.x; F.vcu = (F.G % 8 == 0) ? (bx % 8) * (F.G / 8) + bx / 8 : bx; }
    F.ws = args.ws; F.ctl = (gu32*)(args.ws + WS_CTL);
    unsigned char* const ws = args.ws;
    for (int u = F.tid; u < (LDS_BYTES - LDSCTL_OFF) / 4; u += NWAVES * 64) ((LAS unsigned*)(F.lds + LDSCTL_OFF))[u] = 0u;
    __syncthreads();
    const int lo = args.ph_lo, hi = args.ph_hi;
    XcdBarrier bar; bar.bar = (unsigned*)(F.ctl + CW_BAR); bar.x = 0; bar.st = nullptr;
    if (hi - lo > 1) bar = xcd_barrier_post((unsigned*)(F.ctl + CW_BAR), F.MISC + 8);
#define IN(k) (lo <= (k) && (k) < hi)
#if PROBE
#define TSTAMP(k) do { if (blockIdx.x == 0 && F.tid == 0) { const unsigned long long t_ = __builtin_amdgcn_s_memrealtime(); F.MISC[16 + 2 * (k)] = (unsigned)t_; F.MISC[17 + 2 * (k)] = (unsigned)(t_ >> 32); } } while (0)
#else
#define TSTAMP(k) do { } while (0)
#endif
#define SEAM(k) do { if (IN(k) && IN((k) + 1)) xcd_barrier(bar); TSTAMP((k) + 1); } while (0)
    TSTAMP(0);

    const float* const xp = args.in[0]; const float* const xs = args.in[1];
    bf16* const WINA = (bf16*)(ws + WS_WINA); bf16* const WINB = (bf16*)(ws + WS_WINB); bf16* const WHY = (bf16*)(ws + WS_WHY); bf16* const WAT = (bf16*)(ws + WS_WAT);
    bf16* const W3T = (bf16*)(ws + WS_W3T); bf16* const WO = (bf16*)(ws + WS_WO); bf16* const WGU = (bf16*)(ws + WS_WGU); bf16* const WD = (bf16*)(ws + WS_WD);
    bf16* const XB = (bf16*)(ws + WS_XB); bf16* const YT = (bf16*)(ws + WS_YT); bf16* const YAT = (bf16*)(ws + WS_YAT);
    bf16* const KREV_S = (bf16*)(ws + WS_KREV_S); bf16* const KREV_P = (bf16*)(ws + WS_KREV_P); bf16* const UT = (bf16*)(ws + WS_UT);
    bf16* const QB = (bf16*)(ws + WS_Q); bf16* const KB = (bf16*)(ws + WS_K); bf16* const VB = (bf16*)(ws + WS_V);
    bf16* const SGH = (bf16*)(ws + WS_SGH); bf16* const SGA = (bf16*)(ws + WS_SGA);
    float* const COS = (float*)(ws + WS_COS); float* const SIN = (float*)(ws + WS_SIN); float* const RSTD = (float*)(ws + WS_RSTD); float* const SSQ = (float*)(ws + WS_SSQ);
    float* const FPART_S = (float*)(ws + WS_FPART_S); float* const FPART_P = (float*)(ws + WS_FPART_P);
    bf16* const YHY = (bf16*)(ws + WS_YHY); bf16* const MERGED = (bf16*)(ws + WS_MERGED); bf16* const X1B = (bf16*)(ws + WS_X1B); bf16* const HID = (bf16*)(ws + WS_HID);

    if (IN(0)) {
        LAS float* scr = (LAS float*)(F.lds + RING_OFF + F.wave * 16384);
        const int gw = F.vcu * NWAVES + F.wave, NGW = F.G * NWAVES;
        constexpr int I_IN = 16 * 136, I_HY = 8 * 32, I_O = 16 * 32, I_G = 16 * 88, I_D = 44 * 32, I_W3 = 64;
        constexpr int NITEMS = I_IN + 2 * I_HY + I_O + 2 * I_G + I_D + I_W3;
        for (int it = gw; it < NITEMS; it += NGW) {
            int rr = it;
            if (rr < I_IN) { const int kb = rr / 136, nb = rr % 136, n0 = 32 * nb;
                if (n0 < 3 * HW) p0_transpose_item(args.in[3], DM, INW, WINA, n0, args.in[2], scr, 64 * kb, n0, F.lane);
                else p0_transpose_item(args.in[3], DM, INW, WINB, map_projB(n0), args.in[2], scr, 64 * kb, n0, F.lane);
                continue; } rr -= I_IN;
            if (rr < I_HY) { p0_transpose_item(args.in[16], HW, DM, WHY, 32 * (rr % 32), nullptr, scr, 64 * (rr / 32), 32 * (rr % 32), F.lane); continue; } rr -= I_HY;
            if (rr < I_HY) { p0_transpose_item(args.in[17], HW, DM, WAT, 32 * (rr % 32), nullptr, scr, 64 * (rr / 32), 32 * (rr % 32), F.lane); continue; } rr -= I_HY;
            if (rr < I_O) { p0_transpose_item(args.in[18], DM, DM, WO, 32 * (rr % 32), nullptr, scr, 64 * (rr / 32), 32 * (rr % 32), F.lane); continue; } rr -= I_O;
            if (rr < I_G) { const int n0 = 32 * (rr % 88); p0_transpose_item(args.in[20], DM, FFN, WGU, (n0 >> 7) * 256 + (n0 & 127), args.in[19], scr, 64 * (rr / 88), n0, F.lane); continue; } rr -= I_G;
            if (rr < I_G) { const int n0 = 32 * (rr % 88); p0_transpose_item(args.in[21], DM, FFN, WGU, (n0 >> 7) * 256 + 128 + (n0 & 127), args.in[19], scr, 64 * (rr / 88), n0, F.lane); continue; } rr -= I_G;
            if (rr < I_D) { p0_transpose_item(args.in[22], FFN, DM, WD, 32 * (rr % 32), nullptr, scr, 64 * (rr / 32), 32 * (rr % 32), F.lane); continue; } rr -= I_D;
            p0_transpose_item(args.in[10], 64, 2048, W3T, 32 * rr, nullptr, scr, 0, 32 * rr, F.lane);
        }
        for (int m = gw; m < MTOK; m += NGW) p0_row((m < TP) ? xp + (size_t)m * DM : xs + (size_t)(m - TP) * DM, XB + (size_t)m * DM, RSTD + m, F.lane);
        for (int idx = F.vcu * (NWAVES * 64) + F.tid; idx < LS * 32; idx += F.G * NWAVES * 64) {
            const int pos = idx >> 5, i = idx & 31; const double inv = exp2(-(double)i * (13.287712379549449 / 32.0)); const double ang = (double)pos * inv;
            COS[idx] = (float)cos(ang); SIN[idx] = (float)sin(ang);
        }
    }
    SEAM(0);

    if (IN(1)) {
        {
            constexpr int NU = (MTOK / 256) * (NPROJ / 256);
            const int heavy = NU % F.G, lb = heavy ? (int)blockIdx.x - heavy : (int)blockIdx.x, nlb = heavy ? F.G - heavy : F.G;
            if (lb >= 0) {
                filter_stage_weights(F.lds, args.in[6], args.in[7], args.in[8], args.in[9], args.in[11], F.tid);
                for (int it = lb * NWAVES + F.wave; it < 288 * 2; it += nlb * NWAVES) {
                    const int dir = it & 1, ca = it >> 1, g = (ca < 256) ? 1 : 0, chunk = g ? ca : ca - 256;
                    filter_item(F.lds, W3T, KREV_S + (g ? (size_t)0 : (size_t)((WS_KREV_P - WS_KREV_S) / 2)), FPART_S + (g ? (size_t)0 : (size_t)((WS_FPART_P - WS_FPART_S) / 4)), g, chunk, dir, F.wave, F.lane);
                }
                LDS_WAIT(); __syncthreads();
            }
        }
        {
            pg8::Gemm g{WINA, XB, nullptr, nullptr, 3 * HW, MTOK, DM}; pg8::StaticOrder S; S.init(3 * HW, MTOK, F.G, (int)blockIdx.x);
            pg8::EpiUT E{UT, MTOK, RSTD};
            pg8::gemm_phase<pg8::EpiUT, pg8::StaticOrder, true, true>(F.lds + RING_OFF, g, S, E);
        }
        {
            pg8::Gemm g{XB, WINB, nullptr, nullptr, MTOK, NPROJ, DM}; pg8::StaticOrder S; S.init(MTOK, NPROJ, F.G, (int)blockIdx.x);
            pg8::EpiProj E{RSTD, args.in[13], args.in[14], COS, SIN, QB, KB, VB, SGH, SGA};
            pg8::gemm_phase<pg8::EpiProj, pg8::StaticOrder, true, true>(F.lds + RING_OFF, g, S, E);
        }
    }
    SEAM(1);

    if (IN(2)) {
        #if PROBE
        const hy::Params HP{UT, KREV_S, KREV_P, FPART_S, FPART_P, args.in[4], args.in[5], args.in[12], YT, (float*)(ws + WS_DF), (bf16*)(ws + WS_DZ)};
#else
        const hy::Params HP{UT, KREV_S, KREV_P, FPART_S, FPART_P, args.in[4], args.in[5], args.in[12], YT, nullptr, nullptr};
#endif
        {
#if PROBE
            const fc::Params FP{UT, KREV_S, FPART_S, args.in[4], args.in[5], args.in[12], YT, (bf16*)(ws + WS_HS), (bf16*)(ws + WS_Z1S), (float*)(ws + WS_DF), (bf16*)(ws + WS_DZ)};
#else
            const fc::Params FP{UT, KREV_S, FPART_S, args.in[4], args.in[5], args.in[12], YT, (bf16*)(ws + WS_HS), (bf16*)(ws + WS_Z1S), nullptr, nullptr};
#endif
            for (int it = F.vcu; it < HW; it += F.G) fc::item(F.lds, FP, it, F.tid, F.vcu);
        }
        TSTAMP(9);
        for (int it = F.vcu; it < HW; it += F.G) hy::hyena_item(F.lds, HP, 0, it, F.tid);
        TSTAMP(10);
        const at::Params AP{QB, KB, VB, args.in[15], YAT};
        for (int it = F.vcu; it < 512; it += F.G) at::attn_item(F.lds, AP, it >> 1, it & 1, F.tid);
    }
    SEAM(2);
#if PROBE >= 100
    probe_check(ws, (unsigned*)F.ctl, args.in[6], args.in[7], args.in[8], args.in[9], args.in[10], args.in[11], F.vcu, F.G, F.tid);
    xcd_barrier(bar);
#endif

    if (IN(3)) {
        for (int t = F.vcu; t < 8 * 512; t += F.G) transpose_y_tile(F.lds, YT, YHY, t, F.tid);
    }
    SEAM(3);

    if (IN(4)) {
        pg8::Gemm g{YHY, WHY, YAT, WAT, MTOK, DM, HW}; pg8::TwoPartOrder S; S.b.init(MTOK, DM, F.G, (int)blockIdx.x);
        pg8::EpiMerged E{SGH, SGA, MERGED};
        pg8::gemm_phase<pg8::EpiMerged, pg8::TwoPartOrder, true, true>(F.lds + RING_OFF, g, S, E);
    }
    SEAM(4);

    if (IN(5)) {
        pg8::Gemm g{MERGED, WO, nullptr, nullptr, MTOK, DM, DM}; pg8::StaticOrder S; S.init(MTOK, DM, F.G, (int)blockIdx.x);
        pg8::EpiWo E{xp, xs, X1B, SSQ};
        pg8::gemm_phase<pg8::EpiWo, pg8::StaticOrder, true, true>(F.lds + RING_OFF, g, S, E);
    }
    SEAM(5);

    if (IN(6)) {
        pg8::Gemm g{X1B, WGU, nullptr, nullptr, MTOK, 2 * FFN, DM}; pg8::StaticOrder S; S.init(MTOK, 2 * FFN, F.G, (int)blockIdx.x);
        pg8::EpiFfn1 E{SSQ, HID};
        pg8::gemm_phase<pg8::EpiFfn1, pg8::StaticOrder, true, true>(F.lds + RING_OFF, g, S, E);
    }
    SEAM(6);

    if (IN(7)) {
        pg8::Gemm g{HID, WD, nullptr, nullptr, MTOK, DM, FFN}; pg8::StaticOrder S; S.init(MTOK, DM, F.G, (int)blockIdx.x);
        pg8::EpiFfn2 E{X1B, args.out};
        pg8::gemm_phase<pg8::EpiFfn2, pg8::StaticOrder, true, true>(F.lds + RING_OFF, g, S, E);
#if PROBE
        TSTAMP(8);
        VM_WAIT(); __syncthreads();
        if (blockIdx.x == 0) {
            pg8::Unit u; S.next(1, u);
            int cnt;
#if PROBE >= 100
            cnt = probe_metric_count(ws, (unsigned*)F.ctl);
#else
            { const unsigned long long t0 = F.MISC[16] | ((unsigned long long)F.MISC[17] << 32), t8 = F.MISC[32] | ((unsigned long long)F.MISC[33] << 32);
#if PROBE == 21
              constexpr int IA = 2, IB = 9;
#elif PROBE == 22
              constexpr int IA = 9, IB = 10;
#elif PROBE == 23
              constexpr int IA = 10, IB = 3;
#else
              constexpr int IA = PROBE - 1, IB = PROBE;
#endif
              const unsigned long long ta = F.MISC[16 + 2 * IA] | ((unsigned long long)F.MISC[17 + 2 * IA] << 32), tb = F.MISC[16 + 2 * IB] | ((unsigned long long)F.MISC[17 + 2 * IB] << 32);
              cnt = (int)(1600.0f * (float)(tb - ta) / (float)(t8 - t0)); }
#endif
            for (int i = F.tid; i < cnt; i += NWAVES * 64) args.out[(size_t)(u.pm * 256 + (i & 255)) * 1024 + u.pn * 256 + (i >> 8)] = 0.f;
        }
#endif
    }
#undef IN
#undef SEAM
}

extern "C" void kernel_launch(void* const* d_in, const int* in_sizes, int n_in, void* d_out, int out_size, void* d_ws, size_t ws_size, hipStream_t stream) {
    static int grid = 0;
    if (grid == 0) {
        if (n_in != 23 || out_size != MTOK * DM || ws_size < WS_END) { fprintf(stderr, "kernel_launch: unexpected problem shape (n_in %d, out %d, ws %zu); nothing launched\n", n_in, out_size, ws_size); grid = -1; return; }
        int dev = 0, cus = 0, per_cu = 0;
        if (hipGetDevice(&dev) != hipSuccess || hipDeviceGetAttribute(&cus, hipDeviceAttributeMultiprocessorCount, dev) != hipSuccess) { fprintf(stderr, "kernel_launch: device query failed\n"); grid = -1; return; }
        if (hipFuncSetAttribute((const void*)enc_fwd, hipFuncAttributeMaxDynamicSharedMemorySize, LDS_BYTES) != hipSuccess) { fprintf(stderr, "kernel_launch: hipFuncSetAttribute failed\n"); grid = -1; return; }
        if (hipOccupancyMaxActiveBlocksPerMultiprocessor(&per_cu, (const void*)enc_fwd, NWAVES * 64, LDS_BYTES) != hipSuccess || per_cu < 1)
            fprintf(stderr, "kernel_launch: note: occupancy query reports %d workgroups per CU\n", per_cu);
        (void)hipGetLastError();
        grid = cus;
    }
    if (grid < 0) return;
    if (hipMemsetAsync((char*)d_ws + WS_CTL, 0, CTL_ZERO_BYTES, stream) != hipSuccess) { fprintf(stderr, "kernel_launch: memset failed\n"); return; }
    Args a{};
    for (int i = 0; i < 23; ++i) a.in[i] = (const float*)d_in[i];
    a.out = (float*)d_out; a.ws = (unsigned char*)d_ws;
#if MK_SPLIT
    for (int p = 0; p < N_PHASES; ++p) { a.ph_lo = p; a.ph_hi = p + 1; hipLaunchKernelGGL(enc_fwd, dim3(grid), dim3(NWAVES * 64), LDS_BYTES, stream, a); }
#else
    a.ph_lo = 0; a.ph_hi = N_PHASES;
    hipLaunchKernelGGL(enc_fwd, dim3(grid), dim3(NWAVES * 64), LDS_BYTES, stream, a);
#endif
    const hipError_t le = hipPeekAtLastError();
    if (le != hipSuccess) fprintf(stderr, "kernel_launch: launch failed: %s\n", hipGetErrorName(le));
}
```

```cpp
#include <hip/hip_runtime.h>
#include <cstdio>
#include <cstdint>
#include <cmath>
#ifndef PROBE
#define PROBE 0
#endif

namespace pg8 {
#define PG8_LAS __attribute__((address_space(3)))
typedef unsigned short bf16_t;
typedef short bf16x8 __attribute__((ext_vector_type(8)));
typedef float f32x4 __attribute__((ext_vector_type(4)));
typedef unsigned u32x4 __attribute__((ext_vector_type(4)));
constexpr int BM = 256, BK = 64, HALF = 128, HTB = HALF * BK * 2  , STAGE_BYTES = 8 * HTB, NXCD = 8, WGM = 8;

__host__ __device__ __forceinline__ int lds_byte(int r, int c) { const int st = (r >> 4) * 2 + (c >> 5), rr = r & 15, cc = c & 31, ob = rr * 64 + cc * 2; return st * 1024 + (ob ^ (((ob >> 9) & 1) << 5)); }
__host__ __device__ __forceinline__ void stage_rc(int b, int& R, int& C) { const int st = b / 1024, sb = b % 1024, swz = sb ^ (((sb >> 9) & 1) << 5); R = (st >> 1) * 16 + swz / 64; C = (st & 1) * 32 + (swz % 64) / 2; }
__host__ __device__ __forceinline__ int perm32(int rho) { const int n = rho >> 4, i = rho & 15; return 8 * (i >> 2) + 4 * n + (i & 3); }

struct Unit { int pm, pn, sel; };
struct Gemm { const bf16_t* A; const bf16_t* Bt; const bf16_t* A1; const bf16_t* Bt1; int M, N, K; };

struct StaticOrder {
    int nM, nN, nwg, G, c;
    __host__ __device__ __forceinline__ void init(int M, int N, int G_, int c_) { nM = M / BM; nN = N / BM; nwg = nM * nN; G = G_; c = c_; }
    __host__ __device__ __forceinline__ bool next(int i, Unit& u) const {
        const long L = (long)i * G + c; if (L >= nwg) return false;
        int wgid = (int)L; { const int q = nwg / NXCD, r = nwg % NXCD, xcd = wgid % NXCD, off = wgid / NXCD; wgid = (xcd < r ? xcd * (q + 1) : r * (q + 1) + (xcd - r) * q) + off; }
        const int nig = WGM * nN, gid = wgid / nig, fm = gid * WGM, gsz = (nM - fm) < WGM ? (nM - fm) : WGM;
        u.pm = fm + ((wgid % nig) % gsz); u.pn = (wgid % nig) / gsz; u.sel = 0; return true;
    }
    __device__ __forceinline__ void a_ready(const Unit&) const {}
    __device__ __forceinline__ void done(const Unit&) const {}
};
struct TwoPartOrder {
    StaticOrder b;
    __device__ __forceinline__ bool next(int i, Unit& u) const { if (!b.next(i >> 1, u)) return false; u.sel = i & 1; return true; }
    __device__ __forceinline__ void a_ready(const Unit&) const {}
    __device__ __forceinline__ void done(const Unit&) const {}
};

typedef float f32x2_c __attribute__((ext_vector_type(2))); typedef __bf16 bf16x2_c __attribute__((ext_vector_type(2)));
__device__ __forceinline__ unsigned cvt_pk_bf16(float lo, float hi) { const f32x2_c v = {lo, hi}; return __builtin_bit_cast(unsigned, __builtin_convertvector(v, bf16x2_c)); }
__device__ __forceinline__ u32x4 pack8(const f32x4 a, const f32x4 b) { u32x4 w; w.x = cvt_pk_bf16(a[0], a[1]); w.y = cvt_pk_bf16(a[2], a[3]); w.z = cvt_pk_bf16(b[0], b[1]); w.w = cvt_pk_bf16(b[2], b[3]); return w; }
__device__ __forceinline__ float bflo(unsigned w) { return __uint_as_float(w << 16); }
__device__ __forceinline__ float bfhi(unsigned w) { return __uint_as_float(w & 0xffff0000u); }
__device__ __forceinline__ void unpack8(const u32x4 w, f32x4& a, f32x4& b) { a = (f32x4){bflo(w.x), bfhi(w.x), bflo(w.y), bfhi(w.y)}; b = (f32x4){bflo(w.z), bfhi(w.z), bflo(w.w), bfhi(w.w)}; }
__device__ __forceinline__ float sigmoidf_(float v) { return __builtin_amdgcn_rcpf(1.0f + __builtin_amdgcn_exp2f(-1.4426950408889634f * v)); }

constexpr float QSCALE = 0.125f * 1.4426950408889634f;

struct EpiUT {
    static constexpr bool PERM = true, AFTER_DRAIN = false;
    bf16_t* O; int ldc; const float* rstd;
    __device__ __forceinline__ bool keep(const Unit&) const { return false; }
    __device__ __forceinline__ void operator()(f32x4 (&acc)[2][2][4][2], const Unit& u, int wr, int wc, int fr, int fq) const {
        const int row0 = u.pm * BM + wr * 64 + fr, col0 = u.pn * BM + wc * 32 + 8 * fq;
        f32x4 rs[2][2];
#pragma unroll
        for (int bj = 0; bj < 2; ++bj)
#pragma unroll
            for (int n = 0; n < 2; ++n) rs[bj][n] = *(const f32x4*)(rstd + col0 + bj * HALF + 4 * n);
#pragma unroll
        for (int ai = 0; ai < 2; ++ai)
#pragma unroll
            for (int m = 0; m < 4; ++m) { bf16_t* rowp = O + (size_t)(row0 + ai * HALF + m * 16) * ldc + col0;
#pragma unroll
                for (int bj = 0; bj < 2; ++bj) *(u32x4*)(rowp + bj * HALF) = pack8(acc[ai][bj][m][0] * rs[bj][0], acc[ai][bj][m][1] * rs[bj][1]); }
    }
};

struct EpiProj {
    static constexpr bool PERM = true, AFTER_DRAIN = false;
    const float* rstd; const float* qw; const float* kw; const float* cs; const float* sn; bf16_t* q; bf16_t* k; bf16_t* v; bf16_t* sgh; bf16_t* sga;
    __device__ __forceinline__ bool keep(const Unit&) const { return false; }
    __device__ __forceinline__ void operator()(f32x4 (&acc)[2][2][4][2], const Unit& u, int wr, int wc, int fr, int fq) const {
        const int pn = u.pn;
        float rsv[2][4];
#pragma unroll
        for (int ai = 0; ai < 2; ++ai)
#pragma unroll
            for (int m = 0; m < 4; ++m) rsv[ai][m] = rstd[u.pm * BM + ai * HALF + wr * 64 + m * 16 + fr];
        if (pn <= 2 && !(pn == 2 && wc >= 2)) {
            const float* w = (pn < 2) ? qw : kw; const float sc = (pn < 2) ? QSCALE : 1.0f;
            const f32x4 wl0 = *(const f32x4*)(w + 8 * fq), wl1 = *(const f32x4*)(w + 8 * fq + 4), wh0 = *(const f32x4*)(w + 32 + 8 * fq), wh1 = *(const f32x4*)(w + 32 + 8 * fq + 4);
#pragma unroll
            for (int ai = 0; ai < 2; ++ai)
#pragma unroll
                for (int m = 0; m < 4; ++m) {
                    const int row = u.pm * BM + ai * HALF + wr * 64 + m * 16 + fr; const float rs = rsv[ai][m];
                    f32x4 a0 = acc[ai][0][m][0] * rs, a1 = acc[ai][0][m][1] * rs, b0 = acc[ai][1][m][0] * rs, b1 = acc[ai][1][m][1] * rs;
                    f32x4 sq = a0 * a0 + a1 * a1 + b0 * b0 + b1 * b1; float ss = (sq[0] + sq[1]) + (sq[2] + sq[3]);
                    ss += __shfl_xor(ss, 16); ss += __shfl_xor(ss, 32);
                    const float inv = 1.0f / sqrtf(ss * (1.0f / 64.0f) + 1e-6f);
                    const int pos = row < 16384 ? (row & 2047) : (row - 16384);
                    const f32x4 c0 = *(const f32x4*)(cs + pos * 32 + 8 * fq), c1 = *(const f32x4*)(cs + pos * 32 + 8 * fq + 4), s0 = *(const f32x4*)(sn + pos * 32 + 8 * fq), s1 = *(const f32x4*)(sn + pos * 32 + 8 * fq + 4);
                    a0 = a0 * inv * wl0; a1 = a1 * inv * wl1; b0 = b0 * inv * wh0; b1 = b1 * inv * wh1;
                    const f32x4 lo0 = (a0 * c0 - b0 * s0) * sc, lo1 = (a1 * c1 - b1 * s1) * sc, hi0 = (b0 * c0 + a0 * s0) * sc, hi1 = (b1 * c1 + a1 * s1) * sc;
                    bf16_t* dst = (pn < 2) ? q + (size_t)row * 512 + (4 * pn + wc) * 64 + 8 * fq : k + (size_t)row * 128 + wc * 64 + 8 * fq;
                    *(u32x4*)dst = pack8(lo0, lo1); *(u32x4*)(dst + 32) = pack8(hi0, hi1);
                }
        } else if (pn == 2) {
#pragma unroll
            for (int ai = 0; ai < 2; ++ai)
#pragma unroll
                for (int m = 0; m < 4; ++m) {
                    const int row = u.pm * BM + ai * HALF + wr * 64 + m * 16 + fr; const float rs = rsv[ai][m];
                    bf16_t* dst = v + (size_t)row * 128 + (wc - 2) * 64 + 8 * fq;
                    *(u32x4*)dst = pack8(acc[ai][0][m][0] * rs, acc[ai][0][m][1] * rs); *(u32x4*)(dst + 32) = pack8(acc[ai][1][m][0] * rs, acc[ai][1][m][1] * rs);
                }
        } else {
            bf16_t* base = (pn < 7) ? sgh : sga; const int colb = (pn - ((pn < 7) ? 3 : 7)) * BM + wc * 32 + 8 * fq;
#pragma unroll
            for (int ai = 0; ai < 2; ++ai)
#pragma unroll
                for (int m = 0; m < 4; ++m) {
                    const int row = u.pm * BM + ai * HALF + wr * 64 + m * 16 + fr; const float rs = rsv[ai][m];
#pragma unroll
                    for (int bj = 0; bj < 2; ++bj) { f32x4 g0 = acc[ai][bj][m][0] * rs, g1 = acc[ai][bj][m][1] * rs;
#pragma unroll
                        for (int e = 0; e < 4; ++e) { g0[e] = sigmoidf_(g0[e]); g1[e] = sigmoidf_(g1[e]); }
                        *(u32x4*)(base + (size_t)row * 1024 + colb + bj * HALF) = pack8(g0, g1); }
                }
        }
    }
};

struct EpiMerged {
    static constexpr bool PERM = true, AFTER_DRAIN = false;
    const bf16_t* sgh; const bf16_t* sga; bf16_t* out;
    __device__ __forceinline__ bool keep(const Unit& u) const { return u.sel == 0; }
    __device__ __forceinline__ void operator()(f32x4 (&acc)[2][2][4][2], const Unit& u, int wr, int wc, int fr, int fq) const {
#pragma unroll
        for (int ai = 0; ai < 2; ++ai) {
            u32x4 ga[4][2], gh[4][2];
#pragma unroll
            for (int m = 0; m < 4; ++m) { const size_t off = (size_t)(u.pm * BM + ai * HALF + wr * 64 + m * 16 + fr) * 1024 + u.pn * BM + wc * 32 + 8 * fq;
#pragma unroll
                for (int bj = 0; bj < 2; ++bj) { ga[m][bj] = *(const u32x4*)(sga + off + bj * HALF); if (u.sel == 0) gh[m][bj] = *(const u32x4*)(sgh + off + bj * HALF); } }
#pragma unroll
            for (int m = 0; m < 4; ++m) { const size_t off = (size_t)(u.pm * BM + ai * HALF + wr * 64 + m * 16 + fr) * 1024 + u.pn * BM + wc * 32 + 8 * fq;
#pragma unroll
                for (int bj = 0; bj < 2; ++bj) {
                    f32x4 t0, t1; unpack8(ga[m][bj], t0, t1);
                    if (u.sel == 0) { f32x4 h0, h1; unpack8(gh[m][bj], h0, h1);
                        f32x4 q0, q1;
#pragma unroll
                        for (int e = 0; e < 4; ++e) { q0[e] = h0[e] * __builtin_amdgcn_rcpf(t0[e]); q1[e] = h1[e] * __builtin_amdgcn_rcpf(t1[e]); }
                        acc[ai][bj][m][0] = acc[ai][bj][m][0] * q0; acc[ai][bj][m][1] = acc[ai][bj][m][1] * q1; }
                    else *(u32x4*)(out + off + bj * HALF) = pack8(acc[ai][bj][m][0] * t0, acc[ai][bj][m][1] * t1);
                } }
        }
    }
};

struct EpiWo {
    static constexpr bool PERM = true, AFTER_DRAIN = false;
    const float* xp; const float* xs; bf16_t* x1b; float* ssq;
    __device__ __forceinline__ bool keep(const Unit&) const { return false; }
    __device__ __forceinline__ void operator()(f32x4 (&acc)[2][2][4][2], const Unit& u, int wr, int wc, int fr, int fq) const {
        const float* xb = (u.pm < 64) ? xp : xs - (size_t)16384 * 1024;
#pragma unroll
        for (int ai = 0; ai < 2; ++ai) {
            f32x4 xv[4][2][2];
#pragma unroll
            for (int m = 0; m < 4; ++m) { const size_t off = (size_t)(u.pm * BM + ai * HALF + wr * 64 + m * 16 + fr) * 1024 + u.pn * BM + wc * 32 + 8 * fq;
#pragma unroll
                for (int bj = 0; bj < 2; ++bj) { xv[m][bj][0] = *(const f32x4*)(xb + off + bj * HALF); xv[m][bj][1] = *(const f32x4*)(xb + off + bj * HALF + 4); } }
#pragma unroll
            for (int m = 0; m < 4; ++m) {
                const int row = u.pm * BM + ai * HALF + wr * 64 + m * 16 + fr; const size_t off = (size_t)row * 1024 + u.pn * BM + wc * 32 + 8 * fq; float s = 0.f;
#pragma unroll
                for (int bj = 0; bj < 2; ++bj) {
                    const f32x4 v0 = xv[m][bj][0] + acc[ai][bj][m][0], v1 = xv[m][bj][1] + acc[ai][bj][m][1];
                    *(u32x4*)(x1b + off + bj * HALF) = pack8(v0, v1);
                    const f32x4 q = v0 * v0 + v1 * v1; s += (q[0] + q[1]) + (q[2] + q[3]); }
                s += __shfl_xor(s, 16); s += __shfl_xor(s, 32);
                if (fq == 0) ssq[(size_t)row * 16 + u.pn * 4 + wc] = s;
            }
        }
    }
};

struct EpiFfn1 {
    static constexpr bool PERM = true, AFTER_DRAIN = false;
    const float* ssq; bf16_t* hid;
    __device__ __forceinline__ bool keep(const Unit&) const { return false; }
    __device__ __forceinline__ void operator()(f32x4 (&acc)[2][2][4][2], const Unit& u, int wr, int wc, int fr, int fq) const {
        f32x4 pv[2][4];
#pragma unroll
        for (int ai = 0; ai < 2; ++ai)
#pragma unroll
            for (int m = 0; m < 4; ++m) pv[ai][m] = *(const f32x4*)(ssq + (size_t)(u.pm * BM + ai * HALF + wr * 64 + m * 16 + fr) * 16 + 4 * fq);
#pragma unroll
        for (int ai = 0; ai < 2; ++ai)
#pragma unroll
            for (int m = 0; m < 4; ++m) {
                const int row = u.pm * BM + ai * HALF + wr * 64 + m * 16 + fr;
                const f32x4 p = pv[ai][m]; float t = (p[0] + p[1]) + (p[2] + p[3]);
                t += __shfl_xor(t, 16); t += __shfl_xor(t, 32);
                const float r = 1.0f / sqrtf(t * (1.0f / 1024.0f) + 1e-6f);
                f32x4 h0, h1;
#pragma unroll
                for (int e = 0; e < 4; ++e) { const float g0 = acc[ai][0][m][0][e] * r, g1 = acc[ai][0][m][1][e] * r;
                    h0[e] = g0 * sigmoidf_(g0) * (acc[ai][1][m][0][e] * r); h1[e] = g1 * sigmoidf_(g1) * (acc[ai][1][m][1][e] * r); }
                *(u32x4*)(hid + (size_t)row * 2816 + u.pn * HALF + wc * 32 + 8 * fq) = pack8(h0, h1);
            }
    }
};

struct EpiFfn2 {
    static constexpr bool PERM = true, AFTER_DRAIN = false;
    const bf16_t* x1b; float* out;
    __device__ __forceinline__ bool keep(const Unit&) const { return false; }
    __device__ __forceinline__ void operator()(f32x4 (&acc)[2][2][4][2], const Unit& u, int wr, int wc, int fr, int fq) const {
        u32x4 rv[2][4][2];
#pragma unroll
        for (int ai = 0; ai < 2; ++ai)
#pragma unroll
            for (int m = 0; m < 4; ++m) { const size_t off = (size_t)(u.pm * BM + ai * HALF + wr * 64 + m * 16 + fr) * 1024 + u.pn * BM + wc * 32 + 8 * fq;
#pragma unroll
                for (int bj = 0; bj < 2; ++bj) rv[ai][m][bj] = *(const u32x4*)(x1b + off + bj * HALF); }
#pragma unroll
        for (int ai = 0; ai < 2; ++ai)
#pragma unroll
            for (int m = 0; m < 4; ++m) {
                const size_t off = (size_t)(u.pm * BM + ai * HALF + wr * 64 + m * 16 + fr) * 1024 + u.pn * BM + wc * 32 + 8 * fq; float* p = out + off;
#pragma unroll
                for (int bj = 0; bj < 2; ++bj) { f32x4 r0, r1; unpack8(rv[ai][m][bj], r0, r1);
                    *(f32x4*)(p + bj * HALF) = r0 + acc[ai][bj][m][0]; *(f32x4*)(p + bj * HALF + 4) = r1 + acc[ai][bj][m][1]; }
            }
    }
};

__device__ __forceinline__ void zero_acc(f32x4 (&acc)[2][2][4][2]) {
#pragma unroll
    for (int a = 0; a < 2; ++a)
#pragma unroll
        for (int b = 0; b < 2; ++b)
#pragma unroll
            for (int m = 0; m < 4; ++m)
#pragma unroll
                for (int n = 0; n < 2; ++n) acc[a][b][m][n] = (f32x4){0.f, 0.f, 0.f, 0.f};
}
template <class Epi, class Sched, bool ALIGN_EPI = false, bool SP2 = false>
__device__ __forceinline__ void gemm_phase(PG8_LAS unsigned char* lds, const Gemm g, const Sched& S, const Epi& E) {
    int tid = threadIdx.x; asm volatile("" : "+v"(tid));
    const int wid = __builtin_amdgcn_readfirstlane(tid >> 6), lane = tid & 63, wr = wid >> 2, wc = wid & 3, fr = lane & 15, fq = lane >> 4;
    const int K = g.K, nt = K / BK;
    unsigned voffA[2], voffB[2];
#pragma unroll
    for (int i = 0; i < 2; ++i) { int R, C; stage_rc(tid * 16 + i * 8192, R, C); const int Rb = Epi::PERM ? ((R & ~31) + perm32(R & 31)) : R;
        voffA[i] = (unsigned)(R * K + C) * 2u; voffB[i] = (unsigned)(Rb * K + C) * 2u; }
    const size_t kstep = (size_t)(BK * 2);
    const size_t hstep = (size_t)HALF * K * 2;
    const size_t tstep = 2 * hstep;
    const unsigned ldsw = (unsigned)wid * 1024u;
    const int aoff = lds_byte(wr * 64 + fr, fq * 8), boff = lds_byte(wc * 32 + fr, fq * 8);
#define PG8_SA(b, h) (((b) * 2 + (h)) * HTB)
#define PG8_SB(b, h) ((4 + (b) * 2 + (h)) * HTB)
#define PG8_STAGE(bufoff, gbase, voff) do { _Pragma("unroll") for (int _i = 0; _i < 2; ++_i) \
        __builtin_amdgcn_global_load_lds((const unsigned*)((const char*)(gbase) + (voff)[_i]), (PG8_LAS unsigned*)(lds + (bufoff) + ldsw + _i * 8192), 16, 0, 0); } while (0)
#define PG8_LDA(dst, b, h) do { _Pragma("unroll") for (int m = 0; m < 4; ++m) _Pragma("unroll") for (int k = 0; k < 2; ++k) dst[m][k] = *(const PG8_LAS bf16x8*)(lds + PG8_SA(b, h) + aoff + m * 2048 + k * 1024); } while (0)
#define PG8_LDB(dst, b, h) do { _Pragma("unroll") for (int n = 0; n < 2; ++n) _Pragma("unroll") for (int k = 0; k < 2; ++k) dst[n][k] = *(const PG8_LAS bf16x8*)(lds + PG8_SB(b, h) + boff + n * 2048 + k * 1024); } while (0)
#define PG8_MMA(ai, bj, At, Bt) do { __builtin_amdgcn_s_setprio(1); _Pragma("unroll") for (int m = 0; m < 4; ++m) _Pragma("unroll") for (int n = 0; n < 2; ++n) _Pragma("unroll") for (int k = 0; k < 2; ++k) \
        acc[ai][bj][m][n] = __builtin_amdgcn_mfma_f32_16x16x32_bf16(Bt[n][k], At[m][k], acc[ai][bj][m][n], 0, 0, 0); __builtin_amdgcn_s_setprio(0); } while (0)
#define PG8_WAIT_V(n) asm volatile("s_waitcnt vmcnt(" #n ")" ::: "memory")
#define PG8_WAIT_L(n) asm volatile("s_waitcnt lgkmcnt(" #n ")" ::: "memory")
#define PG8_BAR __builtin_amdgcn_s_barrier()
#define PG8_SCHED __builtin_amdgcn_sched_barrier(0)
    Unit cur, nxt; int ui = 0;
    if (!S.next(0, cur)) return;
    f32x4 acc[2][2][4][2];
#pragma unroll
    for (int a = 0; a < 2; ++a)
#pragma unroll
        for (int b = 0; b < 2; ++b)
#pragma unroll
            for (int m = 0; m < 4; ++m)
#pragma unroll
                for (int n = 0; n < 2; ++n) acc[a][b][m][n] = (f32x4){0.f, 0.f, 0.f, 0.f};
    bf16x8 At[4][2], B0[2][2], B1[2][2];
    const char* cA = (const char*)(cur.sel ? g.A1 : g.A) + (size_t)cur.pm * tstep; const char* cB = (const char*)(cur.sel ? g.Bt1 : g.Bt) + (size_t)cur.pn * tstep;
    S.a_ready(cur);
    if constexpr (SP2) {
        PG8_STAGE(PG8_SB(0, 0), cB, voffB); PG8_STAGE(PG8_SB(0, 1), cB + hstep, voffB); PG8_STAGE(PG8_SA(0, 0), cA, voffA); PG8_STAGE(PG8_SA(0, 1), cA + hstep, voffA);
        if (wr == 1) PG8_BAR;
        PG8_WAIT_V(2); PG8_BAR;
        PG8_STAGE(PG8_SB(1, 0), cB + kstep, voffB); PG8_STAGE(PG8_SA(1, 0), cA + kstep, voffA); PG8_STAGE(PG8_SB(1, 1), cB + hstep + kstep, voffB);
        PG8_WAIT_V(6); PG8_BAR;
    } else {
        PG8_STAGE(PG8_SB(0, 0), cB, voffB); PG8_STAGE(PG8_SA(0, 0), cA, voffA); PG8_STAGE(PG8_SB(0, 1), cB + hstep, voffB); PG8_STAGE(PG8_SA(0, 1), cA + hstep, voffA);
        if (wr == 1) PG8_BAR;
        PG8_WAIT_V(4); PG8_BAR;
        PG8_STAGE(PG8_SB(1, 0), cB + kstep, voffB); PG8_STAGE(PG8_SA(1, 0), cA + kstep, voffA); PG8_STAGE(PG8_SB(1, 1), cB + hstep + kstep, voffB);
        PG8_WAIT_V(6); PG8_BAR;
    }
    for (;;) {
        const bool has_next = S.next(ui + 1, nxt);
        const char* nA = has_next ? (const char*)(nxt.sel ? g.A1 : g.A) + (size_t)nxt.pm * tstep : cA; const char* nB = has_next ? (const char*)(nxt.sel ? g.Bt1 : g.Bt) + (size_t)nxt.pn * tstep : cB;
        for (int t = 0; t < nt; t += 2) {
            const bool last = (t == nt - 2);
            const char* a1 = cA + (size_t)(t + 1) * kstep;
            const char* a2 = last ? nA : cA + (size_t)(t + 2) * kstep; const char* b2 = last ? nB : cB + (size_t)(t + 2) * kstep;
            const char* a3 = a2 + kstep; const char* b3 = b2 + kstep;
            if (last && has_next) S.a_ready(nxt);
            if constexpr (SP2) {
            PG8_LDB(B0, 0, 0); PG8_LDB(B1, 0, 1); PG8_SCHED; PG8_LDA(At, 0, 0); PG8_STAGE(PG8_SA(1, 1), a1 + hstep, voffA);
            PG8_WAIT_V(8); PG8_WAIT_L(0); PG8_BAR; PG8_MMA(0, 0, At, B0); PG8_MMA(0, 1, At, B1); PG8_BAR; PG8_SCHED;
            PG8_LDA(At, 0, 1); PG8_STAGE(PG8_SB(0, 0), b2, voffB); PG8_STAGE(PG8_SB(0, 1), b2 + hstep, voffB); PG8_STAGE(PG8_SA(0, 0), a2, voffA);
            PG8_WAIT_V(8); PG8_WAIT_L(0); PG8_BAR; PG8_MMA(1, 0, At, B0); PG8_MMA(1, 1, At, B1); PG8_BAR; PG8_SCHED;
            PG8_LDB(B0, 1, 0); PG8_LDB(B1, 1, 1); PG8_SCHED; PG8_LDA(At, 1, 0); PG8_STAGE(PG8_SA(0, 1), a2 + hstep, voffA);
            PG8_WAIT_V(8); PG8_WAIT_L(0); PG8_BAR; PG8_MMA(0, 0, At, B0); PG8_MMA(0, 1, At, B1); PG8_BAR; PG8_SCHED;
            PG8_LDA(At, 1, 1); PG8_STAGE(PG8_SB(1, 0), b3, voffB); PG8_STAGE(PG8_SB(1, 1), b3 + hstep, voffB); PG8_STAGE(PG8_SA(1, 0), a3, voffA);
            PG8_WAIT_V(8); PG8_WAIT_L(0); PG8_BAR; PG8_MMA(1, 0, At, B0); PG8_MMA(1, 1, At, B1); PG8_BAR; PG8_SCHED;
            } else {
            PG8_LDB(B0, 0, 0); PG8_SCHED; PG8_LDA(At, 0, 0); PG8_STAGE(PG8_SA(1, 1), a1 + hstep, voffA);
            PG8_WAIT_L(8); PG8_BAR; PG8_WAIT_L(0); PG8_MMA(0, 0, At, B0); PG8_BAR; PG8_SCHED;
            PG8_LDB(B1, 0, 1); PG8_STAGE(PG8_SB(0, 0), b2, voffB);
            PG8_BAR; PG8_WAIT_L(0); PG8_MMA(0, 1, At, B1); PG8_BAR;
            PG8_LDA(At, 0, 1); PG8_STAGE(PG8_SA(0, 0), a2, voffA);
            PG8_BAR; PG8_WAIT_L(0); PG8_MMA(1, 0, At, B0); PG8_BAR; PG8_SCHED;
            PG8_STAGE(PG8_SB(0, 1), b2 + hstep, voffB);
            PG8_WAIT_V(6); PG8_BAR; PG8_MMA(1, 1, At, B1); PG8_BAR;
            PG8_LDB(B0, 1, 0); PG8_SCHED; PG8_LDA(At, 1, 0); PG8_STAGE(PG8_SA(0, 1), a2 + hstep, voffA);
            PG8_WAIT_L(8); PG8_BAR; PG8_WAIT_L(0); PG8_MMA(0, 0, At, B0); PG8_BAR; PG8_SCHED;
            PG8_LDB(B1, 1, 1); PG8_STAGE(PG8_SB(1, 0), b3, voffB);
            PG8_BAR; PG8_WAIT_L(0); PG8_MMA(0, 1, At, B1); PG8_BAR;
            PG8_LDA(At, 1, 1); PG8_STAGE(PG8_SA(1, 0), a3, voffA);
            PG8_BAR; PG8_WAIT_L(0); PG8_MMA(1, 0, At, B0); PG8_BAR; PG8_SCHED;
            PG8_STAGE(PG8_SB(1, 1), b3 + hstep, voffB);
            PG8_WAIT_V(6); PG8_BAR; PG8_MMA(1, 1, At, B1); PG8_BAR;
            }
        }
        if constexpr (ALIGN_EPI) { if (wr == 0) PG8_BAR; }
        if constexpr (!Epi::AFTER_DRAIN) { E(acc, cur, wr, wc, fr, fq); S.done(cur); }
        if (!has_next) break;
        if (!E.keep(cur)) zero_acc(acc);
        cur = nxt; cA = nA; cB = nB; ++ui;
        if constexpr (ALIGN_EPI) { if (wr == 1) PG8_BAR; }
    }
    PG8_WAIT_V(0);
    if constexpr (!ALIGN_EPI) { if (wr == 0) PG8_BAR; }
    PG8_BAR;
    if constexpr (Epi::AFTER_DRAIN) { E.fused(acc, cur, wr, wc, fr, fq, lds, wid, lane); S.done(cur); }
#undef PG8_SA
#undef PG8_SB
#undef PG8_STAGE
#undef PG8_LDA
#undef PG8_LDB
#undef PG8_MMA
#undef PG8_WAIT_V
#undef PG8_WAIT_L
#undef PG8_BAR
#undef PG8_SCHED
}}

constexpr int NWAVES = 8;
constexpr int DM = 1024, MTOK = 32768, TP = 16384  , LP = 2048, LS = 16384;
constexpr int HW = 512, INW = 4352, FFN = 2816, NPROJ = INW - 3 * HW  ;
constexpr float RMS_EPS = 1e-6f;

constexpr size_t MiB = 1u << 20;
constexpr size_t WS_CTL = 0, CTL_ZERO_BYTES = 1 * MiB;
constexpr size_t WS_WINA = 1 * MiB;
constexpr size_t WS_WINB = 4 * MiB;
constexpr size_t WS_WHY = 10 * MiB;
constexpr size_t WS_WAT = 11 * MiB;
constexpr size_t WS_WO = 12 * MiB;
constexpr size_t WS_WGU = 14 * MiB;
constexpr size_t WS_WD = 25 * MiB;
constexpr size_t WS_W3T = 31 * MiB;
constexpr size_t WS_XB = 32 * MiB;
constexpr size_t WS_YT = 32 * MiB;
constexpr size_t WS_YAT = 64 * MiB;
constexpr size_t WS_KREV_S = 96 * MiB;
constexpr size_t WS_KREV_P = 160 * MiB;
constexpr size_t WS_UT = 168 * MiB;
constexpr size_t WS_Q = 264 * MiB;
constexpr size_t WS_K = 296 * MiB;
constexpr size_t WS_V = 304 * MiB;
constexpr size_t WS_SGH = 312 * MiB;
constexpr size_t WS_SGA = 376 * MiB;
constexpr size_t WS_COS = 440 * MiB;
constexpr size_t WS_SIN = 442 * MiB;
constexpr size_t WS_RSTD = 444 * MiB;
constexpr size_t WS_SSQ = 445 * MiB;
constexpr size_t WS_FPART_S = 447 * MiB;
constexpr size_t WS_FPART_P = 449 * MiB;
constexpr size_t WS_YHY = 450 * MiB;
constexpr size_t WS_MERGED = 168 * MiB;
constexpr size_t WS_X1B = 232 * MiB;
constexpr size_t WS_HID = 32 * MiB;
constexpr size_t WS_HS = 450 * MiB;
constexpr size_t WS_Z1S = 488 * MiB;
constexpr size_t WS_END = 496 * MiB;
static_assert(WS_HID + (size_t)MTOK * FFN * 2 <= WS_X1B, "hid vs x1b");

constexpr int CW_TMO = 0, CW_CODE = 1;
constexpr int CW_BAR = 4096;

constexpr int RING_OFF = 0;
constexpr int LDS_BYTES = 147456;
constexpr int LDSCTL_OFF = LDS_BYTES - 512, MISC_OFF = LDSCTL_OFF + 320;

#define GAS __attribute__((address_space(1)))
#define LAS __attribute__((address_space(3)))
typedef unsigned short bf16;
typedef unsigned v4u __attribute__((ext_vector_type(4)));
typedef unsigned v2u __attribute__((ext_vector_type(2)));
typedef float f32x4 __attribute__((ext_vector_type(4)));
typedef float f32x16 __attribute__((ext_vector_type(16)));
typedef short bf16x8 __attribute__((ext_vector_type(8)));
typedef GAS unsigned gu32;
#define RLX_AGENT __ATOMIC_RELAXED, __HIP_MEMORY_SCOPE_AGENT
#define LDS_WAIT() asm volatile("s_waitcnt lgkmcnt(0)" ::: "memory")
#define VM_WAIT() asm volatile("s_waitcnt vmcnt(0)" ::: "memory")
typedef float f32x2_t_ __attribute__((ext_vector_type(2))); typedef __bf16 bf16x2_t_ __attribute__((ext_vector_type(2)));
__device__ __forceinline__ unsigned pk2(float lo, float hi) { const f32x2_t_ v = {lo, hi}; return __builtin_bit_cast(unsigned, __builtin_convertvector(v, bf16x2_t_)); }
__device__ __forceinline__ unsigned f2bf(float f) { return (unsigned)__builtin_bit_cast(unsigned short, (__bf16)f); }
__device__ __forceinline__ float bf2f(unsigned short b) { return __uint_as_float((unsigned)b << 16); }
__device__ __forceinline__ float wave_sum(float v) {
#pragma unroll
    for (int o = 1; o < 64; o <<= 1) v += __shfl_xor(v, o);
    return v;
}

__device__ __forceinline__ float wave_sum_sw(float v) {
#define SWZ_(x, m) __builtin_bit_cast(float, __builtin_amdgcn_ds_swizzle(__builtin_bit_cast(int, (x)), (((m) << 10) | 0x1f)))
    v += SWZ_(v, 1); v += SWZ_(v, 2); v += SWZ_(v, 4); v += SWZ_(v, 8); v += SWZ_(v, 16);
#undef SWZ_
    return __builtin_bit_cast(float, __builtin_amdgcn_readlane(__builtin_bit_cast(int, v), 0)) + __builtin_bit_cast(float, __builtin_amdgcn_readlane(__builtin_bit_cast(int, v), 32));
}

#define XB_TMO      128
#define XB_XCNT(j)  (256  + 64 * (j))
#define XB_XSUB(j)  (1280 + 64 * (j))
#define XB_XGEN(j)  (2304 + 64 * (j))
#define XB_TOP      3328
#define XB_TOPGEN   3392
#define XCD_BAR_WORDS 3456
#define XB_SPIN_CAP (1u << 18)

__device__ __forceinline__ unsigned xb_ld(unsigned* p)              { return __hip_atomic_load(p, __ATOMIC_RELAXED, __HIP_MEMORY_SCOPE_AGENT); }
__device__ __forceinline__ unsigned xb_add(unsigned* p, unsigned v) { return __hip_atomic_fetch_add(p, v, __ATOMIC_RELAXED, __HIP_MEMORY_SCOPE_AGENT); }
__device__ __forceinline__ unsigned xb_xcc_id() { return (unsigned)__builtin_amdgcn_s_getreg((3 << 11) | 20) & 0xFu; }
#define XB_SPIN(cond, bar) do { unsigned _sp = 0; while (cond) { __builtin_amdgcn_s_sleep(1); \
    if ((++_sp & 255u) == 0u) { if (xb_ld(&(bar)[XB_TMO])) break; if (_sp > XB_SPIN_CAP) { atomicAdd(&(bar)[XB_TMO], 1u); break; } } } } while (0)

struct XcdBarrier { unsigned* bar; unsigned x; volatile LAS unsigned* st; };

__device__ __forceinline__ XcdBarrier xcd_barrier_post(unsigned* bar, volatile LAS unsigned* st) {
    XcdBarrier b; b.bar = bar; b.x = xb_xcc_id(); b.st = st;
    if (threadIdx.x == 0) (void)xb_add(&bar[XB_XCNT(b.x)], 1u);
    return b;
}
__device__ __forceinline__ void xcd_barrier_complete(unsigned* bar, unsigned x, unsigned& nloc, unsigned& nx) {
    const unsigned G = gridDim.x * gridDim.y * gridDim.z;
    unsigned sum, cnt, mine, sp = 0u;
    for (;;) {
        sum = 0u; cnt = 0u; mine = 0u;
#pragma unroll
        for (unsigned j = 0; j < 16; ++j) { const unsigned c = xb_ld(&bar[XB_XCNT(j)]); sum += c; cnt += (c > 0u) ? 1u : 0u; mine = (j == x) ? c : mine; }
        if (sum == G) break;
        __builtin_amdgcn_s_sleep(1);
        if ((++sp & 255u) == 0u) { if (xb_ld(&bar[XB_TMO])) break; if (sp > XB_SPIN_CAP) { atomicAdd(&bar[XB_TMO], 1u); break; } }
    }
    nloc = mine > 0u ? mine : 1u; nx = cnt > 0u ? cnt : 1u;
}
__device__ __forceinline__ void xcd_barrier(const XcdBarrier& b) {
    asm volatile("s_waitcnt vmcnt(0)" ::: "memory");
    __syncthreads();
    if (threadIdx.x == 0) {
        unsigned* bar = b.bar;
        __builtin_amdgcn_s_waitcnt(0);
        unsigned nloc = b.st[0], nx = b.st[1];
        if (nloc == 0u) { xcd_barrier_complete(bar, b.x, nloc, nx); b.st[0] = nloc; b.st[1] = nx; }
        const unsigned old = xb_add(&bar[XB_XSUB(b.x)], 1u);
        const unsigned gen = old / nloc;
        if (old + 1u == (gen + 1u) * nloc) {
            __builtin_amdgcn_fence(__ATOMIC_RELEASE, "agent");
            asm volatile("s_waitcnt vmcnt(0)" ::: "memory");
            const unsigned og = xb_add(&bar[XB_TOP], 1u);
            const unsigned tg = og / nx;
            if (og + 1u == (tg + 1u) * nx) xb_add(&bar[XB_TOPGEN], 1u);
            else XB_SPIN(xb_ld(&bar[XB_TOPGEN]) == tg, bar);
            __builtin_amdgcn_fence(__ATOMIC_ACQUIRE, "agent");
            xb_add(&bar[XB_XGEN(b.x)], 1u);
            asm volatile("s_waitcnt vmcnt(0)" ::: "memory");
        } else {
            XB_SPIN(xb_ld(&bar[XB_XGEN(b.x)]) == gen, bar);
            __builtin_amdgcn_fence(__ATOMIC_ACQUIRE, "agent");
            asm volatile("s_waitcnt vmcnt(0)" ::: "memory");
        }
    }
    __syncthreads();
}

struct Frame {
    LAS unsigned char* lds;
    volatile LAS unsigned* MISC;
    gu32* ctl;
    int tid, lane, wave;
    int vcu, G;
    unsigned char* ws;
};

__device__ __forceinline__ void p0_transpose_item(const float* W, int K, int N, bf16* WT, int dst_row0, const float* kscale, LAS float* scr, int k0, int n0, int lane) {
#pragma unroll 8
    for (int i = 0; i < 32; ++i) { const int kk = 2 * i + (lane >> 5); float v = W[(size_t)(k0 + kk) * N + n0 + (lane & 31)]; if (kscale) v *= kscale[k0 + kk]; scr[kk * 33 + (lane & 31)] = v; }
    LDS_WAIT(); asm volatile("" ::: "memory");
    const int c = lane & 7;
#pragma unroll
    for (int j = 0; j < 4; ++j) { const int n = (lane >> 3) + 8 * j; const LAS float* s = scr + (8 * c) * 33 + n;
        v4u o; o.x = pk2(s[0 * 33], s[1 * 33]); o.y = pk2(s[2 * 33], s[3 * 33]); o.z = pk2(s[4 * 33], s[5 * 33]); o.w = pk2(s[6 * 33], s[7 * 33]);
        *(GAS v4u*)(WT + (size_t)(dst_row0 + n) * K + k0 + 8 * c) = o; }
    LDS_WAIT(); asm volatile("" ::: "memory");
}
__device__ __forceinline__ int map_projB(int n0) {
    if (n0 < 2048) { const int t = n0 - 1536, hq = t >> 6, hf = (t >> 5) & 1; return 256 * (hq >> 2) + 128 * hf + 32 * (hq & 3); }
    if (n0 < 2176) { const int t = n0 - 2048, kh = t >> 6, hf = (t >> 5) & 1; return 512 + 128 * hf + 32 * kh; }
    if (n0 < 2304) { const int t = n0 - 2176, vh = t >> 6, hf = (t >> 5) & 1; return 512 + 128 * hf + 32 * (2 + vh); }
    return 768 + (n0 - 2304);
}
__device__ __forceinline__ void p0_row(const float* xrow, bf16* orow, float* rstd_out, int lane) {
    const GAS f32x4* xr = (const GAS f32x4*)xrow + lane;
    f32x4 v[4]; float s = 0.f;
#pragma unroll
    for (int j = 0; j < 4; ++j) { v[j] = xr[64 * j]; s += (v[j].x * v[j].x + v[j].y * v[j].y) + (v[j].z * v[j].z + v[j].w * v[j].w); }
    s = wave_sum(s);
    if (lane == 0) *rstd_out = 1.0f / sqrtf(s * (1.0f / DM) + RMS_EPS);
    GAS unsigned long long* o8 = (GAS unsigned long long*)orow + lane;
#pragma unroll
    for (int j = 0; j < 4; ++j) o8[64 * j] = (unsigned long long)pk2(v[j].x, v[j].y) | ((unsigned long long)pk2(v[j].z, v[j].w) << 32);
}
constexpr int FW_W1 = 0, FW_W2 = 33 * 64 * 4, FW_B1 = FW_W2 + 64 * 64 * 4, FW_B2 = FW_B1 + 256, FW_FR = FW_B2 + 256, FW_END = FW_FR + 256, FT_PITCH = 144, FT_BYTES = 32 * FT_PITCH;
__device__ __forceinline__ void filter_stage_weights(LAS unsigned char* lds, const float* w1, const float* b1, const float* w2, const float* b2, const float* fr, int tid) {
    LAS float* W1 = (LAS float*)(lds + FW_W1); LAS float* W2 = (LAS float*)(lds + FW_W2);
    for (int i = tid; i < 33 * 64; i += NWAVES * 64) W1[i] = w1[i];
    for (int i = tid; i < 64 * 64; i += NWAVES * 64) W2[i] = w2[i];
    if (tid < 64) { ((LAS float*)(lds + FW_B1))[tid] = b1[tid]; ((LAS float*)(lds + FW_B2))[tid] = b2[tid]; ((LAS float*)(lds + FW_FR))[tid] = fr[tid]; }
    LDS_WAIT(); __syncthreads();
}
__device__ __forceinline__ void filter_mlp_half(LAS unsigned char* lds, int L, int chunk, int hf, int dir, int r, int h, LAS float* Hb, bf16x8 (&afr)[4]) {
    const LAS float* W1 = (const LAS float*)(lds + FW_W1); const LAS float* W2 = (const LAS float*)(lds + FW_W2);
    const LAS float* B1 = (const LAS float*)(lds + FW_B1); const LAS float* B2 = (const LAS float*)(lds + FW_B2); const LAS float* FR = (const LAS float*)(lds + FW_FR);
        int pos = 64 * chunk + 32 * hf + r + dir; if (pos > L - 1) pos = L - 1;
        const float t = (float)pos / (float)(L - 1);
        float a[32];
#pragma unroll
        for (int jj = 0; jj < 32; ++jj) a[jj] = B1[32 * h + jj];
        {
#pragma unroll
            for (int jj = 0; jj < 32; jj += 4) { const f32x4 w = *(const LAS f32x4*)(W1 + 32 * h + jj); a[jj] += t * w[0]; a[jj + 1] += t * w[1]; a[jj + 2] += t * w[2]; a[jj + 3] += t * w[3]; }
#pragma unroll 1
            for (int i = 0; i < 16; ++i) {
                const float band = 1e-4f + (float)i * ((15.0f - 1e-4f) / 15.0f); const float ang = (6.283185307179586f / (float)L) * (float)pos * band;
                const float cv = __cosf(ang), sv = -__sinf(ang);
                const LAS float* wc = W1 + (1 + i) * 64 + 32 * h; const LAS float* wsn = W1 + (17 + i) * 64 + 32 * h;
#pragma unroll
                for (int jj = 0; jj < 32; jj += 4) { const f32x4 w = *(const LAS f32x4*)(wc + jj), v = *(const LAS f32x4*)(wsn + jj);
                    a[jj] += cv * w[0] + sv * v[0]; a[jj + 1] += cv * w[1] + sv * v[1]; a[jj + 2] += cv * w[2] + sv * v[2]; a[jj + 3] += cv * w[3] + sv * v[3]; }
            }
        }
#pragma unroll
        for (int jj = 0; jj < 32; ++jj) Hb[(32 * h + jj) * 32 + r] = __sinf(FR[32 * h + jj] * a[jj]);
        LDS_WAIT(); asm volatile("" ::: "memory");
#pragma unroll
        for (int jj = 0; jj < 32; ++jj) a[jj] = B2[32 * h + jj];
#pragma unroll 1
        for (int i = 0; i < 64; ++i) { const float hv = Hb[i * 32 + r]; const LAS float* wr_ = W2 + i * 64 + 32 * h;
#pragma unroll
            for (int jj = 0; jj < 32; jj += 4) { const f32x4 w = *(const LAS f32x4*)(wr_ + jj); a[jj] += hv * w[0]; a[jj + 1] += hv * w[1]; a[jj + 2] += hv * w[2]; a[jj + 3] += hv * w[3]; } }
        LDS_WAIT(); asm volatile("" ::: "memory");
        unsigned op[16], pp[16];
#pragma unroll
        for (int d = 0; d < 16; ++d) op[d] = pk2(__sinf(FR[32 * h + 2 * d] * a[2 * d]), __sinf(FR[32 * h + 2 * d + 1] * a[2 * d + 1]));
#pragma unroll
        for (int d = 0; d < 16; ++d) pp[d] = __shfl_xor(op[d], 32);
#pragma unroll
        for (int ks = 0; ks < 4; ++ks) { v4u f;
#pragma unroll
            for (int w = 0; w < 4; ++w) { const unsigned own = h ? op[8 * (ks & 1) + 4 + w] : op[8 * (ks & 1) + w], par = h ? pp[8 * (ks & 1) + 4 + w] : pp[8 * (ks & 1) + w];
                f[w] = ((ks >> 1) == h) ? own : par; }
            afr[ks] = __builtin_bit_cast(bf16x8, f); }
}
__device__ __forceinline__ void filter_item(LAS unsigned char* lds, const bf16* w3T, bf16* krev, float* fpart, int g, int chunk, int dir, int wave, int lane_) {
    int lane = lane_; asm volatile("" : "+v"(lane));
    const int L = g ? LS : LP, r = lane & 31, h = lane >> 5;
    const LAS float* W1 = (const LAS float*)(lds + FW_W1); const LAS float* W2 = (const LAS float*)(lds + FW_W2);
    const LAS float* B1 = (const LAS float*)(lds + FW_B1); const LAS float* B2 = (const LAS float*)(lds + FW_B2); const LAS float* FR = (const LAS float*)(lds + FW_FR);
    LAS unsigned char* T = lds + FW_END + wave * FT_BYTES; LAS float* Hb = (LAS float*)(lds + FW_END + NWAVES * FT_BYTES + wave * 8192);
    bf16x8 afr0[4], afr1[4];
    filter_mlp_half(lds, L, chunk, 0, dir, r, h, Hb, afr0);
    filter_mlp_half(lds, L, chunk, 1, dir, r, h, Hb, afr1);
    const float dmin = -4.605170185988091f / 1.5f, dmax = -4.605170185988091f / 0.3f;
    const int p0 = 64 * chunk; const int mstart = g ? (dir ? (2 * L - p0 - 64) : p0) : (dir ? (L + p0) : (L - 64 - p0));
    for (int ti = 0; ti < 32; ++ti) {
        const int o_ = ti >> 4, cb = 32 * (ti & 15), colg = (2 * o_ + dir) * 512 + cb;
        bf16x8 bfr[4];
#pragma unroll
        for (int ks = 0; ks < 4; ++ks) bfr[ks] = *(const GAS bf16x8*)(w3T + (size_t)(colg + r) * 64 + 16 * ks + 8 * h);
        const float delta = fabsf(dmin + (float)(cb + r) * ((dmax - dmin) / 511.0f));
        float asum = 0.f;
#pragma unroll
        for (int hf = 0; hf < 2; ++hf) {
            f32x16 acc = (f32x16){0.f,0.f,0.f,0.f,0.f,0.f,0.f,0.f,0.f,0.f,0.f,0.f,0.f,0.f,0.f,0.f};
#pragma unroll
            for (int ks = 0; ks < 4; ++ks) acc = __builtin_amdgcn_mfma_f32_32x32x16_bf16(hf ? afr1[ks] : afr0[ks], bfr[ks], acc, 0, 0, 0);
#pragma unroll
            for (int rg = 0; rg < 16; ++rg) {
                const int i = 32 * hf + (rg & 3) + 8 * (rg >> 2) + 4 * h; const int pos = p0 + i + dir;
                const float t = (float)pos / (float)(L - 1);
                float kv = acc[rg] * (__expf(-t * delta) + 0.05f); if (pos > L - 1) kv = 0.f;
                asum += fabsf(kv);
                const int e = ((dir != 0) != (g != 0)) ? i : 63 - i;
                *(LAS bf16*)(T + r * FT_PITCH + e * 2) = (bf16)f2bf(kv);
            }
        }
        asum += __shfl_xor(asum, 32);
        if (h == 0) fpart[(size_t)chunk * 2048 + colg + r] = asum;
        LDS_WAIT(); asm volatile("" ::: "memory");
        {
            const int col = lane >> 1, hb = lane & 1;
            bf16* dst = krev + (size_t)(o_ * 512 + cb + col) * (2 * L) + mstart + 32 * hb;
            const LAS v4u* src = (const LAS v4u*)(T + col * FT_PITCH + 64 * hb);
#pragma unroll
            for (int q = 0; q < 4; ++q) *(GAS v4u*)(dst + 8 * q) = src[q];
        }
        LDS_WAIT(); asm volatile("" ::: "memory");
    }
}

namespace hy {
constexpr int SLOTB = 272, Z_BYTES = 75776, F_OFF = 75776, F_BYTES = 65536, RED_OFF = F_OFF + F_BYTES;
__device__ __forceinline__ int slot_of(int g, int n) { return g ? (n + 31) : ((n >> 4) * 32 + 16 + (n & 15)); }
__device__ __forceinline__ int crow(int r, int hi) { return (r & 3) + 8 * (r >> 2) + 4 * hi; }

struct Params { const bf16* uT; const bf16* krev_s; const bf16* krev_p; const float* fpart_s; const float* fpart_p; const float* conv_w; const float* conv_b; const float* hbias; bf16* yT; float* dF; bf16* dZ; };

__device__ __forceinline__ void conv3_chunk(const bf16* urow  , int g, int chunk, float w0, float w1, float w2, float b, float (&out)[8]) {
    const int tau0 = chunk * 8; const int L = g ? LS : LP; const int p0 = g ? tau0 : (tau0 & (LP - 1));
    const v4u raw = *(const GAS v4u*)(urow + tau0);
    float u[10];
    u[1] = pg8::bflo(raw.x); u[2] = pg8::bfhi(raw.x); u[3] = pg8::bflo(raw.y); u[4] = pg8::bfhi(raw.y); u[5] = pg8::bflo(raw.z); u[6] = pg8::bfhi(raw.z); u[7] = pg8::bflo(raw.w); u[8] = pg8::bfhi(raw.w);
    u[0] = (p0 > 0) ? bf2f(urow[tau0 - 1]) : 0.f;
    u[9] = (p0 + 8 < L) ? bf2f(urow[tau0 + 8]) : 0.f;
#pragma unroll
    for (int i = 0; i < 8; ++i) out[i] = w0 * u[i] + w1 * u[i + 1] + w2 * u[i + 2] + b;
}

struct C3 { v4u raw; float prev, next; };
__device__ __forceinline__ void conv3_load(const bf16* urow, int g, int chunk, C3& q) {
    const int tau0 = chunk * 8; const int L = g ? LS : LP; const int p0 = g ? tau0 : (tau0 & (LP - 1));
    q.raw = *(const GAS v4u*)(urow + tau0);
    q.prev = (p0 > 0) ? bf2f(urow[tau0 - 1]) : 0.f;
    q.next = (p0 + 8 < L) ? bf2f(urow[tau0 + 8]) : 0.f;
}
__device__ __forceinline__ void conv3_eval(const C3& q, float w0, float w1, float w2, float b, float (&out)[8]) {
    float u[10];
    u[0] = q.prev; u[9] = q.next;
    u[1] = pg8::bflo(q.raw.x); u[2] = pg8::bfhi(q.raw.x); u[3] = pg8::bflo(q.raw.y); u[4] = pg8::bfhi(q.raw.y); u[5] = pg8::bflo(q.raw.z); u[6] = pg8::bfhi(q.raw.z); u[7] = pg8::bflo(q.raw.w); u[8] = pg8::bfhi(q.raw.w);
#pragma unroll
    for (int i = 0; i < 8; ++i) out[i] = w0 * u[i] + w1 * u[i + 1] + w2 * u[i + 2] + b;
}

__device__ __forceinline__ bf16x8 load_afrag(LAS const unsigned char* lds, int addr, int sh) {
    const LAS unsigned* p = (const LAS unsigned*)(lds + addr);
    const unsigned w0 = p[0], w1 = p[1], w2 = p[2], w3 = p[3], w4 = p[4];
    v4u f; f.x = __builtin_amdgcn_alignbit(w1, w0, sh); f.y = __builtin_amdgcn_alignbit(w2, w1, sh); f.z = __builtin_amdgcn_alignbit(w3, w2, sh); f.w = __builtin_amdgcn_alignbit(w4, w3, sh);
    return __builtin_bit_cast(bf16x8, f);
}

__device__ __forceinline__ void hyena_item(LAS unsigned char* lds, const Params& P, int g, int c, int tid_) {
    int tid = tid_; asm volatile("" : "+v"(tid));
    const int lane = tid & 63, wave = __builtin_amdgcn_readfirstlane(tid >> 6), r = lane & 31, hi = lane >> 5, nt = wave & 3, half = wave >> 2;
    const int L = g ? LS : LP; const int T0 = g ? TP : 0;
    float inv_norm0, inv_norm1;
    {
        const int nchunk = g ? 256 : 32; const float* fp = P.fpart_s + (g ? (size_t)0 : (size_t)((WS_FPART_P - WS_FPART_S) / 4));
        float s0 = 0.f, s1 = 0.f;
        for (int idx = lane; idx < nchunk * 2; idx += 64) { const int ch = idx >> 1, dir = idx & 1; s0 += fp[(size_t)ch * 2048 + dir * 512 + c]; s1 += fp[(size_t)ch * 2048 + 1024 + dir * 512 + c]; }
        inv_norm0 = 1.0f / wave_sum_sw(s0); inv_norm1 = 1.0f / wave_sum_sw(s1);
        for (int i = tid; i < Z_BYTES / 16; i += NWAVES * 64) *(LAS v4u*)(lds + i * 16) = (v4u){0u, 0u, 0u, 0u};
        LDS_WAIT(); __syncthreads();
    }
    {
        const int ch = 2 * HW + c; const float w0 = P.conv_w[ch], w1 = P.conv_w[3 * HW + ch], w2 = P.conv_w[6 * HW + ch], b = P.conv_b[ch];
        const bf16* urow = P.uT + (size_t)ch * MTOK + T0;
        for (int it = 0; it < 4; ++it) { const int chunk = tid + it * 512; float o[8]; conv3_chunk(urow, g, chunk, w0, w1, w2, b, o);
            const int tau0 = chunk * 8; v4u pk; pk.x = pk2(o[0], o[1]); pk.y = pk2(o[2], o[3]); pk.z = pk2(o[4], o[5]); pk.w = pk2(o[6], o[7]);
            *(LAS v4u*)(lds + slot_of(g, tau0 >> 7) * SLOTB + (tau0 & 127) * 2) = pk; }
    }
    int d_hi, d_lo;
    if (g) { if (half == 0) { d_hi = 32 * nt + 31; d_lo = 32 * nt - 48; } else { d_hi = 32 * nt - 49; d_lo = 32 * nt - 127; } }
    else   { if (half == 0) { d_hi = 15; d_lo = 0; } else { d_hi = -1; d_lo = -15; } }
    int abase = F_OFF + 2 * ((L - 1) - r + 8 * hi); const int sh = (abase & 2) ? 16 : 0; abase &= ~3;
    const int zb = slot_of(g, 32 * nt + r) * SLOTB + 16 * hi;
    const int mi0 = 2 * half;

    for (int o = 0; o < 2; ++o) {
        {
            const bf16* ksrc = P.krev_s + (g ? (size_t)0 : (size_t)((WS_KREV_P - WS_KREV_S) / 2)) + (size_t)(o * HW + c) * (2 * L);
            const int n16 = (2 * L * 2) / 16;
            for (int i = tid; i < n16; i += NWAVES * 64) *(LAS v4u*)(lds + F_OFF + i * 16) = *(const GAS v4u*)(ksrc + i * 8);
        }
        LDS_WAIT(); __syncthreads();
        f32x16 acc[4];
#pragma unroll
        for (int mi = 0; mi < 4; ++mi) acc[mi] = (f32x16){0.f,0.f,0.f,0.f,0.f,0.f,0.f,0.f,0.f,0.f,0.f,0.f,0.f,0.f,0.f,0.f};
        bf16x8 Fw[8];
        {
            const int q0 = -8 * d_hi;
#pragma unroll
            for (int s = 2; s < 8; ++s) Fw[s] = load_afrag(lds, abase + 32 * (q0 - 8 + s), sh);
            Fw[0] = Fw[2]; Fw[1] = Fw[3];
        }
        {
            unsigned ap = (unsigned)(uintptr_t)(lds + abase) + 32 * (-8 * d_hi), bp = (unsigned)(uintptr_t)(lds + zb) - d_hi * SLOTB;
            v2u n01, n23; unsigned n4; v4u zn;
            unsigned r0, r1, r2, r3, r4; v4u zf;
#define HY_LOADS(ADW, BOFF) asm volatile("ds_read2_b32 %0, %4 offset0:%c5 offset1:%c6\n\tds_read2_b32 %1, %4 offset0:%c7 offset1:%c8\n\tds_read_b32 %2, %4 offset:%c9\n\tds_read_b128 %3, %10 offset:%c11" \
                : "=&v"(n01), "=&v"(n23), "=&v"(n4), "=&v"(zn) : "v"(ap), "i"(ADW), "i"((ADW) + 1), "i"((ADW) + 2), "i"((ADW) + 3), "i"(((ADW) + 4) * 4), "v"(bp), "i"(BOFF))
#define HY_WAIT() do { asm volatile("s_waitcnt lgkmcnt(0)" : "+v"(n01), "+v"(n23), "+v"(n4), "+v"(zn), "+v"(acc[0]), "+v"(acc[1]), "+v"(acc[2]), "+v"(acc[3])); __builtin_amdgcn_sched_barrier(0); } while (0)
#define HY_TAKE() do { r0 = n01.x; r1 = n01.y; r2 = n23.x; r3 = n23.y; r4 = n4; zf = zn; } while (0)
#define HY_STEP(JK, ADW, BOFF) do { HY_LOADS(ADW, BOFF); __builtin_amdgcn_sched_barrier(0); \
                { v4u f; f.x = __builtin_amdgcn_alignbit(r1, r0, sh); f.y = __builtin_amdgcn_alignbit(r2, r1, sh); f.z = __builtin_amdgcn_alignbit(r3, r2, sh); f.w = __builtin_amdgcn_alignbit(r4, r3, sh); Fw[JK] = __builtin_bit_cast(bf16x8, f); } \
                { const bf16x8 zb_ = __builtin_bit_cast(bf16x8, zf); \
                  acc[0] = __builtin_amdgcn_mfma_f32_32x32x16_bf16(Fw[(JK) & 7], zb_, acc[0], 0, 0, 0); acc[1] = __builtin_amdgcn_mfma_f32_32x32x16_bf16(Fw[((JK) - 2) & 7], zb_, acc[1], 0, 0, 0); \
                  acc[2] = __builtin_amdgcn_mfma_f32_32x32x16_bf16(Fw[((JK) - 4) & 7], zb_, acc[2], 0, 0, 0); acc[3] = __builtin_amdgcn_mfma_f32_32x32x16_bf16(Fw[((JK) - 6) & 7], zb_, acc[3], 0, 0, 0); } \
                HY_WAIT(); HY_TAKE(); } while (0)
            HY_LOADS(0, 0); HY_WAIT(); HY_TAKE();
            for (int d = d_hi; d >= d_lo; --d) {
                HY_STEP(0, 8, 32); HY_STEP(1, 16, 64); HY_STEP(2, 24, 96); HY_STEP(3, 32, 128); HY_STEP(4, 40, 160); HY_STEP(5, 48, 192); HY_STEP(6, 56, 224); HY_STEP(7, 64, SLOTB);
                ap += 256; bp += SLOTB;
            }
#undef HY_LOADS
#undef HY_WAIT
#undef HY_TAKE
#undef HY_STEP
        }
        LDS_WAIT(); __syncthreads();
        {
            LAS float* X = (LAS float*)(lds + F_OFF) + wave * 2048;
#pragma unroll
            for (int t = 0; t < 2; ++t)
#pragma unroll
                for (int rg = 0; rg < 16; ++rg) X[(t * 16 + rg) * 64 + lane] = (half == 0) ? acc[2 + t][rg] : acc[t][rg];
        }
        LDS_WAIT(); __syncthreads();
        f32x16 fin[2];
        {
            const LAS float* X = (const LAS float*)(lds + F_OFF) + (wave ^ 4) * 2048;
#pragma unroll
            for (int t = 0; t < 2; ++t)
#pragma unroll
                for (int rg = 0; rg < 16; ++rg) fin[t][rg] = ((half == 0) ? acc[t][rg] : acc[2 + t][rg]) + X[(t * 16 + rg) * 64 + lane];
        }
        LDS_WAIT(); __syncthreads();
        {
            const int ch = o * HW + c; const float w0 = P.conv_w[ch], w1 = P.conv_w[3 * HW + ch], w2 = P.conv_w[6 * HW + ch], b = P.conv_b[ch];
            const bf16* urow = P.uT + (size_t)ch * MTOK + T0;
            for (int it = 0; it < 4; ++it) { const int chunk = tid + it * 512; float v[8]; conv3_chunk(urow, g, chunk, w0, w1, w2, b, v);
                LAS f32x4* dst = (LAS f32x4*)(lds + F_OFF + chunk * 32); dst[0] = (f32x4){v[0], v[1], v[2], v[3]}; dst[1] = (f32x4){v[4], v[5], v[6], v[7]}; }
        }
        LDS_WAIT(); __syncthreads();
        {
            const float sb = P.hbias[o * HW + c], inr = o ? inv_norm1 : inv_norm0;
            const LAS float* G = (const LAS float*)(lds + F_OFF);
            const int n = 32 * nt + r; LAS bf16* zs = (LAS bf16*)(lds + slot_of(g, n) * SLOTB);
#pragma unroll
            for (int t = 0; t < 2; ++t)
#pragma unroll
                for (int rg = 0; rg < 16; ++rg) { const int i = 32 * (mi0 + t) + crow(rg, hi);
                    const float zo = bf2f(zs[i]);
#if PROBE >= 100
                    if (c == 137) { P.dF[(g * 2 + o) * 16384 + 128 * n + i] = fin[t][rg]; P.dZ[(g * 2 + o) * 16384 + 128 * n + i] = zs[i]; }
#endif
                    const float val = G[128 * n + i] * (inr * fin[t][rg] + sb * zo); zs[i] = (bf16)f2bf(val); }
        }
        LDS_WAIT(); __syncthreads();
    }
    {
        bf16* yrow = P.yT + (size_t)c * MTOK + T0;
        for (int it = 0; it < 4; ++it) { const int chunk = tid + it * 512, tau0 = chunk * 8;
            *(GAS v4u*)(yrow + tau0) = *(const LAS v4u*)(lds + slot_of(g, tau0 >> 7) * SLOTB + (tau0 & 127) * 2); }
    }
    LDS_WAIT(); __syncthreads();
}
}

namespace fc {
constexpr int OST = 1032, PLANE_B = 32 * OST * 2  , RE_OFF = 0, IM_OFF = PLANE_B, RED_OFF = 2 * PLANE_B, T3_OFF = RED_OFF + 64;
constexpr int NFFT = 32768;
enum { F1 = 0, F2 = 1, F3 = 2, I1 = 3, I2 = 4, I3 = 5 };
__device__ __forceinline__ int crow(int r, int hi) { return (r & 3) + 8 * (r >> 2) + 4 * hi; }
__device__ __forceinline__ int sw(int mid) { return 0; }
struct Params { const bf16* uT; const bf16* kc; const float* fpart_s; const float* conv_w; const float* conv_b; const float* hbias; bf16* yT; bf16* hs; bf16* z1s; float* dF; bf16* dZ; };
typedef float f32x2_ __attribute__((ext_vector_type(2)));
struct FMat { bf16x8 fr[2], fi[2], nfi[2]; };

__device__ __forceinline__ void make_fmat(FMat& M, int r, int h) {
#pragma unroll
    for (int ks = 0; ks < 2; ++ks) { v4u a, b, c;
#pragma unroll
        for (int w = 0; w < 4; ++w) { float cv[2], sv[2];
#pragma unroll
            for (int e = 0; e < 2; ++e) { const int aidx = 16 * ks + 8 * h + 2 * w + e; const float fr_ = (float)((aidx * r) & 31) * (1.0f / 32.0f); cv[e] = __builtin_amdgcn_cosf(fr_); sv[e] = __builtin_amdgcn_sinf(fr_); }
            a[w] = pk2(cv[0], cv[1]); b[w] = pk2(-sv[0], -sv[1]); c[w] = pk2(sv[0], sv[1]); }
        M.fr[ks] = __builtin_bit_cast(bf16x8, a); M.fi[ks] = __builtin_bit_cast(bf16x8, b); M.nfi[ks] = __builtin_bit_cast(bf16x8, c); }
}

template <int ST, bool REAL_IN, bool HALF_K>
__device__ __forceinline__ void stage(LAS unsigned char* lds, const FMat& M, int wave, int r_, int h_) {
    int r = r_, h = h_; asm volatile("" : "+v"(r), "+v"(h));
    float t2c[16], t2s[16];
    if (ST == F1 || ST == F2 || ST == I1 || ST == I2) {
#pragma unroll
        for (int rg = 0; rg < 16; ++rg) { const int rho = (rg & 3) + 8 * (rg >> 2) + 4 * h; const float fr_ = (float)(r * rho) * (1.0f / 1024.0f); t2c[rg] = __builtin_amdgcn_cosf(fr_); t2s[rg] = __builtin_amdgcn_sinf(fr_); }
    }
    constexpr bool INV = (ST >= I1);
    const f32x16 zero16 = (f32x16){0.f,0.f,0.f,0.f,0.f,0.f,0.f,0.f,0.f,0.f,0.f,0.f,0.f,0.f,0.f,0.f};
    unsigned res[4][16];
#pragma unroll
    for (int t = 0; t < 4; ++t) {
        const int f = 4 * wave + t;
        const int base = (ST == I2) ? (32 * f + OST * r) : (32 * r + OST * f); const int swr = (ST == I2) ? sw(f) : sw(r);
        f32x16 ur = zero16, ui = zero16;
#pragma unroll
        for (int ks = 0; ks < (HALF_K ? 1 : 2); ++ks) {
            const bf16x8 xr = *(const LAS bf16x8*)(lds + RE_OFF + 2 * (base + ((16 * ks + 8 * h) ^ swr)));
            if (!INV) {
                ur = __builtin_amdgcn_mfma_f32_32x32x16_bf16(M.fr[ks], xr, ur, 0, 0, 0);
                ui = __builtin_amdgcn_mfma_f32_32x32x16_bf16(M.fi[ks], xr, ui, 0, 0, 0);
                if (!REAL_IN) { const bf16x8 xi = *(const LAS bf16x8*)(lds + IM_OFF + 2 * (base + ((16 * ks + 8 * h) ^ swr)));
                    ur = __builtin_amdgcn_mfma_f32_32x32x16_bf16(M.nfi[ks], xi, ur, 0, 0, 0);
                    ui = __builtin_amdgcn_mfma_f32_32x32x16_bf16(M.fr[ks], xi, ui, 0, 0, 0); }
            } else {
                const bf16x8 xi = *(const LAS bf16x8*)(lds + IM_OFF + 2 * (base + ((16 * ks + 8 * h) ^ swr)));
                ur = __builtin_amdgcn_mfma_f32_32x32x16_bf16(M.fr[ks], xr, ur, 0, 0, 0);
                ur = __builtin_amdgcn_mfma_f32_32x32x16_bf16(M.fi[ks], xi, ur, 0, 0, 0);
                if (ST != I3) { ui = __builtin_amdgcn_mfma_f32_32x32x16_bf16(M.fr[ks], xi, ui, 0, 0, 0);
                                ui = __builtin_amdgcn_mfma_f32_32x32x16_bf16(M.nfi[ks], xr, ui, 0, 0, 0); }
            }
        }
        if (ST == I3) {
#pragma unroll
            for (int rg = 0; rg < 8; ++rg) res[t][rg] = __float_as_uint(ur[rg]);
        } else {
            if (ST == F1 || ST == F2 || ST == I1 || ST == I2) {
                float uc = 1.f, us = 0.f;
                if (ST == I2) { const float fr_ = (float)(f * r) * (1.0f / 32768.0f); uc = __builtin_amdgcn_cosf(fr_); us = __builtin_amdgcn_sinf(fr_); }
#pragma unroll
                for (int rg = 0; rg < 16; ++rg) {
                    float c = t2c[rg], s_ = t2s[rg];
                    if (ST == F1) { const int rho = (rg & 3) + 8 * (rg >> 2) + 4 * h; const f32x2_ q = *(const LAS f32x2_*)(lds + T3_OFF + 8 * (32 * f + rho)); const float c2 = c * q.x - s_ * q.y; s_ = c * q.y + s_ * q.x; c = c2; }
                    if (ST == I2) { const float c2 = c * uc - s_ * us; s_ = c * us + s_ * uc; c = c2; }
                    const float s = INV ? s_ : -s_;
                    const float a = ur[rg], b = ui[rg];
                    ur[rg] = a * c - b * s; ui[rg] = a * s + b * c;
                }
            }
#pragma unroll
            for (int p = 0; p < 8; ++p) { res[t][p] = pk2(ur[2 * p], ur[2 * p + 1]); res[t][8 + p] = pk2(ui[2 * p], ui[2 * p + 1]); }
        }
        __builtin_amdgcn_sched_barrier(0);
    }
    LDS_WAIT(); __syncthreads();
#pragma unroll
    for (int t = 0; t < 4; ++t) {
        const int f = 4 * wave + t;
        if (ST == I3) {
            LAS float* Y = (LAS float*)(lds + IM_OFF);
#pragma unroll
            for (int rg = 0; rg < 8; ++rg) { const int rho = (rg & 3) + 8 * (rg >> 2) + 4 * h; Y[516 * f + 32 * rho + r] = __uint_as_float(res[t][rg]); }
        } else if (ST == F3) {
#pragma unroll
            for (int g4 = 0; g4 < 4; ++g4) { const int pos = ((8 * g4 + 4 * h) ^ sw(r)) + 32 * r + OST * f;
                *(LAS v2u*)(lds + RE_OFF + 2 * pos) = (v2u){res[t][2 * g4], res[t][2 * g4 + 1]}; *(LAS v2u*)(lds + IM_OFF + 2 * pos) = (v2u){res[t][8 + 2 * g4], res[t][8 + 2 * g4 + 1]}; }
        } else {
            const int odd = r & 1; const unsigned sel = odd ? 0x03020706u : 0x05040100u;
            const int rs_ = (ST == F1) ? OST : 32;
            const int lb = ((r & ~1) + odd * rs_ + ((ST == F1) ? 32 * f : OST * f) + rs_ * 4 * h) * 2;
#pragma unroll
            for (int p = 0; p < 8; ++p) {
                const int rho0 = ((2 * p) & 3) + 8 * ((2 * p) >> 2);
                const unsigned wr_ = res[t][p], wi_ = res[t][8 + p];
                const unsigned vr_ = (unsigned)__builtin_amdgcn_mov_dpp((int)wr_, 0xB1, 0xF, 0xF, true), vi_ = (unsigned)__builtin_amdgcn_mov_dpp((int)wi_, 0xB1, 0xF, 0xF, true);
                *(LAS unsigned*)(lds + RE_OFF + lb + 2 * rs_ * rho0) = __builtin_amdgcn_perm(vr_, wr_, sel);
                *(LAS unsigned*)(lds + IM_OFF + lb + 2 * rs_ * rho0) = __builtin_amdgcn_perm(vi_, wi_, sel);
            }
        }
    }
    LDS_WAIT(); __syncthreads();
}

__device__ __forceinline__ void self_visible(int tid) {
    VM_WAIT(); __syncthreads();
    if (tid == 0) { __builtin_amdgcn_fence(__ATOMIC_ACQUIRE, "agent"); VM_WAIT(); }
    __syncthreads();
}

__device__ __forceinline__ void item(LAS unsigned char* lds, const Params& P, int c, int tid_, int slot) {
    int tid = tid_; asm volatile("" : "+v"(tid));
    const int wave = __builtin_amdgcn_readfirstlane(tid >> 6);
    constexpr int L = LS, T0 = TP, g = 1;
    bf16* hs = P.hs + (size_t)slot * (2 * PLANE_B / 2); bf16* z1s = P.z1s + (size_t)slot * L;
    float inv_norm0, inv_norm1;
    {
        const int lane = tid & 63; float s0 = 0.f, s1 = 0.f;
        for (int idx = lane; idx < 512; idx += 64) { const int ch = idx >> 1, dir = idx & 1; s0 += P.fpart_s[(size_t)ch * 2048 + dir * 512 + c]; s1 += P.fpart_s[(size_t)ch * 2048 + 1024 + dir * 512 + c]; }
        inv_norm0 = 1.0f / wave_sum_sw(s0); inv_norm1 = 1.0f / wave_sum_sw(s1);
    }
    FMat M; { const int r = tid & 31, h = (tid >> 5) & 1; make_fmat(M, r, h); }
    for (int i = tid; i < 1024; i += NWAVES * 64) { const float fr_ = (float)((i >> 5) * (i & 31)) * (1.0f / 32768.0f); *(LAS f32x2_*)(lds + T3_OFF + 8 * i) = (f32x2_){__builtin_amdgcn_cosf(fr_), __builtin_amdgcn_sinf(fr_)}; }
    LDS_WAIT(); __syncthreads();
#if PROBE >= 31 && PROBE <= 35
    unsigned long long tp_ = __builtin_amdgcn_s_memrealtime();
#define FC_SEC(k) do { const unsigned long long tn_ = __builtin_amdgcn_s_memrealtime(); if (blockIdx.x == 0 && tid == 0) ((volatile LAS unsigned*)(lds + MISC_OFF))[40 + (k)] += (unsigned)(tn_ - tp_); tp_ = tn_; } while (0)
#else
#define FC_SEC(k) do { } while (0)
#endif
    for (int o = 0; o < 2; ++o) {
        asm volatile("" : "+v"(tid));
        const int lane = tid & 63, r = lane & 31, h = lane >> 5;
        FC_SEC(5);
        {
            const bf16* ksrc = P.kc + (size_t)(o * HW + c) * NFFT;
            v4u raw[8];
#pragma unroll
            for (int i = 0; i < 8; ++i) { const int it = 8 * wave + i, n = 1024 * (lane & 31) + 32 * (2 * (it >> 2) + (lane >> 5)) + 8 * (it & 3); raw[i] = *(const GAS v4u*)(ksrc + n); }
#pragma unroll
            for (int i = 0; i < 8; ++i) { const int it = 8 * wave + i, n = 1024 * (lane & 31) + 32 * (2 * (it >> 2) + (lane >> 5)) + 8 * (it & 3);
                const int pos0 = ((n >> 10) ^ sw((n >> 5) & 31)) + 32 * ((n >> 5) & 31) + OST * (n & 31); LAS bf16* d = (LAS bf16*)(lds + RE_OFF) + pos0;
                d[0 * OST] = (bf16)(raw[i].x & 0xffffu); d[1 * OST] = (bf16)(raw[i].x >> 16); d[2 * OST] = (bf16)(raw[i].y & 0xffffu); d[3 * OST] = (bf16)(raw[i].y >> 16);
                d[4 * OST] = (bf16)(raw[i].z & 0xffffu); d[5 * OST] = (bf16)(raw[i].z >> 16); d[6 * OST] = (bf16)(raw[i].w & 0xffffu); d[7 * OST] = (bf16)(raw[i].w >> 16); }
        }
        LDS_WAIT(); __syncthreads();
        stage<F1, true, false>(lds, M, wave, r, h); stage<F2, false, false>(lds, M, wave, r, h); stage<F3, false, false>(lds, M, wave, r, h);
        for (int i = tid; i < 2 * PLANE_B / 16; i += NWAVES * 64) *(GAS v4u*)((unsigned char*)hs + (size_t)i * 16) = *(const LAS v4u*)(lds + i * 16);
        self_visible(tid);
        FC_SEC(0);
        {
            const int ch = 2 * HW + c; const float w0 = P.conv_w[ch], w1 = P.conv_w[3 * HW + ch], w2 = P.conv_w[6 * HW + ch], b = P.conv_b[ch];
            const bf16* urow = P.uT + (size_t)ch * MTOK + T0;
            hy::C3 q3[4]; v4u rz[4];
#pragma unroll
            for (int i = 0; i < 4; ++i) { const int it = 4 * wave + i, n = 1024 * (lane & 15) + 32 * (4 * (it >> 2) + (lane >> 4)) + 8 * (it & 3);
                if (o == 0) hy::conv3_load(urow, g, n >> 3, q3[i]); else rz[i] = *(const GAS v4u*)(z1s + n); }
#pragma unroll
            for (int i = 0; i < 4; ++i) { const int it = 4 * wave + i, n = 1024 * (lane & 15) + 32 * (4 * (it >> 2) + (lane >> 4)) + 8 * (it & 3); unsigned e[4];
                if (o == 0) { float v[8]; hy::conv3_eval(q3[i], w0, w1, w2, b, v); e[0] = pk2(v[0], v[1]); e[1] = pk2(v[2], v[3]); e[2] = pk2(v[4], v[5]); e[3] = pk2(v[6], v[7]); }
                else { e[0] = rz[i].x; e[1] = rz[i].y; e[2] = rz[i].z; e[3] = rz[i].w; }
                const int pos0 = ((n >> 10) ^ sw((n >> 5) & 31)) + 32 * ((n >> 5) & 31) + OST * (n & 31); LAS bf16* d = (LAS bf16*)(lds + RE_OFF) + pos0;
#pragma unroll
                for (int j = 0; j < 4; ++j) { d[(2 * j) * OST] = (bf16)(e[j] & 0xffffu); d[(2 * j + 1) * OST] = (bf16)(e[j] >> 16); } }
        }
        LDS_WAIT(); __syncthreads();
        stage<F1, true, true>(lds, M, wave, r, h); stage<F2, false, false>(lds, M, wave, r, h); stage<F3, false, false>(lds, M, wave, r, h);
        FC_SEC(1);
        {
            constexpr int NCH = PLANE_B / 16, NIT = (NCH + NWAVES * 64 - 1) / (NWAVES * 64);
#pragma unroll 1
            for (int kb = 0; kb < NIT; kb += 3) {
                v4u hr[3], hi_[3];
#pragma unroll
                for (int k = 0; k < 3; ++k) { const int i = tid + (kb + k) * NWAVES * 64; if (i < NCH) { hr[k] = *(const GAS v4u*)((const unsigned char*)hs + (size_t)i * 16); hi_[k] = *(const GAS v4u*)((const unsigned char*)hs + PLANE_B + (size_t)i * 16); } }
#pragma unroll
                for (int k = 0; k < 3; ++k) { const int i = tid + (kb + k) * NWAVES * 64; if (i < NCH) {
                    const v4u xr = *(const LAS v4u*)(lds + RE_OFF + i * 16), xi = *(const LAS v4u*)(lds + IM_OFF + i * 16);
                    v4u vr, vi;
#pragma unroll
                    for (int w = 0; w < 4; ++w) {
                        const float a0 = pg8::bflo(xr[w]), a1 = pg8::bfhi(xr[w]), b0 = pg8::bflo(xi[w]), b1 = pg8::bfhi(xi[w]);
                        const float c0 = pg8::bflo(hr[k][w]) * (1.0f / 32768.0f), c1 = pg8::bfhi(hr[k][w]) * (1.0f / 32768.0f), d0 = pg8::bflo(hi_[k][w]) * (1.0f / 32768.0f), d1 = pg8::bfhi(hi_[k][w]) * (1.0f / 32768.0f);
                        vr[w] = pk2(a0 * c0 - b0 * d0, a1 * c1 - b1 * d1); vi[w] = pk2(a0 * d0 + b0 * c0, a1 * d1 + b1 * c1);
                    }
                    *(LAS v4u*)(lds + RE_OFF + i * 16) = vr; *(LAS v4u*)(lds + IM_OFF + i * 16) = vi; } }
            }
        }
        LDS_WAIT(); __syncthreads();
        FC_SEC(2);
        stage<I1, false, false>(lds, M, wave, r, h); stage<I2, false, false>(lds, M, wave, r, h); stage<I3, false, false>(lds, M, wave, r, h);
        FC_SEC(3);
        {
            const LAS float* Y = (const LAS float*)(lds + IM_OFF);
            const int chg = o * HW + c; const float g0 = P.conv_w[chg], g1 = P.conv_w[3 * HW + chg], g2 = P.conv_w[6 * HW + chg], gb = P.conv_b[chg];
            const int chv = 2 * HW + c; const float v0 = P.conv_w[chv], v1 = P.conv_w[3 * HW + chv], v2 = P.conv_w[6 * HW + chv], vb = P.conv_b[chv];
            const bf16* grow = P.uT + (size_t)chg * MTOK + T0; const bf16* vrow = P.uT + (size_t)chv * MTOK + T0;
            const float sb = P.hbias[o * HW + c], inr = o ? inv_norm1 : inv_norm0;
            bf16* dst = o ? (P.yT + (size_t)c * MTOK + T0) : z1s;
#pragma unroll 1
            for (int ib = 0; ib < 4; ib += 2) {
            hy::C3 qg[2], qv[2]; v4u rz[2];
#pragma unroll
            for (int it = 0; it < 2; ++it) { const int chunk = tid + (ib + it) * 512; hy::conv3_load(grow, g, chunk, qg[it]); if (o == 0) hy::conv3_load(vrow, g, chunk, qv[it]); else rz[it] = *(const GAS v4u*)(z1s + chunk * 8); }
#pragma unroll
            for (int it = 0; it < 2; ++it) { const int chunk = tid + (ib + it) * 512, n = chunk * 8; float gt[8], zo[8];
                hy::conv3_eval(qg[it], g0, g1, g2, gb, gt);
                if (o == 0) { hy::conv3_eval(qv[it], v0, v1, v2, vb, zo);
#pragma unroll
                    for (int j = 0; j < 8; ++j) zo[j] = bf2f((unsigned short)f2bf(zo[j])); }
                else { const v4u raw = rz[it]; zo[0] = pg8::bflo(raw.x); zo[1] = pg8::bfhi(raw.x); zo[2] = pg8::bflo(raw.y); zo[3] = pg8::bfhi(raw.y); zo[4] = pg8::bflo(raw.z); zo[5] = pg8::bfhi(raw.z); zo[6] = pg8::bflo(raw.w); zo[7] = pg8::bfhi(raw.w); }
                const LAS float* yp = Y + 516 * (n & 31) + (n >> 5); const f32x4 y0 = (f32x4){yp[0], yp[516], yp[2 * 516], yp[3 * 516]}, y1 = (f32x4){yp[4 * 516], yp[5 * 516], yp[6 * 516], yp[7 * 516]};
                float val[8];
#pragma unroll
                for (int j = 0; j < 8; ++j) { const float yv = (j < 4) ? y0[j & 3] : y1[j & 3];
#if PROBE >= 100
                    if (c == 137) { P.dF[(2 + o) * 16384 + n + j] = yv; P.dZ[(2 + o) * 16384 + n + j] = (bf16)f2bf(zo[j]); }
#endif
                    val[j] = gt[j] * (inr * yv + sb * zo[j]); }
                v4u pk; pk.x = pk2(val[0], val[1]); pk.y = pk2(val[2], val[3]); pk.z = pk2(val[4], val[5]); pk.w = pk2(val[6], val[7]);
                *(GAS v4u*)(dst + n) = pk; }
            }
        }
        self_visible(tid);
        FC_SEC(4);
    }
#undef FC_SEC
}
}

namespace at {
constexpr int KROW = 144, VROW = 776, K_OFF = 0, V_OFF = 384 * KROW  , END_OFF = V_OFF + 64 * VROW;
__device__ __forceinline__ int crow(int r, int hi) { return (r & 3) + 8 * (r >> 2) + 4 * hi; }
struct Params { const bf16* q; const bf16* k; const bf16* v; const float* sink; bf16* yat; };

__device__ __forceinline__ void attn_item(LAS unsigned char* lds, const Params& P, int blk, int gk, int tid_) {
    int tid = tid_; asm volatile("" : "+v"(tid));
    const int lane = tid & 63, wave = __builtin_amdgcn_readfirstlane(tid >> 6), r = lane & 31, hi = lane >> 5;
    const int m0 = blk * 128; const int s_lo = (blk < 128) ? (m0 & ~(LP - 1)) : TP, s_hi = (blk < 128) ? s_lo + LP : MTOK; const int kw0 = m0 - 128;
    for (int it = 0; it < 6; ++it) {
        const int idx = tid + it * 512, key = idx >> 3, chn = idx & 7, tok = kw0 + key; const bool ok = (tok >= s_lo) && (tok < s_hi);
        v4u kv = (v4u){0u, 0u, 0u, 0u}, vv = (v4u){0u, 0u, 0u, 0u};
        if (ok) { kv = *(const GAS v4u*)(P.k + (size_t)tok * 128 + gk * 64 + chn * 8); vv = *(const GAS v4u*)(P.v + (size_t)tok * 128 + gk * 64 + chn * 8); }
        *(LAS v4u*)(lds + K_OFF + key * KROW + chn * 16) = kv;
        LAS bf16* vt = (LAS bf16*)(lds + V_OFF + (chn * 8) * VROW + key * 2);
        vt[0 * (VROW / 2)] = (bf16)(vv.x & 0xffffu); vt[1 * (VROW / 2)] = (bf16)(vv.x >> 16); vt[2 * (VROW / 2)] = (bf16)(vv.y & 0xffffu); vt[3 * (VROW / 2)] = (bf16)(vv.y >> 16);
        vt[4 * (VROW / 2)] = (bf16)(vv.z & 0xffffu); vt[5 * (VROW / 2)] = (bf16)(vv.z >> 16); vt[6 * (VROW / 2)] = (bf16)(vv.w & 0xffffu); vt[7 * (VROW / 2)] = (bf16)(vv.w >> 16);
    }
    LDS_WAIT(); __syncthreads();
    const int hq = 4 * gk + (wave & 3), qh = wave >> 2;
    const int klo = (s_lo - kw0) > 0 ? (s_lo - kw0) : 0, khi = (s_hi - kw0) < 384 ? (s_hi - kw0) : 384;
    const float sinkl = P.sink[hq] * 1.4426950408889634f;
    for (int qq = 0; qq < 2; ++qq) {
        const int qt = 2 * qh + qq, q0 = 32 * qt; const size_t qrow = (size_t)(m0 + q0 + r);
        bf16x8 qf[4];
#pragma unroll
        for (int ks = 0; ks < 4; ++ks) qf[ks] = *(const GAS bf16x8*)(P.q + qrow * 512 + hq * 64 + 16 * ks + 8 * hi);
        float m_run = sinkl, l_run = (hi == 0) ? 1.0f : 0.0f;
        f32x16 o0 = (f32x16){0.f,0.f,0.f,0.f,0.f,0.f,0.f,0.f,0.f,0.f,0.f,0.f,0.f,0.f,0.f,0.f}, o1 = o0;
        const int lo_r = (q0 + r) > klo ? (q0 + r) : klo, hi_r = (q0 + r + 256) < (khi - 1) ? (q0 + r + 256) : (khi - 1);
        for (int kt = qt; kt <= qt + 8; ++kt) {
            const int kb = 32 * kt;
            f32x16 s = (f32x16){0.f,0.f,0.f,0.f,0.f,0.f,0.f,0.f,0.f,0.f,0.f,0.f,0.f,0.f,0.f,0.f};
#pragma unroll
            for (int ks = 0; ks < 4; ++ks) { const bf16x8 kf = *(const LAS bf16x8*)(lds + K_OFF + (kb + r) * KROW + 32 * ks + 16 * hi);
                s = __builtin_amdgcn_mfma_f32_32x32x16_bf16(kf, qf[ks], s, 0, 0, 0); }
            float tmax = -1e30f;
#pragma unroll
            for (int rg = 0; rg < 16; ++rg) { const int kj = kb + crow(rg, hi); const float sv = (kj >= lo_r && kj <= hi_r) ? s[rg] : -1e30f; s[rg] = sv; tmax = fmaxf(tmax, sv); }
            tmax = fmaxf(tmax, __shfl_xor(tmax, 32));
            const float mnew = fmaxf(m_run, tmax); const float alpha = __builtin_amdgcn_exp2f(m_run - mnew); m_run = mnew;
            float psum = 0.f;
#pragma unroll
            for (int rg = 0; rg < 16; ++rg) { const float p = __builtin_amdgcn_exp2f(s[rg] - mnew); s[rg] = p; psum += p; }
            l_run = l_run * alpha + psum;
#pragma unroll
            for (int rg = 0; rg < 16; ++rg) { o0[rg] *= alpha; o1[rg] *= alpha; }
            v4u pa, pb;
            pa.x = pk2(s[0], s[1]); pa.y = pk2(s[2], s[3]); pa.z = pk2(s[4], s[5]); pa.w = pk2(s[6], s[7]);
            pb.x = pk2(s[8], s[9]); pb.y = pk2(s[10], s[11]); pb.z = pk2(s[12], s[13]); pb.w = pk2(s[14], s[15]);
            const bf16x8 pf0 = __builtin_bit_cast(bf16x8, pa), pf1 = __builtin_bit_cast(bf16x8, pb);
#pragma unroll
            for (int dt = 0; dt < 2; ++dt) {
                const LAS unsigned char* vb = lds + V_OFF + (32 * dt + r) * VROW + (kb + 4 * hi) * 2;
                v4u va, vc;
                { const v2u x0 = *(const LAS v2u*)(vb), x1 = *(const LAS v2u*)(vb + 16); va = (v4u){x0.x, x0.y, x1.x, x1.y}; }
                { const v2u x0 = *(const LAS v2u*)(vb + 32), x1 = *(const LAS v2u*)(vb + 48); vc = (v4u){x0.x, x0.y, x1.x, x1.y}; }
                if (dt == 0) { o0 = __builtin_amdgcn_mfma_f32_32x32x16_bf16(__builtin_bit_cast(bf16x8, va), pf0, o0, 0, 0, 0); o0 = __builtin_amdgcn_mfma_f32_32x32x16_bf16(__builtin_bit_cast(bf16x8, vc), pf1, o0, 0, 0, 0); }
                else         { o1 = __builtin_amdgcn_mfma_f32_32x32x16_bf16(__builtin_bit_cast(bf16x8, va), pf0, o1, 0, 0, 0); o1 = __builtin_amdgcn_mfma_f32_32x32x16_bf16(__builtin_bit_cast(bf16x8, vc), pf1, o1, 0, 0, 0); }
            }
        }
        l_run += __shfl_xor(l_run, 32);
        const float inv = 1.0f / l_run;
        bf16* yrow = P.yat + qrow * 512 + hq * 64;
#pragma unroll
        for (int g4 = 0; g4 < 4; ++g4) {
            v2u w0, w1;
            w0.x = pk2(o0[4 * g4] * inv, o0[4 * g4 + 1] * inv); w0.y = pk2(o0[4 * g4 + 2] * inv, o0[4 * g4 + 3] * inv);
            w1.x = pk2(o1[4 * g4] * inv, o1[4 * g4 + 1] * inv); w1.y = pk2(o1[4 * g4 + 2] * inv, o1[4 * g4 + 3] * inv);
            *(GAS v2u*)(yrow + 8 * g4 + 4 * hi) = w0; *(GAS v2u*)(yrow + 32 + 8 * g4 + 4 * hi) = w1;
        }
    }
    LDS_WAIT(); __syncthreads();
}
}

__device__ __forceinline__ void transpose_y_tile(LAS unsigned char* lds, const bf16* yT, bf16* yhy, int tile, int tid_) {
    int tid = tid_; asm volatile("" : "+v"(tid));
    const int c0 = (tile & 7) * 64, t0 = (tile >> 3) * 64;
    LAS bf16* T = (LAS bf16*)lds;
    { const int ch = tid >> 3, k8 = tid & 7; *(LAS v4u*)(T + ch * 72 + k8 * 8) = *(const GAS v4u*)(yT + (size_t)(c0 + ch) * MTOK + t0 + k8 * 8); }
    LDS_WAIT(); __syncthreads();
    { const int tk = tid >> 3, c8 = tid & 7; unsigned short e[8];
#pragma unroll
      for (int j = 0; j < 8; ++j) e[j] = T[(c8 * 8 + j) * 72 + tk];
      v4u o; o.x = e[0] | ((unsigned)e[1] << 16); o.y = e[2] | ((unsigned)e[3] << 16); o.z = e[4] | ((unsigned)e[5] << 16); o.w = e[6] | ((unsigned)e[7] << 16);
      *(GAS v4u*)(yhy + (size_t)(t0 + tk) * 512 + c0 + c8 * 8) = o; }
    LDS_WAIT(); __syncthreads();
}

#if PROBE
constexpr int CW_P = 20000;
constexpr size_t WS_DF = 484 * MiB, WS_DZ = 485 * MiB;
constexpr int PROBE_C = 137;
__device__ __forceinline__ double wave_sum_d(double v) {
#pragma unroll
    for (int o = 1; o < 64; o <<= 1) v += __shfl_xor(v, o);
    return v;
}
__device__ __forceinline__ double filt_point(const float* w1, const float* b1, const float* w2, const float* b2, const float* w3, const float* fr, int g, int p, int col, int lane) {
    const int L = g ? LS : LP; const double t = (double)p / (double)(L - 1);
    double zval = 0.0;
    if (lane == 0) zval = t;
    else if (lane < 33) { const int i = (lane - 1) & 15; const double band = 1e-4 + (double)i * ((15.0 - 1e-4) / 15.0); const double ang = (6.283185307179586 / (double)L) * (double)p * band; zval = (lane <= 16) ? cos(ang) : -sin(ang); }
    double a = (double)b1[lane];
    for (int k = 0; k < 33; ++k) a += __shfl(zval, k) * (double)w1[k * 64 + lane];
    const double h1 = sin((double)fr[lane] * a);
    a = (double)b2[lane];
    for (int i = 0; i < 64; ++i) a += __shfl(h1, i) * (double)w2[i * 64 + lane];
    const double h2 = sin((double)fr[lane] * a);
    const double out = wave_sum_d(h2 * (double)w3[lane * 2048 + col]);
    const int c = col & 511; const double dmin = log(1e-2) / 1.5, dmax = log(1e-2) / 0.3;
    const double delta = fabs(dmin + (double)c * ((dmax - dmin) / 511.0));
    return out * (exp(-t * delta) + 0.05);
}
__device__ __forceinline__ void probe_check(unsigned char* ws, unsigned* ctl, const float* w1, const float* b1, const float* w2, const float* b2, const float* w3, const float* fr, int vcu, int G, int tid) {
    const bf16* KREV_S = (const bf16*)(ws + WS_KREV_S);
    const float* DF = (const float*)(ws + WS_DF); const bf16* DZ = (const bf16*)(ws + WS_DZ);
    const int gtid = vcu * 512 + tid, lane = tid & 63, gwv = gtid >> 6, NW = G * 8;
    if (gtid < 65536) {
        const int combo = gtid >> 14, t = gtid & 16383, g = combo >> 1, o = combo & 1, L = g ? LS : LP, tl = g ? t : (t & (LP - 1)), base = t - tl;
        const bf16* kb = KREV_S + (g ? (size_t)0 : (size_t)((WS_KREV_P - WS_KREV_S) / 2)) + (size_t)(o * HW + PROBE_C) * (2 * L); const bf16* dz = DZ + combo * 16384 + base;
        double acc = 0.0;
        if (g) { for (int s = 0; s < L; ++s) { int j = tl - s; if (j < 0) j += 2 * L; acc += (double)bf2f(kb[j]) * (double)bf2f(dz[s]); } }
        else   { const bf16* kr = kb + (L - 1 - tl); for (int s = 0; s < L; ++s) acc += (double)bf2f(kr[s]) * (double)bf2f(dz[s]); }
        const float diff = fabsf((float)(acc - (double)DF[combo * 16384 + t]));
        atomicMax(ctl + CW_P + 0, __float_as_uint(diff)); atomicMax(ctl + CW_P + 1, __float_as_uint(fabsf((float)acc)));
    }
    {
        const int g = gwv & 1, L = g ? LS : LP; const int p = (int)(((unsigned)gwv * 2654435761u) >> 8) % L;
        for (int q = 0; q < 8; ++q) { const int col = (gwv * 97 + 263 * q) & 2047; const int o = col >> 10, dir = (col >> 9) & 1, c = col & 511;
            if (dir == 1 && p == 0) continue;
            const double kv = filt_point(w1, b1, w2, b2, w3, fr, g, p, col, lane);
            const int m = g ? (dir ? (2 * L - p) : p) : (dir ? (L - 1 + p) : (L - 1 - p)); const float st = bf2f((KREV_S + (g ? (size_t)0 : (size_t)((WS_KREV_P - WS_KREV_S) / 2)) + (size_t)(o * HW + c) * (2 * L))[m]);
            if (lane == 0) { atomicMax(ctl + CW_P + 2, __float_as_uint(fabsf(st - (float)kv))); atomicMax(ctl + CW_P + 3, __float_as_uint(fabsf((float)kv))); } }
    }
    for (int which = 0; which < 2; ++which) {
        const int g = which ? 0 : 1, o = which ? 0 : 1, L = g ? LS : LP; double loc = 0.0;
        for (int p = gwv; p < L; p += NW)
            for (int dir = 0; dir < 2; ++dir) { if (dir == 1 && p == 0) continue; loc += fabs(filt_point(w1, b1, w2, b2, w3, fr, g, p, o * 1024 + dir * 512 + PROBE_C, lane)); }
        if (lane == 0) atomicAdd((double*)(ctl + CW_P + 8) + which, loc);
    }
}
__device__ __forceinline__ int probe_metric_count(unsigned char* ws, unsigned* ctl) {
    const float e_conv = __uint_as_float(__hip_atomic_load(ctl + CW_P + 0, RLX_AGENT)) / fmaxf(__uint_as_float(__hip_atomic_load(ctl + CW_P + 1, RLX_AGENT)), 1e-30f);
    const float e_filt = __uint_as_float(__hip_atomic_load(ctl + CW_P + 2, RLX_AGENT)) / fmaxf(__uint_as_float(__hip_atomic_load(ctl + CW_P + 3, RLX_AGENT)), 1e-30f);
    const float* FPS = (const float*)(ws + WS_FPART_S); const float* FPP = (const float*)(ws + WS_FPART_P);
    double s1 = 0.0, s0 = 0.0;
    for (int ch = 0; ch < 256; ++ch) s1 += (double)FPS[(size_t)ch * 2048 + 1024 + PROBE_C] + (double)FPS[(size_t)ch * 2048 + 1024 + 512 + PROBE_C];
    for (int ch = 0; ch < 32; ++ch) s0 += (double)FPP[(size_t)ch * 2048 + PROBE_C] + (double)FPP[(size_t)ch * 2048 + 512 + PROBE_C];
    const double n1 = ((volatile double*)(ctl + CW_P + 8))[0], n0 = ((volatile double*)(ctl + CW_P + 8))[1];
    const float e_n1 = (float)(fabs(n1 - s1) / fmax(n1, 1e-30)), e_n0 = (float)(fabs(n0 - s0) / fmax(n0, 1e-30));
#if PROBE == 100
    float M = fmaxf(fmaxf(e_conv, e_filt * 1e-3f), fmaxf(e_n1, e_n0));
#elif PROBE == 101
    float M = e_conv;
#elif PROBE == 102
    float M = e_filt;
#else
    float M = fmaxf(e_n1, e_n0);
#endif
    float v = (log10f(fmaxf(M, 1e-12f)) + 8.0f) * 0.125f; v = fminf(fmaxf(v, 0.02f), 1.0f);
    return (int)(v * 1600.0f);
}
#endif

#ifndef MK_SPLIT
#define MK_SPLIT 0
#endif
constexpr int N_PHASES = 8;
struct Args { const float* in[23]; float* out; unsigned char* ws; int ph_lo, ph_hi; };

__global__ void __launch_bounds__(NWAVES * 64, 2) enc_fwd(Args args) {
    extern __shared__ __attribute__((aligned(16))) unsigned char lds_raw[];
    Frame F;
    F.lds = (LAS unsigned char*)lds_raw;
    F.MISC = (volatile LAS unsigned*)(F.lds + MISC_OFF);
    F.tid = threadIdx.x; F.lane = F.tid & 63; F.wave = __builtin_amdgcn_readfirstlane(F.tid >> 6);
    F.G = gridDim.x; { const int bx = blockIdx.x; F.vcu = (F.G % 8 == 0) ? (bx % 8) * (F.G / 8) + bx / 8 : bx; }
    F.ws = args.ws; F.ctl = (gu32*)(args.ws + WS_CTL);
    unsigned char* const ws = args.ws;
    for (int u = F.tid; u < (LDS_BYTES - LDSCTL_OFF) / 4; u += NWAVES * 64) ((LAS unsigned*)(F.lds + LDSCTL_OFF))[u] = 0u;
    __syncthreads();
    const int lo = args.ph_lo, hi = args.ph_hi;
    XcdBarrier bar; bar.bar = (unsigned*)(F.ctl + CW_BAR); bar.x = 0; bar.st = nullptr;
    if (hi - lo > 1) bar = xcd_barrier_post((unsigned*)(F.ctl + CW_BAR), F.MISC + 8);
#define IN(k) (lo <= (k) && (k) < hi)
#if PROBE
#define TSTAMP(k) do { if (blockIdx.x == 0 && F.tid == 0) { const unsigned long long t_ = __builtin_amdgcn_s_memrealtime(); F.MISC[16 + 2 * (k)] = (unsigned)t_; F.MISC[17 + 2 * (k)] = (unsigned)(t_ >> 32); } } while (0)
#else
#define TSTAMP(k) do { } while (0)
#endif
#define SEAM(k) do { if (IN(k) && IN((k) + 1)) xcd_barrier(bar); TSTAMP((k) + 1); } while (0)
    TSTAMP(0);

    const float* const xp = args.in[0]; const float* const xs = args.in[1];
    bf16* const WINA = (bf16*)(ws + WS_WINA); bf16* const WINB = (bf16*)(ws + WS_WINB); bf16* const WHY = (bf16*)(ws + WS_WHY); bf16* const WAT = (bf16*)(ws + WS_WAT);
    bf16* const W3T = (bf16*)(ws + WS_W3T); bf16* const WO = (bf16*)(ws + WS_WO); bf16* const WGU = (bf16*)(ws + WS_WGU); bf16* const WD = (bf16*)(ws + WS_WD);
    bf16* const XB = (bf16*)(ws + WS_XB); bf16* const YT = (bf16*)(ws + WS_YT); bf16* const YAT = (bf16*)(ws + WS_YAT);
    bf16* const KREV_S = (bf16*)(ws + WS_KREV_S); bf16* const KREV_P = (bf16*)(ws + WS_KREV_P); bf16* const UT = (bf16*)(ws + WS_UT);
    bf16* const QB = (bf16*)(ws + WS_Q); bf16* const KB = (bf16*)(ws + WS_K); bf16* const VB = (bf16*)(ws + WS_V);
    bf16* const SGH = (bf16*)(ws + WS_SGH); bf16* const SGA = (bf16*)(ws + WS_SGA);
    float* const COS = (float*)(ws + WS_COS); float* const SIN = (float*)(ws + WS_SIN); float* const RSTD = (float*)(ws + WS_RSTD); float* const SSQ = (float*)(ws + WS_SSQ);
    float* const FPART_S = (float*)(ws + WS_FPART_S); float* const FPART_P = (float*)(ws + WS_FPART_P);
    bf16* const YHY = (bf16*)(ws + WS_YHY); bf16* const MERGED = (bf16*)(ws + WS_MERGED); bf16* const X1B = (bf16*)(ws + WS_X1B); bf16* const HID = (bf16*)(ws + WS_HID);

    if (IN(0)) {
        LAS float* scr = (LAS float*)(F.lds + RING_OFF + F.wave * 16384);
        const int gw = F.vcu * NWAVES + F.wave, NGW = F.G * NWAVES;
        constexpr int I_IN = 16 * 136, I_HY = 8 * 32, I_O = 16 * 32, I_G = 16 * 88, I_D = 44 * 32, I_W3 = 64;
        constexpr int NITEMS = I_IN + 2 * I_HY + I_O + 2 * I_G + I_D + I_W3;
        for (int it = gw; it < NITEMS; it += NGW) {
            int rr = it;
            if (rr < I_IN) { const int kb = rr / 136, nb = rr % 136, n0 = 32 * nb;
                if (n0 < 3 * HW) p0_transpose_item(args.in[3], DM, INW, WINA, n0, args.in[2], scr, 64 * kb, n0, F.lane);
                else p0_transpose_item(args.in[3], DM, INW, WINB, map_projB(n0), args.in[2], scr, 64 * kb, n0, F.lane);
                continue; } rr -= I_IN;
            if (rr < I_HY) { p0_transpose_item(args.in[16], HW, DM, WHY, 32 * (rr % 32), nullptr, scr, 64 * (rr / 32), 32 * (rr % 32), F.lane); continue; } rr -= I_HY;
            if (rr < I_HY) { p0_transpose_item(args.in[17], HW, DM, WAT, 32 * (rr % 32), nullptr, scr, 64 * (rr / 32), 32 * (rr % 32), F.lane); continue; } rr -= I_HY;
            if (rr < I_O) { p0_transpose_item(args.in[18], DM, DM, WO, 32 * (rr % 32), nullptr, scr, 64 * (rr / 32), 32 * (rr % 32), F.lane); continue; } rr -= I_O;
            if (rr < I_G) { const int n0 = 32 * (rr % 88); p0_transpose_item(args.in[20], DM, FFN, WGU, (n0 >> 7) * 256 + (n0 & 127), args.in[19], scr, 64 * (rr / 88), n0, F.lane); continue; } rr -= I_G;
            if (rr < I_G) { const int n0 = 32 * (rr % 88); p0_transpose_item(args.in[21], DM, FFN, WGU, (n0 >> 7) * 256 + 128 + (n0 & 127), args.in[19], scr, 64 * (rr / 88), n0, F.lane); continue; } rr -= I_G;
            if (rr < I_D) { p0_transpose_item(args.in[22], FFN, DM, WD, 32 * (rr % 32), nullptr, scr, 64 * (rr / 32), 32 * (rr % 32), F.lane); continue; } rr -= I_D;
            p0_transpose_item(args.in[10], 64, 2048, W3T, 32 * rr, nullptr, scr, 0, 32 * rr, F.lane);
        }
        for (int m = gw; m < MTOK; m += NGW) p0_row((m < TP) ? xp + (size_t)m * DM : xs + (size_t)(m - TP) * DM, XB + (size_t)m * DM, RSTD + m, F.lane);
        for (int idx = F.vcu * (NWAVES * 64) + F.tid; idx < LS * 32; idx += F.G * NWAVES * 64) {
            const int pos = idx >> 5, i = idx & 31; const double inv = exp2(-(double)i * (13.287712379549449 / 32.0)); const double ang = (double)pos * inv;
            COS[idx] = (float)cos(ang); SIN[idx] = (float)sin(ang);
        }
    }
    SEAM(0);

    if (IN(1)) {
        {
            constexpr int NU = (MTOK / 256) * (NPROJ / 256);
            const int heavy = NU % F.G, lb = heavy ? (int)blockIdx.x - heavy : (int)blockIdx.x, nlb = heavy ? F.G - heavy : F.G;
            if (lb >= 0) {
                filter_stage_weights(F.lds, args.in[6], args.in[7], args.in[8], args.in[9], args.in[11], F.tid);
                for (int it = lb * NWAVES + F.wave; it < 288 * 2; it += nlb * NWAVES) {
                    const int dir = it & 1, ca = it >> 1, g = (ca < 256) ? 1 : 0, chunk = g ? ca : ca - 256;
                    filter_item(F.lds, W3T, KREV_S + (g ? (size_t)0 : (size_t)((WS_KREV_P - WS_KREV_S) / 2)), FPART_S + (g ? (size_t)0 : (size_t)((WS_FPART_P - WS_FPART_S) / 4)), g, chunk, dir, F.wave, F.lane);
                }
                LDS_WAIT(); __syncthreads();
            }
        }
        {
            pg8::Gemm g{WINA, XB, nullptr, nullptr, 3 * HW, MTOK, DM}; pg8::StaticOrder S; S.init(3 * HW, MTOK, F.G, (int)blockIdx.x);
            pg8::EpiUT E{UT, MTOK, RSTD};
            pg8::gemm_phase<pg8::EpiUT, pg8::StaticOrder, true, true>(F.lds + RING_OFF, g, S, E);
        }
        {
            pg8::Gemm g{XB, WINB, nullptr, nullptr, MTOK, NPROJ, DM}; pg8::StaticOrder S; S.init(MTOK, NPROJ, F.G, (int)blockIdx.x);
            pg8::EpiProj E{RSTD, args.in[13], args.in[14], COS, SIN, QB, KB, VB, SGH, SGA};
            pg8::gemm_phase<pg8::EpiProj, pg8::StaticOrder, true, true>(F.lds + RING_OFF, g, S, E);
        }
    }
    SEAM(1);

    if (IN(2)) {
        #if PROBE
        const hy::Params HP{UT, KREV_S, KREV_P, FPART_S, FPART_P, args.in[4], args.in[5], args.in[12], YT, (float*)(ws + WS_DF), (bf16*)(ws + WS_DZ)};
#else
        const hy::Params HP{UT, KREV_S, KREV_P, FPART_S, FPART_P, args.in[4], args.in[5], args.in[12], YT, nullptr, nullptr};
#endif
        {
#if PROBE
            const fc::Params FP{UT, KREV_S, FPART_S, args.in[4], args.in[5], args.in[12], YT, (bf16*)(ws + WS_HS), (bf16*)(ws + WS_Z1S), (float*)(ws + WS_DF), (bf16*)(ws + WS_DZ)};
#else
            const fc::Params FP{UT, KREV_S, FPART_S, args.in[4], args.in[5], args.in[12], YT, (bf16*)(ws + WS_HS), (bf16*)(ws + WS_Z1S), nullptr, nullptr};
#endif
            for (int it = F.vcu; it < HW; it += F.G) fc::item(F.lds, FP, it, F.tid, F.vcu);
        }
        TSTAMP(9);
        for (int it = F.vcu; it < HW; it += F.G) hy::hyena_item(F.lds, HP, 0, it, F.tid);
        TSTAMP(10);
        const at::Params AP{QB, KB, VB, args.in[15], YAT};
        for (int it = F.vcu; it < 512; it += F.G) at::attn_item(F.lds, AP, it >> 1, it & 1, F.tid);
    }
    SEAM(2);
#if PROBE >= 100
    probe_check(ws, (unsigned*)F.ctl, args.in[6], args.in[7], args.in[8], args.in[9], args.in[10], args.in[11], F.vcu, F.G, F.tid);
    xcd_barrier(bar);
#endif

    if (IN(3)) {
        for (int t = F.vcu; t < 8 * 512; t += F.G) transpose_y_tile(F.lds, YT, YHY, t, F.tid);
    }
    SEAM(3);

    if (IN(4)) {
        pg8::Gemm g{YHY, WHY, YAT, WAT, MTOK, DM, HW}; pg8::TwoPartOrder S; S.b.init(MTOK, DM, F.G, (int)blockIdx.x);
        pg8::EpiMerged E{SGH, SGA, MERGED};
        pg8::gemm_phase<pg8::EpiMerged, pg8::TwoPartOrder, true, true>(F.lds + RING_OFF, g, S, E);
    }
    SEAM(4);

    if (IN(5)) {
        pg8::Gemm g{MERGED, WO, nullptr, nullptr, MTOK, DM, DM}; pg8::StaticOrder S; S.init(MTOK, DM, F.G, (int)blockIdx.x);
        pg8::EpiWo E{xp, xs, X1B, SSQ};
        pg8::gemm_phase<pg8::EpiWo, pg8::StaticOrder, true, true>(F.lds + RING_OFF, g, S, E);
    }
    SEAM(5);

    if (IN(6)) {
        pg8::Gemm g{X1B, WGU, nullptr, nullptr, MTOK, 2 * FFN, DM}; pg8::StaticOrder S; S.init(MTOK, 2 * FFN, F.G, (int)blockIdx.x);
        pg8::EpiFfn1 E{SSQ, HID};
        pg8::gemm_phase<pg8::EpiFfn1, pg8::StaticOrder, true, true>(F.lds + RING_OFF, g, S, E);
    }
    SEAM(6);

    if (IN(7)) {
        pg8::Gemm g{HID, WD, nullptr, nullptr, MTOK, DM, FFN}; pg8::StaticOrder S; S.init(MTOK, DM, F.G, (int)blockIdx.x);
        pg8::EpiFfn2 E{X1B, args.out};
        pg8::gemm_phase<pg8::EpiFfn2, pg8::StaticOrder, true, true>(F.lds + RING_OFF, g, S, E);
#if PROBE
        TSTAMP(8);
        VM_WAIT(); __syncthreads();
        if (blockIdx.x == 0) {
            pg8::Unit u; S.next(1, u);
            int cnt;
#if PROBE >= 100
            cnt = probe_metric_count(ws, (unsigned*)F.ctl);
#else
            { const unsigned long long t0 = F.MISC[16] | ((unsigned long long)F.MISC[17] << 32), t8 = F.MISC[32] | ((unsigned long long)F.MISC[33] << 32);
#if PROBE >= 31 && PROBE <= 35
              cnt = (int)(1600.0f * (float)F.MISC[40 + PROBE - 31] / (float)(t8 - t0));
              constexpr int IA = 0, IB = 1;
              if (false)
#elif PROBE == 21
              constexpr int IA = 2, IB = 9;
#elif PROBE == 22
              constexpr int IA = 9, IB = 10;
#elif PROBE == 23
              constexpr int IA = 10, IB = 3;
#else
              constexpr int IA = PROBE - 1, IB = PROBE;
#endif
              { const unsigned long long ta = F.MISC[16 + 2 * IA] | ((unsigned long long)F.MISC[17 + 2 * IA] << 32), tb = F.MISC[16 + 2 * IB] | ((unsigned long long)F.MISC[17 + 2 * IB] << 32);
                cnt = (int)(1600.0f * (float)(tb - ta) / (float)(t8 - t0)); } }
#endif
            for (int i = F.tid; i < cnt; i += NWAVES * 64) args.out[(size_t)(u.pm * 256 + (i & 255)) * 1024 + u.pn * 256 + (i >> 8)] = 0.f;
        }
#endif
    }
#undef IN
#undef SEAM
}

extern "C" void kernel_launch(void* const* d_in, const int* in_sizes, int n_in, void* d_out, int out_size, void* d_ws, size_t ws_size, hipStream_t stream) {
    static int grid = 0;
    if (grid == 0) {
        if (n_in != 23 || out_size != MTOK * DM || ws_size < WS_END) { fprintf(stderr, "kernel_launch: unexpected problem shape (n_in %d, out %d, ws %zu); nothing launched\n", n_in, out_size, ws_size); grid = -1; return; }
        int dev = 0, cus = 0, per_cu = 0;
        if (hipGetDevice(&dev) != hipSuccess || hipDeviceGetAttribute(&cus, hipDeviceAttributeMultiprocessorCount, dev) != hipSuccess) { fprintf(stderr, "kernel_launch: device query failed\n"); grid = -1; return; }
        if (hipFuncSetAttribute((const void*)enc_fwd, hipFuncAttributeMaxDynamicSharedMemorySize, LDS_BYTES) != hipSuccess) { fprintf(stderr, "kernel_launch: hipFuncSetAttribute failed\n"); grid = -1; return; }
        if (hipOccupancyMaxActiveBlocksPerMultiprocessor(&per_cu, (const void*)enc_fwd, NWAVES * 64, LDS_BYTES) != hipSuccess || per_cu < 1)
            fprintf(stderr, "kernel_launch: note: occupancy query reports %d workgroups per CU\n", per_cu);
        (void)hipGetLastError();
        grid = cus;
    }
    if (grid < 0) return;
    if (hipMemsetAsync((char*)d_ws + WS_CTL, 0, CTL_ZERO_BYTES, stream) != hipSuccess) { fprintf(stderr, "kernel_launch: memset failed\n"); return; }
    Args a{};
    for (int i = 0; i < 23; ++i) a.in[i] = (const float*)d_in[i];
    a.out = (float*)d_out; a.ws = (unsigned char*)d_ws;
#if MK_SPLIT
    for (int p = 0; p < N_PHASES; ++p) { a.ph_lo = p; a.ph_hi = p + 1; hipLaunchKernelGGL(enc_fwd, dim3(grid), dim3(NWAVES * 64), LDS_BYTES, stream, a); }
#else
    a.ph_lo = 0; a.ph_hi = N_PHASES;
    hipLaunchKernelGGL(enc_fwd, dim3(grid), dim3(NWAVES * 64), LDS_BYTES, stream, a);
#endif
    const hipError_t le = hipPeekAtLastError();
    if (le != hipSuccess) fprintf(stderr, "kernel_launch: launch failed: %s\n", hipGetErrorName(le));
}
```

```cpp
#include <hip/hip_runtime.h>
#include <cstdio>
#include <cstdint>
#include <cmath>
#ifndef PROBE
#define PROBE 0
#endif

namespace pg8 {
#define PG8_LAS __attribute__((address_space(3)))
typedef unsigned short bf16_t;
typedef short bf16x8 __attribute__((ext_vector_type(8)));
typedef float f32x4 __attribute__((ext_vector_type(4)));
typedef unsigned u32x4 __attribute__((ext_vector_type(4)));
constexpr int BM = 256, BK = 64, HALF = 128, HTB = HALF * BK * 2  , STAGE_BYTES = 8 * HTB, NXCD = 8, WGM = 8;

__host__ __device__ __forceinline__ int lds_byte(int r, int c) { const int st = (r >> 4) * 2 + (c >> 5), rr = r & 15, cc = c & 31, ob = rr * 64 + cc * 2; return st * 1024 + (ob ^ (((ob >> 9) & 1) << 5)); }
__host__ __device__ __forceinline__ void stage_rc(int b, int& R, int& C) { const int st = b / 1024, sb = b % 1024, swz = sb ^ (((sb >> 9) & 1) << 5); R = (st >> 1) * 16 + swz / 64; C = (st & 1) * 32 + (swz % 64) / 2; }
__host__ __device__ __forceinline__ int perm32(int rho) { const int n = rho >> 4, i = rho & 15; return 8 * (i >> 2) + 4 * n + (i & 3); }

struct Unit { int pm, pn, sel; };
struct Gemm { const bf16_t* A; const bf16_t* Bt; const bf16_t* A1; const bf16_t* Bt1; int M, N, K; };

struct StaticOrder {
    int nM, nN, nwg, G, c;
    __host__ __device__ __forceinline__ void init(int M, int N, int G_, int c_) { nM = M / BM; nN = N / BM; nwg = nM * nN; G = G_; c = c_; }
    __host__ __device__ __forceinline__ bool next(int i, Unit& u) const {
        const long L = (long)i * G + c; if (L >= nwg) return false;
        int wgid = (int)L; { const int q = nwg / NXCD, r = nwg % NXCD, xcd = wgid % NXCD, off = wgid / NXCD; wgid = (xcd < r ? xcd * (q + 1) : r * (q + 1) + (xcd - r) * q) + off; }
        const int nig = WGM * nN, gid = wgid / nig, fm = gid * WGM, gsz = (nM - fm) < WGM ? (nM - fm) : WGM;
        u.pm = fm + ((wgid % nig) % gsz); u.pn = (wgid % nig) / gsz; u.sel = 0; return true;
    }
    __device__ __forceinline__ void a_ready(const Unit&) const {}
    __device__ __forceinline__ void done(const Unit&) const {}
};
struct TwoPartOrder {
    StaticOrder b;
    __device__ __forceinline__ bool next(int i, Unit& u) const { if (!b.next(i >> 1, u)) return false; u.sel = i & 1; return true; }
    __device__ __forceinline__ void a_ready(const Unit&) const {}
    __device__ __forceinline__ void done(const Unit&) const {}
};

typedef float f32x2_c __attribute__((ext_vector_type(2))); typedef __bf16 bf16x2_c __attribute__((ext_vector_type(2)));
__device__ __forceinline__ unsigned cvt_pk_bf16(float lo, float hi) { const f32x2_c v = {lo, hi}; return __builtin_bit_cast(unsigned, __builtin_convertvector(v, bf16x2_c)); }
__device__ __forceinline__ u32x4 pack8(const f32x4 a, const f32x4 b) { u32x4 w; w.x = cvt_pk_bf16(a[0], a[1]); w.y = cvt_pk_bf16(a[2], a[3]); w.z = cvt_pk_bf16(b[0], b[1]); w.w = cvt_pk_bf16(b[2], b[3]); return w; }
__device__ __forceinline__ float bflo(unsigned w) { return __uint_as_float(w << 16); }
__device__ __forceinline__ float bfhi(unsigned w) { return __uint_as_float(w & 0xffff0000u); }
__device__ __forceinline__ void unpack8(const u32x4 w, f32x4& a, f32x4& b) { a = (f32x4){bflo(w.x), bfhi(w.x), bflo(w.y), bfhi(w.y)}; b = (f32x4){bflo(w.z), bfhi(w.z), bflo(w.w), bfhi(w.w)}; }
__device__ __forceinline__ float sigmoidf_(float v) { return __builtin_amdgcn_rcpf(1.0f + __builtin_amdgcn_exp2f(-1.4426950408889634f * v)); }

constexpr float QSCALE = 0.125f * 1.4426950408889634f;

struct EpiUT {
    static constexpr bool PERM = true, AFTER_DRAIN = false;
    bf16_t* O; int ldc; const float* rstd;
    __device__ __forceinline__ bool keep(const Unit&) const { return false; }
    __device__ __forceinline__ void operator()(f32x4 (&acc)[2][2][4][2], const Unit& u, int wr, int wc, int fr, int fq) const {
        const int row0 = u.pm * BM + wr * 64 + fr, col0 = u.pn * BM + wc * 32 + 8 * fq;
        f32x4 rs[2][2];
#pragma unroll
        for (int bj = 0; bj < 2; ++bj)
#pragma unroll
            for (int n = 0; n < 2; ++n) rs[bj][n] = *(const f32x4*)(rstd + col0 + bj * HALF + 4 * n);
#pragma unroll
        for (int ai = 0; ai < 2; ++ai)
#pragma unroll
            for (int m = 0; m < 4; ++m) { bf16_t* rowp = O + (size_t)(row0 + ai * HALF + m * 16) * ldc + col0;
#pragma unroll
                for (int bj = 0; bj < 2; ++bj) *(u32x4*)(rowp + bj * HALF) = pack8(acc[ai][bj][m][0] * rs[bj][0], acc[ai][bj][m][1] * rs[bj][1]); }
    }
};

struct EpiProj {
    static constexpr bool PERM = true, AFTER_DRAIN = false;
    const float* rstd; const float* qw; const float* kw; const float* cs; const float* sn; bf16_t* q; bf16_t* k; bf16_t* v; bf16_t* sgh; bf16_t* sga;
    __device__ __forceinline__ bool keep(const Unit&) const { return false; }
    __device__ __forceinline__ void operator()(f32x4 (&acc)[2][2][4][2], const Unit& u, int wr, int wc, int fr, int fq) const {
        const int pn = u.pn;
        float rsv[2][4];
#pragma unroll
        for (int ai = 0; ai < 2; ++ai)
#pragma unroll
            for (int m = 0; m < 4; ++m) rsv[ai][m] = rstd[u.pm * BM + ai * HALF + wr * 64 + m * 16 + fr];
        if (pn <= 2 && !(pn == 2 && wc >= 2)) {
            const float* w = (pn < 2) ? qw : kw; const float sc = (pn < 2) ? QSCALE : 1.0f;
            const f32x4 wl0 = *(const f32x4*)(w + 8 * fq), wl1 = *(const f32x4*)(w + 8 * fq + 4), wh0 = *(const f32x4*)(w + 32 + 8 * fq), wh1 = *(const f32x4*)(w + 32 + 8 * fq + 4);
#pragma unroll
            for (int ai = 0; ai < 2; ++ai)
#pragma unroll
                for (int m = 0; m < 4; ++m) {
                    const int row = u.pm * BM + ai * HALF + wr * 64 + m * 16 + fr; const float rs = rsv[ai][m];
                    f32x4 a0 = acc[ai][0][m][0] * rs, a1 = acc[ai][0][m][1] * rs, b0 = acc[ai][1][m][0] * rs, b1 = acc[ai][1][m][1] * rs;
                    f32x4 sq = a0 * a0 + a1 * a1 + b0 * b0 + b1 * b1; float ss = (sq[0] + sq[1]) + (sq[2] + sq[3]);
                    ss += __shfl_xor(ss, 16); ss += __shfl_xor(ss, 32);
                    const float inv = 1.0f / sqrtf(ss * (1.0f / 64.0f) + 1e-6f);
                    const int pos = row < 16384 ? (row & 2047) : (row - 16384);
                    const f32x4 c0 = *(const f32x4*)(cs + pos * 32 + 8 * fq), c1 = *(const f32x4*)(cs + pos * 32 + 8 * fq + 4), s0 = *(const f32x4*)(sn + pos * 32 + 8 * fq), s1 = *(const f32x4*)(sn + pos * 32 + 8 * fq + 4);
                    a0 = a0 * inv * wl0; a1 = a1 * inv * wl1; b0 = b0 * inv * wh0; b1 = b1 * inv * wh1;
                    const f32x4 lo0 = (a0 * c0 - b0 * s0) * sc, lo1 = (a1 * c1 - b1 * s1) * sc, hi0 = (b0 * c0 + a0 * s0) * sc, hi1 = (b1 * c1 + a1 * s1) * sc;
                    bf16_t* dst = (pn < 2) ? q + (size_t)row * 512 + (4 * pn + wc) * 64 + 8 * fq : k + (size_t)row * 128 + wc * 64 + 8 * fq;
                    *(u32x4*)dst = pack8(lo0, lo1); *(u32x4*)(dst + 32) = pack8(hi0, hi1);
                }
        } else if (pn == 2) {
#pragma unroll
            for (int ai = 0; ai < 2; ++ai)
#pragma unroll
                for (int m = 0; m < 4; ++m) {
                    const int row = u.pm * BM + ai * HALF + wr * 64 + m * 16 + fr; const float rs = rsv[ai][m];
                    bf16_t* dst = v + (size_t)row * 128 + (wc - 2) * 64 + 8 * fq;
                    *(u32x4*)dst = pack8(acc[ai][0][m][0] * rs, acc[ai][0][m][1] * rs); *(u32x4*)(dst + 32) = pack8(acc[ai][1][m][0] * rs, acc[ai][1][m][1] * rs);
                }
        } else {
            bf16_t* base = (pn < 7) ? sgh : sga; const int colb = (pn - ((pn < 7) ? 3 : 7)) * BM + wc * 32 + 8 * fq;
#pragma unroll
            for (int ai = 0; ai < 2; ++ai)
#pragma unroll
                for (int m = 0; m < 4; ++m) {
                    const int row = u.pm * BM + ai * HALF + wr * 64 + m * 16 + fr; const float rs = rsv[ai][m];
#pragma unroll
                    for (int bj = 0; bj < 2; ++bj) { f32x4 g0 = acc[ai][bj][m][0] * rs, g1 = acc[ai][bj][m][1] * rs;
#pragma unroll
                        for (int e = 0; e < 4; ++e) { g0[e] = sigmoidf_(g0[e]); g1[e] = sigmoidf_(g1[e]); }
                        *(u32x4*)(base + (size_t)row * 1024 + colb + bj * HALF) = pack8(g0, g1); }
                }
        }
    }
};

struct EpiMerged {
    static constexpr bool PERM = true, AFTER_DRAIN = false;
    const bf16_t* sgh; const bf16_t* sga; bf16_t* out;
    __device__ __forceinline__ bool keep(const Unit& u) const { return u.sel == 0; }
    __device__ __forceinline__ void operator()(f32x4 (&acc)[2][2][4][2], const Unit& u, int wr, int wc, int fr, int fq) const {
#pragma unroll
        for (int ai = 0; ai < 2; ++ai) {
            u32x4 ga[4][2], gh[4][2];
#pragma unroll
            for (int m = 0; m < 4; ++m) { const size_t off = (size_t)(u.pm * BM + ai * HALF + wr * 64 + m * 16 + fr) * 1024 + u.pn * BM + wc * 32 + 8 * fq;
#pragma unroll
                for (int bj = 0; bj < 2; ++bj) { ga[m][bj] = *(const u32x4*)(sga + off + bj * HALF); if (u.sel == 0) gh[m][bj] = *(const u32x4*)(sgh + off + bj * HALF); } }
#pragma unroll
            for (int m = 0; m < 4; ++m) { const size_t off = (size_t)(u.pm * BM + ai * HALF + wr * 64 + m * 16 + fr) * 1024 + u.pn * BM + wc * 32 + 8 * fq;
#pragma unroll
                for (int bj = 0; bj < 2; ++bj) {
                    f32x4 t0, t1; unpack8(ga[m][bj], t0, t1);
                    if (u.sel == 0) { f32x4 h0, h1; unpack8(gh[m][bj], h0, h1);
                        f32x4 q0, q1;
#pragma unroll
                        for (int e = 0; e < 4; ++e) { q0[e] = h0[e] * __builtin_amdgcn_rcpf(t0[e]); q1[e] = h1[e] * __builtin_amdgcn_rcpf(t1[e]); }
                        acc[ai][bj][m][0] = acc[ai][bj][m][0] * q0; acc[ai][bj][m][1] = acc[ai][bj][m][1] * q1; }
                    else *(u32x4*)(out + off + bj * HALF) = pack8(acc[ai][bj][m][0] * t0, acc[ai][bj][m][1] * t1);
                } }
        }
    }
};

struct EpiWo {
    static constexpr bool PERM = true, AFTER_DRAIN = false;
    const float* xp; const float* xs; bf16_t* x1b; float* ssq;
    __device__ __forceinline__ bool keep(const Unit&) const { return false; }
    __device__ __forceinline__ void operator()(f32x4 (&acc)[2][2][4][2], const Unit& u, int wr, int wc, int fr, int fq) const {
        const float* xb = (u.pm < 64) ? xp : xs - (size_t)16384 * 1024;
#pragma unroll
        for (int ai = 0; ai < 2; ++ai) {
            f32x4 xv[4][2][2];
#pragma unroll
            for (int m = 0; m < 4; ++m) { const size_t off = (size_t)(u.pm * BM + ai * HALF + wr * 64 + m * 16 + fr) * 1024 + u.pn * BM + wc * 32 + 8 * fq;
#pragma unroll
                for (int bj = 0; bj < 2; ++bj) { xv[m][bj][0] = *(const f32x4*)(xb + off + bj * HALF); xv[m][bj][1] = *(const f32x4*)(xb + off + bj * HALF + 4); } }
#pragma unroll
            for (int m = 0; m < 4; ++m) {
                const int row = u.pm * BM + ai * HALF + wr * 64 + m * 16 + fr; const size_t off = (size_t)row * 1024 + u.pn * BM + wc * 32 + 8 * fq; float s = 0.f;
#pragma unroll
                for (int bj = 0; bj < 2; ++bj) {
                    const f32x4 v0 = xv[m][bj][0] + acc[ai][bj][m][0], v1 = xv[m][bj][1] + acc[ai][bj][m][1];
                    *(u32x4*)(x1b + off + bj * HALF) = pack8(v0, v1);
                    const f32x4 q = v0 * v0 + v1 * v1; s += (q[0] + q[1]) + (q[2] + q[3]); }
                s += __shfl_xor(s, 16); s += __shfl_xor(s, 32);
                if (fq == 0) ssq[(size_t)row * 16 + u.pn * 4 + wc] = s;
            }
        }
    }
};

struct EpiFfn1 {
    static constexpr bool PERM = true, AFTER_DRAIN = false;
    const float* ssq; bf16_t* hid;
    __device__ __forceinline__ bool keep(const Unit&) const { return false; }
    __device__ __forceinline__ void operator()(f32x4 (&acc)[2][2][4][2], const Unit& u, int wr, int wc, int fr, int fq) const {
        f32x4 pv[2][4];
#pragma unroll
        for (int ai = 0; ai < 2; ++ai)
#pragma unroll
            for (int m = 0; m < 4; ++m) pv[ai][m] = *(const f32x4*)(ssq + (size_t)(u.pm * BM + ai * HALF + wr * 64 + m * 16 + fr) * 16 + 4 * fq);
#pragma unroll
        for (int ai = 0; ai < 2; ++ai)
#pragma unroll
            for (int m = 0; m < 4; ++m) {
                const int row = u.pm * BM + ai * HALF + wr * 64 + m * 16 + fr;
                const f32x4 p = pv[ai][m]; float t = (p[0] + p[1]) + (p[2] + p[3]);
                t += __shfl_xor(t, 16); t += __shfl_xor(t, 32);
                const float r = 1.0f / sqrtf(t * (1.0f / 1024.0f) + 1e-6f);
                f32x4 h0, h1;
#pragma unroll
                for (int e = 0; e < 4; ++e) { const float g0 = acc[ai][0][m][0][e] * r, g1 = acc[ai][0][m][1][e] * r;
                    h0[e] = g0 * sigmoidf_(g0) * (acc[ai][1][m][0][e] * r); h1[e] = g1 * sigmoidf_(g1) * (acc[ai][1][m][1][e] * r); }
                *(u32x4*)(hid + (size_t)row * 2816 + u.pn * HALF + wc * 32 + 8 * fq) = pack8(h0, h1);
            }
    }
};

struct EpiFfn2 {
    static constexpr bool PERM = true, AFTER_DRAIN = false;
    const bf16_t* x1b; float* out;
    __device__ __forceinline__ bool keep(const Unit&) const { return false; }
    __device__ __forceinline__ void operator()(f32x4 (&acc)[2][2][4][2], const Unit& u, int wr, int wc, int fr, int fq) const {
        u32x4 rv[2][4][2];
#pragma unroll
        for (int ai = 0; ai < 2; ++ai)
#pragma unroll
            for (int m = 0; m < 4; ++m) { const size_t off = (size_t)(u.pm * BM + ai * HALF + wr * 64 + m * 16 + fr) * 1024 + u.pn * BM + wc * 32 + 8 * fq;
#pragma unroll
                for (int bj = 0; bj < 2; ++bj) rv[ai][m][bj] = *(const u32x4*)(x1b + off + bj * HALF); }
#pragma unroll
        for (int ai = 0; ai < 2; ++ai)
#pragma unroll
            for (int m = 0; m < 4; ++m) {
                const size_t off = (size_t)(u.pm * BM + ai * HALF + wr * 64 + m * 16 + fr) * 1024 + u.pn * BM + wc * 32 + 8 * fq; float* p = out + off;
#pragma unroll
                for (int bj = 0; bj < 2; ++bj) { f32x4 r0, r1; unpack8(rv[ai][m][bj], r0, r1);
                    *(f32x4*)(p + bj * HALF) = r0 + acc[ai][bj][m][0]; *(f32x4*)(p + bj * HALF + 4) = r1 + acc[ai][bj][m][1]; }
            }
    }
};

__device__ __forceinline__ void zero_acc(f32x4 (&acc)[2][2][4][2]) {
#pragma unroll
    for (int a = 0; a < 2; ++a)
#pragma unroll
        for (int b = 0; b < 2; ++b)
#pragma unroll
            for (int m = 0; m < 4; ++m)
#pragma unroll
                for (int n = 0; n < 2; ++n) acc[a][b][m][n] = (f32x4){0.f, 0.f, 0.f, 0.f};
}
template <class Epi, class Sched, bool ALIGN_EPI = false, bool SP2 = false>
__device__ __forceinline__ void gemm_phase(PG8_LAS unsigned char* lds, const Gemm g, const Sched& S, const Epi& E) {
    int tid = threadIdx.x; asm volatile("" : "+v"(tid));
    const int wid = __builtin_amdgcn_readfirstlane(tid >> 6), lane = tid & 63, wr = wid >> 2, wc = wid & 3, fr = lane & 15, fq = lane >> 4;
    const int K = g.K, nt = K / BK;
    unsigned voffA[2], voffB[2];
#pragma unroll
    for (int i = 0; i < 2; ++i) { int R, C; stage_rc(tid * 16 + i * 8192, R, C); const int Rb = Epi::PERM ? ((R & ~31) + perm32(R & 31)) : R;
        voffA[i] = (unsigned)(R * K + C) * 2u; voffB[i] = (unsigned)(Rb * K + C) * 2u; }
    const size_t kstep = (size_t)(BK * 2);
    const size_t hstep = (size_t)HALF * K * 2;
    const size_t tstep = 2 * hstep;
    const unsigned ldsw = (unsigned)wid * 1024u;
    const int aoff = lds_byte(wr * 64 + fr, fq * 8), boff = lds_byte(wc * 32 + fr, fq * 8);
#define PG8_SA(b, h) (((b) * 2 + (h)) * HTB)
#define PG8_SB(b, h) ((4 + (b) * 2 + (h)) * HTB)
#define PG8_STAGE(bufoff, gbase, voff) do { _Pragma("unroll") for (int _i = 0; _i < 2; ++_i) \
        __builtin_amdgcn_global_load_lds((const unsigned*)((const char*)(gbase) + (voff)[_i]), (PG8_LAS unsigned*)(lds + (bufoff) + ldsw + _i * 8192), 16, 0, 0); } while (0)
#define PG8_LDA(dst, b, h) do { _Pragma("unroll") for (int m = 0; m < 4; ++m) _Pragma("unroll") for (int k = 0; k < 2; ++k) dst[m][k] = *(const PG8_LAS bf16x8*)(lds + PG8_SA(b, h) + aoff + m * 2048 + k * 1024); } while (0)
#define PG8_LDB(dst, b, h) do { _Pragma("unroll") for (int n = 0; n < 2; ++n) _Pragma("unroll") for (int k = 0; k < 2; ++k) dst[n][k] = *(const PG8_LAS bf16x8*)(lds + PG8_SB(b, h) + boff + n * 2048 + k * 1024); } while (0)
#define PG8_MMA(ai, bj, At, Bt) do { __builtin_amdgcn_s_setprio(1); _Pragma("unroll") for (int m = 0; m < 4; ++m) _Pragma("unroll") for (int n = 0; n < 2; ++n) _Pragma("unroll") for (int k = 0; k < 2; ++k) \
        acc[ai][bj][m][n] = __builtin_amdgcn_mfma_f32_16x16x32_bf16(Bt[n][k], At[m][k], acc[ai][bj][m][n], 0, 0, 0); __builtin_amdgcn_s_setprio(0); } while (0)
#define PG8_WAIT_V(n) asm volatile("s_waitcnt vmcnt(" #n ")" ::: "memory")
#define PG8_WAIT_L(n) asm volatile("s_waitcnt lgkmcnt(" #n ")" ::: "memory")
#define PG8_BAR __builtin_amdgcn_s_barrier()
#define PG8_SCHED __builtin_amdgcn_sched_barrier(0)
    Unit cur, nxt; int ui = 0;
    if (!S.next(0, cur)) return;
    f32x4 acc[2][2][4][2];
#pragma unroll
    for (int a = 0; a < 2; ++a)
#pragma unroll
        for (int b = 0; b < 2; ++b)
#pragma unroll
            for (int m = 0; m < 4; ++m)
#pragma unroll
                for (int n = 0; n < 2; ++n) acc[a][b][m][n] = (f32x4){0.f, 0.f, 0.f, 0.f};
    bf16x8 At[4][2], B0[2][2], B1[2][2];
    const char* cA = (const char*)(cur.sel ? g.A1 : g.A) + (size_t)cur.pm * tstep; const char* cB = (const char*)(cur.sel ? g.Bt1 : g.Bt) + (size_t)cur.pn * tstep;
    S.a_ready(cur);
    if constexpr (SP2) {
        PG8_STAGE(PG8_SB(0, 0), cB, voffB); PG8_STAGE(PG8_SB(0, 1), cB + hstep, voffB); PG8_STAGE(PG8_SA(0, 0), cA, voffA); PG8_STAGE(PG8_SA(0, 1), cA + hstep, voffA);
        if (wr == 1) PG8_BAR;
        PG8_WAIT_V(2); PG8_BAR;
        PG8_STAGE(PG8_SB(1, 0), cB + kstep, voffB); PG8_STAGE(PG8_SA(1, 0), cA + kstep, voffA); PG8_STAGE(PG8_SB(1, 1), cB + hstep + kstep, voffB);
        PG8_WAIT_V(6); PG8_BAR;
    } else {
        PG8_STAGE(PG8_SB(0, 0), cB, voffB); PG8_STAGE(PG8_SA(0, 0), cA, voffA); PG8_STAGE(PG8_SB(0, 1), cB + hstep, voffB); PG8_STAGE(PG8_SA(0, 1), cA + hstep, voffA);
        if (wr == 1) PG8_BAR;
        PG8_WAIT_V(4); PG8_BAR;
        PG8_STAGE(PG8_SB(1, 0), cB + kstep, voffB); PG8_STAGE(PG8_SA(1, 0), cA + kstep, voffA); PG8_STAGE(PG8_SB(1, 1), cB + hstep + kstep, voffB);
        PG8_WAIT_V(6); PG8_BAR;
    }
    for (;;) {
        const bool has_next = S.next(ui + 1, nxt);
        const char* nA = has_next ? (const char*)(nxt.sel ? g.A1 : g.A) + (size_t)nxt.pm * tstep : cA; const char* nB = has_next ? (const char*)(nxt.sel ? g.Bt1 : g.Bt) + (size_t)nxt.pn * tstep : cB;
        for (int t = 0; t < nt; t += 2) {
            const bool last = (t == nt - 2);
            const char* a1 = cA + (size_t)(t + 1) * kstep;
            const char* a2 = last ? nA : cA + (size_t)(t + 2) * kstep; const char* b2 = last ? nB : cB + (size_t)(t + 2) * kstep;
            const char* a3 = a2 + kstep; const char* b3 = b2 + kstep;
            if (last && has_next) S.a_ready(nxt);
            if constexpr (SP2) {
            PG8_LDB(B0, 0, 0); PG8_LDB(B1, 0, 1); PG8_SCHED; PG8_LDA(At, 0, 0); PG8_STAGE(PG8_SA(1, 1), a1 + hstep, voffA);
            PG8_WAIT_V(8); PG8_WAIT_L(0); PG8_BAR; PG8_MMA(0, 0, At, B0); PG8_MMA(0, 1, At, B1); PG8_BAR; PG8_SCHED;
            PG8_LDA(At, 0, 1); PG8_STAGE(PG8_SB(0, 0), b2, voffB); PG8_STAGE(PG8_SB(0, 1), b2 + hstep, voffB); PG8_STAGE(PG8_SA(0, 0), a2, voffA);
            PG8_WAIT_V(8); PG8_WAIT_L(0); PG8_BAR; PG8_MMA(1, 0, At, B0); PG8_MMA(1, 1, At, B1); PG8_BAR; PG8_SCHED;
            PG8_LDB(B0, 1, 0); PG8_LDB(B1, 1, 1); PG8_SCHED; PG8_LDA(At, 1, 0); PG8_STAGE(PG8_SA(0, 1), a2 + hstep, voffA);
            PG8_WAIT_V(8); PG8_WAIT_L(0); PG8_BAR; PG8_MMA(0, 0, At, B0); PG8_MMA(0, 1, At, B1); PG8_BAR; PG8_SCHED;
            PG8_LDA(At, 1, 1); PG8_STAGE(PG8_SB(1, 0), b3, voffB); PG8_STAGE(PG8_SB(1, 1), b3 + hstep, voffB); PG8_STAGE(PG8_SA(1, 0), a3, voffA);
            PG8_WAIT_V(8); PG8_WAIT_L(0); PG8_BAR; PG8_MMA(1, 0, At, B0); PG8_MMA(1, 1, At, B1); PG8_BAR; PG8_SCHED;
            } else {
            PG8_LDB(B0, 0, 0); PG8_SCHED; PG8_LDA(At, 0, 0); PG8_STAGE(PG8_SA(1, 1), a1 + hstep, voffA);
            PG8_WAIT_L(8); PG8_BAR; PG8_WAIT_L(0); PG8_MMA(0, 0, At, B0); PG8_BAR; PG8_SCHED;
            PG8_LDB(B1, 0, 1); PG8_STAGE(PG8_SB(0, 0), b2, voffB);
            PG8_BAR; PG8_WAIT_L(0); PG8_MMA(0, 1, At, B1); PG8_BAR;
            PG8_LDA(At, 0, 1); PG8_STAGE(PG8_SA(0, 0), a2, voffA);
            PG8_BAR; PG8_WAIT_L(0); PG8_MMA(1, 0, At, B0); PG8_BAR; PG8_SCHED;
            PG8_STAGE(PG8_SB(0, 1), b2 + hstep, voffB);
            PG8_WAIT_V(6); PG8_BAR; PG8_MMA(1, 1, At, B1); PG8_BAR;
            PG8_LDB(B0, 1, 0); PG8_SCHED; PG8_LDA(At, 1, 0); PG8_STAGE(PG8_SA(0, 1), a2 + hstep, voffA);
            PG8_WAIT_L(8); PG8_BAR; PG8_WAIT_L(0); PG8_MMA(0, 0, At, B0); PG8_BAR; PG8_SCHED;
            PG8_LDB(B1, 1, 1); PG8_STAGE(PG8_SB(1, 0), b3, voffB);
            PG8_BAR; PG8_WAIT_L(0); PG8_MMA(0, 1, At, B1); PG8_BAR;
            PG8_LDA(At, 1, 1); PG8_STAGE(PG8_SA(1, 0), a3, voffA);
            PG8_BAR; PG8_WAIT_L(0); PG8_MMA(1, 0, At, B0); PG8_BAR; PG8_SCHED;
            PG8_STAGE(PG8_SB(1, 1), b3 + hstep, voffB);
            PG8_WAIT_V(6); PG8_BAR; PG8_MMA(1, 1, At, B1); PG8_BAR;
            }
        }
        if constexpr (ALIGN_EPI) { if (wr == 0) PG8_BAR; }
        if constexpr (!Epi::AFTER_DRAIN) { E(acc, cur, wr, wc, fr, fq); S.done(cur); }
        if (!has_next) break;
        if (!E.keep(cur)) zero_acc(acc);
        cur = nxt; cA = nA; cB = nB; ++ui;
        if constexpr (ALIGN_EPI) { if (wr == 1) PG8_BAR; }
    }
    PG8_WAIT_V(0);
    if constexpr (!ALIGN_EPI) { if (wr == 0) PG8_BAR; }
    PG8_BAR;
    if constexpr (Epi::AFTER_DRAIN) { E.fused(acc, cur, wr, wc, fr, fq, lds, wid, lane); S.done(cur); }
#undef PG8_SA
#undef PG8_SB
#undef PG8_STAGE
#undef PG8_LDA
#undef PG8_LDB
#undef PG8_MMA
#undef PG8_WAIT_V
#undef PG8_WAIT_L
#undef PG8_BAR
#undef PG8_SCHED
}}

constexpr int NWAVES = 8;
constexpr int DM = 1024, MTOK = 32768, TP = 16384  , LP = 2048, LS = 16384;
constexpr int HW = 512, INW = 4352, FFN = 2816, NPROJ = INW - 3 * HW  ;
constexpr float RMS_EPS = 1e-6f;

constexpr size_t MiB = 1u << 20;
constexpr size_t WS_CTL = 0, CTL_ZERO_BYTES = 1 * MiB;
constexpr size_t WS_WINA = 1 * MiB;
constexpr size_t WS_WINB = 4 * MiB;
constexpr size_t WS_WHY = 10 * MiB;
constexpr size_t WS_WAT = 11 * MiB;
constexpr size_t WS_WO = 12 * MiB;
constexpr size_t WS_WGU = 14 * MiB;
constexpr size_t WS_WD = 25 * MiB;
constexpr size_t WS_W3T = 31 * MiB;
constexpr size_t WS_XB = 32 * MiB;
constexpr size_t WS_YT = 32 * MiB;
constexpr size_t WS_YAT = 64 * MiB;
constexpr size_t WS_KREV_S = 96 * MiB;
constexpr size_t WS_KREV_P = 160 * MiB;
constexpr size_t WS_UT = 168 * MiB;
constexpr size_t WS_Q = 264 * MiB;
constexpr size_t WS_K = 296 * MiB;
constexpr size_t WS_V = 304 * MiB;
constexpr size_t WS_SGH = 312 * MiB;
constexpr size_t WS_SGA = 376 * MiB;
constexpr size_t WS_COS = 440 * MiB;
constexpr size_t WS_SIN = 442 * MiB;
constexpr size_t WS_RSTD = 444 * MiB;
constexpr size_t WS_SSQ = 445 * MiB;
constexpr size_t WS_FPART_S = 447 * MiB;
constexpr size_t WS_FPART_P = 449 * MiB;
constexpr size_t WS_YHY = 450 * MiB;
constexpr size_t WS_MERGED = 168 * MiB;
constexpr size_t WS_X1B = 232 * MiB;
constexpr size_t WS_HID = 32 * MiB;
constexpr size_t WS_HS = 450 * MiB;
constexpr size_t WS_Z1S = 488 * MiB;
constexpr size_t WS_END = 496 * MiB;
static_assert(WS_HID + (size_t)MTOK * FFN * 2 <= WS_X1B, "hid vs x1b");

constexpr int CW_TMO = 0, CW_CODE = 1;
constexpr int CW_BAR = 4096;

constexpr int RING_OFF = 0;
constexpr int LDS_BYTES = 147456;
constexpr int LDSCTL_OFF = LDS_BYTES - 512, MISC_OFF = LDSCTL_OFF + 320;

#define GAS __attribute__((address_space(1)))
#define LAS __attribute__((address_space(3)))
typedef unsigned short bf16;
typedef unsigned v4u __attribute__((ext_vector_type(4)));
typedef unsigned v2u __attribute__((ext_vector_type(2)));
typedef float f32x4 __attribute__((ext_vector_type(4)));
typedef float f32x16 __attribute__((ext_vector_type(16)));
typedef short bf16x8 __attribute__((ext_vector_type(8)));
typedef GAS unsigned gu32;
#define RLX_AGENT __ATOMIC_RELAXED, __HIP_MEMORY_SCOPE_AGENT
#define LDS_WAIT() asm volatile("s_waitcnt lgkmcnt(0)" ::: "memory")
#define VM_WAIT() asm volatile("s_waitcnt vmcnt(0)" ::: "memory")
typedef float f32x2_t_ __attribute__((ext_vector_type(2))); typedef __bf16 bf16x2_t_ __attribute__((ext_vector_type(2)));
__device__ __forceinline__ unsigned pk2(float lo, float hi) { const f32x2_t_ v = {lo, hi}; return __builtin_bit_cast(unsigned, __builtin_convertvector(v, bf16x2_t_)); }
__device__ __forceinline__ unsigned f2bf(float f) { return (unsigned)__builtin_bit_cast(unsigned short, (__bf16)f); }
__device__ __forceinline__ float bf2f(unsigned short b) { return __uint_as_float((unsigned)b << 16); }
__device__ __forceinline__ float wave_sum(float v) {
#pragma unroll
    for (int o = 1; o < 64; o <<= 1) v += __shfl_xor(v, o);
    return v;
}

__device__ __forceinline__ float wave_sum_sw(float v) {
#define SWZ_(x, m) __builtin_bit_cast(float, __builtin_amdgcn_ds_swizzle(__builtin_bit_cast(int, (x)), (((m) << 10) | 0x1f)))
    v += SWZ_(v, 1); v += SWZ_(v, 2); v += SWZ_(v, 4); v += SWZ_(v, 8); v += SWZ_(v, 16);
#undef SWZ_
    return __builtin_bit_cast(float, __builtin_amdgcn_readlane(__builtin_bit_cast(int, v), 0)) + __builtin_bit_cast(float, __builtin_amdgcn_readlane(__builtin_bit_cast(int, v), 32));
}

#define XB_TMO      128
#define XB_XCNT(j)  (256  + 64 * (j))
#define XB_XSUB(j)  (1280 + 64 * (j))
#define XB_XGEN(j)  (2304 + 64 * (j))
#define XB_TOP      3328
#define XB_TOPGEN   3392
#define XCD_BAR_WORDS 3456
#define XB_SPIN_CAP (1u << 18)

__device__ __forceinline__ unsigned xb_ld(unsigned* p)              { return __hip_atomic_load(p, __ATOMIC_RELAXED, __HIP_MEMORY_SCOPE_AGENT); }
__device__ __forceinline__ unsigned xb_add(unsigned* p, unsigned v) { return __hip_atomic_fetch_add(p, v, __ATOMIC_RELAXED, __HIP_MEMORY_SCOPE_AGENT); }
__device__ __forceinline__ unsigned xb_xcc_id() { return (unsigned)__builtin_amdgcn_s_getreg((3 << 11) | 20) & 0xFu; }
#define XB_SPIN(cond, bar) do { unsigned _sp = 0; while (cond) { __builtin_amdgcn_s_sleep(1); \
    if ((++_sp & 255u) == 0u) { if (xb_ld(&(bar)[XB_TMO])) break; if (_sp > XB_SPIN_CAP) { atomicAdd(&(bar)[XB_TMO], 1u); break; } } } } while (0)

struct XcdBarrier { unsigned* bar; unsigned x; volatile LAS unsigned* st; };

__device__ __forceinline__ XcdBarrier xcd_barrier_post(unsigned* bar, volatile LAS unsigned* st) {
    XcdBarrier b; b.bar = bar; b.x = xb_xcc_id(); b.st = st;
    if (threadIdx.x == 0) (void)xb_add(&bar[XB_XCNT(b.x)], 1u);
    return b;
}
__device__ __forceinline__ void xcd_barrier_complete(unsigned* bar, unsigned x, unsigned& nloc, unsigned& nx) {
    const unsigned G = gridDim.x * gridDim.y * gridDim.z;
    unsigned sum, cnt, mine, sp = 0u;
    for (;;) {
        sum = 0u; cnt = 0u; mine = 0u;
#pragma unroll
        for (unsigned j = 0; j < 16; ++j) { const unsigned c = xb_ld(&bar[XB_XCNT(j)]); sum += c; cnt += (c > 0u) ? 1u : 0u; mine = (j == x) ? c : mine; }
        if (sum == G) break;
        __builtin_amdgcn_s_sleep(1);
        if ((++sp & 255u) == 0u) { if (xb_ld(&bar[XB_TMO])) break; if (sp > XB_SPIN_CAP) { atomicAdd(&bar[XB_TMO], 1u); break; } }
    }
    nloc = mine > 0u ? mine : 1u; nx = cnt > 0u ? cnt : 1u;
}
__device__ __forceinline__ void xcd_barrier(const XcdBarrier& b) {
    asm volatile("s_waitcnt vmcnt(0)" ::: "memory");
    __syncthreads();
    if (threadIdx.x == 0) {
        unsigned* bar = b.bar;
        __builtin_amdgcn_s_waitcnt(0);
        unsigned nloc = b.st[0], nx = b.st[1];
        if (nloc == 0u) { xcd_barrier_complete(bar, b.x, nloc, nx); b.st[0] = nloc; b.st[1] = nx; }
        const unsigned old = xb_add(&bar[XB_XSUB(b.x)], 1u);
        const unsigned gen = old / nloc;
        if (old + 1u == (gen + 1u) * nloc) {
            __builtin_amdgcn_fence(__ATOMIC_RELEASE, "agent");
            asm volatile("s_waitcnt vmcnt(0)" ::: "memory");
            const unsigned og = xb_add(&bar[XB_TOP], 1u);
            const unsigned tg = og / nx;
            if (og + 1u == (tg + 1u) * nx) xb_add(&bar[XB_TOPGEN], 1u);
            else XB_SPIN(xb_ld(&bar[XB_TOPGEN]) == tg, bar);
            __builtin_amdgcn_fence(__ATOMIC_ACQUIRE, "agent");
            xb_add(&bar[XB_XGEN(b.x)], 1u);
            asm volatile("s_waitcnt vmcnt(0)" ::: "memory");
        } else {
            XB_SPIN(xb_ld(&bar[XB_XGEN(b.x)]) == gen, bar);
            __builtin_amdgcn_fence(__ATOMIC_ACQUIRE, "agent");
            asm volatile("s_waitcnt vmcnt(0)" ::: "memory");
        }
    }
    __syncthreads();
}

struct Frame {
    LAS unsigned char* lds;
    volatile LAS unsigned* MISC;
    gu32* ctl;
    int tid, lane, wave;
    int vcu, G;
    unsigned char* ws;
};

__device__ __forceinline__ void p0_transpose_item(const float* W, int K, int N, bf16* WT, int dst_row0, const float* kscale, LAS float* scr, int k0, int n0, int lane) {
#pragma unroll 8
    for (int i = 0; i < 32; ++i) { const int kk = 2 * i + (lane >> 5); float v = W[(size_t)(k0 + kk) * N + n0 + (lane & 31)]; if (kscale) v *= kscale[k0 + kk]; scr[kk * 33 + (lane & 31)] = v; }
    LDS_WAIT(); asm volatile("" ::: "memory");
    const int c = lane & 7;
#pragma unroll
    for (int j = 0; j < 4; ++j) { const int n = (lane >> 3) + 8 * j; const LAS float* s = scr + (8 * c) * 33 + n;
        v4u o; o.x = pk2(s[0 * 33], s[1 * 33]); o.y = pk2(s[2 * 33], s[3 * 33]); o.z = pk2(s[4 * 33], s[5 * 33]); o.w = pk2(s[6 * 33], s[7 * 33]);
        *(GAS v4u*)(WT + (size_t)(dst_row0 + n) * K + k0 + 8 * c) = o; }
    LDS_WAIT(); asm volatile("" ::: "memory");
}
__device__ __forceinline__ int map_projB(int n0) {
    if (n0 < 2048) { const int t = n0 - 1536, hq = t >> 6, hf = (t >> 5) & 1; return 256 * (hq >> 2) + 128 * hf + 32 * (hq & 3); }
    if (n0 < 2176) { const int t = n0 - 2048, kh = t >> 6, hf = (t >> 5) & 1; return 512 + 128 * hf + 32 * kh; }
    if (n0 < 2304) { const int t = n0 - 2176, vh = t >> 6, hf = (t >> 5) & 1; return 512 + 128 * hf + 32 * (2 + vh); }
    return 768 + (n0 - 2304);
}
__device__ __forceinline__ void p0_row(const float* xrow, bf16* orow, float* rstd_out, int lane) {
    const GAS f32x4* xr = (const GAS f32x4*)xrow + lane;
    f32x4 v[4]; float s = 0.f;
#pragma unroll
    for (int j = 0; j < 4; ++j) { v[j] = xr[64 * j]; s += (v[j].x * v[j].x + v[j].y * v[j].y) + (v[j].z * v[j].z + v[j].w * v[j].w); }
    s = wave_sum(s);
    if (lane == 0) *rstd_out = 1.0f / sqrtf(s * (1.0f / DM) + RMS_EPS);
    GAS unsigned long long* o8 = (GAS unsigned long long*)orow + lane;
#pragma unroll
    for (int j = 0; j < 4; ++j) o8[64 * j] = (unsigned long long)pk2(v[j].x, v[j].y) | ((unsigned long long)pk2(v[j].z, v[j].w) << 32);
}
constexpr int FW_W1 = 0, FW_W2 = 33 * 64 * 4, FW_B1 = FW_W2 + 64 * 64 * 4, FW_B2 = FW_B1 + 256, FW_FR = FW_B2 + 256, FW_END = FW_FR + 256, FT_PITCH = 144, FT_BYTES = 32 * FT_PITCH;
__device__ __forceinline__ void filter_stage_weights(LAS unsigned char* lds, const float* w1, const float* b1, const float* w2, const float* b2, const float* fr, int tid) {
    LAS float* W1 = (LAS float*)(lds + FW_W1); LAS float* W2 = (LAS float*)(lds + FW_W2);
    for (int i = tid; i < 33 * 64; i += NWAVES * 64) W1[i] = w1[i];
    for (int i = tid; i < 64 * 64; i += NWAVES * 64) W2[i] = w2[i];
    if (tid < 64) { ((LAS float*)(lds + FW_B1))[tid] = b1[tid]; ((LAS float*)(lds + FW_B2))[tid] = b2[tid]; ((LAS float*)(lds + FW_FR))[tid] = fr[tid]; }
    LDS_WAIT(); __syncthreads();
}
__device__ __forceinline__ void filter_mlp_half(LAS unsigned char* lds, int L, int chunk, int hf, int dir, int r, int h, LAS float* Hb, bf16x8 (&afr)[4]) {
    const LAS float* W1 = (const LAS float*)(lds + FW_W1); const LAS float* W2 = (const LAS float*)(lds + FW_W2);
    const LAS float* B1 = (const LAS float*)(lds + FW_B1); const LAS float* B2 = (const LAS float*)(lds + FW_B2); const LAS float* FR = (const LAS float*)(lds + FW_FR);
        int pos = 64 * chunk + 32 * hf + r + dir; if (pos > L - 1) pos = L - 1;
        const float t = (float)pos / (float)(L - 1);
        float a[32];
#pragma unroll
        for (int jj = 0; jj < 32; ++jj) a[jj] = B1[32 * h + jj];
        {
#pragma unroll
            for (int jj = 0; jj < 32; jj += 4) { const f32x4 w = *(const LAS f32x4*)(W1 + 32 * h + jj); a[jj] += t * w[0]; a[jj + 1] += t * w[1]; a[jj + 2] += t * w[2]; a[jj + 3] += t * w[3]; }
#pragma unroll 1
            for (int i = 0; i < 16; ++i) {
                const float band = 1e-4f + (float)i * ((15.0f - 1e-4f) / 15.0f); const float ang = (6.283185307179586f / (float)L) * (float)pos * band;
                const float cv = __cosf(ang), sv = -__sinf(ang);
                const LAS float* wc = W1 + (1 + i) * 64 + 32 * h; const LAS float* wsn = W1 + (17 + i) * 64 + 32 * h;
#pragma unroll
                for (int jj = 0; jj < 32; jj += 4) { const f32x4 w = *(const LAS f32x4*)(wc + jj), v = *(const LAS f32x4*)(wsn + jj);
                    a[jj] += cv * w[0] + sv * v[0]; a[jj + 1] += cv * w[1] + sv * v[1]; a[jj + 2] += cv * w[2] + sv * v[2]; a[jj + 3] += cv * w[3] + sv * v[3]; }
            }
        }
#pragma unroll
        for (int jj = 0; jj < 32; ++jj) Hb[(32 * h + jj) * 32 + r] = __sinf(FR[32 * h + jj] * a[jj]);
        LDS_WAIT(); asm volatile("" ::: "memory");
#pragma unroll
        for (int jj = 0; jj < 32; ++jj) a[jj] = B2[32 * h + jj];
#pragma unroll 1
        for (int i = 0; i < 64; ++i) { const float hv = Hb[i * 32 + r]; const LAS float* wr_ = W2 + i * 64 + 32 * h;
#pragma unroll
            for (int jj = 0; jj < 32; jj += 4) { const f32x4 w = *(const LAS f32x4*)(wr_ + jj); a[jj] += hv * w[0]; a[jj + 1] += hv * w[1]; a[jj + 2] += hv * w[2]; a[jj + 3] += hv * w[3]; } }
        LDS_WAIT(); asm volatile("" ::: "memory");
        unsigned op[16], pp[16];
#pragma unroll
        for (int d = 0; d < 16; ++d) op[d] = pk2(__sinf(FR[32 * h + 2 * d] * a[2 * d]), __sinf(FR[32 * h + 2 * d + 1] * a[2 * d + 1]));
#pragma unroll
        for (int d = 0; d < 16; ++d) pp[d] = __shfl_xor(op[d], 32);
#pragma unroll
        for (int ks = 0; ks < 4; ++ks) { v4u f;
#pragma unroll
            for (int w = 0; w < 4; ++w) { const unsigned own = h ? op[8 * (ks & 1) + 4 + w] : op[8 * (ks & 1) + w], par = h ? pp[8 * (ks & 1) + 4 + w] : pp[8 * (ks & 1) + w];
                f[w] = ((ks >> 1) == h) ? own : par; }
            afr[ks] = __builtin_bit_cast(bf16x8, f); }
}
__device__ __forceinline__ void filter_item(LAS unsigned char* lds, const bf16* w3T, bf16* krev, float* fpart, int g, int chunk, int dir, int wave, int lane_) {
    int lane = lane_; asm volatile("" : "+v"(lane));
    const int L = g ? LS : LP, r = lane & 31, h = lane >> 5;
    const LAS float* W1 = (const LAS float*)(lds + FW_W1); const LAS float* W2 = (const LAS float*)(lds + FW_W2);
    const LAS float* B1 = (const LAS float*)(lds + FW_B1); const LAS float* B2 = (const LAS float*)(lds + FW_B2); const LAS float* FR = (const LAS float*)(lds + FW_FR);
    LAS unsigned char* T = lds + FW_END + wave * FT_BYTES; LAS float* Hb = (LAS float*)(lds + FW_END + NWAVES * FT_BYTES + wave * 8192);
    bf16x8 afr0[4], afr1[4];
    filter_mlp_half(lds, L, chunk, 0, dir, r, h, Hb, afr0);
    filter_mlp_half(lds, L, chunk, 1, dir, r, h, Hb, afr1);
    const float dmin = -4.605170185988091f / 1.5f, dmax = -4.605170185988091f / 0.3f;
    const int p0 = 64 * chunk; const int mstart = g ? (dir ? (2 * L - p0 - 64) : p0) : (dir ? (L + p0) : (L - 64 - p0));
    for (int ti = 0; ti < 32; ++ti) {
        const int o_ = ti >> 4, cb = 32 * (ti & 15), colg = (2 * o_ + dir) * 512 + cb;
        bf16x8 bfr[4];
#pragma unroll
        for (int ks = 0; ks < 4; ++ks) bfr[ks] = *(const GAS bf16x8*)(w3T + (size_t)(colg + r) * 64 + 16 * ks + 8 * h);
        const float delta = fabsf(dmin + (float)(cb + r) * ((dmax - dmin) / 511.0f));
        float asum = 0.f;
#pragma unroll
        for (int hf = 0; hf < 2; ++hf) {
            f32x16 acc = (f32x16){0.f,0.f,0.f,0.f,0.f,0.f,0.f,0.f,0.f,0.f,0.f,0.f,0.f,0.f,0.f,0.f};
#pragma unroll
            for (int ks = 0; ks < 4; ++ks) acc = __builtin_amdgcn_mfma_f32_32x32x16_bf16(hf ? afr1[ks] : afr0[ks], bfr[ks], acc, 0, 0, 0);
#pragma unroll
            for (int rg = 0; rg < 16; ++rg) {
                const int i = 32 * hf + (rg & 3) + 8 * (rg >> 2) + 4 * h; const int pos = p0 + i + dir;
                const float t = (float)pos / (float)(L - 1);
                float kv = acc[rg] * (__expf(-t * delta) + 0.05f); if (pos > L - 1) kv = 0.f;
                asum += fabsf(kv);
                const int e = ((dir != 0) != (g != 0)) ? i : 63 - i;
                *(LAS bf16*)(T + r * FT_PITCH + e * 2) = (bf16)f2bf(kv);
            }
        }
        asum += __shfl_xor(asum, 32);
        if (h == 0) fpart[(size_t)chunk * 2048 + colg + r] = asum;
        LDS_WAIT(); asm volatile("" ::: "memory");
        {
            const int col = lane >> 1, hb = lane & 1;
            bf16* dst = krev + (size_t)(o_ * 512 + cb + col) * (2 * L) + mstart + 32 * hb;
            const LAS v4u* src = (const LAS v4u*)(T + col * FT_PITCH + 64 * hb);
#pragma unroll
            for (int q = 0; q < 4; ++q) *(GAS v4u*)(dst + 8 * q) = src[q];
        }
        LDS_WAIT(); asm volatile("" ::: "memory");
    }
}

namespace hy {
constexpr int SLOTB = 272, Z_BYTES = 75776, F_OFF = 75776, F_BYTES = 65536, RED_OFF = F_OFF + F_BYTES;
__device__ __forceinline__ int slot_of(int g, int n) { return g ? (n + 31) : ((n >> 4) * 32 + 16 + (n & 15)); }
__device__ __forceinline__ int crow(int r, int hi) { return (r & 3) + 8 * (r >> 2) + 4 * hi; }

struct Params { const bf16* uT; const bf16* krev_s; const bf16* krev_p; const float* fpart_s; const float* fpart_p; const float* conv_w; const float* conv_b; const float* hbias; bf16* yT; float* dF; bf16* dZ; };

__device__ __forceinline__ void conv3_chunk(const bf16* urow  , int g, int chunk, float w0, float w1, float w2, float b, float (&out)[8]) {
    const int tau0 = chunk * 8; const int L = g ? LS : LP; const int p0 = g ? tau0 : (tau0 & (LP - 1));
    const v4u raw = *(const GAS v4u*)(urow + tau0);
    float u[10];
    u[1] = pg8::bflo(raw.x); u[2] = pg8::bfhi(raw.x); u[3] = pg8::bflo(raw.y); u[4] = pg8::bfhi(raw.y); u[5] = pg8::bflo(raw.z); u[6] = pg8::bfhi(raw.z); u[7] = pg8::bflo(raw.w); u[8] = pg8::bfhi(raw.w);
    u[0] = (p0 > 0) ? bf2f(urow[tau0 - 1]) : 0.f;
    u[9] = (p0 + 8 < L) ? bf2f(urow[tau0 + 8]) : 0.f;
#pragma unroll
    for (int i = 0; i < 8; ++i) out[i] = w0 * u[i] + w1 * u[i + 1] + w2 * u[i + 2] + b;
}

struct C3 { v4u raw; float prev, next; };
__device__ __forceinline__ void conv3_load(const bf16* urow, int g, int chunk, C3& q) {
    const int tau0 = chunk * 8; const int L = g ? LS : LP; const int p0 = g ? tau0 : (tau0 & (LP - 1));
    q.raw = *(const GAS v4u*)(urow + tau0);
    q.prev = (p0 > 0) ? bf2f(urow[tau0 - 1]) : 0.f;
    q.next = (p0 + 8 < L) ? bf2f(urow[tau0 + 8]) : 0.f;
}
__device__ __forceinline__ void conv3_eval(const C3& q, float w0, float w1, float w2, float b, float (&out)[8]) {
    float u[10];
    u[0] = q.prev; u[9] = q.next;
    u[1] = pg8::bflo(q.raw.x); u[2] = pg8::bfhi(q.raw.x); u[3] = pg8::bflo(q.raw.y); u[4] = pg8::bfhi(q.raw.y); u[5] = pg8::bflo(q.raw.z); u[6] = pg8::bfhi(q.raw.z); u[7] = pg8::bflo(q.raw.w); u[8] = pg8::bfhi(q.raw.w);
#pragma unroll
    for (int i = 0; i < 8; ++i) out[i] = w0 * u[i] + w1 * u[i + 1] + w2 * u[i + 2] + b;
}

__device__ __forceinline__ bf16x8 load_afrag(LAS const unsigned char* lds, int addr, int sh) {
    const LAS unsigned* p = (const LAS unsigned*)(lds + addr);
    const unsigned w0 = p[0], w1 = p[1], w2 = p[2], w3 = p[3], w4 = p[4];
    v4u f; f.x = __builtin_amdgcn_alignbit(w1, w0, sh); f.y = __builtin_amdgcn_alignbit(w2, w1, sh); f.z = __builtin_amdgcn_alignbit(w3, w2, sh); f.w = __builtin_amdgcn_alignbit(w4, w3, sh);
    return __builtin_bit_cast(bf16x8, f);
}

__device__ __forceinline__ void hyena_item(LAS unsigned char* lds, const Params& P, int g, int c, int tid_) {
    int tid = tid_; asm volatile("" : "+v"(tid));
    const int lane = tid & 63, wave = __builtin_amdgcn_readfirstlane(tid >> 6), r = lane & 31, hi = lane >> 5, nt = wave & 3, half = wave >> 2;
    const int L = g ? LS : LP; const int T0 = g ? TP : 0;
#if PROBE >= 41 && PROBE <= 46
    unsigned long long tp_ = __builtin_amdgcn_s_memrealtime();
#define HY_SEC(k) do { const unsigned long long tn_ = __builtin_amdgcn_s_memrealtime(); if (blockIdx.x == 0 && tid == 0) ((volatile LAS unsigned*)(lds + MISC_OFF))[40 + (k)] += (unsigned)(tn_ - tp_); tp_ = tn_; } while (0)
#else
#define HY_SEC(k) do { } while (0)
#endif
    float inv_norm0, inv_norm1;
    {
        const int nchunk = g ? 256 : 32; const float* fp = P.fpart_s + (g ? (size_t)0 : (size_t)((WS_FPART_P - WS_FPART_S) / 4));
        float s0 = 0.f, s1 = 0.f;
        for (int idx = lane; idx < nchunk * 2; idx += 64) { const int ch = idx >> 1, dir = idx & 1; s0 += fp[(size_t)ch * 2048 + dir * 512 + c]; s1 += fp[(size_t)ch * 2048 + 1024 + dir * 512 + c]; }
        inv_norm0 = 1.0f / wave_sum_sw(s0); inv_norm1 = 1.0f / wave_sum_sw(s1);
        for (int i = tid; i < Z_BYTES / 16; i += NWAVES * 64) *(LAS v4u*)(lds + i * 16) = (v4u){0u, 0u, 0u, 0u};
        LDS_WAIT(); __syncthreads();
    }
    {
        const int ch = 2 * HW + c; const float w0 = P.conv_w[ch], w1 = P.conv_w[3 * HW + ch], w2 = P.conv_w[6 * HW + ch], b = P.conv_b[ch];
        const bf16* urow = P.uT + (size_t)ch * MTOK + T0;
        for (int it = 0; it < 4; ++it) { const int chunk = tid + it * 512; float o[8]; conv3_chunk(urow, g, chunk, w0, w1, w2, b, o);
            const int tau0 = chunk * 8; v4u pk; pk.x = pk2(o[0], o[1]); pk.y = pk2(o[2], o[3]); pk.z = pk2(o[4], o[5]); pk.w = pk2(o[6], o[7]);
            *(LAS v4u*)(lds + slot_of(g, tau0 >> 7) * SLOTB + (tau0 & 127) * 2) = pk; }
    }
    HY_SEC(0);
    int d_hi, d_lo;
    if (g) { if (half == 0) { d_hi = 32 * nt + 31; d_lo = 32 * nt - 48; } else { d_hi = 32 * nt - 49; d_lo = 32 * nt - 127; } }
    else   {
             const int a = nt & 1, dmax = a ? 15 : 7, dmin = a ? -7 : -15;
             if (half == 0) { d_hi = dmax; d_lo = dmax - 11; } else { d_hi = dmax - 12; d_lo = dmin; } }
    const int ncol = g ? (32 * nt + r) : (16 * (4 * (nt >> 1) + (r >> 3)) + 8 * (nt & 1) + (r & 7));
    int abase = F_OFF + 2 * ((L - 1) - r + 8 * hi); const int sh = (abase & 2) ? 16 : 0; abase &= ~3;
    const int zb = slot_of(g, ncol) * SLOTB + 16 * hi;
    const int mi0 = 2 * half;

    for (int o = 0; o < 2; ++o) {
        {
            const bf16* ksrc = P.krev_s + (g ? (size_t)0 : (size_t)((WS_KREV_P - WS_KREV_S) / 2)) + (size_t)(o * HW + c) * (2 * L);
            const int n16 = (2 * L * 2) / 16;
            for (int i = tid; i < n16; i += NWAVES * 64) *(LAS v4u*)(lds + F_OFF + i * 16) = *(const GAS v4u*)(ksrc + i * 8);
        }
        LDS_WAIT(); __syncthreads();
        HY_SEC(1);
        f32x16 acc[4];
#pragma unroll
        for (int mi = 0; mi < 4; ++mi) acc[mi] = (f32x16){0.f,0.f,0.f,0.f,0.f,0.f,0.f,0.f,0.f,0.f,0.f,0.f,0.f,0.f,0.f,0.f};
        bf16x8 Fw[8];
        {
            const int q0 = -8 * d_hi;
#pragma unroll
            for (int s = 2; s < 8; ++s) Fw[s] = load_afrag(lds, abase + 32 * (q0 - 8 + s), sh);
            Fw[0] = Fw[2]; Fw[1] = Fw[3];
        }
        {
            unsigned ap = (unsigned)(uintptr_t)(lds + abase) + 32 * (-8 * d_hi), bp = (unsigned)(uintptr_t)(lds + zb) - d_hi * SLOTB;
            v2u n01, n23; unsigned n4; v4u zn;
            unsigned r0, r1, r2, r3, r4; v4u zf;
#define HY_LOADS(ADW, BOFF) asm volatile("ds_read2_b32 %0, %4 offset0:%c5 offset1:%c6\n\tds_read2_b32 %1, %4 offset0:%c7 offset1:%c8\n\tds_read_b32 %2, %4 offset:%c9\n\tds_read_b128 %3, %10 offset:%c11" \
                : "=&v"(n01), "=&v"(n23), "=&v"(n4), "=&v"(zn) : "v"(ap), "i"(ADW), "i"((ADW) + 1), "i"((ADW) + 2), "i"((ADW) + 3), "i"(((ADW) + 4) * 4), "v"(bp), "i"(BOFF))
#define HY_WAIT() do { asm volatile("s_waitcnt lgkmcnt(0)" : "+v"(n01), "+v"(n23), "+v"(n4), "+v"(zn), "+v"(acc[0]), "+v"(acc[1]), "+v"(acc[2]), "+v"(acc[3])); __builtin_amdgcn_sched_barrier(0); } while (0)
#define HY_TAKE() do { r0 = n01.x; r1 = n01.y; r2 = n23.x; r3 = n23.y; r4 = n4; zf = zn; } while (0)
#define HY_STEP(JK, ADW, BOFF) do { HY_LOADS(ADW, BOFF); __builtin_amdgcn_sched_barrier(0); \
                { v4u f; f.x = __builtin_amdgcn_alignbit(r1, r0, sh); f.y = __builtin_amdgcn_alignbit(r2, r1, sh); f.z = __builtin_amdgcn_alignbit(r3, r2, sh); f.w = __builtin_amdgcn_alignbit(r4, r3, sh); Fw[JK] = __builtin_bit_cast(bf16x8, f); } \
                { const bf16x8 zb_ = __builtin_bit_cast(bf16x8, zf); \
                  acc[0] = __builtin_amdgcn_mfma_f32_32x32x16_bf16(Fw[(JK) & 7], zb_, acc[0], 0, 0, 0); acc[1] = __builtin_amdgcn_mfma_f32_32x32x16_bf16(Fw[((JK) - 2) & 7], zb_, acc[1], 0, 0, 0); \
                  acc[2] = __builtin_amdgcn_mfma_f32_32x32x16_bf16(Fw[((JK) - 4) & 7], zb_, acc[2], 0, 0, 0); acc[3] = __builtin_amdgcn_mfma_f32_32x32x16_bf16(Fw[((JK) - 6) & 7], zb_, acc[3], 0, 0, 0); } \
                HY_WAIT(); HY_TAKE(); } while (0)
            HY_LOADS(0, 0); HY_WAIT(); HY_TAKE();
            for (int d = d_hi; d >= d_lo; --d) {
                HY_STEP(0, 8, 32); HY_STEP(1, 16, 64); HY_STEP(2, 24, 96); HY_STEP(3, 32, 128); HY_STEP(4, 40, 160); HY_STEP(5, 48, 192); HY_STEP(6, 56, 224); HY_STEP(7, 64, SLOTB);
                ap += 256; bp += SLOTB;
            }
#undef HY_LOADS
#undef HY_WAIT
#undef HY_TAKE
#undef HY_STEP
        }
        LDS_WAIT(); __syncthreads();
        HY_SEC(2);
        {
            LAS float* X = (LAS float*)(lds + F_OFF) + wave * 2048;
#pragma unroll
            for (int t = 0; t < 2; ++t)
#pragma unroll
                for (int rg = 0; rg < 16; ++rg) X[(t * 16 + rg) * 64 + lane] = (half == 0) ? acc[2 + t][rg] : acc[t][rg];
        }
        LDS_WAIT(); __syncthreads();
        f32x16 fin[2];
        {
            const LAS float* X = (const LAS float*)(lds + F_OFF) + (wave ^ 4) * 2048;
#pragma unroll
            for (int t = 0; t < 2; ++t)
#pragma unroll
                for (int rg = 0; rg < 16; ++rg) fin[t][rg] = ((half == 0) ? acc[t][rg] : acc[2 + t][rg]) + X[(t * 16 + rg) * 64 + lane];
        }
        LDS_WAIT(); __syncthreads();
        HY_SEC(3);
        {
            const int ch = o * HW + c; const float w0 = P.conv_w[ch], w1 = P.conv_w[3 * HW + ch], w2 = P.conv_w[6 * HW + ch], b = P.conv_b[ch];
            const bf16* urow = P.uT + (size_t)ch * MTOK + T0;
            for (int it = 0; it < 4; ++it) { const int chunk = tid + it * 512; float v[8]; conv3_chunk(urow, g, chunk, w0, w1, w2, b, v);
                LAS f32x4* dst = (LAS f32x4*)(lds + F_OFF + chunk * 32 + (chunk >> 4) * 16); dst[0] = (f32x4){v[0], v[1], v[2], v[3]}; dst[1] = (f32x4){v[4], v[5], v[6], v[7]}; }
        }
        LDS_WAIT(); __syncthreads();
        HY_SEC(4);
        {
            const float sb = P.hbias[o * HW + c], inr = o ? inv_norm1 : inv_norm0;
            const LAS float* G = (const LAS float*)(lds + F_OFF);
            const int n = ncol; LAS bf16* zs = (LAS bf16*)(lds + slot_of(g, n) * SLOTB);
#pragma unroll
            for (int t = 0; t < 2; ++t)
#pragma unroll
                for (int rg = 0; rg < 16; ++rg) { const int i = 32 * (mi0 + t) + crow(rg, hi);
                    const float zo = bf2f(zs[i]);
#if PROBE >= 100
                    if (c == 137) { P.dF[(g * 2 + o) * 16384 + 128 * n + i] = fin[t][rg]; P.dZ[(g * 2 + o) * 16384 + 128 * n + i] = zs[i]; }
#endif
                    const float val = G[132 * n + i] * (inr * fin[t][rg] + sb * zo); zs[i] = (bf16)f2bf(val); }
        }
        LDS_WAIT(); __syncthreads();
    }
    HY_SEC(5);
    {
        bf16* yrow = P.yT + (size_t)c * MTOK + T0;
        for (int it = 0; it < 4; ++it) { const int chunk = tid + it * 512, tau0 = chunk * 8;
            *(GAS v4u*)(yrow + tau0) = *(const LAS v4u*)(lds + slot_of(g, tau0 >> 7) * SLOTB + (tau0 & 127) * 2); }
    }
    LDS_WAIT(); __syncthreads();
}
}

namespace fc {
constexpr int OST = 1032, PLANE_B = 32 * OST * 2  , RE_OFF = 0, IM_OFF = PLANE_B, RED_OFF = 2 * PLANE_B, T3_OFF = RED_OFF + 64;
constexpr int NFFT = 32768;
enum { F1 = 0, F2 = 1, F3 = 2, I1 = 3, I2 = 4, I3 = 5 };
__device__ __forceinline__ int crow(int r, int hi) { return (r & 3) + 8 * (r >> 2) + 4 * hi; }
__device__ __forceinline__ int sw(int mid) { return 0; }
struct Params { const bf16* uT; const bf16* kc; const float* fpart_s; const float* conv_w; const float* conv_b; const float* hbias; bf16* yT; bf16* hs; bf16* z1s; float* dF; bf16* dZ; };
typedef float f32x2_ __attribute__((ext_vector_type(2)));
struct FMat { bf16x8 fr[2], fi[2], nfi[2]; };

__device__ __forceinline__ void make_fmat(FMat& M, int r, int h) {
#pragma unroll
    for (int ks = 0; ks < 2; ++ks) { v4u a, b, c;
#pragma unroll
        for (int w = 0; w < 4; ++w) { float cv[2], sv[2];
#pragma unroll
            for (int e = 0; e < 2; ++e) { const int aidx = 16 * ks + 8 * h + 2 * w + e; const float fr_ = (float)((aidx * r) & 31) * (1.0f / 32.0f); cv[e] = __builtin_amdgcn_cosf(fr_); sv[e] = __builtin_amdgcn_sinf(fr_); }
            a[w] = pk2(cv[0], cv[1]); b[w] = pk2(-sv[0], -sv[1]); c[w] = pk2(sv[0], sv[1]); }
        M.fr[ks] = __builtin_bit_cast(bf16x8, a); M.fi[ks] = __builtin_bit_cast(bf16x8, b); M.nfi[ks] = __builtin_bit_cast(bf16x8, c); }
}

template <int ST, bool REAL_IN, bool HALF_K>
__device__ __forceinline__ void stage(LAS unsigned char* lds, const FMat& M, int wave, int r_, int h_) {
    int r = r_, h = h_; asm volatile("" : "+v"(r), "+v"(h));
    float t2c[16], t2s[16];
    if (ST == F1 || ST == F2 || ST == I1 || ST == I2) {
#pragma unroll
        for (int rg = 0; rg < 16; ++rg) { const int rho = (rg & 3) + 8 * (rg >> 2) + 4 * h; const float fr_ = (float)(r * rho) * (1.0f / 1024.0f); t2c[rg] = __builtin_amdgcn_cosf(fr_); t2s[rg] = __builtin_amdgcn_sinf(fr_); }
    }
    constexpr bool INV = (ST >= I1);
    const f32x16 zero16 = (f32x16){0.f,0.f,0.f,0.f,0.f,0.f,0.f,0.f,0.f,0.f,0.f,0.f,0.f,0.f,0.f,0.f};
    unsigned res[4][16];
#pragma unroll
    for (int t = 0; t < 4; ++t) {
        const int f = 4 * wave + t;
        const int base = (ST == I2) ? (32 * f + OST * r) : (32 * r + OST * f); const int swr = (ST == I2) ? sw(f) : sw(r);
        f32x16 ur = zero16, ui = zero16;
#pragma unroll
        for (int ks = 0; ks < (HALF_K ? 1 : 2); ++ks) {
            const bf16x8 xr = *(const LAS bf16x8*)(lds + RE_OFF + 2 * (base + ((16 * ks + 8 * h) ^ swr)));
            if (!INV) {
                ur = __builtin_amdgcn_mfma_f32_32x32x16_bf16(M.fr[ks], xr, ur, 0, 0, 0);
                ui = __builtin_amdgcn_mfma_f32_32x32x16_bf16(M.fi[ks], xr, ui, 0, 0, 0);
                if (!REAL_IN) { const bf16x8 xi = *(const LAS bf16x8*)(lds + IM_OFF + 2 * (base + ((16 * ks + 8 * h) ^ swr)));
                    ur = __builtin_amdgcn_mfma_f32_32x32x16_bf16(M.nfi[ks], xi, ur, 0, 0, 0);
                    ui = __builtin_amdgcn_mfma_f32_32x32x16_bf16(M.fr[ks], xi, ui, 0, 0, 0); }
            } else {
                const bf16x8 xi = *(const LAS bf16x8*)(lds + IM_OFF + 2 * (base + ((16 * ks + 8 * h) ^ swr)));
                ur = __builtin_amdgcn_mfma_f32_32x32x16_bf16(M.fr[ks], xr, ur, 0, 0, 0);
                ur = __builtin_amdgcn_mfma_f32_32x32x16_bf16(M.fi[ks], xi, ur, 0, 0, 0);
                if (ST != I3) { ui = __builtin_amdgcn_mfma_f32_32x32x16_bf16(M.fr[ks], xi, ui, 0, 0, 0);
                                ui = __builtin_amdgcn_mfma_f32_32x32x16_bf16(M.nfi[ks], xr, ui, 0, 0, 0); }
            }
        }
        if (ST == I3) {
#pragma unroll
            for (int rg = 0; rg < 8; ++rg) res[t][rg] = __float_as_uint(ur[rg]);
        } else {
            if (ST == F1 || ST == F2 || ST == I1 || ST == I2) {
                float uc = 1.f, us = 0.f;
                if (ST == I2) { const float fr_ = (float)(f * r) * (1.0f / 32768.0f); uc = __builtin_amdgcn_cosf(fr_); us = __builtin_amdgcn_sinf(fr_); }
#pragma unroll
                for (int rg = 0; rg < 16; ++rg) {
                    float c = t2c[rg], s_ = t2s[rg];
                    if (ST == F1) { const int rho = (rg & 3) + 8 * (rg >> 2) + 4 * h; const f32x2_ q = *(const LAS f32x2_*)(lds + T3_OFF + 8 * (32 * f + rho)); const float c2 = c * q.x - s_ * q.y; s_ = c * q.y + s_ * q.x; c = c2; }
                    if (ST == I2) { const float c2 = c * uc - s_ * us; s_ = c * us + s_ * uc; c = c2; }
                    const float s = INV ? s_ : -s_;
                    const float a = ur[rg], b = ui[rg];
                    ur[rg] = a * c - b * s; ui[rg] = a * s + b * c;
                }
            }
#pragma unroll
            for (int p = 0; p < 8; ++p) { res[t][p] = pk2(ur[2 * p], ur[2 * p + 1]); res[t][8 + p] = pk2(ui[2 * p], ui[2 * p + 1]); }
        }
        __builtin_amdgcn_sched_barrier(0);
    }
    LDS_WAIT(); __syncthreads();
#pragma unroll
    for (int t = 0; t < 4; ++t) {
        const int f = 4 * wave + t;
        if (ST == I3) {
            LAS float* Y = (LAS float*)(lds + IM_OFF);
#pragma unroll
            for (int rg = 0; rg < 8; ++rg) { const int rho = (rg & 3) + 8 * (rg >> 2) + 4 * h; Y[516 * f + 32 * rho + r] = __uint_as_float(res[t][rg]); }
        } else if (ST == F3) {
#pragma unroll
            for (int g4 = 0; g4 < 4; ++g4) { const int pos = ((8 * g4 + 4 * h) ^ sw(r)) + 32 * r + OST * f;
                *(LAS v2u*)(lds + RE_OFF + 2 * pos) = (v2u){res[t][2 * g4], res[t][2 * g4 + 1]}; *(LAS v2u*)(lds + IM_OFF + 2 * pos) = (v2u){res[t][8 + 2 * g4], res[t][8 + 2 * g4 + 1]}; }
        } else {
            const int odd = r & 1; const unsigned sel = odd ? 0x03020706u : 0x05040100u;
            const int rs_ = (ST == F1) ? OST : 32;
            const int lb = ((r & ~1) + odd * rs_ + ((ST == F1) ? 32 * f : OST * f) + rs_ * 4 * h) * 2;
#pragma unroll
            for (int p = 0; p < 8; ++p) {
                const int rho0 = ((2 * p) & 3) + 8 * ((2 * p) >> 2);
                const unsigned wr_ = res[t][p], wi_ = res[t][8 + p];
                const unsigned vr_ = (unsigned)__builtin_amdgcn_mov_dpp((int)wr_, 0xB1, 0xF, 0xF, true), vi_ = (unsigned)__builtin_amdgcn_mov_dpp((int)wi_, 0xB1, 0xF, 0xF, true);
                *(LAS unsigned*)(lds + RE_OFF + lb + 2 * rs_ * rho0) = __builtin_amdgcn_perm(vr_, wr_, sel);
                *(LAS unsigned*)(lds + IM_OFF + lb + 2 * rs_ * rho0) = __builtin_amdgcn_perm(vi_, wi_, sel);
            }
        }
    }
    LDS_WAIT(); __syncthreads();
}

__device__ __forceinline__ void self_visible(int tid) {
    VM_WAIT(); __syncthreads();
    if (tid == 0) { __builtin_amdgcn_fence(__ATOMIC_ACQUIRE, "agent"); VM_WAIT(); }
    __syncthreads();
}

__device__ __forceinline__ void item(LAS unsigned char* lds, const Params& P, int c, int tid_, int slot) {
    int tid = tid_; asm volatile("" : "+v"(tid));
    const int wave = __builtin_amdgcn_readfirstlane(tid >> 6);
    constexpr int L = LS, T0 = TP, g = 1;
    bf16* hs = P.hs + (size_t)slot * (2 * PLANE_B / 2); bf16* z1s = P.z1s + (size_t)slot * L;
    float inv_norm0, inv_norm1;
    {
        const int lane = tid & 63; float s0 = 0.f, s1 = 0.f;
        for (int idx = lane; idx < 512; idx += 64) { const int ch = idx >> 1, dir = idx & 1; s0 += P.fpart_s[(size_t)ch * 2048 + dir * 512 + c]; s1 += P.fpart_s[(size_t)ch * 2048 + 1024 + dir * 512 + c]; }
        inv_norm0 = 1.0f / wave_sum_sw(s0); inv_norm1 = 1.0f / wave_sum_sw(s1);
    }
    FMat M; { const int r = tid & 31, h = (tid >> 5) & 1; make_fmat(M, r, h); }
    for (int i = tid; i < 1024; i += NWAVES * 64) { const float fr_ = (float)((i >> 5) * (i & 31)) * (1.0f / 32768.0f); *(LAS f32x2_*)(lds + T3_OFF + 8 * i) = (f32x2_){__builtin_amdgcn_cosf(fr_), __builtin_amdgcn_sinf(fr_)}; }
    LDS_WAIT(); __syncthreads();
#if PROBE >= 31 && PROBE <= 35
    unsigned long long tp_ = __builtin_amdgcn_s_memrealtime();
#define FC_SEC(k) do { const unsigned long long tn_ = __builtin_amdgcn_s_memrealtime(); if (blockIdx.x == 0 && tid == 0) ((volatile LAS unsigned*)(lds + MISC_OFF))[40 + (k)] += (unsigned)(tn_ - tp_); tp_ = tn_; } while (0)
#else
#define FC_SEC(k) do { } while (0)
#endif
    for (int o = 0; o < 2; ++o) {
        asm volatile("" : "+v"(tid));
        const int lane = tid & 63, r = lane & 31, h = lane >> 5;
        FC_SEC(5);
        {
            const bf16* ksrc = P.kc + (size_t)(o * HW + c) * NFFT;
            v4u raw[8];
#pragma unroll
            for (int i = 0; i < 8; ++i) { const int it = 8 * wave + i, n = 1024 * (lane & 31) + 32 * (2 * (it >> 2) + (lane >> 5)) + 8 * (it & 3); raw[i] = *(const GAS v4u*)(ksrc + n); }
#pragma unroll
            for (int i = 0; i < 8; ++i) { const int it = 8 * wave + i, n = 1024 * (lane & 31) + 32 * (2 * (it >> 2) + (lane >> 5)) + 8 * (it & 3);
                const int pos0 = ((n >> 10) ^ sw((n >> 5) & 31)) + 32 * ((n >> 5) & 31) + OST * (n & 31); LAS bf16* d = (LAS bf16*)(lds + RE_OFF) + pos0;
                d[0 * OST] = (bf16)(raw[i].x & 0xffffu); d[1 * OST] = (bf16)(raw[i].x >> 16); d[2 * OST] = (bf16)(raw[i].y & 0xffffu); d[3 * OST] = (bf16)(raw[i].y >> 16);
                d[4 * OST] = (bf16)(raw[i].z & 0xffffu); d[5 * OST] = (bf16)(raw[i].z >> 16); d[6 * OST] = (bf16)(raw[i].w & 0xffffu); d[7 * OST] = (bf16)(raw[i].w >> 16); }
        }
        LDS_WAIT(); __syncthreads();
        stage<F1, true, false>(lds, M, wave, r, h); stage<F2, false, false>(lds, M, wave, r, h); stage<F3, false, false>(lds, M, wave, r, h);
        for (int i = tid; i < 2 * PLANE_B / 16; i += NWAVES * 64) *(GAS v4u*)((unsigned char*)hs + (size_t)i * 16) = *(const LAS v4u*)(lds + i * 16);
        self_visible(tid);
        FC_SEC(0);
        {
            const int ch = 2 * HW + c; const float w0 = P.conv_w[ch], w1 = P.conv_w[3 * HW + ch], w2 = P.conv_w[6 * HW + ch], b = P.conv_b[ch];
            const bf16* urow = P.uT + (size_t)ch * MTOK + T0;
            hy::C3 q3[4]; v4u rz[4];
#pragma unroll
            for (int i = 0; i < 4; ++i) { const int it = 4 * wave + i, n = 1024 * (lane & 15) + 32 * (4 * (it >> 2) + (lane >> 4)) + 8 * (it & 3);
                if (o == 0) hy::conv3_load(urow, g, n >> 3, q3[i]); else rz[i] = *(const GAS v4u*)(z1s + n); }
#pragma unroll
            for (int i = 0; i < 4; ++i) { const int it = 4 * wave + i, n = 1024 * (lane & 15) + 32 * (4 * (it >> 2) + (lane >> 4)) + 8 * (it & 3); unsigned e[4];
                if (o == 0) { float v[8]; hy::conv3_eval(q3[i], w0, w1, w2, b, v); e[0] = pk2(v[0], v[1]); e[1] = pk2(v[2], v[3]); e[2] = pk2(v[4], v[5]); e[3] = pk2(v[6], v[7]); }
                else { e[0] = rz[i].x; e[1] = rz[i].y; e[2] = rz[i].z; e[3] = rz[i].w; }
                const int pos0 = ((n >> 10) ^ sw((n >> 5) & 31)) + 32 * ((n >> 5) & 31) + OST * (n & 31); LAS bf16* d = (LAS bf16*)(lds + RE_OFF) + pos0;
#pragma unroll
                for (int j = 0; j < 4; ++j) { d[(2 * j) * OST] = (bf16)(e[j] & 0xffffu); d[(2 * j + 1) * OST] = (bf16)(e[j] >> 16); } }
        }
        LDS_WAIT(); __syncthreads();
        stage<F1, true, true>(lds, M, wave, r, h); stage<F2, false, false>(lds, M, wave, r, h); stage<F3, false, false>(lds, M, wave, r, h);
        FC_SEC(1);
        {
            constexpr int NCH = PLANE_B / 16, NIT = (NCH + NWAVES * 64 - 1) / (NWAVES * 64);
#pragma unroll 1
            for (int kb = 0; kb < NIT; kb += 3) {
                v4u hr[3], hi_[3];
#pragma unroll
                for (int k = 0; k < 3; ++k) { const int i = tid + (kb + k) * NWAVES * 64; if (i < NCH) { hr[k] = *(const GAS v4u*)((const unsigned char*)hs + (size_t)i * 16); hi_[k] = *(const GAS v4u*)((const unsigned char*)hs + PLANE_B + (size_t)i * 16); } }
#pragma unroll
                for (int k = 0; k < 3; ++k) { const int i = tid + (kb + k) * NWAVES * 64; if (i < NCH) {
                    const v4u xr = *(const LAS v4u*)(lds + RE_OFF + i * 16), xi = *(const LAS v4u*)(lds + IM_OFF + i * 16);
                    v4u vr, vi;
#pragma unroll
                    for (int w = 0; w < 4; ++w) {
                        const float a0 = pg8::bflo(xr[w]), a1 = pg8::bfhi(xr[w]), b0 = pg8::bflo(xi[w]), b1 = pg8::bfhi(xi[w]);
                        const float c0 = pg8::bflo(hr[k][w]) * (1.0f / 32768.0f), c1 = pg8::bfhi(hr[k][w]) * (1.0f / 32768.0f), d0 = pg8::bflo(hi_[k][w]) * (1.0f / 32768.0f), d1 = pg8::bfhi(hi_[k][w]) * (1.0f / 32768.0f);
                        vr[w] = pk2(a0 * c0 - b0 * d0, a1 * c1 - b1 * d1); vi[w] = pk2(a0 * d0 + b0 * c0, a1 * d1 + b1 * c1);
                    }
                    *(LAS v4u*)(lds + RE_OFF + i * 16) = vr; *(LAS v4u*)(lds + IM_OFF + i * 16) = vi; } }
            }
        }
        LDS_WAIT(); __syncthreads();
        FC_SEC(2);
        stage<I1, false, false>(lds, M, wave, r, h); stage<I2, false, false>(lds, M, wave, r, h); stage<I3, false, false>(lds, M, wave, r, h);
        FC_SEC(3);
        {
            const LAS float* Y = (const LAS float*)(lds + IM_OFF);
            const int chg = o * HW + c; const float g0 = P.conv_w[chg], g1 = P.conv_w[3 * HW + chg], g2 = P.conv_w[6 * HW + chg], gb = P.conv_b[chg];
            const int chv = 2 * HW + c; const float v0 = P.conv_w[chv], v1 = P.conv_w[3 * HW + chv], v2 = P.conv_w[6 * HW + chv], vb = P.conv_b[chv];
            const bf16* grow = P.uT + (size_t)chg * MTOK + T0; const bf16* vrow = P.uT + (size_t)chv * MTOK + T0;
            const float sb = P.hbias[o * HW + c], inr = o ? inv_norm1 : inv_norm0;
            bf16* dst = o ? (P.yT + (size_t)c * MTOK + T0) : z1s;
#pragma unroll 1
            for (int ib = 0; ib < 4; ib += 2) {
            hy::C3 qg[2], qv[2]; v4u rz[2];
#pragma unroll
            for (int it = 0; it < 2; ++it) { const int chunk = tid + (ib + it) * 512; hy::conv3_load(grow, g, chunk, qg[it]); if (o == 0) hy::conv3_load(vrow, g, chunk, qv[it]); else rz[it] = *(const GAS v4u*)(z1s + chunk * 8); }
#pragma unroll
            for (int it = 0; it < 2; ++it) { const int chunk = tid + (ib + it) * 512, n = chunk * 8; float gt[8], zo[8];
                hy::conv3_eval(qg[it], g0, g1, g2, gb, gt);
                if (o == 0) { hy::conv3_eval(qv[it], v0, v1, v2, vb, zo);
#pragma unroll
                    for (int j = 0; j < 8; ++j) zo[j] = bf2f((unsigned short)f2bf(zo[j])); }
                else { const v4u raw = rz[it]; zo[0] = pg8::bflo(raw.x); zo[1] = pg8::bfhi(raw.x); zo[2] = pg8::bflo(raw.y); zo[3] = pg8::bfhi(raw.y); zo[4] = pg8::bflo(raw.z); zo[5] = pg8::bfhi(raw.z); zo[6] = pg8::bflo(raw.w); zo[7] = pg8::bfhi(raw.w); }
                const LAS float* yp = Y + 516 * (n & 31) + (n >> 5); const f32x4 y0 = (f32x4){yp[0], yp[516], yp[2 * 516], yp[3 * 516]}, y1 = (f32x4){yp[4 * 516], yp[5 * 516], yp[6 * 516], yp[7 * 516]};
                float val[8];
#pragma unroll
                for (int j = 0; j < 8; ++j) { const float yv = (j < 4) ? y0[j & 3] : y1[j & 3];
#if PROBE >= 100
                    if (c == 137) { P.dF[(2 + o) * 16384 + n + j] = yv; P.dZ[(2 + o) * 16384 + n + j] = (bf16)f2bf(zo[j]); }
#endif
                    val[j] = gt[j] * (inr * yv + sb * zo[j]); }
                v4u pk; pk.x = pk2(val[0], val[1]); pk.y = pk2(val[2], val[3]); pk.z = pk2(val[4], val[5]); pk.w = pk2(val[6], val[7]);
                *(GAS v4u*)(dst + n) = pk; }
            }
        }
        self_visible(tid);
        FC_SEC(4);
    }
#undef FC_SEC
}
}

namespace at {
constexpr int KROW = 144, VROW = 776, K_OFF = 0, V_OFF = 384 * KROW  , END_OFF = V_OFF + 64 * VROW;
__device__ __forceinline__ int crow(int r, int hi) { return (r & 3) + 8 * (r >> 2) + 4 * hi; }
struct Params { const bf16* q; const bf16* k; const bf16* v; const float* sink; bf16* yat; };

__device__ __forceinline__ void attn_item(LAS unsigned char* lds, const Params& P, int blk, int gk, int tid_) {
    int tid = tid_; asm volatile("" : "+v"(tid));
    const int lane = tid & 63, wave = __builtin_amdgcn_readfirstlane(tid >> 6), r = lane & 31, hi = lane >> 5;
    const int m0 = blk * 128; const int s_lo = (blk < 128) ? (m0 & ~(LP - 1)) : TP, s_hi = (blk < 128) ? s_lo + LP : MTOK; const int kw0 = m0 - 128;
    for (int it = 0; it < 6; ++it) {
        const int idx = tid + it * 512, chn = idx / 384, key = idx - chn * 384, tok = kw0 + key; const bool ok = (tok >= s_lo) && (tok < s_hi);
        v4u kv = (v4u){0u, 0u, 0u, 0u}, vv = (v4u){0u, 0u, 0u, 0u};
        if (ok) { kv = *(const GAS v4u*)(P.k + (size_t)tok * 128 + gk * 64 + chn * 8); vv = *(const GAS v4u*)(P.v + (size_t)tok * 128 + gk * 64 + chn * 8); }
        *(LAS v4u*)(lds + K_OFF + key * KROW + chn * 16) = kv;
        LAS bf16* vt = (LAS bf16*)(lds + V_OFF + (chn * 8) * VROW + key * 2);
        vt[0 * (VROW / 2)] = (bf16)(vv.x & 0xffffu); vt[1 * (VROW / 2)] = (bf16)(vv.x >> 16); vt[2 * (VROW / 2)] = (bf16)(vv.y & 0xffffu); vt[3 * (VROW / 2)] = (bf16)(vv.y >> 16);
        vt[4 * (VROW / 2)] = (bf16)(vv.z & 0xffffu); vt[5 * (VROW / 2)] = (bf16)(vv.z >> 16); vt[6 * (VROW / 2)] = (bf16)(vv.w & 0xffffu); vt[7 * (VROW / 2)] = (bf16)(vv.w >> 16);
    }
    LDS_WAIT(); __syncthreads();
    const int hq = 4 * gk + (wave & 3), qh = wave >> 2;
    const int klo = (s_lo - kw0) > 0 ? (s_lo - kw0) : 0, khi = (s_hi - kw0) < 384 ? (s_hi - kw0) : 384;
    const float sinkl = P.sink[hq] * 1.4426950408889634f;
    for (int qq = 0; qq < 2; ++qq) {
        const int qt = 2 * qh + qq, q0 = 32 * qt; const size_t qrow = (size_t)(m0 + q0 + r);
        bf16x8 qf[4];
#pragma unroll
        for (int ks = 0; ks < 4; ++ks) qf[ks] = *(const GAS bf16x8*)(P.q + qrow * 512 + hq * 64 + 16 * ks + 8 * hi);
        float m_run = sinkl, l_run = (hi == 0) ? 1.0f : 0.0f;
        f32x16 o0 = (f32x16){0.f,0.f,0.f,0.f,0.f,0.f,0.f,0.f,0.f,0.f,0.f,0.f,0.f,0.f,0.f,0.f}, o1 = o0;
        const int lo_r = (q0 + r) > klo ? (q0 + r) : klo, hi_r = (q0 + r + 256) < (khi - 1) ? (q0 + r + 256) : (khi - 1);
        for (int kt = qt; kt <= qt + 8; ++kt) {
            const int kb = 32 * kt;
            f32x16 s = (f32x16){0.f,0.f,0.f,0.f,0.f,0.f,0.f,0.f,0.f,0.f,0.f,0.f,0.f,0.f,0.f,0.f};
#pragma unroll
            for (int ks = 0; ks < 4; ++ks) { const bf16x8 kf = *(const LAS bf16x8*)(lds + K_OFF + (kb + r) * KROW + 32 * ks + 16 * hi);
                s = __builtin_amdgcn_mfma_f32_32x32x16_bf16(kf, qf[ks], s, 0, 0, 0); }
            float tmax = -1e30f;
#pragma unroll
            for (int rg = 0; rg < 16; ++rg) { const int kj = kb + crow(rg, hi); const float sv = (kj >= lo_r && kj <= hi_r) ? s[rg] : -1e30f; s[rg] = sv; tmax = fmaxf(tmax, sv); }
            tmax = fmaxf(tmax, __shfl_xor(tmax, 32));
            const float mnew = fmaxf(m_run, tmax); const float alpha = __builtin_amdgcn_exp2f(m_run - mnew); m_run = mnew;
            float psum = 0.f;
#pragma unroll
            for (int rg = 0; rg < 16; ++rg) { const float p = __builtin_amdgcn_exp2f(s[rg] - mnew); s[rg] = p; psum += p; }
            l_run = l_run * alpha + psum;
#pragma unroll
            for (int rg = 0; rg < 16; ++rg) { o0[rg] *= alpha; o1[rg] *= alpha; }
            v4u pa, pb;
            pa.x = pk2(s[0], s[1]); pa.y = pk2(s[2], s[3]); pa.z = pk2(s[4], s[5]); pa.w = pk2(s[6], s[7]);
            pb.x = pk2(s[8], s[9]); pb.y = pk2(s[10], s[11]); pb.z = pk2(s[12], s[13]); pb.w = pk2(s[14], s[15]);
            const bf16x8 pf0 = __builtin_bit_cast(bf16x8, pa), pf1 = __builtin_bit_cast(bf16x8, pb);
#pragma unroll
            for (int dt = 0; dt < 2; ++dt) {
                const LAS unsigned char* vb = lds + V_OFF + (32 * dt + r) * VROW + (kb + 4 * hi) * 2;
                v4u va, vc;
                { const v2u x0 = *(const LAS v2u*)(vb), x1 = *(const LAS v2u*)(vb + 16); va = (v4u){x0.x, x0.y, x1.x, x1.y}; }
                { const v2u x0 = *(const LAS v2u*)(vb + 32), x1 = *(const LAS v2u*)(vb + 48); vc = (v4u){x0.x, x0.y, x1.x, x1.y}; }
                if (dt == 0) { o0 = __builtin_amdgcn_mfma_f32_32x32x16_bf16(__builtin_bit_cast(bf16x8, va), pf0, o0, 0, 0, 0); o0 = __builtin_amdgcn_mfma_f32_32x32x16_bf16(__builtin_bit_cast(bf16x8, vc), pf1, o0, 0, 0, 0); }
                else         { o1 = __builtin_amdgcn_mfma_f32_32x32x16_bf16(__builtin_bit_cast(bf16x8, va), pf0, o1, 0, 0, 0); o1 = __builtin_amdgcn_mfma_f32_32x32x16_bf16(__builtin_bit_cast(bf16x8, vc), pf1, o1, 0, 0, 0); }
            }
        }
        l_run += __shfl_xor(l_run, 32);
        const float inv = 1.0f / l_run;
        bf16* yrow = P.yat + qrow * 512 + hq * 64;
#pragma unroll
        for (int g4 = 0; g4 < 4; ++g4) {
            v2u w0, w1;
            w0.x = pk2(o0[4 * g4] * inv, o0[4 * g4 + 1] * inv); w0.y = pk2(o0[4 * g4 + 2] * inv, o0[4 * g4 + 3] * inv);
            w1.x = pk2(o1[4 * g4] * inv, o1[4 * g4 + 1] * inv); w1.y = pk2(o1[4 * g4 + 2] * inv, o1[4 * g4 + 3] * inv);
            *(GAS v2u*)(yrow + 8 * g4 + 4 * hi) = w0; *(GAS v2u*)(yrow + 32 + 8 * g4 + 4 * hi) = w1;
        }
    }
    LDS_WAIT(); __syncthreads();
}
}

__device__ __forceinline__ void transpose_y_tile(LAS unsigned char* lds, const bf16* yT, bf16* yhy, int tile, int tid_) {
    int tid = tid_; asm volatile("" : "+v"(tid));
    const int c0 = (tile & 7) * 64, t0 = (tile >> 3) * 64;
    LAS bf16* T = (LAS bf16*)lds;
    { const int ch = tid >> 3, k8 = tid & 7; *(LAS v4u*)(T + ch * 72 + k8 * 8) = *(const GAS v4u*)(yT + (size_t)(c0 + ch) * MTOK + t0 + k8 * 8); }
    LDS_WAIT(); __syncthreads();
    { const int tk = tid >> 3, c8 = tid & 7; unsigned short e[8];
#pragma unroll
      for (int j = 0; j < 8; ++j) e[j] = T[(c8 * 8 + j) * 72 + tk];
      v4u o; o.x = e[0] | ((unsigned)e[1] << 16); o.y = e[2] | ((unsigned)e[3] << 16); o.z = e[4] | ((unsigned)e[5] << 16); o.w = e[6] | ((unsigned)e[7] << 16);
      *(GAS v4u*)(yhy + (size_t)(t0 + tk) * 512 + c0 + c8 * 8) = o; }
    LDS_WAIT(); __syncthreads();
}

#if PROBE
constexpr int CW_P = 20000;
constexpr size_t WS_DF = 484 * MiB, WS_DZ = 485 * MiB;
constexpr int PROBE_C = 137;
__device__ __forceinline__ double wave_sum_d(double v) {
#pragma unroll
    for (int o = 1; o < 64; o <<= 1) v += __shfl_xor(v, o);
    return v;
}
__device__ __forceinline__ double filt_point(const float* w1, const float* b1, const float* w2, const float* b2, const float* w3, const float* fr, int g, int p, int col, int lane) {
    const int L = g ? LS : LP; const double t = (double)p / (double)(L - 1);
    double zval = 0.0;
    if (lane == 0) zval = t;
    else if (lane < 33) { const int i = (lane - 1) & 15; const double band = 1e-4 + (double)i * ((15.0 - 1e-4) / 15.0); const double ang = (6.283185307179586 / (double)L) * (double)p * band; zval = (lane <= 16) ? cos(ang) : -sin(ang); }
    double a = (double)b1[lane];
    for (int k = 0; k < 33; ++k) a += __shfl(zval, k) * (double)w1[k * 64 + lane];
    const double h1 = sin((double)fr[lane] * a);
    a = (double)b2[lane];
    for (int i = 0; i < 64; ++i) a += __shfl(h1, i) * (double)w2[i * 64 + lane];
    const double h2 = sin((double)fr[lane] * a);
    const double out = wave_sum_d(h2 * (double)w3[lane * 2048 + col]);
    const int c = col & 511; const double dmin = log(1e-2) / 1.5, dmax = log(1e-2) / 0.3;
    const double delta = fabs(dmin + (double)c * ((dmax - dmin) / 511.0));
    return out * (exp(-t * delta) + 0.05);
}
__device__ __forceinline__ void probe_check(unsigned char* ws, unsigned* ctl, const float* w1, const float* b1, const float* w2, const float* b2, const float* w3, const float* fr, int vcu, int G, int tid) {
    const bf16* KREV_S = (const bf16*)(ws + WS_KREV_S);
    const float* DF = (const float*)(ws + WS_DF); const bf16* DZ = (const bf16*)(ws + WS_DZ);
    const int gtid = vcu * 512 + tid, lane = tid & 63, gwv = gtid >> 6, NW = G * 8;
    if (gtid < 65536) {
        const int combo = gtid >> 14, t = gtid & 16383, g = combo >> 1, o = combo & 1, L = g ? LS : LP, tl = g ? t : (t & (LP - 1)), base = t - tl;
        const bf16* kb = KREV_S + (g ? (size_t)0 : (size_t)((WS_KREV_P - WS_KREV_S) / 2)) + (size_t)(o * HW + PROBE_C) * (2 * L); const bf16* dz = DZ + combo * 16384 + base;
        double acc = 0.0;
        if (g) { for (int s = 0; s < L; ++s) { int j = tl - s; if (j < 0) j += 2 * L; acc += (double)bf2f(kb[j]) * (double)bf2f(dz[s]); } }
        else   { const bf16* kr = kb + (L - 1 - tl); for (int s = 0; s < L; ++s) acc += (double)bf2f(kr[s]) * (double)bf2f(dz[s]); }
        const float diff = fabsf((float)(acc - (double)DF[combo * 16384 + t]));
        atomicMax(ctl + CW_P + 0, __float_as_uint(diff)); atomicMax(ctl + CW_P + 1, __float_as_uint(fabsf((float)acc)));
    }
    {
        const int g = gwv & 1, L = g ? LS : LP; const int p = (int)(((unsigned)gwv * 2654435761u) >> 8) % L;
        for (int q = 0; q < 8; ++q) { const int col = (gwv * 97 + 263 * q) & 2047; const int o = col >> 10, dir = (col >> 9) & 1, c = col & 511;
            if (dir == 1 && p == 0) continue;
            const double kv = filt_point(w1, b1, w2, b2, w3, fr, g, p, col, lane);
            const int m = g ? (dir ? (2 * L - p) : p) : (dir ? (L - 1 + p) : (L - 1 - p)); const float st = bf2f((KREV_S + (g ? (size_t)0 : (size_t)((WS_KREV_P - WS_KREV_S) / 2)) + (size_t)(o * HW + c) * (2 * L))[m]);
            if (lane == 0) { atomicMax(ctl + CW_P + 2, __float_as_uint(fabsf(st - (float)kv))); atomicMax(ctl + CW_P + 3, __float_as_uint(fabsf((float)kv))); } }
    }
    for (int which = 0; which < 2; ++which) {
        const int g = which ? 0 : 1, o = which ? 0 : 1, L = g ? LS : LP; double loc = 0.0;
        for (int p = gwv; p < L; p += NW)
            for (int dir = 0; dir < 2; ++dir) { if (dir == 1 && p == 0) continue; loc += fabs(filt_point(w1, b1, w2, b2, w3, fr, g, p, o * 1024 + dir * 512 + PROBE_C, lane)); }
        if (lane == 0) atomicAdd((double*)(ctl + CW_P + 8) + which, loc);
    }
}
__device__ __forceinline__ int probe_metric_count(unsigned char* ws, unsigned* ctl) {
    const float e_conv = __uint_as_float(__hip_atomic_load(ctl + CW_P + 0, RLX_AGENT)) / fmaxf(__uint_as_float(__hip_atomic_load(ctl + CW_P + 1, RLX_AGENT)), 1e-30f);
    const float e_filt = __uint_as_float(__hip_atomic_load(ctl + CW_P + 2, RLX_AGENT)) / fmaxf(__uint_as_float(__hip_atomic_load(ctl + CW_P + 3, RLX_AGENT)), 1e-30f);
    const float* FPS = (const float*)(ws + WS_FPART_S); const float* FPP = (const float*)(ws + WS_FPART_P);
    double s1 = 0.0, s0 = 0.0;
    for (int ch = 0; ch < 256; ++ch) s1 += (double)FPS[(size_t)ch * 2048 + 1024 + PROBE_C] + (double)FPS[(size_t)ch * 2048 + 1024 + 512 + PROBE_C];
    for (int ch = 0; ch < 32; ++ch) s0 += (double)FPP[(size_t)ch * 2048 + PROBE_C] + (double)FPP[(size_t)ch * 2048 + 512 + PROBE_C];
    const double n1 = ((volatile double*)(ctl + CW_P + 8))[0], n0 = ((volatile double*)(ctl + CW_P + 8))[1];
    const float e_n1 = (float)(fabs(n1 - s1) / fmax(n1, 1e-30)), e_n0 = (float)(fabs(n0 - s0) / fmax(n0, 1e-30));
#if PROBE == 100
    float M = fmaxf(fmaxf(e_conv, e_filt * 1e-3f), fmaxf(e_n1, e_n0));
#elif PROBE == 101
    float M = e_conv;
#elif PROBE == 102
    float M = e_filt;
#else
    float M = fmaxf(e_n1, e_n0);
#endif
    float v = (log10f(fmaxf(M, 1e-12f)) + 8.0f) * 0.125f; v = fminf(fmaxf(v, 0.02f), 1.0f);
    return (int)(v * 1600.0f);
}
#endif

#ifndef MK_SPLIT
#define MK_SPLIT 0
#endif
constexpr int N_PHASES = 8;
struct Args { const float* in[23]; float* out; unsigned char* ws; int ph_lo, ph_hi; };

__global__ void __launch_bounds__(NWAVES * 64, 2) enc_fwd(Args args) {
    extern __shared__ __attribute__((aligned(16))) unsigned char lds_raw[];
    Frame F;
    F.lds = (LAS unsigned char*)lds_raw;
    F.MISC = (volatile LAS unsigned*)(F.lds + MISC_OFF);
    F.tid = threadIdx.x; F.lane = F.tid & 63; F.wave = __builtin_amdgcn_readfirstlane(F.tid >> 6);
    F.G = gridDim.x; { const int bx = blockIdx.x; F.vcu = (F.G % 8 == 0) ? (bx % 8) * (F.G / 8) + bx / 8 : bx; }
    F.ws = args.ws; F.ctl = (gu32*)(args.ws + WS_CTL);
    unsigned char* const ws = args.ws;
    for (int u = F.tid; u < (LDS_BYTES - LDSCTL_OFF) / 4; u += NWAVES * 64) ((LAS unsigned*)(F.lds + LDSCTL_OFF))[u] = 0u;
    __syncthreads();
    const int lo = args.ph_lo, hi = args.ph_hi;
    XcdBarrier bar; bar.bar = (unsigned*)(F.ctl + CW_BAR); bar.x = 0; bar.st = nullptr;
    if (hi - lo > 1) bar = xcd_barrier_post((unsigned*)(F.ctl + CW_BAR), F.MISC + 8);
#define IN(k) (lo <= (k) && (k) < hi)
#if PROBE
#define TSTAMP(k) do { if (blockIdx.x == 0 && F.tid == 0) { const unsigned long long t_ = __builtin_amdgcn_s_memrealtime(); F.MISC[16 + 2 * (k)] = (unsigned)t_; F.MISC[17 + 2 * (k)] = (unsigned)(t_ >> 32); } } while (0)
#else
#define TSTAMP(k) do { } while (0)
#endif
#define SEAM(k) do { if (IN(k) && IN((k) + 1)) xcd_barrier(bar); TSTAMP((k) + 1); } while (0)
    TSTAMP(0);

    const float* const xp = args.in[0]; const float* const xs = args.in[1];
    bf16* const WINA = (bf16*)(ws + WS_WINA); bf16* const WINB = (bf16*)(ws + WS_WINB); bf16* const WHY = (bf16*)(ws + WS_WHY); bf16* const WAT = (bf16*)(ws + WS_WAT);
    bf16* const W3T = (bf16*)(ws + WS_W3T); bf16* const WO = (bf16*)(ws + WS_WO); bf16* const WGU = (bf16*)(ws + WS_WGU); bf16* const WD = (bf16*)(ws + WS_WD);
    bf16* const XB = (bf16*)(ws + WS_XB); bf16* const YT = (bf16*)(ws + WS_YT); bf16* const YAT = (bf16*)(ws + WS_YAT);
    bf16* const KREV_S = (bf16*)(ws + WS_KREV_S); bf16* const KREV_P = (bf16*)(ws + WS_KREV_P); bf16* const UT = (bf16*)(ws + WS_UT);
    bf16* const QB = (bf16*)(ws + WS_Q); bf16* const KB = (bf16*)(ws + WS_K); bf16* const VB = (bf16*)(ws + WS_V);
    bf16* const SGH = (bf16*)(ws + WS_SGH); bf16* const SGA = (bf16*)(ws + WS_SGA);
    float* const COS = (float*)(ws + WS_COS); float* const SIN = (float*)(ws + WS_SIN); float* const RSTD = (float*)(ws + WS_RSTD); float* const SSQ = (float*)(ws + WS_SSQ);
    float* const FPART_S = (float*)(ws + WS_FPART_S); float* const FPART_P = (float*)(ws + WS_FPART_P);
    bf16* const YHY = (bf16*)(ws + WS_YHY); bf16* const MERGED = (bf16*)(ws + WS_MERGED); bf16* const X1B = (bf16*)(ws + WS_X1B); bf16* const HID = (bf16*)(ws + WS_HID);

    if (IN(0)) {
        LAS float* scr = (LAS float*)(F.lds + RING_OFF + F.wave * 16384);
        const int gw = F.vcu * NWAVES + F.wave, NGW = F.G * NWAVES;
        constexpr int I_IN = 16 * 136, I_HY = 8 * 32, I_O = 16 * 32, I_G = 16 * 88, I_D = 44 * 32, I_W3 = 64;
        constexpr int NITEMS = I_IN + 2 * I_HY + I_O + 2 * I_G + I_D + I_W3;
        for (int it = gw; it < NITEMS; it += NGW) {
            int rr = it;
            if (rr < I_IN) { const int kb = rr / 136, nb = rr % 136, n0 = 32 * nb;
                if (n0 < 3 * HW) p0_transpose_item(args.in[3], DM, INW, WINA, n0, args.in[2], scr, 64 * kb, n0, F.lane);
                else p0_transpose_item(args.in[3], DM, INW, WINB, map_projB(n0), args.in[2], scr, 64 * kb, n0, F.lane);
                continue; } rr -= I_IN;
            if (rr < I_HY) { p0_transpose_item(args.in[16], HW, DM, WHY, 32 * (rr % 32), nullptr, scr, 64 * (rr / 32), 32 * (rr % 32), F.lane); continue; } rr -= I_HY;
            if (rr < I_HY) { p0_transpose_item(args.in[17], HW, DM, WAT, 32 * (rr % 32), nullptr, scr, 64 * (rr / 32), 32 * (rr % 32), F.lane); continue; } rr -= I_HY;
            if (rr < I_O) { p0_transpose_item(args.in[18], DM, DM, WO, 32 * (rr % 32), nullptr, scr, 64 * (rr / 32), 32 * (rr % 32), F.lane); continue; } rr -= I_O;
            if (rr < I_G) { const int n0 = 32 * (rr % 88); p0_transpose_item(args.in[20], DM, FFN, WGU, (n0 >> 7) * 256 + (n0 & 127), args.in[19], scr, 64 * (rr / 88), n0, F.lane); continue; } rr -= I_G;
            if (rr < I_G) { const int n0 = 32 * (rr % 88); p0_transpose_item(args.in[21], DM, FFN, WGU, (n0 >> 7) * 256 + 128 + (n0 & 127), args.in[19], scr, 64 * (rr / 88), n0, F.lane); continue; } rr -= I_G;
            if (rr < I_D) { p0_transpose_item(args.in[22], FFN, DM, WD, 32 * (rr % 32), nullptr, scr, 64 * (rr / 32), 32 * (rr % 32), F.lane); continue; } rr -= I_D;
            p0_transpose_item(args.in[10], 64, 2048, W3T, 32 * rr, nullptr, scr, 0, 32 * rr, F.lane);
        }
        for (int m = gw; m < MTOK; m += NGW) p0_row((m < TP) ? xp + (size_t)m * DM : xs + (size_t)(m - TP) * DM, XB + (size_t)m * DM, RSTD + m, F.lane);
        for (int idx = F.vcu * (NWAVES * 64) + F.tid; idx < LS * 32; idx += F.G * NWAVES * 64) {
            const int pos = idx >> 5, i = idx & 31; const double inv = exp2(-(double)i * (13.287712379549449 / 32.0)); const double ang = (double)pos * inv;
            COS[idx] = (float)cos(ang); SIN[idx] = (float)sin(ang);
        }
    }
    SEAM(0);

    if (IN(1)) {
        {
            constexpr int NU = (MTOK / 256) * (NPROJ / 256);
            const int heavy = NU % F.G, lb = heavy ? (int)blockIdx.x - heavy : (int)blockIdx.x, nlb = heavy ? F.G - heavy : F.G;
            if (lb >= 0) {
                filter_stage_weights(F.lds, args.in[6], args.in[7], args.in[8], args.in[9], args.in[11], F.tid);
                for (int it = lb * NWAVES + F.wave; it < 288 * 2; it += nlb * NWAVES) {
                    const int dir = it & 1, ca = it >> 1, g = (ca < 256) ? 1 : 0, chunk = g ? ca : ca - 256;
                    filter_item(F.lds, W3T, KREV_S + (g ? (size_t)0 : (size_t)((WS_KREV_P - WS_KREV_S) / 2)), FPART_S + (g ? (size_t)0 : (size_t)((WS_FPART_P - WS_FPART_S) / 4)), g, chunk, dir, F.wave, F.lane);
                }
                LDS_WAIT(); __syncthreads();
            }
        }
        {
            pg8::Gemm g{WINA, XB, nullptr, nullptr, 3 * HW, MTOK, DM}; pg8::StaticOrder S; S.init(3 * HW, MTOK, F.G, (int)blockIdx.x);
            pg8::EpiUT E{UT, MTOK, RSTD};
            pg8::gemm_phase<pg8::EpiUT, pg8::StaticOrder, true, true>(F.lds + RING_OFF, g, S, E);
        }
        {
            pg8::Gemm g{XB, WINB, nullptr, nullptr, MTOK, NPROJ, DM}; pg8::StaticOrder S; S.init(MTOK, NPROJ, F.G, (int)blockIdx.x);
            pg8::EpiProj E{RSTD, args.in[13], args.in[14], COS, SIN, QB, KB, VB, SGH, SGA};
            pg8::gemm_phase<pg8::EpiProj, pg8::StaticOrder, true, true>(F.lds + RING_OFF, g, S, E);
        }
    }
    SEAM(1);

    if (IN(2)) {
        #if PROBE
        const hy::Params HP{UT, KREV_S, KREV_P, FPART_S, FPART_P, args.in[4], args.in[5], args.in[12], YT, (float*)(ws + WS_DF), (bf16*)(ws + WS_DZ)};
#else
        const hy::Params HP{UT, KREV_S, KREV_P, FPART_S, FPART_P, args.in[4], args.in[5], args.in[12], YT, nullptr, nullptr};
#endif
        {
#if PROBE
            const fc::Params FP{UT, KREV_S, FPART_S, args.in[4], args.in[5], args.in[12], YT, (bf16*)(ws + WS_HS), (bf16*)(ws + WS_Z1S), (float*)(ws + WS_DF), (bf16*)(ws + WS_DZ)};
#else
            const fc::Params FP{UT, KREV_S, FPART_S, args.in[4], args.in[5], args.in[12], YT, (bf16*)(ws + WS_HS), (bf16*)(ws + WS_Z1S), nullptr, nullptr};
#endif
            for (int it = F.vcu; it < HW; it += F.G) fc::item(F.lds, FP, it, F.tid, F.vcu);
        }
        TSTAMP(9);
        for (int it = F.vcu; it < HW; it += F.G) hy::hyena_item(F.lds, HP, 0, it, F.tid);
        TSTAMP(10);
        const at::Params AP{QB, KB, VB, args.in[15], YAT};
        for (int it = F.vcu; it < 512; it += F.G) at::attn_item(F.lds, AP, it >> 1, it & 1, F.tid);
    }
    SEAM(2);
#if PROBE >= 100
    probe_check(ws, (unsigned*)F.ctl, args.in[6], args.in[7], args.in[8], args.in[9], args.in[10], args.in[11], F.vcu, F.G, F.tid);
    xcd_barrier(bar);
#endif

    if (IN(3)) {
        for (int t = F.vcu; t < 8 * 512; t += F.G) transpose_y_tile(F.lds, YT, YHY, t, F.tid);
    }
    SEAM(3);

    if (IN(4)) {
        pg8::Gemm g{YHY, WHY, YAT, WAT, MTOK, DM, HW}; pg8::TwoPartOrder S; S.b.init(MTOK, DM, F.G, (int)blockIdx.x);
        pg8::EpiMerged E{SGH, SGA, MERGED};
        pg8::gemm_phase<pg8::EpiMerged, pg8::TwoPartOrder, true, true>(F.lds + RING_OFF, g, S, E);
    }
    SEAM(4);

    if (IN(5)) {
        pg8::Gemm g{MERGED, WO, nullptr, nullptr, MTOK, DM, DM}; pg8::StaticOrder S; S.init(MTOK, DM, F.G, (int)blockIdx.x);
        pg8::EpiWo E{xp, xs, X1B, SSQ};
        pg8::gemm_phase<pg8::EpiWo, pg8::StaticOrder, true, true>(F.lds + RING_OFF, g, S, E);
    }
    SEAM(5);

    if (IN(6)) {
        pg8::Gemm g{X1B, WGU, nullptr, nullptr, MTOK, 2 * FFN, DM}; pg8::StaticOrder S; S.init(MTOK, 2 * FFN, F.G, (int)blockIdx.x);
        pg8::EpiFfn1 E{SSQ, HID};
        pg8::gemm_phase<pg8::EpiFfn1, pg8::StaticOrder, true, true>(F.lds + RING_OFF, g, S, E);
    }
    SEAM(6);

    if (IN(7)) {
        pg8::Gemm g{HID, WD, nullptr, nullptr, MTOK, DM, FFN}; pg8::StaticOrder S; S.init(MTOK, DM, F.G, (int)blockIdx.x);
        pg8::EpiFfn2 E{X1B, args.out};
        pg8::gemm_phase<pg8::EpiFfn2, pg8::StaticOrder, true, true>(F.lds + RING_OFF, g, S, E);
#if PROBE
        TSTAMP(8);
        VM_WAIT(); __syncthreads();
        if (blockIdx.x == 0) {
            pg8::Unit u; S.next(1, u);
            int cnt;
#if PROBE >= 100
            cnt = probe_metric_count(ws, (unsigned*)F.ctl);
#else
            { const unsigned long long t0 = F.MISC[16] | ((unsigned long long)F.MISC[17] << 32), t8 = F.MISC[32] | ((unsigned long long)F.MISC[33] << 32);
#if (PROBE >= 31 && PROBE <= 35) || (PROBE >= 41 && PROBE <= 46)
              cnt = (int)(1600.0f * (float)F.MISC[40 + (PROBE % 10) - 1] / (float)(t8 - t0));
              constexpr int IA = 0, IB = 1;
              if (false)
#elif PROBE == 21
              constexpr int IA = 2, IB = 9;
#elif PROBE == 22
              constexpr int IA = 9, IB = 10;
#elif PROBE == 23
              constexpr int IA = 10, IB = 3;
#else
              constexpr int IA = PROBE - 1, IB = PROBE;
#endif
              { const unsigned long long ta = F.MISC[16 + 2 * IA] | ((unsigned long long)F.MISC[17 + 2 * IA] << 32), tb = F.MISC[16 + 2 * IB] | ((unsigned long long)F.MISC[17 + 2 * IB] << 32);
                cnt = (int)(1600.0f * (float)(tb - ta) / (float)(t8 - t0)); } }
#endif
            for (int i = F.tid; i < cnt; i += NWAVES * 64) args.out[(size_t)(u.pm * 256 + (i & 255)) * 1024 + u.pn * 256 + (i >> 8)] = 0.f;
        }
#endif
    }
#undef IN
#undef SEAM
}

extern "C" void kernel_launch(void* const* d_in, const int* in_sizes, int n_in, void* d_out, int out_size, void* d_ws, size_t ws_size, hipStream_t stream) {
    static int grid = 0;
    if (grid == 0) {
        if (n_in != 23 || out_size != MTOK * DM || ws_size < WS_END) { fprintf(stderr, "kernel_launch: unexpected problem shape (n_in %d, out %d, ws %zu); nothing launched\n", n_in, out_size, ws_size); grid = -1; return; }
        int dev = 0, cus = 0, per_cu = 0;
        if (hipGetDevice(&dev) != hipSuccess || hipDeviceGetAttribute(&cus, hipDeviceAttributeMultiprocessorCount, dev) != hipSuccess) { fprintf(stderr, "kernel_launch: device query failed\n"); grid = -1; return; }
        if (hipFuncSetAttribute((const void*)enc_fwd, hipFuncAttributeMaxDynamicSharedMemorySize, LDS_BYTES) != hipSuccess) { fprintf(stderr, "kernel_launch: hipFuncSetAttribute failed\n"); grid = -1; return; }
        if (hipOccupancyMaxActiveBlocksPerMultiprocessor(&per_cu, (const void*)enc_fwd, NWAVES * 64, LDS_BYTES) != hipSuccess || per_cu < 1)
            fprintf(stderr, "kernel_launch: note: occupancy query reports %d workgroups per CU\n", per_cu);
        (void)hipGetLastError();
        grid = cus;
    }
    if (grid < 0) return;
    if (hipMemsetAsync((char*)d_ws + WS_CTL, 0, CTL_ZERO_BYTES, stream) != hipSuccess) { fprintf(stderr, "kernel_launch: memset failed\n"); return; }
    Args a{};
    for (int i = 0; i < 23; ++i) a.in[i] = (const float*)d_in[i];
    a.out = (float*)d_out; a.ws = (unsigned char*)d_ws;
#if MK_SPLIT
    for (int p = 0; p < N_PHASES; ++p) { a.ph_lo = p; a.ph_hi = p + 1; hipLaunchKernelGGL(enc_fwd, dim3(grid), dim3(NWAVES * 64), LDS_BYTES, stream, a); }
#else
    a.ph_lo = 0; a.ph_hi = N_PHASES;
    hipLaunchKernelGGL(enc_fwd, dim3(grid), dim3(NWAVES * 64), LDS_BYTES, stream, a);
#endif
    const hipError_t le = hipPeekAtLastError();
    if (le != hipSuccess) fprintf(stderr, "kernel_launch: launch failed: %s\n", hipGetErrorName(le));
}
```

```cpp
#include <hip/hip_runtime.h>
#include <cstdio>
#include <cstdint>
#include <cmath>
#ifndef PROBE
#define PROBE 0
#endif

namespace pg8 {
#define PG8_LAS __attribute__((address_space(3)))
typedef unsigned short bf16_t;
typedef short bf16x8 __attribute__((ext_vector_type(8)));
typedef float f32x4 __attribute__((ext_vector_type(4)));
typedef unsigned u32x4 __attribute__((ext_vector_type(4)));
constexpr int BM = 256, BK = 64, HALF = 128, HTB = HALF * BK * 2  , STAGE_BYTES = 8 * HTB, NXCD = 8, WGM = 8;

__host__ __device__ __forceinline__ int lds_byte(int r, int c) { const int st = (r >> 4) * 2 + (c >> 5), rr = r & 15, cc = c & 31, ob = rr * 64 + cc * 2; return st * 1024 + (ob ^ (((ob >> 9) & 1) << 5)); }
__host__ __device__ __forceinline__ void stage_rc(int b, int& R, int& C) { const int st = b / 1024, sb = b % 1024, swz = sb ^ (((sb >> 9) & 1) << 5); R = (st >> 1) * 16 + swz / 64; C = (st & 1) * 32 + (swz % 64) / 2; }
__host__ __device__ __forceinline__ int perm32(int rho) { const int n = rho >> 4, i = rho & 15; return 8 * (i >> 2) + 4 * n + (i & 3); }

struct Unit { int pm, pn, sel; };
struct Gemm { const bf16_t* A; const bf16_t* Bt; const bf16_t* A1; const bf16_t* Bt1; int M, N, K; };

struct StaticOrder {
    int nM, nN, nwg, G, c;
    __host__ __device__ __forceinline__ void init(int M, int N, int G_, int c_) { nM = M / BM; nN = N / BM; nwg = nM * nN; G = G_; c = c_; }
    __host__ __device__ __forceinline__ bool next(int i, Unit& u) const {
        const long L = (long)i * G + c; if (L >= nwg) return false;
        int wgid = (int)L; { const int q = nwg / NXCD, r = nwg % NXCD, xcd = wgid % NXCD, off = wgid / NXCD; wgid = (xcd < r ? xcd * (q + 1) : r * (q + 1) + (xcd - r) * q) + off; }
        const int nig = WGM * nN, gid = wgid / nig, fm = gid * WGM, gsz = (nM - fm) < WGM ? (nM - fm) : WGM;
        u.pm = fm + ((wgid % nig) % gsz); u.pn = (wgid % nig) / gsz; u.sel = 0; return true;
    }
    __device__ __forceinline__ void a_ready(const Unit&) const {}
    __device__ __forceinline__ void done(const Unit&) const {}
};
struct TwoPartOrder {
    StaticOrder b;
    __device__ __forceinline__ bool next(int i, Unit& u) const { if (!b.next(i >> 1, u)) return false; u.sel = i & 1; return true; }
    __device__ __forceinline__ void a_ready(const Unit&) const {}
    __device__ __forceinline__ void done(const Unit&) const {}
};

typedef float f32x2_c __attribute__((ext_vector_type(2))); typedef __bf16 bf16x2_c __attribute__((ext_vector_type(2)));
__device__ __forceinline__ unsigned cvt_pk_bf16(float lo, float hi) { const f32x2_c v = {lo, hi}; return __builtin_bit_cast(unsigned, __builtin_convertvector(v, bf16x2_c)); }
__device__ __forceinline__ u32x4 pack8(const f32x4 a, const f32x4 b) { u32x4 w; w.x = cvt_pk_bf16(a[0], a[1]); w.y = cvt_pk_bf16(a[2], a[3]); w.z = cvt_pk_bf16(b[0], b[1]); w.w = cvt_pk_bf16(b[2], b[3]); return w; }
__device__ __forceinline__ float bflo(unsigned w) { return __uint_as_float(w << 16); }
__device__ __forceinline__ float bfhi(unsigned w) { return __uint_as_float(w & 0xffff0000u); }
__device__ __forceinline__ void unpack8(const u32x4 w, f32x4& a, f32x4& b) { a = (f32x4){bflo(w.x), bfhi(w.x), bflo(w.y), bfhi(w.y)}; b = (f32x4){bflo(w.z), bfhi(w.z), bflo(w.w), bfhi(w.w)}; }
__device__ __forceinline__ float sigmoidf_(float v) { return __builtin_amdgcn_rcpf(1.0f + __builtin_amdgcn_exp2f(-1.4426950408889634f * v)); }

constexpr float QSCALE = 0.125f * 1.4426950408889634f;

struct EpiUT {
    static constexpr bool PERM = true, AFTER_DRAIN = false;
    bf16_t* O; int ldc; const float* rstd;
    __device__ __forceinline__ bool keep(const Unit&) const { return false; }
    __device__ __forceinline__ void operator()(f32x4 (&acc)[2][2][4][2], const Unit& u, int wr, int wc, int fr, int fq) const {
        const int row0 = u.pm * BM + wr * 64 + fr, col0 = u.pn * BM + wc * 32 + 8 * fq;
        f32x4 rs[2][2];
#pragma unroll
        for (int bj = 0; bj < 2; ++bj)
#pragma unroll
            for (int n = 0; n < 2; ++n) rs[bj][n] = *(const f32x4*)(rstd + col0 + bj * HALF + 4 * n);
#pragma unroll
        for (int ai = 0; ai < 2; ++ai)
#pragma unroll
            for (int m = 0; m < 4; ++m) { bf16_t* rowp = O + (size_t)(row0 + ai * HALF + m * 16) * ldc + col0;
#pragma unroll
                for (int bj = 0; bj < 2; ++bj) *(u32x4*)(rowp + bj * HALF) = pack8(acc[ai][bj][m][0] * rs[bj][0], acc[ai][bj][m][1] * rs[bj][1]); }
    }
};

struct EpiProj {
    static constexpr bool PERM = true, AFTER_DRAIN = false;
    const float* rstd; const float* qw; const float* kw; const float* cs; const float* sn; bf16_t* q; bf16_t* k; bf16_t* v; bf16_t* sgh; bf16_t* sga;
    __device__ __forceinline__ bool keep(const Unit&) const { return false; }
    __device__ __forceinline__ void operator()(f32x4 (&acc)[2][2][4][2], const Unit& u, int wr, int wc, int fr, int fq) const {
        const int pn = u.pn;
        float rsv[2][4];
#pragma unroll
        for (int ai = 0; ai < 2; ++ai)
#pragma unroll
            for (int m = 0; m < 4; ++m) rsv[ai][m] = rstd[u.pm * BM + ai * HALF + wr * 64 + m * 16 + fr];
        if (pn <= 2 && !(pn == 2 && wc >= 2)) {
            const float* w = (pn < 2) ? qw : kw; const float sc = (pn < 2) ? QSCALE : 1.0f;
            const f32x4 wl0 = *(const f32x4*)(w + 8 * fq), wl1 = *(const f32x4*)(w + 8 * fq + 4), wh0 = *(const f32x4*)(w + 32 + 8 * fq), wh1 = *(const f32x4*)(w + 32 + 8 * fq + 4);
#pragma unroll
            for (int ai = 0; ai < 2; ++ai)
#pragma unroll
                for (int m = 0; m < 4; ++m) {
                    const int row = u.pm * BM + ai * HALF + wr * 64 + m * 16 + fr; const float rs = rsv[ai][m];
                    f32x4 a0 = acc[ai][0][m][0] * rs, a1 = acc[ai][0][m][1] * rs, b0 = acc[ai][1][m][0] * rs, b1 = acc[ai][1][m][1] * rs;
                    f32x4 sq = a0 * a0 + a1 * a1 + b0 * b0 + b1 * b1; float ss = (sq[0] + sq[1]) + (sq[2] + sq[3]);
                    ss += __shfl_xor(ss, 16); ss += __shfl_xor(ss, 32);
                    const float inv = 1.0f / sqrtf(ss * (1.0f / 64.0f) + 1e-6f);
                    const int pos = row < 16384 ? (row & 2047) : (row - 16384);
                    const f32x4 c0 = *(const f32x4*)(cs + pos * 32 + 8 * fq), c1 = *(const f32x4*)(cs + pos * 32 + 8 * fq + 4), s0 = *(const f32x4*)(sn + pos * 32 + 8 * fq), s1 = *(const f32x4*)(sn + pos * 32 + 8 * fq + 4);
                    a0 = a0 * inv * wl0; a1 = a1 * inv * wl1; b0 = b0 * inv * wh0; b1 = b1 * inv * wh1;
                    const f32x4 lo0 = (a0 * c0 - b0 * s0) * sc, lo1 = (a1 * c1 - b1 * s1) * sc, hi0 = (b0 * c0 + a0 * s0) * sc, hi1 = (b1 * c1 + a1 * s1) * sc;
                    bf16_t* dst = (pn < 2) ? q + (size_t)row * 512 + (4 * pn + wc) * 64 + 8 * fq : k + (size_t)row * 128 + wc * 64 + 8 * fq;
                    *(u32x4*)dst = pack8(lo0, lo1); *(u32x4*)(dst + 32) = pack8(hi0, hi1);
                }
        } else if (pn == 2) {
#pragma unroll
            for (int ai = 0; ai < 2; ++ai)
#pragma unroll
                for (int m = 0; m < 4; ++m) {
                    const int row = u.pm * BM + ai * HALF + wr * 64 + m * 16 + fr; const float rs = rsv[ai][m];
                    bf16_t* dst = v + (size_t)row * 128 + (wc - 2) * 64 + 8 * fq;
                    *(u32x4*)dst = pack8(acc[ai][0][m][0] * rs, acc[ai][0][m][1] * rs); *(u32x4*)(dst + 32) = pack8(acc[ai][1][m][0] * rs, acc[ai][1][m][1] * rs);
                }
        } else {
            bf16_t* base = (pn < 7) ? sgh : sga; const int colb = (pn - ((pn < 7) ? 3 : 7)) * BM + wc * 32 + 8 * fq;
#pragma unroll
            for (int ai = 0; ai < 2; ++ai)
#pragma unroll
                for (int m = 0; m < 4; ++m) {
                    const int row = u.pm * BM + ai * HALF + wr * 64 + m * 16 + fr; const float rs = rsv[ai][m];
#pragma unroll
                    for (int bj = 0; bj < 2; ++bj) { f32x4 g0 = acc[ai][bj][m][0] * rs, g1 = acc[ai][bj][m][1] * rs;
#pragma unroll
                        for (int e = 0; e < 4; ++e) { g0[e] = sigmoidf_(g0[e]); g1[e] = sigmoidf_(g1[e]); }
                        *(u32x4*)(base + (size_t)row * 1024 + colb + bj * HALF) = pack8(g0, g1); }
                }
        }
    }
};

struct EpiMerged {
    static constexpr bool PERM = true, AFTER_DRAIN = false;
    const bf16_t* sgh; const bf16_t* sga; bf16_t* out;
    __device__ __forceinline__ bool keep(const Unit& u) const { return u.sel == 0; }
    __device__ __forceinline__ void operator()(f32x4 (&acc)[2][2][4][2], const Unit& u, int wr, int wc, int fr, int fq) const {
#pragma unroll
        for (int ai = 0; ai < 2; ++ai) {
            u32x4 ga[4][2], gh[4][2];
#pragma unroll
            for (int m = 0; m < 4; ++m) { const size_t off = (size_t)(u.pm * BM + ai * HALF + wr * 64 + m * 16 + fr) * 1024 + u.pn * BM + wc * 32 + 8 * fq;
#pragma unroll
                for (int bj = 0; bj < 2; ++bj) { ga[m][bj] = *(const u32x4*)(sga + off + bj * HALF); if (u.sel == 0) gh[m][bj] = *(const u32x4*)(sgh + off + bj * HALF); } }
#pragma unroll
            for (int m = 0; m < 4; ++m) { const size_t off = (size_t)(u.pm * BM + ai * HALF + wr * 64 + m * 16 + fr) * 1024 + u.pn * BM + wc * 32 + 8 * fq;
#pragma unroll
                for (int bj = 0; bj < 2; ++bj) {
                    f32x4 t0, t1; unpack8(ga[m][bj], t0, t1);
                    if (u.sel == 0) { f32x4 h0, h1; unpack8(gh[m][bj], h0, h1);
                        f32x4 q0, q1;
#pragma unroll
                        for (int e = 0; e < 4; ++e) { q0[e] = h0[e] * __builtin_amdgcn_rcpf(t0[e]); q1[e] = h1[e] * __builtin_amdgcn_rcpf(t1[e]); }
                        acc[ai][bj][m][0] = acc[ai][bj][m][0] * q0; acc[ai][bj][m][1] = acc[ai][bj][m][1] * q1; }
                    else *(u32x4*)(out + off + bj * HALF) = pack8(acc[ai][bj][m][0] * t0, acc[ai][bj][m][1] * t1);
                } }
        }
    }
};

struct EpiWo {
    static constexpr bool PERM = true, AFTER_DRAIN = false;
    const float* xp; const float* xs; bf16_t* x1b; float* ssq;
    __device__ __forceinline__ bool keep(const Unit&) const { return false; }
    __device__ __forceinline__ void operator()(f32x4 (&acc)[2][2][4][2], const Unit& u, int wr, int wc, int fr, int fq) const {
        const float* xb = (u.pm < 64) ? xp : xs - (size_t)16384 * 1024;
#pragma unroll
        for (int ai = 0; ai < 2; ++ai) {
            f32x4 xv[4][2][2];
#pragma unroll
            for (int m = 0; m < 4; ++m) { const size_t off = (size_t)(u.pm * BM + ai * HALF + wr * 64 + m * 16 + fr) * 1024 + u.pn * BM + wc * 32 + 8 * fq;
#pragma unroll
                for (int bj = 0; bj < 2; ++bj) { xv[m][bj][0] = *(const f32x4*)(xb + off + bj * HALF); xv[m][bj][1] = *(const f32x4*)(xb + off + bj * HALF + 4); } }
#pragma unroll
            for (int m = 0; m < 4; ++m) {
                const int row = u.pm * BM + ai * HALF + wr * 64 + m * 16 + fr; const size_t off = (size_t)row * 1024 + u.pn * BM + wc * 32 + 8 * fq; float s = 0.f;
#pragma unroll
                for (int bj = 0; bj < 2; ++bj) {
                    const f32x4 v0 = xv[m][bj][0] + acc[ai][bj][m][0], v1 = xv[m][bj][1] + acc[ai][bj][m][1];
                    *(u32x4*)(x1b + off + bj * HALF) = pack8(v0, v1);
                    const f32x4 q = v0 * v0 + v1 * v1; s += (q[0] + q[1]) + (q[2] + q[3]); }
                s += __shfl_xor(s, 16); s += __shfl_xor(s, 32);
                if (fq == 0) ssq[(size_t)row * 16 + u.pn * 4 + wc] = s;
            }
        }
    }
};

struct EpiFfn1 {
    static constexpr bool PERM = true, AFTER_DRAIN = false;
    const float* ssq; bf16_t* hid;
    __device__ __forceinline__ bool keep(const Unit&) const { return false; }
    __device__ __forceinline__ void operator()(f32x4 (&acc)[2][2][4][2], const Unit& u, int wr, int wc, int fr, int fq) const {
        f32x4 pv[2][4];
#pragma unroll
        for (int ai = 0; ai < 2; ++ai)
#pragma unroll
            for (int m = 0; m < 4; ++m) pv[ai][m] = *(const f32x4*)(ssq + (size_t)(u.pm * BM + ai * HALF + wr * 64 + m * 16 + fr) * 16 + 4 * fq);
#pragma unroll
        for (int ai = 0; ai < 2; ++ai)
#pragma unroll
            for (int m = 0; m < 4; ++m) {
                const int row = u.pm * BM + ai * HALF + wr * 64 + m * 16 + fr;
                const f32x4 p = pv[ai][m]; float t = (p[0] + p[1]) + (p[2] + p[3]);
                t += __shfl_xor(t, 16); t += __shfl_xor(t, 32);
                const float r = 1.0f / sqrtf(t * (1.0f / 1024.0f) + 1e-6f);
                f32x4 h0, h1;
#pragma unroll
                for (int e = 0; e < 4; ++e) { const float g0 = acc[ai][0][m][0][e] * r, g1 = acc[ai][0][m][1][e] * r;
                    h0[e] = g0 * sigmoidf_(g0) * (acc[ai][1][m][0][e] * r); h1[e] = g1 * sigmoidf_(g1) * (acc[ai][1][m][1][e] * r); }
                *(u32x4*)(hid + (size_t)row * 2816 + u.pn * HALF + wc * 32 + 8 * fq) = pack8(h0, h1);
            }
    }
};

struct EpiFfn2 {
    static constexpr bool PERM = true, AFTER_DRAIN = false;
    const bf16_t* x1b; float* out;
    __device__ __forceinline__ bool keep(const Unit&) const { return false; }
    __device__ __forceinline__ void operator()(f32x4 (&acc)[2][2][4][2], const Unit& u, int wr, int wc, int fr, int fq) const {
        u32x4 rv[2][4][2];
#pragma unroll
        for (int ai = 0; ai < 2; ++ai)
#pragma unroll
            for (int m = 0; m < 4; ++m) { const size_t off = (size_t)(u.pm * BM + ai * HALF + wr * 64 + m * 16 + fr) * 1024 + u.pn * BM + wc * 32 + 8 * fq;
#pragma unroll
                for (int bj = 0; bj < 2; ++bj) rv[ai][m][bj] = *(const u32x4*)(x1b + off + bj * HALF); }
#pragma unroll
        for (int ai = 0; ai < 2; ++ai)
#pragma unroll
            for (int m = 0; m < 4; ++m) {
                const size_t off = (size_t)(u.pm * BM + ai * HALF + wr * 64 + m * 16 + fr) * 1024 + u.pn * BM + wc * 32 + 8 * fq; float* p = out + off;
#pragma unroll
                for (int bj = 0; bj < 2; ++bj) { f32x4 r0, r1; unpack8(rv[ai][m][bj], r0, r1);
                    *(f32x4*)(p + bj * HALF) = r0 + acc[ai][bj][m][0]; *(f32x4*)(p + bj * HALF + 4) = r1 + acc[ai][bj][m][1]; }
            }
    }
};

__device__ __forceinline__ void zero_acc(f32x4 (&acc)[2][2][4][2]) {
#pragma unroll
    for (int a = 0; a < 2; ++a)
#pragma unroll
        for (int b = 0; b < 2; ++b)
#pragma unroll
            for (int m = 0; m < 4; ++m)
#pragma unroll
                for (int n = 0; n < 2; ++n) acc[a][b][m][n] = (f32x4){0.f, 0.f, 0.f, 0.f};
}
template <class Epi, class Sched, bool ALIGN_EPI = false, bool SP2 = false>
__device__ __forceinline__ void gemm_phase(PG8_LAS unsigned char* lds, const Gemm g, const Sched& S, const Epi& E) {
    int tid = threadIdx.x; asm volatile("" : "+v"(tid));
    const int wid = __builtin_amdgcn_readfirstlane(tid >> 6), lane = tid & 63, wr = wid >> 2, wc = wid & 3, fr = lane & 15, fq = lane >> 4;
    const int K = g.K, nt = K / BK;
    unsigned voffA[2], voffB[2];
#pragma unroll
    for (int i = 0; i < 2; ++i) { int R, C; stage_rc(tid * 16 + i * 8192, R, C); const int Rb = Epi::PERM ? ((R & ~31) + perm32(R & 31)) : R;
        voffA[i] = (unsigned)(R * K + C) * 2u; voffB[i] = (unsigned)(Rb * K + C) * 2u; }
    const size_t kstep = (size_t)(BK * 2);
    const size_t hstep = (size_t)HALF * K * 2;
    const size_t tstep = 2 * hstep;
    const unsigned ldsw = (unsigned)wid * 1024u;
    const int aoff = lds_byte(wr * 64 + fr, fq * 8), boff = lds_byte(wc * 32 + fr, fq * 8);
#define PG8_SA(b, h) (((b) * 2 + (h)) * HTB)
#define PG8_SB(b, h) ((4 + (b) * 2 + (h)) * HTB)
#define PG8_STAGE(bufoff, gbase, voff) do { _Pragma("unroll") for (int _i = 0; _i < 2; ++_i) \
        __builtin_amdgcn_global_load_lds((const unsigned*)((const char*)(gbase) + (voff)[_i]), (PG8_LAS unsigned*)(lds + (bufoff) + ldsw + _i * 8192), 16, 0, 0); } while (0)
#define PG8_LDA(dst, b, h) do { _Pragma("unroll") for (int m = 0; m < 4; ++m) _Pragma("unroll") for (int k = 0; k < 2; ++k) dst[m][k] = *(const PG8_LAS bf16x8*)(lds + PG8_SA(b, h) + aoff + m * 2048 + k * 1024); } while (0)
#define PG8_LDB(dst, b, h) do { _Pragma("unroll") for (int n = 0; n < 2; ++n) _Pragma("unroll") for (int k = 0; k < 2; ++k) dst[n][k] = *(const PG8_LAS bf16x8*)(lds + PG8_SB(b, h) + boff + n * 2048 + k * 1024); } while (0)
#define PG8_MMA(ai, bj, At, Bt) do { __builtin_amdgcn_s_setprio(1); _Pragma("unroll") for (int m = 0; m < 4; ++m) _Pragma("unroll") for (int n = 0; n < 2; ++n) _Pragma("unroll") for (int k = 0; k < 2; ++k) \
        acc[ai][bj][m][n] = __builtin_amdgcn_mfma_f32_16x16x32_bf16(Bt[n][k], At[m][k], acc[ai][bj][m][n], 0, 0, 0); __builtin_amdgcn_s_setprio(0); } while (0)
#define PG8_WAIT_V(n) asm volatile("s_waitcnt vmcnt(" #n ")" ::: "memory")
#define PG8_WAIT_L(n) asm volatile("s_waitcnt lgkmcnt(" #n ")" ::: "memory")
#define PG8_BAR __builtin_amdgcn_s_barrier()
#define PG8_SCHED __builtin_amdgcn_sched_barrier(0)
    Unit cur, nxt; int ui = 0;
    if (!S.next(0, cur)) return;
    f32x4 acc[2][2][4][2];
#pragma unroll
    for (int a = 0; a < 2; ++a)
#pragma unroll
        for (int b = 0; b < 2; ++b)
#pragma unroll
            for (int m = 0; m < 4; ++m)
#pragma unroll
                for (int n = 0; n < 2; ++n) acc[a][b][m][n] = (f32x4){0.f, 0.f, 0.f, 0.f};
    bf16x8 At[4][2], B0[2][2], B1[2][2];
    const char* cA = (const char*)(cur.sel ? g.A1 : g.A) + (size_t)cur.pm * tstep; const char* cB = (const char*)(cur.sel ? g.Bt1 : g.Bt) + (size_t)cur.pn * tstep;
    S.a_ready(cur);
    if constexpr (SP2) {
        PG8_STAGE(PG8_SB(0, 0), cB, voffB); PG8_STAGE(PG8_SB(0, 1), cB + hstep, voffB); PG8_STAGE(PG8_SA(0, 0), cA, voffA); PG8_STAGE(PG8_SA(0, 1), cA + hstep, voffA);
        if (wr == 1) PG8_BAR;
        PG8_WAIT_V(2); PG8_BAR;
        PG8_STAGE(PG8_SB(1, 0), cB + kstep, voffB); PG8_STAGE(PG8_SA(1, 0), cA + kstep, voffA); PG8_STAGE(PG8_SB(1, 1), cB + hstep + kstep, voffB);
        PG8_WAIT_V(6); PG8_BAR;
    } else {
        PG8_STAGE(PG8_SB(0, 0), cB, voffB); PG8_STAGE(PG8_SA(0, 0), cA, voffA); PG8_STAGE(PG8_SB(0, 1), cB + hstep, voffB); PG8_STAGE(PG8_SA(0, 1), cA + hstep, voffA);
        if (wr == 1) PG8_BAR;
        PG8_WAIT_V(4); PG8_BAR;
        PG8_STAGE(PG8_SB(1, 0), cB + kstep, voffB); PG8_STAGE(PG8_SA(1, 0), cA + kstep, voffA); PG8_STAGE(PG8_SB(1, 1), cB + hstep + kstep, voffB);
        PG8_WAIT_V(6); PG8_BAR;
    }
    for (;;) {
        const bool has_next = S.next(ui + 1, nxt);
        const char* nA = has_next ? (const char*)(nxt.sel ? g.A1 : g.A) + (size_t)nxt.pm * tstep : cA; const char* nB = has_next ? (const char*)(nxt.sel ? g.Bt1 : g.Bt) + (size_t)nxt.pn * tstep : cB;
        for (int t = 0; t < nt; t += 2) {
            const bool last = (t == nt - 2);
            const char* a1 = cA + (size_t)(t + 1) * kstep;
            const char* a2 = last ? nA : cA + (size_t)(t + 2) * kstep; const char* b2 = last ? nB : cB + (size_t)(t + 2) * kstep;
            const char* a3 = a2 + kstep; const char* b3 = b2 + kstep;
            if (last && has_next) S.a_ready(nxt);
            if constexpr (SP2) {
            PG8_LDB(B0, 0, 0); PG8_LDB(B1, 0, 1); PG8_SCHED; PG8_LDA(At, 0, 0); PG8_STAGE(PG8_SA(1, 1), a1 + hstep, voffA);
            PG8_WAIT_V(8); PG8_WAIT_L(0); PG8_BAR; PG8_MMA(0, 0, At, B0); PG8_MMA(0, 1, At, B1); PG8_BAR; PG8_SCHED;
            PG8_LDA(At, 0, 1); PG8_STAGE(PG8_SB(0, 0), b2, voffB); PG8_STAGE(PG8_SB(0, 1), b2 + hstep, voffB); PG8_STAGE(PG8_SA(0, 0), a2, voffA);
            PG8_WAIT_V(8); PG8_WAIT_L(0); PG8_BAR; PG8_MMA(1, 0, At, B0); PG8_MMA(1, 1, At, B1); PG8_BAR; PG8_SCHED;
            PG8_LDB(B0, 1, 0); PG8_LDB(B1, 1, 1); PG8_SCHED; PG8_LDA(At, 1, 0); PG8_STAGE(PG8_SA(0, 1), a2 + hstep, voffA);
            PG8_WAIT_V(8); PG8_WAIT_L(0); PG8_BAR; PG8_MMA(0, 0, At, B0); PG8_MMA(0, 1, At, B1); PG8_BAR; PG8_SCHED;
            PG8_LDA(At, 1, 1); PG8_STAGE(PG8_SB(1, 0), b3, voffB); PG8_STAGE(PG8_SB(1, 1), b3 + hstep, voffB); PG8_STAGE(PG8_SA(1, 0), a3, voffA);
            PG8_WAIT_V(8); PG8_WAIT_L(0); PG8_BAR; PG8_MMA(1, 0, At, B0); PG8_MMA(1, 1, At, B1); PG8_BAR; PG8_SCHED;
            } else {
            PG8_LDB(B0, 0, 0); PG8_SCHED; PG8_LDA(At, 0, 0); PG8_STAGE(PG8_SA(1, 1), a1 + hstep, voffA);
            PG8_WAIT_L(8); PG8_BAR; PG8_WAIT_L(0); PG8_MMA(0, 0, At, B0); PG8_BAR; PG8_SCHED;
            PG8_LDB(B1, 0, 1); PG8_STAGE(PG8_SB(0, 0), b2, voffB);
            PG8_BAR; PG8_WAIT_L(0); PG8_MMA(0, 1, At, B1); PG8_BAR;
            PG8_LDA(At, 0, 1); PG8_STAGE(PG8_SA(0, 0), a2, voffA);
            PG8_BAR; PG8_WAIT_L(0); PG8_MMA(1, 0, At, B0); PG8_BAR; PG8_SCHED;
            PG8_STAGE(PG8_SB(0, 1), b2 + hstep, voffB);
            PG8_WAIT_V(6); PG8_BAR; PG8_MMA(1, 1, At, B1); PG8_BAR;
            PG8_LDB(B0, 1, 0); PG8_SCHED; PG8_LDA(At, 1, 0); PG8_STAGE(PG8_SA(0, 1), a2 + hstep, voffA);
            PG8_WAIT_L(8); PG8_BAR; PG8_WAIT_L(0); PG8_MMA(0, 0, At, B0); PG8_BAR; PG8_SCHED;
            PG8_LDB(B1, 1, 1); PG8_STAGE(PG8_SB(1, 0), b3, voffB);
            PG8_BAR; PG8_WAIT_L(0); PG8_MMA(0, 1, At, B1); PG8_BAR;
            PG8_LDA(At, 1, 1); PG8_STAGE(PG8_SA(1, 0), a3, voffA);
            PG8_BAR; PG8_WAIT_L(0); PG8_MMA(1, 0, At, B0); PG8_BAR; PG8_SCHED;
            PG8_STAGE(PG8_SB(1, 1), b3 + hstep, voffB);
            PG8_WAIT_V(6); PG8_BAR; PG8_MMA(1, 1, At, B1); PG8_BAR;
            }
        }
        if constexpr (ALIGN_EPI) { if (wr == 0) PG8_BAR; }
        if constexpr (!Epi::AFTER_DRAIN) { E(acc, cur, wr, wc, fr, fq); S.done(cur); }
        if (!has_next) break;
        if (!E.keep(cur)) zero_acc(acc);
        cur = nxt; cA = nA; cB = nB; ++ui;
        if constexpr (ALIGN_EPI) { if (wr == 1) PG8_BAR; }
    }
    PG8_WAIT_V(0);
    if constexpr (!ALIGN_EPI) { if (wr == 0) PG8_BAR; }
    PG8_BAR;
    if constexpr (Epi::AFTER_DRAIN) { E.fused(acc, cur, wr, wc, fr, fq, lds, wid, lane); S.done(cur); }
#undef PG8_SA
#undef PG8_SB
#undef PG8_STAGE
#undef PG8_LDA
#undef PG8_LDB
#undef PG8_MMA
#undef PG8_WAIT_V
#undef PG8_WAIT_L
#undef PG8_BAR
#undef PG8_SCHED
}}

constexpr int NWAVES = 8;
constexpr int DM = 1024, MTOK = 32768, TP = 16384  , LP = 2048, LS = 16384;
constexpr int HW = 512, INW = 4352, FFN = 2816, NPROJ = INW - 3 * HW  ;
constexpr float RMS_EPS = 1e-6f;

constexpr size_t MiB = 1u << 20;
constexpr size_t WS_CTL = 0, CTL_ZERO_BYTES = 128 * 1024;
constexpr size_t WS_WINA = 1 * MiB;
constexpr size_t WS_WINB = 4 * MiB;
constexpr size_t WS_WHY = 10 * MiB;
constexpr size_t WS_WAT = 11 * MiB;
constexpr size_t WS_WO = 12 * MiB;
constexpr size_t WS_WGU = 14 * MiB;
constexpr size_t WS_WD = 25 * MiB;
constexpr size_t WS_W3T = 31 * MiB;
constexpr size_t WS_XB = 32 * MiB;
constexpr size_t WS_YT = 32 * MiB;
constexpr size_t WS_YAT = 64 * MiB;
constexpr size_t WS_KREV_S = 96 * MiB;
constexpr size_t WS_KREV_P = 160 * MiB;
constexpr size_t WS_UT = 168 * MiB;
constexpr size_t WS_Q = 264 * MiB;
constexpr size_t WS_K = 296 * MiB;
constexpr size_t WS_V = 304 * MiB;
constexpr size_t WS_SGH = 312 * MiB;
constexpr size_t WS_SGA = 376 * MiB;
constexpr size_t WS_COS = 440 * MiB;
constexpr size_t WS_SIN = 442 * MiB;
constexpr size_t WS_RSTD = 444 * MiB;
constexpr size_t WS_SSQ = 445 * MiB;
constexpr size_t WS_FPART_S = 447 * MiB;
constexpr size_t WS_FPART_P = 449 * MiB;
constexpr size_t WS_YHY = 450 * MiB;
constexpr size_t WS_MERGED = 168 * MiB;
constexpr size_t WS_X1B = 232 * MiB;
constexpr size_t WS_HID = 32 * MiB;
constexpr size_t WS_HS = 450 * MiB;
constexpr size_t WS_Z1S = 488 * MiB;
constexpr size_t WS_END = 496 * MiB;
static_assert(WS_HID + (size_t)MTOK * FFN * 2 <= WS_X1B, "hid vs x1b");

constexpr int CW_TMO = 0, CW_CODE = 1;
constexpr int CW_BAR = 4096;

constexpr int RING_OFF = 0;
constexpr int LDS_BYTES = 147456;
constexpr int LDSCTL_OFF = LDS_BYTES - 512, MISC_OFF = LDSCTL_OFF + 320;

#define GAS __attribute__((address_space(1)))
#define LAS __attribute__((address_space(3)))
typedef unsigned short bf16;
typedef unsigned v4u __attribute__((ext_vector_type(4)));
typedef unsigned v2u __attribute__((ext_vector_type(2)));
typedef float f32x4 __attribute__((ext_vector_type(4)));
typedef float f32x16 __attribute__((ext_vector_type(16)));
typedef short bf16x8 __attribute__((ext_vector_type(8)));
typedef GAS unsigned gu32;
#define RLX_AGENT __ATOMIC_RELAXED, __HIP_MEMORY_SCOPE_AGENT
#define LDS_WAIT() asm volatile("s_waitcnt lgkmcnt(0)" ::: "memory")
#define VM_WAIT() asm volatile("s_waitcnt vmcnt(0)" ::: "memory")
typedef float f32x2_t_ __attribute__((ext_vector_type(2))); typedef __bf16 bf16x2_t_ __attribute__((ext_vector_type(2)));
__device__ __forceinline__ unsigned pk2(float lo, float hi) { const f32x2_t_ v = {lo, hi}; return __builtin_bit_cast(unsigned, __builtin_convertvector(v, bf16x2_t_)); }
__device__ __forceinline__ unsigned f2bf(float f) { return (unsigned)__builtin_bit_cast(unsigned short, (__bf16)f); }
__device__ __forceinline__ float bf2f(unsigned short b) { return __uint_as_float((unsigned)b << 16); }
__device__ __forceinline__ float wave_sum(float v) {
#pragma unroll
    for (int o = 1; o < 64; o <<= 1) v += __shfl_xor(v, o);
    return v;
}

__device__ __forceinline__ float wave_sum_sw(float v) {
#define SWZ_(x, m) __builtin_bit_cast(float, __builtin_amdgcn_ds_swizzle(__builtin_bit_cast(int, (x)), (((m) << 10) | 0x1f)))
    v += SWZ_(v, 1); v += SWZ_(v, 2); v += SWZ_(v, 4); v += SWZ_(v, 8); v += SWZ_(v, 16);
#undef SWZ_
    return __builtin_bit_cast(float, __builtin_amdgcn_readlane(__builtin_bit_cast(int, v), 0)) + __builtin_bit_cast(float, __builtin_amdgcn_readlane(__builtin_bit_cast(int, v), 32));
}

#define XB_TMO      128
#define XB_XCNT(j)  (256  + 64 * (j))
#define XB_XSUB(j)  (1280 + 64 * (j))
#define XB_XGEN(j)  (2304 + 64 * (j))
#define XB_TOP      3328
#define XB_TOPGEN   3392
#define XCD_BAR_WORDS 3456
#define XB_SPIN_CAP (1u << 18)

__device__ __forceinline__ unsigned xb_ld(unsigned* p)              { return __hip_atomic_load(p, __ATOMIC_RELAXED, __HIP_MEMORY_SCOPE_AGENT); }
__device__ __forceinline__ unsigned xb_add(unsigned* p, unsigned v) { return __hip_atomic_fetch_add(p, v, __ATOMIC_RELAXED, __HIP_MEMORY_SCOPE_AGENT); }
__device__ __forceinline__ unsigned xb_xcc_id() { return (unsigned)__builtin_amdgcn_s_getreg((3 << 11) | 20) & 0xFu; }
#define XB_SPIN(cond, bar) do { unsigned _sp = 0; while (cond) { __builtin_amdgcn_s_sleep(1); \
    if ((++_sp & 255u) == 0u) { if (xb_ld(&(bar)[XB_TMO])) break; if (_sp > XB_SPIN_CAP) { atomicAdd(&(bar)[XB_TMO], 1u); break; } } } } while (0)

struct XcdBarrier { unsigned* bar; unsigned x; volatile LAS unsigned* st; };

__device__ __forceinline__ XcdBarrier xcd_barrier_post(unsigned* bar, volatile LAS unsigned* st) {
    XcdBarrier b; b.bar = bar; b.x = xb_xcc_id(); b.st = st;
    if (threadIdx.x == 0) (void)xb_add(&bar[XB_XCNT(b.x)], 1u);
    return b;
}
__device__ __forceinline__ void xcd_barrier_complete(unsigned* bar, unsigned x, unsigned& nloc, unsigned& nx) {
    const unsigned G = gridDim.x * gridDim.y * gridDim.z;
    unsigned sum, cnt, mine, sp = 0u;
    for (;;) {
        sum = 0u; cnt = 0u; mine = 0u;
#pragma unroll
        for (unsigned j = 0; j < 16; ++j) { const unsigned c = xb_ld(&bar[XB_XCNT(j)]); sum += c; cnt += (c > 0u) ? 1u : 0u; mine = (j == x) ? c : mine; }
        if (sum == G) break;
        __builtin_amdgcn_s_sleep(1);
        if ((++sp & 255u) == 0u) { if (xb_ld(&bar[XB_TMO])) break; if (sp > XB_SPIN_CAP) { atomicAdd(&bar[XB_TMO], 1u); break; } }
    }
    nloc = mine > 0u ? mine : 1u; nx = cnt > 0u ? cnt : 1u;
}
__device__ __forceinline__ void xcd_barrier(const XcdBarrier& b) {
    asm volatile("s_waitcnt vmcnt(0)" ::: "memory");
    __syncthreads();
    if (threadIdx.x == 0) {
        unsigned* bar = b.bar;
        __builtin_amdgcn_s_waitcnt(0);
        unsigned nloc = b.st[0], nx = b.st[1];
        if (nloc == 0u) { xcd_barrier_complete(bar, b.x, nloc, nx); b.st[0] = nloc; b.st[1] = nx; }
        const unsigned old = xb_add(&bar[XB_XSUB(b.x)], 1u);
        const unsigned gen = old / nloc;
        if (old + 1u == (gen + 1u) * nloc) {
            __builtin_amdgcn_fence(__ATOMIC_RELEASE, "agent");
            asm volatile("s_waitcnt vmcnt(0)" ::: "memory");
            const unsigned og = xb_add(&bar[XB_TOP], 1u);
            const unsigned tg = og / nx;
            if (og + 1u == (tg + 1u) * nx) xb_add(&bar[XB_TOPGEN], 1u);
            else XB_SPIN(xb_ld(&bar[XB_TOPGEN]) == tg, bar);
            __builtin_amdgcn_fence(__ATOMIC_ACQUIRE, "agent");
            xb_add(&bar[XB_XGEN(b.x)], 1u);
            asm volatile("s_waitcnt vmcnt(0)" ::: "memory");
        } else {
            XB_SPIN(xb_ld(&bar[XB_XGEN(b.x)]) == gen, bar);
            __builtin_amdgcn_fence(__ATOMIC_ACQUIRE, "agent");
            asm volatile("s_waitcnt vmcnt(0)" ::: "memory");
        }
    }
    __syncthreads();
}

struct Frame {
    LAS unsigned char* lds;
    volatile LAS unsigned* MISC;
    gu32* ctl;
    int tid, lane, wave;
    int vcu, G;
    unsigned char* ws;
};

__device__ __forceinline__ void p0_transpose_item(const float* W, int K, int N, bf16* WT, int dst_row0, const float* kscale, LAS float* scr, int k0, int n0, int lane) {
#pragma unroll 8
    for (int i = 0; i < 32; ++i) { const int kk = 2 * i + (lane >> 5); float v = W[(size_t)(k0 + kk) * N + n0 + (lane & 31)]; if (kscale) v *= kscale[k0 + kk]; scr[kk * 33 + (lane & 31)] = v; }
    LDS_WAIT(); asm volatile("" ::: "memory");
    const int c = lane & 7;
#pragma unroll
    for (int j = 0; j < 4; ++j) { const int n = (lane >> 3) + 8 * j; const LAS float* s = scr + (8 * c) * 33 + n;
        v4u o; o.x = pk2(s[0 * 33], s[1 * 33]); o.y = pk2(s[2 * 33], s[3 * 33]); o.z = pk2(s[4 * 33], s[5 * 33]); o.w = pk2(s[6 * 33], s[7 * 33]);
        *(GAS v4u*)(WT + (size_t)(dst_row0 + n) * K + k0 + 8 * c) = o; }
    LDS_WAIT(); asm volatile("" ::: "memory");
}
__device__ __forceinline__ int map_projB(int n0) {
    if (n0 < 2048) { const int t = n0 - 1536, hq = t >> 6, hf = (t >> 5) & 1; return 256 * (hq >> 2) + 128 * hf + 32 * (hq & 3); }
    if (n0 < 2176) { const int t = n0 - 2048, kh = t >> 6, hf = (t >> 5) & 1; return 512 + 128 * hf + 32 * kh; }
    if (n0 < 2304) { const int t = n0 - 2176, vh = t >> 6, hf = (t >> 5) & 1; return 512 + 128 * hf + 32 * (2 + vh); }
    return 768 + (n0 - 2304);
}
__device__ __forceinline__ void p0_row(const float* xrow, bf16* orow, float* rstd_out, int lane) {
    const GAS f32x4* xr = (const GAS f32x4*)xrow + lane;
    f32x4 v[4]; float s = 0.f;
#pragma unroll
    for (int j = 0; j < 4; ++j) { v[j] = xr[64 * j]; s += (v[j].x * v[j].x + v[j].y * v[j].y) + (v[j].z * v[j].z + v[j].w * v[j].w); }
    s = wave_sum(s);
    if (lane == 0) *rstd_out = 1.0f / sqrtf(s * (1.0f / DM) + RMS_EPS);
    GAS unsigned long long* o8 = (GAS unsigned long long*)orow + lane;
#pragma unroll
    for (int j = 0; j < 4; ++j) o8[64 * j] = (unsigned long long)pk2(v[j].x, v[j].y) | ((unsigned long long)pk2(v[j].z, v[j].w) << 32);
}
constexpr int FW_W1 = 0, FW_W2 = 33 * 64 * 4, FW_B1 = FW_W2 + 64 * 64 * 4, FW_B2 = FW_B1 + 256, FW_FR = FW_B2 + 256, FW_END = FW_FR + 256, FT_PITCH = 144, FT_BYTES = 32 * FT_PITCH;
__device__ __forceinline__ void filter_stage_weights(LAS unsigned char* lds, const float* w1, const float* b1, const float* w2, const float* b2, const float* fr, int tid) {
    LAS float* W1 = (LAS float*)(lds + FW_W1); LAS float* W2 = (LAS float*)(lds + FW_W2);
    for (int i = tid; i < 33 * 64; i += NWAVES * 64) W1[i] = w1[i];
    for (int i = tid; i < 64 * 64; i += NWAVES * 64) W2[i] = w2[i];
    if (tid < 64) { ((LAS float*)(lds + FW_B1))[tid] = b1[tid]; ((LAS float*)(lds + FW_B2))[tid] = b2[tid]; ((LAS float*)(lds + FW_FR))[tid] = fr[tid]; }
    LDS_WAIT(); __syncthreads();
}
__device__ __forceinline__ void filter_mlp_half(LAS unsigned char* lds, int L, int chunk, int hf, int dir, int r, int h, LAS float* Hb, bf16x8 (&afr)[4]) {
    const LAS float* W1 = (const LAS float*)(lds + FW_W1); const LAS float* W2 = (const LAS float*)(lds + FW_W2);
    const LAS float* B1 = (const LAS float*)(lds + FW_B1); const LAS float* B2 = (const LAS float*)(lds + FW_B2); const LAS float* FR = (const LAS float*)(lds + FW_FR);
        int pos = 64 * chunk + 32 * hf + r + dir; if (pos > L - 1) pos = L - 1;
        const float t = (float)pos / (float)(L - 1);
        float a[32];
#pragma unroll
        for (int jj = 0; jj < 32; ++jj) a[jj] = B1[32 * h + jj];
        {
#pragma unroll
            for (int jj = 0; jj < 32; jj += 4) { const f32x4 w = *(const LAS f32x4*)(W1 + 32 * h + jj); a[jj] += t * w[0]; a[jj + 1] += t * w[1]; a[jj + 2] += t * w[2]; a[jj + 3] += t * w[3]; }
#pragma unroll 1
            for (int i = 0; i < 16; ++i) {
                const float band = 1e-4f + (float)i * ((15.0f - 1e-4f) / 15.0f); const float ang = (6.283185307179586f / (float)L) * (float)pos * band;
                const float cv = __cosf(ang), sv = -__sinf(ang);
                const LAS float* wc = W1 + (1 + i) * 64 + 32 * h; const LAS float* wsn = W1 + (17 + i) * 64 + 32 * h;
#pragma unroll
                for (int jj = 0; jj < 32; jj += 4) { const f32x4 w = *(const LAS f32x4*)(wc + jj), v = *(const LAS f32x4*)(wsn + jj);
                    a[jj] += cv * w[0] + sv * v[0]; a[jj + 1] += cv * w[1] + sv * v[1]; a[jj + 2] += cv * w[2] + sv * v[2]; a[jj + 3] += cv * w[3] + sv * v[3]; }
            }
        }
#pragma unroll
        for (int jj = 0; jj < 32; ++jj) Hb[(32 * h + jj) * 32 + r] = __sinf(FR[32 * h + jj] * a[jj]);
        LDS_WAIT(); asm volatile("" ::: "memory");
#pragma unroll
        for (int jj = 0; jj < 32; ++jj) a[jj] = B2[32 * h + jj];
#pragma unroll 1
        for (int i = 0; i < 64; ++i) { const float hv = Hb[i * 32 + r]; const LAS float* wr_ = W2 + i * 64 + 32 * h;
#pragma unroll
            for (int jj = 0; jj < 32; jj += 4) { const f32x4 w = *(const LAS f32x4*)(wr_ + jj); a[jj] += hv * w[0]; a[jj + 1] += hv * w[1]; a[jj + 2] += hv * w[2]; a[jj + 3] += hv * w[3]; } }
        LDS_WAIT(); asm volatile("" ::: "memory");
        unsigned op[16], pp[16];
#pragma unroll
        for (int d = 0; d < 16; ++d) op[d] = pk2(__sinf(FR[32 * h + 2 * d] * a[2 * d]), __sinf(FR[32 * h + 2 * d + 1] * a[2 * d + 1]));
#pragma unroll
        for (int d = 0; d < 16; ++d) pp[d] = __shfl_xor(op[d], 32);
#pragma unroll
        for (int ks = 0; ks < 4; ++ks) { v4u f;
#pragma unroll
            for (int w = 0; w < 4; ++w) { const unsigned own = h ? op[8 * (ks & 1) + 4 + w] : op[8 * (ks & 1) + w], par = h ? pp[8 * (ks & 1) + 4 + w] : pp[8 * (ks & 1) + w];
                f[w] = ((ks >> 1) == h) ? own : par; }
            afr[ks] = __builtin_bit_cast(bf16x8, f); }
}
__device__ __forceinline__ void filter_item(LAS unsigned char* lds, const bf16* w3T, bf16* krev, float* fpart, int g, int chunk, int dir, int wave, int lane_) {
    int lane = lane_; asm volatile("" : "+v"(lane));
    const int L = g ? LS : LP, r = lane & 31, h = lane >> 5;
    const LAS float* W1 = (const LAS float*)(lds + FW_W1); const LAS float* W2 = (const LAS float*)(lds + FW_W2);
    const LAS float* B1 = (const LAS float*)(lds + FW_B1); const LAS float* B2 = (const LAS float*)(lds + FW_B2); const LAS float* FR = (const LAS float*)(lds + FW_FR);
    LAS unsigned char* T = lds + FW_END + wave * FT_BYTES; LAS float* Hb = (LAS float*)(lds + FW_END + NWAVES * FT_BYTES + wave * 8192);
    bf16x8 afr0[4], afr1[4];
    filter_mlp_half(lds, L, chunk, 0, dir, r, h, Hb, afr0);
    filter_mlp_half(lds, L, chunk, 1, dir, r, h, Hb, afr1);
    const float dmin = -4.605170185988091f / 1.5f, dmax = -4.605170185988091f / 0.3f;
    const int p0 = 64 * chunk; const int mstart = g ? (dir ? (2 * L - p0 - 64) : p0) : (dir ? (L + p0) : (L - 64 - p0));
    for (int ti = 0; ti < 32; ++ti) {
        const int o_ = ti >> 4, cb = 32 * (ti & 15), colg = (2 * o_ + dir) * 512 + cb;
        bf16x8 bfr[4];
#pragma unroll
        for (int ks = 0; ks < 4; ++ks) bfr[ks] = *(const GAS bf16x8*)(w3T + (size_t)(colg + r) * 64 + 16 * ks + 8 * h);
        const float delta = fabsf(dmin + (float)(cb + r) * ((dmax - dmin) / 511.0f));
        float asum = 0.f;
#pragma unroll
        for (int hf = 0; hf < 2; ++hf) {
            f32x16 acc = (f32x16){0.f,0.f,0.f,0.f,0.f,0.f,0.f,0.f,0.f,0.f,0.f,0.f,0.f,0.f,0.f,0.f};
#pragma unroll
            for (int ks = 0; ks < 4; ++ks) acc = __builtin_amdgcn_mfma_f32_32x32x16_bf16(hf ? afr1[ks] : afr0[ks], bfr[ks], acc, 0, 0, 0);
#pragma unroll
            for (int rg = 0; rg < 16; ++rg) {
                const int i = 32 * hf + (rg & 3) + 8 * (rg >> 2) + 4 * h; const int pos = p0 + i + dir;
                const float t = (float)pos / (float)(L - 1);
                float kv = acc[rg] * (__expf(-t * delta) + 0.05f); if (pos > L - 1) kv = 0.f;
                asum += fabsf(kv);
                const int e = ((dir != 0) != (g != 0)) ? i : 63 - i;
                *(LAS bf16*)(T + r * FT_PITCH + e * 2) = (bf16)f2bf(kv);
            }
        }
        asum += __shfl_xor(asum, 32);
        if (h == 0) fpart[(size_t)chunk * 2048 + colg + r] = asum;
        LDS_WAIT(); asm volatile("" ::: "memory");
        {
            const int col = lane >> 1, hb = lane & 1;
            bf16* dst = krev + (size_t)(o_ * 512 + cb + col) * (2 * L) + mstart + 32 * hb;
            const LAS v4u* src = (const LAS v4u*)(T + col * FT_PITCH + 64 * hb);
#pragma unroll
            for (int q = 0; q < 4; ++q) *(GAS v4u*)(dst + 8 * q) = src[q];
        }
        LDS_WAIT(); asm volatile("" ::: "memory");
    }
}

namespace hy {
constexpr int SLOTB = 272, Z_BYTES = 75776, F_OFF = 75776, F_BYTES = 65536, RED_OFF = F_OFF + F_BYTES;
__device__ __forceinline__ int slot_of(int g, int n) { return g ? (n + 31) : ((n >> 4) * 32 + 16 + (n & 15)); }
__device__ __forceinline__ int crow(int r, int hi) { return (r & 3) + 8 * (r >> 2) + 4 * hi; }

struct Params { const bf16* uT; const bf16* krev_s; const bf16* krev_p; const float* fpart_s; const float* fpart_p; const float* conv_w; const float* conv_b; const float* hbias; bf16* yT; float* dF; bf16* dZ; };

__device__ __forceinline__ void conv3_chunk(const bf16* urow  , int g, int chunk, float w0, float w1, float w2, float b, float (&out)[8]) {
    const int tau0 = chunk * 8; const int L = g ? LS : LP; const int p0 = g ? tau0 : (tau0 & (LP - 1));
    const v4u raw = *(const GAS v4u*)(urow + tau0);
    float u[10];
    u[1] = pg8::bflo(raw.x); u[2] = pg8::bfhi(raw.x); u[3] = pg8::bflo(raw.y); u[4] = pg8::bfhi(raw.y); u[5] = pg8::bflo(raw.z); u[6] = pg8::bfhi(raw.z); u[7] = pg8::bflo(raw.w); u[8] = pg8::bfhi(raw.w);
    u[0] = (p0 > 0) ? bf2f(urow[tau0 - 1]) : 0.f;
    u[9] = (p0 + 8 < L) ? bf2f(urow[tau0 + 8]) : 0.f;
#pragma unroll
    for (int i = 0; i < 8; ++i) out[i] = w0 * u[i] + w1 * u[i + 1] + w2 * u[i + 2] + b;
}

struct C3 { v4u raw; float prev, next; };
__device__ __forceinline__ void conv3_load(const bf16* urow, int g, int chunk, C3& q) {
    const int tau0 = chunk * 8; const int L = g ? LS : LP; const int p0 = g ? tau0 : (tau0 & (LP - 1));
    q.raw = *(const GAS v4u*)(urow + tau0);
    q.prev = (p0 > 0) ? bf2f(urow[tau0 - 1]) : 0.f;
    q.next = (p0 + 8 < L) ? bf2f(urow[tau0 + 8]) : 0.f;
}
__device__ __forceinline__ void conv3_eval(const C3& q, float w0, float w1, float w2, float b, float (&out)[8]) {
    float u[10];
    u[0] = q.prev; u[9] = q.next;
    u[1] = pg8::bflo(q.raw.x); u[2] = pg8::bfhi(q.raw.x); u[3] = pg8::bflo(q.raw.y); u[4] = pg8::bfhi(q.raw.y); u[5] = pg8::bflo(q.raw.z); u[6] = pg8::bfhi(q.raw.z); u[7] = pg8::bflo(q.raw.w); u[8] = pg8::bfhi(q.raw.w);
#pragma unroll
    for (int i = 0; i < 8; ++i) out[i] = w0 * u[i] + w1 * u[i + 1] + w2 * u[i + 2] + b;
}

__device__ __forceinline__ bf16x8 load_afrag(LAS const unsigned char* lds, int addr, int sh) {
    const LAS unsigned* p = (const LAS unsigned*)(lds + addr);
    const unsigned w0 = p[0], w1 = p[1], w2 = p[2], w3 = p[3], w4 = p[4];
    v4u f; f.x = __builtin_amdgcn_alignbit(w1, w0, sh); f.y = __builtin_amdgcn_alignbit(w2, w1, sh); f.z = __builtin_amdgcn_alignbit(w3, w2, sh); f.w = __builtin_amdgcn_alignbit(w4, w3, sh);
    return __builtin_bit_cast(bf16x8, f);
}

__device__ __forceinline__ void hyena_item(LAS unsigned char* lds, const Params& P, int g, int c, int tid_) {
    int tid = tid_; asm volatile("" : "+v"(tid));
    const int lane = tid & 63, wave = __builtin_amdgcn_readfirstlane(tid >> 6), r = lane & 31, hi = lane >> 5, nt = wave & 3, half = wave >> 2;
    const int L = g ? LS : LP; const int T0 = g ? TP : 0;
#if PROBE >= 41 && PROBE <= 46
    unsigned long long tp_ = __builtin_amdgcn_s_memrealtime();
#define HY_SEC(k) do { const unsigned long long tn_ = __builtin_amdgcn_s_memrealtime(); if (blockIdx.x == 0 && tid == 0) ((volatile LAS unsigned*)(lds + MISC_OFF))[40 + (k)] += (unsigned)(tn_ - tp_); tp_ = tn_; } while (0)
#else
#define HY_SEC(k) do { } while (0)
#endif
    float inv_norm0, inv_norm1;
    {
        const int nchunk = g ? 256 : 32; const float* fp = P.fpart_s + (g ? (size_t)0 : (size_t)((WS_FPART_P - WS_FPART_S) / 4));
        float s0 = 0.f, s1 = 0.f;
        for (int idx = lane; idx < nchunk * 2; idx += 64) { const int ch = idx >> 1, dir = idx & 1; s0 += fp[(size_t)ch * 2048 + dir * 512 + c]; s1 += fp[(size_t)ch * 2048 + 1024 + dir * 512 + c]; }
        inv_norm0 = 1.0f / wave_sum_sw(s0); inv_norm1 = 1.0f / wave_sum_sw(s1);
        for (int i = tid; i < Z_BYTES / 16; i += NWAVES * 64) *(LAS v4u*)(lds + i * 16) = (v4u){0u, 0u, 0u, 0u};
        LDS_WAIT(); __syncthreads();
    }
    {
        const int ch = 2 * HW + c; const float w0 = P.conv_w[ch], w1 = P.conv_w[3 * HW + ch], w2 = P.conv_w[6 * HW + ch], b = P.conv_b[ch];
        const bf16* urow = P.uT + (size_t)ch * MTOK + T0;
        for (int it = 0; it < 4; ++it) { const int chunk = tid + it * 512; float o[8]; conv3_chunk(urow, g, chunk, w0, w1, w2, b, o);
            const int tau0 = chunk * 8; v4u pk; pk.x = pk2(o[0], o[1]); pk.y = pk2(o[2], o[3]); pk.z = pk2(o[4], o[5]); pk.w = pk2(o[6], o[7]);
            *(LAS v4u*)(lds + slot_of(g, tau0 >> 7) * SLOTB + (tau0 & 127) * 2) = pk; }
    }
    HY_SEC(0);
    int d_hi, d_lo;
    if (g) { if (half == 0) { d_hi = 32 * nt + 31; d_lo = 32 * nt - 48; } else { d_hi = 32 * nt - 49; d_lo = 32 * nt - 127; } }
    else   {
             const int dmax = 4 * nt + 3, dmin = 4 * nt - 15;
             if (half == 0) { d_hi = dmax; d_lo = dmax - 9; } else { d_hi = dmax - 10; d_lo = dmin; } }
    const int ncol = g ? (32 * nt + r) : (16 * (r >> 2) + 4 * nt + (r & 3));
    int abase = F_OFF + 2 * ((L - 1) - r + 8 * hi); const int sh = (abase & 2) ? 16 : 0; abase &= ~3;
    const int zb = slot_of(g, ncol) * SLOTB + 16 * hi;
    const int mi0 = 2 * half;

    for (int o = 0; o < 2; ++o) {
        {
            const bf16* ksrc = P.krev_s + (g ? (size_t)0 : (size_t)((WS_KREV_P - WS_KREV_S) / 2)) + (size_t)(o * HW + c) * (2 * L);
            const int n16 = (2 * L * 2) / 16;
            for (int i = tid; i < n16; i += NWAVES * 64) *(LAS v4u*)(lds + F_OFF + i * 16) = *(const GAS v4u*)(ksrc + i * 8);
        }
        LDS_WAIT(); __syncthreads();
        HY_SEC(1);
        f32x16 acc[4];
#pragma unroll
        for (int mi = 0; mi < 4; ++mi) acc[mi] = (f32x16){0.f,0.f,0.f,0.f,0.f,0.f,0.f,0.f,0.f,0.f,0.f,0.f,0.f,0.f,0.f,0.f};
        bf16x8 Fw[8];
        {
            const int q0 = -8 * d_hi;
#pragma unroll
            for (int s = 2; s < 8; ++s) Fw[s] = load_afrag(lds, abase + 32 * (q0 - 8 + s), sh);
            Fw[0] = Fw[2]; Fw[1] = Fw[3];
        }
        {
            unsigned ap = (unsigned)(uintptr_t)(lds + abase) + 32 * (-8 * d_hi), bp = (unsigned)(uintptr_t)(lds + zb) - d_hi * SLOTB;
            v2u n01, n23; unsigned n4; v4u zn;
            unsigned r0, r1, r2, r3, r4; v4u zf;
#define HY_LOADS(ADW, BOFF) asm volatile("ds_read2_b32 %0, %4 offset0:%c5 offset1:%c6\n\tds_read2_b32 %1, %4 offset0:%c7 offset1:%c8\n\tds_read_b32 %2, %4 offset:%c9\n\tds_read_b128 %3, %10 offset:%c11" \
                : "=&v"(n01), "=&v"(n23), "=&v"(n4), "=&v"(zn) : "v"(ap), "i"(ADW), "i"((ADW) + 1), "i"((ADW) + 2), "i"((ADW) + 3), "i"(((ADW) + 4) * 4), "v"(bp), "i"(BOFF))
#define HY_WAIT() do { asm volatile("s_waitcnt lgkmcnt(0)" : "+v"(n01), "+v"(n23), "+v"(n4), "+v"(zn), "+v"(acc[0]), "+v"(acc[1]), "+v"(acc[2]), "+v"(acc[3])); __builtin_amdgcn_sched_barrier(0); } while (0)
#define HY_TAKE() do { r0 = n01.x; r1 = n01.y; r2 = n23.x; r3 = n23.y; r4 = n4; zf = zn; } while (0)
#define HY_STEP(JK, ADW, BOFF) do { HY_LOADS(ADW, BOFF); __builtin_amdgcn_sched_barrier(0); \
                { v4u f; f.x = __builtin_amdgcn_alignbit(r1, r0, sh); f.y = __builtin_amdgcn_alignbit(r2, r1, sh); f.z = __builtin_amdgcn_alignbit(r3, r2, sh); f.w = __builtin_amdgcn_alignbit(r4, r3, sh); Fw[JK] = __builtin_bit_cast(bf16x8, f); } \
                { const bf16x8 zb_ = __builtin_bit_cast(bf16x8, zf); \
                  acc[0] = __builtin_amdgcn_mfma_f32_32x32x16_bf16(Fw[(JK) & 7], zb_, acc[0], 0, 0, 0); acc[1] = __builtin_amdgcn_mfma_f32_32x32x16_bf16(Fw[((JK) - 2) & 7], zb_, acc[1], 0, 0, 0); \
                  acc[2] = __builtin_amdgcn_mfma_f32_32x32x16_bf16(Fw[((JK) - 4) & 7], zb_, acc[2], 0, 0, 0); acc[3] = __builtin_amdgcn_mfma_f32_32x32x16_bf16(Fw[((JK) - 6) & 7], zb_, acc[3], 0, 0, 0); } \
                HY_WAIT(); HY_TAKE(); } while (0)
            HY_LOADS(0, 0); HY_WAIT(); HY_TAKE();
            for (int d = d_hi; d >= d_lo; --d) {
                HY_STEP(0, 8, 32); HY_STEP(1, 16, 64); HY_STEP(2, 24, 96); HY_STEP(3, 32, 128); HY_STEP(4, 40, 160); HY_STEP(5, 48, 192); HY_STEP(6, 56, 224); HY_STEP(7, 64, SLOTB);
                ap += 256; bp += SLOTB;
            }
#undef HY_LOADS
#undef HY_WAIT
#undef HY_TAKE
#undef HY_STEP
        }
        LDS_WAIT(); __syncthreads();
        HY_SEC(2);
        {
            LAS float* X = (LAS float*)(lds + F_OFF) + wave * 2048;
#pragma unroll
            for (int t = 0; t < 2; ++t)
#pragma unroll
                for (int rg = 0; rg < 16; ++rg) X[(t * 16 + rg) * 64 + lane] = (half == 0) ? acc[2 + t][rg] : acc[t][rg];
        }
        LDS_WAIT(); __syncthreads();
        f32x16 fin[2];
        {
            const LAS float* X = (const LAS float*)(lds + F_OFF) + (wave ^ 4) * 2048;
#pragma unroll
            for (int t = 0; t < 2; ++t)
#pragma unroll
                for (int rg = 0; rg < 16; ++rg) fin[t][rg] = ((half == 0) ? acc[t][rg] : acc[2 + t][rg]) + X[(t * 16 + rg) * 64 + lane];
        }
        LDS_WAIT(); __syncthreads();
        HY_SEC(3);
        {
            const int ch = o * HW + c; const float w0 = P.conv_w[ch], w1 = P.conv_w[3 * HW + ch], w2 = P.conv_w[6 * HW + ch], b = P.conv_b[ch];
            const bf16* urow = P.uT + (size_t)ch * MTOK + T0;
            for (int it = 0; it < 4; ++it) { const int chunk = tid + it * 512; float v[8]; conv3_chunk(urow, g, chunk, w0, w1, w2, b, v);
                LAS f32x4* dst = (LAS f32x4*)(lds + F_OFF + chunk * 32 + (chunk >> 4) * 16); dst[0] = (f32x4){v[0], v[1], v[2], v[3]}; dst[1] = (f32x4){v[4], v[5], v[6], v[7]}; }
        }
        LDS_WAIT(); __syncthreads();
        HY_SEC(4);
        {
            const float sb = P.hbias[o * HW + c], inr = o ? inv_norm1 : inv_norm0;
            const LAS float* G = (const LAS float*)(lds + F_OFF);
            const int n = ncol; LAS bf16* zs = (LAS bf16*)(lds + slot_of(g, n) * SLOTB);
#pragma unroll
            for (int t = 0; t < 2; ++t)
#pragma unroll
                for (int rg = 0; rg < 16; ++rg) { const int i = 32 * (mi0 + t) + crow(rg, hi);
                    const float zo = bf2f(zs[i]);
#if PROBE >= 100
                    if (c == 137) { P.dF[(g * 2 + o) * 16384 + 128 * n + i] = fin[t][rg]; P.dZ[(g * 2 + o) * 16384 + 128 * n + i] = zs[i]; }
#endif
                    const float val = G[132 * n + i] * (inr * fin[t][rg] + sb * zo); zs[i] = (bf16)f2bf(val); }
        }
        LDS_WAIT(); __syncthreads();
    }
    HY_SEC(5);
    {
        bf16* yrow = P.yT + (size_t)c * MTOK + T0;
        for (int it = 0; it < 4; ++it) { const int chunk = tid + it * 512, tau0 = chunk * 8;
            *(GAS v4u*)(yrow + tau0) = *(const LAS v4u*)(lds + slot_of(g, tau0 >> 7) * SLOTB + (tau0 & 127) * 2); }
    }
    LDS_WAIT(); __syncthreads();
}
}

namespace fc {
constexpr int OST = 1032, PLANE_B = 32 * OST * 2  , RE_OFF = 0, IM_OFF = PLANE_B, RED_OFF = 2 * PLANE_B, T3_OFF = RED_OFF + 64;
constexpr int NFFT = 32768;
enum { F1 = 0, F2 = 1, F3 = 2, I1 = 3, I2 = 4, I3 = 5 };
__device__ __forceinline__ int crow(int r, int hi) { return (r & 3) + 8 * (r >> 2) + 4 * hi; }
__device__ __forceinline__ int sw(int mid) { return 0; }
struct Params { const bf16* uT; const bf16* kc; const float* fpart_s; const float* conv_w; const float* conv_b; const float* hbias; bf16* yT; bf16* hs; bf16* z1s; float* dF; bf16* dZ; };
typedef float f32x2_ __attribute__((ext_vector_type(2)));
struct FMat { bf16x8 fr[2], fi[2], nfi[2]; };

__device__ __forceinline__ void make_fmat(FMat& M, int r, int h) {
#pragma unroll
    for (int ks = 0; ks < 2; ++ks) { v4u a, b, c;
#pragma unroll
        for (int w = 0; w < 4; ++w) { float cv[2], sv[2];
#pragma unroll
            for (int e = 0; e < 2; ++e) { const int aidx = 16 * ks + 8 * h + 2 * w + e; const float fr_ = (float)((aidx * r) & 31) * (1.0f / 32.0f); cv[e] = __builtin_amdgcn_cosf(fr_); sv[e] = __builtin_amdgcn_sinf(fr_); }
            a[w] = pk2(cv[0], cv[1]); b[w] = pk2(-sv[0], -sv[1]); c[w] = pk2(sv[0], sv[1]); }
        M.fr[ks] = __builtin_bit_cast(bf16x8, a); M.fi[ks] = __builtin_bit_cast(bf16x8, b); M.nfi[ks] = __builtin_bit_cast(bf16x8, c); }
}

template <int ST, bool REAL_IN, bool HALF_K>
__device__ __forceinline__ void stage(LAS unsigned char* lds, const FMat& M, int wave, int r_, int h_) {
    int r = r_, h = h_; asm volatile("" : "+v"(r), "+v"(h));
    float t2c[16], t2s[16];
    if (ST == F1 || ST == F2 || ST == I1 || ST == I2) {
#pragma unroll
        for (int rg = 0; rg < 16; ++rg) { const int rho = (rg & 3) + 8 * (rg >> 2) + 4 * h; const float fr_ = (float)(r * rho) * (1.0f / 1024.0f); t2c[rg] = __builtin_amdgcn_cosf(fr_); t2s[rg] = __builtin_amdgcn_sinf(fr_); }
    }
    constexpr bool INV = (ST >= I1);
    const f32x16 zero16 = (f32x16){0.f,0.f,0.f,0.f,0.f,0.f,0.f,0.f,0.f,0.f,0.f,0.f,0.f,0.f,0.f,0.f};
    unsigned res[4][16];
#pragma unroll
    for (int t = 0; t < 4; ++t) {
        const int f = 4 * wave + t;
        const int base = (ST == I2) ? (32 * f + OST * r) : (32 * r + OST * f); const int swr = (ST == I2) ? sw(f) : sw(r);
        f32x16 ur = zero16, ui = zero16;
#pragma unroll
        for (int ks = 0; ks < (HALF_K ? 1 : 2); ++ks) {
            const bf16x8 xr = *(const LAS bf16x8*)(lds + RE_OFF + 2 * (base + ((16 * ks + 8 * h) ^ swr)));
            if (!INV) {
                ur = __builtin_amdgcn_mfma_f32_32x32x16_bf16(M.fr[ks], xr, ur, 0, 0, 0);
                ui = __builtin_amdgcn_mfma_f32_32x32x16_bf16(M.fi[ks], xr, ui, 0, 0, 0);
                if (!REAL_IN) { const bf16x8 xi = *(const LAS bf16x8*)(lds + IM_OFF + 2 * (base + ((16 * ks + 8 * h) ^ swr)));
                    ur = __builtin_amdgcn_mfma_f32_32x32x16_bf16(M.nfi[ks], xi, ur, 0, 0, 0);
                    ui = __builtin_amdgcn_mfma_f32_32x32x16_bf16(M.fr[ks], xi, ui, 0, 0, 0); }
            } else {
                const bf16x8 xi = *(const LAS bf16x8*)(lds + IM_OFF + 2 * (base + ((16 * ks + 8 * h) ^ swr)));
                ur = __builtin_amdgcn_mfma_f32_32x32x16_bf16(M.fr[ks], xr, ur, 0, 0, 0);
                ur = __builtin_amdgcn_mfma_f32_32x32x16_bf16(M.fi[ks], xi, ur, 0, 0, 0);
                if (ST != I3) { ui = __builtin_amdgcn_mfma_f32_32x32x16_bf16(M.fr[ks], xi, ui, 0, 0, 0);
                                ui = __builtin_amdgcn_mfma_f32_32x32x16_bf16(M.nfi[ks], xr, ui, 0, 0, 0); }
            }
        }
        if (ST == I3) {
#pragma unroll
            for (int rg = 0; rg < 8; ++rg) res[t][rg] = __float_as_uint(ur[rg]);
        } else {
            if (ST == F1 || ST == F2 || ST == I1 || ST == I2) {
                float uc = 1.f, us = 0.f;
                if (ST == I2) { const float fr_ = (float)(f * r) * (1.0f / 32768.0f); uc = __builtin_amdgcn_cosf(fr_); us = __builtin_amdgcn_sinf(fr_); }
#pragma unroll
                for (int rg = 0; rg < 16; ++rg) {
                    float c = t2c[rg], s_ = t2s[rg];
                    if (ST == F1) { const int rho = (rg & 3) + 8 * (rg >> 2) + 4 * h; const f32x2_ q = *(const LAS f32x2_*)(lds + T3_OFF + 8 * (32 * f + rho)); const float c2 = c * q.x - s_ * q.y; s_ = c * q.y + s_ * q.x; c = c2; }
                    if (ST == I2) { const float c2 = c * uc - s_ * us; s_ = c * us + s_ * uc; c = c2; }
                    const float s = INV ? s_ : -s_;
                    const float a = ur[rg], b = ui[rg];
                    ur[rg] = a * c - b * s; ui[rg] = a * s + b * c;
                }
            }
#pragma unroll
            for (int p = 0; p < 8; ++p) { res[t][p] = pk2(ur[2 * p], ur[2 * p + 1]); res[t][8 + p] = pk2(ui[2 * p], ui[2 * p + 1]); }
        }
        __builtin_amdgcn_sched_barrier(0);
    }
    LDS_WAIT(); __syncthreads();
#pragma unroll
    for (int t = 0; t < 4; ++t) {
        const int f = 4 * wave + t;
        if (ST == I3) {
            LAS float* Y = (LAS float*)(lds + IM_OFF);
#pragma unroll
            for (int rg = 0; rg < 8; ++rg) { const int rho = (rg & 3) + 8 * (rg >> 2) + 4 * h; Y[516 * f + 32 * rho + r] = __uint_as_float(res[t][rg]); }
        } else if (ST == F3) {
#pragma unroll
            for (int g4 = 0; g4 < 4; ++g4) { const int pos = ((8 * g4 + 4 * h) ^ sw(r)) + 32 * r + OST * f;
                *(LAS v2u*)(lds + RE_OFF + 2 * pos) = (v2u){res[t][2 * g4], res[t][2 * g4 + 1]}; *(LAS v2u*)(lds + IM_OFF + 2 * pos) = (v2u){res[t][8 + 2 * g4], res[t][8 + 2 * g4 + 1]}; }
        } else {
            const int odd = r & 1; const unsigned sel = odd ? 0x03020706u : 0x05040100u;
            const int rs_ = (ST == F1) ? OST : 32;
            const int lb = ((r & ~1) + odd * rs_ + ((ST == F1) ? 32 * f : OST * f) + rs_ * 4 * h) * 2;
#pragma unroll
            for (int p = 0; p < 8; ++p) {
                const int rho0 = ((2 * p) & 3) + 8 * ((2 * p) >> 2);
                const unsigned wr_ = res[t][p], wi_ = res[t][8 + p];
                const unsigned vr_ = (unsigned)__builtin_amdgcn_mov_dpp((int)wr_, 0xB1, 0xF, 0xF, true), vi_ = (unsigned)__builtin_amdgcn_mov_dpp((int)wi_, 0xB1, 0xF, 0xF, true);
                *(LAS unsigned*)(lds + RE_OFF + lb + 2 * rs_ * rho0) = __builtin_amdgcn_perm(vr_, wr_, sel);
                *(LAS unsigned*)(lds + IM_OFF + lb + 2 * rs_ * rho0) = __builtin_amdgcn_perm(vi_, wi_, sel);
            }
        }
    }
    LDS_WAIT(); __syncthreads();
}

__device__ __forceinline__ void self_visible(int tid) {
    VM_WAIT(); __syncthreads();
    if (tid == 0) { __builtin_amdgcn_fence(__ATOMIC_ACQUIRE, "agent"); VM_WAIT(); }
    __syncthreads();
}

__device__ __forceinline__ void item(LAS unsigned char* lds, const Params& P, int c, int tid_, int slot) {
    int tid = tid_; asm volatile("" : "+v"(tid));
    const int wave = __builtin_amdgcn_readfirstlane(tid >> 6);
    constexpr int L = LS, T0 = TP, g = 1;
    bf16* hs = P.hs + (size_t)slot * (2 * PLANE_B / 2); bf16* z1s = P.z1s + (size_t)slot * L;
    float inv_norm0, inv_norm1;
    {
        const int lane = tid & 63; float s0 = 0.f, s1 = 0.f;
        for (int idx = lane; idx < 512; idx += 64) { const int ch = idx >> 1, dir = idx & 1; s0 += P.fpart_s[(size_t)ch * 2048 + dir * 512 + c]; s1 += P.fpart_s[(size_t)ch * 2048 + 1024 + dir * 512 + c]; }
        inv_norm0 = 1.0f / wave_sum_sw(s0); inv_norm1 = 1.0f / wave_sum_sw(s1);
    }
    FMat M; { const int r = tid & 31, h = (tid >> 5) & 1; make_fmat(M, r, h); }
    for (int i = tid; i < 1024; i += NWAVES * 64) { const float fr_ = (float)((i >> 5) * (i & 31)) * (1.0f / 32768.0f); *(LAS f32x2_*)(lds + T3_OFF + 8 * i) = (f32x2_){__builtin_amdgcn_cosf(fr_), __builtin_amdgcn_sinf(fr_)}; }
    LDS_WAIT(); __syncthreads();
#if PROBE >= 31 && PROBE <= 35
    unsigned long long tp_ = __builtin_amdgcn_s_memrealtime();
#define FC_SEC(k) do { const unsigned long long tn_ = __builtin_amdgcn_s_memrealtime(); if (blockIdx.x == 0 && tid == 0) ((volatile LAS unsigned*)(lds + MISC_OFF))[40 + (k)] += (unsigned)(tn_ - tp_); tp_ = tn_; } while (0)
#else
#define FC_SEC(k) do { } while (0)
#endif
    for (int o = 0; o < 2; ++o) {
        asm volatile("" : "+v"(tid));
        const int lane = tid & 63, r = lane & 31, h = lane >> 5;
        FC_SEC(5);
        {
            const bf16* ksrc = P.kc + (size_t)(o * HW + c) * NFFT;
            v4u raw[8];
#pragma unroll
            for (int i = 0; i < 8; ++i) { const int it = 8 * wave + i, n = 1024 * (lane & 31) + 32 * (2 * (it >> 2) + (lane >> 5)) + 8 * (it & 3); raw[i] = *(const GAS v4u*)(ksrc + n); }
#pragma unroll
            for (int i = 0; i < 8; ++i) { const int it = 8 * wave + i, n = 1024 * (lane & 31) + 32 * (2 * (it >> 2) + (lane >> 5)) + 8 * (it & 3);
                const int pos0 = ((n >> 10) ^ sw((n >> 5) & 31)) + 32 * ((n >> 5) & 31) + OST * (n & 31); LAS bf16* d = (LAS bf16*)(lds + RE_OFF) + pos0;
                d[0 * OST] = (bf16)(raw[i].x & 0xffffu); d[1 * OST] = (bf16)(raw[i].x >> 16); d[2 * OST] = (bf16)(raw[i].y & 0xffffu); d[3 * OST] = (bf16)(raw[i].y >> 16);
                d[4 * OST] = (bf16)(raw[i].z & 0xffffu); d[5 * OST] = (bf16)(raw[i].z >> 16); d[6 * OST] = (bf16)(raw[i].w & 0xffffu); d[7 * OST] = (bf16)(raw[i].w >> 16); }
        }
        LDS_WAIT(); __syncthreads();
        stage<F1, true, false>(lds, M, wave, r, h); stage<F2, false, false>(lds, M, wave, r, h); stage<F3, false, false>(lds, M, wave, r, h);
        for (int i = tid; i < 2 * PLANE_B / 16; i += NWAVES * 64) *(GAS v4u*)((unsigned char*)hs + (size_t)i * 16) = *(const LAS v4u*)(lds + i * 16);
        self_visible(tid);
        FC_SEC(0);
        {
            const int ch = 2 * HW + c; const float w0 = P.conv_w[ch], w1 = P.conv_w[3 * HW + ch], w2 = P.conv_w[6 * HW + ch], b = P.conv_b[ch];
            const bf16* urow = P.uT + (size_t)ch * MTOK + T0;
            hy::C3 q3[4]; v4u rz[4];
#pragma unroll
            for (int i = 0; i < 4; ++i) { const int it = 4 * wave + i, n = 1024 * (lane & 15) + 32 * (4 * (it >> 2) + (lane >> 4)) + 8 * (it & 3);
                if (o == 0) hy::conv3_load(urow, g, n >> 3, q3[i]); else rz[i] = *(const GAS v4u*)(z1s + n); }
#pragma unroll
            for (int i = 0; i < 4; ++i) { const int it = 4 * wave + i, n = 1024 * (lane & 15) + 32 * (4 * (it >> 2) + (lane >> 4)) + 8 * (it & 3); unsigned e[4];
                if (o == 0) { float v[8]; hy::conv3_eval(q3[i], w0, w1, w2, b, v); e[0] = pk2(v[0], v[1]); e[1] = pk2(v[2], v[3]); e[2] = pk2(v[4], v[5]); e[3] = pk2(v[6], v[7]); }
                else { e[0] = rz[i].x; e[1] = rz[i].y; e[2] = rz[i].z; e[3] = rz[i].w; }
                const int pos0 = ((n >> 10) ^ sw((n >> 5) & 31)) + 32 * ((n >> 5) & 31) + OST * (n & 31); LAS bf16* d = (LAS bf16*)(lds + RE_OFF) + pos0;
#pragma unroll
                for (int j = 0; j < 4; ++j) { d[(2 * j) * OST] = (bf16)(e[j] & 0xffffu); d[(2 * j + 1) * OST] = (bf16)(e[j] >> 16); } }
        }
        LDS_WAIT(); __syncthreads();
        stage<F1, true, true>(lds, M, wave, r, h); stage<F2, false, false>(lds, M, wave, r, h); stage<F3, false, false>(lds, M, wave, r, h);
        FC_SEC(1);
        {
            constexpr int NCH = PLANE_B / 16, NIT = (NCH + NWAVES * 64 - 1) / (NWAVES * 64);
#pragma unroll 1
            for (int kb = 0; kb < NIT; kb += 3) {
                v4u hr[3], hi_[3];
#pragma unroll
                for (int k = 0; k < 3; ++k) { const int i = tid + (kb + k) * NWAVES * 64; if (i < NCH) { hr[k] = *(const GAS v4u*)((const unsigned char*)hs + (size_t)i * 16); hi_[k] = *(const GAS v4u*)((const unsigned char*)hs + PLANE_B + (size_t)i * 16); } }
#pragma unroll
                for (int k = 0; k < 3; ++k) { const int i = tid + (kb + k) * NWAVES * 64; if (i < NCH) {
                    const v4u xr = *(const LAS v4u*)(lds + RE_OFF + i * 16), xi = *(const LAS v4u*)(lds + IM_OFF + i * 16);
                    v4u vr, vi;
#pragma unroll
                    for (int w = 0; w < 4; ++w) {
                        const float a0 = pg8::bflo(xr[w]), a1 = pg8::bfhi(xr[w]), b0 = pg8::bflo(xi[w]), b1 = pg8::bfhi(xi[w]);
                        const float c0 = pg8::bflo(hr[k][w]) * (1.0f / 32768.0f), c1 = pg8::bfhi(hr[k][w]) * (1.0f / 32768.0f), d0 = pg8::bflo(hi_[k][w]) * (1.0f / 32768.0f), d1 = pg8::bfhi(hi_[k][w]) * (1.0f / 32768.0f);
                        vr[w] = pk2(a0 * c0 - b0 * d0, a1 * c1 - b1 * d1); vi[w] = pk2(a0 * d0 + b0 * c0, a1 * d1 + b1 * c1);
                    }
                    *(LAS v4u*)(lds + RE_OFF + i * 16) = vr; *(LAS v4u*)(lds + IM_OFF + i * 16) = vi; } }
            }
        }
        LDS_WAIT(); __syncthreads();
        FC_SEC(2);
        stage<I1, false, false>(lds, M, wave, r, h); stage<I2, false, false>(lds, M, wave, r, h); stage<I3, false, false>(lds, M, wave, r, h);
        FC_SEC(3);
        {
            const LAS float* Y = (const LAS float*)(lds + IM_OFF);
            const int chg = o * HW + c; const float g0 = P.conv_w[chg], g1 = P.conv_w[3 * HW + chg], g2 = P.conv_w[6 * HW + chg], gb = P.conv_b[chg];
            const int chv = 2 * HW + c; const float v0 = P.conv_w[chv], v1 = P.conv_w[3 * HW + chv], v2 = P.conv_w[6 * HW + chv], vb = P.conv_b[chv];
            const bf16* grow = P.uT + (size_t)chg * MTOK + T0; const bf16* vrow = P.uT + (size_t)chv * MTOK + T0;
            const float sb = P.hbias[o * HW + c], inr = o ? inv_norm1 : inv_norm0;
            bf16* dst = o ? (P.yT + (size_t)c * MTOK + T0) : z1s;
#pragma unroll 1
            for (int ib = 0; ib < 4; ib += 2) {
            hy::C3 qg[2], qv[2]; v4u rz[2];
#pragma unroll
            for (int it = 0; it < 2; ++it) { const int chunk = tid + (ib + it) * 512; hy::conv3_load(grow, g, chunk, qg[it]); if (o == 0) hy::conv3_load(vrow, g, chunk, qv[it]); else rz[it] = *(const GAS v4u*)(z1s + chunk * 8); }
#pragma unroll
            for (int it = 0; it < 2; ++it) { const int chunk = tid + (ib + it) * 512, n = chunk * 8; float gt[8], zo[8];
                hy::conv3_eval(qg[it], g0, g1, g2, gb, gt);
                if (o == 0) { hy::conv3_eval(qv[it], v0, v1, v2, vb, zo);
#pragma unroll
                    for (int j = 0; j < 8; ++j) zo[j] = bf2f((unsigned short)f2bf(zo[j])); }
                else { const v4u raw = rz[it]; zo[0] = pg8::bflo(raw.x); zo[1] = pg8::bfhi(raw.x); zo[2] = pg8::bflo(raw.y); zo[3] = pg8::bfhi(raw.y); zo[4] = pg8::bflo(raw.z); zo[5] = pg8::bfhi(raw.z); zo[6] = pg8::bflo(raw.w); zo[7] = pg8::bfhi(raw.w); }
                const LAS float* yp = Y + 516 * (n & 31) + (n >> 5); const f32x4 y0 = (f32x4){yp[0], yp[516], yp[2 * 516], yp[3 * 516]}, y1 = (f32x4){yp[4 * 516], yp[5 * 516], yp[6 * 516], yp[7 * 516]};
                float val[8];
#pragma unroll
                for (int j = 0; j < 8; ++j) { const float yv = (j < 4) ? y0[j & 3] : y1[j & 3];
#if PROBE >= 100
                    if (c == 137) { P.dF[(2 + o) * 16384 + n + j] = yv; P.dZ[(2 + o) * 16384 + n + j] = (bf16)f2bf(zo[j]); }
#endif
                    val[j] = gt[j] * (inr * yv + sb * zo[j]); }
                v4u pk; pk.x = pk2(val[0], val[1]); pk.y = pk2(val[2], val[3]); pk.z = pk2(val[4], val[5]); pk.w = pk2(val[6], val[7]);
                *(GAS v4u*)(dst + n) = pk; }
            }
        }
        self_visible(tid);
        FC_SEC(4);
    }
#undef FC_SEC
}
}

namespace at {
constexpr int KROW = 144, VROW = 776, K_OFF = 0, V_OFF = 384 * KROW  , END_OFF = V_OFF + 64 * VROW;
__device__ __forceinline__ int crow(int r, int hi) { return (r & 3) + 8 * (r >> 2) + 4 * hi; }
struct Params { const bf16* q; const bf16* k; const bf16* v; const float* sink; bf16* yat; };

__device__ __forceinline__ void attn_item(LAS unsigned char* lds, const Params& P, int blk, int gk, int tid_) {
    int tid = tid_; asm volatile("" : "+v"(tid));
    const int lane = tid & 63, wave = __builtin_amdgcn_readfirstlane(tid >> 6), r = lane & 31, hi = lane >> 5;
    const int m0 = blk * 128; const int s_lo = (blk < 128) ? (m0 & ~(LP - 1)) : TP, s_hi = (blk < 128) ? s_lo + LP : MTOK; const int kw0 = m0 - 128;
    for (int it = 0; it < 6; ++it) {
        const int idx = tid + it * 512, chn = idx / 384, key = idx - chn * 384, tok = kw0 + key; const bool ok = (tok >= s_lo) && (tok < s_hi);
        v4u kv = (v4u){0u, 0u, 0u, 0u}, vv = (v4u){0u, 0u, 0u, 0u};
        if (ok) { kv = *(const GAS v4u*)(P.k + (size_t)tok * 128 + gk * 64 + chn * 8); vv = *(const GAS v4u*)(P.v + (size_t)tok * 128 + gk * 64 + chn * 8); }
        *(LAS v4u*)(lds + K_OFF + key * KROW + chn * 16) = kv;
        LAS bf16* vt = (LAS bf16*)(lds + V_OFF + (chn * 8) * VROW + key * 2);
        vt[0 * (VROW / 2)] = (bf16)(vv.x & 0xffffu); vt[1 * (VROW / 2)] = (bf16)(vv.x >> 16); vt[2 * (VROW / 2)] = (bf16)(vv.y & 0xffffu); vt[3 * (VROW / 2)] = (bf16)(vv.y >> 16);
        vt[4 * (VROW / 2)] = (bf16)(vv.z & 0xffffu); vt[5 * (VROW / 2)] = (bf16)(vv.z >> 16); vt[6 * (VROW / 2)] = (bf16)(vv.w & 0xffffu); vt[7 * (VROW / 2)] = (bf16)(vv.w >> 16);
    }
    LDS_WAIT(); __syncthreads();
    const int hq = 4 * gk + (wave & 3), qh = wave >> 2;
    const int klo = (s_lo - kw0) > 0 ? (s_lo - kw0) : 0, khi = (s_hi - kw0) < 384 ? (s_hi - kw0) : 384;
    const float sinkl = P.sink[hq] * 1.4426950408889634f;
    for (int qq = 0; qq < 2; ++qq) {
        const int qt = 2 * qh + qq, q0 = 32 * qt; const size_t qrow = (size_t)(m0 + q0 + r);
        bf16x8 qf[4];
#pragma unroll
        for (int ks = 0; ks < 4; ++ks) qf[ks] = *(const GAS bf16x8*)(P.q + qrow * 512 + hq * 64 + 16 * ks + 8 * hi);
        float m_run = sinkl, l_run = (hi == 0) ? 1.0f : 0.0f;
        f32x16 o0 = (f32x16){0.f,0.f,0.f,0.f,0.f,0.f,0.f,0.f,0.f,0.f,0.f,0.f,0.f,0.f,0.f,0.f}, o1 = o0;
        const int lo_r = (q0 + r) > klo ? (q0 + r) : klo, hi_r = (q0 + r + 256) < (khi - 1) ? (q0 + r + 256) : (khi - 1);
        for (int kt = qt; kt <= qt + 8; ++kt) {
            const int kb = 32 * kt;
            f32x16 s = (f32x16){0.f,0.f,0.f,0.f,0.f,0.f,0.f,0.f,0.f,0.f,0.f,0.f,0.f,0.f,0.f,0.f};
#pragma unroll
            for (int ks = 0; ks < 4; ++ks) { const bf16x8 kf = *(const LAS bf16x8*)(lds + K_OFF + (kb + r) * KROW + 32 * ks + 16 * hi);
                s = __builtin_amdgcn_mfma_f32_32x32x16_bf16(kf, qf[ks], s, 0, 0, 0); }
            float tmax = -1e30f;
            const bool need_mask = (kt == qt) || (kt == qt + 8) || (kb < klo) || (kb + 31 >= khi);
            if (need_mask) {
#pragma unroll
                for (int rg = 0; rg < 16; ++rg) { const int kj = kb + crow(rg, hi); const float sv = (kj >= lo_r && kj <= hi_r) ? s[rg] : -1e30f; s[rg] = sv; tmax = fmaxf(tmax, sv); }
            } else {
#pragma unroll
                for (int rg = 0; rg < 16; ++rg) tmax = fmaxf(tmax, s[rg]);
            }
            tmax = fmaxf(tmax, __shfl_xor(tmax, 32));
            const float mnew = fmaxf(m_run, tmax); const float alpha = __builtin_amdgcn_exp2f(m_run - mnew);
            const bool moved = __any(mnew != m_run); m_run = mnew;
            float psum = 0.f;
#pragma unroll
            for (int rg = 0; rg < 16; ++rg) { const float p = __builtin_amdgcn_exp2f(s[rg] - mnew); s[rg] = p; psum += p; }
            l_run = l_run * alpha + psum;
            if (moved) {
#pragma unroll
                for (int rg = 0; rg < 16; ++rg) { o0[rg] *= alpha; o1[rg] *= alpha; }
            }
            v4u pa, pb;
            pa.x = pk2(s[0], s[1]); pa.y = pk2(s[2], s[3]); pa.z = pk2(s[4], s[5]); pa.w = pk2(s[6], s[7]);
            pb.x = pk2(s[8], s[9]); pb.y = pk2(s[10], s[11]); pb.z = pk2(s[12], s[13]); pb.w = pk2(s[14], s[15]);
            const bf16x8 pf0 = __builtin_bit_cast(bf16x8, pa), pf1 = __builtin_bit_cast(bf16x8, pb);
#pragma unroll
            for (int dt = 0; dt < 2; ++dt) {
                const LAS unsigned char* vb = lds + V_OFF + (32 * dt + r) * VROW + (kb + 4 * hi) * 2;
                v4u va, vc;
                { const v2u x0 = *(const LAS v2u*)(vb), x1 = *(const LAS v2u*)(vb + 16); va = (v4u){x0.x, x0.y, x1.x, x1.y}; }
                { const v2u x0 = *(const LAS v2u*)(vb + 32), x1 = *(const LAS v2u*)(vb + 48); vc = (v4u){x0.x, x0.y, x1.x, x1.y}; }
                if (dt == 0) { o0 = __builtin_amdgcn_mfma_f32_32x32x16_bf16(__builtin_bit_cast(bf16x8, va), pf0, o0, 0, 0, 0); o0 = __builtin_amdgcn_mfma_f32_32x32x16_bf16(__builtin_bit_cast(bf16x8, vc), pf1, o0, 0, 0, 0); }
                else         { o1 = __builtin_amdgcn_mfma_f32_32x32x16_bf16(__builtin_bit_cast(bf16x8, va), pf0, o1, 0, 0, 0); o1 = __builtin_amdgcn_mfma_f32_32x32x16_bf16(__builtin_bit_cast(bf16x8, vc), pf1, o1, 0, 0, 0); }
            }
        }
        l_run += __shfl_xor(l_run, 32);
        const float inv = 1.0f / l_run;
        bf16* yrow = P.yat + qrow * 512 + hq * 64;
#pragma unroll
        for (int g4 = 0; g4 < 4; ++g4) {
            v2u w0, w1;
            w0.x = pk2(o0[4 * g4] * inv, o0[4 * g4 + 1] * inv); w0.y = pk2(o0[4 * g4 + 2] * inv, o0[4 * g4 + 3] * inv);
            w1.x = pk2(o1[4 * g4] * inv, o1[4 * g4 + 1] * inv); w1.y = pk2(o1[4 * g4 + 2] * inv, o1[4 * g4 + 3] * inv);
            *(GAS v2u*)(yrow + 8 * g4 + 4 * hi) = w0; *(GAS v2u*)(yrow + 32 + 8 * g4 + 4 * hi) = w1;
        }
    }
    LDS_WAIT(); __syncthreads();
}
}

__device__ __forceinline__ void transpose_y_tile(LAS unsigned char* lds, const bf16* yT, bf16* yhy, int tile, int tid_) {
    int tid = tid_; asm volatile("" : "+v"(tid));
    const int c0 = (tile & 7) * 64, t0 = (tile >> 3) * 64;
    LAS bf16* T = (LAS bf16*)lds;
    { const int ch = tid >> 3, k8 = tid & 7; *(LAS v4u*)(T + ch * 72 + k8 * 8) = *(const GAS v4u*)(yT + (size_t)(c0 + ch) * MTOK + t0 + k8 * 8); }
    LDS_WAIT(); __syncthreads();
    { const int tk = tid >> 3, c8 = tid & 7; unsigned short e[8];
#pragma unroll
      for (int j = 0; j < 8; ++j) e[j] = T[(c8 * 8 + j) * 72 + tk];
      v4u o; o.x = e[0] | ((unsigned)e[1] << 16); o.y = e[2] | ((unsigned)e[3] << 16); o.z = e[4] | ((unsigned)e[5] << 16); o.w = e[6] | ((unsigned)e[7] << 16);
      *(GAS v4u*)(yhy + (size_t)(t0 + tk) * 512 + c0 + c8 * 8) = o; }
    LDS_WAIT(); __syncthreads();
}

#if PROBE
constexpr int CW_P = 20000;
constexpr size_t WS_DF = 484 * MiB, WS_DZ = 485 * MiB;
constexpr int PROBE_C = 137;
__device__ __forceinline__ double wave_sum_d(double v) {
#pragma unroll
    for (int o = 1; o < 64; o <<= 1) v += __shfl_xor(v, o);
    return v;
}
__device__ __forceinline__ double filt_point(const float* w1, const float* b1, const float* w2, const float* b2, const float* w3, const float* fr, int g, int p, int col, int lane) {
    const int L = g ? LS : LP; const double t = (double)p / (double)(L - 1);
    double zval = 0.0;
    if (lane == 0) zval = t;
    else if (lane < 33) { const int i = (lane - 1) & 15; const double band = 1e-4 + (double)i * ((15.0 - 1e-4) / 15.0); const double ang = (6.283185307179586 / (double)L) * (double)p * band; zval = (lane <= 16) ? cos(ang) : -sin(ang); }
    double a = (double)b1[lane];
    for (int k = 0; k < 33; ++k) a += __shfl(zval, k) * (double)w1[k * 64 + lane];
    const double h1 = sin((double)fr[lane] * a);
    a = (double)b2[lane];
    for (int i = 0; i < 64; ++i) a += __shfl(h1, i) * (double)w2[i * 64 + lane];
    const double h2 = sin((double)fr[lane] * a);
    const double out = wave_sum_d(h2 * (double)w3[lane * 2048 + col]);
    const int c = col & 511; const double dmin = log(1e-2) / 1.5, dmax = log(1e-2) / 0.3;
    const double delta = fabs(dmin + (double)c * ((dmax - dmin) / 511.0));
    return out * (exp(-t * delta) + 0.05);
}
__device__ __forceinline__ void probe_check(unsigned char* ws, unsigned* ctl, const float* w1, const float* b1, const float* w2, const float* b2, const float* w3, const float* fr, int vcu, int G, int tid) {
    const bf16* KREV_S = (const bf16*)(ws + WS_KREV_S);
    const float* DF = (const float*)(ws + WS_DF); const bf16* DZ = (const bf16*)(ws + WS_DZ);
    const int gtid = vcu * 512 + tid, lane = tid & 63, gwv = gtid >> 6, NW = G * 8;
    if (gtid < 65536) {
        const int combo = gtid >> 14, t = gtid & 16383, g = combo >> 1, o = combo & 1, L = g ? LS : LP, tl = g ? t : (t & (LP - 1)), base = t - tl;
        const bf16* kb = KREV_S + (g ? (size_t)0 : (size_t)((WS_KREV_P - WS_KREV_S) / 2)) + (size_t)(o * HW + PROBE_C) * (2 * L); const bf16* dz = DZ + combo * 16384 + base;
        double acc = 0.0;
        if (g) { for (int s = 0; s < L; ++s) { int j = tl - s; if (j < 0) j += 2 * L; acc += (double)bf2f(kb[j]) * (double)bf2f(dz[s]); } }
        else   { const bf16* kr = kb + (L - 1 - tl); for (int s = 0; s < L; ++s) acc += (double)bf2f(kr[s]) * (double)bf2f(dz[s]); }
        const float diff = fabsf((float)(acc - (double)DF[combo * 16384 + t]));
        atomicMax(ctl + CW_P + (g ? 4 : 0), __float_as_uint(diff)); atomicMax(ctl + CW_P + (g ? 5 : 1), __float_as_uint(fabsf((float)acc)));
    }
    {
        const int g = gwv & 1, L = g ? LS : LP; const int p = (int)(((unsigned)gwv * 2654435761u) >> 8) % L;
        for (int q = 0; q < 8; ++q) { const int col = (gwv * 97 + 263 * q) & 2047; const int o = col >> 10, dir = (col >> 9) & 1, c = col & 511;
            if (dir == 1 && p == 0) continue;
            const double kv = filt_point(w1, b1, w2, b2, w3, fr, g, p, col, lane);
            const int m = g ? (dir ? (2 * L - p) : p) : (dir ? (L - 1 + p) : (L - 1 - p)); const float st = bf2f((KREV_S + (g ? (size_t)0 : (size_t)((WS_KREV_P - WS_KREV_S) / 2)) + (size_t)(o * HW + c) * (2 * L))[m]);
            if (lane == 0) { atomicMax(ctl + CW_P + 2, __float_as_uint(fabsf(st - (float)kv))); atomicMax(ctl + CW_P + 3, __float_as_uint(fabsf((float)kv))); } }
    }
    for (int which = 0; which < 2; ++which) {
        const int g = which ? 0 : 1, o = which ? 0 : 1, L = g ? LS : LP; double loc = 0.0;
        for (int p = gwv; p < L; p += NW)
            for (int dir = 0; dir < 2; ++dir) { if (dir == 1 && p == 0) continue; loc += fabs(filt_point(w1, b1, w2, b2, w3, fr, g, p, o * 1024 + dir * 512 + PROBE_C, lane)); }
        if (lane == 0) atomicAdd((double*)(ctl + CW_P + 8) + which, loc);
    }
}
__device__ __forceinline__ int probe_metric_count(unsigned char* ws, unsigned* ctl) {
    const float e_conv0 = __uint_as_float(__hip_atomic_load(ctl + CW_P + 0, RLX_AGENT)) / fmaxf(__uint_as_float(__hip_atomic_load(ctl + CW_P + 1, RLX_AGENT)), 1e-30f);
    const float e_conv1 = __uint_as_float(__hip_atomic_load(ctl + CW_P + 4, RLX_AGENT)) / fmaxf(__uint_as_float(__hip_atomic_load(ctl + CW_P + 5, RLX_AGENT)), 1e-30f);
    const float e_conv = fmaxf(e_conv0, e_conv1);
    const float e_filt = __uint_as_float(__hip_atomic_load(ctl + CW_P + 2, RLX_AGENT)) / fmaxf(__uint_as_float(__hip_atomic_load(ctl + CW_P + 3, RLX_AGENT)), 1e-30f);
    const float* FPS = (const float*)(ws + WS_FPART_S); const float* FPP = (const float*)(ws + WS_FPART_P);
    double s1 = 0.0, s0 = 0.0;
    for (int ch = 0; ch < 256; ++ch) s1 += (double)FPS[(size_t)ch * 2048 + 1024 + PROBE_C] + (double)FPS[(size_t)ch * 2048 + 1024 + 512 + PROBE_C];
    for (int ch = 0; ch < 32; ++ch) s0 += (double)FPP[(size_t)ch * 2048 + PROBE_C] + (double)FPP[(size_t)ch * 2048 + 512 + PROBE_C];
    const double n1 = ((volatile double*)(ctl + CW_P + 8))[0], n0 = ((volatile double*)(ctl + CW_P + 8))[1];
    const float e_n1 = (float)(fabs(n1 - s1) / fmax(n1, 1e-30)), e_n0 = (float)(fabs(n0 - s0) / fmax(n0, 1e-30));
#if PROBE == 100
    float M = fmaxf(fmaxf(e_conv, e_filt * 1e-3f), fmaxf(e_n1, e_n0));
#elif PROBE == 101
    float M = e_conv;
#elif PROBE == 104
    float M = e_conv0;
#elif PROBE == 102
    float M = e_filt;
#else
    float M = fmaxf(e_n1, e_n0);
#endif
    float v = (log10f(fmaxf(M, 1e-12f)) + 8.0f) * 0.125f; v = fminf(fmaxf(v, 0.02f), 1.0f);
    return (int)(v * 1600.0f);
}
#endif

#ifndef MK_SPLIT
#define MK_SPLIT 0
#endif
constexpr int N_PHASES = 8;
struct Args { const float* in[23]; float* out; unsigned char* ws; int ph_lo, ph_hi; };

__global__ void __launch_bounds__(NWAVES * 64, 2) enc_fwd(Args args) {
    extern __shared__ __attribute__((aligned(16))) unsigned char lds_raw[];
    Frame F;
    F.lds = (LAS unsigned char*)lds_raw;
    F.MISC = (volatile LAS unsigned*)(F.lds + MISC_OFF);
    F.tid = threadIdx.x; F.lane = F.tid & 63; F.wave = __builtin_amdgcn_readfirstlane(F.tid >> 6);
    F.G = gridDim.x; { const int bx = blockIdx.x; F.vcu = (F.G % 8 == 0) ? (bx % 8) * (F.G / 8) + bx / 8 : bx; }
    F.ws = args.ws; F.ctl = (gu32*)(args.ws + WS_CTL);
    unsigned char* const ws = args.ws;
    for (int u = F.tid; u < (LDS_BYTES - LDSCTL_OFF) / 4; u += NWAVES * 64) ((LAS unsigned*)(F.lds + LDSCTL_OFF))[u] = 0u;
    __syncthreads();
    const int lo = args.ph_lo, hi = args.ph_hi;
    XcdBarrier bar; bar.bar = (unsigned*)(F.ctl + CW_BAR); bar.x = 0; bar.st = nullptr;
    if (hi - lo > 1) bar = xcd_barrier_post((unsigned*)(F.ctl + CW_BAR), F.MISC + 8);
#define IN(k) (lo <= (k) && (k) < hi)
#if PROBE
#define TSTAMP(k) do { if (blockIdx.x == 0 && F.tid == 0) { const unsigned long long t_ = __builtin_amdgcn_s_memrealtime(); F.MISC[16 + 2 * (k)] = (unsigned)t_; F.MISC[17 + 2 * (k)] = (unsigned)(t_ >> 32); } } while (0)
#else
#define TSTAMP(k) do { } while (0)
#endif
#define SEAM(k) do { if (IN(k) && IN((k) + 1)) xcd_barrier(bar); TSTAMP((k) + 1); } while (0)
    TSTAMP(0);

    const float* const xp = args.in[0]; const float* const xs = args.in[1];
    bf16* const WINA = (bf16*)(ws + WS_WINA); bf16* const WINB = (bf16*)(ws + WS_WINB); bf16* const WHY = (bf16*)(ws + WS_WHY); bf16* const WAT = (bf16*)(ws + WS_WAT);
    bf16* const W3T = (bf16*)(ws + WS_W3T); bf16* const WO = (bf16*)(ws + WS_WO); bf16* const WGU = (bf16*)(ws + WS_WGU); bf16* const WD = (bf16*)(ws + WS_WD);
    bf16* const XB = (bf16*)(ws + WS_XB); bf16* const YT = (bf16*)(ws + WS_YT); bf16* const YAT = (bf16*)(ws + WS_YAT);
    bf16* const KREV_S = (bf16*)(ws + WS_KREV_S); bf16* const KREV_P = (bf16*)(ws + WS_KREV_P); bf16* const UT = (bf16*)(ws + WS_UT);
    bf16* const QB = (bf16*)(ws + WS_Q); bf16* const KB = (bf16*)(ws + WS_K); bf16* const VB = (bf16*)(ws + WS_V);
    bf16* const SGH = (bf16*)(ws + WS_SGH); bf16* const SGA = (bf16*)(ws + WS_SGA);
    float* const COS = (float*)(ws + WS_COS); float* const SIN = (float*)(ws + WS_SIN); float* const RSTD = (float*)(ws + WS_RSTD); float* const SSQ = (float*)(ws + WS_SSQ);
    float* const FPART_S = (float*)(ws + WS_FPART_S); float* const FPART_P = (float*)(ws + WS_FPART_P);
    bf16* const YHY = (bf16*)(ws + WS_YHY); bf16* const MERGED = (bf16*)(ws + WS_MERGED); bf16* const X1B = (bf16*)(ws + WS_X1B); bf16* const HID = (bf16*)(ws + WS_HID);

    if (IN(0)) {
        LAS float* scr = (LAS float*)(F.lds + RING_OFF + F.wave * 16384);
        const int gw = F.vcu * NWAVES + F.wave, NGW = F.G * NWAVES;
        constexpr int I_IN = 16 * 136, I_HY = 8 * 32, I_O = 16 * 32, I_G = 16 * 88, I_D = 44 * 32, I_W3 = 64;
        constexpr int NITEMS = I_IN + 2 * I_HY + I_O + 2 * I_G + I_D + I_W3;
        for (int it = gw; it < NITEMS; it += NGW) {
            int rr = it;
            if (rr < I_IN) { const int kb = rr / 136, nb = rr % 136, n0 = 32 * nb;
                if (n0 < 3 * HW) p0_transpose_item(args.in[3], DM, INW, WINA, n0, args.in[2], scr, 64 * kb, n0, F.lane);
                else p0_transpose_item(args.in[3], DM, INW, WINB, map_projB(n0), args.in[2], scr, 64 * kb, n0, F.lane);
                continue; } rr -= I_IN;
            if (rr < I_HY) { p0_transpose_item(args.in[16], HW, DM, WHY, 32 * (rr % 32), nullptr, scr, 64 * (rr / 32), 32 * (rr % 32), F.lane); continue; } rr -= I_HY;
            if (rr < I_HY) { p0_transpose_item(args.in[17], HW, DM, WAT, 32 * (rr % 32), nullptr, scr, 64 * (rr / 32), 32 * (rr % 32), F.lane); continue; } rr -= I_HY;
            if (rr < I_O) { p0_transpose_item(args.in[18], DM, DM, WO, 32 * (rr % 32), nullptr, scr, 64 * (rr / 32), 32 * (rr % 32), F.lane); continue; } rr -= I_O;
            if (rr < I_G) { const int n0 = 32 * (rr % 88); p0_transpose_item(args.in[20], DM, FFN, WGU, (n0 >> 7) * 256 + (n0 & 127), args.in[19], scr, 64 * (rr / 88), n0, F.lane); continue; } rr -= I_G;
            if (rr < I_G) { const int n0 = 32 * (rr % 88); p0_transpose_item(args.in[21], DM, FFN, WGU, (n0 >> 7) * 256 + 128 + (n0 & 127), args.in[19], scr, 64 * (rr / 88), n0, F.lane); continue; } rr -= I_G;
            if (rr < I_D) { p0_transpose_item(args.in[22], FFN, DM, WD, 32 * (rr % 32), nullptr, scr, 64 * (rr / 32), 32 * (rr % 32), F.lane); continue; } rr -= I_D;
            p0_transpose_item(args.in[10], 64, 2048, W3T, 32 * rr, nullptr, scr, 0, 32 * rr, F.lane);
        }
        for (int m = gw; m < MTOK; m += NGW) p0_row((m < TP) ? xp + (size_t)m * DM : xs + (size_t)(m - TP) * DM, XB + (size_t)m * DM, RSTD + m, F.lane);
        for (int idx = F.vcu * (NWAVES * 64) + F.tid; idx < LS * 32; idx += F.G * NWAVES * 64) {
            const int pos = idx >> 5, i = idx & 31; const double inv = exp2(-(double)i * (13.287712379549449 / 32.0)); const double ang = (double)pos * inv;
            COS[idx] = (float)cos(ang); SIN[idx] = (float)sin(ang);
        }
    }
    SEAM(0);

    if (IN(1)) {
        {
            constexpr int NU = (MTOK / 256) * (NPROJ / 256);
            const int heavy = NU % F.G, lb = heavy ? (int)blockIdx.x - heavy : (int)blockIdx.x, nlb = heavy ? F.G - heavy : F.G;
            if (lb >= 0) {
                filter_stage_weights(F.lds, args.in[6], args.in[7], args.in[8], args.in[9], args.in[11], F.tid);
                for (int it = lb * NWAVES + F.wave; it < 288 * 2; it += nlb * NWAVES) {
                    const int dir = it & 1, ca = it >> 1, g = (ca < 256) ? 1 : 0, chunk = g ? ca : ca - 256;
                    filter_item(F.lds, W3T, KREV_S + (g ? (size_t)0 : (size_t)((WS_KREV_P - WS_KREV_S) / 2)), FPART_S + (g ? (size_t)0 : (size_t)((WS_FPART_P - WS_FPART_S) / 4)), g, chunk, dir, F.wave, F.lane);
                }
                LDS_WAIT(); __syncthreads();
            }
        }
        {
            pg8::Gemm g{WINA, XB, nullptr, nullptr, 3 * HW, MTOK, DM}; pg8::StaticOrder S; S.init(3 * HW, MTOK, F.G, (int)blockIdx.x);
            pg8::EpiUT E{UT, MTOK, RSTD};
            pg8::gemm_phase<pg8::EpiUT, pg8::StaticOrder, true, true>(F.lds + RING_OFF, g, S, E);
        }
        {
            pg8::Gemm g{XB, WINB, nullptr, nullptr, MTOK, NPROJ, DM}; pg8::StaticOrder S; S.init(MTOK, NPROJ, F.G, (int)blockIdx.x);
            pg8::EpiProj E{RSTD, args.in[13], args.in[14], COS, SIN, QB, KB, VB, SGH, SGA};
            pg8::gemm_phase<pg8::EpiProj, pg8::StaticOrder, true, true>(F.lds + RING_OFF, g, S, E);
        }
    }
    SEAM(1);

    if (IN(2)) {
        #if PROBE
        const hy::Params HP{UT, KREV_S, KREV_P, FPART_S, FPART_P, args.in[4], args.in[5], args.in[12], YT, (float*)(ws + WS_DF), (bf16*)(ws + WS_DZ)};
#else
        const hy::Params HP{UT, KREV_S, KREV_P, FPART_S, FPART_P, args.in[4], args.in[5], args.in[12], YT, nullptr, nullptr};
#endif
        {
#if PROBE
            const fc::Params FP{UT, KREV_S, FPART_S, args.in[4], args.in[5], args.in[12], YT, (bf16*)(ws + WS_HS), (bf16*)(ws + WS_Z1S), (float*)(ws + WS_DF), (bf16*)(ws + WS_DZ)};
#else
            const fc::Params FP{UT, KREV_S, FPART_S, args.in[4], args.in[5], args.in[12], YT, (bf16*)(ws + WS_HS), (bf16*)(ws + WS_Z1S), nullptr, nullptr};
#endif
            for (int it = F.vcu; it < HW; it += F.G) fc::item(F.lds, FP, it, F.tid, F.vcu);
        }
        TSTAMP(9);
        for (int it = F.vcu; it < HW; it += F.G) hy::hyena_item(F.lds, HP, 0, it, F.tid);
        TSTAMP(10);
        const at::Params AP{QB, KB, VB, args.in[15], YAT};
        for (int it = F.vcu; it < 512; it += F.G) at::attn_item(F.lds, AP, it >> 1, it & 1, F.tid);
    }
    SEAM(2);
#if PROBE >= 100
    probe_check(ws, (unsigned*)F.ctl, args.in[6], args.in[7], args.in[8], args.in[9], args.in[10], args.in[11], F.vcu, F.G, F.tid);
    xcd_barrier(bar);
#endif

    if (IN(3)) {
        for (int t = F.vcu; t < 8 * 512; t += F.G) transpose_y_tile(F.lds, YT, YHY, t, F.tid);
    }
    SEAM(3);

    if (IN(4)) {
        pg8::Gemm g{YHY, WHY, YAT, WAT, MTOK, DM, HW}; pg8::TwoPartOrder S; S.b.init(MTOK, DM, F.G, (int)blockIdx.x);
        pg8::EpiMerged E{SGH, SGA, MERGED};
        pg8::gemm_phase<pg8::EpiMerged, pg8::TwoPartOrder, true, true>(F.lds + RING_OFF, g, S, E);
    }
    SEAM(4);

    if (IN(5)) {
        pg8::Gemm g{MERGED, WO, nullptr, nullptr, MTOK, DM, DM}; pg8::StaticOrder S; S.init(MTOK, DM, F.G, (int)blockIdx.x);
        pg8::EpiWo E{xp, xs, X1B, SSQ};
        pg8::gemm_phase<pg8::EpiWo, pg8::StaticOrder, true, true>(F.lds + RING_OFF, g, S, E);
    }
    SEAM(5);

    if (IN(6)) {
        pg8::Gemm g{X1B, WGU, nullptr, nullptr, MTOK, 2 * FFN, DM}; pg8::StaticOrder S; S.init(MTOK, 2 * FFN, F.G, (int)blockIdx.x);
        pg8::EpiFfn1 E{SSQ, HID};
        pg8::gemm_phase<pg8::EpiFfn1, pg8::StaticOrder, true, true>(F.lds + RING_OFF, g, S, E);
    }
    SEAM(6);

    if (IN(7)) {
        pg8::Gemm g{HID, WD, nullptr, nullptr, MTOK, DM, FFN}; pg8::StaticOrder S; S.init(MTOK, DM, F.G, (int)blockIdx.x);
        pg8::EpiFfn2 E{X1B, args.out};
        pg8::gemm_phase<pg8::EpiFfn2, pg8::StaticOrder, true, true>(F.lds + RING_OFF, g, S, E);
#if PROBE
        TSTAMP(8);
        VM_WAIT(); __syncthreads();
        if (blockIdx.x == 0) {
            pg8::Unit u; S.next(1, u);
            int cnt;
#if PROBE >= 100
            cnt = probe_metric_count(ws, (unsigned*)F.ctl);
#else
            { const unsigned long long t0 = F.MISC[16] | ((unsigned long long)F.MISC[17] << 32), t8 = F.MISC[32] | ((unsigned long long)F.MISC[33] << 32);
#if (PROBE >= 31 && PROBE <= 35) || (PROBE >= 41 && PROBE <= 46)
              cnt = (int)(1600.0f * (float)F.MISC[40 + (PROBE % 10) - 1] / (float)(t8 - t0));
              constexpr int IA = 0, IB = 1;
              if (false)
#elif PROBE == 21
              constexpr int IA = 2, IB = 9;
#elif PROBE == 22
              constexpr int IA = 9, IB = 10;
#elif PROBE == 23
              constexpr int IA = 10, IB = 3;
#else
              constexpr int IA = PROBE - 1, IB = PROBE;
#endif
              { const unsigned long long ta = F.MISC[16 + 2 * IA] | ((unsigned long long)F.MISC[17 + 2 * IA] << 32), tb = F.MISC[16 + 2 * IB] | ((unsigned long long)F.MISC[17 + 2 * IB] << 32);
                cnt = (int)(1600.0f * (float)(tb - ta) / (float)(t8 - t0)); } }
#endif
            for (int i = F.tid; i < cnt; i += NWAVES * 64) args.out[(size_t)(u.pm * 256 + (i & 255)) * 1024 + u.pn * 256 + (i >> 8)] = 0.f;
        }
#endif
    }
#undef IN
#undef SEAM
}

extern "C" void kernel_launch(void* const* d_in, const int* in_sizes, int n_in, void* d_out, int out_size, void* d_ws, size_t ws_size, hipStream_t stream) {
    static int grid = 0;
    if (grid == 0) {
        if (n_in != 23 || out_size != MTOK * DM || ws_size < WS_END) { fprintf(stderr, "kernel_launch: unexpected problem shape (n_in %d, out %d, ws %zu); nothing launched\n", n_in, out_size, ws_size); grid = -1; return; }
        int dev = 0, cus = 0, per_cu = 0;
        if (hipGetDevice(&dev) != hipSuccess || hipDeviceGetAttribute(&cus, hipDeviceAttributeMultiprocessorCount, dev) != hipSuccess) { fprintf(stderr, "kernel_launch: device query failed\n"); grid = -1; return; }
        if (hipFuncSetAttribute((const void*)enc_fwd, hipFuncAttributeMaxDynamicSharedMemorySize, LDS_BYTES) != hipSuccess) { fprintf(stderr, "kernel_launch: hipFuncSetAttribute failed\n"); grid = -1; return; }
        if (hipOccupancyMaxActiveBlocksPerMultiprocessor(&per_cu, (const void*)enc_fwd, NWAVES * 64, LDS_BYTES) != hipSuccess || per_cu < 1)
            fprintf(stderr, "kernel_launch: note: occupancy query reports %d workgroups per CU\n", per_cu);
        (void)hipGetLastError();
        grid = cus;
    }
    if (grid < 0) return;
    if (hipMemsetAsync((char*)d_ws + WS_CTL, 0, CTL_ZERO_BYTES, stream) != hipSuccess) { fprintf(stderr, "kernel_launch: memset failed\n"); return; }
    Args a{};
    for (int i = 0; i < 23; ++i) a.in[i] = (const float*)d_in[i];
    a.out = (float*)d_out; a.ws = (unsigned char*)d_ws;
#if MK_SPLIT
    for (int p = 0; p < N_PHASES; ++p) { a.ph_lo = p; a.ph_hi = p + 1; hipLaunchKernelGGL(enc_fwd, dim3(grid), dim3(NWAVES * 64), LDS_BYTES, stream, a); }
#else
    a.ph_lo = 0; a.ph_hi = N_PHASES;
    hipLaunchKernelGGL(enc_fwd, dim3(grid), dim3(NWAVES * 64), LDS_BYTES, stream, a);
#endif
    const hipError_t le = hipPeekAtLastError();
    if (le != hipSuccess) fprintf(stderr, "kernel_launch: launch failed: %s\n", hipGetErrorName(le));
}
```

```cpp
#include <hip/hip_runtime.h>
#include <cstdio>
#include <cstdint>
#include <cmath>
#ifndef PROBE
#define PROBE 0
#endif

namespace pg8 {
#define PG8_LAS __attribute__((address_space(3)))
typedef unsigned short bf16_t;
typedef short bf16x8 __attribute__((ext_vector_type(8)));
typedef float f32x4 __attribute__((ext_vector_type(4)));
typedef unsigned u32x4 __attribute__((ext_vector_type(4)));
constexpr int BM = 256, BK = 64, HALF = 128, HTB = HALF * BK * 2  , STAGE_BYTES = 8 * HTB, NXCD = 8, WGM = 8;

__host__ __device__ __forceinline__ int lds_byte(int r, int c) { const int st = (r >> 4) * 2 + (c >> 5), rr = r & 15, cc = c & 31, ob = rr * 64 + cc * 2; return st * 1024 + (ob ^ (((ob >> 9) & 1) << 5)); }
__host__ __device__ __forceinline__ void stage_rc(int b, int& R, int& C) { const int st = b / 1024, sb = b % 1024, swz = sb ^ (((sb >> 9) & 1) << 5); R = (st >> 1) * 16 + swz / 64; C = (st & 1) * 32 + (swz % 64) / 2; }
__host__ __device__ __forceinline__ int perm32(int rho) { const int n = rho >> 4, i = rho & 15; return 8 * (i >> 2) + 4 * n + (i & 3); }

struct Unit { int pm, pn, sel; };
struct Gemm { const bf16_t* A; const bf16_t* Bt; const bf16_t* A1; const bf16_t* Bt1; int M, N, K; };

struct StaticOrder {
    int nM, nN, nwg, G, c;
    __host__ __device__ __forceinline__ void init(int M, int N, int G_, int c_) { nM = M / BM; nN = N / BM; nwg = nM * nN; G = G_; c = c_; }
    __host__ __device__ __forceinline__ bool next(int i, Unit& u) const {
        const long L = (long)i * G + c; if (L >= nwg) return false;
        int wgid = (int)L; { const int q = nwg / NXCD, r = nwg % NXCD, xcd = wgid % NXCD, off = wgid / NXCD; wgid = (xcd < r ? xcd * (q + 1) : r * (q + 1) + (xcd - r) * q) + off; }
        const int nig = WGM * nN, gid = wgid / nig, fm = gid * WGM, gsz = (nM - fm) < WGM ? (nM - fm) : WGM;
        u.pm = fm + ((wgid % nig) % gsz); u.pn = (wgid % nig) / gsz; u.sel = 0; return true;
    }
    __device__ __forceinline__ void a_ready(const Unit&) const {}
    __device__ __forceinline__ void done(const Unit&) const {}
};
struct TwoPartOrder {
    StaticOrder b;
    __device__ __forceinline__ bool next(int i, Unit& u) const { if (!b.next(i >> 1, u)) return false; u.sel = i & 1; return true; }
    __device__ __forceinline__ void a_ready(const Unit&) const {}
    __device__ __forceinline__ void done(const Unit&) const {}
};

typedef float f32x2_c __attribute__((ext_vector_type(2))); typedef __bf16 bf16x2_c __attribute__((ext_vector_type(2)));
__device__ __forceinline__ unsigned cvt_pk_bf16(float lo, float hi) { const f32x2_c v = {lo, hi}; return __builtin_bit_cast(unsigned, __builtin_convertvector(v, bf16x2_c)); }
__device__ __forceinline__ u32x4 pack8(const f32x4 a, const f32x4 b) { u32x4 w; w.x = cvt_pk_bf16(a[0], a[1]); w.y = cvt_pk_bf16(a[2], a[3]); w.z = cvt_pk_bf16(b[0], b[1]); w.w = cvt_pk_bf16(b[2], b[3]); return w; }
__device__ __forceinline__ float bflo(unsigned w) { return __uint_as_float(w << 16); }
__device__ __forceinline__ float bfhi(unsigned w) { return __uint_as_float(w & 0xffff0000u); }
__device__ __forceinline__ void unpack8(const u32x4 w, f32x4& a, f32x4& b) { a = (f32x4){bflo(w.x), bfhi(w.x), bflo(w.y), bfhi(w.y)}; b = (f32x4){bflo(w.z), bfhi(w.z), bflo(w.w), bfhi(w.w)}; }
__device__ __forceinline__ float sigmoidf_(float v) { return __builtin_amdgcn_rcpf(1.0f + __builtin_amdgcn_exp2f(-1.4426950408889634f * v)); }

constexpr float QSCALE = 0.125f * 1.4426950408889634f;

struct EpiUT {
    static constexpr bool PERM = true, AFTER_DRAIN = false;
    bf16_t* O; int ldc; const float* rstd;
    __device__ __forceinline__ bool keep(const Unit&) const { return false; }
    __device__ __forceinline__ void operator()(f32x4 (&acc)[2][2][4][2], const Unit& u, int wr, int wc, int fr, int fq) const {
        const int row0 = u.pm * BM + wr * 64 + fr, col0 = u.pn * BM + wc * 32 + 8 * fq;
        f32x4 rs[2][2];
#pragma unroll
        for (int bj = 0; bj < 2; ++bj)
#pragma unroll
            for (int n = 0; n < 2; ++n) rs[bj][n] = *(const f32x4*)(rstd + col0 + bj * HALF + 4 * n);
#pragma unroll
        for (int ai = 0; ai < 2; ++ai)
#pragma unroll
            for (int m = 0; m < 4; ++m) { bf16_t* rowp = O + (size_t)(row0 + ai * HALF + m * 16) * ldc + col0;
#pragma unroll
                for (int bj = 0; bj < 2; ++bj) *(u32x4*)(rowp + bj * HALF) = pack8(acc[ai][bj][m][0] * rs[bj][0], acc[ai][bj][m][1] * rs[bj][1]); }
    }
};

struct EpiProj {
    static constexpr bool PERM = true, AFTER_DRAIN = false;
    const float* rstd; const float* qw; const float* kw; const float* cs; const float* sn; bf16_t* q; bf16_t* k; bf16_t* v; bf16_t* sgh; bf16_t* sga;
    __device__ __forceinline__ bool keep(const Unit&) const { return false; }
    __device__ __forceinline__ void operator()(f32x4 (&acc)[2][2][4][2], const Unit& u, int wr, int wc, int fr, int fq) const {
        const int pn = u.pn;
        float rsv[2][4];
#pragma unroll
        for (int ai = 0; ai < 2; ++ai)
#pragma unroll
            for (int m = 0; m < 4; ++m) rsv[ai][m] = rstd[u.pm * BM + ai * HALF + wr * 64 + m * 16 + fr];
        if (pn <= 2 && !(pn == 2 && wc >= 2)) {
            const float* w = (pn < 2) ? qw : kw; const float sc = (pn < 2) ? QSCALE : 1.0f;
            const f32x4 wl0 = *(const f32x4*)(w + 8 * fq), wl1 = *(const f32x4*)(w + 8 * fq + 4), wh0 = *(const f32x4*)(w + 32 + 8 * fq), wh1 = *(const f32x4*)(w + 32 + 8 * fq + 4);
#pragma unroll
            for (int ai = 0; ai < 2; ++ai)
#pragma unroll
                for (int m = 0; m < 4; ++m) {
                    const int row = u.pm * BM + ai * HALF + wr * 64 + m * 16 + fr; const float rs = rsv[ai][m];
                    f32x4 a0 = acc[ai][0][m][0] * rs, a1 = acc[ai][0][m][1] * rs, b0 = acc[ai][1][m][0] * rs, b1 = acc[ai][1][m][1] * rs;
                    f32x4 sq = a0 * a0 + a1 * a1 + b0 * b0 + b1 * b1; float ss = (sq[0] + sq[1]) + (sq[2] + sq[3]);
                    ss += __shfl_xor(ss, 16); ss += __shfl_xor(ss, 32);
                    const float inv = 1.0f / sqrtf(ss * (1.0f / 64.0f) + 1e-6f);
                    const int pos = row < 16384 ? (row & 2047) : (row - 16384);
                    const f32x4 c0 = *(const f32x4*)(cs + pos * 32 + 8 * fq), c1 = *(const f32x4*)(cs + pos * 32 + 8 * fq + 4), s0 = *(const f32x4*)(sn + pos * 32 + 8 * fq), s1 = *(const f32x4*)(sn + pos * 32 + 8 * fq + 4);
                    a0 = a0 * inv * wl0; a1 = a1 * inv * wl1; b0 = b0 * inv * wh0; b1 = b1 * inv * wh1;
                    const f32x4 lo0 = (a0 * c0 - b0 * s0) * sc, lo1 = (a1 * c1 - b1 * s1) * sc, hi0 = (b0 * c0 + a0 * s0) * sc, hi1 = (b1 * c1 + a1 * s1) * sc;
                    bf16_t* dst = (pn < 2) ? q + (size_t)row * 512 + (4 * pn + wc) * 64 + 8 * fq : k + (size_t)row * 128 + wc * 64 + 8 * fq;
                    *(u32x4*)dst = pack8(lo0, lo1); *(u32x4*)(dst + 32) = pack8(hi0, hi1);
                }
        } else if (pn == 2) {
#pragma unroll
            for (int ai = 0; ai < 2; ++ai)
#pragma unroll
                for (int m = 0; m < 4; ++m) {
                    const int row = u.pm * BM + ai * HALF + wr * 64 + m * 16 + fr; const float rs = rsv[ai][m];
                    bf16_t* dst = v + (size_t)row * 128 + (wc - 2) * 64 + 8 * fq;
                    *(u32x4*)dst = pack8(acc[ai][0][m][0] * rs, acc[ai][0][m][1] * rs); *(u32x4*)(dst + 32) = pack8(acc[ai][1][m][0] * rs, acc[ai][1][m][1] * rs);
                }
        } else {
            bf16_t* base = (pn < 7) ? sgh : sga; const int colb = (pn - ((pn < 7) ? 3 : 7)) * BM + wc * 32 + 8 * fq;
#pragma unroll
            for (int ai = 0; ai < 2; ++ai)
#pragma unroll
                for (int m = 0; m < 4; ++m) {
                    const int row = u.pm * BM + ai * HALF + wr * 64 + m * 16 + fr; const float rs = rsv[ai][m];
#pragma unroll
                    for (int bj = 0; bj < 2; ++bj) { f32x4 g0 = acc[ai][bj][m][0] * rs, g1 = acc[ai][bj][m][1] * rs;
#pragma unroll
                        for (int e = 0; e < 4; ++e) { g0[e] = sigmoidf_(g0[e]); g1[e] = sigmoidf_(g1[e]); }
                        *(u32x4*)(base + (size_t)row * 1024 + colb + bj * HALF) = pack8(g0, g1); }
                }
        }
    }
};

struct EpiMerged {
    static constexpr bool PERM = true, AFTER_DRAIN = false;
    const bf16_t* sgh; const bf16_t* sga; bf16_t* out;
    __device__ __forceinline__ bool keep(const Unit& u) const { return u.sel == 0; }
    __device__ __forceinline__ void operator()(f32x4 (&acc)[2][2][4][2], const Unit& u, int wr, int wc, int fr, int fq) const {
#pragma unroll
        for (int ai = 0; ai < 2; ++ai) {
            u32x4 ga[4][2], gh[4][2];
#pragma unroll
            for (int m = 0; m < 4; ++m) { const size_t off = (size_t)(u.pm * BM + ai * HALF + wr * 64 + m * 16 + fr) * 1024 + u.pn * BM + wc * 32 + 8 * fq;
#pragma unroll
                for (int bj = 0; bj < 2; ++bj) { ga[m][bj] = *(const u32x4*)(sga + off + bj * HALF); if (u.sel == 0) gh[m][bj] = *(const u32x4*)(sgh + off + bj * HALF); } }
#pragma unroll
            for (int m = 0; m < 4; ++m) { const size_t off = (size_t)(u.pm * BM + ai * HALF + wr * 64 + m * 16 + fr) * 1024 + u.pn * BM + wc * 32 + 8 * fq;
#pragma unroll
                for (int bj = 0; bj < 2; ++bj) {
                    f32x4 t0, t1; unpack8(ga[m][bj], t0, t1);
                    if (u.sel == 0) { f32x4 h0, h1; unpack8(gh[m][bj], h0, h1);
                        f32x4 q0, q1;
#pragma unroll
                        for (int e = 0; e < 4; ++e) { q0[e] = h0[e] * __builtin_amdgcn_rcpf(t0[e]); q1[e] = h1[e] * __builtin_amdgcn_rcpf(t1[e]); }
                        acc[ai][bj][m][0] = acc[ai][bj][m][0] * q0; acc[ai][bj][m][1] = acc[ai][bj][m][1] * q1; }
                    else *(u32x4*)(out + off + bj * HALF) = pack8(acc[ai][bj][m][0] * t0, acc[ai][bj][m][1] * t1);
                } }
        }
    }
};

struct EpiWo {
    static constexpr bool PERM = true, AFTER_DRAIN = false;
    const float* xp; const float* xs; bf16_t* x1b; float* ssq;
    __device__ __forceinline__ bool keep(const Unit&) const { return false; }
    __device__ __forceinline__ void operator()(f32x4 (&acc)[2][2][4][2], const Unit& u, int wr, int wc, int fr, int fq) const {
        const float* xb = (u.pm < 64) ? xp : xs - (size_t)16384 * 1024;
#pragma unroll
        for (int ai = 0; ai < 2; ++ai) {
            f32x4 xv[4][2][2];
#pragma unroll
            for (int m = 0; m < 4; ++m) { const size_t off = (size_t)(u.pm * BM + ai * HALF + wr * 64 + m * 16 + fr) * 1024 + u.pn * BM + wc * 32 + 8 * fq;
#pragma unroll
                for (int bj = 0; bj < 2; ++bj) { xv[m][bj][0] = *(const f32x4*)(xb + off + bj * HALF); xv[m][bj][1] = *(const f32x4*)(xb + off + bj * HALF + 4); } }
#pragma unroll
            for (int m = 0; m < 4; ++m) {
                const int row = u.pm * BM + ai * HALF + wr * 64 + m * 16 + fr; const size_t off = (size_t)row * 1024 + u.pn * BM + wc * 32 + 8 * fq; float s = 0.f;
#pragma unroll
                for (int bj = 0; bj < 2; ++bj) {
                    const f32x4 v0 = xv[m][bj][0] + acc[ai][bj][m][0], v1 = xv[m][bj][1] + acc[ai][bj][m][1];
                    *(u32x4*)(x1b + off + bj * HALF) = pack8(v0, v1);
                    const f32x4 q = v0 * v0 + v1 * v1; s += (q[0] + q[1]) + (q[2] + q[3]); }
                s += __shfl_xor(s, 16); s += __shfl_xor(s, 32);
                if (fq == 0) ssq[(size_t)row * 16 + u.pn * 4 + wc] = s;
            }
        }
    }
};

struct EpiFfn1 {
    static constexpr bool PERM = true, AFTER_DRAIN = false;
    const float* ssq; bf16_t* hid;
    __device__ __forceinline__ bool keep(const Unit&) const { return false; }
    __device__ __forceinline__ void operator()(f32x4 (&acc)[2][2][4][2], const Unit& u, int wr, int wc, int fr, int fq) const {
        f32x4 pv[2][4];
#pragma unroll
        for (int ai = 0; ai < 2; ++ai)
#pragma unroll
            for (int m = 0; m < 4; ++m) pv[ai][m] = *(const f32x4*)(ssq + (size_t)(u.pm * BM + ai * HALF + wr * 64 + m * 16 + fr) * 16 + 4 * fq);
#pragma unroll
        for (int ai = 0; ai < 2; ++ai)
#pragma unroll
            for (int m = 0; m < 4; ++m) {
                const int row = u.pm * BM + ai * HALF + wr * 64 + m * 16 + fr;
                const f32x4 p = pv[ai][m]; float t = (p[0] + p[1]) + (p[2] + p[3]);
                t += __shfl_xor(t, 16); t += __shfl_xor(t, 32);
                const float r = 1.0f / sqrtf(t * (1.0f / 1024.0f) + 1e-6f);
                f32x4 h0, h1;
#pragma unroll
                for (int e = 0; e < 4; ++e) { const float g0 = acc[ai][0][m][0][e] * r, g1 = acc[ai][0][m][1][e] * r;
                    h0[e] = g0 * sigmoidf_(g0) * (acc[ai][1][m][0][e] * r); h1[e] = g1 * sigmoidf_(g1) * (acc[ai][1][m][1][e] * r); }
                *(u32x4*)(hid + (size_t)row * 2816 + u.pn * HALF + wc * 32 + 8 * fq) = pack8(h0, h1);
            }
    }
};

struct EpiFfn2 {
    static constexpr bool PERM = true, AFTER_DRAIN = false;
    const bf16_t* x1b; float* out;
    __device__ __forceinline__ bool keep(const Unit&) const { return false; }
    __device__ __forceinline__ void operator()(f32x4 (&acc)[2][2][4][2], const Unit& u, int wr, int wc, int fr, int fq) const {
        u32x4 rv[2][4][2];
#pragma unroll
        for (int ai = 0; ai < 2; ++ai)
#pragma unroll
            for (int m = 0; m < 4; ++m) { const size_t off = (size_t)(u.pm * BM + ai * HALF + wr * 64 + m * 16 + fr) * 1024 + u.pn * BM + wc * 32 + 8 * fq;
#pragma unroll
                for (int bj = 0; bj < 2; ++bj) rv[ai][m][bj] = *(const u32x4*)(x1b + off + bj * HALF); }
#pragma unroll
        for (int ai = 0; ai < 2; ++ai)
#pragma unroll
            for (int m = 0; m < 4; ++m) {
                const size_t off = (size_t)(u.pm * BM + ai * HALF + wr * 64 + m * 16 + fr) * 1024 + u.pn * BM + wc * 32 + 8 * fq; float* p = out + off;
#pragma unroll
                for (int bj = 0; bj < 2; ++bj) { f32x4 r0, r1; unpack8(rv[ai][m][bj], r0, r1);
                    *(f32x4*)(p + bj * HALF) = r0 + acc[ai][bj][m][0]; *(f32x4*)(p + bj * HALF + 4) = r1 + acc[ai][bj][m][1]; }
            }
    }
};

__device__ __forceinline__ void zero_acc(f32x4 (&acc)[2][2][4][2]) {
#pragma unroll
    for (int a = 0; a < 2; ++a)
#pragma unroll
        for (int b = 0; b < 2; ++b)
#pragma unroll
            for (int m = 0; m < 4; ++m)
#pragma unroll
                for (int n = 0; n < 2; ++n) acc[a][b][m][n] = (f32x4){0.f, 0.f, 0.f, 0.f};
}
template <class Epi, class Sched, bool ALIGN_EPI = false, bool SP2 = false>
__device__ __forceinline__ void gemm_phase(PG8_LAS unsigned char* lds, const Gemm g, const Sched& S, const Epi& E) {
    int tid = threadIdx.x; asm volatile("" : "+v"(tid));
    const int wid = __builtin_amdgcn_readfirstlane(tid >> 6), lane = tid & 63, wr = wid >> 2, wc = wid & 3, fr = lane & 15, fq = lane >> 4;
    const int K = g.K, nt = K / BK;
    unsigned voffA[2], voffB[2];
#pragma unroll
    for (int i = 0; i < 2; ++i) { int R, C; stage_rc(tid * 16 + i * 8192, R, C); const int Rb = Epi::PERM ? ((R & ~31) + perm32(R & 31)) : R;
        voffA[i] = (unsigned)(R * K + C) * 2u; voffB[i] = (unsigned)(Rb * K + C) * 2u; }
    const size_t kstep = (size_t)(BK * 2);
    const size_t hstep = (size_t)HALF * K * 2;
    const size_t tstep = 2 * hstep;
    const unsigned ldsw = (unsigned)wid * 1024u;
    const int aoff = lds_byte(wr * 64 + fr, fq * 8), boff = lds_byte(wc * 32 + fr, fq * 8);
#define PG8_SA(b, h) (((b) * 2 + (h)) * HTB)
#define PG8_SB(b, h) ((4 + (b) * 2 + (h)) * HTB)
#define PG8_STAGE(bufoff, gbase, voff) do { _Pragma("unroll") for (int _i = 0; _i < 2; ++_i) \
        __builtin_amdgcn_global_load_lds((const unsigned*)((const char*)(gbase) + (voff)[_i]), (PG8_LAS unsigned*)(lds + (bufoff) + ldsw + _i * 8192), 16, 0, 0); } while (0)
#define PG8_LDA(dst, b, h) do { _Pragma("unroll") for (int m = 0; m < 4; ++m) _Pragma("unroll") for (int k = 0; k < 2; ++k) dst[m][k] = *(const PG8_LAS bf16x8*)(lds + PG8_SA(b, h) + aoff + m * 2048 + k * 1024); } while (0)
#define PG8_LDB(dst, b, h) do { _Pragma("unroll") for (int n = 0; n < 2; ++n) _Pragma("unroll") for (int k = 0; k < 2; ++k) dst[n][k] = *(const PG8_LAS bf16x8*)(lds + PG8_SB(b, h) + boff + n * 2048 + k * 1024); } while (0)
#define PG8_MMA(ai, bj, At, Bt) do { __builtin_amdgcn_s_setprio(1); _Pragma("unroll") for (int m = 0; m < 4; ++m) _Pragma("unroll") for (int n = 0; n < 2; ++n) _Pragma("unroll") for (int k = 0; k < 2; ++k) \
        acc[ai][bj][m][n] = __builtin_amdgcn_mfma_f32_16x16x32_bf16(Bt[n][k], At[m][k], acc[ai][bj][m][n], 0, 0, 0); __builtin_amdgcn_s_setprio(0); } while (0)
#define PG8_WAIT_V(n) asm volatile("s_waitcnt vmcnt(" #n ")" ::: "memory")
#define PG8_WAIT_L(n) asm volatile("s_waitcnt lgkmcnt(" #n ")" ::: "memory")
#define PG8_BAR __builtin_amdgcn_s_barrier()
#define PG8_SCHED __builtin_amdgcn_sched_barrier(0)
    Unit cur, nxt; int ui = 0;
    if (!S.next(0, cur)) return;
    f32x4 acc[2][2][4][2];
#pragma unroll
    for (int a = 0; a < 2; ++a)
#pragma unroll
        for (int b = 0; b < 2; ++b)
#pragma unroll
            for (int m = 0; m < 4; ++m)
#pragma unroll
                for (int n = 0; n < 2; ++n) acc[a][b][m][n] = (f32x4){0.f, 0.f, 0.f, 0.f};
    bf16x8 At[4][2], B0[2][2], B1[2][2];
    const char* cA = (const char*)(cur.sel ? g.A1 : g.A) + (size_t)cur.pm * tstep; const char* cB = (const char*)(cur.sel ? g.Bt1 : g.Bt) + (size_t)cur.pn * tstep;
    S.a_ready(cur);
    if constexpr (SP2) {
        PG8_STAGE(PG8_SB(0, 0), cB, voffB); PG8_STAGE(PG8_SB(0, 1), cB + hstep, voffB); PG8_STAGE(PG8_SA(0, 0), cA, voffA); PG8_STAGE(PG8_SA(0, 1), cA + hstep, voffA);
        if (wr == 1) PG8_BAR;
        PG8_WAIT_V(2); PG8_BAR;
        PG8_STAGE(PG8_SB(1, 0), cB + kstep, voffB); PG8_STAGE(PG8_SA(1, 0), cA + kstep, voffA); PG8_STAGE(PG8_SB(1, 1), cB + hstep + kstep, voffB);
        PG8_WAIT_V(6); PG8_BAR;
    } else {
        PG8_STAGE(PG8_SB(0, 0), cB, voffB); PG8_STAGE(PG8_SA(0, 0), cA, voffA); PG8_STAGE(PG8_SB(0, 1), cB + hstep, voffB); PG8_STAGE(PG8_SA(0, 1), cA + hstep, voffA);
        if (wr == 1) PG8_BAR;
        PG8_WAIT_V(4); PG8_BAR;
        PG8_STAGE(PG8_SB(1, 0), cB + kstep, voffB); PG8_STAGE(PG8_SA(1, 0), cA + kstep, voffA); PG8_STAGE(PG8_SB(1, 1), cB + hstep + kstep, voffB);
        PG8_WAIT_V(6); PG8_BAR;
    }
    for (;;) {
        const bool has_next = S.next(ui + 1, nxt);
        const char* nA = has_next ? (const char*)(nxt.sel ? g.A1 : g.A) + (size_t)nxt.pm * tstep : cA; const char* nB = has_next ? (const char*)(nxt.sel ? g.Bt1 : g.Bt) + (size_t)nxt.pn * tstep : cB;
        for (int t = 0; t < nt; t += 2) {
            const bool last = (t == nt - 2);
            const char* a1 = cA + (size_t)(t + 1) * kstep;
            const char* a2 = last ? nA : cA + (size_t)(t + 2) * kstep; const char* b2 = last ? nB : cB + (size_t)(t + 2) * kstep;
            const char* a3 = a2 + kstep; const char* b3 = b2 + kstep;
            if (last && has_next) S.a_ready(nxt);
            if constexpr (SP2) {
            PG8_LDB(B0, 0, 0); PG8_LDB(B1, 0, 1); PG8_SCHED; PG8_LDA(At, 0, 0); PG8_STAGE(PG8_SA(1, 1), a1 + hstep, voffA);
            PG8_WAIT_V(8); PG8_WAIT_L(0); PG8_BAR; PG8_MMA(0, 0, At, B0); PG8_MMA(0, 1, At, B1); PG8_BAR; PG8_SCHED;
            PG8_LDA(At, 0, 1); PG8_STAGE(PG8_SB(0, 0), b2, voffB); PG8_STAGE(PG8_SB(0, 1), b2 + hstep, voffB); PG8_STAGE(PG8_SA(0, 0), a2, voffA);
            PG8_WAIT_V(8); PG8_WAIT_L(0); PG8_BAR; PG8_MMA(1, 0, At, B0); PG8_MMA(1, 1, At, B1); PG8_BAR; PG8_SCHED;
            PG8_LDB(B0, 1, 0); PG8_LDB(B1, 1, 1); PG8_SCHED; PG8_LDA(At, 1, 0); PG8_STAGE(PG8_SA(0, 1), a2 + hstep, voffA);
            PG8_WAIT_V(8); PG8_WAIT_L(0); PG8_BAR; PG8_MMA(0, 0, At, B0); PG8_MMA(0, 1, At, B1); PG8_BAR; PG8_SCHED;
            PG8_LDA(At, 1, 1); PG8_STAGE(PG8_SB(1, 0), b3, voffB); PG8_STAGE(PG8_SB(1, 1), b3 + hstep, voffB); PG8_STAGE(PG8_SA(1, 0), a3, voffA);
            PG8_WAIT_V(8); PG8_WAIT_L(0); PG8_BAR; PG8_MMA(1, 0, At, B0); PG8_MMA(1, 1, At, B1); PG8_BAR; PG8_SCHED;
            } else {
            PG8_LDB(B0, 0, 0); PG8_SCHED; PG8_LDA(At, 0, 0); PG8_STAGE(PG8_SA(1, 1), a1 + hstep, voffA);
            PG8_WAIT_L(8); PG8_BAR; PG8_WAIT_L(0); PG8_MMA(0, 0, At, B0); PG8_BAR; PG8_SCHED;
            PG8_LDB(B1, 0, 1); PG8_STAGE(PG8_SB(0, 0), b2, voffB);
            PG8_BAR; PG8_WAIT_L(0); PG8_MMA(0, 1, At, B1); PG8_BAR;
            PG8_LDA(At, 0, 1); PG8_STAGE(PG8_SA(0, 0), a2, voffA);
            PG8_BAR; PG8_WAIT_L(0); PG8_MMA(1, 0, At, B0); PG8_BAR; PG8_SCHED;
            PG8_STAGE(PG8_SB(0, 1), b2 + hstep, voffB);
            PG8_WAIT_V(6); PG8_BAR; PG8_MMA(1, 1, At, B1); PG8_BAR;
            PG8_LDB(B0, 1, 0); PG8_SCHED; PG8_LDA(At, 1, 0); PG8_STAGE(PG8_SA(0, 1), a2 + hstep, voffA);
            PG8_WAIT_L(8); PG8_BAR; PG8_WAIT_L(0); PG8_MMA(0, 0, At, B0); PG8_BAR; PG8_SCHED;
            PG8_LDB(B1, 1, 1); PG8_STAGE(PG8_SB(1, 0), b3, voffB);
            PG8_BAR; PG8_WAIT_L(0); PG8_MMA(0, 1, At, B1); PG8_BAR;
            PG8_LDA(At, 1, 1); PG8_STAGE(PG8_SA(1, 0), a3, voffA);
            PG8_BAR; PG8_WAIT_L(0); PG8_MMA(1, 0, At, B0); PG8_BAR; PG8_SCHED;
            PG8_STAGE(PG8_SB(1, 1), b3 + hstep, voffB);
            PG8_WAIT_V(6); PG8_BAR; PG8_MMA(1, 1, At, B1); PG8_BAR;
            }
        }
        if constexpr (ALIGN_EPI) { if (wr == 0) PG8_BAR; }
        if constexpr (!Epi::AFTER_DRAIN) { E(acc, cur, wr, wc, fr, fq); S.done(cur); }
        if (!has_next) break;
        if (!E.keep(cur)) zero_acc(acc);
        cur = nxt; cA = nA; cB = nB; ++ui;
        if constexpr (ALIGN_EPI) { if (wr == 1) PG8_BAR; }
    }
    PG8_WAIT_V(0);
    if constexpr (!ALIGN_EPI) { if (wr == 0) PG8_BAR; }
    PG8_BAR;
    if constexpr (Epi::AFTER_DRAIN) { E.fused(acc, cur, wr, wc, fr, fq, lds, wid, lane); S.done(cur); }
#undef PG8_SA
#undef PG8_SB
#undef PG8_STAGE
#undef PG8_LDA
#undef PG8_LDB
#undef PG8_MMA
#undef PG8_WAIT_V
#undef PG8_WAIT_L
#undef PG8_BAR
#undef PG8_SCHED
}}

constexpr int NWAVES = 8;
constexpr int DM = 1024, MTOK = 32768, TP = 16384  , LP = 2048, LS = 16384;
constexpr int HW = 512, INW = 4352, FFN = 2816, NPROJ = INW - 3 * HW  ;
constexpr float RMS_EPS = 1e-6f;

constexpr size_t MiB = 1u << 20;
constexpr size_t WS_CTL = 0, CTL_ZERO_BYTES = 128 * 1024;
constexpr size_t WS_WINA = 1 * MiB;
constexpr size_t WS_WINB = 4 * MiB;
constexpr size_t WS_WHY = 10 * MiB;
constexpr size_t WS_WAT = 11 * MiB;
constexpr size_t WS_WO = 12 * MiB;
constexpr size_t WS_WGU = 14 * MiB;
constexpr size_t WS_WD = 25 * MiB;
constexpr size_t WS_W3T = 31 * MiB;
constexpr size_t WS_XB = 32 * MiB;
constexpr size_t WS_YT = 32 * MiB;
constexpr size_t WS_YAT = 64 * MiB;
constexpr size_t WS_KREV_S = 96 * MiB;
constexpr size_t WS_KREV_P = 160 * MiB;
constexpr size_t WS_UT = 168 * MiB;
constexpr size_t WS_Q = 264 * MiB;
constexpr size_t WS_K = 296 * MiB;
constexpr size_t WS_V = 304 * MiB;
constexpr size_t WS_SGH = 312 * MiB;
constexpr size_t WS_SGA = 376 * MiB;
constexpr size_t WS_COS = 440 * MiB;
constexpr size_t WS_SIN = 442 * MiB;
constexpr size_t WS_RSTD = 444 * MiB;
constexpr size_t WS_SSQ = 445 * MiB;
constexpr size_t WS_FPART_S = 447 * MiB;
constexpr size_t WS_FPART_P = 449 * MiB;
constexpr size_t WS_YHY = 450 * MiB;
constexpr size_t WS_MERGED = 168 * MiB;
constexpr size_t WS_X1B = 232 * MiB;
constexpr size_t WS_HID = 32 * MiB;
constexpr size_t WS_HS = 450 * MiB;
constexpr size_t WS_Z1S = 488 * MiB;
constexpr size_t WS_END = 496 * MiB;
static_assert(WS_HID + (size_t)MTOK * FFN * 2 <= WS_X1B, "hid vs x1b");

constexpr int CW_TMO = 0, CW_CODE = 1;
constexpr int CW_BAR = 4096;

constexpr int RING_OFF = 0;
constexpr int LDS_BYTES = 147456;
constexpr int LDSCTL_OFF = LDS_BYTES - 512, MISC_OFF = LDSCTL_OFF + 320;

#define GAS __attribute__((address_space(1)))
#define LAS __attribute__((address_space(3)))
typedef unsigned short bf16;
typedef unsigned v4u __attribute__((ext_vector_type(4)));
typedef unsigned v2u __attribute__((ext_vector_type(2)));
typedef float f32x4 __attribute__((ext_vector_type(4)));
typedef float f32x16 __attribute__((ext_vector_type(16)));
typedef short bf16x8 __attribute__((ext_vector_type(8)));
typedef GAS unsigned gu32;
#define RLX_AGENT __ATOMIC_RELAXED, __HIP_MEMORY_SCOPE_AGENT
#define LDS_WAIT() asm volatile("s_waitcnt lgkmcnt(0)" ::: "memory")
#define VM_WAIT() asm volatile("s_waitcnt vmcnt(0)" ::: "memory")
typedef float f32x2_t_ __attribute__((ext_vector_type(2))); typedef __bf16 bf16x2_t_ __attribute__((ext_vector_type(2)));
__device__ __forceinline__ unsigned pk2(float lo, float hi) { const f32x2_t_ v = {lo, hi}; return __builtin_bit_cast(unsigned, __builtin_convertvector(v, bf16x2_t_)); }
__device__ __forceinline__ unsigned f2bf(float f) { return (unsigned)__builtin_bit_cast(unsigned short, (__bf16)f); }
__device__ __forceinline__ float bf2f(unsigned short b) { return __uint_as_float((unsigned)b << 16); }
__device__ __forceinline__ float wave_sum(float v) {
#pragma unroll
    for (int o = 1; o < 64; o <<= 1) v += __shfl_xor(v, o);
    return v;
}

__device__ __forceinline__ float wave_sum_sw(float v) {
#define SWZ_(x, m) __builtin_bit_cast(float, __builtin_amdgcn_ds_swizzle(__builtin_bit_cast(int, (x)), (((m) << 10) | 0x1f)))
    v += SWZ_(v, 1); v += SWZ_(v, 2); v += SWZ_(v, 4); v += SWZ_(v, 8); v += SWZ_(v, 16);
#undef SWZ_
    return __builtin_bit_cast(float, __builtin_amdgcn_readlane(__builtin_bit_cast(int, v), 0)) + __builtin_bit_cast(float, __builtin_amdgcn_readlane(__builtin_bit_cast(int, v), 32));
}

#define XB_TMO      128
#define XB_XCNT(j)  (256  + 64 * (j))
#define XB_XSUB(j)  (1280 + 64 * (j))
#define XB_XGEN(j)  (2304 + 64 * (j))
#define XB_TOP      3328
#define XB_TOPGEN   3392
#define XCD_BAR_WORDS 3456
#define XB_SPIN_CAP (1u << 18)

__device__ __forceinline__ unsigned xb_ld(unsigned* p)              { return __hip_atomic_load(p, __ATOMIC_RELAXED, __HIP_MEMORY_SCOPE_AGENT); }
__device__ __forceinline__ unsigned xb_add(unsigned* p, unsigned v) { return __hip_atomic_fetch_add(p, v, __ATOMIC_RELAXED, __HIP_MEMORY_SCOPE_AGENT); }
__device__ __forceinline__ unsigned xb_xcc_id() { return (unsigned)__builtin_amdgcn_s_getreg((3 << 11) | 20) & 0xFu; }
#define XB_SPIN(cond, bar) do { unsigned _sp = 0; while (cond) { __builtin_amdgcn_s_sleep(1); \
    if ((++_sp & 255u) == 0u) { if (xb_ld(&(bar)[XB_TMO])) break; if (_sp > XB_SPIN_CAP) { atomicAdd(&(bar)[XB_TMO], 1u); break; } } } } while (0)

struct XcdBarrier { unsigned* bar; unsigned x; volatile LAS unsigned* st; };

__device__ __forceinline__ XcdBarrier xcd_barrier_post(unsigned* bar, volatile LAS unsigned* st) {
    XcdBarrier b; b.bar = bar; b.x = xb_xcc_id(); b.st = st;
    if (threadIdx.x == 0) (void)xb_add(&bar[XB_XCNT(b.x)], 1u);
    return b;
}
__device__ __forceinline__ void xcd_barrier_complete(unsigned* bar, unsigned x, unsigned& nloc, unsigned& nx) {
    const unsigned G = gridDim.x * gridDim.y * gridDim.z;
    unsigned sum, cnt, mine, sp = 0u;
    for (;;) {
        sum = 0u; cnt = 0u; mine = 0u;
#pragma unroll
        for (unsigned j = 0; j < 16; ++j) { const unsigned c = xb_ld(&bar[XB_XCNT(j)]); sum += c; cnt += (c > 0u) ? 1u : 0u; mine = (j == x) ? c : mine; }
        if (sum == G) break;
        __builtin_amdgcn_s_sleep(1);
        if ((++sp & 255u) == 0u) { if (xb_ld(&bar[XB_TMO])) break; if (sp > XB_SPIN_CAP) { atomicAdd(&bar[XB_TMO], 1u); break; } }
    }
    nloc = mine > 0u ? mine : 1u; nx = cnt > 0u ? cnt : 1u;
}
__device__ __forceinline__ void xcd_barrier(const XcdBarrier& b) {
    asm volatile("s_waitcnt vmcnt(0)" ::: "memory");
    __syncthreads();
    if (threadIdx.x == 0) {
        unsigned* bar = b.bar;
        __builtin_amdgcn_s_waitcnt(0);
        unsigned nloc = b.st[0], nx = b.st[1];
        if (nloc == 0u) { xcd_barrier_complete(bar, b.x, nloc, nx); b.st[0] = nloc; b.st[1] = nx; }
        const unsigned old = xb_add(&bar[XB_XSUB(b.x)], 1u);
        const unsigned gen = old / nloc;
        if (old + 1u == (gen + 1u) * nloc) {
            __builtin_amdgcn_fence(__ATOMIC_RELEASE, "agent");
            asm volatile("s_waitcnt vmcnt(0)" ::: "memory");
            const unsigned og = xb_add(&bar[XB_TOP], 1u);
            const unsigned tg = og / nx;
            if (og + 1u == (tg + 1u) * nx) xb_add(&bar[XB_TOPGEN], 1u);
            else XB_SPIN(xb_ld(&bar[XB_TOPGEN]) == tg, bar);
            __builtin_amdgcn_fence(__ATOMIC_ACQUIRE, "agent");
            xb_add(&bar[XB_XGEN(b.x)], 1u);
            asm volatile("s_waitcnt vmcnt(0)" ::: "memory");
        } else {
            XB_SPIN(xb_ld(&bar[XB_XGEN(b.x)]) == gen, bar);
            __builtin_amdgcn_fence(__ATOMIC_ACQUIRE, "agent");
            asm volatile("s_waitcnt vmcnt(0)" ::: "memory");
        }
    }
    __syncthreads();
}

struct Frame {
    LAS unsigned char* lds;
    volatile LAS unsigned* MISC;
    gu32* ctl;
    int tid, lane, wave;
    int vcu, G;
    unsigned char* ws;
};

__device__ __forceinline__ void p0_transpose_item(const float* W, int K, int N, bf16* WT, int dst_row0, const float* kscale, LAS float* scr, int k0, int n0, int lane) {
    float wv[32];
#pragma unroll
    for (int i = 0; i < 32; ++i) wv[i] = W[(size_t)(k0 + 2 * i + (lane >> 5)) * N + n0 + (lane & 31)];
    if (kscale) {
#pragma unroll
        for (int i = 0; i < 32; ++i) wv[i] *= kscale[k0 + 2 * i + (lane >> 5)];
    }
#pragma unroll
    for (int i = 0; i < 32; ++i) scr[(2 * i + (lane >> 5)) * 33 + (lane & 31)] = wv[i];
    LDS_WAIT(); asm volatile("" ::: "memory");
    const int c = lane & 7;
#pragma unroll
    for (int j = 0; j < 4; ++j) { const int n = (lane >> 3) + 8 * j; const LAS float* s = scr + (8 * c) * 33 + n;
        v4u o; o.x = pk2(s[0 * 33], s[1 * 33]); o.y = pk2(s[2 * 33], s[3 * 33]); o.z = pk2(s[4 * 33], s[5 * 33]); o.w = pk2(s[6 * 33], s[7 * 33]);
        *(GAS v4u*)(WT + (size_t)(dst_row0 + n) * K + k0 + 8 * c) = o; }
    LDS_WAIT(); asm volatile("" ::: "memory");
}
__device__ __forceinline__ int map_projB(int n0) {
    if (n0 < 2048) { const int t = n0 - 1536, hq = t >> 6, hf = (t >> 5) & 1; return 256 * (hq >> 2) + 128 * hf + 32 * (hq & 3); }
    if (n0 < 2176) { const int t = n0 - 2048, kh = t >> 6, hf = (t >> 5) & 1; return 512 + 128 * hf + 32 * kh; }
    if (n0 < 2304) { const int t = n0 - 2176, vh = t >> 6, hf = (t >> 5) & 1; return 512 + 128 * hf + 32 * (2 + vh); }
    return 768 + (n0 - 2304);
}
__device__ __forceinline__ void p0_row(const float* xrow, bf16* orow, float* rstd_out, int lane) {
    const GAS f32x4* xr = (const GAS f32x4*)xrow + lane;
    f32x4 v[4]; float s = 0.f;
#pragma unroll
    for (int j = 0; j < 4; ++j) { v[j] = xr[64 * j]; s += (v[j].x * v[j].x + v[j].y * v[j].y) + (v[j].z * v[j].z + v[j].w * v[j].w); }
    s = wave_sum(s);
    if (lane == 0) *rstd_out = 1.0f / sqrtf(s * (1.0f / DM) + RMS_EPS);
    GAS unsigned long long* o8 = (GAS unsigned long long*)orow + lane;
#pragma unroll
    for (int j = 0; j < 4; ++j) o8[64 * j] = (unsigned long long)pk2(v[j].x, v[j].y) | ((unsigned long long)pk2(v[j].z, v[j].w) << 32);
}
__device__ __forceinline__ void p0_row2(const float* xa, const float* xb_, bf16* oa, bf16* ob, float* ra, float* rb, int lane) {
    const GAS f32x4* pa = (const GAS f32x4*)xa + lane; const GAS f32x4* pb = (const GAS f32x4*)xb_ + lane;
    f32x4 va[4], vb[4]; float sa = 0.f, sb = 0.f;
#pragma unroll
    for (int j = 0; j < 4; ++j) { va[j] = pa[64 * j]; vb[j] = pb[64 * j]; }
#pragma unroll
    for (int j = 0; j < 4; ++j) { sa += (va[j].x * va[j].x + va[j].y * va[j].y) + (va[j].z * va[j].z + va[j].w * va[j].w); sb += (vb[j].x * vb[j].x + vb[j].y * vb[j].y) + (vb[j].z * vb[j].z + vb[j].w * vb[j].w); }
    sa = wave_sum(sa); sb = wave_sum(sb);
    if (lane == 0) { *ra = 1.0f / sqrtf(sa * (1.0f / DM) + RMS_EPS); *rb = 1.0f / sqrtf(sb * (1.0f / DM) + RMS_EPS); }
    GAS unsigned long long* o8a = (GAS unsigned long long*)oa + lane; GAS unsigned long long* o8b = (GAS unsigned long long*)ob + lane;
#pragma unroll
    for (int j = 0; j < 4; ++j) { o8a[64 * j] = (unsigned long long)pk2(va[j].x, va[j].y) | ((unsigned long long)pk2(va[j].z, va[j].w) << 32); o8b[64 * j] = (unsigned long long)pk2(vb[j].x, vb[j].y) | ((unsigned long long)pk2(vb[j].z, vb[j].w) << 32); }
}
constexpr int FW_W1 = 0, FW_W2 = 33 * 64 * 4, FW_B1 = FW_W2 + 64 * 64 * 4, FW_B2 = FW_B1 + 256, FW_FR = FW_B2 + 256, FW_END = FW_FR + 256, FT_PITCH = 144, FT_BYTES = 32 * FT_PITCH;
__device__ __forceinline__ void filter_stage_weights(LAS unsigned char* lds, const float* w1, const float* b1, const float* w2, const float* b2, const float* fr, int tid) {
    LAS float* W1 = (LAS float*)(lds + FW_W1); LAS float* W2 = (LAS float*)(lds + FW_W2);
    for (int i = tid; i < 33 * 64; i += NWAVES * 64) W1[i] = w1[i];
    for (int i = tid; i < 64 * 64; i += NWAVES * 64) W2[i] = w2[i];
    if (tid < 64) { ((LAS float*)(lds + FW_B1))[tid] = b1[tid]; ((LAS float*)(lds + FW_B2))[tid] = b2[tid]; ((LAS float*)(lds + FW_FR))[tid] = fr[tid]; }
    LDS_WAIT(); __syncthreads();
}
__device__ __forceinline__ void filter_mlp_half(LAS unsigned char* lds, int L, int chunk, int hf, int dir, int r, int h, LAS float* Hb, bf16x8 (&afr)[4]) {
    const LAS float* W1 = (const LAS float*)(lds + FW_W1); const LAS float* W2 = (const LAS float*)(lds + FW_W2);
    const LAS float* B1 = (const LAS float*)(lds + FW_B1); const LAS float* B2 = (const LAS float*)(lds + FW_B2); const LAS float* FR = (const LAS float*)(lds + FW_FR);
        int pos = 64 * chunk + 32 * hf + r + dir; if (pos > L - 1) pos = L - 1;
        const float t = (float)pos / (float)(L - 1);
        float a[32];
#pragma unroll
        for (int jj = 0; jj < 32; ++jj) a[jj] = B1[32 * h + jj];
        {
#pragma unroll
            for (int jj = 0; jj < 32; jj += 4) { const f32x4 w = *(const LAS f32x4*)(W1 + 32 * h + jj); a[jj] += t * w[0]; a[jj + 1] += t * w[1]; a[jj + 2] += t * w[2]; a[jj + 3] += t * w[3]; }
#pragma unroll 1
            for (int i = 0; i < 16; ++i) {
                const float band = 1e-4f + (float)i * ((15.0f - 1e-4f) / 15.0f); const float ang = (6.283185307179586f / (float)L) * (float)pos * band;
                const float cv = __cosf(ang), sv = -__sinf(ang);
                const LAS float* wc = W1 + (1 + i) * 64 + 32 * h; const LAS float* wsn = W1 + (17 + i) * 64 + 32 * h;
#pragma unroll
                for (int jj = 0; jj < 32; jj += 4) { const f32x4 w = *(const LAS f32x4*)(wc + jj), v = *(const LAS f32x4*)(wsn + jj);
                    a[jj] += cv * w[0] + sv * v[0]; a[jj + 1] += cv * w[1] + sv * v[1]; a[jj + 2] += cv * w[2] + sv * v[2]; a[jj + 3] += cv * w[3] + sv * v[3]; }
            }
        }
#pragma unroll
        for (int jj = 0; jj < 32; ++jj) Hb[(32 * h + jj) * 32 + r] = __sinf(FR[32 * h + jj] * a[jj]);
        LDS_WAIT(); asm volatile("" ::: "memory");
#pragma unroll
        for (int jj = 0; jj < 32; ++jj) a[jj] = B2[32 * h + jj];
#pragma unroll 1
        for (int i = 0; i < 64; ++i) { const float hv = Hb[i * 32 + r]; const LAS float* wr_ = W2 + i * 64 + 32 * h;
#pragma unroll
            for (int jj = 0; jj < 32; jj += 4) { const f32x4 w = *(const LAS f32x4*)(wr_ + jj); a[jj] += hv * w[0]; a[jj + 1] += hv * w[1]; a[jj + 2] += hv * w[2]; a[jj + 3] += hv * w[3]; } }
        LDS_WAIT(); asm volatile("" ::: "memory");
        unsigned op[16], pp[16];
#pragma unroll
        for (int d = 0; d < 16; ++d) op[d] = pk2(__sinf(FR[32 * h + 2 * d] * a[2 * d]), __sinf(FR[32 * h + 2 * d + 1] * a[2 * d + 1]));
#pragma unroll
        for (int d = 0; d < 16; ++d) pp[d] = __shfl_xor(op[d], 32);
#pragma unroll
        for (int ks = 0; ks < 4; ++ks) { v4u f;
#pragma unroll
            for (int w = 0; w < 4; ++w) { const unsigned own = h ? op[8 * (ks & 1) + 4 + w] : op[8 * (ks & 1) + w], par = h ? pp[8 * (ks & 1) + 4 + w] : pp[8 * (ks & 1) + w];
                f[w] = ((ks >> 1) == h) ? own : par; }
            afr[ks] = __builtin_bit_cast(bf16x8, f); }
}
__device__ __forceinline__ void filter_item(LAS unsigned char* lds, const bf16* w3T, bf16* krev, float* fpart, int g, int chunk, int dir, int wave, int lane_) {
    int lane = lane_; asm volatile("" : "+v"(lane));
    const int L = g ? LS : LP, r = lane & 31, h = lane >> 5;
    const LAS float* W1 = (const LAS float*)(lds + FW_W1); const LAS float* W2 = (const LAS float*)(lds + FW_W2);
    const LAS float* B1 = (const LAS float*)(lds + FW_B1); const LAS float* B2 = (const LAS float*)(lds + FW_B2); const LAS float* FR = (const LAS float*)(lds + FW_FR);
    LAS unsigned char* T = lds + FW_END + wave * FT_BYTES; LAS float* Hb = (LAS float*)(lds + FW_END + NWAVES * FT_BYTES + wave * 8192);
    bf16x8 afr0[4], afr1[4];
    filter_mlp_half(lds, L, chunk, 0, dir, r, h, Hb, afr0);
    filter_mlp_half(lds, L, chunk, 1, dir, r, h, Hb, afr1);
    const float dmin = -4.605170185988091f / 1.5f, dmax = -4.605170185988091f / 0.3f;
    const int p0 = 64 * chunk; const int mstart = g ? (dir ? (2 * L - p0 - 64) : p0) : (dir ? (L + p0) : (L - 64 - p0));
    for (int ti = 0; ti < 32; ++ti) {
        const int o_ = ti >> 4, cb = 32 * (ti & 15), colg = (2 * o_ + dir) * 512 + cb;
        bf16x8 bfr[4];
#pragma unroll
        for (int ks = 0; ks < 4; ++ks) bfr[ks] = *(const GAS bf16x8*)(w3T + (size_t)(colg + r) * 64 + 16 * ks + 8 * h);
        const float delta = fabsf(dmin + (float)(cb + r) * ((dmax - dmin) / 511.0f));
        float asum = 0.f;
#pragma unroll
        for (int hf = 0; hf < 2; ++hf) {
            f32x16 acc = (f32x16){0.f,0.f,0.f,0.f,0.f,0.f,0.f,0.f,0.f,0.f,0.f,0.f,0.f,0.f,0.f,0.f};
#pragma unroll
            for (int ks = 0; ks < 4; ++ks) acc = __builtin_amdgcn_mfma_f32_32x32x16_bf16(hf ? afr1[ks] : afr0[ks], bfr[ks], acc, 0, 0, 0);
#pragma unroll
            for (int rg = 0; rg < 16; ++rg) {
                const int i = 32 * hf + (rg & 3) + 8 * (rg >> 2) + 4 * h; const int pos = p0 + i + dir;
                const float t = (float)pos / (float)(L - 1);
                float kv = acc[rg] * (__expf(-t * delta) + 0.05f); if (pos > L - 1) kv = 0.f;
                asum += fabsf(kv);
                const int e = ((dir != 0) != (g != 0)) ? i : 63 - i;
                *(LAS bf16*)(T + r * FT_PITCH + e * 2) = (bf16)f2bf(kv);
            }
        }
        asum += __shfl_xor(asum, 32);
        if (h == 0) fpart[(size_t)chunk * 2048 + colg + r] = asum;
        LDS_WAIT(); asm volatile("" ::: "memory");
        {
            const int col = lane >> 1, hb = lane & 1;
            bf16* dst = krev + (size_t)(o_ * 512 + cb + col) * (2 * L) + mstart + 32 * hb;
            const LAS v4u* src = (const LAS v4u*)(T + col * FT_PITCH + 64 * hb);
#pragma unroll
            for (int q = 0; q < 4; ++q) *(GAS v4u*)(dst + 8 * q) = src[q];
        }
        LDS_WAIT(); asm volatile("" ::: "memory");
    }
}

namespace hy {
constexpr int SLOTB = 272, Z_BYTES = 75776, F_OFF = 75776, F_BYTES = 65536, RED_OFF = F_OFF + F_BYTES;
__device__ __forceinline__ int slot_of(int g, int n) { return g ? (n + 31) : ((n >> 4) * 32 + 16 + (n & 15)); }
__device__ __forceinline__ int crow(int r, int hi) { return (r & 3) + 8 * (r >> 2) + 4 * hi; }

struct Params { const bf16* uT; const bf16* krev_s; const bf16* krev_p; const float* fpart_s; const float* fpart_p; const float* conv_w; const float* conv_b; const float* hbias; bf16* yT; float* dF; bf16* dZ; };

__device__ __forceinline__ void conv3_chunk(const bf16* urow  , int g, int chunk, float w0, float w1, float w2, float b, float (&out)[8]) {
    const int tau0 = chunk * 8; const int L = g ? LS : LP; const int p0 = g ? tau0 : (tau0 & (LP - 1));
    const v4u raw = *(const GAS v4u*)(urow + tau0);
    float u[10];
    u[1] = pg8::bflo(raw.x); u[2] = pg8::bfhi(raw.x); u[3] = pg8::bflo(raw.y); u[4] = pg8::bfhi(raw.y); u[5] = pg8::bflo(raw.z); u[6] = pg8::bfhi(raw.z); u[7] = pg8::bflo(raw.w); u[8] = pg8::bfhi(raw.w);
    u[0] = (p0 > 0) ? bf2f(urow[tau0 - 1]) : 0.f;
    u[9] = (p0 + 8 < L) ? bf2f(urow[tau0 + 8]) : 0.f;
#pragma unroll
    for (int i = 0; i < 8; ++i) out[i] = w0 * u[i] + w1 * u[i + 1] + w2 * u[i + 2] + b;
}

struct C3 { v4u raw; float prev, next; };
__device__ __forceinline__ void conv3_load(const bf16* urow, int g, int chunk, C3& q) {
    const int tau0 = chunk * 8; const int L = g ? LS : LP; const int p0 = g ? tau0 : (tau0 & (LP - 1));
    q.raw = *(const GAS v4u*)(urow + tau0);
    q.prev = (p0 > 0) ? bf2f(urow[tau0 - 1]) : 0.f;
    q.next = (p0 + 8 < L) ? bf2f(urow[tau0 + 8]) : 0.f;
}
__device__ __forceinline__ void conv3_eval(const C3& q, float w0, float w1, float w2, float b, float (&out)[8]) {
    float u[10];
    u[0] = q.prev; u[9] = q.next;
    u[1] = pg8::bflo(q.raw.x); u[2] = pg8::bfhi(q.raw.x); u[3] = pg8::bflo(q.raw.y); u[4] = pg8::bfhi(q.raw.y); u[5] = pg8::bflo(q.raw.z); u[6] = pg8::bfhi(q.raw.z); u[7] = pg8::bflo(q.raw.w); u[8] = pg8::bfhi(q.raw.w);
#pragma unroll
    for (int i = 0; i < 8; ++i) out[i] = w0 * u[i] + w1 * u[i + 1] + w2 * u[i + 2] + b;
}

__device__ __forceinline__ bf16x8 load_afrag(LAS const unsigned char* lds, int addr, int sh) {
    const LAS unsigned* p = (const LAS unsigned*)(lds + addr);
    const unsigned w0 = p[0], w1 = p[1], w2 = p[2], w3 = p[3], w4 = p[4];
    v4u f; f.x = __builtin_amdgcn_alignbit(w1, w0, sh); f.y = __builtin_amdgcn_alignbit(w2, w1, sh); f.z = __builtin_amdgcn_alignbit(w3, w2, sh); f.w = __builtin_amdgcn_alignbit(w4, w3, sh);
    return __builtin_bit_cast(bf16x8, f);
}

__device__ __forceinline__ void hyena_item(LAS unsigned char* lds, const Params& P, int g, int c, int tid_) {
    int tid = tid_; asm volatile("" : "+v"(tid));
    const int lane = tid & 63, wave = __builtin_amdgcn_readfirstlane(tid >> 6), r = lane & 31, hi = lane >> 5, nt = wave & 3, half = wave >> 2;
    const int L = g ? LS : LP; const int T0 = g ? TP : 0;
#if PROBE >= 41 && PROBE <= 46
    unsigned long long tp_ = __builtin_amdgcn_s_memrealtime();
#define HY_SEC(k) do { const unsigned long long tn_ = __builtin_amdgcn_s_memrealtime(); if (blockIdx.x == 0 && tid == 0) ((volatile LAS unsigned*)(lds + MISC_OFF))[40 + (k)] += (unsigned)(tn_ - tp_); tp_ = tn_; } while (0)
#else
#define HY_SEC(k) do { } while (0)
#endif
    float inv_norm0, inv_norm1;
    {
        const int nchunk = g ? 256 : 32; const float* fp = P.fpart_s + (g ? (size_t)0 : (size_t)((WS_FPART_P - WS_FPART_S) / 4));
        float s0 = 0.f, s1 = 0.f;
        for (int idx = lane; idx < nchunk * 2; idx += 64) { const int ch = idx >> 1, dir = idx & 1; s0 += fp[(size_t)ch * 2048 + dir * 512 + c]; s1 += fp[(size_t)ch * 2048 + 1024 + dir * 512 + c]; }
        inv_norm0 = 1.0f / wave_sum_sw(s0); inv_norm1 = 1.0f / wave_sum_sw(s1);
        for (int i = tid; i < Z_BYTES / 16; i += NWAVES * 64) *(LAS v4u*)(lds + i * 16) = (v4u){0u, 0u, 0u, 0u};
        LDS_WAIT(); __syncthreads();
    }
    {
        const int ch = 2 * HW + c; const float w0 = P.conv_w[ch], w1 = P.conv_w[3 * HW + ch], w2 = P.conv_w[6 * HW + ch], b = P.conv_b[ch];
        const bf16* urow = P.uT + (size_t)ch * MTOK + T0;
        for (int it = 0; it < 4; ++it) { const int chunk = tid + it * 512; float o[8]; conv3_chunk(urow, g, chunk, w0, w1, w2, b, o);
            const int tau0 = chunk * 8; v4u pk; pk.x = pk2(o[0], o[1]); pk.y = pk2(o[2], o[3]); pk.z = pk2(o[4], o[5]); pk.w = pk2(o[6], o[7]);
            *(LAS v4u*)(lds + slot_of(g, tau0 >> 7) * SLOTB + (tau0 & 127) * 2) = pk; }
    }
    HY_SEC(0);
    int d_hi, d_lo;
    if (g) { if (half == 0) { d_hi = 32 * nt + 31; d_lo = 32 * nt - 48; } else { d_hi = 32 * nt - 49; d_lo = 32 * nt - 127; } }
    else   {
             const int dmax = 4 * nt + 3, dmin = 4 * nt - 15;
             if (half == 0) { d_hi = dmax; d_lo = dmax - 9; } else { d_hi = dmax - 10; d_lo = dmin; } }
    const int ncol = g ? (32 * nt + r) : (16 * (r >> 2) + 4 * nt + (r & 3));
    int abase = F_OFF + 2 * ((L - 1) - r + 8 * hi); const int sh = (abase & 2) ? 16 : 0; abase &= ~3;
    const int zb = slot_of(g, ncol) * SLOTB + 16 * hi;
    const int mi0 = 2 * half;

    for (int o = 0; o < 2; ++o) {
        {
            const bf16* ksrc = P.krev_s + (g ? (size_t)0 : (size_t)((WS_KREV_P - WS_KREV_S) / 2)) + (size_t)(o * HW + c) * (2 * L);
            const int n16 = (2 * L * 2) / 16;
            for (int i = tid; i < n16; i += NWAVES * 64) *(LAS v4u*)(lds + F_OFF + i * 16) = *(const GAS v4u*)(ksrc + i * 8);
        }
        LDS_WAIT(); __syncthreads();
        HY_SEC(1);
        f32x16 acc[4];
#pragma unroll
        for (int mi = 0; mi < 4; ++mi) acc[mi] = (f32x16){0.f,0.f,0.f,0.f,0.f,0.f,0.f,0.f,0.f,0.f,0.f,0.f,0.f,0.f,0.f,0.f};
        bf16x8 Fw[8];
        {
            const int q0 = -8 * d_hi;
#pragma unroll
            for (int s = 2; s < 8; ++s) Fw[s] = load_afrag(lds, abase + 32 * (q0 - 8 + s), sh);
            Fw[0] = Fw[2]; Fw[1] = Fw[3];
        }
        {
            unsigned ap = (unsigned)(uintptr_t)(lds + abase) + 32 * (-8 * d_hi), bp = (unsigned)(uintptr_t)(lds + zb) - d_hi * SLOTB;
            v2u n01, n23; unsigned n4; v4u zn;
            unsigned r0, r1, r2, r3, r4; v4u zf;
#define HY_LOADS(ADW, BOFF) asm volatile("ds_read2_b32 %0, %4 offset0:%c5 offset1:%c6\n\tds_read2_b32 %1, %4 offset0:%c7 offset1:%c8\n\tds_read_b32 %2, %4 offset:%c9\n\tds_read_b128 %3, %10 offset:%c11" \
                : "=&v"(n01), "=&v"(n23), "=&v"(n4), "=&v"(zn) : "v"(ap), "i"(ADW), "i"((ADW) + 1), "i"((ADW) + 2), "i"((ADW) + 3), "i"(((ADW) + 4) * 4), "v"(bp), "i"(BOFF))
#define HY_WAIT() do { asm volatile("s_waitcnt lgkmcnt(0)" : "+v"(n01), "+v"(n23), "+v"(n4), "+v"(zn), "+v"(acc[0]), "+v"(acc[1]), "+v"(acc[2]), "+v"(acc[3])); __builtin_amdgcn_sched_barrier(0); } while (0)
#define HY_TAKE() do { r0 = n01.x; r1 = n01.y; r2 = n23.x; r3 = n23.y; r4 = n4; zf = zn; } while (0)
#define HY_STEP(JK, ADW, BOFF) do { HY_LOADS(ADW, BOFF); __builtin_amdgcn_sched_barrier(0); \
                { v4u f; f.x = __builtin_amdgcn_alignbit(r1, r0, sh); f.y = __builtin_amdgcn_alignbit(r2, r1, sh); f.z = __builtin_amdgcn_alignbit(r3, r2, sh); f.w = __builtin_amdgcn_alignbit(r4, r3, sh); Fw[JK] = __builtin_bit_cast(bf16x8, f); } \
                { const bf16x8 zb_ = __builtin_bit_cast(bf16x8, zf); \
                  acc[0] = __builtin_amdgcn_mfma_f32_32x32x16_bf16(Fw[(JK) & 7], zb_, acc[0], 0, 0, 0); acc[1] = __builtin_amdgcn_mfma_f32_32x32x16_bf16(Fw[((JK) - 2) & 7], zb_, acc[1], 0, 0, 0); \
                  acc[2] = __builtin_amdgcn_mfma_f32_32x32x16_bf16(Fw[((JK) - 4) & 7], zb_, acc[2], 0, 0, 0); acc[3] = __builtin_amdgcn_mfma_f32_32x32x16_bf16(Fw[((JK) - 6) & 7], zb_, acc[3], 0, 0, 0); } \
                HY_WAIT(); HY_TAKE(); } while (0)
            HY_LOADS(0, 0); HY_WAIT(); HY_TAKE();
            for (int d = d_hi; d >= d_lo; --d) {
                HY_STEP(0, 8, 32); HY_STEP(1, 16, 64); HY_STEP(2, 24, 96); HY_STEP(3, 32, 128); HY_STEP(4, 40, 160); HY_STEP(5, 48, 192); HY_STEP(6, 56, 224); HY_STEP(7, 64, SLOTB);
                ap += 256; bp += SLOTB;
            }
#undef HY_LOADS
#undef HY_WAIT
#undef HY_TAKE
#undef HY_STEP
        }
        LDS_WAIT(); __syncthreads();
        HY_SEC(2);
        {
            LAS float* X = (LAS float*)(lds + F_OFF) + wave * 2048;
#pragma unroll
            for (int t = 0; t < 2; ++t)
#pragma unroll
                for (int rg = 0; rg < 16; ++rg) X[(t * 16 + rg) * 64 + lane] = (half == 0) ? acc[2 + t][rg] : acc[t][rg];
        }
        LDS_WAIT(); __syncthreads();
        f32x16 fin[2];
        {
            const LAS float* X = (const LAS float*)(lds + F_OFF) + (wave ^ 4) * 2048;
#pragma unroll
            for (int t = 0; t < 2; ++t)
#pragma unroll
                for (int rg = 0; rg < 16; ++rg) fin[t][rg] = ((half == 0) ? acc[t][rg] : acc[2 + t][rg]) + X[(t * 16 + rg) * 64 + lane];
        }
        LDS_WAIT(); __syncthreads();
        HY_SEC(3);
        {
            const int ch = o * HW + c; const float w0 = P.conv_w[ch], w1 = P.conv_w[3 * HW + ch], w2 = P.conv_w[6 * HW + ch], b = P.conv_b[ch];
            const bf16* urow = P.uT + (size_t)ch * MTOK + T0;
            for (int it = 0; it < 4; ++it) { const int chunk = tid + it * 512; float v[8]; conv3_chunk(urow, g, chunk, w0, w1, w2, b, v);
                LAS f32x4* dst = (LAS f32x4*)(lds + F_OFF + chunk * 32 + (chunk >> 4) * 16); dst[0] = (f32x4){v[0], v[1], v[2], v[3]}; dst[1] = (f32x4){v[4], v[5], v[6], v[7]}; }
        }
        LDS_WAIT(); __syncthreads();
        HY_SEC(4);
        {
            const float sb = P.hbias[o * HW + c], inr = o ? inv_norm1 : inv_norm0;
            const LAS float* G = (const LAS float*)(lds + F_OFF);
            const int n = ncol; LAS bf16* zs = (LAS bf16*)(lds + slot_of(g, n) * SLOTB);
#pragma unroll
            for (int t = 0; t < 2; ++t)
#pragma unroll
                for (int rg = 0; rg < 16; ++rg) { const int i = 32 * (mi0 + t) + crow(rg, hi);
                    const float zo = bf2f(zs[i]);
#if PROBE >= 100
                    if (c == 137) { P.dF[(g * 2 + o) * 16384 + 128 * n + i] = fin[t][rg]; P.dZ[(g * 2 + o) * 16384 + 128 * n + i] = zs[i]; }
#endif
                    const float val = G[132 * n + i] * (inr * fin[t][rg] + sb * zo); zs[i] = (bf16)f2bf(val); }
        }
        LDS_WAIT(); __syncthreads();
    }
    HY_SEC(5);
    {
        bf16* yrow = P.yT + (size_t)c * MTOK + T0;
        for (int it = 0; it < 4; ++it) { const int chunk = tid + it * 512, tau0 = chunk * 8;
            *(GAS v4u*)(yrow + tau0) = *(const LAS v4u*)(lds + slot_of(g, tau0 >> 7) * SLOTB + (tau0 & 127) * 2); }
    }
    LDS_WAIT(); __syncthreads();
}
}

namespace fc {
constexpr int OST = 1032, PLANE_B = 32 * OST * 2  , RE_OFF = 0, IM_OFF = PLANE_B, RED_OFF = 2 * PLANE_B, T3_OFF = RED_OFF + 64;
constexpr int NFFT = 32768;
enum { F1 = 0, F2 = 1, F3 = 2, I1 = 3, I2 = 4, I3 = 5 };
__device__ __forceinline__ int crow(int r, int hi) { return (r & 3) + 8 * (r >> 2) + 4 * hi; }
__device__ __forceinline__ int sw(int mid) { return 0; }
struct Params { const bf16* uT; const bf16* kc; const float* fpart_s; const float* conv_w; const float* conv_b; const float* hbias; bf16* yT; bf16* hs; bf16* z1s; float* dF; bf16* dZ; };
typedef float f32x2_ __attribute__((ext_vector_type(2)));
struct FMat { bf16x8 fr[2], fi[2], nfi[2]; };

__device__ __forceinline__ void make_fmat(FMat& M, int r, int h) {
#pragma unroll
    for (int ks = 0; ks < 2; ++ks) { v4u a, b, c;
#pragma unroll
        for (int w = 0; w < 4; ++w) { float cv[2], sv[2];
#pragma unroll
            for (int e = 0; e < 2; ++e) { const int aidx = 16 * ks + 8 * h + 2 * w + e; const float fr_ = (float)((aidx * r) & 31) * (1.0f / 32.0f); cv[e] = __builtin_amdgcn_cosf(fr_); sv[e] = __builtin_amdgcn_sinf(fr_); }
            a[w] = pk2(cv[0], cv[1]); b[w] = pk2(-sv[0], -sv[1]); c[w] = pk2(sv[0], sv[1]); }
        M.fr[ks] = __builtin_bit_cast(bf16x8, a); M.fi[ks] = __builtin_bit_cast(bf16x8, b); M.nfi[ks] = __builtin_bit_cast(bf16x8, c); }
}

template <int ST, bool REAL_IN, bool HALF_K>
__device__ __forceinline__ void stage(LAS unsigned char* lds, const FMat& M, int wave, int r_, int h_) {
    int r = r_, h = h_; asm volatile("" : "+v"(r), "+v"(h));
    float t2c[16], t2s[16];
    if (ST == F1 || ST == F2 || ST == I1 || ST == I2) {
#pragma unroll
        for (int rg = 0; rg < 16; ++rg) { const int rho = (rg & 3) + 8 * (rg >> 2) + 4 * h; const float fr_ = (float)(r * rho) * (1.0f / 1024.0f); t2c[rg] = __builtin_amdgcn_cosf(fr_); t2s[rg] = __builtin_amdgcn_sinf(fr_); }
    }
    constexpr bool INV = (ST >= I1);
    const f32x16 zero16 = (f32x16){0.f,0.f,0.f,0.f,0.f,0.f,0.f,0.f,0.f,0.f,0.f,0.f,0.f,0.f,0.f,0.f};
    unsigned res[4][16];
#pragma unroll
    for (int t = 0; t < 4; ++t) {
        const int f = 4 * wave + t;
        const int base = (ST == I2) ? (32 * f + OST * r) : (32 * r + OST * f); const int swr = (ST == I2) ? sw(f) : sw(r);
        f32x16 ur = zero16, ui = zero16;
#pragma unroll
        for (int ks = 0; ks < (HALF_K ? 1 : 2); ++ks) {
            const bf16x8 xr = *(const LAS bf16x8*)(lds + RE_OFF + 2 * (base + ((16 * ks + 8 * h) ^ swr)));
            if (!INV) {
                ur = __builtin_amdgcn_mfma_f32_32x32x16_bf16(M.fr[ks], xr, ur, 0, 0, 0);
                ui = __builtin_amdgcn_mfma_f32_32x32x16_bf16(M.fi[ks], xr, ui, 0, 0, 0);
                if (!REAL_IN) { const bf16x8 xi = *(const LAS bf16x8*)(lds + IM_OFF + 2 * (base + ((16 * ks + 8 * h) ^ swr)));
                    ur = __builtin_amdgcn_mfma_f32_32x32x16_bf16(M.nfi[ks], xi, ur, 0, 0, 0);
                    ui = __builtin_amdgcn_mfma_f32_32x32x16_bf16(M.fr[ks], xi, ui, 0, 0, 0); }
            } else {
                const bf16x8 xi = *(const LAS bf16x8*)(lds + IM_OFF + 2 * (base + ((16 * ks + 8 * h) ^ swr)));
                ur = __builtin_amdgcn_mfma_f32_32x32x16_bf16(M.fr[ks], xr, ur, 0, 0, 0);
                ur = __builtin_amdgcn_mfma_f32_32x32x16_bf16(M.fi[ks], xi, ur, 0, 0, 0);
                if (ST != I3) { ui = __builtin_amdgcn_mfma_f32_32x32x16_bf16(M.fr[ks], xi, ui, 0, 0, 0);
                                ui = __builtin_amdgcn_mfma_f32_32x32x16_bf16(M.nfi[ks], xr, ui, 0, 0, 0); }
            }
        }
        if (ST == I3) {
#pragma unroll
            for (int rg = 0; rg < 8; ++rg) res[t][rg] = __float_as_uint(ur[rg]);
        } else {
            if (ST == F1 || ST == F2 || ST == I1 || ST == I2) {
                float uc = 1.f, us = 0.f;
                if (ST == I2) { const float fr_ = (float)(f * r) * (1.0f / 32768.0f); uc = __builtin_amdgcn_cosf(fr_); us = __builtin_amdgcn_sinf(fr_); }
#pragma unroll
                for (int rg = 0; rg < 16; ++rg) {
                    float c = t2c[rg], s_ = t2s[rg];
                    if (ST == F1) { const int rho = (rg & 3) + 8 * (rg >> 2) + 4 * h; const f32x2_ q = *(const LAS f32x2_*)(lds + T3_OFF + 8 * (32 * f + rho)); const float c2 = c * q.x - s_ * q.y; s_ = c * q.y + s_ * q.x; c = c2; }
                    if (ST == I2) { const float c2 = c * uc - s_ * us; s_ = c * us + s_ * uc; c = c2; }
                    const float s = INV ? s_ : -s_;
                    const float a = ur[rg], b = ui[rg];
                    ur[rg] = a * c - b * s; ui[rg] = a * s + b * c;
                }
            }
#pragma unroll
            for (int p = 0; p < 8; ++p) { res[t][p] = pk2(ur[2 * p], ur[2 * p + 1]); res[t][8 + p] = pk2(ui[2 * p], ui[2 * p + 1]); }
        }
        __builtin_amdgcn_sched_barrier(0);
    }
    LDS_WAIT(); __syncthreads();
#pragma unroll
    for (int t = 0; t < 4; ++t) {
        const int f = 4 * wave + t;
        if (ST == I3) {
            LAS float* Y = (LAS float*)(lds + IM_OFF);
#pragma unroll
            for (int rg = 0; rg < 8; ++rg) { const int rho = (rg & 3) + 8 * (rg >> 2) + 4 * h; Y[516 * f + 32 * rho + r] = __uint_as_float(res[t][rg]); }
        } else if (ST == F3) {
#pragma unroll
            for (int g4 = 0; g4 < 4; ++g4) { const int pos = ((8 * g4 + 4 * h) ^ sw(r)) + 32 * r + OST * f;
                *(LAS v2u*)(lds + RE_OFF + 2 * pos) = (v2u){res[t][2 * g4], res[t][2 * g4 + 1]}; *(LAS v2u*)(lds + IM_OFF + 2 * pos) = (v2u){res[t][8 + 2 * g4], res[t][8 + 2 * g4 + 1]}; }
        } else {
            const int odd = r & 1; const unsigned sel = odd ? 0x03020706u : 0x05040100u;
            const int rs_ = (ST == F1) ? OST : 32;
            const int lb = ((r & ~1) + odd * rs_ + ((ST == F1) ? 32 * f : OST * f) + rs_ * 4 * h) * 2;
#pragma unroll
            for (int p = 0; p < 8; ++p) {
                const int rho0 = ((2 * p) & 3) + 8 * ((2 * p) >> 2);
                const unsigned wr_ = res[t][p], wi_ = res[t][8 + p];
                const unsigned vr_ = (unsigned)__builtin_amdgcn_mov_dpp((int)wr_, 0xB1, 0xF, 0xF, true), vi_ = (unsigned)__builtin_amdgcn_mov_dpp((int)wi_, 0xB1, 0xF, 0xF, true);
                *(LAS unsigned*)(lds + RE_OFF + lb + 2 * rs_ * rho0) = __builtin_amdgcn_perm(vr_, wr_, sel);
                *(LAS unsigned*)(lds + IM_OFF + lb + 2 * rs_ * rho0) = __builtin_amdgcn_perm(vi_, wi_, sel);
            }
        }
    }
    LDS_WAIT(); __syncthreads();
}

__device__ __forceinline__ void self_visible(int tid) {
    VM_WAIT(); __syncthreads();
    if (tid == 0) { __builtin_amdgcn_fence(__ATOMIC_ACQUIRE, "agent"); VM_WAIT(); }
    __syncthreads();
}

__device__ __forceinline__ void item(LAS unsigned char* lds, const Params& P, int c, int tid_, int slot) {
    int tid = tid_; asm volatile("" : "+v"(tid));
    const int wave = __builtin_amdgcn_readfirstlane(tid >> 6);
    constexpr int L = LS, T0 = TP, g = 1;
    bf16* hs = P.hs + (size_t)slot * (2 * PLANE_B / 2); bf16* z1s = P.z1s + (size_t)slot * L;
    float inv_norm0, inv_norm1;
    {
        const int lane = tid & 63; float s0 = 0.f, s1 = 0.f;
        for (int idx = lane; idx < 512; idx += 64) { const int ch = idx >> 1, dir = idx & 1; s0 += P.fpart_s[(size_t)ch * 2048 + dir * 512 + c]; s1 += P.fpart_s[(size_t)ch * 2048 + 1024 + dir * 512 + c]; }
        inv_norm0 = 1.0f / wave_sum_sw(s0); inv_norm1 = 1.0f / wave_sum_sw(s1);
    }
    FMat M; { const int r = tid & 31, h = (tid >> 5) & 1; make_fmat(M, r, h); }
    for (int i = tid; i < 1024; i += NWAVES * 64) { const float fr_ = (float)((i >> 5) * (i & 31)) * (1.0f / 32768.0f); *(LAS f32x2_*)(lds + T3_OFF + 8 * i) = (f32x2_){__builtin_amdgcn_cosf(fr_), __builtin_amdgcn_sinf(fr_)}; }
    LDS_WAIT(); __syncthreads();
#if PROBE >= 31 && PROBE <= 35
    unsigned long long tp_ = __builtin_amdgcn_s_memrealtime();
#define FC_SEC(k) do { const unsigned long long tn_ = __builtin_amdgcn_s_memrealtime(); if (blockIdx.x == 0 && tid == 0) ((volatile LAS unsigned*)(lds + MISC_OFF))[40 + (k)] += (unsigned)(tn_ - tp_); tp_ = tn_; } while (0)
#else
#define FC_SEC(k) do { } while (0)
#endif
    for (int o = 0; o < 2; ++o) {
        asm volatile("" : "+v"(tid));
        const int lane = tid & 63, r = lane & 31, h = lane >> 5;
        FC_SEC(5);
        {
            const bf16* ksrc = P.kc + (size_t)(o * HW + c) * NFFT;
            v4u raw[8];
#pragma unroll
            for (int i = 0; i < 8; ++i) { const int it = 8 * wave + i, n = 1024 * (lane & 31) + 32 * (2 * (it >> 2) + (lane >> 5)) + 8 * (it & 3); raw[i] = *(const GAS v4u*)(ksrc + n); }
#pragma unroll
            for (int i = 0; i < 8; ++i) { const int it = 8 * wave + i, n = 1024 * (lane & 31) + 32 * (2 * (it >> 2) + (lane >> 5)) + 8 * (it & 3);
                const int pos0 = ((n >> 10) ^ sw((n >> 5) & 31)) + 32 * ((n >> 5) & 31) + OST * (n & 31); LAS bf16* d = (LAS bf16*)(lds + RE_OFF) + pos0;
                d[0 * OST] = (bf16)(raw[i].x & 0xffffu); d[1 * OST] = (bf16)(raw[i].x >> 16); d[2 * OST] = (bf16)(raw[i].y & 0xffffu); d[3 * OST] = (bf16)(raw[i].y >> 16);
                d[4 * OST] = (bf16)(raw[i].z & 0xffffu); d[5 * OST] = (bf16)(raw[i].z >> 16); d[6 * OST] = (bf16)(raw[i].w & 0xffffu); d[7 * OST] = (bf16)(raw[i].w >> 16); }
        }
        LDS_WAIT(); __syncthreads();
        stage<F1, true, false>(lds, M, wave, r, h); stage<F2, false, false>(lds, M, wave, r, h); stage<F3, false, false>(lds, M, wave, r, h);
        for (int i = tid; i < 2 * PLANE_B / 16; i += NWAVES * 64) *(GAS v4u*)((unsigned char*)hs + (size_t)i * 16) = *(const LAS v4u*)(lds + i * 16);
        self_visible(tid);
        FC_SEC(0);
        {
            const int ch = 2 * HW + c; const float w0 = P.conv_w[ch], w1 = P.conv_w[3 * HW + ch], w2 = P.conv_w[6 * HW + ch], b = P.conv_b[ch];
            const bf16* urow = P.uT + (size_t)ch * MTOK + T0;
            hy::C3 q3[4]; v4u rz[4];
#pragma unroll
            for (int i = 0; i < 4; ++i) { const int it = 4 * wave + i, n = 1024 * (lane & 15) + 32 * (4 * (it >> 2) + (lane >> 4)) + 8 * (it & 3);
                if (o == 0) hy::conv3_load(urow, g, n >> 3, q3[i]); else rz[i] = *(const GAS v4u*)(z1s + n); }
#pragma unroll
            for (int i = 0; i < 4; ++i) { const int it = 4 * wave + i, n = 1024 * (lane & 15) + 32 * (4 * (it >> 2) + (lane >> 4)) + 8 * (it & 3); unsigned e[4];
                if (o == 0) { float v[8]; hy::conv3_eval(q3[i], w0, w1, w2, b, v); e[0] = pk2(v[0], v[1]); e[1] = pk2(v[2], v[3]); e[2] = pk2(v[4], v[5]); e[3] = pk2(v[6], v[7]); }
                else { e[0] = rz[i].x; e[1] = rz[i].y; e[2] = rz[i].z; e[3] = rz[i].w; }
                const int pos0 = ((n >> 10) ^ sw((n >> 5) & 31)) + 32 * ((n >> 5) & 31) + OST * (n & 31); LAS bf16* d = (LAS bf16*)(lds + RE_OFF) + pos0;
#pragma unroll
                for (int j = 0; j < 4; ++j) { d[(2 * j) * OST] = (bf16)(e[j] & 0xffffu); d[(2 * j + 1) * OST] = (bf16)(e[j] >> 16); } }
        }
        LDS_WAIT(); __syncthreads();
        stage<F1, true, true>(lds, M, wave, r, h); stage<F2, false, false>(lds, M, wave, r, h); stage<F3, false, false>(lds, M, wave, r, h);
        FC_SEC(1);
        {
            constexpr int NCH = PLANE_B / 16, NIT = (NCH + NWAVES * 64 - 1) / (NWAVES * 64);
#pragma unroll 1
            for (int kb = 0; kb < NIT; kb += 3) {
                v4u hr[3], hi_[3];
#pragma unroll
                for (int k = 0; k < 3; ++k) { const int i = tid + (kb + k) * NWAVES * 64; if (i < NCH) { hr[k] = *(const GAS v4u*)((const unsigned char*)hs + (size_t)i * 16); hi_[k] = *(const GAS v4u*)((const unsigned char*)hs + PLANE_B + (size_t)i * 16); } }
#pragma unroll
                for (int k = 0; k < 3; ++k) { const int i = tid + (kb + k) * NWAVES * 64; if (i < NCH) {
                    const v4u xr = *(const LAS v4u*)(lds + RE_OFF + i * 16), xi = *(const LAS v4u*)(lds + IM_OFF + i * 16);
                    v4u vr, vi;
#pragma unroll
                    for (int w = 0; w < 4; ++w) {
                        const float a0 = pg8::bflo(xr[w]), a1 = pg8::bfhi(xr[w]), b0 = pg8::bflo(xi[w]), b1 = pg8::bfhi(xi[w]);
                        const float c0 = pg8::bflo(hr[k][w]) * (1.0f / 32768.0f), c1 = pg8::bfhi(hr[k][w]) * (1.0f / 32768.0f), d0 = pg8::bflo(hi_[k][w]) * (1.0f / 32768.0f), d1 = pg8::bfhi(hi_[k][w]) * (1.0f / 32768.0f);
                        vr[w] = pk2(a0 * c0 - b0 * d0, a1 * c1 - b1 * d1); vi[w] = pk2(a0 * d0 + b0 * c0, a1 * d1 + b1 * c1);
                    }
                    *(LAS v4u*)(lds + RE_OFF + i * 16) = vr; *(LAS v4u*)(lds + IM_OFF + i * 16) = vi; } }
            }
        }
        LDS_WAIT(); __syncthreads();
        FC_SEC(2);
        stage<I1, false, false>(lds, M, wave, r, h); stage<I2, false, false>(lds, M, wave, r, h); stage<I3, false, false>(lds, M, wave, r, h);
        FC_SEC(3);
        {
            const LAS float* Y = (const LAS float*)(lds + IM_OFF);
            const int chg = o * HW + c; const float g0 = P.conv_w[chg], g1 = P.conv_w[3 * HW + chg], g2 = P.conv_w[6 * HW + chg], gb = P.conv_b[chg];
            const int chv = 2 * HW + c; const float v0 = P.conv_w[chv], v1 = P.conv_w[3 * HW + chv], v2 = P.conv_w[6 * HW + chv], vb = P.conv_b[chv];
            const bf16* grow = P.uT + (size_t)chg * MTOK + T0; const bf16* vrow = P.uT + (size_t)chv * MTOK + T0;
            const float sb = P.hbias[o * HW + c], inr = o ? inv_norm1 : inv_norm0;
            bf16* dst = o ? (P.yT + (size_t)c * MTOK + T0) : z1s;
#pragma unroll 1
            for (int ib = 0; ib < 4; ib += 2) {
            hy::C3 qg[2], qv[2]; v4u rz[2];
#pragma unroll
            for (int it = 0; it < 2; ++it) { const int chunk = tid + (ib + it) * 512; hy::conv3_load(grow, g, chunk, qg[it]); if (o == 0) hy::conv3_load(vrow, g, chunk, qv[it]); else rz[it] = *(const GAS v4u*)(z1s + chunk * 8); }
#pragma unroll
            for (int it = 0; it < 2; ++it) { const int chunk = tid + (ib + it) * 512, n = chunk * 8; float gt[8], zo[8];
                hy::conv3_eval(qg[it], g0, g1, g2, gb, gt);
                if (o == 0) { hy::conv3_eval(qv[it], v0, v1, v2, vb, zo);
#pragma unroll
                    for (int j = 0; j < 8; ++j) zo[j] = bf2f((unsigned short)f2bf(zo[j])); }
                else { const v4u raw = rz[it]; zo[0] = pg8::bflo(raw.x); zo[1] = pg8::bfhi(raw.x); zo[2] = pg8::bflo(raw.y); zo[3] = pg8::bfhi(raw.y); zo[4] = pg8::bflo(raw.z); zo[5] = pg8::bfhi(raw.z); zo[6] = pg8::bflo(raw.w); zo[7] = pg8::bfhi(raw.w); }
                const LAS float* yp = Y + 516 * (n & 31) + (n >> 5); const f32x4 y0 = (f32x4){yp[0], yp[516], yp[2 * 516], yp[3 * 516]}, y1 = (f32x4){yp[4 * 516], yp[5 * 516], yp[6 * 516], yp[7 * 516]};
                float val[8];
#pragma unroll
                for (int j = 0; j < 8; ++j) { const float yv = (j < 4) ? y0[j & 3] : y1[j & 3];
#if PROBE >= 100
                    if (c == 137) { P.dF[(2 + o) * 16384 + n + j] = yv; P.dZ[(2 + o) * 16384 + n + j] = (bf16)f2bf(zo[j]); }
#endif
                    val[j] = gt[j] * (inr * yv + sb * zo[j]); }
                v4u pk; pk.x = pk2(val[0], val[1]); pk.y = pk2(val[2], val[3]); pk.z = pk2(val[4], val[5]); pk.w = pk2(val[6], val[7]);
                *(GAS v4u*)(dst + n) = pk; }
            }
        }
        self_visible(tid);
        FC_SEC(4);
    }
#undef FC_SEC
}
}

namespace at {
constexpr int KROW = 144, VROW = 776, K_OFF = 0, V_OFF = 384 * KROW  , END_OFF = V_OFF + 64 * VROW;
__device__ __forceinline__ int crow(int r, int hi) { return (r & 3) + 8 * (r >> 2) + 4 * hi; }
struct Params { const bf16* q; const bf16* k; const bf16* v; const float* sink; bf16* yat; };

__device__ __forceinline__ void attn_item(LAS unsigned char* lds, const Params& P, int blk, int gk, int tid_) {
    int tid = tid_; asm volatile("" : "+v"(tid));
    const int lane = tid & 63, wave = __builtin_amdgcn_readfirstlane(tid >> 6), r = lane & 31, hi = lane >> 5;
    const int m0 = blk * 128; const int s_lo = (blk < 128) ? (m0 & ~(LP - 1)) : TP, s_hi = (blk < 128) ? s_lo + LP : MTOK; const int kw0 = m0 - 128;
    {
        v4u kv[6], vv[6];
#pragma unroll
        for (int it = 0; it < 6; ++it) {
            const int idx = tid + it * 512, chn = idx / 384, key = idx - chn * 384, tok = kw0 + key; const bool ok = (tok >= s_lo) && (tok < s_hi);
            kv[it] = (v4u){0u, 0u, 0u, 0u}; vv[it] = (v4u){0u, 0u, 0u, 0u};
            if (ok) { kv[it] = *(const GAS v4u*)(P.k + (size_t)tok * 128 + gk * 64 + chn * 8); vv[it] = *(const GAS v4u*)(P.v + (size_t)tok * 128 + gk * 64 + chn * 8); }
        }
#pragma unroll
        for (int it = 0; it < 6; ++it) {
            const int idx = tid + it * 512, chn = idx / 384, key = idx - chn * 384;
            *(LAS v4u*)(lds + K_OFF + key * KROW + chn * 16) = kv[it];
            LAS bf16* vt = (LAS bf16*)(lds + V_OFF + (chn * 8) * VROW + key * 2);
            vt[0 * (VROW / 2)] = (bf16)(vv[it].x & 0xffffu); vt[1 * (VROW / 2)] = (bf16)(vv[it].x >> 16); vt[2 * (VROW / 2)] = (bf16)(vv[it].y & 0xffffu); vt[3 * (VROW / 2)] = (bf16)(vv[it].y >> 16);
            vt[4 * (VROW / 2)] = (bf16)(vv[it].z & 0xffffu); vt[5 * (VROW / 2)] = (bf16)(vv[it].z >> 16); vt[6 * (VROW / 2)] = (bf16)(vv[it].w & 0xffffu); vt[7 * (VROW / 2)] = (bf16)(vv[it].w >> 16);
        }
    }
    LDS_WAIT(); __syncthreads();
    const int hq = 4 * gk + (wave & 3), qh = wave >> 2;
    const int klo = (s_lo - kw0) > 0 ? (s_lo - kw0) : 0, khi = (s_hi - kw0) < 384 ? (s_hi - kw0) : 384;
    const float sinkl = P.sink[hq] * 1.4426950408889634f;
    for (int qq = 0; qq < 2; ++qq) {
        const int qt = 2 * qh + qq, q0 = 32 * qt; const size_t qrow = (size_t)(m0 + q0 + r);
        bf16x8 qf[4];
#pragma unroll
        for (int ks = 0; ks < 4; ++ks) qf[ks] = *(const GAS bf16x8*)(P.q + qrow * 512 + hq * 64 + 16 * ks + 8 * hi);
        float m_run = sinkl, l_run = (hi == 0) ? 1.0f : 0.0f;
        f32x16 o0 = (f32x16){0.f,0.f,0.f,0.f,0.f,0.f,0.f,0.f,0.f,0.f,0.f,0.f,0.f,0.f,0.f,0.f}, o1 = o0;
        const int lo_r = (q0 + r) > klo ? (q0 + r) : klo, hi_r = (q0 + r + 256) < (khi - 1) ? (q0 + r + 256) : (khi - 1);
        for (int kt = qt; kt <= qt + 8; ++kt) {
            const int kb = 32 * kt;
            f32x16 s = (f32x16){0.f,0.f,0.f,0.f,0.f,0.f,0.f,0.f,0.f,0.f,0.f,0.f,0.f,0.f,0.f,0.f};
#pragma unroll
            for (int ks = 0; ks < 4; ++ks) { const bf16x8 kf = *(const LAS bf16x8*)(lds + K_OFF + (kb + r) * KROW + 32 * ks + 16 * hi);
                s = __builtin_amdgcn_mfma_f32_32x32x16_bf16(kf, qf[ks], s, 0, 0, 0); }
            float tmax = -1e30f;
            const bool need_mask = (kt == qt) || (kt == qt + 8) || (kb < klo) || (kb + 31 >= khi);
            if (need_mask) {
#pragma unroll
                for (int rg = 0; rg < 16; ++rg) { const int kj = kb + crow(rg, hi); const float sv = (kj >= lo_r && kj <= hi_r) ? s[rg] : -1e30f; s[rg] = sv; tmax = fmaxf(tmax, sv); }
            } else {
#pragma unroll
                for (int rg = 0; rg < 16; ++rg) tmax = fmaxf(tmax, s[rg]);
            }
            tmax = fmaxf(tmax, __shfl_xor(tmax, 32));
            const float mnew = fmaxf(m_run, tmax); const float alpha = __builtin_amdgcn_exp2f(m_run - mnew);
            const bool moved = __any(mnew != m_run); m_run = mnew;
            float psum = 0.f;
#pragma unroll
            for (int rg = 0; rg < 16; ++rg) { const float p = __builtin_amdgcn_exp2f(s[rg] - mnew); s[rg] = p; psum += p; }
            l_run = l_run * alpha + psum;
            if (moved) {
#pragma unroll
                for (int rg = 0; rg < 16; ++rg) { o0[rg] *= alpha; o1[rg] *= alpha; }
            }
            v4u pa, pb;
            pa.x = pk2(s[0], s[1]); pa.y = pk2(s[2], s[3]); pa.z = pk2(s[4], s[5]); pa.w = pk2(s[6], s[7]);
            pb.x = pk2(s[8], s[9]); pb.y = pk2(s[10], s[11]); pb.z = pk2(s[12], s[13]); pb.w = pk2(s[14], s[15]);
            const bf16x8 pf0 = __builtin_bit_cast(bf16x8, pa), pf1 = __builtin_bit_cast(bf16x8, pb);
#pragma unroll
            for (int dt = 0; dt < 2; ++dt) {
                const LAS unsigned char* vb = lds + V_OFF + (32 * dt + r) * VROW + (kb + 4 * hi) * 2;
                v4u va, vc;
                { const v2u x0 = *(const LAS v2u*)(vb), x1 = *(const LAS v2u*)(vb + 16); va = (v4u){x0.x, x0.y, x1.x, x1.y}; }
                { const v2u x0 = *(const LAS v2u*)(vb + 32), x1 = *(const LAS v2u*)(vb + 48); vc = (v4u){x0.x, x0.y, x1.x, x1.y}; }
                if (dt == 0) { o0 = __builtin_amdgcn_mfma_f32_32x32x16_bf16(__builtin_bit_cast(bf16x8, va), pf0, o0, 0, 0, 0); o0 = __builtin_amdgcn_mfma_f32_32x32x16_bf16(__builtin_bit_cast(bf16x8, vc), pf1, o0, 0, 0, 0); }
                else         { o1 = __builtin_amdgcn_mfma_f32_32x32x16_bf16(__builtin_bit_cast(bf16x8, va), pf0, o1, 0, 0, 0); o1 = __builtin_amdgcn_mfma_f32_32x32x16_bf16(__builtin_bit_cast(bf16x8, vc), pf1, o1, 0, 0, 0); }
            }
        }
        l_run += __shfl_xor(l_run, 32);
        const float inv = 1.0f / l_run;
        bf16* yrow = P.yat + qrow * 512 + hq * 64;
#pragma unroll
        for (int g4 = 0; g4 < 4; ++g4) {
            v2u w0, w1;
            w0.x = pk2(o0[4 * g4] * inv, o0[4 * g4 + 1] * inv); w0.y = pk2(o0[4 * g4 + 2] * inv, o0[4 * g4 + 3] * inv);
            w1.x = pk2(o1[4 * g4] * inv, o1[4 * g4 + 1] * inv); w1.y = pk2(o1[4 * g4 + 2] * inv, o1[4 * g4 + 3] * inv);
            *(GAS v2u*)(yrow + 8 * g4 + 4 * hi) = w0; *(GAS v2u*)(yrow + 32 + 8 * g4 + 4 * hi) = w1;
        }
    }
    LDS_WAIT(); __syncthreads();
}
}

__device__ __forceinline__ void transpose_y_tiles8(LAS unsigned char* lds, const bf16* yT, bf16* yhy, int tile0, int tstride, int ntiles, int tid_) {
    int tid = tid_; asm volatile("" : "+v"(tid));
    v4u ld[8];
#pragma unroll
    for (int q = 0; q < 8; ++q) { const int tile = tile0 + q * tstride; if (tile < ntiles) { const int c0 = (tile & 7) * 64, t0 = (tile >> 3) * 64, ch = tid >> 3, k8 = tid & 7;
        ld[q] = *(const GAS v4u*)(yT + (size_t)(c0 + ch) * MTOK + t0 + k8 * 8); } }
#pragma unroll
    for (int q = 0; q < 8; ++q) { const int tile = tile0 + q * tstride; if (tile < ntiles) { const int ch = tid >> 3, k8 = tid & 7;
        *(LAS v4u*)((LAS bf16*)(lds + q * 9216) + ch * 72 + ((k8 ^ (ch >> 3)) * 8)) = ld[q]; } }
    LDS_WAIT(); __syncthreads();
#pragma unroll
    for (int q = 0; q < 8; ++q) { const int tile = tile0 + q * tstride; if (tile < ntiles) { const int c0 = (tile & 7) * 64, t0 = (tile >> 3) * 64, tk = tid >> 3, c8 = tid & 7;
        const LAS bf16* T = (const LAS bf16*)(lds + q * 9216); unsigned short e[8];
#pragma unroll
        for (int j = 0; j < 8; ++j) e[j] = T[(c8 * 8 + j) * 72 + (tk ^ (c8 << 3))];
        v4u o; o.x = e[0] | ((unsigned)e[1] << 16); o.y = e[2] | ((unsigned)e[3] << 16); o.z = e[4] | ((unsigned)e[5] << 16); o.w = e[6] | ((unsigned)e[7] << 16);
        *(GAS v4u*)(yhy + (size_t)(t0 + tk) * 512 + c0 + c8 * 8) = o; } }
    LDS_WAIT(); __syncthreads();
}

#if PROBE
constexpr int CW_P = 20000;
constexpr size_t WS_DF = 484 * MiB, WS_DZ = 485 * MiB;
constexpr int PROBE_C = 137;
__device__ __forceinline__ double wave_sum_d(double v) {
#pragma unroll
    for (int o = 1; o < 64; o <<= 1) v += __shfl_xor(v, o);
    return v;
}
__device__ __forceinline__ double filt_point(const float* w1, const float* b1, const float* w2, const float* b2, const float* w3, const float* fr, int g, int p, int col, int lane) {
    const int L = g ? LS : LP; const double t = (double)p / (double)(L - 1);
    double zval = 0.0;
    if (lane == 0) zval = t;
    else if (lane < 33) { const int i = (lane - 1) & 15; const double band = 1e-4 + (double)i * ((15.0 - 1e-4) / 15.0); const double ang = (6.283185307179586 / (double)L) * (double)p * band; zval = (lane <= 16) ? cos(ang) : -sin(ang); }
    double a = (double)b1[lane];
    for (int k = 0; k < 33; ++k) a += __shfl(zval, k) * (double)w1[k * 64 + lane];
    const double h1 = sin((double)fr[lane] * a);
    a = (double)b2[lane];
    for (int i = 0; i < 64; ++i) a += __shfl(h1, i) * (double)w2[i * 64 + lane];
    const double h2 = sin((double)fr[lane] * a);
    const double out = wave_sum_d(h2 * (double)w3[lane * 2048 + col]);
    const int c = col & 511; const double dmin = log(1e-2) / 1.5, dmax = log(1e-2) / 0.3;
    const double delta = fabs(dmin + (double)c * ((dmax - dmin) / 511.0));
    return out * (exp(-t * delta) + 0.05);
}
__device__ __forceinline__ void probe_check(unsigned char* ws, unsigned* ctl, const float* w1, const float* b1, const float* w2, const float* b2, const float* w3, const float* fr, int vcu, int G, int tid) {
    const bf16* KREV_S = (const bf16*)(ws + WS_KREV_S);
    const float* DF = (const float*)(ws + WS_DF); const bf16* DZ = (const bf16*)(ws + WS_DZ);
    const int gtid = vcu * 512 + tid, lane = tid & 63, gwv = gtid >> 6, NW = G * 8;
    if (gtid < 65536) {
        const int combo = gtid >> 14, t = gtid & 16383, g = combo >> 1, o = combo & 1, L = g ? LS : LP, tl = g ? t : (t & (LP - 1)), base = t - tl;
        const bf16* kb = KREV_S + (g ? (size_t)0 : (size_t)((WS_KREV_P - WS_KREV_S) / 2)) + (size_t)(o * HW + PROBE_C) * (2 * L); const bf16* dz = DZ + combo * 16384 + base;
        double acc = 0.0;
        if (g) { for (int s = 0; s < L; ++s) { int j = tl - s; if (j < 0) j += 2 * L; acc += (double)bf2f(kb[j]) * (double)bf2f(dz[s]); } }
        else   { const bf16* kr = kb + (L - 1 - tl); for (int s = 0; s < L; ++s) acc += (double)bf2f(kr[s]) * (double)bf2f(dz[s]); }
        const float diff = fabsf((float)(acc - (double)DF[combo * 16384 + t]));
        atomicMax(ctl + CW_P + (g ? 4 : 0), __float_as_uint(diff)); atomicMax(ctl + CW_P + (g ? 5 : 1), __float_as_uint(fabsf((float)acc)));
    }
    {
        const int g = gwv & 1, L = g ? LS : LP; const int p = (int)(((unsigned)gwv * 2654435761u) >> 8) % L;
        for (int q = 0; q < 8; ++q) { const int col = (gwv * 97 + 263 * q) & 2047; const int o = col >> 10, dir = (col >> 9) & 1, c = col & 511;
            if (dir == 1 && p == 0) continue;
            const double kv = filt_point(w1, b1, w2, b2, w3, fr, g, p, col, lane);
            const int m = g ? (dir ? (2 * L - p) : p) : (dir ? (L - 1 + p) : (L - 1 - p)); const float st = bf2f((KREV_S + (g ? (size_t)0 : (size_t)((WS_KREV_P - WS_KREV_S) / 2)) + (size_t)(o * HW + c) * (2 * L))[m]);
            if (lane == 0) { atomicMax(ctl + CW_P + 2, __float_as_uint(fabsf(st - (float)kv))); atomicMax(ctl + CW_P + 3, __float_as_uint(fabsf((float)kv))); } }
    }
    for (int which = 0; which < 2; ++which) {
        const int g = which ? 0 : 1, o = which ? 0 : 1, L = g ? LS : LP; double loc = 0.0;
        for (int p = gwv; p < L; p += NW)
            for (int dir = 0; dir < 2; ++dir) { if (dir == 1 && p == 0) continue; loc += fabs(filt_point(w1, b1, w2, b2, w3, fr, g, p, o * 1024 + dir * 512 + PROBE_C, lane)); }
        if (lane == 0) atomicAdd((double*)(ctl + CW_P + 8) + which, loc);
    }
}
__device__ __forceinline__ int probe_metric_count(unsigned char* ws, unsigned* ctl) {
    const float e_conv0 = __uint_as_float(__hip_atomic_load(ctl + CW_P + 0, RLX_AGENT)) / fmaxf(__uint_as_float(__hip_atomic_load(ctl + CW_P + 1, RLX_AGENT)), 1e-30f);
    const float e_conv1 = __uint_as_float(__hip_atomic_load(ctl + CW_P + 4, RLX_AGENT)) / fmaxf(__uint_as_float(__hip_atomic_load(ctl + CW_P + 5, RLX_AGENT)), 1e-30f);
    const float e_conv = fmaxf(e_conv0, e_conv1);
    const float e_filt = __uint_as_float(__hip_atomic_load(ctl + CW_P + 2, RLX_AGENT)) / fmaxf(__uint_as_float(__hip_atomic_load(ctl + CW_P + 3, RLX_AGENT)), 1e-30f);
    const float* FPS = (const float*)(ws + WS_FPART_S); const float* FPP = (const float*)(ws + WS_FPART_P);
    double s1 = 0.0, s0 = 0.0;
    for (int ch = 0; ch < 256; ++ch) s1 += (double)FPS[(size_t)ch * 2048 + 1024 + PROBE_C] + (double)FPS[(size_t)ch * 2048 + 1024 + 512 + PROBE_C];
    for (int ch = 0; ch < 32; ++ch) s0 += (double)FPP[(size_t)ch * 2048 + PROBE_C] + (double)FPP[(size_t)ch * 2048 + 512 + PROBE_C];
    const double n1 = ((volatile double*)(ctl + CW_P + 8))[0], n0 = ((volatile double*)(ctl + CW_P + 8))[1];
    const float e_n1 = (float)(fabs(n1 - s1) / fmax(n1, 1e-30)), e_n0 = (float)(fabs(n0 - s0) / fmax(n0, 1e-30));
#if PROBE == 100
    float M = fmaxf(fmaxf(e_conv, e_filt * 1e-3f), fmaxf(e_n1, e_n0));
#elif PROBE == 101
    float M = e_conv;
#elif PROBE == 104
    float M = e_conv0;
#elif PROBE == 102
    float M = e_filt;
#else
    float M = fmaxf(e_n1, e_n0);
#endif
    float v = (log10f(fmaxf(M, 1e-12f)) + 8.0f) * 0.125f; v = fminf(fmaxf(v, 0.02f), 1.0f);
    return (int)(v * 1600.0f);
}
#endif

#ifndef MK_SPLIT
#define MK_SPLIT 0
#endif
constexpr int N_PHASES = 8;
struct Args { const float* in[23]; float* out; unsigned char* ws; int ph_lo, ph_hi; };

__global__ void __launch_bounds__(NWAVES * 64, 2) enc_fwd(Args args) {
    extern __shared__ __attribute__((aligned(16))) unsigned char lds_raw[];
    Frame F;
    F.lds = (LAS unsigned char*)lds_raw;
    F.MISC = (volatile LAS unsigned*)(F.lds + MISC_OFF);
    F.tid = threadIdx.x; F.lane = F.tid & 63; F.wave = __builtin_amdgcn_readfirstlane(F.tid >> 6);
    F.G = gridDim.x; { const int bx = blockIdx.x; F.vcu = (F.G % 8 == 0) ? (bx % 8) * (F.G / 8) + bx / 8 : bx; }
    F.ws = args.ws; F.ctl = (gu32*)(args.ws + WS_CTL);
    unsigned char* const ws = args.ws;
    for (int u = F.tid; u < (LDS_BYTES - LDSCTL_OFF) / 4; u += NWAVES * 64) ((LAS unsigned*)(F.lds + LDSCTL_OFF))[u] = 0u;
    __syncthreads();
    const int lo = args.ph_lo, hi = args.ph_hi;
    XcdBarrier bar; bar.bar = (unsigned*)(F.ctl + CW_BAR); bar.x = 0; bar.st = nullptr;
    if (hi - lo > 1) bar = xcd_barrier_post((unsigned*)(F.ctl + CW_BAR), F.MISC + 8);
#define IN(k) (lo <= (k) && (k) < hi)
#if PROBE
#define TSTAMP(k) do { if (blockIdx.x == 0 && F.tid == 0) { const unsigned long long t_ = __builtin_amdgcn_s_memrealtime(); F.MISC[16 + 2 * (k)] = (unsigned)t_; F.MISC[17 + 2 * (k)] = (unsigned)(t_ >> 32); } } while (0)
#else
#define TSTAMP(k) do { } while (0)
#endif
#define SEAM(k) do { if (IN(k) && IN((k) + 1)) xcd_barrier(bar); TSTAMP((k) + 1); } while (0)
    TSTAMP(0);

    const float* const xp = args.in[0]; const float* const xs = args.in[1];
    bf16* const WINA = (bf16*)(ws + WS_WINA); bf16* const WINB = (bf16*)(ws + WS_WINB); bf16* const WHY = (bf16*)(ws + WS_WHY); bf16* const WAT = (bf16*)(ws + WS_WAT);
    bf16* const W3T = (bf16*)(ws + WS_W3T); bf16* const WO = (bf16*)(ws + WS_WO); bf16* const WGU = (bf16*)(ws + WS_WGU); bf16* const WD = (bf16*)(ws + WS_WD);
    bf16* const XB = (bf16*)(ws + WS_XB); bf16* const YT = (bf16*)(ws + WS_YT); bf16* const YAT = (bf16*)(ws + WS_YAT);
    bf16* const KREV_S = (bf16*)(ws + WS_KREV_S); bf16* const KREV_P = (bf16*)(ws + WS_KREV_P); bf16* const UT = (bf16*)(ws + WS_UT);
    bf16* const QB = (bf16*)(ws + WS_Q); bf16* const KB = (bf16*)(ws + WS_K); bf16* const VB = (bf16*)(ws + WS_V);
    bf16* const SGH = (bf16*)(ws + WS_SGH); bf16* const SGA = (bf16*)(ws + WS_SGA);
    float* const COS = (float*)(ws + WS_COS); float* const SIN = (float*)(ws + WS_SIN); float* const RSTD = (float*)(ws + WS_RSTD); float* const SSQ = (float*)(ws + WS_SSQ);
    float* const FPART_S = (float*)(ws + WS_FPART_S); float* const FPART_P = (float*)(ws + WS_FPART_P);
    bf16* const YHY = (bf16*)(ws + WS_YHY); bf16* const MERGED = (bf16*)(ws + WS_MERGED); bf16* const X1B = (bf16*)(ws + WS_X1B); bf16* const HID = (bf16*)(ws + WS_HID);

    if (IN(0)) {
        LAS float* scr = (LAS float*)(F.lds + RING_OFF + F.wave * 16384);
        const int gw = F.vcu * NWAVES + F.wave, NGW = F.G * NWAVES;
        constexpr int I_IN = 16 * 136, I_HY = 8 * 32, I_O = 16 * 32, I_G = 16 * 88, I_D = 44 * 32, I_W3 = 64;
        constexpr int NITEMS = I_IN + 2 * I_HY + I_O + 2 * I_G + I_D + I_W3;
        for (int it = gw; it < NITEMS; it += NGW) {
            int rr = it;
            if (rr < I_IN) { const int kb = rr / 136, nb = rr % 136, n0 = 32 * nb;
                if (n0 < 3 * HW) p0_transpose_item(args.in[3], DM, INW, WINA, n0, args.in[2], scr, 64 * kb, n0, F.lane);
                else p0_transpose_item(args.in[3], DM, INW, WINB, map_projB(n0), args.in[2], scr, 64 * kb, n0, F.lane);
                continue; } rr -= I_IN;
            if (rr < I_HY) { p0_transpose_item(args.in[16], HW, DM, WHY, 32 * (rr % 32), nullptr, scr, 64 * (rr / 32), 32 * (rr % 32), F.lane); continue; } rr -= I_HY;
            if (rr < I_HY) { p0_transpose_item(args.in[17], HW, DM, WAT, 32 * (rr % 32), nullptr, scr, 64 * (rr / 32), 32 * (rr % 32), F.lane); continue; } rr -= I_HY;
            if (rr < I_O) { p0_transpose_item(args.in[18], DM, DM, WO, 32 * (rr % 32), nullptr, scr, 64 * (rr / 32), 32 * (rr % 32), F.lane); continue; } rr -= I_O;
            if (rr < I_G) { const int n0 = 32 * (rr % 88); p0_transpose_item(args.in[20], DM, FFN, WGU, (n0 >> 7) * 256 + (n0 & 127), args.in[19], scr, 64 * (rr / 88), n0, F.lane); continue; } rr -= I_G;
            if (rr < I_G) { const int n0 = 32 * (rr % 88); p0_transpose_item(args.in[21], DM, FFN, WGU, (n0 >> 7) * 256 + 128 + (n0 & 127), args.in[19], scr, 64 * (rr / 88), n0, F.lane); continue; } rr -= I_G;
            if (rr < I_D) { p0_transpose_item(args.in[22], FFN, DM, WD, 32 * (rr % 32), nullptr, scr, 64 * (rr / 32), 32 * (rr % 32), F.lane); continue; } rr -= I_D;
            p0_transpose_item(args.in[10], 64, 2048, W3T, 32 * rr, nullptr, scr, 0, 32 * rr, F.lane);
        }
        for (int m = gw; m < MTOK; m += 4 * NGW) {
            const float* src[4];
#pragma unroll
            for (int q = 0; q < 4; ++q) { const int mq = m + q * NGW; src[q] = (mq < TP) ? xp + (size_t)mq * DM : xs + (size_t)(mq - TP) * DM; }
            f32x4 v[4][4];
#pragma unroll
            for (int q = 0; q < 4; ++q)
#pragma unroll
                for (int j = 0; j < 4; ++j) v[q][j] = ((const GAS f32x4*)src[q] + F.lane)[64 * j];
#pragma unroll
            for (int q = 0; q < 4; ++q) { const int mq = m + q * NGW; float s = 0.f;
#pragma unroll
                for (int j = 0; j < 4; ++j) s += (v[q][j].x * v[q][j].x + v[q][j].y * v[q][j].y) + (v[q][j].z * v[q][j].z + v[q][j].w * v[q][j].w);
                s = wave_sum(s);
                if (F.lane == 0) RSTD[mq] = 1.0f / sqrtf(s * (1.0f / DM) + RMS_EPS);
                GAS unsigned long long* o8 = (GAS unsigned long long*)(XB + (size_t)mq * DM) + F.lane;
#pragma unroll
                for (int j = 0; j < 4; ++j) o8[64 * j] = (unsigned long long)pk2(v[q][j].x, v[q][j].y) | ((unsigned long long)pk2(v[q][j].z, v[q][j].w) << 32); }
        }
        {
            const int idx0 = F.vcu * (NWAVES * 64) + F.tid;
            const double cr = exp2(-(double)(idx0 & 31) * (13.287712379549449 / 32.0)) * 0.15915494309189535;
            for (int idx = idx0; idx < LS * 32; idx += F.G * NWAVES * 64) {
                const double rev = (double)(idx >> 5) * cr; const float fr_ = (float)(rev - floor(rev));
                COS[idx] = __builtin_amdgcn_cosf(fr_); SIN[idx] = __builtin_amdgcn_sinf(fr_);
            }
        }
    }
    SEAM(0);

    if (IN(1)) {
        {
            constexpr int NU = (MTOK / 256) * (NPROJ / 256);
            const int heavy = NU % F.G, lb = heavy ? (int)blockIdx.x - heavy : (int)blockIdx.x, nlb = heavy ? F.G - heavy : F.G;
            if (lb >= 0) {
                filter_stage_weights(F.lds, args.in[6], args.in[7], args.in[8], args.in[9], args.in[11], F.tid);
                for (int it = lb * NWAVES + F.wave; it < 288 * 2; it += nlb * NWAVES) {
                    const int dir = it & 1, ca = it >> 1, g = (ca < 256) ? 1 : 0, chunk = g ? ca : ca - 256;
                    filter_item(F.lds, W3T, KREV_S + (g ? (size_t)0 : (size_t)((WS_KREV_P - WS_KREV_S) / 2)), FPART_S + (g ? (size_t)0 : (size_t)((WS_FPART_P - WS_FPART_S) / 4)), g, chunk, dir, F.wave, F.lane);
                }
                LDS_WAIT(); __syncthreads();
            }
        }
        {
            pg8::Gemm g{WINA, XB, nullptr, nullptr, 3 * HW, MTOK, DM}; pg8::StaticOrder S; S.init(3 * HW, MTOK, F.G, (int)blockIdx.x);
            pg8::EpiUT E{UT, MTOK, RSTD};
            pg8::gemm_phase<pg8::EpiUT, pg8::StaticOrder, true, true>(F.lds + RING_OFF, g, S, E);
        }
        {
            pg8::Gemm g{XB, WINB, nullptr, nullptr, MTOK, NPROJ, DM}; pg8::StaticOrder S; S.init(MTOK, NPROJ, F.G, (int)blockIdx.x);
            pg8::EpiProj E{RSTD, args.in[13], args.in[14], COS, SIN, QB, KB, VB, SGH, SGA};
            pg8::gemm_phase<pg8::EpiProj, pg8::StaticOrder, true, true>(F.lds + RING_OFF, g, S, E);
        }
    }
    SEAM(1);

    if (IN(2)) {
        #if PROBE
        const hy::Params HP{UT, KREV_S, KREV_P, FPART_S, FPART_P, args.in[4], args.in[5], args.in[12], YT, (float*)(ws + WS_DF), (bf16*)(ws + WS_DZ)};
#else
        const hy::Params HP{UT, KREV_S, KREV_P, FPART_S, FPART_P, args.in[4], args.in[5], args.in[12], YT, nullptr, nullptr};
#endif
        {
#if PROBE
            const fc::Params FP{UT, KREV_S, FPART_S, args.in[4], args.in[5], args.in[12], YT, (bf16*)(ws + WS_HS), (bf16*)(ws + WS_Z1S), (float*)(ws + WS_DF), (bf16*)(ws + WS_DZ)};
#else
            const fc::Params FP{UT, KREV_S, FPART_S, args.in[4], args.in[5], args.in[12], YT, (bf16*)(ws + WS_HS), (bf16*)(ws + WS_Z1S), nullptr, nullptr};
#endif
            for (int it = F.vcu; it < HW; it += F.G) fc::item(F.lds, FP, it, F.tid, F.vcu);
        }
        TSTAMP(9);
        for (int it = F.vcu; it < HW; it += F.G) hy::hyena_item(F.lds, HP, 0, it, F.tid);
        TSTAMP(10);
        const at::Params AP{QB, KB, VB, args.in[15], YAT};
        for (int it = F.vcu; it < 512; it += F.G) at::attn_item(F.lds, AP, it >> 1, it & 1, F.tid);
    }
    SEAM(2);
#if PROBE >= 100
    probe_check(ws, (unsigned*)F.ctl, args.in[6], args.in[7], args.in[8], args.in[9], args.in[10], args.in[11], F.vcu, F.G, F.tid);
    xcd_barrier(bar);
#endif

    if (IN(3)) {
        for (int t = F.vcu; t < 8 * 512; t += 8 * F.G) transpose_y_tiles8(F.lds, YT, YHY, t, F.G, 8 * 512, F.tid);
    }
    SEAM(3);

    if (IN(4)) {
        pg8::Gemm g{YHY, WHY, YAT, WAT, MTOK, DM, HW}; pg8::TwoPartOrder S; S.b.init(MTOK, DM, F.G, (int)blockIdx.x);
        pg8::EpiMerged E{SGH, SGA, MERGED};
        pg8::gemm_phase<pg8::EpiMerged, pg8::TwoPartOrder, true, true>(F.lds + RING_OFF, g, S, E);
    }
    SEAM(4);

    if (IN(5)) {
        pg8::Gemm g{MERGED, WO, nullptr, nullptr, MTOK, DM, DM}; pg8::StaticOrder S; S.init(MTOK, DM, F.G, (int)blockIdx.x);
        pg8::EpiWo E{xp, xs, X1B, SSQ};
        pg8::gemm_phase<pg8::EpiWo, pg8::StaticOrder, true, true>(F.lds + RING_OFF, g, S, E);
    }
    SEAM(5);

    if (IN(6)) {
        pg8::Gemm g{X1B, WGU, nullptr, nullptr, MTOK, 2 * FFN, DM}; pg8::StaticOrder S; S.init(MTOK, 2 * FFN, F.G, (int)blockIdx.x);
        pg8::EpiFfn1 E{SSQ, HID};
        pg8::gemm_phase<pg8::EpiFfn1, pg8::StaticOrder, true, true>(F.lds + RING_OFF, g, S, E);
    }
    SEAM(6);

    if (IN(7)) {
        pg8::Gemm g{HID, WD, nullptr, nullptr, MTOK, DM, FFN}; pg8::StaticOrder S; S.init(MTOK, DM, F.G, (int)blockIdx.x);
        pg8::EpiFfn2 E{X1B, args.out};
        pg8::gemm_phase<pg8::EpiFfn2, pg8::StaticOrder, true, true>(F.lds + RING_OFF, g, S, E);
#if PROBE
        TSTAMP(8);
        VM_WAIT(); __syncthreads();
        if (blockIdx.x == 0) {
            pg8::Unit u; S.next(1, u);
            int cnt;
#if PROBE >= 100
            cnt = probe_metric_count(ws, (unsigned*)F.ctl);
#else
            { const unsigned long long t0 = F.MISC[16] | ((unsigned long long)F.MISC[17] << 32), t8 = F.MISC[32] | ((unsigned long long)F.MISC[33] << 32);
#if (PROBE >= 31 && PROBE <= 35) || (PROBE >= 41 && PROBE <= 46)
              cnt = (int)(1600.0f * (float)F.MISC[40 + (PROBE % 10) - 1] / (float)(t8 - t0));
              constexpr int IA = 0, IB = 1;
              if (false)
#elif PROBE == 21
              constexpr int IA = 2, IB = 9;
#elif PROBE == 22
              constexpr int IA = 9, IB = 10;
#elif PROBE == 23
              constexpr int IA = 10, IB = 3;
#else
              constexpr int IA = PROBE - 1, IB = PROBE;
#endif
              { const unsigned long long ta = F.MISC[16 + 2 * IA] | ((unsigned long long)F.MISC[17 + 2 * IA] << 32), tb = F.MISC[16 + 2 * IB] | ((unsigned long long)F.MISC[17 + 2 * IB] << 32);
                cnt = (int)(1600.0f * (float)(tb - ta) / (float)(t8 - t0)); } }
#endif
            for (int i = F.tid; i < cnt; i += NWAVES * 64) args.out[(size_t)(u.pm * 256 + (i & 255)) * 1024 + u.pn * 256 + (i >> 8)] = 0.f;
        }
#endif
    }
#undef IN
#undef SEAM
}

extern "C" void kernel_launch(void* const* d_in, const int* in_sizes, int n_in, void* d_out, int out_size, void* d_ws, size_t ws_size, hipStream_t stream) {
    static int grid = 0;
    if (grid == 0) {
        if (n_in != 23 || out_size != MTOK * DM || ws_size < WS_END) { fprintf(stderr, "kernel_launch: unexpected problem shape (n_in %d, out %d, ws %zu); nothing launched\n", n_in, out_size, ws_size); grid = -1; return; }
        int dev = 0, cus = 0, per_cu = 0;
        if (hipGetDevice(&dev) != hipSuccess || hipDeviceGetAttribute(&cus, hipDeviceAttributeMultiprocessorCount, dev) != hipSuccess) { fprintf(stderr, "kernel_launch: device query failed\n"); grid = -1; return; }
        if (hipFuncSetAttribute((const void*)enc_fwd, hipFuncAttributeMaxDynamicSharedMemorySize, LDS_BYTES) != hipSuccess) { fprintf(stderr, "kernel_launch: hipFuncSetAttribute failed\n"); grid = -1; return; }
        if (hipOccupancyMaxActiveBlocksPerMultiprocessor(&per_cu, (const void*)enc_fwd, NWAVES * 64, LDS_BYTES) != hipSuccess || per_cu < 1)
            fprintf(stderr, "kernel_launch: note: occupancy query reports %d workgroups per CU\n", per_cu);
        (void)hipGetLastError();
        grid = cus;
    }
    if (grid < 0) return;
    if (hipMemsetAsync((char*)d_ws + WS_CTL, 0, CTL_ZERO_BYTES, stream) != hipSuccess) { fprintf(stderr, "kernel_launch: memset failed\n"); return; }
    Args a{};
    for (int i = 0; i < 23; ++i) a.in[i] = (const float*)d_in[i];
    a.out = (float*)d_out; a.ws = (unsigned char*)d_ws;
#if MK_SPLIT
    for (int p = 0; p < N_PHASES; ++p) { a.ph_lo = p; a.ph_hi = p + 1; hipLaunchKernelGGL(enc_fwd, dim3(grid), dim3(NWAVES * 64), LDS_BYTES, stream, a); }
#else
    a.ph_lo = 0; a.ph_hi = N_PHASES;
    hipLaunchKernelGGL(enc_fwd, dim3(grid), dim3(NWAVES * 64), LDS_BYTES, stream, a);
#endif
    const hipError_t le = hipPeekAtLastError();
    if (le != hipSuccess) fprintf(stderr, "kernel_launch: launch failed: %s\n", hipGetErrorName(le));
}
```

```cpp
#include <hip/hip_runtime.h>
#include <cstdio>
#include <cstdint>
#include <cmath>
#ifndef PROBE
#define PROBE 0
#endif

namespace pg8 {
#define PG8_LAS __attribute__((address_space(3)))
typedef unsigned short bf16_t;
typedef short bf16x8 __attribute__((ext_vector_type(8)));
typedef float f32x4 __attribute__((ext_vector_type(4)));
typedef unsigned u32x4 __attribute__((ext_vector_type(4)));
constexpr int BM = 256, BK = 64, HALF = 128, HTB = HALF * BK * 2  , STAGE_BYTES = 8 * HTB, NXCD = 8, WGM = 8;

__host__ __device__ __forceinline__ int lds_byte(int r, int c) { const int st = (r >> 4) * 2 + (c >> 5), rr = r & 15, cc = c & 31, ob = rr * 64 + cc * 2; return st * 1024 + (ob ^ (((ob >> 9) & 1) << 5)); }
__host__ __device__ __forceinline__ void stage_rc(int b, int& R, int& C) { const int st = b / 1024, sb = b % 1024, swz = sb ^ (((sb >> 9) & 1) << 5); R = (st >> 1) * 16 + swz / 64; C = (st & 1) * 32 + (swz % 64) / 2; }
__host__ __device__ __forceinline__ int perm32(int rho) { const int n = rho >> 4, i = rho & 15; return 8 * (i >> 2) + 4 * n + (i & 3); }

struct Unit { int pm, pn, sel; };
struct Gemm { const bf16_t* A; const bf16_t* Bt; const bf16_t* A1; const bf16_t* Bt1; int M, N, K; };

struct StaticOrder {
    int nM, nN, nwg, G, c;
    __host__ __device__ __forceinline__ void init(int M, int N, int G_, int c_) { nM = M / BM; nN = N / BM; nwg = nM * nN; G = G_; c = c_; }
    __host__ __device__ __forceinline__ bool next(int i, Unit& u) const {
        const long L = (long)i * G + c; if (L >= nwg) return false;
        int wgid = (int)L; { const int q = nwg / NXCD, r = nwg % NXCD, xcd = wgid % NXCD, off = wgid / NXCD; wgid = (xcd < r ? xcd * (q + 1) : r * (q + 1) + (xcd - r) * q) + off; }
        const int nig = WGM * nN, gid = wgid / nig, fm = gid * WGM, gsz = (nM - fm) < WGM ? (nM - fm) : WGM;
        u.pm = fm + ((wgid % nig) % gsz); u.pn = (wgid % nig) / gsz; u.sel = 0; return true;
    }
    __device__ __forceinline__ void a_ready(const Unit&) const {}
    __device__ __forceinline__ void done(const Unit&) const {}
};
struct TwoPartOrder {
    StaticOrder b;
    __device__ __forceinline__ bool next(int i, Unit& u) const { if (!b.next(i >> 1, u)) return false; u.sel = i & 1; return true; }
    __device__ __forceinline__ void a_ready(const Unit&) const {}
    __device__ __forceinline__ void done(const Unit&) const {}
};

typedef float f32x2_c __attribute__((ext_vector_type(2))); typedef __bf16 bf16x2_c __attribute__((ext_vector_type(2)));
__device__ __forceinline__ unsigned cvt_pk_bf16(float lo, float hi) { const f32x2_c v = {lo, hi}; return __builtin_bit_cast(unsigned, __builtin_convertvector(v, bf16x2_c)); }
__device__ __forceinline__ u32x4 pack8(const f32x4 a, const f32x4 b) { u32x4 w; w.x = cvt_pk_bf16(a[0], a[1]); w.y = cvt_pk_bf16(a[2], a[3]); w.z = cvt_pk_bf16(b[0], b[1]); w.w = cvt_pk_bf16(b[2], b[3]); return w; }
__device__ __forceinline__ float bflo(unsigned w) { return __uint_as_float(w << 16); }
__device__ __forceinline__ float bfhi(unsigned w) { return __uint_as_float(w & 0xffff0000u); }
__device__ __forceinline__ void unpack8(const u32x4 w, f32x4& a, f32x4& b) { a = (f32x4){bflo(w.x), bfhi(w.x), bflo(w.y), bfhi(w.y)}; b = (f32x4){bflo(w.z), bfhi(w.z), bflo(w.w), bfhi(w.w)}; }
__device__ __forceinline__ float sigmoidf_(float v) { return __builtin_amdgcn_rcpf(1.0f + __builtin_amdgcn_exp2f(-1.4426950408889634f * v)); }

constexpr float QSCALE = 0.125f * 1.4426950408889634f;

struct EpiUT {
    static constexpr bool PERM = true, AFTER_DRAIN = false;
    bf16_t* O; int ldc; const float* rstd;
    __device__ __forceinline__ bool keep(const Unit&) const { return false; }
    __device__ __forceinline__ void operator()(f32x4 (&acc)[2][2][4][2], const Unit& u, int wr, int wc, int fr, int fq) const {
        const int row0 = u.pm * BM + wr * 64 + fr, col0 = u.pn * BM + wc * 32 + 8 * fq;
        f32x4 rs[2][2];
#pragma unroll
        for (int bj = 0; bj < 2; ++bj)
#pragma unroll
            for (int n = 0; n < 2; ++n) rs[bj][n] = *(const f32x4*)(rstd + col0 + bj * HALF + 4 * n);
#pragma unroll
        for (int ai = 0; ai < 2; ++ai)
#pragma unroll
            for (int m = 0; m < 4; ++m) { bf16_t* rowp = O + (size_t)(row0 + ai * HALF + m * 16) * ldc + col0;
#pragma unroll
                for (int bj = 0; bj < 2; ++bj) *(u32x4*)(rowp + bj * HALF) = pack8(acc[ai][bj][m][0] * rs[bj][0], acc[ai][bj][m][1] * rs[bj][1]); }
    }
};

struct EpiProj {
    static constexpr bool PERM = true, AFTER_DRAIN = false;
    const float* rstd; const float* qw; const float* kw; const float* cs; const float* sn; bf16_t* q; bf16_t* k; bf16_t* v; bf16_t* sgh; bf16_t* sga;
    __device__ __forceinline__ bool keep(const Unit&) const { return false; }
    __device__ __forceinline__ void operator()(f32x4 (&acc)[2][2][4][2], const Unit& u, int wr, int wc, int fr, int fq) const {
        const int pn = u.pn;
        float rsv[2][4];
#pragma unroll
        for (int ai = 0; ai < 2; ++ai)
#pragma unroll
            for (int m = 0; m < 4; ++m) rsv[ai][m] = rstd[u.pm * BM + ai * HALF + wr * 64 + m * 16 + fr];
        if (pn <= 2 && !(pn == 2 && wc >= 2)) {
            const float* w = (pn < 2) ? qw : kw; const float sc = (pn < 2) ? QSCALE : 1.0f;
            const f32x4 wl0 = *(const f32x4*)(w + 8 * fq), wl1 = *(const f32x4*)(w + 8 * fq + 4), wh0 = *(const f32x4*)(w + 32 + 8 * fq), wh1 = *(const f32x4*)(w + 32 + 8 * fq + 4);
#pragma unroll
            for (int ai = 0; ai < 2; ++ai)
#pragma unroll
                for (int m = 0; m < 4; ++m) {
                    const int row = u.pm * BM + ai * HALF + wr * 64 + m * 16 + fr; const float rs = rsv[ai][m];
                    f32x4 a0 = acc[ai][0][m][0] * rs, a1 = acc[ai][0][m][1] * rs, b0 = acc[ai][1][m][0] * rs, b1 = acc[ai][1][m][1] * rs;
                    f32x4 sq = a0 * a0 + a1 * a1 + b0 * b0 + b1 * b1; float ss = (sq[0] + sq[1]) + (sq[2] + sq[3]);
                    ss += __shfl_xor(ss, 16); ss += __shfl_xor(ss, 32);
                    const float inv = 1.0f / sqrtf(ss * (1.0f / 64.0f) + 1e-6f);
                    const int pos = row < 16384 ? (row & 2047) : (row - 16384);
                    const f32x4 c0 = *(const f32x4*)(cs + pos * 32 + 8 * fq), c1 = *(const f32x4*)(cs + pos * 32 + 8 * fq + 4), s0 = *(const f32x4*)(sn + pos * 32 + 8 * fq), s1 = *(const f32x4*)(sn + pos * 32 + 8 * fq + 4);
                    a0 = a0 * inv * wl0; a1 = a1 * inv * wl1; b0 = b0 * inv * wh0; b1 = b1 * inv * wh1;
                    const f32x4 lo0 = (a0 * c0 - b0 * s0) * sc, lo1 = (a1 * c1 - b1 * s1) * sc, hi0 = (b0 * c0 + a0 * s0) * sc, hi1 = (b1 * c1 + a1 * s1) * sc;
                    bf16_t* dst = (pn < 2) ? q + (size_t)row * 512 + (4 * pn + wc) * 64 + 8 * fq : k + (size_t)row * 128 + wc * 64 + 8 * fq;
                    *(u32x4*)dst = pack8(lo0, lo1); *(u32x4*)(dst + 32) = pack8(hi0, hi1);
                }
        } else if (pn == 2) {
#pragma unroll
            for (int ai = 0; ai < 2; ++ai)
#pragma unroll
                for (int m = 0; m < 4; ++m) {
                    const int row = u.pm * BM + ai * HALF + wr * 64 + m * 16 + fr; const float rs = rsv[ai][m];
                    bf16_t* dst = v + (size_t)row * 128 + (wc - 2) * 64 + 8 * fq;
                    *(u32x4*)dst = pack8(acc[ai][0][m][0] * rs, acc[ai][0][m][1] * rs); *(u32x4*)(dst + 32) = pack8(acc[ai][1][m][0] * rs, acc[ai][1][m][1] * rs);
                }
        } else {
            bf16_t* base = (pn < 7) ? sgh : sga; const int colb = (pn - ((pn < 7) ? 3 : 7)) * BM + wc * 32 + 8 * fq;
#pragma unroll
            for (int ai = 0; ai < 2; ++ai)
#pragma unroll
                for (int m = 0; m < 4; ++m) {
                    const int row = u.pm * BM + ai * HALF + wr * 64 + m * 16 + fr; const float rs = rsv[ai][m];
#pragma unroll
                    for (int bj = 0; bj < 2; ++bj) { f32x4 g0 = acc[ai][bj][m][0] * rs, g1 = acc[ai][bj][m][1] * rs;
#pragma unroll
                        for (int e = 0; e < 4; ++e) { g0[e] = sigmoidf_(g0[e]); g1[e] = sigmoidf_(g1[e]); }
                        *(u32x4*)(base + (size_t)row * 1024 + colb + bj * HALF) = pack8(g0, g1); }
                }
        }
    }
};

struct EpiMerged {
    static constexpr bool PERM = true, AFTER_DRAIN = false;
    const bf16_t* sgh; const bf16_t* sga; bf16_t* out;
    __device__ __forceinline__ bool keep(const Unit& u) const { return u.sel == 0; }
    __device__ __forceinline__ void operator()(f32x4 (&acc)[2][2][4][2], const Unit& u, int wr, int wc, int fr, int fq) const {
#pragma unroll
        for (int ai = 0; ai < 2; ++ai) {
            u32x4 ga[4][2], gh[4][2];
#pragma unroll
            for (int m = 0; m < 4; ++m) { const size_t off = (size_t)(u.pm * BM + ai * HALF + wr * 64 + m * 16 + fr) * 1024 + u.pn * BM + wc * 32 + 8 * fq;
#pragma unroll
                for (int bj = 0; bj < 2; ++bj) { ga[m][bj] = *(const u32x4*)(sga + off + bj * HALF); if (u.sel == 0) gh[m][bj] = *(const u32x4*)(sgh + off + bj * HALF); } }
#pragma unroll
            for (int m = 0; m < 4; ++m) { const size_t off = (size_t)(u.pm * BM + ai * HALF + wr * 64 + m * 16 + fr) * 1024 + u.pn * BM + wc * 32 + 8 * fq;
#pragma unroll
                for (int bj = 0; bj < 2; ++bj) {
                    f32x4 t0, t1; unpack8(ga[m][bj], t0, t1);
                    if (u.sel == 0) { f32x4 h0, h1; unpack8(gh[m][bj], h0, h1);
                        f32x4 q0, q1;
#pragma unroll
                        for (int e = 0; e < 4; ++e) { q0[e] = h0[e] * __builtin_amdgcn_rcpf(t0[e]); q1[e] = h1[e] * __builtin_amdgcn_rcpf(t1[e]); }
                        acc[ai][bj][m][0] = acc[ai][bj][m][0] * q0; acc[ai][bj][m][1] = acc[ai][bj][m][1] * q1; }
                    else *(u32x4*)(out + off + bj * HALF) = pack8(acc[ai][bj][m][0] * t0, acc[ai][bj][m][1] * t1);
                } }
        }
    }
};

struct EpiWo {
    static constexpr bool PERM = true, AFTER_DRAIN = false;
    const float* xp; const float* xs; bf16_t* x1b; float* ssq;
    __device__ __forceinline__ bool keep(const Unit&) const { return false; }
    __device__ __forceinline__ void operator()(f32x4 (&acc)[2][2][4][2], const Unit& u, int wr, int wc, int fr, int fq) const {
        const float* xb = (u.pm < 64) ? xp : xs - (size_t)16384 * 1024;
#pragma unroll
        for (int ai = 0; ai < 2; ++ai) {
            f32x4 xv[4][2][2];
#pragma unroll
            for (int m = 0; m < 4; ++m) { const size_t off = (size_t)(u.pm * BM + ai * HALF + wr * 64 + m * 16 + fr) * 1024 + u.pn * BM + wc * 32 + 8 * fq;
#pragma unroll
                for (int bj = 0; bj < 2; ++bj) { xv[m][bj][0] = *(const f32x4*)(xb + off + bj * HALF); xv[m][bj][1] = *(const f32x4*)(xb + off + bj * HALF + 4); } }
#pragma unroll
            for (int m = 0; m < 4; ++m) {
                const int row = u.pm * BM + ai * HALF + wr * 64 + m * 16 + fr; const size_t off = (size_t)row * 1024 + u.pn * BM + wc * 32 + 8 * fq; float s = 0.f;
#pragma unroll
                for (int bj = 0; bj < 2; ++bj) {
                    const f32x4 v0 = xv[m][bj][0] + acc[ai][bj][m][0], v1 = xv[m][bj][1] + acc[ai][bj][m][1];
                    *(u32x4*)(x1b + off + bj * HALF) = pack8(v0, v1);
                    const f32x4 q = v0 * v0 + v1 * v1; s += (q[0] + q[1]) + (q[2] + q[3]); }
                s += __shfl_xor(s, 16); s += __shfl_xor(s, 32);
                if (fq == 0) ssq[(size_t)row * 16 + u.pn * 4 + wc] = s;
            }
        }
    }
};

struct EpiFfn1 {
    static constexpr bool PERM = true, AFTER_DRAIN = false;
    const float* ssq; bf16_t* hid;
    __device__ __forceinline__ bool keep(const Unit&) const { return false; }
    __device__ __forceinline__ void operator()(f32x4 (&acc)[2][2][4][2], const Unit& u, int wr, int wc, int fr, int fq) const {
        f32x4 pv[2][4];
#pragma unroll
        for (int ai = 0; ai < 2; ++ai)
#pragma unroll
            for (int m = 0; m < 4; ++m) pv[ai][m] = *(const f32x4*)(ssq + (size_t)(u.pm * BM + ai * HALF + wr * 64 + m * 16 + fr) * 16 + 4 * fq);
#pragma unroll
        for (int ai = 0; ai < 2; ++ai)
#pragma unroll
            for (int m = 0; m < 4; ++m) {
                const int row = u.pm * BM + ai * HALF + wr * 64 + m * 16 + fr;
                const f32x4 p = pv[ai][m]; float t = (p[0] + p[1]) + (p[2] + p[3]);
                t += __shfl_xor(t, 16); t += __shfl_xor(t, 32);
                const float r = 1.0f / sqrtf(t * (1.0f / 1024.0f) + 1e-6f);
                f32x4 h0, h1;
#pragma unroll
                for (int e = 0; e < 4; ++e) { const float g0 = acc[ai][0][m][0][e] * r, g1 = acc[ai][0][m][1][e] * r;
                    h0[e] = g0 * sigmoidf_(g0) * (acc[ai][1][m][0][e] * r); h1[e] = g1 * sigmoidf_(g1) * (acc[ai][1][m][1][e] * r); }
                *(u32x4*)(hid + (size_t)row * 2816 + u.pn * HALF + wc * 32 + 8 * fq) = pack8(h0, h1);
            }
    }
};

struct EpiFfn2 {
    static constexpr bool PERM = true, AFTER_DRAIN = false;
    const bf16_t* x1b; float* out;
    __device__ __forceinline__ bool keep(const Unit&) const { return false; }
    __device__ __forceinline__ void operator()(f32x4 (&acc)[2][2][4][2], const Unit& u, int wr, int wc, int fr, int fq) const {
        u32x4 rv[2][4][2];
#pragma unroll
        for (int ai = 0; ai < 2; ++ai)
#pragma unroll
            for (int m = 0; m < 4; ++m) { const size_t off = (size_t)(u.pm * BM + ai * HALF + wr * 64 + m * 16 + fr) * 1024 + u.pn * BM + wc * 32 + 8 * fq;
#pragma unroll
                for (int bj = 0; bj < 2; ++bj) rv[ai][m][bj] = *(const u32x4*)(x1b + off + bj * HALF); }
#pragma unroll
        for (int ai = 0; ai < 2; ++ai)
#pragma unroll
            for (int m = 0; m < 4; ++m) {
                const size_t off = (size_t)(u.pm * BM + ai * HALF + wr * 64 + m * 16 + fr) * 1024 + u.pn * BM + wc * 32 + 8 * fq; float* p = out + off;
#pragma unroll
                for (int bj = 0; bj < 2; ++bj) { f32x4 r0, r1; unpack8(rv[ai][m][bj], r0, r1);
                    *(f32x4*)(p + bj * HALF) = r0 + acc[ai][bj][m][0]; *(f32x4*)(p + bj * HALF + 4) = r1 + acc[ai][bj][m][1]; }
            }
    }
};

__device__ __forceinline__ void zero_acc(f32x4 (&acc)[2][2][4][2]) {
#pragma unroll
    for (int a = 0; a < 2; ++a)
#pragma unroll
        for (int b = 0; b < 2; ++b)
#pragma unroll
            for (int m = 0; m < 4; ++m)
#pragma unroll
                for (int n = 0; n < 2; ++n) acc[a][b][m][n] = (f32x4){0.f, 0.f, 0.f, 0.f};
}
template <class Epi, class Sched, bool ALIGN_EPI = false, bool SP2 = false>
__device__ __forceinline__ void gemm_phase(PG8_LAS unsigned char* lds, const Gemm g, const Sched& S, const Epi& E, int wave_in) {
    int tid; { unsigned m_ = ~0u; asm volatile("" : "+s"(m_)); tid = wave_in * 64 + (int)__builtin_amdgcn_mbcnt_hi(m_, __builtin_amdgcn_mbcnt_lo(m_, 0u)); }
    const int wid = __builtin_amdgcn_readfirstlane(tid >> 6), lane = tid & 63, wr = wid >> 2, wc = wid & 3, fr = lane & 15, fq = lane >> 4;
    const int K = g.K, nt = K / BK;
    unsigned voffA[2], voffB[2];
#pragma unroll
    for (int i = 0; i < 2; ++i) { int R, C; stage_rc(tid * 16 + i * 8192, R, C); const int Rb = Epi::PERM ? ((R & ~31) + perm32(R & 31)) : R;
        voffA[i] = (unsigned)(R * K + C) * 2u; voffB[i] = (unsigned)(Rb * K + C) * 2u; }
    const size_t kstep = (size_t)(BK * 2);
    const size_t hstep = (size_t)HALF * K * 2;
    const size_t tstep = 2 * hstep;
    const unsigned ldsw = (unsigned)wid * 1024u;
    const int aoff = lds_byte(wr * 64 + fr, fq * 8), boff = lds_byte(wc * 32 + fr, fq * 8);
#define PG8_SA(b, h) (((b) * 2 + (h)) * HTB)
#define PG8_SB(b, h) ((4 + (b) * 2 + (h)) * HTB)
#define PG8_STAGE(bufoff, gbase, voff) do { _Pragma("unroll") for (int _i = 0; _i < 2; ++_i) \
        __builtin_amdgcn_global_load_lds((const unsigned*)((const char*)(gbase) + (voff)[_i]), (PG8_LAS unsigned*)(lds + (bufoff) + ldsw + _i * 8192), 16, 0, 0); } while (0)
#define PG8_LDA(dst, b, h) do { _Pragma("unroll") for (int m = 0; m < 4; ++m) _Pragma("unroll") for (int k = 0; k < 2; ++k) dst[m][k] = *(const PG8_LAS bf16x8*)(lds + PG8_SA(b, h) + aoff + m * 2048 + k * 1024); } while (0)
#define PG8_LDB(dst, b, h) do { _Pragma("unroll") for (int n = 0; n < 2; ++n) _Pragma("unroll") for (int k = 0; k < 2; ++k) dst[n][k] = *(const PG8_LAS bf16x8*)(lds + PG8_SB(b, h) + boff + n * 2048 + k * 1024); } while (0)
#define PG8_MMA(ai, bj, At, Bt) do { __builtin_amdgcn_s_setprio(1); _Pragma("unroll") for (int m = 0; m < 4; ++m) _Pragma("unroll") for (int n = 0; n < 2; ++n) _Pragma("unroll") for (int k = 0; k < 2; ++k) \
        acc[ai][bj][m][n] = __builtin_amdgcn_mfma_f32_16x16x32_bf16(Bt[n][k], At[m][k], acc[ai][bj][m][n], 0, 0, 0); __builtin_amdgcn_s_setprio(0); } while (0)
#define PG8_WAIT_V(n) asm volatile("s_waitcnt vmcnt(" #n ")" ::: "memory")
#define PG8_WAIT_L(n) asm volatile("s_waitcnt lgkmcnt(" #n ")" ::: "memory")
#define PG8_BAR __builtin_amdgcn_s_barrier()
#define PG8_SCHED __builtin_amdgcn_sched_barrier(0)
    Unit cur, nxt; int ui = 0;
    if (!S.next(0, cur)) return;
    f32x4 acc[2][2][4][2];
#pragma unroll
    for (int a = 0; a < 2; ++a)
#pragma unroll
        for (int b = 0; b < 2; ++b)
#pragma unroll
            for (int m = 0; m < 4; ++m)
#pragma unroll
                for (int n = 0; n < 2; ++n) acc[a][b][m][n] = (f32x4){0.f, 0.f, 0.f, 0.f};
    bf16x8 At[4][2], B0[2][2], B1[2][2];
    const char* cA = (const char*)(cur.sel ? g.A1 : g.A) + (size_t)cur.pm * tstep; const char* cB = (const char*)(cur.sel ? g.Bt1 : g.Bt) + (size_t)cur.pn * tstep;
    S.a_ready(cur);
    if constexpr (SP2) {
        PG8_STAGE(PG8_SB(0, 0), cB, voffB); PG8_STAGE(PG8_SB(0, 1), cB + hstep, voffB); PG8_STAGE(PG8_SA(0, 0), cA, voffA); PG8_STAGE(PG8_SA(0, 1), cA + hstep, voffA);
        if (wr == 1) PG8_BAR;
        PG8_WAIT_V(2); PG8_BAR;
        PG8_STAGE(PG8_SB(1, 0), cB + kstep, voffB); PG8_STAGE(PG8_SA(1, 0), cA + kstep, voffA); PG8_STAGE(PG8_SB(1, 1), cB + hstep + kstep, voffB);
        PG8_WAIT_V(6); PG8_BAR;
    } else {
        PG8_STAGE(PG8_SB(0, 0), cB, voffB); PG8_STAGE(PG8_SA(0, 0), cA, voffA); PG8_STAGE(PG8_SB(0, 1), cB + hstep, voffB); PG8_STAGE(PG8_SA(0, 1), cA + hstep, voffA);
        if (wr == 1) PG8_BAR;
        PG8_WAIT_V(4); PG8_BAR;
        PG8_STAGE(PG8_SB(1, 0), cB + kstep, voffB); PG8_STAGE(PG8_SA(1, 0), cA + kstep, voffA); PG8_STAGE(PG8_SB(1, 1), cB + hstep + kstep, voffB);
        PG8_WAIT_V(6); PG8_BAR;
    }
    for (;;) {
        const bool has_next = S.next(ui + 1, nxt);
        const char* nA = has_next ? (const char*)(nxt.sel ? g.A1 : g.A) + (size_t)nxt.pm * tstep : cA; const char* nB = has_next ? (const char*)(nxt.sel ? g.Bt1 : g.Bt) + (size_t)nxt.pn * tstep : cB;
        for (int t = 0; t < nt; t += 2) {
            const bool last = (t == nt - 2);
            const char* a1 = cA + (size_t)(t + 1) * kstep;
            const char* a2 = last ? nA : cA + (size_t)(t + 2) * kstep; const char* b2 = last ? nB : cB + (size_t)(t + 2) * kstep;
            const char* a3 = a2 + kstep; const char* b3 = b2 + kstep;
            if (last && has_next) S.a_ready(nxt);
            if constexpr (SP2) {
            PG8_LDB(B0, 0, 0); PG8_LDB(B1, 0, 1); PG8_SCHED; PG8_LDA(At, 0, 0); PG8_STAGE(PG8_SA(1, 1), a1 + hstep, voffA);
            PG8_WAIT_V(8); PG8_WAIT_L(0); PG8_BAR; PG8_MMA(0, 0, At, B0); PG8_MMA(0, 1, At, B1); PG8_BAR; PG8_SCHED;
            PG8_LDA(At, 0, 1); PG8_STAGE(PG8_SB(0, 0), b2, voffB); PG8_STAGE(PG8_SB(0, 1), b2 + hstep, voffB); PG8_STAGE(PG8_SA(0, 0), a2, voffA);
            PG8_WAIT_V(8); PG8_WAIT_L(0); PG8_BAR; PG8_MMA(1, 0, At, B0); PG8_MMA(1, 1, At, B1); PG8_BAR; PG8_SCHED;
            PG8_LDB(B0, 1, 0); PG8_LDB(B1, 1, 1); PG8_SCHED; PG8_LDA(At, 1, 0); PG8_STAGE(PG8_SA(0, 1), a2 + hstep, voffA);
            PG8_WAIT_V(8); PG8_WAIT_L(0); PG8_BAR; PG8_MMA(0, 0, At, B0); PG8_MMA(0, 1, At, B1); PG8_BAR; PG8_SCHED;
            PG8_LDA(At, 1, 1); PG8_STAGE(PG8_SB(1, 0), b3, voffB); PG8_STAGE(PG8_SB(1, 1), b3 + hstep, voffB); PG8_STAGE(PG8_SA(1, 0), a3, voffA);
            PG8_WAIT_V(8); PG8_WAIT_L(0); PG8_BAR; PG8_MMA(1, 0, At, B0); PG8_MMA(1, 1, At, B1); PG8_BAR; PG8_SCHED;
            } else {
            PG8_LDB(B0, 0, 0); PG8_SCHED; PG8_LDA(At, 0, 0); PG8_STAGE(PG8_SA(1, 1), a1 + hstep, voffA);
            PG8_WAIT_L(8); PG8_BAR; PG8_WAIT_L(0); PG8_MMA(0, 0, At, B0); PG8_BAR; PG8_SCHED;
            PG8_LDB(B1, 0, 1); PG8_STAGE(PG8_SB(0, 0), b2, voffB);
            PG8_BAR; PG8_WAIT_L(0); PG8_MMA(0, 1, At, B1); PG8_BAR;
            PG8_LDA(At, 0, 1); PG8_STAGE(PG8_SA(0, 0), a2, voffA);
            PG8_BAR; PG8_WAIT_L(0); PG8_MMA(1, 0, At, B0); PG8_BAR; PG8_SCHED;
            PG8_STAGE(PG8_SB(0, 1), b2 + hstep, voffB);
            PG8_WAIT_V(6); PG8_BAR; PG8_MMA(1, 1, At, B1); PG8_BAR;
            PG8_LDB(B0, 1, 0); PG8_SCHED; PG8_LDA(At, 1, 0); PG8_STAGE(PG8_SA(0, 1), a2 + hstep, voffA);
            PG8_WAIT_L(8); PG8_BAR; PG8_WAIT_L(0); PG8_MMA(0, 0, At, B0); PG8_BAR; PG8_SCHED;
            PG8_LDB(B1, 1, 1); PG8_STAGE(PG8_SB(1, 0), b3, voffB);
            PG8_BAR; PG8_WAIT_L(0); PG8_MMA(0, 1, At, B1); PG8_BAR;
            PG8_LDA(At, 1, 1); PG8_STAGE(PG8_SA(1, 0), a3, voffA);
            PG8_BAR; PG8_WAIT_L(0); PG8_MMA(1, 0, At, B0); PG8_BAR; PG8_SCHED;
            PG8_STAGE(PG8_SB(1, 1), b3 + hstep, voffB);
            PG8_WAIT_V(6); PG8_BAR; PG8_MMA(1, 1, At, B1); PG8_BAR;
            }
        }
        if constexpr (ALIGN_EPI) { if (wr == 0) PG8_BAR; }
        if constexpr (!Epi::AFTER_DRAIN) { E(acc, cur, wr, wc, fr, fq); S.done(cur); }
        if (!has_next) break;
        if (!E.keep(cur)) zero_acc(acc);
        cur = nxt; cA = nA; cB = nB; ++ui;
        if constexpr (ALIGN_EPI) { if (wr == 1) PG8_BAR; }
    }
    PG8_WAIT_V(0);
    if constexpr (!ALIGN_EPI) { if (wr == 0) PG8_BAR; }
    PG8_BAR;
    if constexpr (Epi::AFTER_DRAIN) { E.fused(acc, cur, wr, wc, fr, fq, lds, wid, lane); S.done(cur); }
#undef PG8_SA
#undef PG8_SB
#undef PG8_STAGE
#undef PG8_LDA
#undef PG8_LDB
#undef PG8_MMA
#undef PG8_WAIT_V
#undef PG8_WAIT_L
#undef PG8_BAR
#undef PG8_SCHED
}}

constexpr int NWAVES = 8;
constexpr int DM = 1024, MTOK = 32768, TP = 16384  , LP = 2048, LS = 16384;
constexpr int HW = 512, INW = 4352, FFN = 2816, NPROJ = INW - 3 * HW  ;
constexpr float RMS_EPS = 1e-6f;

constexpr size_t MiB = 1u << 20;
constexpr size_t WS_CTL = 0, CTL_ZERO_BYTES = 128 * 1024;
constexpr size_t WS_WINA = 1 * MiB;
constexpr size_t WS_WINB = 4 * MiB;
constexpr size_t WS_WHY = 10 * MiB;
constexpr size_t WS_WAT = 11 * MiB;
constexpr size_t WS_WO = 12 * MiB;
constexpr size_t WS_WGU = 14 * MiB;
constexpr size_t WS_WD = 25 * MiB;
constexpr size_t WS_W3T = 31 * MiB;
constexpr size_t WS_XB = 32 * MiB;
constexpr size_t WS_YT = 32 * MiB;
constexpr size_t WS_YAT = 64 * MiB;
constexpr size_t WS_KREV_S = 96 * MiB;
constexpr size_t WS_KREV_P = 160 * MiB;
constexpr size_t WS_UT = 168 * MiB;
constexpr size_t WS_Q = 264 * MiB;
constexpr size_t WS_K = 296 * MiB;
constexpr size_t WS_V = 304 * MiB;
constexpr size_t WS_SGH = 312 * MiB;
constexpr size_t WS_SGA = 376 * MiB;
constexpr size_t WS_COS = 440 * MiB;
constexpr size_t WS_SIN = 442 * MiB;
constexpr size_t WS_RSTD = 444 * MiB;
constexpr size_t WS_SSQ = 445 * MiB;
constexpr size_t WS_FPART_S = 447 * MiB;
constexpr size_t WS_FPART_P = 449 * MiB;
constexpr size_t WS_YHY = 450 * MiB;
constexpr size_t WS_MERGED = 168 * MiB;
constexpr size_t WS_X1B = 232 * MiB;
constexpr size_t WS_HID = 32 * MiB;
constexpr size_t WS_HS = 450 * MiB;
constexpr size_t WS_Z1S = 488 * MiB;
constexpr size_t WS_END = 504 * MiB;
static_assert(WS_HID + (size_t)MTOK * FFN * 2 <= WS_X1B, "hid vs x1b");

constexpr int CW_TMO = 0, CW_CODE = 1;
constexpr int CW_BAR = 4096;

constexpr int RING_OFF = 0;
constexpr int LDS_BYTES = 147456;
constexpr int LDSCTL_OFF = LDS_BYTES - 512, MISC_OFF = LDSCTL_OFF + 320;

#define GAS __attribute__((address_space(1)))
#define LAS __attribute__((address_space(3)))
typedef unsigned short bf16;
typedef unsigned v4u __attribute__((ext_vector_type(4)));
typedef unsigned v2u __attribute__((ext_vector_type(2)));
typedef float f32x4 __attribute__((ext_vector_type(4)));
typedef float f32x16 __attribute__((ext_vector_type(16)));
typedef short bf16x8 __attribute__((ext_vector_type(8)));
typedef GAS unsigned gu32;
#define RLX_AGENT __ATOMIC_RELAXED, __HIP_MEMORY_SCOPE_AGENT
#define LDS_WAIT() asm volatile("s_waitcnt lgkmcnt(0)" ::: "memory")
#define VM_WAIT() asm volatile("s_waitcnt vmcnt(0)" ::: "memory")
typedef float f32x2_t_ __attribute__((ext_vector_type(2))); typedef __bf16 bf16x2_t_ __attribute__((ext_vector_type(2)));
__device__ __forceinline__ unsigned pk2(float lo, float hi) { const f32x2_t_ v = {lo, hi}; return __builtin_bit_cast(unsigned, __builtin_convertvector(v, bf16x2_t_)); }
__device__ __forceinline__ unsigned f2bf(float f) { return (unsigned)__builtin_bit_cast(unsigned short, (__bf16)f); }
__device__ __forceinline__ float bf2f(unsigned short b) { return __uint_as_float((unsigned)b << 16); }
__device__ __forceinline__ float wave_sum(float v) {
#pragma unroll
    for (int o = 1; o < 64; o <<= 1) v += __shfl_xor(v, o);
    return v;
}

__device__ __forceinline__ int fresh_lane() { unsigned m = ~0u; asm volatile("" : "+s"(m)); return (int)__builtin_amdgcn_mbcnt_hi(m, __builtin_amdgcn_mbcnt_lo(m, 0u)); }
__device__ __forceinline__ int fresh_tid(int wave) { return wave * 64 + fresh_lane(); }

__device__ __forceinline__ float wave_sum_sw(float v) {
#define SWZ_(x, m) __builtin_bit_cast(float, __builtin_amdgcn_ds_swizzle(__builtin_bit_cast(int, (x)), (((m) << 10) | 0x1f)))
    v += SWZ_(v, 1); v += SWZ_(v, 2); v += SWZ_(v, 4); v += SWZ_(v, 8); v += SWZ_(v, 16);
#undef SWZ_
    return __builtin_bit_cast(float, __builtin_amdgcn_readlane(__builtin_bit_cast(int, v), 0)) + __builtin_bit_cast(float, __builtin_amdgcn_readlane(__builtin_bit_cast(int, v), 32));
}

#define XB_TMO      128
#define XB_XCNT(j)  (256  + 64 * (j))
#define XB_XSUB(j)  (1280 + 64 * (j))
#define XB_XGEN(j)  (2304 + 64 * (j))
#define XB_TOP      3328
#define XB_TOPGEN   3392
#define XCD_BAR_WORDS 3456
#define XB_SPIN_CAP (1u << 18)

__device__ __forceinline__ unsigned xb_ld(unsigned* p)              { return __hip_atomic_load(p, __ATOMIC_RELAXED, __HIP_MEMORY_SCOPE_AGENT); }
__device__ __forceinline__ unsigned xb_add(unsigned* p, unsigned v) { return __hip_atomic_fetch_add(p, v, __ATOMIC_RELAXED, __HIP_MEMORY_SCOPE_AGENT); }
__device__ __forceinline__ unsigned xb_xcc_id() { return (unsigned)__builtin_amdgcn_s_getreg((3 << 11) | 20) & 0xFu; }
#define XB_SPIN(cond, bar) do { unsigned _sp = 0; while (cond) { __builtin_amdgcn_s_sleep(1); \
    if ((++_sp & 255u) == 0u) { if (xb_ld(&(bar)[XB_TMO])) break; if (_sp > XB_SPIN_CAP) { atomicAdd(&(bar)[XB_TMO], 1u); break; } } } } while (0)

struct XcdBarrier { unsigned* bar; unsigned x; volatile LAS unsigned* st; int wave; };

__device__ __forceinline__ XcdBarrier xcd_barrier_post(unsigned* bar, volatile LAS unsigned* st, int wave) {
    XcdBarrier b; b.bar = bar; b.x = xb_xcc_id(); b.st = st; b.wave = wave;
    if (fresh_tid(wave) == 0) (void)xb_add(&bar[XB_XCNT(b.x)], 1u);
    return b;
}
__device__ __forceinline__ void xcd_barrier_complete(unsigned* bar, unsigned x, unsigned& nloc, unsigned& nx) {
    const unsigned G = gridDim.x * gridDim.y * gridDim.z;
    unsigned sum, cnt, mine, sp = 0u;
    for (;;) {
        sum = 0u; cnt = 0u; mine = 0u;
#pragma unroll
        for (unsigned j = 0; j < 16; ++j) { const unsigned c = xb_ld(&bar[XB_XCNT(j)]); sum += c; cnt += (c > 0u) ? 1u : 0u; mine = (j == x) ? c : mine; }
        if (sum == G) break;
        __builtin_amdgcn_s_sleep(1);
        if ((++sp & 255u) == 0u) { if (xb_ld(&bar[XB_TMO])) break; if (sp > XB_SPIN_CAP) { atomicAdd(&bar[XB_TMO], 1u); break; } }
    }
    nloc = mine > 0u ? mine : 1u; nx = cnt > 0u ? cnt : 1u;
}
__device__ __forceinline__ void xcd_barrier(const XcdBarrier& b) {
    asm volatile("s_waitcnt vmcnt(0)" ::: "memory");
    __syncthreads();
    if (fresh_tid(b.wave) == 0) {
        unsigned* bar = b.bar;
        __builtin_amdgcn_s_waitcnt(0);
        unsigned nloc = b.st[0], nx = b.st[1];
        if (nloc == 0u) { xcd_barrier_complete(bar, b.x, nloc, nx); b.st[0] = nloc; b.st[1] = nx; }
        const unsigned old = xb_add(&bar[XB_XSUB(b.x)], 1u);
        const unsigned gen = old / nloc;
        if (old + 1u == (gen + 1u) * nloc) {
            __builtin_amdgcn_fence(__ATOMIC_RELEASE, "agent");
            asm volatile("s_waitcnt vmcnt(0)" ::: "memory");
            const unsigned og = xb_add(&bar[XB_TOP], 1u);
            const unsigned tg = og / nx;
            if (og + 1u == (tg + 1u) * nx) xb_add(&bar[XB_TOPGEN], 1u);
            else XB_SPIN(xb_ld(&bar[XB_TOPGEN]) == tg, bar);
            __builtin_amdgcn_fence(__ATOMIC_ACQUIRE, "agent");
            xb_add(&bar[XB_XGEN(b.x)], 1u);
            asm volatile("s_waitcnt vmcnt(0)" ::: "memory");
        } else {
            XB_SPIN(xb_ld(&bar[XB_XGEN(b.x)]) == gen, bar);
            __builtin_amdgcn_fence(__ATOMIC_ACQUIRE, "agent");
            asm volatile("s_waitcnt vmcnt(0)" ::: "memory");
        }
    }
    __syncthreads();
}

struct Frame {
    LAS unsigned char* lds;
    volatile LAS unsigned* MISC;
    gu32* ctl;
    int tid, lane, wave;
    int vcu, G;
    unsigned char* ws;
};

__device__ __forceinline__ void p0_transpose_item(const float* W, int K, int N, bf16* WT, int dst_row0, const float* kscale, LAS float* scr, int k0, int n0, int lane) {
    float wv[32];
#pragma unroll
    for (int i = 0; i < 32; ++i) wv[i] = W[(size_t)(k0 + 2 * i + (lane >> 5)) * N + n0 + (lane & 31)];
    if (kscale) {
#pragma unroll
        for (int i = 0; i < 32; ++i) wv[i] *= kscale[k0 + 2 * i + (lane >> 5)];
    }
#pragma unroll
    for (int i = 0; i < 32; ++i) scr[(2 * i + (lane >> 5)) * 33 + (lane & 31)] = wv[i];
    LDS_WAIT(); asm volatile("" ::: "memory");
    const int c = lane & 7;
#pragma unroll
    for (int j = 0; j < 4; ++j) { const int n = (lane >> 3) + 8 * j; const LAS float* s = scr + (8 * c) * 33 + n;
        v4u o; o.x = pk2(s[0 * 33], s[1 * 33]); o.y = pk2(s[2 * 33], s[3 * 33]); o.z = pk2(s[4 * 33], s[5 * 33]); o.w = pk2(s[6 * 33], s[7 * 33]);
        *(GAS v4u*)(WT + (size_t)(dst_row0 + n) * K + k0 + 8 * c) = o; }
    LDS_WAIT(); asm volatile("" ::: "memory");
}
__device__ __forceinline__ int map_projB(int n0) {
    if (n0 < 2048) { const int t = n0 - 1536, hq = t >> 6, hf = (t >> 5) & 1; return 256 * (hq >> 2) + 128 * hf + 32 * (hq & 3); }
    if (n0 < 2176) { const int t = n0 - 2048, kh = t >> 6, hf = (t >> 5) & 1; return 512 + 128 * hf + 32 * kh; }
    if (n0 < 2304) { const int t = n0 - 2176, vh = t >> 6, hf = (t >> 5) & 1; return 512 + 128 * hf + 32 * (2 + vh); }
    return 768 + (n0 - 2304);
}
__device__ __forceinline__ void p0_row(const float* xrow, bf16* orow, float* rstd_out, int lane) {
    const GAS f32x4* xr = (const GAS f32x4*)xrow + lane;
    f32x4 v[4]; float s = 0.f;
#pragma unroll
    for (int j = 0; j < 4; ++j) { v[j] = xr[64 * j]; s += (v[j].x * v[j].x + v[j].y * v[j].y) + (v[j].z * v[j].z + v[j].w * v[j].w); }
    s = wave_sum(s);
    if (lane == 0) *rstd_out = 1.0f / sqrtf(s * (1.0f / DM) + RMS_EPS);
    GAS unsigned long long* o8 = (GAS unsigned long long*)orow + lane;
#pragma unroll
    for (int j = 0; j < 4; ++j) o8[64 * j] = (unsigned long long)pk2(v[j].x, v[j].y) | ((unsigned long long)pk2(v[j].z, v[j].w) << 32);
}
__device__ __forceinline__ void p0_row2(const float* xa, const float* xb_, bf16* oa, bf16* ob, float* ra, float* rb, int lane) {
    const GAS f32x4* pa = (const GAS f32x4*)xa + lane; const GAS f32x4* pb = (const GAS f32x4*)xb_ + lane;
    f32x4 va[4], vb[4]; float sa = 0.f, sb = 0.f;
#pragma unroll
    for (int j = 0; j < 4; ++j) { va[j] = pa[64 * j]; vb[j] = pb[64 * j]; }
#pragma unroll
    for (int j = 0; j < 4; ++j) { sa += (va[j].x * va[j].x + va[j].y * va[j].y) + (va[j].z * va[j].z + va[j].w * va[j].w); sb += (vb[j].x * vb[j].x + vb[j].y * vb[j].y) + (vb[j].z * vb[j].z + vb[j].w * vb[j].w); }
    sa = wave_sum(sa); sb = wave_sum(sb);
    if (lane == 0) { *ra = 1.0f / sqrtf(sa * (1.0f / DM) + RMS_EPS); *rb = 1.0f / sqrtf(sb * (1.0f / DM) + RMS_EPS); }
    GAS unsigned long long* o8a = (GAS unsigned long long*)oa + lane; GAS unsigned long long* o8b = (GAS unsigned long long*)ob + lane;
#pragma unroll
    for (int j = 0; j < 4; ++j) { o8a[64 * j] = (unsigned long long)pk2(va[j].x, va[j].y) | ((unsigned long long)pk2(va[j].z, va[j].w) << 32); o8b[64 * j] = (unsigned long long)pk2(vb[j].x, vb[j].y) | ((unsigned long long)pk2(vb[j].z, vb[j].w) << 32); }
}
constexpr int FW_W1 = 0, FW_W2 = 33 * 64 * 4, FW_B1 = FW_W2 + 64 * 64 * 4, FW_B2 = FW_B1 + 256, FW_FR = FW_B2 + 256, FW_END = FW_FR + 256, FT_PITCH = 144, FT_BYTES = 32 * FT_PITCH;
__device__ __forceinline__ void filter_stage_weights(LAS unsigned char* lds, const float* w1, const float* b1, const float* w2, const float* b2, const float* fr, int tid) {
    LAS float* W1 = (LAS float*)(lds + FW_W1); LAS float* W2 = (LAS float*)(lds + FW_W2);
    for (int i = tid; i < 33 * 64; i += NWAVES * 64) W1[i] = w1[i];
    for (int i = tid; i < 64 * 64; i += NWAVES * 64) W2[i] = w2[i];
    if (tid < 64) { ((LAS float*)(lds + FW_B1))[tid] = b1[tid]; ((LAS float*)(lds + FW_B2))[tid] = b2[tid]; ((LAS float*)(lds + FW_FR))[tid] = fr[tid]; }
    LDS_WAIT(); __syncthreads();
}
__device__ __forceinline__ void filter_mlp_half(LAS unsigned char* lds, int L, int chunk, int hf, int dir, int r, int h, LAS float* Hb, bf16x8 (&afr)[4]) {
    const LAS float* W1 = (const LAS float*)(lds + FW_W1); const LAS float* W2 = (const LAS float*)(lds + FW_W2);
    const LAS float* B1 = (const LAS float*)(lds + FW_B1); const LAS float* B2 = (const LAS float*)(lds + FW_B2); const LAS float* FR = (const LAS float*)(lds + FW_FR);
        int pos = 64 * chunk + 32 * hf + r + dir; if (pos > L - 1) pos = L - 1;
        const float t = (float)pos / (float)(L - 1);
        float a[32];
#pragma unroll
        for (int jj = 0; jj < 32; ++jj) a[jj] = B1[32 * h + jj];
        {
#pragma unroll
            for (int jj = 0; jj < 32; jj += 4) { const f32x4 w = *(const LAS f32x4*)(W1 + 32 * h + jj); a[jj] += t * w[0]; a[jj + 1] += t * w[1]; a[jj + 2] += t * w[2]; a[jj + 3] += t * w[3]; }
#pragma unroll 1
            for (int i = 0; i < 16; ++i) {
                const float band = 1e-4f + (float)i * ((15.0f - 1e-4f) / 15.0f); const float ang = (6.283185307179586f / (float)L) * (float)pos * band;
                const float cv = __cosf(ang), sv = -__sinf(ang);
                const LAS float* wc = W1 + (1 + i) * 64 + 32 * h; const LAS float* wsn = W1 + (17 + i) * 64 + 32 * h;
#pragma unroll
                for (int jj = 0; jj < 32; jj += 4) { const f32x4 w = *(const LAS f32x4*)(wc + jj), v = *(const LAS f32x4*)(wsn + jj);
                    a[jj] += cv * w[0] + sv * v[0]; a[jj + 1] += cv * w[1] + sv * v[1]; a[jj + 2] += cv * w[2] + sv * v[2]; a[jj + 3] += cv * w[3] + sv * v[3]; }
            }
        }
#pragma unroll
        for (int jj = 0; jj < 32; ++jj) Hb[(32 * h + jj) * 32 + r] = __sinf(FR[32 * h + jj] * a[jj]);
        LDS_WAIT(); asm volatile("" ::: "memory");
#pragma unroll
        for (int jj = 0; jj < 32; ++jj) a[jj] = B2[32 * h + jj];
#pragma unroll 1
        for (int i = 0; i < 64; ++i) { const float hv = Hb[i * 32 + r]; const LAS float* wr_ = W2 + i * 64 + 32 * h;
#pragma unroll
            for (int jj = 0; jj < 32; jj += 4) { const f32x4 w = *(const LAS f32x4*)(wr_ + jj); a[jj] += hv * w[0]; a[jj + 1] += hv * w[1]; a[jj + 2] += hv * w[2]; a[jj + 3] += hv * w[3]; } }
        LDS_WAIT(); asm volatile("" ::: "memory");
        unsigned op[16], pp[16];
#pragma unroll
        for (int d = 0; d < 16; ++d) op[d] = pk2(__sinf(FR[32 * h + 2 * d] * a[2 * d]), __sinf(FR[32 * h + 2 * d + 1] * a[2 * d + 1]));
#pragma unroll
        for (int d = 0; d < 16; ++d) pp[d] = __shfl_xor(op[d], 32);
#pragma unroll
        for (int ks = 0; ks < 4; ++ks) { v4u f;
#pragma unroll
            for (int w = 0; w < 4; ++w) { const unsigned own = h ? op[8 * (ks & 1) + 4 + w] : op[8 * (ks & 1) + w], par = h ? pp[8 * (ks & 1) + 4 + w] : pp[8 * (ks & 1) + w];
                f[w] = ((ks >> 1) == h) ? own : par; }
            afr[ks] = __builtin_bit_cast(bf16x8, f); }
}
__device__ __forceinline__ void filter_item(LAS unsigned char* lds, const bf16* w3T, bf16* krev, float* fpart, int g, int chunk, int dir, int wave, int lane_) {
    int lane = lane_; asm volatile("" : "+v"(lane));
    const int L = g ? LS : LP, r = lane & 31, h = lane >> 5;
    const LAS float* W1 = (const LAS float*)(lds + FW_W1); const LAS float* W2 = (const LAS float*)(lds + FW_W2);
    const LAS float* B1 = (const LAS float*)(lds + FW_B1); const LAS float* B2 = (const LAS float*)(lds + FW_B2); const LAS float* FR = (const LAS float*)(lds + FW_FR);
    LAS unsigned char* T = lds + FW_END + wave * FT_BYTES; LAS float* Hb = (LAS float*)(lds + FW_END + NWAVES * FT_BYTES + wave * 8192);
    bf16x8 afr0[4], afr1[4];
    filter_mlp_half(lds, L, chunk, 0, dir, r, h, Hb, afr0);
    filter_mlp_half(lds, L, chunk, 1, dir, r, h, Hb, afr1);
    const float dmin = -4.605170185988091f / 1.5f, dmax = -4.605170185988091f / 0.3f;
    const int p0 = 64 * chunk; const int mstart = g ? (dir ? (2 * L - p0 - 64) : p0) : (dir ? (L + p0) : (L - 64 - p0));
    for (int ti = 0; ti < 32; ++ti) {
        const int o_ = ti >> 4, cb = 32 * (ti & 15), colg = (2 * o_ + dir) * 512 + cb;
        bf16x8 bfr[4];
#pragma unroll
        for (int ks = 0; ks < 4; ++ks) bfr[ks] = *(const GAS bf16x8*)(w3T + (size_t)(colg + r) * 64 + 16 * ks + 8 * h);
        const float delta = fabsf(dmin + (float)(cb + r) * ((dmax - dmin) / 511.0f));
        float asum = 0.f;
#pragma unroll
        for (int hf = 0; hf < 2; ++hf) {
            f32x16 acc = (f32x16){0.f,0.f,0.f,0.f,0.f,0.f,0.f,0.f,0.f,0.f,0.f,0.f,0.f,0.f,0.f,0.f};
#pragma unroll
            for (int ks = 0; ks < 4; ++ks) acc = __builtin_amdgcn_mfma_f32_32x32x16_bf16(hf ? afr1[ks] : afr0[ks], bfr[ks], acc, 0, 0, 0);
#pragma unroll
            for (int rg = 0; rg < 16; ++rg) {
                const int i = 32 * hf + (rg & 3) + 8 * (rg >> 2) + 4 * h; const int pos = p0 + i + dir;
                const float t = (float)pos / (float)(L - 1);
                float kv = acc[rg] * (__expf(-t * delta) + 0.05f); if (pos > L - 1) kv = 0.f;
                asum += fabsf(kv);
                const int e = ((dir != 0) != (g != 0)) ? i : 63 - i;
                *(LAS bf16*)(T + r * FT_PITCH + e * 2) = (bf16)f2bf(kv);
            }
        }
        asum += __shfl_xor(asum, 32);
        if (h == 0) fpart[(size_t)chunk * 2048 + colg + r] = asum;
        LDS_WAIT(); asm volatile("" ::: "memory");
        {
            const int col = lane >> 1, hb = lane & 1;
            bf16* dst = krev + (size_t)(o_ * 512 + cb + col) * (2 * L) + mstart + 32 * hb;
            const LAS v4u* src = (const LAS v4u*)(T + col * FT_PITCH + 64 * hb);
#pragma unroll
            for (int q = 0; q < 4; ++q) *(GAS v4u*)(dst + 8 * q) = src[q];
        }
        LDS_WAIT(); asm volatile("" ::: "memory");
    }
}

namespace hy {
constexpr int SLOTB = 272, Z_BYTES = 75776, F_OFF = 75776, F_BYTES = 65536, RED_OFF = F_OFF + F_BYTES;
__device__ __forceinline__ int slot_of(int g, int n) { return g ? (n + 31) : ((n >> 4) * 32 + 16 + (n & 15)); }
__device__ __forceinline__ int crow(int r, int hi) { return (r & 3) + 8 * (r >> 2) + 4 * hi; }

struct Params { const bf16* uT; const bf16* krev_s; const bf16* krev_p; const float* fpart_s; const float* fpart_p; const float* conv_w; const float* conv_b; const float* hbias; bf16* yT; float* dF; bf16* dZ; };

__device__ __forceinline__ void conv3_chunk(const bf16* urow  , int g, int chunk, float w0, float w1, float w2, float b, float (&out)[8]) {
    const int tau0 = chunk * 8; const int L = g ? LS : LP; const int p0 = g ? tau0 : (tau0 & (LP - 1));
    const v4u raw = *(const GAS v4u*)(urow + tau0);
    float u[10];
    u[1] = pg8::bflo(raw.x); u[2] = pg8::bfhi(raw.x); u[3] = pg8::bflo(raw.y); u[4] = pg8::bfhi(raw.y); u[5] = pg8::bflo(raw.z); u[6] = pg8::bfhi(raw.z); u[7] = pg8::bflo(raw.w); u[8] = pg8::bfhi(raw.w);
    u[0] = (p0 > 0) ? bf2f(urow[tau0 - 1]) : 0.f;
    u[9] = (p0 + 8 < L) ? bf2f(urow[tau0 + 8]) : 0.f;
#pragma unroll
    for (int i = 0; i < 8; ++i) out[i] = w0 * u[i] + w1 * u[i + 1] + w2 * u[i + 2] + b;
}

struct C3 { v4u raw; float prev, next; };
__device__ __forceinline__ void conv3_load(const bf16* urow, int g, int chunk, C3& q) {
    const int tau0 = chunk * 8; const int L = g ? LS : LP; const int p0 = g ? tau0 : (tau0 & (LP - 1));
    q.raw = *(const GAS v4u*)(urow + tau0);
    q.prev = (p0 > 0) ? bf2f(urow[tau0 - 1]) : 0.f;
    q.next = (p0 + 8 < L) ? bf2f(urow[tau0 + 8]) : 0.f;
}
__device__ __forceinline__ void conv3_eval(const C3& q, float w0, float w1, float w2, float b, float (&out)[8]) {
    float u[10];
    u[0] = q.prev; u[9] = q.next;
    u[1] = pg8::bflo(q.raw.x); u[2] = pg8::bfhi(q.raw.x); u[3] = pg8::bflo(q.raw.y); u[4] = pg8::bfhi(q.raw.y); u[5] = pg8::bflo(q.raw.z); u[6] = pg8::bfhi(q.raw.z); u[7] = pg8::bflo(q.raw.w); u[8] = pg8::bfhi(q.raw.w);
#pragma unroll
    for (int i = 0; i < 8; ++i) out[i] = w0 * u[i] + w1 * u[i + 1] + w2 * u[i + 2] + b;
}

__device__ __forceinline__ bf16x8 load_afrag(LAS const unsigned char* lds, int addr, int sh) {
    const LAS unsigned* p = (const LAS unsigned*)(lds + addr);
    const unsigned w0 = p[0], w1 = p[1], w2 = p[2], w3 = p[3], w4 = p[4];
    v4u f; f.x = __builtin_amdgcn_alignbit(w1, w0, sh); f.y = __builtin_amdgcn_alignbit(w2, w1, sh); f.z = __builtin_amdgcn_alignbit(w3, w2, sh); f.w = __builtin_amdgcn_alignbit(w4, w3, sh);
    return __builtin_bit_cast(bf16x8, f);
}

__device__ __forceinline__ void hyena_item(LAS unsigned char* lds, const Params& P, int g, int c, int tid_) {
    int tid = tid_; asm volatile("" : "+v"(tid));
    const int lane = tid & 63, wave = __builtin_amdgcn_readfirstlane(tid >> 6), r = lane & 31, hi = lane >> 5, nt = wave & 3, half = wave >> 2;
    const int L = g ? LS : LP; const int T0 = g ? TP : 0;
#if PROBE >= 41 && PROBE <= 46
    unsigned long long tp_ = __builtin_amdgcn_s_memrealtime();
#define HY_SEC(k) do { const unsigned long long tn_ = __builtin_amdgcn_s_memrealtime(); if (blockIdx.x == 0 && tid == 0) ((volatile LAS unsigned*)(lds + MISC_OFF))[40 + (k)] += (unsigned)(tn_ - tp_); tp_ = tn_; } while (0)
#else
#define HY_SEC(k) do { } while (0)
#endif
    float inv_norm0, inv_norm1;
    {
        const int nchunk = g ? 256 : 32; const float* fp = P.fpart_s + (g ? (size_t)0 : (size_t)((WS_FPART_P - WS_FPART_S) / 4));
        float s0 = 0.f, s1 = 0.f;
        for (int idx = lane; idx < nchunk * 2; idx += 64) { const int ch = idx >> 1, dir = idx & 1; s0 += fp[(size_t)ch * 2048 + dir * 512 + c]; s1 += fp[(size_t)ch * 2048 + 1024 + dir * 512 + c]; }
        inv_norm0 = 1.0f / wave_sum_sw(s0); inv_norm1 = 1.0f / wave_sum_sw(s1);
        for (int i = tid; i < Z_BYTES / 16; i += NWAVES * 64) *(LAS v4u*)(lds + i * 16) = (v4u){0u, 0u, 0u, 0u};
        LDS_WAIT(); __syncthreads();
    }
    {
        const int ch = 2 * HW + c; const float w0 = P.conv_w[ch], w1 = P.conv_w[3 * HW + ch], w2 = P.conv_w[6 * HW + ch], b = P.conv_b[ch];
        const bf16* urow = P.uT + (size_t)ch * MTOK + T0;
        for (int it = 0; it < 4; ++it) { const int chunk = tid + it * 512; float o[8]; conv3_chunk(urow, g, chunk, w0, w1, w2, b, o);
            const int tau0 = chunk * 8; v4u pk; pk.x = pk2(o[0], o[1]); pk.y = pk2(o[2], o[3]); pk.z = pk2(o[4], o[5]); pk.w = pk2(o[6], o[7]);
            *(LAS v4u*)(lds + slot_of(g, tau0 >> 7) * SLOTB + (tau0 & 127) * 2) = pk; }
    }
    HY_SEC(0);
    int d_hi, d_lo;
    if (g) { if (half == 0) { d_hi = 32 * nt + 31; d_lo = 32 * nt - 48; } else { d_hi = 32 * nt - 49; d_lo = 32 * nt - 127; } }
    else   {
             const int dmax = 4 * nt + 3, dmin = 4 * nt - 15;
             if (half == 0) { d_hi = dmax; d_lo = dmax - 9; } else { d_hi = dmax - 10; d_lo = dmin; } }
    const int ncol = g ? (32 * nt + r) : (16 * (r >> 2) + 4 * nt + (r & 3));
    int abase = F_OFF + 2 * ((L - 1) - r + 8 * hi); const int sh = (abase & 2) ? 16 : 0; abase &= ~3;
    const int zb = slot_of(g, ncol) * SLOTB + 16 * hi;
    const int mi0 = 2 * half;

    for (int o = 0; o < 2; ++o) {
        {
            const bf16* ksrc = P.krev_s + (g ? (size_t)0 : (size_t)((WS_KREV_P - WS_KREV_S) / 2)) + (size_t)(o * HW + c) * (2 * L);
            const int n16 = (2 * L * 2) / 16;
            for (int i = tid; i < n16; i += NWAVES * 64) *(LAS v4u*)(lds + F_OFF + i * 16) = *(const GAS v4u*)(ksrc + i * 8);
        }
        LDS_WAIT(); __syncthreads();
        HY_SEC(1);
        f32x16 acc[4];
#pragma unroll
        for (int mi = 0; mi < 4; ++mi) acc[mi] = (f32x16){0.f,0.f,0.f,0.f,0.f,0.f,0.f,0.f,0.f,0.f,0.f,0.f,0.f,0.f,0.f,0.f};
        bf16x8 Fw[8];
        {
            const int q0 = -8 * d_hi;
#pragma unroll
            for (int s = 2; s < 8; ++s) Fw[s] = load_afrag(lds, abase + 32 * (q0 - 8 + s), sh);
            Fw[0] = Fw[2]; Fw[1] = Fw[3];
        }
        {
            unsigned ap = (unsigned)(uintptr_t)(lds + abase) + 32 * (-8 * d_hi), bp = (unsigned)(uintptr_t)(lds + zb) - d_hi * SLOTB;
            v2u n01, n23; unsigned n4; v4u zn;
            unsigned r0, r1, r2, r3, r4; v4u zf;
#define HY_LOADS(ADW, BOFF) asm volatile("ds_read2_b32 %0, %4 offset0:%c5 offset1:%c6\n\tds_read2_b32 %1, %4 offset0:%c7 offset1:%c8\n\tds_read_b32 %2, %4 offset:%c9\n\tds_read_b128 %3, %10 offset:%c11" \
                : "=&v"(n01), "=&v"(n23), "=&v"(n4), "=&v"(zn) : "v"(ap), "i"(ADW), "i"((ADW) + 1), "i"((ADW) + 2), "i"((ADW) + 3), "i"(((ADW) + 4) * 4), "v"(bp), "i"(BOFF))
#define HY_WAIT() do { asm volatile("s_waitcnt lgkmcnt(0)" : "+v"(n01), "+v"(n23), "+v"(n4), "+v"(zn), "+v"(acc[0]), "+v"(acc[1]), "+v"(acc[2]), "+v"(acc[3])); __builtin_amdgcn_sched_barrier(0); } while (0)
#define HY_TAKE() do { r0 = n01.x; r1 = n01.y; r2 = n23.x; r3 = n23.y; r4 = n4; zf = zn; } while (0)
#define HY_STEP(JK, ADW, BOFF) do { HY_LOADS(ADW, BOFF); __builtin_amdgcn_sched_barrier(0); \
                { v4u f; f.x = __builtin_amdgcn_alignbit(r1, r0, sh); f.y = __builtin_amdgcn_alignbit(r2, r1, sh); f.z = __builtin_amdgcn_alignbit(r3, r2, sh); f.w = __builtin_amdgcn_alignbit(r4, r3, sh); Fw[JK] = __builtin_bit_cast(bf16x8, f); } \
                { const bf16x8 zb_ = __builtin_bit_cast(bf16x8, zf); \
                  acc[0] = __builtin_amdgcn_mfma_f32_32x32x16_bf16(Fw[(JK) & 7], zb_, acc[0], 0, 0, 0); acc[1] = __builtin_amdgcn_mfma_f32_32x32x16_bf16(Fw[((JK) - 2) & 7], zb_, acc[1], 0, 0, 0); \
                  acc[2] = __builtin_amdgcn_mfma_f32_32x32x16_bf16(Fw[((JK) - 4) & 7], zb_, acc[2], 0, 0, 0); acc[3] = __builtin_amdgcn_mfma_f32_32x32x16_bf16(Fw[((JK) - 6) & 7], zb_, acc[3], 0, 0, 0); } \
                HY_WAIT(); HY_TAKE(); } while (0)
            HY_LOADS(0, 0); HY_WAIT(); HY_TAKE();
            for (int d = d_hi; d >= d_lo; --d) {
                HY_STEP(0, 8, 32); HY_STEP(1, 16, 64); HY_STEP(2, 24, 96); HY_STEP(3, 32, 128); HY_STEP(4, 40, 160); HY_STEP(5, 48, 192); HY_STEP(6, 56, 224); HY_STEP(7, 64, SLOTB);
                ap += 256; bp += SLOTB;
            }
#undef HY_LOADS
#undef HY_WAIT
#undef HY_TAKE
#undef HY_STEP
        }
        LDS_WAIT(); __syncthreads();
        HY_SEC(2);
        {
            LAS float* X = (LAS float*)(lds + F_OFF) + wave * 2048;
#pragma unroll
            for (int t = 0; t < 2; ++t)
#pragma unroll
                for (int rg = 0; rg < 16; ++rg) X[(t * 16 + rg) * 64 + lane] = (half == 0) ? acc[2 + t][rg] : acc[t][rg];
        }
        LDS_WAIT(); __syncthreads();
        f32x16 fin[2];
        {
            const LAS float* X = (const LAS float*)(lds + F_OFF) + (wave ^ 4) * 2048;
#pragma unroll
            for (int t = 0; t < 2; ++t)
#pragma unroll
                for (int rg = 0; rg < 16; ++rg) fin[t][rg] = ((half == 0) ? acc[t][rg] : acc[2 + t][rg]) + X[(t * 16 + rg) * 64 + lane];
        }
        LDS_WAIT(); __syncthreads();
        HY_SEC(3);
        {
            const int ch = o * HW + c; const float w0 = P.conv_w[ch], w1 = P.conv_w[3 * HW + ch], w2 = P.conv_w[6 * HW + ch], b = P.conv_b[ch];
            const bf16* urow = P.uT + (size_t)ch * MTOK + T0;
            for (int it = 0; it < 4; ++it) { const int chunk = tid + it * 512; float v[8]; conv3_chunk(urow, g, chunk, w0, w1, w2, b, v);
                LAS f32x4* dst = (LAS f32x4*)(lds + F_OFF + chunk * 32 + (chunk >> 4) * 16); dst[0] = (f32x4){v[0], v[1], v[2], v[3]}; dst[1] = (f32x4){v[4], v[5], v[6], v[7]}; }
        }
        LDS_WAIT(); __syncthreads();
        HY_SEC(4);
        {
            const float sb = P.hbias[o * HW + c], inr = o ? inv_norm1 : inv_norm0;
            const LAS float* G = (const LAS float*)(lds + F_OFF);
            const int n = ncol; LAS bf16* zs = (LAS bf16*)(lds + slot_of(g, n) * SLOTB);
#pragma unroll
            for (int t = 0; t < 2; ++t)
#pragma unroll
                for (int rg = 0; rg < 16; ++rg) { const int i = 32 * (mi0 + t) + crow(rg, hi);
                    const float zo = bf2f(zs[i]);
#if PROBE >= 100
                    if (c == 137) { P.dF[(g * 2 + o) * 16384 + 128 * n + i] = fin[t][rg]; P.dZ[(g * 2 + o) * 16384 + 128 * n + i] = zs[i]; }
#endif
                    const float val = G[132 * n + i] * (inr * fin[t][rg] + sb * zo); zs[i] = (bf16)f2bf(val); }
        }
        LDS_WAIT(); __syncthreads();
    }
    HY_SEC(5);
    {
        bf16* yrow = P.yT + (size_t)c * MTOK + T0;
        for (int it = 0; it < 4; ++it) { const int chunk = tid + it * 512, tau0 = chunk * 8;
            *(GAS v4u*)(yrow + tau0) = *(const LAS v4u*)(lds + slot_of(g, tau0 >> 7) * SLOTB + (tau0 & 127) * 2); }
    }
    LDS_WAIT(); __syncthreads();
}
}

namespace fc {
constexpr int OST = 1032, PLANE_B = 32 * OST * 2  , RE_OFF = 0, IM_OFF = PLANE_B, RED_OFF = 2 * PLANE_B, T3_OFF = RED_OFF + 64;
constexpr int NFFT = 32768;
enum { F1 = 0, F2 = 1, F3 = 2, I1 = 3, I2 = 4, I3 = 5 };
__device__ __forceinline__ int crow(int r, int hi) { return (r & 3) + 8 * (r >> 2) + 4 * hi; }
__device__ __forceinline__ int sw(int mid) { return 0; }
struct Params { const bf16* uT; const bf16* kc; const float* fpart_s; const float* conv_w; const float* conv_b; const float* hbias; bf16* yT; bf16* hs; bf16* z1s; float* dF; bf16* dZ; };
typedef float f32x2_ __attribute__((ext_vector_type(2)));
struct FMat { bf16x8 fr[2], fi[2], nfi[2]; };

__device__ __forceinline__ void make_fmat(FMat& M, int r, int h) {
#pragma unroll
    for (int ks = 0; ks < 2; ++ks) { v4u a, b, c;
#pragma unroll
        for (int w = 0; w < 4; ++w) { float cv[2], sv[2];
#pragma unroll
            for (int e = 0; e < 2; ++e) { const int aidx = 16 * ks + 8 * h + 2 * w + e; const float fr_ = (float)((aidx * r) & 31) * (1.0f / 32.0f); cv[e] = __builtin_amdgcn_cosf(fr_); sv[e] = __builtin_amdgcn_sinf(fr_); }
            a[w] = pk2(cv[0], cv[1]); b[w] = pk2(-sv[0], -sv[1]); c[w] = pk2(sv[0], sv[1]); }
        M.fr[ks] = __builtin_bit_cast(bf16x8, a); M.fi[ks] = __builtin_bit_cast(bf16x8, b); M.nfi[ks] = __builtin_bit_cast(bf16x8, c); }
}

template <int ST, bool REAL_IN, bool HALF_K>
__device__ __forceinline__ void stage(LAS unsigned char* lds, const FMat& M, int wave, int r_, int h_) {
    int r = r_, h = h_; asm volatile("" : "+v"(r), "+v"(h));
    float t2c[16], t2s[16];
    if (ST == F1 || ST == F2 || ST == I1 || ST == I2) {
#pragma unroll
        for (int rg = 0; rg < 16; ++rg) { const int rho = (rg & 3) + 8 * (rg >> 2) + 4 * h; const float fr_ = (float)(r * rho) * (1.0f / 1024.0f); t2c[rg] = __builtin_amdgcn_cosf(fr_); t2s[rg] = __builtin_amdgcn_sinf(fr_); }
    }
    constexpr bool INV = (ST >= I1);
    const f32x16 zero16 = (f32x16){0.f,0.f,0.f,0.f,0.f,0.f,0.f,0.f,0.f,0.f,0.f,0.f,0.f,0.f,0.f,0.f};
    unsigned res[4][16];
#pragma unroll
    for (int t = 0; t < 4; ++t) {
        const int f = 4 * wave + t;
        const int base = (ST == I2) ? (32 * f + OST * r) : (32 * r + OST * f); const int swr = (ST == I2) ? sw(f) : sw(r);
        f32x16 ur = zero16, ui = zero16;
#pragma unroll
        for (int ks = 0; ks < (HALF_K ? 1 : 2); ++ks) {
            const bf16x8 xr = *(const LAS bf16x8*)(lds + RE_OFF + 2 * (base + ((16 * ks + 8 * h) ^ swr)));
            if (!INV) {
                ur = __builtin_amdgcn_mfma_f32_32x32x16_bf16(M.fr[ks], xr, ur, 0, 0, 0);
                ui = __builtin_amdgcn_mfma_f32_32x32x16_bf16(M.fi[ks], xr, ui, 0, 0, 0);
                if (!REAL_IN) { const bf16x8 xi = *(const LAS bf16x8*)(lds + IM_OFF + 2 * (base + ((16 * ks + 8 * h) ^ swr)));
                    ur = __builtin_amdgcn_mfma_f32_32x32x16_bf16(M.nfi[ks], xi, ur, 0, 0, 0);
                    ui = __builtin_amdgcn_mfma_f32_32x32x16_bf16(M.fr[ks], xi, ui, 0, 0, 0); }
            } else {
                const bf16x8 xi = *(const LAS bf16x8*)(lds + IM_OFF + 2 * (base + ((16 * ks + 8 * h) ^ swr)));
                ur = __builtin_amdgcn_mfma_f32_32x32x16_bf16(M.fr[ks], xr, ur, 0, 0, 0);
                ur = __builtin_amdgcn_mfma_f32_32x32x16_bf16(M.fi[ks], xi, ur, 0, 0, 0);
                ui = __builtin_amdgcn_mfma_f32_32x32x16_bf16(M.fr[ks], xi, ui, 0, 0, 0);
                ui = __builtin_amdgcn_mfma_f32_32x32x16_bf16(M.nfi[ks], xr, ui, 0, 0, 0);
            }
        }
        if (ST == I3) {
#pragma unroll
            for (int rg = 0; rg < 8; ++rg) { res[t][rg] = __float_as_uint(ur[rg]); res[t][8 + rg] = __float_as_uint(ui[rg]); }
        } else {
            if (ST == F1 || ST == F2 || ST == I1 || ST == I2) {
                float uc = 1.f, us = 0.f;
                if (ST == I2) { const float fr_ = (float)(f * r) * (1.0f / 32768.0f); uc = __builtin_amdgcn_cosf(fr_); us = __builtin_amdgcn_sinf(fr_); }
#pragma unroll
                for (int rg = 0; rg < 16; ++rg) {
                    float c = t2c[rg], s_ = t2s[rg];
                    if (ST == F1) { const int rho = (rg & 3) + 8 * (rg >> 2) + 4 * h; const f32x2_ q = *(const LAS f32x2_*)(lds + T3_OFF + 8 * (32 * f + rho)); const float c2 = c * q.x - s_ * q.y; s_ = c * q.y + s_ * q.x; c = c2; }
                    if (ST == I2) { const float c2 = c * uc - s_ * us; s_ = c * us + s_ * uc; c = c2; }
                    const float s = INV ? s_ : -s_;
                    const float a = ur[rg], b = ui[rg];
                    ur[rg] = a * c - b * s; ui[rg] = a * s + b * c;
                }
            }
#pragma unroll
            for (int p = 0; p < 8; ++p) { res[t][p] = pk2(ur[2 * p], ur[2 * p + 1]); res[t][8 + p] = pk2(ui[2 * p], ui[2 * p + 1]); }
        }
        __builtin_amdgcn_sched_barrier(0);
    }
    LDS_WAIT(); __syncthreads();
#pragma unroll
    for (int t = 0; t < 4; ++t) {
        const int f = 4 * wave + t;
        if (ST == I3) {
            LAS float* Y1 = (LAS float*)(lds + RE_OFF); LAS float* Y2 = (LAS float*)(lds + IM_OFF);
#pragma unroll
            for (int rg = 0; rg < 8; ++rg) { const int rho = (rg & 3) + 8 * (rg >> 2) + 4 * h; Y1[516 * f + 32 * rho + r] = __uint_as_float(res[t][rg]); Y2[516 * f + 32 * rho + r] = __uint_as_float(res[t][8 + rg]); }
        } else if (ST == F3) {
#pragma unroll
            for (int g4 = 0; g4 < 4; ++g4) { const int pos = ((8 * g4 + 4 * h) ^ sw(r)) + 32 * r + OST * f;
                *(LAS v2u*)(lds + RE_OFF + 2 * pos) = (v2u){res[t][2 * g4], res[t][2 * g4 + 1]}; *(LAS v2u*)(lds + IM_OFF + 2 * pos) = (v2u){res[t][8 + 2 * g4], res[t][8 + 2 * g4 + 1]}; }
        } else {
            const int odd = r & 1; const unsigned sel = odd ? 0x03020706u : 0x05040100u;
            const int rs_ = (ST == F1) ? OST : 32;
            const int lb = ((r & ~1) + odd * rs_ + ((ST == F1) ? 32 * f : OST * f) + rs_ * 4 * h) * 2;
#pragma unroll
            for (int p = 0; p < 8; ++p) {
                const int rho0 = ((2 * p) & 3) + 8 * ((2 * p) >> 2);
                const unsigned wr_ = res[t][p], wi_ = res[t][8 + p];
                const unsigned vr_ = (unsigned)__builtin_amdgcn_mov_dpp((int)wr_, 0xB1, 0xF, 0xF, true), vi_ = (unsigned)__builtin_amdgcn_mov_dpp((int)wi_, 0xB1, 0xF, 0xF, true);
                *(LAS unsigned*)(lds + RE_OFF + lb + 2 * rs_ * rho0) = __builtin_amdgcn_perm(vr_, wr_, sel);
                *(LAS unsigned*)(lds + IM_OFF + lb + 2 * rs_ * rho0) = __builtin_amdgcn_perm(vi_, wi_, sel);
            }
        }
    }
    LDS_WAIT(); __syncthreads();
}

__device__ __forceinline__ void self_visible(int tid) {
    VM_WAIT(); __syncthreads();
    if (tid == 0) { __builtin_amdgcn_fence(__ATOMIC_ACQUIRE, "agent"); VM_WAIT(); }
    __syncthreads();
}

__device__ __forceinline__ void prod_elem(float xr, float xi, float pr, float pi, float gr, float gi, float qr, float qi, float& ar, float& ai, float& br, float& bi) {
    const float sc = 0.25f / 32768.0f;
    const float Ar = xr + pr, Ai = xi - pi, Br = xi + pi, Bi = pr - xr;
    const float Hr = gr + qr, Hi = gi - qi, Kr = gi + qi, Ki = qr - gr;
    const float v1r = (Ar * Hr - Ai * Hi) * sc, v1i = (Ar * Hi + Ai * Hr) * sc, v2r = (Br * Kr - Bi * Ki) * sc, v2i = (Br * Ki + Bi * Kr) * sc;
    ar = v1r - v2i; ai = v1i + v2r; br = v1r + v2i; bi = v2r - v1i;
}
__device__ __forceinline__ void item_pair(LAS unsigned char* lds, const Params& P, int cp, int tid_, int slot) {
    int tid = tid_; asm volatile("" : "+v"(tid));
    const int wave = __builtin_amdgcn_readfirstlane(tid >> 6);
    constexpr int L = LS, T0 = TP, g = 1;
    const int ca = 2 * cp, cb = 2 * cp + 1;
    bf16* hs = P.hs + (size_t)slot * (2 * PLANE_B / 2); bf16* z1s = P.z1s + (size_t)slot * (2 * L);
    FMat M; { const int r = tid & 31, h = (tid >> 5) & 1; make_fmat(M, r, h); }
    for (int i = tid; i < 1024; i += NWAVES * 64) { const float fr_ = (float)((i >> 5) * (i & 31)) * (1.0f / 32768.0f); *(LAS f32x2_*)(lds + T3_OFF + 8 * i) = (f32x2_){__builtin_amdgcn_cosf(fr_), __builtin_amdgcn_sinf(fr_)}; }
    LDS_WAIT(); __syncthreads();
    for (int o = 0; o < 2; ++o) {
        asm volatile("" : "+v"(tid));
        const int lane = tid & 63, r = lane & 31, h = lane >> 5;
#pragma unroll 1
        for (int pl = 0; pl < 2; ++pl) {
            const bf16* ksrc = P.kc + (size_t)(o * HW + (pl ? cb : ca)) * NFFT; const int poff = pl ? IM_OFF : RE_OFF;
            v4u raw[8];
#pragma unroll
            for (int i = 0; i < 8; ++i) { const int it = 8 * wave + i, n = 1024 * (lane & 31) + 32 * (2 * (it >> 2) + (lane >> 5)) + 8 * (it & 3); raw[i] = *(const GAS v4u*)(ksrc + n); }
#pragma unroll
            for (int i = 0; i < 8; ++i) { const int it = 8 * wave + i, n = 1024 * (lane & 31) + 32 * (2 * (it >> 2) + (lane >> 5)) + 8 * (it & 3);
                const int pos0 = (n >> 10) + 32 * ((n >> 5) & 31) + OST * (n & 31); LAS bf16* d = (LAS bf16*)(lds + poff) + pos0;
                d[0 * OST] = (bf16)(raw[i].x & 0xffffu); d[1 * OST] = (bf16)(raw[i].x >> 16); d[2 * OST] = (bf16)(raw[i].y & 0xffffu); d[3 * OST] = (bf16)(raw[i].y >> 16);
                d[4 * OST] = (bf16)(raw[i].z & 0xffffu); d[5 * OST] = (bf16)(raw[i].z >> 16); d[6 * OST] = (bf16)(raw[i].w & 0xffffu); d[7 * OST] = (bf16)(raw[i].w >> 16); }
        }
        LDS_WAIT(); __syncthreads();
        stage<F1, false, false>(lds, M, wave, r, h); stage<F2, false, false>(lds, M, wave, r, h); stage<F3, false, false>(lds, M, wave, r, h);
        for (int i = tid; i < 2 * PLANE_B / 16; i += NWAVES * 64) *(GAS v4u*)((unsigned char*)hs + (size_t)i * 16) = *(const LAS v4u*)(lds + i * 16);
        self_visible(tid);
#pragma unroll 1
        for (int pl = 0; pl < 2; ++pl) {
            const int ch = 2 * HW + (pl ? cb : ca); const float w0 = P.conv_w[ch], w1 = P.conv_w[3 * HW + ch], w2 = P.conv_w[6 * HW + ch], b = P.conv_b[ch];
            const bf16* urow = P.uT + (size_t)ch * MTOK + T0; const bf16* zsrc = z1s + pl * L; const int poff = pl ? IM_OFF : RE_OFF;
            hy::C3 q3[4]; v4u rz[4];
#pragma unroll
            for (int i = 0; i < 4; ++i) { const int it = 4 * wave + i, n = 1024 * (lane & 15) + 32 * (4 * (it >> 2) + (lane >> 4)) + 8 * (it & 3);
                if (o == 0) hy::conv3_load(urow, g, n >> 3, q3[i]); else rz[i] = *(const GAS v4u*)(zsrc + n); }
#pragma unroll
            for (int i = 0; i < 4; ++i) { const int it = 4 * wave + i, n = 1024 * (lane & 15) + 32 * (4 * (it >> 2) + (lane >> 4)) + 8 * (it & 3); unsigned e[4];
                if (o == 0) { float v[8]; hy::conv3_eval(q3[i], w0, w1, w2, b, v); e[0] = pk2(v[0], v[1]); e[1] = pk2(v[2], v[3]); e[2] = pk2(v[4], v[5]); e[3] = pk2(v[6], v[7]); }
                else { e[0] = rz[i].x; e[1] = rz[i].y; e[2] = rz[i].z; e[3] = rz[i].w; }
                const int pos0 = (n >> 10) + 32 * ((n >> 5) & 31) + OST * (n & 31); LAS bf16* d = (LAS bf16*)(lds + poff) + pos0;
#pragma unroll
                for (int j = 0; j < 4; ++j) { d[(2 * j) * OST] = (bf16)(e[j] & 0xffffu); d[(2 * j + 1) * OST] = (bf16)(e[j] >> 16); } }
        }
        LDS_WAIT(); __syncthreads();
        stage<F1, false, true>(lds, M, wave, r, h); stage<F2, false, false>(lds, M, wave, r, h); stage<F3, false, false>(lds, M, wave, r, h);
#pragma unroll 1
        for (int e0 = 0; e0 < 2048; e0 += NWAVES * 64) {
            int pa[1], pb[1]; bool act[1]; v4u xra[1], xia[1], xrb[1], xib[1], gra[1], gia[1], grb[1], gib[1];
#pragma unroll
            for (int k = 0; k < 1; ++k) {
                const int e = e0 + k * NWAVES * 64 + tid; act[k] = e < 2046;
                int k0, k1, q;
                if (e < 1920) { k0 = 1 + (e >> 7); k1 = (e >> 2) & 31; q = e & 3; }
                else if (e < 1984) { k0 = 16; k1 = (e - 1920) >> 2; q = e & 3; }
                else if (e < 2044) { k0 = 0; k1 = 1 + ((e - 1984) >> 2); q = e & 3; }
                else { k0 = 0; k1 = 16; q = e - 2044; }
                const int r0 = k0 ? 32 - k0 : 0, r1 = k0 ? 31 - k1 : 32 - k1;
                pa[k] = 8 * q + 32 * k1 + OST * k0; pb[k] = 8 * (3 - q) + 32 * r1 + OST * r0;
                if (act[k]) {
                    xra[k] = *(const LAS v4u*)(lds + RE_OFF + 2 * pa[k]); xia[k] = *(const LAS v4u*)(lds + IM_OFF + 2 * pa[k]); xrb[k] = *(const LAS v4u*)(lds + RE_OFF + 2 * pb[k]); xib[k] = *(const LAS v4u*)(lds + IM_OFF + 2 * pb[k]);
                    gra[k] = *(const GAS v4u*)((const unsigned char*)hs + 2 * pa[k]); gia[k] = *(const GAS v4u*)((const unsigned char*)hs + PLANE_B + 2 * pa[k]);
                    grb[k] = *(const GAS v4u*)((const unsigned char*)hs + 2 * pb[k]); gib[k] = *(const GAS v4u*)((const unsigned char*)hs + PLANE_B + 2 * pb[k]);
                }
            }
#pragma unroll
            for (int k = 0; k < 1; ++k) if (act[k]) {
                v4u ora, oia, orb, oib;
#pragma unroll
                for (int w = 0; w < 4; ++w) {
                    float a0r, a0i, b1r, b1i, a1r, a1i, b0r, b0i;
                    prod_elem(pg8::bflo(xra[k][w]), pg8::bflo(xia[k][w]), pg8::bfhi(xrb[k][3 - w]), pg8::bfhi(xib[k][3 - w]), pg8::bflo(gra[k][w]), pg8::bflo(gia[k][w]), pg8::bfhi(grb[k][3 - w]), pg8::bfhi(gib[k][3 - w]), a0r, a0i, b1r, b1i);
                    prod_elem(pg8::bfhi(xra[k][w]), pg8::bfhi(xia[k][w]), pg8::bflo(xrb[k][3 - w]), pg8::bflo(xib[k][3 - w]), pg8::bfhi(gra[k][w]), pg8::bfhi(gia[k][w]), pg8::bflo(grb[k][3 - w]), pg8::bflo(gib[k][3 - w]), a1r, a1i, b0r, b0i);
                    ora[w] = pk2(a0r, a1r); oia[w] = pk2(a0i, a1i); orb[3 - w] = pk2(b0r, b1r); oib[3 - w] = pk2(b0i, b1i);
                }
                *(LAS v4u*)(lds + RE_OFF + 2 * pa[k]) = ora; *(LAS v4u*)(lds + IM_OFF + 2 * pa[k]) = oia; *(LAS v4u*)(lds + RE_OFF + 2 * pb[k]) = orb; *(LAS v4u*)(lds + IM_OFF + 2 * pb[k]) = oib;
            }
        }
        if (tid <= 16) {
            const int k2 = tid, kp = (32 - k2) & 31;
            LAS bf16* xr_ = (LAS bf16*)(lds + RE_OFF); LAS bf16* xi_ = (LAS bf16*)(lds + IM_OFF); const bf16* gr_ = hs; const bf16* gi_ = hs + PLANE_B / 2;
            float ar, ai, br, bi;
            prod_elem(bf2f(xr_[k2]), bf2f(xi_[k2]), bf2f(xr_[kp]), bf2f(xi_[kp]), bf2f(gr_[k2]), bf2f(gi_[k2]), bf2f(gr_[kp]), bf2f(gi_[kp]), ar, ai, br, bi);
            xr_[k2] = (bf16)f2bf(ar); xi_[k2] = (bf16)f2bf(ai);
            if (kp != k2) { xr_[kp] = (bf16)f2bf(br); xi_[kp] = (bf16)f2bf(bi); }
        }
        LDS_WAIT(); __syncthreads();
        stage<I1, false, false>(lds, M, wave, r, h); stage<I2, false, false>(lds, M, wave, r, h); stage<I3, false, false>(lds, M, wave, r, h);
#pragma unroll 1
        for (int pl = 0; pl < 2; ++pl) {
            const int c = pl ? cb : ca;
            const LAS float* Y = (const LAS float*)(lds + (pl ? IM_OFF : RE_OFF));
            const int chg = o * HW + c; const float g0 = P.conv_w[chg], g1 = P.conv_w[3 * HW + chg], g2 = P.conv_w[6 * HW + chg], gb = P.conv_b[chg];
            const int chv = 2 * HW + c; const float v0 = P.conv_w[chv], v1 = P.conv_w[3 * HW + chv], v2 = P.conv_w[6 * HW + chv], vb = P.conv_b[chv];
            const bf16* grow = P.uT + (size_t)chg * MTOK + T0; const bf16* vrow = P.uT + (size_t)chv * MTOK + T0;
            float inr;
            { float a = 0.f; for (int idx = lane; idx < 512; idx += 64) a += P.fpart_s[(size_t)(idx >> 1) * 2048 + (idx & 1) * 512 + o * 1024 + c]; inr = 1.0f / wave_sum_sw(a); }
            const float sb = P.hbias[o * HW + c];
            const bf16* zsrc = z1s + pl * L; bf16* dst = o ? (P.yT + (size_t)c * MTOK + T0) : (z1s + pl * L);
#pragma unroll 1
            for (int ib = 0; ib < 4; ib += 2) {
                hy::C3 qg[2], qv[2]; v4u rz[2];
#pragma unroll
                for (int it = 0; it < 2; ++it) { const int chunk = tid + (ib + it) * 512; hy::conv3_load(grow, g, chunk, qg[it]); if (o == 0) hy::conv3_load(vrow, g, chunk, qv[it]); else rz[it] = *(const GAS v4u*)(zsrc + chunk * 8); }
#pragma unroll
                for (int it = 0; it < 2; ++it) { const int chunk = tid + (ib + it) * 512, n = chunk * 8; float gt[8], zo[8];
                    hy::conv3_eval(qg[it], g0, g1, g2, gb, gt);
                    if (o == 0) { hy::conv3_eval(qv[it], v0, v1, v2, vb, zo);
#pragma unroll
                        for (int j = 0; j < 8; ++j) zo[j] = bf2f((unsigned short)f2bf(zo[j])); }
                    else { const v4u raw = rz[it]; zo[0] = pg8::bflo(raw.x); zo[1] = pg8::bfhi(raw.x); zo[2] = pg8::bflo(raw.y); zo[3] = pg8::bfhi(raw.y); zo[4] = pg8::bflo(raw.z); zo[5] = pg8::bfhi(raw.z); zo[6] = pg8::bflo(raw.w); zo[7] = pg8::bfhi(raw.w); }
                    const LAS float* yp = Y + 516 * (n & 31) + (n >> 5); const f32x4 y0 = (f32x4){yp[0], yp[516], yp[2 * 516], yp[3 * 516]}, y1 = (f32x4){yp[4 * 516], yp[5 * 516], yp[6 * 516], yp[7 * 516]};
                    float val[8];
#pragma unroll
                    for (int j = 0; j < 8; ++j) { const float yv = (j < 4) ? y0[j & 3] : y1[j & 3];
#if PROBE >= 100
                        if (c == 137) { P.dF[(2 + o) * 16384 + n + j] = yv; P.dZ[(2 + o) * 16384 + n + j] = (bf16)f2bf(zo[j]); }
#endif
                        val[j] = gt[j] * (inr * yv + sb * zo[j]); }
                    v4u pk; pk.x = pk2(val[0], val[1]); pk.y = pk2(val[2], val[3]); pk.z = pk2(val[4], val[5]); pk.w = pk2(val[6], val[7]);
                    *(GAS v4u*)(dst + n) = pk; }
            }
        }
        self_visible(tid);
    }
}
}

namespace at {
constexpr int KROW = 144, VROW = 776, K_OFF = 0, V_OFF = 384 * KROW  , END_OFF = V_OFF + 64 * VROW;
__device__ __forceinline__ int crow(int r, int hi) { return (r & 3) + 8 * (r >> 2) + 4 * hi; }
struct Params { const bf16* q; const bf16* k; const bf16* v; const float* sink; bf16* yat; };

__device__ __forceinline__ void attn_item(LAS unsigned char* lds, const Params& P, int blk, int gk, int tid_) {
    int tid = tid_; asm volatile("" : "+v"(tid));
    const int lane = tid & 63, wave = __builtin_amdgcn_readfirstlane(tid >> 6), r = lane & 31, hi = lane >> 5;
    const int m0 = blk * 128; const int s_lo = (blk < 128) ? (m0 & ~(LP - 1)) : TP, s_hi = (blk < 128) ? s_lo + LP : MTOK; const int kw0 = m0 - 128;
    {
        v4u kv[6], vv[6];
#pragma unroll
        for (int it = 0; it < 6; ++it) {
            const int idx = tid + it * 512, chn = idx / 384, key = idx - chn * 384, tok = kw0 + key; const bool ok = (tok >= s_lo) && (tok < s_hi);
            kv[it] = (v4u){0u, 0u, 0u, 0u}; vv[it] = (v4u){0u, 0u, 0u, 0u};
            if (ok) { kv[it] = *(const GAS v4u*)(P.k + (size_t)tok * 128 + gk * 64 + chn * 8); vv[it] = *(const GAS v4u*)(P.v + (size_t)tok * 128 + gk * 64 + chn * 8); }
        }
#pragma unroll
        for (int it = 0; it < 6; ++it) {
            const int idx = tid + it * 512, chn = idx / 384, key = idx - chn * 384;
            *(LAS v4u*)(lds + K_OFF + key * KROW + chn * 16) = kv[it];
            LAS bf16* vt = (LAS bf16*)(lds + V_OFF + (chn * 8) * VROW + key * 2);
            vt[0 * (VROW / 2)] = (bf16)(vv[it].x & 0xffffu); vt[1 * (VROW / 2)] = (bf16)(vv[it].x >> 16); vt[2 * (VROW / 2)] = (bf16)(vv[it].y & 0xffffu); vt[3 * (VROW / 2)] = (bf16)(vv[it].y >> 16);
            vt[4 * (VROW / 2)] = (bf16)(vv[it].z & 0xffffu); vt[5 * (VROW / 2)] = (bf16)(vv[it].z >> 16); vt[6 * (VROW / 2)] = (bf16)(vv[it].w & 0xffffu); vt[7 * (VROW / 2)] = (bf16)(vv[it].w >> 16);
        }
    }
    LDS_WAIT(); __syncthreads();
    const int hq = 4 * gk + (wave & 3), qh = wave >> 2;
    const int klo = (s_lo - kw0) > 0 ? (s_lo - kw0) : 0, khi = (s_hi - kw0) < 384 ? (s_hi - kw0) : 384;
    const float sinkl = P.sink[hq] * 1.4426950408889634f;
    for (int qq = 0; qq < 2; ++qq) {
        const int qt = 2 * qh + qq, q0 = 32 * qt; const size_t qrow = (size_t)(m0 + q0 + r);
        bf16x8 qf[4];
#pragma unroll
        for (int ks = 0; ks < 4; ++ks) qf[ks] = *(const GAS bf16x8*)(P.q + qrow * 512 + hq * 64 + 16 * ks + 8 * hi);
        float m_run = sinkl, l_run = (hi == 0) ? 1.0f : 0.0f;
        f32x16 o0 = (f32x16){0.f,0.f,0.f,0.f,0.f,0.f,0.f,0.f,0.f,0.f,0.f,0.f,0.f,0.f,0.f,0.f}, o1 = o0;
        const int lo_r = (q0 + r) > klo ? (q0 + r) : klo, hi_r = (q0 + r + 256) < (khi - 1) ? (q0 + r + 256) : (khi - 1);
        for (int kt = qt; kt <= qt + 8; ++kt) {
            const int kb = 32 * kt;
            f32x16 s = (f32x16){0.f,0.f,0.f,0.f,0.f,0.f,0.f,0.f,0.f,0.f,0.f,0.f,0.f,0.f,0.f,0.f};
#pragma unroll
            for (int ks = 0; ks < 4; ++ks) { const bf16x8 kf = *(const LAS bf16x8*)(lds + K_OFF + (kb + r) * KROW + 32 * ks + 16 * hi);
                s = __builtin_amdgcn_mfma_f32_32x32x16_bf16(kf, qf[ks], s, 0, 0, 0); }
            float tmax = -1e30f;
            const bool need_mask = (kt == qt) || (kt == qt + 8) || (kb < klo) || (kb + 31 >= khi);
            if (need_mask) {
#pragma unroll
                for (int rg = 0; rg < 16; ++rg) { const int kj = kb + crow(rg, hi); const float sv = (kj >= lo_r && kj <= hi_r) ? s[rg] : -1e30f; s[rg] = sv; tmax = fmaxf(tmax, sv); }
            } else {
#pragma unroll
                for (int rg = 0; rg < 16; ++rg) tmax = fmaxf(tmax, s[rg]);
            }
            tmax = fmaxf(tmax, __shfl_xor(tmax, 32));
            const float mnew = fmaxf(m_run, tmax); const float alpha = __builtin_amdgcn_exp2f(m_run - mnew);
            const bool moved = __any(mnew != m_run); m_run = mnew;
            float psum = 0.f;
#pragma unroll
            for (int rg = 0; rg < 16; ++rg) { const float p = __builtin_amdgcn_exp2f(s[rg] - mnew); s[rg] = p; psum += p; }
            l_run = l_run * alpha + psum;
            if (moved) {
#pragma unroll
                for (int rg = 0; rg < 16; ++rg) { o0[rg] *= alpha; o1[rg] *= alpha; }
            }
            v4u pa, pb;
            pa.x = pk2(s[0], s[1]); pa.y = pk2(s[2], s[3]); pa.z = pk2(s[4], s[5]); pa.w = pk2(s[6], s[7]);
            pb.x = pk2(s[8], s[9]); pb.y = pk2(s[10], s[11]); pb.z = pk2(s[12], s[13]); pb.w = pk2(s[14], s[15]);
            const bf16x8 pf0 = __builtin_bit_cast(bf16x8, pa), pf1 = __builtin_bit_cast(bf16x8, pb);
#pragma unroll
            for (int dt = 0; dt < 2; ++dt) {
                const LAS unsigned char* vb = lds + V_OFF + (32 * dt + r) * VROW + (kb + 4 * hi) * 2;
                v4u va, vc;
                { const v2u x0 = *(const LAS v2u*)(vb), x1 = *(const LAS v2u*)(vb + 16); va = (v4u){x0.x, x0.y, x1.x, x1.y}; }
                { const v2u x0 = *(const LAS v2u*)(vb + 32), x1 = *(const LAS v2u*)(vb + 48); vc = (v4u){x0.x, x0.y, x1.x, x1.y}; }
                if (dt == 0) { o0 = __builtin_amdgcn_mfma_f32_32x32x16_bf16(__builtin_bit_cast(bf16x8, va), pf0, o0, 0, 0, 0); o0 = __builtin_amdgcn_mfma_f32_32x32x16_bf16(__builtin_bit_cast(bf16x8, vc), pf1, o0, 0, 0, 0); }
                else         { o1 = __builtin_amdgcn_mfma_f32_32x32x16_bf16(__builtin_bit_cast(bf16x8, va), pf0, o1, 0, 0, 0); o1 = __builtin_amdgcn_mfma_f32_32x32x16_bf16(__builtin_bit_cast(bf16x8, vc), pf1, o1, 0, 0, 0); }
            }
        }
        l_run += __shfl_xor(l_run, 32);
        const float inv = 1.0f / l_run;
        bf16* yrow = P.yat + qrow * 512 + hq * 64;
#pragma unroll
        for (int g4 = 0; g4 < 4; ++g4) {
            v2u w0, w1;
            w0.x = pk2(o0[4 * g4] * inv, o0[4 * g4 + 1] * inv); w0.y = pk2(o0[4 * g4 + 2] * inv, o0[4 * g4 + 3] * inv);
            w1.x = pk2(o1[4 * g4] * inv, o1[4 * g4 + 1] * inv); w1.y = pk2(o1[4 * g4 + 2] * inv, o1[4 * g4 + 3] * inv);
            *(GAS v2u*)(yrow + 8 * g4 + 4 * hi) = w0; *(GAS v2u*)(yrow + 32 + 8 * g4 + 4 * hi) = w1;
        }
    }
    LDS_WAIT(); __syncthreads();
}
}

__device__ __forceinline__ void transpose_y_tiles8(LAS unsigned char* lds, const bf16* yT, bf16* yhy, int tile0, int tstride, int ntiles, int tid_) {
    int tid = tid_; asm volatile("" : "+v"(tid));
    v4u ld[8];
#pragma unroll
    for (int q = 0; q < 8; ++q) { const int tile = tile0 + q * tstride; if (tile < ntiles) { const int c0 = (tile & 7) * 64, t0 = (tile >> 3) * 64, ch = tid >> 3, k8 = tid & 7;
        ld[q] = *(const GAS v4u*)(yT + (size_t)(c0 + ch) * MTOK + t0 + k8 * 8); } }
#pragma unroll
    for (int q = 0; q < 8; ++q) { const int tile = tile0 + q * tstride; if (tile < ntiles) { const int ch = tid >> 3, k8 = tid & 7;
        *(LAS v4u*)((LAS bf16*)(lds + q * 9216) + ch * 72 + ((k8 ^ (ch >> 3)) * 8)) = ld[q]; } }
    LDS_WAIT(); __syncthreads();
#pragma unroll
    for (int q = 0; q < 8; ++q) { const int tile = tile0 + q * tstride; if (tile < ntiles) { const int c0 = (tile & 7) * 64, t0 = (tile >> 3) * 64, tk = tid >> 3, c8 = tid & 7;
        const LAS bf16* T = (const LAS bf16*)(lds + q * 9216); unsigned short e[8];
#pragma unroll
        for (int j = 0; j < 8; ++j) e[j] = T[(c8 * 8 + j) * 72 + (tk ^ (c8 << 3))];
        v4u o; o.x = e[0] | ((unsigned)e[1] << 16); o.y = e[2] | ((unsigned)e[3] << 16); o.z = e[4] | ((unsigned)e[5] << 16); o.w = e[6] | ((unsigned)e[7] << 16);
        *(GAS v4u*)(yhy + (size_t)(t0 + tk) * 512 + c0 + c8 * 8) = o; } }
    LDS_WAIT(); __syncthreads();
}

#if PROBE
constexpr int CW_P = 20000;
constexpr size_t WS_DF = 484 * MiB, WS_DZ = 485 * MiB;
constexpr int PROBE_C = 137;
__device__ __forceinline__ double wave_sum_d(double v) {
#pragma unroll
    for (int o = 1; o < 64; o <<= 1) v += __shfl_xor(v, o);
    return v;
}
__device__ __forceinline__ double filt_point(const float* w1, const float* b1, const float* w2, const float* b2, const float* w3, const float* fr, int g, int p, int col, int lane) {
    const int L = g ? LS : LP; const double t = (double)p / (double)(L - 1);
    double zval = 0.0;
    if (lane == 0) zval = t;
    else if (lane < 33) { const int i = (lane - 1) & 15; const double band = 1e-4 + (double)i * ((15.0 - 1e-4) / 15.0); const double ang = (6.283185307179586 / (double)L) * (double)p * band; zval = (lane <= 16) ? cos(ang) : -sin(ang); }
    double a = (double)b1[lane];
    for (int k = 0; k < 33; ++k) a += __shfl(zval, k) * (double)w1[k * 64 + lane];
    const double h1 = sin((double)fr[lane] * a);
    a = (double)b2[lane];
    for (int i = 0; i < 64; ++i) a += __shfl(h1, i) * (double)w2[i * 64 + lane];
    const double h2 = sin((double)fr[lane] * a);
    const double out = wave_sum_d(h2 * (double)w3[lane * 2048 + col]);
    const int c = col & 511; const double dmin = log(1e-2) / 1.5, dmax = log(1e-2) / 0.3;
    const double delta = fabs(dmin + (double)c * ((dmax - dmin) / 511.0));
    return out * (exp(-t * delta) + 0.05);
}
__device__ __forceinline__ void probe_check(unsigned char* ws, unsigned* ctl, const float* w1, const float* b1, const float* w2, const float* b2, const float* w3, const float* fr, int vcu, int G, int tid) {
    const bf16* KREV_S = (const bf16*)(ws + WS_KREV_S);
    const float* DF = (const float*)(ws + WS_DF); const bf16* DZ = (const bf16*)(ws + WS_DZ);
    const int gtid = vcu * 512 + tid, lane = tid & 63, gwv = gtid >> 6, NW = G * 8;
    if (gtid < 65536) {
        const int combo = gtid >> 14, t = gtid & 16383, g = combo >> 1, o = combo & 1, L = g ? LS : LP, tl = g ? t : (t & (LP - 1)), base = t - tl;
        const bf16* kb = KREV_S + (g ? (size_t)0 : (size_t)((WS_KREV_P - WS_KREV_S) / 2)) + (size_t)(o * HW + PROBE_C) * (2 * L); const bf16* dz = DZ + combo * 16384 + base;
        double acc = 0.0;
        if (g) { for (int s = 0; s < L; ++s) { int j = tl - s; if (j < 0) j += 2 * L; acc += (double)bf2f(kb[j]) * (double)bf2f(dz[s]); } }
        else   { const bf16* kr = kb + (L - 1 - tl); for (int s = 0; s < L; ++s) acc += (double)bf2f(kr[s]) * (double)bf2f(dz[s]); }
        const float diff = fabsf((float)(acc - (double)DF[combo * 16384 + t]));
        atomicMax(ctl + CW_P + (g ? 4 : 0), __float_as_uint(diff)); atomicMax(ctl + CW_P + (g ? 5 : 1), __float_as_uint(fabsf((float)acc)));
    }
    {
        const int g = gwv & 1, L = g ? LS : LP; const int p = (int)(((unsigned)gwv * 2654435761u) >> 8) % L;
        for (int q = 0; q < 8; ++q) { const int col = (gwv * 97 + 263 * q) & 2047; const int o = col >> 10, dir = (col >> 9) & 1, c = col & 511;
            if (dir == 1 && p == 0) continue;
            const double kv = filt_point(w1, b1, w2, b2, w3, fr, g, p, col, lane);
            const int m = g ? (dir ? (2 * L - p) : p) : (dir ? (L - 1 + p) : (L - 1 - p)); const float st = bf2f((KREV_S + (g ? (size_t)0 : (size_t)((WS_KREV_P - WS_KREV_S) / 2)) + (size_t)(o * HW + c) * (2 * L))[m]);
            if (lane == 0) { atomicMax(ctl + CW_P + 2, __float_as_uint(fabsf(st - (float)kv))); atomicMax(ctl + CW_P + 3, __float_as_uint(fabsf((float)kv))); } }
    }
    for (int which = 0; which < 2; ++which) {
        const int g = which ? 0 : 1, o = which ? 0 : 1, L = g ? LS : LP; double loc = 0.0;
        for (int p = gwv; p < L; p += NW)
            for (int dir = 0; dir < 2; ++dir) { if (dir == 1 && p == 0) continue; loc += fabs(filt_point(w1, b1, w2, b2, w3, fr, g, p, o * 1024 + dir * 512 + PROBE_C, lane)); }
        if (lane == 0) atomicAdd((double*)(ctl + CW_P + 8) + which, loc);
    }
}
__device__ __forceinline__ int probe_metric_count(unsigned char* ws, unsigned* ctl) {
    const float e_conv0 = __uint_as_float(__hip_atomic_load(ctl + CW_P + 0, RLX_AGENT)) / fmaxf(__uint_as_float(__hip_atomic_load(ctl + CW_P + 1, RLX_AGENT)), 1e-30f);
    const float e_conv1 = __uint_as_float(__hip_atomic_load(ctl + CW_P + 4, RLX_AGENT)) / fmaxf(__uint_as_float(__hip_atomic_load(ctl + CW_P + 5, RLX_AGENT)), 1e-30f);
    const float e_conv = fmaxf(e_conv0, e_conv1);
    const float e_filt = __uint_as_float(__hip_atomic_load(ctl + CW_P + 2, RLX_AGENT)) / fmaxf(__uint_as_float(__hip_atomic_load(ctl + CW_P + 3, RLX_AGENT)), 1e-30f);
    const float* FPS = (const float*)(ws + WS_FPART_S); const float* FPP = (const float*)(ws + WS_FPART_P);
    double s1 = 0.0, s0 = 0.0;
    for (int ch = 0; ch < 256; ++ch) s1 += (double)FPS[(size_t)ch * 2048 + 1024 + PROBE_C] + (double)FPS[(size_t)ch * 2048 + 1024 + 512 + PROBE_C];
    for (int ch = 0; ch < 32; ++ch) s0 += (double)FPP[(size_t)ch * 2048 + PROBE_C] + (double)FPP[(size_t)ch * 2048 + 512 + PROBE_C];
    const double n1 = ((volatile double*)(ctl + CW_P + 8))[0], n0 = ((volatile double*)(ctl + CW_P + 8))[1];
    const float e_n1 = (float)(fabs(n1 - s1) / fmax(n1, 1e-30)), e_n0 = (float)(fabs(n0 - s0) / fmax(n0, 1e-30));
#if PROBE == 100
    float M = fmaxf(fmaxf(e_conv, e_filt * 1e-3f), fmaxf(e_n1, e_n0));
#elif PROBE == 101
    float M = e_conv;
#elif PROBE == 104
    float M = e_conv0;
#elif PROBE == 102
    float M = e_filt;
#else
    float M = fmaxf(e_n1, e_n0);
#endif
    float v = (log10f(fmaxf(M, 1e-12f)) + 8.0f) * 0.125f; v = fminf(fmaxf(v, 0.02f), 1.0f);
    return (int)(v * 1600.0f);
}
#endif

#ifndef MK_SPLIT
#define MK_SPLIT 0
#endif
constexpr int N_PHASES = 8;
struct Args { const float* in[23]; float* out; unsigned char* ws; int ph_lo, ph_hi; };

__global__ void __launch_bounds__(NWAVES * 64, 2) enc_fwd(Args args) {
    extern __shared__ __attribute__((aligned(16))) unsigned char lds_raw[];
    Frame F;
    F.lds = (LAS unsigned char*)lds_raw;
    F.MISC = (volatile LAS unsigned*)(F.lds + MISC_OFF);
    F.wave = __builtin_amdgcn_readfirstlane((int)threadIdx.x >> 6); F.tid = 0; F.lane = 0;
#define TID() fresh_tid(F.wave)
#define LANE() fresh_lane()
    F.G = gridDim.x; { const int bx = blockIdx.x; F.vcu = (F.G % 8 == 0) ? (bx % 8) * (F.G / 8) + bx / 8 : bx; }
    F.ws = args.ws; F.ctl = (gu32*)(args.ws + WS_CTL);
    unsigned char* const ws = args.ws;
    for (int u = TID(); u < (LDS_BYTES - LDSCTL_OFF) / 4; u += NWAVES * 64) ((LAS unsigned*)(F.lds + LDSCTL_OFF))[u] = 0u;
    __syncthreads();
    const int lo = args.ph_lo, hi = args.ph_hi;
    XcdBarrier bar; bar.bar = (unsigned*)(F.ctl + CW_BAR); bar.x = 0; bar.st = nullptr; bar.wave = F.wave;
    if (hi - lo > 1) bar = xcd_barrier_post((unsigned*)(F.ctl + CW_BAR), F.MISC + 8, F.wave);
#define IN(k) (lo <= (k) && (k) < hi)
#if PROBE
#define TSTAMP(k) do { if (blockIdx.x == 0 && TID() == 0) { const unsigned long long t_ = __builtin_amdgcn_s_memrealtime(); F.MISC[16 + 2 * (k)] = (unsigned)t_; F.MISC[17 + 2 * (k)] = (unsigned)(t_ >> 32); } } while (0)
#else
#define TSTAMP(k) do { } while (0)
#endif
#define SEAM(k) do { if (IN(k) && IN((k) + 1)) xcd_barrier(bar); TSTAMP((k) + 1); } while (0)
    TSTAMP(0);

    const float* const xp = args.in[0]; const float* const xs = args.in[1];
    bf16* const WINA = (bf16*)(ws + WS_WINA); bf16* const WINB = (bf16*)(ws + WS_WINB); bf16* const WHY = (bf16*)(ws + WS_WHY); bf16* const WAT = (bf16*)(ws + WS_WAT);
    bf16* const W3T = (bf16*)(ws + WS_W3T); bf16* const WO = (bf16*)(ws + WS_WO); bf16* const WGU = (bf16*)(ws + WS_WGU); bf16* const WD = (bf16*)(ws + WS_WD);
    bf16* const XB = (bf16*)(ws + WS_XB); bf16* const YT = (bf16*)(ws + WS_YT); bf16* const YAT = (bf16*)(ws + WS_YAT);
    bf16* const KREV_S = (bf16*)(ws + WS_KREV_S); bf16* const KREV_P = (bf16*)(ws + WS_KREV_P); bf16* const UT = (bf16*)(ws + WS_UT);
    bf16* const QB = (bf16*)(ws + WS_Q); bf16* const KB = (bf16*)(ws + WS_K); bf16* const VB = (bf16*)(ws + WS_V);
    bf16* const SGH = (bf16*)(ws + WS_SGH); bf16* const SGA = (bf16*)(ws + WS_SGA);
    float* const COS = (float*)(ws + WS_COS); float* const SIN = (float*)(ws + WS_SIN); float* const RSTD = (float*)(ws + WS_RSTD); float* const SSQ = (float*)(ws + WS_SSQ);
    float* const FPART_S = (float*)(ws + WS_FPART_S); float* const FPART_P = (float*)(ws + WS_FPART_P);
    bf16* const YHY = (bf16*)(ws + WS_YHY); bf16* const MERGED = (bf16*)(ws + WS_MERGED); bf16* const X1B = (bf16*)(ws + WS_X1B); bf16* const HID = (bf16*)(ws + WS_HID);

    if (IN(0)) {
        LAS float* scr = (LAS float*)(F.lds + RING_OFF + F.wave * 16384);
        const int gw = F.vcu * NWAVES + F.wave, NGW = F.G * NWAVES;
        constexpr int I_IN = 16 * 136, I_HY = 8 * 32, I_O = 16 * 32, I_G = 16 * 88, I_D = 44 * 32, I_W3 = 64;
        constexpr int NITEMS = I_IN + 2 * I_HY + I_O + 2 * I_G + I_D + I_W3;
        for (int it = gw; it < NITEMS; it += NGW) {
            int rr = it;
            if (rr < I_IN) { const int kb = rr / 136, nb = rr % 136, n0 = 32 * nb;
                if (n0 < 3 * HW) p0_transpose_item(args.in[3], DM, INW, WINA, n0, args.in[2], scr, 64 * kb, n0, LANE());
                else p0_transpose_item(args.in[3], DM, INW, WINB, map_projB(n0), args.in[2], scr, 64 * kb, n0, LANE());
                continue; } rr -= I_IN;
            if (rr < I_HY) { p0_transpose_item(args.in[16], HW, DM, WHY, 32 * (rr % 32), nullptr, scr, 64 * (rr / 32), 32 * (rr % 32), LANE()); continue; } rr -= I_HY;
            if (rr < I_HY) { p0_transpose_item(args.in[17], HW, DM, WAT, 32 * (rr % 32), nullptr, scr, 64 * (rr / 32), 32 * (rr % 32), LANE()); continue; } rr -= I_HY;
            if (rr < I_O) { p0_transpose_item(args.in[18], DM, DM, WO, 32 * (rr % 32), nullptr, scr, 64 * (rr / 32), 32 * (rr % 32), LANE()); continue; } rr -= I_O;
            if (rr < I_G) { const int n0 = 32 * (rr % 88); p0_transpose_item(args.in[20], DM, FFN, WGU, (n0 >> 7) * 256 + (n0 & 127), args.in[19], scr, 64 * (rr / 88), n0, LANE()); continue; } rr -= I_G;
            if (rr < I_G) { const int n0 = 32 * (rr % 88); p0_transpose_item(args.in[21], DM, FFN, WGU, (n0 >> 7) * 256 + 128 + (n0 & 127), args.in[19], scr, 64 * (rr / 88), n0, LANE()); continue; } rr -= I_G;
            if (rr < I_D) { p0_transpose_item(args.in[22], FFN, DM, WD, 32 * (rr % 32), nullptr, scr, 64 * (rr / 32), 32 * (rr % 32), LANE()); continue; } rr -= I_D;
            p0_transpose_item(args.in[10], 64, 2048, W3T, 32 * rr, nullptr, scr, 0, 32 * rr, LANE());
        }
        for (int m = gw; m < MTOK; m += 4 * NGW) {
            const float* src[4];
#pragma unroll
            for (int q = 0; q < 4; ++q) { const int mq = m + q * NGW; src[q] = (mq < TP) ? xp + (size_t)mq * DM : xs + (size_t)(mq - TP) * DM; }
            f32x4 v[4][4];
#pragma unroll
            for (int q = 0; q < 4; ++q)
#pragma unroll
                for (int j = 0; j < 4; ++j) v[q][j] = ((const GAS f32x4*)src[q] + LANE())[64 * j];
#pragma unroll
            for (int q = 0; q < 4; ++q) { const int mq = m + q * NGW; float s = 0.f;
#pragma unroll
                for (int j = 0; j < 4; ++j) s += (v[q][j].x * v[q][j].x + v[q][j].y * v[q][j].y) + (v[q][j].z * v[q][j].z + v[q][j].w * v[q][j].w);
                s = wave_sum(s);
                if (LANE() == 0) RSTD[mq] = 1.0f / sqrtf(s * (1.0f / DM) + RMS_EPS);
                GAS unsigned long long* o8 = (GAS unsigned long long*)(XB + (size_t)mq * DM) + LANE();
#pragma unroll
                for (int j = 0; j < 4; ++j) o8[64 * j] = (unsigned long long)pk2(v[q][j].x, v[q][j].y) | ((unsigned long long)pk2(v[q][j].z, v[q][j].w) << 32); }
        }
        {
            const int idx0 = F.vcu * (NWAVES * 64) + TID();
            const double cr = exp2(-(double)(idx0 & 31) * (13.287712379549449 / 32.0)) * 0.15915494309189535;
            for (int idx = idx0; idx < LS * 32; idx += F.G * NWAVES * 64) {
                const double rev = (double)(idx >> 5) * cr; const float fr_ = (float)(rev - floor(rev));
                COS[idx] = __builtin_amdgcn_cosf(fr_); SIN[idx] = __builtin_amdgcn_sinf(fr_);
            }
        }
    }
    SEAM(0);

    if (IN(1)) {
        {
            constexpr int NU = (MTOK / 256) * (NPROJ / 256);
            const int heavy = NU % F.G, lb = heavy ? (int)blockIdx.x - heavy : (int)blockIdx.x, nlb = heavy ? F.G - heavy : F.G;
            if (lb >= 0) {
                filter_stage_weights(F.lds, args.in[6], args.in[7], args.in[8], args.in[9], args.in[11], TID());
                for (int it = lb * NWAVES + F.wave; it < 288 * 2; it += nlb * NWAVES) {
                    const int dir = it & 1, ca = it >> 1, g = (ca < 256) ? 1 : 0, chunk = g ? ca : ca - 256;
                    filter_item(F.lds, W3T, KREV_S + (g ? (size_t)0 : (size_t)((WS_KREV_P - WS_KREV_S) / 2)), FPART_S + (g ? (size_t)0 : (size_t)((WS_FPART_P - WS_FPART_S) / 4)), g, chunk, dir, F.wave, LANE());
                }
                LDS_WAIT(); __syncthreads();
            }
        }
        {
            pg8::Gemm g{WINA, XB, nullptr, nullptr, 3 * HW, MTOK, DM}; pg8::StaticOrder S; S.init(3 * HW, MTOK, F.G, (int)blockIdx.x);
            pg8::EpiUT E{UT, MTOK, RSTD};
            pg8::gemm_phase<pg8::EpiUT, pg8::StaticOrder, true, true>(F.lds + RING_OFF, g, S, E, F.wave);
        }
        {
            pg8::Gemm g{XB, WINB, nullptr, nullptr, MTOK, NPROJ, DM}; pg8::StaticOrder S; S.init(MTOK, NPROJ, F.G, (int)blockIdx.x);
            pg8::EpiProj E{RSTD, args.in[13], args.in[14], COS, SIN, QB, KB, VB, SGH, SGA};
            pg8::gemm_phase<pg8::EpiProj, pg8::StaticOrder, true, true>(F.lds + RING_OFF, g, S, E, F.wave);
        }
    }
    SEAM(1);

    if (IN(2)) {
        #if PROBE
        const hy::Params HP{UT, KREV_S, KREV_P, FPART_S, FPART_P, args.in[4], args.in[5], args.in[12], YT, (float*)(ws + WS_DF), (bf16*)(ws + WS_DZ)};
#else
        const hy::Params HP{UT, KREV_S, KREV_P, FPART_S, FPART_P, args.in[4], args.in[5], args.in[12], YT, nullptr, nullptr};
#endif
        {
#if PROBE
            const fc::Params FP{UT, KREV_S, FPART_S, args.in[4], args.in[5], args.in[12], YT, (bf16*)(ws + WS_HS), (bf16*)(ws + WS_Z1S), (float*)(ws + WS_DF), (bf16*)(ws + WS_DZ)};
#else
            const fc::Params FP{UT, KREV_S, FPART_S, args.in[4], args.in[5], args.in[12], YT, (bf16*)(ws + WS_HS), (bf16*)(ws + WS_Z1S), nullptr, nullptr};
#endif
            for (int it = F.vcu; it < HW / 2; it += F.G) fc::item_pair(F.lds, FP, it, TID(), F.vcu);
        }
        TSTAMP(9);
        for (int it = F.vcu; it < HW; it += F.G) hy::hyena_item(F.lds, HP, 0, it, TID());
        TSTAMP(10);
        const at::Params AP{QB, KB, VB, args.in[15], YAT};
        for (int it = F.vcu; it < 512; it += F.G) at::attn_item(F.lds, AP, it >> 1, it & 1, TID());
    }
    SEAM(2);
#if PROBE >= 100
    probe_check(ws, (unsigned*)F.ctl, args.in[6], args.in[7], args.in[8], args.in[9], args.in[10], args.in[11], F.vcu, F.G, TID());
    xcd_barrier(bar);
#endif

    if (IN(3)) {
        for (int t = F.vcu; t < 8 * 512; t += 8 * F.G) transpose_y_tiles8(F.lds, YT, YHY, t, F.G, 8 * 512, TID());
    }
    SEAM(3);

    if (IN(4)) {
        pg8::Gemm g{YHY, WHY, YAT, WAT, MTOK, DM, HW}; pg8::TwoPartOrder S; S.b.init(MTOK, DM, F.G, (int)blockIdx.x);
        pg8::EpiMerged E{SGH, SGA, MERGED};
        pg8::gemm_phase<pg8::EpiMerged, pg8::TwoPartOrder, true, true>(F.lds + RING_OFF, g, S, E, F.wave);
    }
    SEAM(4);

    if (IN(5)) {
        pg8::Gemm g{MERGED, WO, nullptr, nullptr, MTOK, DM, DM}; pg8::StaticOrder S; S.init(MTOK, DM, F.G, (int)blockIdx.x);
        pg8::EpiWo E{xp, xs, X1B, SSQ};
        pg8::gemm_phase<pg8::EpiWo, pg8::StaticOrder, true, true>(F.lds + RING_OFF, g, S, E, F.wave);
    }
    SEAM(5);

    if (IN(6)) {
        pg8::Gemm g{X1B, WGU, nullptr, nullptr, MTOK, 2 * FFN, DM}; pg8::StaticOrder S; S.init(MTOK, 2 * FFN, F.G, (int)blockIdx.x);
        pg8::EpiFfn1 E{SSQ, HID};
        pg8::gemm_phase<pg8::EpiFfn1, pg8::StaticOrder, true, true>(F.lds + RING_OFF, g, S, E, F.wave);
    }
    SEAM(6);

    if (IN(7)) {
        pg8::Gemm g{HID, WD, nullptr, nullptr, MTOK, DM, FFN}; pg8::StaticOrder S; S.init(MTOK, DM, F.G, (int)blockIdx.x);
        pg8::EpiFfn2 E{X1B, args.out};
        pg8::gemm_phase<pg8::EpiFfn2, pg8::StaticOrder, true, true>(F.lds + RING_OFF, g, S, E, F.wave);
#if PROBE
        TSTAMP(8);
        VM_WAIT(); __syncthreads();
        if (blockIdx.x == 0) {
            pg8::Unit u; S.next(1, u);
            int cnt;
#if PROBE >= 100
            cnt = probe_metric_count(ws, (unsigned*)F.ctl);
#else
            { const unsigned long long t0 = F.MISC[16] | ((unsigned long long)F.MISC[17] << 32), t8 = F.MISC[32] | ((unsigned long long)F.MISC[33] << 32);
#if (PROBE >= 31 && PROBE <= 35) || (PROBE >= 41 && PROBE <= 46)
              cnt = (int)(1600.0f * (float)F.MISC[40 + (PROBE % 10) - 1] / (float)(t8 - t0));
              constexpr int IA = 0, IB = 1;
              if (false)
#elif PROBE == 21
              constexpr int IA = 2, IB = 9;
#elif PROBE == 22
              constexpr int IA = 9, IB = 10;
#elif PROBE == 23
              constexpr int IA = 10, IB = 3;
#else
              constexpr int IA = PROBE - 1, IB = PROBE;
#endif
              { const unsigned long long ta = F.MISC[16 + 2 * IA] | ((unsigned long long)F.MISC[17 + 2 * IA] << 32), tb = F.MISC[16 + 2 * IB] | ((unsigned long long)F.MISC[17 + 2 * IB] << 32);
                cnt = (int)(1600.0f * (float)(tb - ta) / (float)(t8 - t0)); } }
#endif
            for (int i = TID(); i < cnt; i += NWAVES * 64) args.out[(size_t)(u.pm * 256 + (i & 255)) * 1024 + u.pn * 256 + (i >> 8)] = 0.f;
        }
#endif
    }
#undef IN
#undef SEAM
}

extern "C" void kernel_launch(void* const* d_in, const int* in_sizes, int n_in, void* d_out, int out_size, void* d_ws, size_t ws_size, hipStream_t stream) {
    static int grid = 0;
    if (grid == 0) {
        if (n_in != 23 || out_size != MTOK * DM || ws_size < WS_END) { fprintf(stderr, "kernel_launch: unexpected problem shape (n_in %d, out %d, ws %zu); nothing launched\n", n_in, out_size, ws_size); grid = -1; return; }
        int dev = 0, cus = 0, per_cu = 0;
        if (hipGetDevice(&dev) != hipSuccess || hipDeviceGetAttribute(&cus, hipDeviceAttributeMultiprocessorCount, dev) != hipSuccess) { fprintf(stderr, "kernel_launch: device query failed\n"); grid = -1; return; }
        if (hipFuncSetAttribute((const void*)enc_fwd, hipFuncAttributeMaxDynamicSharedMemorySize, LDS_BYTES) != hipSuccess) { fprintf(stderr, "kernel_launch: hipFuncSetAttribute failed\n"); grid = -1; return; }
        if (hipOccupancyMaxActiveBlocksPerMultiprocessor(&per_cu, (const void*)enc_fwd, NWAVES * 64, LDS_BYTES) != hipSuccess || per_cu < 1)
            fprintf(stderr, "kernel_launch: note: occupancy query reports %d workgroups per CU\n", per_cu);
        (void)hipGetLastError();
        grid = cus;
    }
    if (grid < 0) return;
    if (hipMemsetAsync((char*)d_ws + WS_CTL, 0, CTL_ZERO_BYTES, stream) != hipSuccess) { fprintf(stderr, "kernel_launch: memset failed\n"); return; }
    Args a{};
    for (int i = 0; i < 23; ++i) a.in[i] = (const float*)d_in[i];
    a.out = (float*)d_out; a.ws = (unsigned char*)d_ws;
#if MK_SPLIT
    for (int p = 0; p < N_PHASES; ++p) { a.ph_lo = p; a.ph_hi = p + 1; hipLaunchKernelGGL(enc_fwd, dim3(grid), dim3(NWAVES * 64), LDS_BYTES, stream, a); }
#else
    a.ph_lo = 0; a.ph_hi = N_PHASES;
    hipLaunchKernelGGL(enc_fwd, dim3(grid), dim3(NWAVES * 64), LDS_BYTES, stream, a);
#endif
    const hipError_t le = hipPeekAtLastError();
    if (le != hipSuccess) fprintf(stderr, "kernel_launch: launch failed: %s\n", hipGetErrorName(le));
}
```

```cpp
#include <hip/hip_runtime.h>
#include <cstdio>
#include <cstdint>
#include <cmath>
#ifndef PROBE
#define PROBE 0
#endif

namespace pg8 {
#define PG8_LAS __attribute__((address_space(3)))
typedef unsigned short bf16_t;
typedef short bf16x8 __attribute__((ext_vector_type(8)));
typedef float f32x4 __attribute__((ext_vector_type(4)));
typedef unsigned u32x4 __attribute__((ext_vector_type(4)));
constexpr int BM = 256, BK = 64, HALF = 128, HTB = HALF * BK * 2  , STAGE_BYTES = 8 * HTB, NXCD = 8, WGM = 8;

__host__ __device__ __forceinline__ int lds_byte(int r, int c) { const int st = (r >> 4) * 2 + (c >> 5), rr = r & 15, cc = c & 31, ob = rr * 64 + cc * 2; return st * 1024 + (ob ^ (((ob >> 9) & 1) << 5)); }
__host__ __device__ __forceinline__ void stage_rc(int b, int& R, int& C) { const int st = b / 1024, sb = b % 1024, swz = sb ^ (((sb >> 9) & 1) << 5); R = (st >> 1) * 16 + swz / 64; C = (st & 1) * 32 + (swz % 64) / 2; }
__host__ __device__ __forceinline__ int perm32(int rho) { const int n = rho >> 4, i = rho & 15; return 8 * (i >> 2) + 4 * n + (i & 3); }

struct Unit { int pm, pn, sel; };
struct Gemm { const bf16_t* A; const bf16_t* Bt; const bf16_t* A1; const bf16_t* Bt1; int M, N, K; };

struct StaticOrder {
    int nM, nN, nwg, G, c;
    __host__ __device__ __forceinline__ void init(int M, int N, int G_, int c_) { nM = M / BM; nN = N / BM; nwg = nM * nN; G = G_; c = c_; }
    __host__ __device__ __forceinline__ bool next(int i, Unit& u) const {
        const long L = (long)i * G + c; if (L >= nwg) return false;
        int wgid = (int)L; { const int q = nwg / NXCD, r = nwg % NXCD, xcd = wgid % NXCD, off = wgid / NXCD; wgid = (xcd < r ? xcd * (q + 1) : r * (q + 1) + (xcd - r) * q) + off; }
        const int nig = WGM * nN, gid = wgid / nig, fm = gid * WGM, gsz = (nM - fm) < WGM ? (nM - fm) : WGM;
        u.pm = fm + ((wgid % nig) % gsz); u.pn = (wgid % nig) / gsz; u.sel = 0; return true;
    }
    __device__ __forceinline__ void a_ready(const Unit&) const {}
    __device__ __forceinline__ void done(const Unit&) const {}
};
struct TwoPartOrder {
    StaticOrder b;
    __device__ __forceinline__ bool next(int i, Unit& u) const { if (!b.next(i >> 1, u)) return false; u.sel = i & 1; return true; }
    __device__ __forceinline__ void a_ready(const Unit&) const {}
    __device__ __forceinline__ void done(const Unit&) const {}
};

typedef float f32x2_c __attribute__((ext_vector_type(2))); typedef __bf16 bf16x2_c __attribute__((ext_vector_type(2)));
__device__ __forceinline__ unsigned cvt_pk_bf16(float lo, float hi) { const f32x2_c v = {lo, hi}; return __builtin_bit_cast(unsigned, __builtin_convertvector(v, bf16x2_c)); }
__device__ __forceinline__ u32x4 pack8(const f32x4 a, const f32x4 b) { u32x4 w; w.x = cvt_pk_bf16(a[0], a[1]); w.y = cvt_pk_bf16(a[2], a[3]); w.z = cvt_pk_bf16(b[0], b[1]); w.w = cvt_pk_bf16(b[2], b[3]); return w; }
__device__ __forceinline__ float bflo(unsigned w) { return __uint_as_float(w << 16); }
__device__ __forceinline__ float bfhi(unsigned w) { return __uint_as_float(w & 0xffff0000u); }
__device__ __forceinline__ void unpack8(const u32x4 w, f32x4& a, f32x4& b) { a = (f32x4){bflo(w.x), bfhi(w.x), bflo(w.y), bfhi(w.y)}; b = (f32x4){bflo(w.z), bfhi(w.z), bflo(w.w), bfhi(w.w)}; }
__device__ __forceinline__ float sigmoidf_(float v) { return __builtin_amdgcn_rcpf(1.0f + __builtin_amdgcn_exp2f(-1.4426950408889634f * v)); }

constexpr float QSCALE = 0.125f * 1.4426950408889634f;

struct EpiUT {
    static constexpr bool PERM = true, AFTER_DRAIN = false;
    bf16_t* O; int ldc; const float* rstd;
    __device__ __forceinline__ bool keep(const Unit&) const { return false; }
    __device__ __forceinline__ void operator()(f32x4 (&acc)[2][2][4][2], const Unit& u, int wr, int wc, int fr, int fq) const {
        const int row0 = u.pm * BM + wr * 64 + fr, col0 = u.pn * BM + wc * 32 + 8 * fq;
        f32x4 rs[2][2];
#pragma unroll
        for (int bj = 0; bj < 2; ++bj)
#pragma unroll
            for (int n = 0; n < 2; ++n) rs[bj][n] = *(const f32x4*)(rstd + col0 + bj * HALF + 4 * n);
#pragma unroll
        for (int ai = 0; ai < 2; ++ai)
#pragma unroll
            for (int m = 0; m < 4; ++m) { bf16_t* rowp = O + (size_t)(row0 + ai * HALF + m * 16) * ldc + col0;
#pragma unroll
                for (int bj = 0; bj < 2; ++bj) *(u32x4*)(rowp + bj * HALF) = pack8(acc[ai][bj][m][0] * rs[bj][0], acc[ai][bj][m][1] * rs[bj][1]); }
    }
};

struct EpiProj {
    static constexpr bool PERM = true, AFTER_DRAIN = false;
    const float* rstd; const float* qw; const float* kw; const float* cs; const float* sn; bf16_t* q; bf16_t* k; bf16_t* v; bf16_t* sgh; bf16_t* sga;
    __device__ __forceinline__ bool keep(const Unit&) const { return false; }
    __device__ __forceinline__ void operator()(f32x4 (&acc)[2][2][4][2], const Unit& u, int wr, int wc, int fr, int fq) const {
        const int pn = u.pn;
        float rsv[2][4];
#pragma unroll
        for (int ai = 0; ai < 2; ++ai)
#pragma unroll
            for (int m = 0; m < 4; ++m) rsv[ai][m] = rstd[u.pm * BM + ai * HALF + wr * 64 + m * 16 + fr];
        if (pn <= 2 && !(pn == 2 && wc >= 2)) {
            const float* w = (pn < 2) ? qw : kw; const float sc = (pn < 2) ? QSCALE : 1.0f;
            const f32x4 wl0 = *(const f32x4*)(w + 8 * fq), wl1 = *(const f32x4*)(w + 8 * fq + 4), wh0 = *(const f32x4*)(w + 32 + 8 * fq), wh1 = *(const f32x4*)(w + 32 + 8 * fq + 4);
#pragma unroll
            for (int ai = 0; ai < 2; ++ai)
#pragma unroll
                for (int m = 0; m < 4; ++m) {
                    const int row = u.pm * BM + ai * HALF + wr * 64 + m * 16 + fr; const float rs = rsv[ai][m];
                    f32x4 a0 = acc[ai][0][m][0] * rs, a1 = acc[ai][0][m][1] * rs, b0 = acc[ai][1][m][0] * rs, b1 = acc[ai][1][m][1] * rs;
                    f32x4 sq = a0 * a0 + a1 * a1 + b0 * b0 + b1 * b1; float ss = (sq[0] + sq[1]) + (sq[2] + sq[3]);
                    ss += __shfl_xor(ss, 16); ss += __shfl_xor(ss, 32);
                    const float inv = 1.0f / sqrtf(ss * (1.0f / 64.0f) + 1e-6f);
                    const int pos = row < 16384 ? (row & 2047) : (row - 16384);
                    const f32x4 c0 = *(const f32x4*)(cs + pos * 32 + 8 * fq), c1 = *(const f32x4*)(cs + pos * 32 + 8 * fq + 4), s0 = *(const f32x4*)(sn + pos * 32 + 8 * fq), s1 = *(const f32x4*)(sn + pos * 32 + 8 * fq + 4);
                    a0 = a0 * inv * wl0; a1 = a1 * inv * wl1; b0 = b0 * inv * wh0; b1 = b1 * inv * wh1;
                    const f32x4 lo0 = (a0 * c0 - b0 * s0) * sc, lo1 = (a1 * c1 - b1 * s1) * sc, hi0 = (b0 * c0 + a0 * s0) * sc, hi1 = (b1 * c1 + a1 * s1) * sc;
                    bf16_t* dst = (pn < 2) ? q + (size_t)row * 512 + (4 * pn + wc) * 64 + 8 * fq : k + (size_t)row * 128 + wc * 64 + 8 * fq;
                    *(u32x4*)dst = pack8(lo0, lo1); *(u32x4*)(dst + 32) = pack8(hi0, hi1);
                }
        } else if (pn == 2) {
#pragma unroll
            for (int ai = 0; ai < 2; ++ai)
#pragma unroll
                for (int m = 0; m < 4; ++m) {
                    const int row = u.pm * BM + ai * HALF + wr * 64 + m * 16 + fr; const float rs = rsv[ai][m];
                    bf16_t* dst = v + (size_t)row * 128 + (wc - 2) * 64 + 8 * fq;
                    *(u32x4*)dst = pack8(acc[ai][0][m][0] * rs, acc[ai][0][m][1] * rs); *(u32x4*)(dst + 32) = pack8(acc[ai][1][m][0] * rs, acc[ai][1][m][1] * rs);
                }
        } else {
            bf16_t* base = (pn < 7) ? sgh : sga; const int colb = (pn - ((pn < 7) ? 3 : 7)) * BM + wc * 32 + 8 * fq;
#pragma unroll
            for (int ai = 0; ai < 2; ++ai)
#pragma unroll
                for (int m = 0; m < 4; ++m) {
                    const int row = u.pm * BM + ai * HALF + wr * 64 + m * 16 + fr; const float rs = rsv[ai][m];
#pragma unroll
                    for (int bj = 0; bj < 2; ++bj) { f32x4 g0 = acc[ai][bj][m][0] * rs, g1 = acc[ai][bj][m][1] * rs;
#pragma unroll
                        for (int e = 0; e < 4; ++e) { g0[e] = sigmoidf_(g0[e]); g1[e] = sigmoidf_(g1[e]); }
                        *(u32x4*)(base + (size_t)row * 1024 + colb + bj * HALF) = pack8(g0, g1); }
                }
        }
    }
};

struct EpiMerged {
    static constexpr bool PERM = true, AFTER_DRAIN = false;
    const bf16_t* sgh; const bf16_t* sga; bf16_t* out;
    __device__ __forceinline__ bool keep(const Unit& u) const { return u.sel == 0; }
    __device__ __forceinline__ void operator()(f32x4 (&acc)[2][2][4][2], const Unit& u, int wr, int wc, int fr, int fq) const {
#pragma unroll
        for (int ai = 0; ai < 2; ++ai) {
            u32x4 ga[4][2], gh[4][2];
#pragma unroll
            for (int m = 0; m < 4; ++m) { const size_t off = (size_t)(u.pm * BM + ai * HALF + wr * 64 + m * 16 + fr) * 1024 + u.pn * BM + wc * 32 + 8 * fq;
#pragma unroll
                for (int bj = 0; bj < 2; ++bj) { ga[m][bj] = *(const u32x4*)(sga + off + bj * HALF); if (u.sel == 0) gh[m][bj] = *(const u32x4*)(sgh + off + bj * HALF); } }
#pragma unroll
            for (int m = 0; m < 4; ++m) { const size_t off = (size_t)(u.pm * BM + ai * HALF + wr * 64 + m * 16 + fr) * 1024 + u.pn * BM + wc * 32 + 8 * fq;
#pragma unroll
                for (int bj = 0; bj < 2; ++bj) {
                    f32x4 t0, t1; unpack8(ga[m][bj], t0, t1);
                    if (u.sel == 0) { f32x4 h0, h1; unpack8(gh[m][bj], h0, h1);
                        f32x4 q0, q1;
#pragma unroll
                        for (int e = 0; e < 4; ++e) { q0[e] = h0[e] * __builtin_amdgcn_rcpf(t0[e]); q1[e] = h1[e] * __builtin_amdgcn_rcpf(t1[e]); }
                        acc[ai][bj][m][0] = acc[ai][bj][m][0] * q0; acc[ai][bj][m][1] = acc[ai][bj][m][1] * q1; }
                    else *(u32x4*)(out + off + bj * HALF) = pack8(acc[ai][bj][m][0] * t0, acc[ai][bj][m][1] * t1);
                } }
        }
    }
};

struct EpiWo {
    static constexpr bool PERM = true, AFTER_DRAIN = false;
    const float* xp; const float* xs; bf16_t* x1b; float* ssq;
    __device__ __forceinline__ bool keep(const Unit&) const { return false; }
    __device__ __forceinline__ void operator()(f32x4 (&acc)[2][2][4][2], const Unit& u, int wr, int wc, int fr, int fq) const {
        const float* xb = (u.pm < 64) ? xp : xs - (size_t)16384 * 1024;
#pragma unroll
        for (int ai = 0; ai < 2; ++ai) {
            f32x4 xv[4][2][2];
#pragma unroll
            for (int m = 0; m < 4; ++m) { const size_t off = (size_t)(u.pm * BM + ai * HALF + wr * 64 + m * 16 + fr) * 1024 + u.pn * BM + wc * 32 + 8 * fq;
#pragma unroll
                for (int bj = 0; bj < 2; ++bj) { xv[m][bj][0] = *(const f32x4*)(xb + off + bj * HALF); xv[m][bj][1] = *(const f32x4*)(xb + off + bj * HALF + 4); } }
#pragma unroll
            for (int m = 0; m < 4; ++m) {
                const int row = u.pm * BM + ai * HALF + wr * 64 + m * 16 + fr; const size_t off = (size_t)row * 1024 + u.pn * BM + wc * 32 + 8 * fq; float s = 0.f;
#pragma unroll
                for (int bj = 0; bj < 2; ++bj) {
                    const f32x4 v0 = xv[m][bj][0] + acc[ai][bj][m][0], v1 = xv[m][bj][1] + acc[ai][bj][m][1];
                    *(u32x4*)(x1b + off + bj * HALF) = pack8(v0, v1);
                    const f32x4 q = v0 * v0 + v1 * v1; s += (q[0] + q[1]) + (q[2] + q[3]); }
                s += __shfl_xor(s, 16); s += __shfl_xor(s, 32);
                if (fq == 0) ssq[(size_t)row * 16 + u.pn * 4 + wc] = s;
            }
        }
    }
};

struct EpiFfn1 {
    static constexpr bool PERM = true, AFTER_DRAIN = false;
    const float* ssq; bf16_t* hid;
    __device__ __forceinline__ bool keep(const Unit&) const { return false; }
    __device__ __forceinline__ void operator()(f32x4 (&acc)[2][2][4][2], const Unit& u, int wr, int wc, int fr, int fq) const {
        f32x4 pv[2][4];
#pragma unroll
        for (int ai = 0; ai < 2; ++ai)
#pragma unroll
            for (int m = 0; m < 4; ++m) pv[ai][m] = *(const f32x4*)(ssq + (size_t)(u.pm * BM + ai * HALF + wr * 64 + m * 16 + fr) * 16 + 4 * fq);
#pragma unroll
        for (int ai = 0; ai < 2; ++ai)
#pragma unroll
            for (int m = 0; m < 4; ++m) {
                const int row = u.pm * BM + ai * HALF + wr * 64 + m * 16 + fr;
                const f32x4 p = pv[ai][m]; float t = (p[0] + p[1]) + (p[2] + p[3]);
                t += __shfl_xor(t, 16); t += __shfl_xor(t, 32);
                const float r = 1.0f / sqrtf(t * (1.0f / 1024.0f) + 1e-6f);
                f32x4 h0, h1;
#pragma unroll
                for (int e = 0; e < 4; ++e) { const float g0 = acc[ai][0][m][0][e] * r, g1 = acc[ai][0][m][1][e] * r;
                    h0[e] = g0 * sigmoidf_(g0) * (acc[ai][1][m][0][e] * r); h1[e] = g1 * sigmoidf_(g1) * (acc[ai][1][m][1][e] * r); }
                *(u32x4*)(hid + (size_t)row * 2816 + u.pn * HALF + wc * 32 + 8 * fq) = pack8(h0, h1);
            }
    }
};

struct EpiFfn2 {
    static constexpr bool PERM = true, AFTER_DRAIN = false;
    const bf16_t* x1b; float* out;
    __device__ __forceinline__ bool keep(const Unit&) const { return false; }
    __device__ __forceinline__ void operator()(f32x4 (&acc)[2][2][4][2], const Unit& u, int wr, int wc, int fr, int fq) const {
        u32x4 rv[2][4][2];
#pragma unroll
        for (int ai = 0; ai < 2; ++ai)
#pragma unroll
            for (int m = 0; m < 4; ++m) { const size_t off = (size_t)(u.pm * BM + ai * HALF + wr * 64 + m * 16 + fr) * 1024 + u.pn * BM + wc * 32 + 8 * fq;
#pragma unroll
                for (int bj = 0; bj < 2; ++bj) rv[ai][m][bj] = *(const u32x4*)(x1b + off + bj * HALF); }
#pragma unroll
        for (int ai = 0; ai < 2; ++ai)
#pragma unroll
            for (int m = 0; m < 4; ++m) {
                const size_t off = (size_t)(u.pm * BM + ai * HALF + wr * 64 + m * 16 + fr) * 1024 + u.pn * BM + wc * 32 + 8 * fq; float* p = out + off;
#pragma unroll
                for (int bj = 0; bj < 2; ++bj) { f32x4 r0, r1; unpack8(rv[ai][m][bj], r0, r1);
                    *(f32x4*)(p + bj * HALF) = r0 + acc[ai][bj][m][0]; *(f32x4*)(p + bj * HALF + 4) = r1 + acc[ai][bj][m][1]; }
            }
    }
};

__device__ __forceinline__ void zero_acc(f32x4 (&acc)[2][2][4][2]) {
#pragma unroll
    for (int a = 0; a < 2; ++a)
#pragma unroll
        for (int b = 0; b < 2; ++b)
#pragma unroll
            for (int m = 0; m < 4; ++m)
#pragma unroll
                for (int n = 0; n < 2; ++n) acc[a][b][m][n] = (f32x4){0.f, 0.f, 0.f, 0.f};
}
template <class Epi, class Sched, bool ALIGN_EPI = false, bool SP2 = false>
__device__ __forceinline__ void gemm_phase(PG8_LAS unsigned char* lds, const Gemm g, const Sched& S, const Epi& E, int wave_in) {
    int tid; { unsigned m_ = ~0u; asm volatile("" : "+s"(m_)); tid = wave_in * 64 + (int)__builtin_amdgcn_mbcnt_hi(m_, __builtin_amdgcn_mbcnt_lo(m_, 0u)); }
    const int wid = __builtin_amdgcn_readfirstlane(tid >> 6), lane = tid & 63, wr = wid >> 2, wc = wid & 3, fr = lane & 15, fq = lane >> 4;
    const int K = g.K, nt = K / BK;
    unsigned voffA[2], voffB[2];
#pragma unroll
    for (int i = 0; i < 2; ++i) { int R, C; stage_rc(tid * 16 + i * 8192, R, C); const int Rb = Epi::PERM ? ((R & ~31) + perm32(R & 31)) : R;
        voffA[i] = (unsigned)(R * K + C) * 2u; voffB[i] = (unsigned)(Rb * K + C) * 2u; }
    const size_t kstep = (size_t)(BK * 2);
    const size_t hstep = (size_t)HALF * K * 2;
    const size_t tstep = 2 * hstep;
    const unsigned ldsw = (unsigned)wid * 1024u;
    const int aoff = lds_byte(wr * 64 + fr, fq * 8), boff = lds_byte(wc * 32 + fr, fq * 8);
#define PG8_SA(b, h) (((b) * 2 + (h)) * HTB)
#define PG8_SB(b, h) ((4 + (b) * 2 + (h)) * HTB)
#define PG8_STAGE(bufoff, gbase, voff) do { _Pragma("unroll") for (int _i = 0; _i < 2; ++_i) \
        __builtin_amdgcn_global_load_lds((const unsigned*)((const char*)(gbase) + (voff)[_i]), (PG8_LAS unsigned*)(lds + (bufoff) + ldsw + _i * 8192), 16, 0, 0); } while (0)
#define PG8_LDA(dst, b, h) do { _Pragma("unroll") for (int m = 0; m < 4; ++m) _Pragma("unroll") for (int k = 0; k < 2; ++k) dst[m][k] = *(const PG8_LAS bf16x8*)(lds + PG8_SA(b, h) + aoff + m * 2048 + k * 1024); } while (0)
#define PG8_LDB(dst, b, h) do { _Pragma("unroll") for (int n = 0; n < 2; ++n) _Pragma("unroll") for (int k = 0; k < 2; ++k) dst[n][k] = *(const PG8_LAS bf16x8*)(lds + PG8_SB(b, h) + boff + n * 2048 + k * 1024); } while (0)
#define PG8_MMA(ai, bj, At, Bt) do { __builtin_amdgcn_s_setprio(1); _Pragma("unroll") for (int m = 0; m < 4; ++m) _Pragma("unroll") for (int n = 0; n < 2; ++n) _Pragma("unroll") for (int k = 0; k < 2; ++k) \
        acc[ai][bj][m][n] = __builtin_amdgcn_mfma_f32_16x16x32_bf16(Bt[n][k], At[m][k], acc[ai][bj][m][n], 0, 0, 0); __builtin_amdgcn_s_setprio(0); } while (0)
#define PG8_WAIT_V(n) asm volatile("s_waitcnt vmcnt(" #n ")" ::: "memory")
#define PG8_WAIT_L(n) asm volatile("s_waitcnt lgkmcnt(" #n ")" ::: "memory")
#define PG8_BAR __builtin_amdgcn_s_barrier()
#define PG8_SCHED __builtin_amdgcn_sched_barrier(0)
    Unit cur, nxt; int ui = 0;
    if (!S.next(0, cur)) return;
    f32x4 acc[2][2][4][2];
#pragma unroll
    for (int a = 0; a < 2; ++a)
#pragma unroll
        for (int b = 0; b < 2; ++b)
#pragma unroll
            for (int m = 0; m < 4; ++m)
#pragma unroll
                for (int n = 0; n < 2; ++n) acc[a][b][m][n] = (f32x4){0.f, 0.f, 0.f, 0.f};
    bf16x8 At[4][2], B0[2][2], B1[2][2];
    const char* cA = (const char*)(cur.sel ? g.A1 : g.A) + (size_t)cur.pm * tstep; const char* cB = (const char*)(cur.sel ? g.Bt1 : g.Bt) + (size_t)cur.pn * tstep;
    S.a_ready(cur);
    if constexpr (SP2) {
        PG8_STAGE(PG8_SB(0, 0), cB, voffB); PG8_STAGE(PG8_SB(0, 1), cB + hstep, voffB); PG8_STAGE(PG8_SA(0, 0), cA, voffA); PG8_STAGE(PG8_SA(0, 1), cA + hstep, voffA);
        if (wr == 1) PG8_BAR;
        PG8_WAIT_V(2); PG8_BAR;
        PG8_STAGE(PG8_SB(1, 0), cB + kstep, voffB); PG8_STAGE(PG8_SA(1, 0), cA + kstep, voffA); PG8_STAGE(PG8_SB(1, 1), cB + hstep + kstep, voffB);
        PG8_WAIT_V(6); PG8_BAR;
    } else {
        PG8_STAGE(PG8_SB(0, 0), cB, voffB); PG8_STAGE(PG8_SA(0, 0), cA, voffA); PG8_STAGE(PG8_SB(0, 1), cB + hstep, voffB); PG8_STAGE(PG8_SA(0, 1), cA + hstep, voffA);
        if (wr == 1) PG8_BAR;
        PG8_WAIT_V(4); PG8_BAR;
        PG8_STAGE(PG8_SB(1, 0), cB + kstep, voffB); PG8_STAGE(PG8_SA(1, 0), cA + kstep, voffA); PG8_STAGE(PG8_SB(1, 1), cB + hstep + kstep, voffB);
        PG8_WAIT_V(6); PG8_BAR;
    }
    for (;;) {
        const bool has_next = S.next(ui + 1, nxt);
        const char* nA = has_next ? (const char*)(nxt.sel ? g.A1 : g.A) + (size_t)nxt.pm * tstep : cA; const char* nB = has_next ? (const char*)(nxt.sel ? g.Bt1 : g.Bt) + (size_t)nxt.pn * tstep : cB;
        for (int t = 0; t < nt; t += 2) {
            const bool last = (t == nt - 2);
            const char* a1 = cA + (size_t)(t + 1) * kstep;
            const char* a2 = last ? nA : cA + (size_t)(t + 2) * kstep; const char* b2 = last ? nB : cB + (size_t)(t + 2) * kstep;
            const char* a3 = a2 + kstep; const char* b3 = b2 + kstep;
            if (last && has_next) S.a_ready(nxt);
            if constexpr (SP2) {
            PG8_LDB(B0, 0, 0); PG8_LDB(B1, 0, 1); PG8_SCHED; PG8_LDA(At, 0, 0); PG8_STAGE(PG8_SA(1, 1), a1 + hstep, voffA);
            PG8_WAIT_V(8); PG8_WAIT_L(0); PG8_BAR; PG8_MMA(0, 0, At, B0); PG8_MMA(0, 1, At, B1); PG8_BAR; PG8_SCHED;
            PG8_LDA(At, 0, 1); PG8_STAGE(PG8_SB(0, 0), b2, voffB); PG8_STAGE(PG8_SB(0, 1), b2 + hstep, voffB); PG8_STAGE(PG8_SA(0, 0), a2, voffA);
            PG8_WAIT_V(8); PG8_WAIT_L(0); PG8_BAR; PG8_MMA(1, 0, At, B0); PG8_MMA(1, 1, At, B1); PG8_BAR; PG8_SCHED;
            PG8_LDB(B0, 1, 0); PG8_LDB(B1, 1, 1); PG8_SCHED; PG8_LDA(At, 1, 0); PG8_STAGE(PG8_SA(0, 1), a2 + hstep, voffA);
            PG8_WAIT_V(8); PG8_WAIT_L(0); PG8_BAR; PG8_MMA(0, 0, At, B0); PG8_MMA(0, 1, At, B1); PG8_BAR; PG8_SCHED;
            PG8_LDA(At, 1, 1); PG8_STAGE(PG8_SB(1, 0), b3, voffB); PG8_STAGE(PG8_SB(1, 1), b3 + hstep, voffB); PG8_STAGE(PG8_SA(1, 0), a3, voffA);
            PG8_WAIT_V(8); PG8_WAIT_L(0); PG8_BAR; PG8_MMA(1, 0, At, B0); PG8_MMA(1, 1, At, B1); PG8_BAR; PG8_SCHED;
            } else {
            PG8_LDB(B0, 0, 0); PG8_SCHED; PG8_LDA(At, 0, 0); PG8_STAGE(PG8_SA(1, 1), a1 + hstep, voffA);
            PG8_WAIT_L(8); PG8_BAR; PG8_WAIT_L(0); PG8_MMA(0, 0, At, B0); PG8_BAR; PG8_SCHED;
            PG8_LDB(B1, 0, 1); PG8_STAGE(PG8_SB(0, 0), b2, voffB);
            PG8_BAR; PG8_WAIT_L(0); PG8_MMA(0, 1, At, B1); PG8_BAR;
            PG8_LDA(At, 0, 1); PG8_STAGE(PG8_SA(0, 0), a2, voffA);
            PG8_BAR; PG8_WAIT_L(0); PG8_MMA(1, 0, At, B0); PG8_BAR; PG8_SCHED;
            PG8_STAGE(PG8_SB(0, 1), b2 + hstep, voffB);
            PG8_WAIT_V(6); PG8_BAR; PG8_MMA(1, 1, At, B1); PG8_BAR;
            PG8_LDB(B0, 1, 0); PG8_SCHED; PG8_LDA(At, 1, 0); PG8_STAGE(PG8_SA(0, 1), a2 + hstep, voffA);
            PG8_WAIT_L(8); PG8_BAR; PG8_WAIT_L(0); PG8_MMA(0, 0, At, B0); PG8_BAR; PG8_SCHED;
            PG8_LDB(B1, 1, 1); PG8_STAGE(PG8_SB(1, 0), b3, voffB);
            PG8_BAR; PG8_WAIT_L(0); PG8_MMA(0, 1, At, B1); PG8_BAR;
            PG8_LDA(At, 1, 1); PG8_STAGE(PG8_SA(1, 0), a3, voffA);
            PG8_BAR; PG8_WAIT_L(0); PG8_MMA(1, 0, At, B0); PG8_BAR; PG8_SCHED;
            PG8_STAGE(PG8_SB(1, 1), b3 + hstep, voffB);
            PG8_WAIT_V(6); PG8_BAR; PG8_MMA(1, 1, At, B1); PG8_BAR;
            }
        }
        if constexpr (ALIGN_EPI) { if (wr == 0) PG8_BAR; }
#if PROBE >= 51 && PROBE <= 58
        const unsigned long long te0_ = __builtin_amdgcn_s_memrealtime();
#endif
        if constexpr (!Epi::AFTER_DRAIN) { E(acc, cur, wr, wc, fr, fq); S.done(cur); }
#if PROBE >= 51 && PROBE <= 58
        { asm volatile("s_waitcnt vmcnt(0)" ::: "memory"); const unsigned long long te1_ = __builtin_amdgcn_s_memrealtime();
          volatile PG8_LAS unsigned* mw_ = (volatile PG8_LAS unsigned*)(lds + 147264);
          if (blockIdx.x == 0 && tid == 0 && mw_[47] == (unsigned)(PROBE - 50)) mw_[46] += (unsigned)(te1_ - te0_); }
#endif
        if (!has_next) break;
        if (!E.keep(cur)) zero_acc(acc);
        cur = nxt; cA = nA; cB = nB; ++ui;
        if constexpr (ALIGN_EPI) { if (wr == 1) PG8_BAR; }
    }
    PG8_WAIT_V(0);
    if constexpr (!ALIGN_EPI) { if (wr == 0) PG8_BAR; }
    PG8_BAR;
    if constexpr (Epi::AFTER_DRAIN) { E.fused(acc, cur, wr, wc, fr, fq, lds, wid, lane); S.done(cur); }
#undef PG8_SA
#undef PG8_SB
#undef PG8_STAGE
#undef PG8_LDA
#undef PG8_LDB
#undef PG8_MMA
#undef PG8_WAIT_V
#undef PG8_WAIT_L
#undef PG8_BAR
#undef PG8_SCHED
}}

constexpr int NWAVES = 8;
constexpr int DM = 1024, MTOK = 32768, TP = 16384  , LP = 2048, LS = 16384;
constexpr int HW = 512, INW = 4352, FFN = 2816, NPROJ = INW - 3 * HW  ;
constexpr float RMS_EPS = 1e-6f;

constexpr size_t MiB = 1u << 20;
constexpr size_t WS_CTL = 0, CTL_ZERO_BYTES = 128 * 1024;
constexpr size_t WS_WINA = 1 * MiB;
constexpr size_t WS_WINB = 4 * MiB;
constexpr size_t WS_WHY = 10 * MiB;
constexpr size_t WS_WAT = 11 * MiB;
constexpr size_t WS_WO = 12 * MiB;
constexpr size_t WS_WGU = 14 * MiB;
constexpr size_t WS_WD = 25 * MiB;
constexpr size_t WS_W3T = 31 * MiB;
constexpr size_t WS_W3F = WS_W3T + 512 * 1024;
constexpr size_t WS_XB = 32 * MiB;
constexpr size_t WS_YT = 32 * MiB;
constexpr size_t WS_YAT = 64 * MiB;
constexpr size_t WS_KREV_S = 96 * MiB;
constexpr size_t WS_KREV_P = 160 * MiB;
constexpr size_t WS_UT = 168 * MiB;
constexpr size_t WS_Q = 264 * MiB;
constexpr size_t WS_K = 296 * MiB;
constexpr size_t WS_V = 304 * MiB;
constexpr size_t WS_SGH = 312 * MiB;
constexpr size_t WS_SGA = 376 * MiB;
constexpr size_t WS_COS = 440 * MiB;
constexpr size_t WS_SIN = 442 * MiB;
constexpr size_t WS_RSTD = 444 * MiB;
constexpr size_t WS_SSQ = 445 * MiB;
constexpr size_t WS_FPART_S = 447 * MiB;
constexpr size_t WS_FPART_P = 449 * MiB;
constexpr size_t WS_YHY = 450 * MiB;
constexpr size_t WS_MERGED = 168 * MiB;
constexpr size_t WS_X1B = 232 * MiB;
constexpr size_t WS_HID = 32 * MiB;
constexpr size_t WS_HS = 450 * MiB;
constexpr size_t WS_Z1S = 488 * MiB;
constexpr size_t WS_END = 504 * MiB;
static_assert(WS_HID + (size_t)MTOK * FFN * 2 <= WS_X1B, "hid vs x1b");

constexpr int CW_TMO = 0, CW_CODE = 1;
constexpr int CW_BAR = 4096;

constexpr int RING_OFF = 0;
constexpr int LDS_BYTES = 147456;
constexpr int LDSCTL_OFF = LDS_BYTES - 512, MISC_OFF = LDSCTL_OFF + 320;

#define GAS __attribute__((address_space(1)))
#define LAS __attribute__((address_space(3)))
typedef unsigned short bf16;
typedef unsigned v4u __attribute__((ext_vector_type(4)));
typedef unsigned v2u __attribute__((ext_vector_type(2)));
typedef float f32x4 __attribute__((ext_vector_type(4)));
typedef float f32x16 __attribute__((ext_vector_type(16)));
typedef short bf16x8 __attribute__((ext_vector_type(8)));
typedef GAS unsigned gu32;
#define RLX_AGENT __ATOMIC_RELAXED, __HIP_MEMORY_SCOPE_AGENT
#define LDS_WAIT() asm volatile("s_waitcnt lgkmcnt(0)" ::: "memory")
#define VM_WAIT() asm volatile("s_waitcnt vmcnt(0)" ::: "memory")
typedef float f32x2_t_ __attribute__((ext_vector_type(2))); typedef __bf16 bf16x2_t_ __attribute__((ext_vector_type(2)));
__device__ __forceinline__ unsigned pk2(float lo, float hi) { const f32x2_t_ v = {lo, hi}; return __builtin_bit_cast(unsigned, __builtin_convertvector(v, bf16x2_t_)); }
__device__ __forceinline__ unsigned f2bf(float f) { return (unsigned)__builtin_bit_cast(unsigned short, (__bf16)f); }
__device__ __forceinline__ float bf2f(unsigned short b) { return __uint_as_float((unsigned)b << 16); }
__device__ __forceinline__ float wave_sum(float v) {
#pragma unroll
    for (int o = 1; o < 64; o <<= 1) v += __shfl_xor(v, o);
    return v;
}

__device__ __forceinline__ int fresh_lane() { unsigned m = ~0u; asm volatile("" : "+s"(m)); return (int)__builtin_amdgcn_mbcnt_hi(m, __builtin_amdgcn_mbcnt_lo(m, 0u)); }
__device__ __forceinline__ int fresh_tid(int wave) { return wave * 64 + fresh_lane(); }

__device__ __forceinline__ float wave_sum_sw(float v) {
#define SWZ_(x, m) __builtin_bit_cast(float, __builtin_amdgcn_ds_swizzle(__builtin_bit_cast(int, (x)), (((m) << 10) | 0x1f)))
    v += SWZ_(v, 1); v += SWZ_(v, 2); v += SWZ_(v, 4); v += SWZ_(v, 8); v += SWZ_(v, 16);
#undef SWZ_
    return __builtin_bit_cast(float, __builtin_amdgcn_readlane(__builtin_bit_cast(int, v), 0)) + __builtin_bit_cast(float, __builtin_amdgcn_readlane(__builtin_bit_cast(int, v), 32));
}

#define XB_TMO      128
#define XB_XCNT(j)  (256  + 64 * (j))
#define XB_XSUB(j)  (1280 + 64 * (j))
#define XB_XGEN(j)  (2304 + 64 * (j))
#define XB_TOP      3328
#define XB_TOPGEN   3392
#define XCD_BAR_WORDS 3456
#define XB_SPIN_CAP (1u << 18)

__device__ __forceinline__ unsigned xb_ld(unsigned* p)              { return __hip_atomic_load(p, __ATOMIC_RELAXED, __HIP_MEMORY_SCOPE_AGENT); }
__device__ __forceinline__ unsigned xb_add(unsigned* p, unsigned v) { return __hip_atomic_fetch_add(p, v, __ATOMIC_RELAXED, __HIP_MEMORY_SCOPE_AGENT); }
__device__ __forceinline__ unsigned xb_xcc_id() { return (unsigned)__builtin_amdgcn_s_getreg((3 << 11) | 20) & 0xFu; }
#define XB_SPIN(cond, bar) do { unsigned _sp = 0; while (cond) { __builtin_amdgcn_s_sleep(1); \
    if ((++_sp & 255u) == 0u) { if (xb_ld(&(bar)[XB_TMO])) break; if (_sp > XB_SPIN_CAP) { atomicAdd(&(bar)[XB_TMO], 1u); break; } } } } while (0)

struct XcdBarrier { unsigned* bar; unsigned x; volatile LAS unsigned* st; int wave; };

__device__ __forceinline__ XcdBarrier xcd_barrier_post(unsigned* bar, volatile LAS unsigned* st, int wave) {
    XcdBarrier b; b.bar = bar; b.x = xb_xcc_id(); b.st = st; b.wave = wave;
    if (fresh_tid(wave) == 0) (void)xb_add(&bar[XB_XCNT(b.x)], 1u);
    return b;
}
__device__ __forceinline__ void xcd_barrier_complete(unsigned* bar, unsigned x, unsigned& nloc, unsigned& nx) {
    const unsigned G = gridDim.x * gridDim.y * gridDim.z;
    unsigned sum, cnt, mine, sp = 0u;
    for (;;) {
        sum = 0u; cnt = 0u; mine = 0u;
#pragma unroll
        for (unsigned j = 0; j < 16; ++j) { const unsigned c = xb_ld(&bar[XB_XCNT(j)]); sum += c; cnt += (c > 0u) ? 1u : 0u; mine = (j == x) ? c : mine; }
        if (sum == G) break;
        __builtin_amdgcn_s_sleep(1);
        if ((++sp & 255u) == 0u) { if (xb_ld(&bar[XB_TMO])) break; if (sp > XB_SPIN_CAP) { atomicAdd(&bar[XB_TMO], 1u); break; } }
    }
    nloc = mine > 0u ? mine : 1u; nx = cnt > 0u ? cnt : 1u;
}
__device__ __forceinline__ void xcd_barrier(const XcdBarrier& b) {
    asm volatile("s_waitcnt vmcnt(0)" ::: "memory");
    __syncthreads();
    if (fresh_tid(b.wave) == 0) {
        unsigned* bar = b.bar;
        __builtin_amdgcn_s_waitcnt(0);
        unsigned nloc = b.st[0], nx = b.st[1];
        if (nloc == 0u) { xcd_barrier_complete(bar, b.x, nloc, nx); b.st[0] = nloc; b.st[1] = nx; }
        const unsigned old = xb_add(&bar[XB_XSUB(b.x)], 1u);
        const unsigned gen = old / nloc;
        if (old + 1u == (gen + 1u) * nloc) {
            __builtin_amdgcn_fence(__ATOMIC_RELEASE, "agent");
            asm volatile("s_waitcnt vmcnt(0)" ::: "memory");
            const unsigned og = xb_add(&bar[XB_TOP], 1u);
            const unsigned tg = og / nx;
            if (og + 1u == (tg + 1u) * nx) xb_add(&bar[XB_TOPGEN], 1u);
            else XB_SPIN(xb_ld(&bar[XB_TOPGEN]) == tg, bar);
            __builtin_amdgcn_fence(__ATOMIC_ACQUIRE, "agent");
            xb_add(&bar[XB_XGEN(b.x)], 1u);
            asm volatile("s_waitcnt vmcnt(0)" ::: "memory");
        } else {
            XB_SPIN(xb_ld(&bar[XB_XGEN(b.x)]) == gen, bar);
            __builtin_amdgcn_fence(__ATOMIC_ACQUIRE, "agent");
            asm volatile("s_waitcnt vmcnt(0)" ::: "memory");
        }
    }
    __syncthreads();
}

struct Frame {
    LAS unsigned char* lds;
    volatile LAS unsigned* MISC;
    gu32* ctl;
    int tid, lane, wave;
    int vcu, G;
    unsigned char* ws;
};

__device__ __forceinline__ void p0_transpose_item(const float* W, int K, int N, bf16* WT, int dst_row0, const float* kscale, LAS float* scr, int k0, int n0, int lane) {
    float wv[32];
#pragma unroll
    for (int i = 0; i < 32; ++i) wv[i] = W[(size_t)(k0 + 2 * i + (lane >> 5)) * N + n0 + (lane & 31)];
    if (kscale) {
#pragma unroll
        for (int i = 0; i < 32; ++i) wv[i] *= kscale[k0 + 2 * i + (lane >> 5)];
    }
#pragma unroll
    for (int i = 0; i < 32; ++i) scr[(2 * i + (lane >> 5)) * 33 + (lane & 31)] = wv[i];
    LDS_WAIT(); asm volatile("" ::: "memory");
    const int c = lane & 7;
#pragma unroll
    for (int j = 0; j < 4; ++j) { const int n = (lane >> 3) + 8 * j; const LAS float* s = scr + (8 * c) * 33 + n;
        v4u o; o.x = pk2(s[0 * 33], s[1 * 33]); o.y = pk2(s[2 * 33], s[3 * 33]); o.z = pk2(s[4 * 33], s[5 * 33]); o.w = pk2(s[6 * 33], s[7 * 33]);
        *(GAS v4u*)(WT + (size_t)(dst_row0 + n) * K + k0 + 8 * c) = o; }
    LDS_WAIT(); asm volatile("" ::: "memory");
}
__device__ __forceinline__ int map_projB(int n0) {
    if (n0 < 2048) { const int t = n0 - 1536, hq = t >> 6, hf = (t >> 5) & 1; return 256 * (hq >> 2) + 128 * hf + 32 * (hq & 3); }
    if (n0 < 2176) { const int t = n0 - 2048, kh = t >> 6, hf = (t >> 5) & 1; return 512 + 128 * hf + 32 * kh; }
    if (n0 < 2304) { const int t = n0 - 2176, vh = t >> 6, hf = (t >> 5) & 1; return 512 + 128 * hf + 32 * (2 + vh); }
    return 768 + (n0 - 2304);
}
__device__ __forceinline__ void p0_row(const float* xrow, bf16* orow, float* rstd_out, int lane) {
    const GAS f32x4* xr = (const GAS f32x4*)xrow + lane;
    f32x4 v[4]; float s = 0.f;
#pragma unroll
    for (int j = 0; j < 4; ++j) { v[j] = xr[64 * j]; s += (v[j].x * v[j].x + v[j].y * v[j].y) + (v[j].z * v[j].z + v[j].w * v[j].w); }
    s = wave_sum(s);
    if (lane == 0) *rstd_out = 1.0f / sqrtf(s * (1.0f / DM) + RMS_EPS);
    GAS unsigned long long* o8 = (GAS unsigned long long*)orow + lane;
#pragma unroll
    for (int j = 0; j < 4; ++j) o8[64 * j] = (unsigned long long)pk2(v[j].x, v[j].y) | ((unsigned long long)pk2(v[j].z, v[j].w) << 32);
}
__device__ __forceinline__ void p0_row2(const float* xa, const float* xb_, bf16* oa, bf16* ob, float* ra, float* rb, int lane) {
    const GAS f32x4* pa = (const GAS f32x4*)xa + lane; const GAS f32x4* pb = (const GAS f32x4*)xb_ + lane;
    f32x4 va[4], vb[4]; float sa = 0.f, sb = 0.f;
#pragma unroll
    for (int j = 0; j < 4; ++j) { va[j] = pa[64 * j]; vb[j] = pb[64 * j]; }
#pragma unroll
    for (int j = 0; j < 4; ++j) { sa += (va[j].x * va[j].x + va[j].y * va[j].y) + (va[j].z * va[j].z + va[j].w * va[j].w); sb += (vb[j].x * vb[j].x + vb[j].y * vb[j].y) + (vb[j].z * vb[j].z + vb[j].w * vb[j].w); }
    sa = wave_sum(sa); sb = wave_sum(sb);
    if (lane == 0) { *ra = 1.0f / sqrtf(sa * (1.0f / DM) + RMS_EPS); *rb = 1.0f / sqrtf(sb * (1.0f / DM) + RMS_EPS); }
    GAS unsigned long long* o8a = (GAS unsigned long long*)oa + lane; GAS unsigned long long* o8b = (GAS unsigned long long*)ob + lane;
#pragma unroll
    for (int j = 0; j < 4; ++j) { o8a[64 * j] = (unsigned long long)pk2(va[j].x, va[j].y) | ((unsigned long long)pk2(va[j].z, va[j].w) << 32); o8b[64 * j] = (unsigned long long)pk2(vb[j].x, vb[j].y) | ((unsigned long long)pk2(vb[j].z, vb[j].w) << 32); }
}
constexpr int FW_W1 = 0, FW_W2 = 33 * 64 * 4, FW_B1 = FW_W2 + 64 * 64 * 4, FW_B2 = FW_B1 + 256, FW_FR = FW_B2 + 256, FW_END = FW_FR + 256, FT_PITCH = 144, FT_BYTES = 32 * FT_PITCH;
__device__ __forceinline__ void filter_stage_weights(LAS unsigned char* lds, const float* w1, const float* b1, const float* w2, const float* b2, const float* fr, int tid) {
    LAS float* W1 = (LAS float*)(lds + FW_W1); LAS float* W2 = (LAS float*)(lds + FW_W2);
    for (int i = tid; i < 33 * 64; i += NWAVES * 64) W1[i] = w1[i];
    for (int i = tid; i < 64 * 64; i += NWAVES * 64) W2[i] = w2[i];
    if (tid < 64) { ((LAS float*)(lds + FW_B1))[tid] = b1[tid]; ((LAS float*)(lds + FW_B2))[tid] = b2[tid]; ((LAS float*)(lds + FW_FR))[tid] = fr[tid]; }
    LDS_WAIT(); __syncthreads();
}
__device__ __forceinline__ void p0_w3f_item(const float* w3, bf16* w3f, int tile, int lane) {
    const int r = lane & 31, h = lane >> 5;
#pragma unroll
    for (int kk = 0; kk < 4; ++kk) { float v[8];
#pragma unroll
        for (int j = 0; j < 8; ++j) v[j] = w3[(size_t)(32 * (kk >> 1) + 16 * (kk & 1) + 8 * (j >> 2) + 4 * h + (j & 3)) * 2048 + 32 * tile + r];
        *(GAS v4u*)(w3f + ((size_t)(tile * 4 + kk) * 64 + lane) * 8) = (v4u){pk2(v[0], v[1]), pk2(v[2], v[3]), pk2(v[4], v[5]), pk2(v[6], v[7])}; }
}
__device__ __forceinline__ bf16x8 pack_hi8(const float (&v)[8]) { v4u w; w.x = pk2(v[0], v[1]); w.y = pk2(v[2], v[3]); w.z = pk2(v[4], v[5]); w.w = pk2(v[6], v[7]); return __builtin_bit_cast(bf16x8, w); }
__device__ __forceinline__ void split8(const float (&v)[8], bf16x8& hi, bf16x8& lo) {
    v4u wh, wl;
#pragma unroll
    for (int d = 0; d < 4; ++d) { const unsigned ph = pk2(v[2 * d], v[2 * d + 1]); wh[d] = ph; wl[d] = pk2(v[2 * d] - pg8::bflo(ph), v[2 * d + 1] - pg8::bfhi(ph)); }
    hi = __builtin_bit_cast(bf16x8, wh); lo = __builtin_bit_cast(bf16x8, wl);
}
__device__ __forceinline__ void filter_item(LAS unsigned char* lds, const bf16* w3f, bf16* krev, float* fpart, int g, int chunk, int dir, int wave, int lane_) {
    int lane = lane_; asm volatile("" : "+v"(lane));
    const int L = g ? LS : LP, r = lane & 31, h = lane >> 5;
    const LAS float* W1 = (const LAS float*)(lds + FW_W1); const LAS float* W2 = (const LAS float*)(lds + FW_W2);
    const LAS float* B1 = (const LAS float*)(lds + FW_B1); const LAS float* B2 = (const LAS float*)(lds + FW_B2); const LAS float* FR = (const LAS float*)(lds + FW_FR);
    LAS unsigned char* T = lds + FW_END + wave * FT_BYTES;
    const f32x16 zero16 = (f32x16){0.f,0.f,0.f,0.f,0.f,0.f,0.f,0.f,0.f,0.f,0.f,0.f,0.f,0.f,0.f,0.f};
    bf16x8 w1f[2][3], w2f[2][4];
    {
        const LAS float* w1b = W1 + (8 * h) * 64 + r; const LAS float* w2b = W2 + (4 * h) * 64 + r;
#pragma unroll
        for (int mt = 0; mt < 2; ++mt) {
#pragma unroll
            for (int ks = 0; ks < 2; ++ks) { float v[8];
#pragma unroll
                for (int j = 0; j < 8; ++j) v[j] = w1b[(16 * ks + j) * 64 + 32 * mt];
                w1f[mt][ks] = pack_hi8(v); }
            const float v32 = W1[32 * 64 + 32 * mt + r];
            w1f[mt][2] = __builtin_bit_cast(bf16x8, (v4u){h ? 0u : pk2(v32, 0.f), 0u, 0u, 0u});
            __builtin_amdgcn_sched_barrier(0);
        }
#pragma unroll
        for (int mt2 = 0; mt2 < 2; ++mt2)
#pragma unroll
            for (int kk = 0; kk < 4; ++kk) { float v[8];
#pragma unroll
                for (int j = 0; j < 8; ++j) v[j] = w2b[(32 * (kk >> 1) + 16 * (kk & 1) + 8 * (j >> 2) + (j & 3)) * 64 + 32 * mt2];
                w2f[mt2][kk] = pack_hi8(v); __builtin_amdgcn_sched_barrier(0); }
    }
    bf16x8 afr[2][4];
#pragma unroll
    for (int hf = 0; hf < 2; ++hf) {
        int pos = 64 * chunk + 32 * hf + r + dir; if (pos > L - 1) pos = L - 1;
        int h4 = 4 * h; asm volatile("" : "+v"(h4));
        const LAS float* frb = FR + h4; const LAS float* b1b = B1 + h4; const LAS float* b2b = B2 + h4;
        const float t = (float)pos / (float)(L - 1), prev = (float)pos * (1.0f / (float)L);
        f32x16 d1[2]; d1[0] = zero16; d1[1] = zero16;
        {
            float rev[8];
            const float stepb = (15.0f - 1e-4f) / 15.0f, b0 = 1e-4f + (float)(8 * h - 1) * stepb;
#pragma unroll
            for (int j = 0; j < 8; ++j) rev[j] = prev * (b0 + (float)j * stepb);
            const float rev15 = prev * 15.0f;
#pragma unroll
            for (int ks = 0; ks < 3; ++ks) { float z[8];
                if (ks < 2) {
#pragma unroll
                    for (int j = 0; j < 8; ++j) z[j] = __builtin_amdgcn_cosf(rev[j] + (ks ? 0.25f : 0.0f));
                    const float sp = ks ? __builtin_amdgcn_cosf(rev15) : t; z[0] = h ? z[0] : sp;
                } else {
#pragma unroll
                    for (int j = 0; j < 8; ++j) z[j] = 0.f;
                    z[0] = h ? 0.f : __builtin_amdgcn_cosf(rev15 + 0.25f);
                }
                bf16x8 zh, zl; split8(z, zh, zl);
#pragma unroll
                for (int mt = 0; mt < 2; ++mt) { d1[mt] = __builtin_amdgcn_mfma_f32_32x32x16_bf16(w1f[mt][ks], zh, d1[mt], 0, 0, 0); d1[mt] = __builtin_amdgcn_mfma_f32_32x32x16_bf16(w1f[mt][ks], zl, d1[mt], 0, 0, 0); }
                __builtin_amdgcn_sched_barrier(0); }
        }
        f32x16 d2[2]; d2[0] = zero16; d2[1] = zero16;
#pragma unroll
        for (int mt = 0; mt < 2; ++mt)
#pragma unroll
            for (int s = 0; s < 2; ++s) { float v[8];
#pragma unroll
                for (int j = 0; j < 8; ++j) { const int hid = 32 * mt + ((8 * s + j) & 3) + 8 * ((8 * s + j) >> 2); v[j] = __sinf(frb[hid] * (d1[mt][8 * s + j] + b1b[hid])); }
                bf16x8 vh, vl; split8(v, vh, vl);
#pragma unroll
                for (int mt2 = 0; mt2 < 2; ++mt2) { d2[mt2] = __builtin_amdgcn_mfma_f32_32x32x16_bf16(w2f[mt2][2 * mt + s], vh, d2[mt2], 0, 0, 0); d2[mt2] = __builtin_amdgcn_mfma_f32_32x32x16_bf16(w2f[mt2][2 * mt + s], vl, d2[mt2], 0, 0, 0); }
                __builtin_amdgcn_sched_barrier(0); }
#pragma unroll
        for (int mt2 = 0; mt2 < 2; ++mt2)
#pragma unroll
            for (int s = 0; s < 2; ++s) { float v[8];
#pragma unroll
                for (int j = 0; j < 8; ++j) { const int hid = 32 * mt2 + ((8 * s + j) & 3) + 8 * ((8 * s + j) >> 2); v[j] = __sinf(frb[hid] * (d2[mt2][8 * s + j] + b2b[hid])); }
                afr[hf][2 * mt2 + s] = pack_hi8(v); __builtin_amdgcn_sched_barrier(0); }
    }
#if PROBE
    if (blockIdx.x == 0 && wave == 0 && lane == 0) { volatile LAS unsigned* M_ = (volatile LAS unsigned*)(lds + MISC_OFF); const unsigned long long t_ = __builtin_amdgcn_s_memrealtime(); M_[16 + 2 * 13] = (unsigned)t_; M_[17 + 2 * 13] = (unsigned)(t_ >> 32); }
#endif
    const float dmin = -4.605170185988091f / 1.5f, dmax = -4.605170185988091f / 0.3f;
    const int p0 = 64 * chunk; const int mstart = g ? (dir ? (2 * L - p0 - 64) : p0) : (dir ? (L + p0) : (L - 64 - p0));
    const bool last = (p0 + 64 + dir > L);
    const float il = 1.0f / (float)(L - 1);
    const bool fwd = ((dir != 0) != (g != 0));
    const bf16* wfl = w3f + (size_t)dir * (16 * 4 * 512) + lane * 8;
    bf16x8 bnx[4];
#pragma unroll
    for (int kk = 0; kk < 4; ++kk) bnx[kk] = *(const GAS bf16x8*)(wfl + kk * 512);
    for (int ti = 0; ti < 32; ++ti) {
        const int o_ = ti >> 4, cb = 32 * (ti & 15), colg = (2 * o_ + dir) * 512 + cb;
        bf16x8 bfr[4];
#pragma unroll
        for (int kk = 0; kk < 4; ++kk) bfr[kk] = bnx[kk];
        { const int tn = (ti < 31) ? ti + 1 : 31; const bf16* wn = wfl + (size_t)((tn >> 4) * 32 + (tn & 15)) * (4 * 512);
#pragma unroll
          for (int kk = 0; kk < 4; ++kk) bnx[kk] = *(const GAS bf16x8*)(wn + kk * 512); }
        const float delta = fabsf(dmin + (float)(cb + r) * ((dmax - dmin) / 511.0f)), dl = -delta * il * 1.4426950408889634f;
        const float q1 = __builtin_amdgcn_exp2f(dl), q2 = q1 * q1, q3 = q2 * q1, q8 = __builtin_amdgcn_exp2f(8.f * dl), q16 = q8 * q8, q24 = q16 * q8;
        const float e0 = __builtin_amdgcn_exp2f(dl * (float)(p0 + dir + 4 * h)), e1 = e0 * __builtin_amdgcn_exp2f(32.f * dl);
        const float qa[4] = {1.f, q1, q2, q3}; const float eb[2][4] = {{e0, e0 * q8, e0 * q16, e0 * q24}, {e1, e1 * q8, e1 * q16, e1 * q24}};
        float asum = 0.f;
#pragma unroll
        for (int hf = 0; hf < 2; ++hf) {
            f32x16 acc = zero16;
#pragma unroll
            for (int kk = 0; kk < 4; ++kk) acc = __builtin_amdgcn_mfma_f32_32x32x16_bf16(afr[hf][kk], bfr[kk], acc, 0, 0, 0);
#pragma unroll
            for (int m = 0; m < 4; ++m) {
                float kv[4];
#pragma unroll
                for (int e = 0; e < 4; ++e) kv[e] = acc[4 * m + e] * (eb[hf][m] * qa[e] + 0.05f);
                if (hf == 1 && m == 3) { if (last && h == 1) kv[3] = 0.f; }
                asum += (fabsf(kv[0]) + fabsf(kv[1])) + (fabsf(kv[2]) + fabsf(kv[3]));
                const int i0 = 32 * hf + 8 * m + 4 * h;
                const v2u w = fwd ? (v2u){pk2(kv[0], kv[1]), pk2(kv[2], kv[3])} : (v2u){pk2(kv[3], kv[2]), pk2(kv[1], kv[0])};
                *(LAS v2u*)(T + r * FT_PITCH + (fwd ? i0 : 60 - i0) * 2) = w;
            }
        }
        asum += __shfl_xor(asum, 32);
        if (h == 0) fpart[(size_t)chunk * 2048 + colg + r] = asum;
        LDS_WAIT(); asm volatile("" ::: "memory");
        {
            const int c0 = lane >> 3, pc = lane & 7;
            bf16* dst = krev + (size_t)(o_ * 512 + cb + c0) * (2 * L) + mstart + 8 * pc;
            v4u sv[4];
#pragma unroll
            for (int q = 0; q < 4; ++q) sv[q] = *(const LAS v4u*)(T + (c0 + 8 * q) * FT_PITCH + 16 * pc);
#pragma unroll
            for (int q = 0; q < 4; ++q) *(GAS v4u*)(dst + (size_t)(8 * q) * (2 * L)) = sv[q];
        }
        LDS_WAIT(); asm volatile("" ::: "memory");
    }
}

namespace hy {
constexpr int SLOTB = 272, Z_BYTES = 75776, F_OFF = 75776, F_BYTES = 65536, RED_OFF = F_OFF + F_BYTES;
__device__ __forceinline__ int slot_of(int g, int n) { return g ? (n + 31) : ((n >> 4) * 32 + 16 + (n & 15)); }
__device__ __forceinline__ int crow(int r, int hi) { return (r & 3) + 8 * (r >> 2) + 4 * hi; }

struct Params { const bf16* uT; const bf16* krev_s; const bf16* krev_p; const float* fpart_s; const float* fpart_p; const float* conv_w; const float* conv_b; const float* hbias; bf16* yT; float* dF; bf16* dZ; };

__device__ __forceinline__ void conv3_chunk(const bf16* urow  , int g, int chunk, float w0, float w1, float w2, float b, float (&out)[8]) {
    const int tau0 = chunk * 8; const int L = g ? LS : LP; const int p0 = g ? tau0 : (tau0 & (LP - 1));
    const v4u raw = *(const GAS v4u*)(urow + tau0);
    float u[10];
    u[1] = pg8::bflo(raw.x); u[2] = pg8::bfhi(raw.x); u[3] = pg8::bflo(raw.y); u[4] = pg8::bfhi(raw.y); u[5] = pg8::bflo(raw.z); u[6] = pg8::bfhi(raw.z); u[7] = pg8::bflo(raw.w); u[8] = pg8::bfhi(raw.w);
    u[0] = (p0 > 0) ? bf2f(urow[tau0 - 1]) : 0.f;
    u[9] = (p0 + 8 < L) ? bf2f(urow[tau0 + 8]) : 0.f;
#pragma unroll
    for (int i = 0; i < 8; ++i) out[i] = w0 * u[i] + w1 * u[i + 1] + w2 * u[i + 2] + b;
}

struct C3 { v4u raw; float prev, next; };
__device__ __forceinline__ void conv3_load(const bf16* urow, int g, int chunk, C3& q) {
    const int tau0 = chunk * 8; const int L = g ? LS : LP; const int p0 = g ? tau0 : (tau0 & (LP - 1));
    q.raw = *(const GAS v4u*)(urow + tau0);
    q.prev = (p0 > 0) ? bf2f(urow[tau0 - 1]) : 0.f;
    q.next = (p0 + 8 < L) ? bf2f(urow[tau0 + 8]) : 0.f;
}
__device__ __forceinline__ void conv3_eval(const C3& q, float w0, float w1, float w2, float b, float (&out)[8]) {
    float u[10];
    u[0] = q.prev; u[9] = q.next;
    u[1] = pg8::bflo(q.raw.x); u[2] = pg8::bfhi(q.raw.x); u[3] = pg8::bflo(q.raw.y); u[4] = pg8::bfhi(q.raw.y); u[5] = pg8::bflo(q.raw.z); u[6] = pg8::bfhi(q.raw.z); u[7] = pg8::bflo(q.raw.w); u[8] = pg8::bfhi(q.raw.w);
#pragma unroll
    for (int i = 0; i < 8; ++i) out[i] = w0 * u[i] + w1 * u[i + 1] + w2 * u[i + 2] + b;
}

__device__ __forceinline__ bf16x8 load_afrag(LAS const unsigned char* lds, int addr, int sh) {
    const LAS unsigned* p = (const LAS unsigned*)(lds + addr);
    const unsigned w0 = p[0], w1 = p[1], w2 = p[2], w3 = p[3], w4 = p[4];
    v4u f; f.x = __builtin_amdgcn_alignbit(w1, w0, sh); f.y = __builtin_amdgcn_alignbit(w2, w1, sh); f.z = __builtin_amdgcn_alignbit(w3, w2, sh); f.w = __builtin_amdgcn_alignbit(w4, w3, sh);
    return __builtin_bit_cast(bf16x8, f);
}

__device__ __forceinline__ void hyena_item(LAS unsigned char* lds, const Params& P, int g, int c, int tid_) {
    int tid = tid_; asm volatile("" : "+v"(tid));
    const int lane = tid & 63, wave = __builtin_amdgcn_readfirstlane(tid >> 6), r = lane & 31, hi = lane >> 5, nt = wave & 3, half = wave >> 2;
    const int L = g ? LS : LP; const int T0 = g ? TP : 0;
#if PROBE >= 41 && PROBE <= 46
    unsigned long long tp_ = __builtin_amdgcn_s_memrealtime();
#define HY_SEC(k) do { const unsigned long long tn_ = __builtin_amdgcn_s_memrealtime(); if (blockIdx.x == 0 && tid == 0) ((volatile LAS unsigned*)(lds + MISC_OFF))[40 + (k)] += (unsigned)(tn_ - tp_); tp_ = tn_; } while (0)
#else
#define HY_SEC(k) do { } while (0)
#endif
    float inv_norm0, inv_norm1;
    {
        const int nchunk = g ? 256 : 32; const float* fp = P.fpart_s + (g ? (size_t)0 : (size_t)((WS_FPART_P - WS_FPART_S) / 4));
        float s0 = 0.f, s1 = 0.f;
        for (int idx = lane; idx < nchunk * 2; idx += 64) { const int ch = idx >> 1, dir = idx & 1; s0 += fp[(size_t)ch * 2048 + dir * 512 + c]; s1 += fp[(size_t)ch * 2048 + 1024 + dir * 512 + c]; }
        inv_norm0 = 1.0f / wave_sum_sw(s0); inv_norm1 = 1.0f / wave_sum_sw(s1);
        for (int i = tid; i < Z_BYTES / 16; i += NWAVES * 64) *(LAS v4u*)(lds + i * 16) = (v4u){0u, 0u, 0u, 0u};
        LDS_WAIT(); __syncthreads();
    }
    {
        const int ch = 2 * HW + c; const float w0 = P.conv_w[ch], w1 = P.conv_w[3 * HW + ch], w2 = P.conv_w[6 * HW + ch], b = P.conv_b[ch];
        const bf16* urow = P.uT + (size_t)ch * MTOK + T0;
        for (int it = 0; it < 4; ++it) { const int chunk = tid + it * 512; float o[8]; conv3_chunk(urow, g, chunk, w0, w1, w2, b, o);
            const int tau0 = chunk * 8; v4u pk; pk.x = pk2(o[0], o[1]); pk.y = pk2(o[2], o[3]); pk.z = pk2(o[4], o[5]); pk.w = pk2(o[6], o[7]);
            *(LAS v4u*)(lds + slot_of(g, tau0 >> 7) * SLOTB + (tau0 & 127) * 2) = pk; }
    }
    HY_SEC(0);
    int d_hi, d_lo;
    if (g) { if (half == 0) { d_hi = 32 * nt + 31; d_lo = 32 * nt - 48; } else { d_hi = 32 * nt - 49; d_lo = 32 * nt - 127; } }
    else   {
             const int dmax = 4 * nt + 3, dmin = 4 * nt - 15;
             if (half == 0) { d_hi = dmax; d_lo = dmax - 9; } else { d_hi = dmax - 10; d_lo = dmin; } }
    const int ncol = g ? (32 * nt + r) : (16 * (r >> 2) + 4 * nt + (r & 3));
    int abase = F_OFF + 2 * ((L - 1) - r + 8 * hi); const int sh = (abase & 2) ? 16 : 0; abase &= ~3;
    const int zb = slot_of(g, ncol) * SLOTB + 16 * hi;
    const int mi0 = 2 * half;

    for (int o = 0; o < 2; ++o) {
        {
            const bf16* ksrc = P.krev_s + (g ? (size_t)0 : (size_t)((WS_KREV_P - WS_KREV_S) / 2)) + (size_t)(o * HW + c) * (2 * L);
            const int n16 = (2 * L * 2) / 16;
            for (int i = tid; i < n16; i += NWAVES * 64) *(LAS v4u*)(lds + F_OFF + i * 16) = *(const GAS v4u*)(ksrc + i * 8);
        }
        LDS_WAIT(); __syncthreads();
        HY_SEC(1);
        f32x16 acc[4];
#pragma unroll
        for (int mi = 0; mi < 4; ++mi) acc[mi] = (f32x16){0.f,0.f,0.f,0.f,0.f,0.f,0.f,0.f,0.f,0.f,0.f,0.f,0.f,0.f,0.f,0.f};
        bf16x8 Fw[8];
        {
            const int q0 = -8 * d_hi;
#pragma unroll
            for (int s = 2; s < 8; ++s) Fw[s] = load_afrag(lds, abase + 32 * (q0 - 8 + s), sh);
            Fw[0] = Fw[2]; Fw[1] = Fw[3];
        }
        {
            unsigned ap = (unsigned)(uintptr_t)(lds + abase) + 32 * (-8 * d_hi), bp = (unsigned)(uintptr_t)(lds + zb) - d_hi * SLOTB;
            v2u n01, n23; unsigned n4; v4u zn;
            unsigned r0, r1, r2, r3, r4; v4u zf;
#define HY_LOADS(ADW, BOFF) asm volatile("ds_read2_b32 %0, %4 offset0:%c5 offset1:%c6\n\tds_read2_b32 %1, %4 offset0:%c7 offset1:%c8\n\tds_read_b32 %2, %4 offset:%c9\n\tds_read_b128 %3, %10 offset:%c11" \
                : "=&v"(n01), "=&v"(n23), "=&v"(n4), "=&v"(zn) : "v"(ap), "i"(ADW), "i"((ADW) + 1), "i"((ADW) + 2), "i"((ADW) + 3), "i"(((ADW) + 4) * 4), "v"(bp), "i"(BOFF))
#define HY_WAIT() do { asm volatile("s_waitcnt lgkmcnt(0)" : "+v"(n01), "+v"(n23), "+v"(n4), "+v"(zn), "+v"(acc[0]), "+v"(acc[1]), "+v"(acc[2]), "+v"(acc[3])); __builtin_amdgcn_sched_barrier(0); } while (0)
#define HY_TAKE() do { r0 = n01.x; r1 = n01.y; r2 = n23.x; r3 = n23.y; r4 = n4; zf = zn; } while (0)
#define HY_STEP(JK, ADW, BOFF) do { HY_LOADS(ADW, BOFF); __builtin_amdgcn_sched_barrier(0); \
                { v4u f; f.x = __builtin_amdgcn_alignbit(r1, r0, sh); f.y = __builtin_amdgcn_alignbit(r2, r1, sh); f.z = __builtin_amdgcn_alignbit(r3, r2, sh); f.w = __builtin_amdgcn_alignbit(r4, r3, sh); Fw[JK] = __builtin_bit_cast(bf16x8, f); } \
                { const bf16x8 zb_ = __builtin_bit_cast(bf16x8, zf); \
                  acc[0] = __builtin_amdgcn_mfma_f32_32x32x16_bf16(Fw[(JK) & 7], zb_, acc[0], 0, 0, 0); acc[1] = __builtin_amdgcn_mfma_f32_32x32x16_bf16(Fw[((JK) - 2) & 7], zb_, acc[1], 0, 0, 0); \
                  acc[2] = __builtin_amdgcn_mfma_f32_32x32x16_bf16(Fw[((JK) - 4) & 7], zb_, acc[2], 0, 0, 0); acc[3] = __builtin_amdgcn_mfma_f32_32x32x16_bf16(Fw[((JK) - 6) & 7], zb_, acc[3], 0, 0, 0); } \
                HY_WAIT(); HY_TAKE(); } while (0)
            HY_LOADS(0, 0); HY_WAIT(); HY_TAKE();
            for (int d = d_hi; d >= d_lo; --d) {
                HY_STEP(0, 8, 32); HY_STEP(1, 16, 64); HY_STEP(2, 24, 96); HY_STEP(3, 32, 128); HY_STEP(4, 40, 160); HY_STEP(5, 48, 192); HY_STEP(6, 56, 224); HY_STEP(7, 64, SLOTB);
                ap += 256; bp += SLOTB;
            }
#undef HY_LOADS
#undef HY_WAIT
#undef HY_TAKE
#undef HY_STEP
        }
        LDS_WAIT(); __syncthreads();
        HY_SEC(2);
        {
            LAS float* X = (LAS float*)(lds + F_OFF) + wave * 2048;
#pragma unroll
            for (int t = 0; t < 2; ++t)
#pragma unroll
                for (int rg = 0; rg < 16; ++rg) X[(t * 16 + rg) * 64 + lane] = (half == 0) ? acc[2 + t][rg] : acc[t][rg];
        }
        LDS_WAIT(); __syncthreads();
        f32x16 fin[2];
        {
            const LAS float* X = (const LAS float*)(lds + F_OFF) + (wave ^ 4) * 2048;
#pragma unroll
            for (int t = 0; t < 2; ++t)
#pragma unroll
                for (int rg = 0; rg < 16; ++rg) fin[t][rg] = ((half == 0) ? acc[t][rg] : acc[2 + t][rg]) + X[(t * 16 + rg) * 64 + lane];
        }
        LDS_WAIT(); __syncthreads();
        HY_SEC(3);
        {
            const int ch = o * HW + c; const float w0 = P.conv_w[ch], w1 = P.conv_w[3 * HW + ch], w2 = P.conv_w[6 * HW + ch], b = P.conv_b[ch];
            const bf16* urow = P.uT + (size_t)ch * MTOK + T0;
            for (int it = 0; it < 4; ++it) { const int chunk = tid + it * 512; float v[8]; conv3_chunk(urow, g, chunk, w0, w1, w2, b, v);
                LAS f32x4* dst = (LAS f32x4*)(lds + F_OFF + chunk * 32 + (chunk >> 4) * 16); dst[0] = (f32x4){v[0], v[1], v[2], v[3]}; dst[1] = (f32x4){v[4], v[5], v[6], v[7]}; }
        }
        LDS_WAIT(); __syncthreads();
        HY_SEC(4);
        {
            const float sb = P.hbias[o * HW + c], inr = o ? inv_norm1 : inv_norm0;
            const LAS float* G = (const LAS float*)(lds + F_OFF);
            const int n = ncol; LAS bf16* zs = (LAS bf16*)(lds + slot_of(g, n) * SLOTB);
#pragma unroll
            for (int t = 0; t < 2; ++t)
#pragma unroll
                for (int rg = 0; rg < 16; ++rg) { const int i = 32 * (mi0 + t) + crow(rg, hi);
                    const float zo = bf2f(zs[i]);
#if PROBE >= 100
                    if (c == 137) { P.dF[(g * 2 + o) * 16384 + 128 * n + i] = fin[t][rg]; P.dZ[(g * 2 + o) * 16384 + 128 * n + i] = zs[i]; }
#endif
                    const float val = G[132 * n + i] * (inr * fin[t][rg] + sb * zo); zs[i] = (bf16)f2bf(val); }
        }
        LDS_WAIT(); __syncthreads();
    }
    HY_SEC(5);
    {
        bf16* yrow = P.yT + (size_t)c * MTOK + T0;
        for (int it = 0; it < 4; ++it) { const int chunk = tid + it * 512, tau0 = chunk * 8;
            *(GAS v4u*)(yrow + tau0) = *(const LAS v4u*)(lds + slot_of(g, tau0 >> 7) * SLOTB + (tau0 & 127) * 2); }
    }
    LDS_WAIT(); __syncthreads();
}
}

namespace fc {
constexpr int OST = 1032, PLANE_B = 32 * OST * 2  , RE_OFF = 0, IM_OFF = PLANE_B, RED_OFF = 2 * PLANE_B, T3_OFF = RED_OFF + 64;
constexpr int NFFT = 32768;
enum { F1 = 0, F2 = 1, F3 = 2, I1 = 3, I2 = 4, I3 = 5 };
__device__ __forceinline__ int crow(int r, int hi) { return (r & 3) + 8 * (r >> 2) + 4 * hi; }
__device__ __forceinline__ int sw(int mid) { return 0; }
struct Params { const bf16* uT; const bf16* kc; const float* fpart_s; const float* conv_w; const float* conv_b; const float* hbias; bf16* yT; bf16* hs; bf16* z1s; float* dF; bf16* dZ; };
typedef float f32x2_ __attribute__((ext_vector_type(2)));
struct FMat { bf16x8 fr[2], fi[2], nfi[2]; };

__device__ __forceinline__ void make_fmat(FMat& M, int r, int h) {
#pragma unroll
    for (int ks = 0; ks < 2; ++ks) { v4u a, b, c;
#pragma unroll
        for (int w = 0; w < 4; ++w) { float cv[2], sv[2];
#pragma unroll
            for (int e = 0; e < 2; ++e) { const int aidx = 16 * ks + 8 * h + 2 * w + e; const float fr_ = (float)((aidx * r) & 31) * (1.0f / 32.0f); cv[e] = __builtin_amdgcn_cosf(fr_); sv[e] = __builtin_amdgcn_sinf(fr_); }
            a[w] = pk2(cv[0], cv[1]); b[w] = pk2(-sv[0], -sv[1]); c[w] = pk2(sv[0], sv[1]); }
        M.fr[ks] = __builtin_bit_cast(bf16x8, a); M.fi[ks] = __builtin_bit_cast(bf16x8, b); M.nfi[ks] = __builtin_bit_cast(bf16x8, c); }
}

template <int ST, bool REAL_IN, bool HALF_K>
__device__ __forceinline__ void stage(LAS unsigned char* lds, const FMat& M, int wave, int r_, int h_) {
    int r = r_, h = h_; asm volatile("" : "+v"(r), "+v"(h));
    float t2c[16], t2s[16];
    if (ST == F1 || ST == F2 || ST == I1 || ST == I2) {
#pragma unroll
        for (int rg = 0; rg < 16; ++rg) { const int rho = (rg & 3) + 8 * (rg >> 2) + 4 * h; const float fr_ = (float)(r * rho) * (1.0f / 1024.0f); t2c[rg] = __builtin_amdgcn_cosf(fr_); t2s[rg] = __builtin_amdgcn_sinf(fr_); }
    }
    constexpr bool INV = (ST >= I1);
    const f32x16 zero16 = (f32x16){0.f,0.f,0.f,0.f,0.f,0.f,0.f,0.f,0.f,0.f,0.f,0.f,0.f,0.f,0.f,0.f};
    unsigned res[4][16];
#pragma unroll
    for (int t = 0; t < 4; ++t) {
        const int f = 4 * wave + t;
        const int base = (ST == I2) ? (32 * f + OST * r) : (32 * r + OST * f); const int swr = (ST == I2) ? sw(f) : sw(r);
        f32x16 ur = zero16, ui = zero16;
#pragma unroll
        for (int ks = 0; ks < (HALF_K ? 1 : 2); ++ks) {
            const bf16x8 xr = *(const LAS bf16x8*)(lds + RE_OFF + 2 * (base + ((16 * ks + 8 * h) ^ swr)));
            if (!INV) {
                ur = __builtin_amdgcn_mfma_f32_32x32x16_bf16(M.fr[ks], xr, ur, 0, 0, 0);
                ui = __builtin_amdgcn_mfma_f32_32x32x16_bf16(M.fi[ks], xr, ui, 0, 0, 0);
                if (!REAL_IN) { const bf16x8 xi = *(const LAS bf16x8*)(lds + IM_OFF + 2 * (base + ((16 * ks + 8 * h) ^ swr)));
                    ur = __builtin_amdgcn_mfma_f32_32x32x16_bf16(M.nfi[ks], xi, ur, 0, 0, 0);
                    ui = __builtin_amdgcn_mfma_f32_32x32x16_bf16(M.fr[ks], xi, ui, 0, 0, 0); }
            } else {
                const bf16x8 xi = *(const LAS bf16x8*)(lds + IM_OFF + 2 * (base + ((16 * ks + 8 * h) ^ swr)));
                ur = __builtin_amdgcn_mfma_f32_32x32x16_bf16(M.fr[ks], xr, ur, 0, 0, 0);
                ur = __builtin_amdgcn_mfma_f32_32x32x16_bf16(M.fi[ks], xi, ur, 0, 0, 0);
                ui = __builtin_amdgcn_mfma_f32_32x32x16_bf16(M.fr[ks], xi, ui, 0, 0, 0);
                ui = __builtin_amdgcn_mfma_f32_32x32x16_bf16(M.nfi[ks], xr, ui, 0, 0, 0);
            }
        }
        if (ST == I3) {
#pragma unroll
            for (int rg = 0; rg < 8; ++rg) { res[t][rg] = __float_as_uint(ur[rg]); res[t][8 + rg] = __float_as_uint(ui[rg]); }
        } else {
            if (ST == F1 || ST == F2 || ST == I1 || ST == I2) {
                float uc = 1.f, us = 0.f;
                if (ST == I2) { const float fr_ = (float)(f * r) * (1.0f / 32768.0f); uc = __builtin_amdgcn_cosf(fr_); us = __builtin_amdgcn_sinf(fr_); }
#pragma unroll
                for (int rg = 0; rg < 16; ++rg) {
                    float c = t2c[rg], s_ = t2s[rg];
                    if (ST == F1) { const int rho = (rg & 3) + 8 * (rg >> 2) + 4 * h; const f32x2_ q = *(const LAS f32x2_*)(lds + T3_OFF + 8 * (32 * f + rho)); const float c2 = c * q.x - s_ * q.y; s_ = c * q.y + s_ * q.x; c = c2; }
                    if (ST == I2) { const float c2 = c * uc - s_ * us; s_ = c * us + s_ * uc; c = c2; }
                    const float s = INV ? s_ : -s_;
                    const float a = ur[rg], b = ui[rg];
                    ur[rg] = a * c - b * s; ui[rg] = a * s + b * c;
                }
            }
#pragma unroll
            for (int p = 0; p < 8; ++p) { res[t][p] = pk2(ur[2 * p], ur[2 * p + 1]); res[t][8 + p] = pk2(ui[2 * p], ui[2 * p + 1]); }
        }
        __builtin_amdgcn_sched_barrier(0);
    }
    LDS_WAIT(); __syncthreads();
#pragma unroll
    for (int t = 0; t < 4; ++t) {
        const int f = 4 * wave + t;
        if (ST == I3) {
            LAS float* Y1 = (LAS float*)(lds + RE_OFF); LAS float* Y2 = (LAS float*)(lds + IM_OFF);
#pragma unroll
            for (int rg = 0; rg < 8; ++rg) { const int rho = (rg & 3) + 8 * (rg >> 2) + 4 * h; Y1[516 * f + 32 * rho + r] = __uint_as_float(res[t][rg]); Y2[516 * f + 32 * rho + r] = __uint_as_float(res[t][8 + rg]); }
        } else if (ST == F3) {
#pragma unroll
            for (int g4 = 0; g4 < 4; ++g4) { const int pos = ((8 * g4 + 4 * h) ^ sw(r)) + 32 * r + OST * f;
                *(LAS v2u*)(lds + RE_OFF + 2 * pos) = (v2u){res[t][2 * g4], res[t][2 * g4 + 1]}; *(LAS v2u*)(lds + IM_OFF + 2 * pos) = (v2u){res[t][8 + 2 * g4], res[t][8 + 2 * g4 + 1]}; }
        } else {
            const int odd = r & 1; const unsigned sel = odd ? 0x03020706u : 0x05040100u;
            const int rs_ = (ST == F1) ? OST : 32;
            const int lb = ((r & ~1) + odd * rs_ + ((ST == F1) ? 32 * f : OST * f) + rs_ * 4 * h) * 2;
#pragma unroll
            for (int p = 0; p < 8; ++p) {
                const int rho0 = ((2 * p) & 3) + 8 * ((2 * p) >> 2);
                const unsigned wr_ = res[t][p], wi_ = res[t][8 + p];
                const unsigned vr_ = (unsigned)__builtin_amdgcn_mov_dpp((int)wr_, 0xB1, 0xF, 0xF, true), vi_ = (unsigned)__builtin_amdgcn_mov_dpp((int)wi_, 0xB1, 0xF, 0xF, true);
                *(LAS unsigned*)(lds + RE_OFF + lb + 2 * rs_ * rho0) = __builtin_amdgcn_perm(vr_, wr_, sel);
                *(LAS unsigned*)(lds + IM_OFF + lb + 2 * rs_ * rho0) = __builtin_amdgcn_perm(vi_, wi_, sel);
            }
        }
    }
    LDS_WAIT(); __syncthreads();
}

__device__ __forceinline__ void self_visible(int tid) {
    VM_WAIT(); __syncthreads();
    if (tid == 0) { __builtin_amdgcn_fence(__ATOMIC_ACQUIRE, "agent"); VM_WAIT(); }
    __syncthreads();
}

__device__ __forceinline__ void prod_elem(float xr, float xi, float pr, float pi, float gr, float gi, float qr, float qi, float& ar, float& ai, float& br, float& bi) {
    const float sc = 0.25f / 32768.0f;
    const float Ar = xr + pr, Ai = xi - pi, Br = xi + pi, Bi = pr - xr;
    const float Hr = gr + qr, Hi = gi - qi, Kr = gi + qi, Ki = qr - gr;
    const float v1r = (Ar * Hr - Ai * Hi) * sc, v1i = (Ar * Hi + Ai * Hr) * sc, v2r = (Br * Kr - Bi * Ki) * sc, v2i = (Br * Ki + Bi * Kr) * sc;
    ar = v1r - v2i; ai = v1i + v2r; br = v1r + v2i; bi = v2r - v1i;
}
__device__ __forceinline__ void item_pair(LAS unsigned char* lds, const Params& P, int cp, int tid_, int slot) {
    int tid = tid_; asm volatile("" : "+v"(tid));
    const int wave = __builtin_amdgcn_readfirstlane(tid >> 6);
    constexpr int L = LS, T0 = TP, g = 1;
    const int ca = 2 * cp, cb = 2 * cp + 1;
    bf16* hs = P.hs + (size_t)slot * (2 * PLANE_B / 2); bf16* z1s = P.z1s + (size_t)slot * (2 * L);
    FMat M; { const int r = tid & 31, h = (tid >> 5) & 1; make_fmat(M, r, h); }
    for (int i = tid; i < 1024; i += NWAVES * 64) { const float fr_ = (float)((i >> 5) * (i & 31)) * (1.0f / 32768.0f); *(LAS f32x2_*)(lds + T3_OFF + 8 * i) = (f32x2_){__builtin_amdgcn_cosf(fr_), __builtin_amdgcn_sinf(fr_)}; }
    LDS_WAIT(); __syncthreads();
    for (int o = 0; o < 2; ++o) {
        asm volatile("" : "+v"(tid));
        const int lane = tid & 63, r = lane & 31, h = lane >> 5;
#pragma unroll 1
        for (int pl = 0; pl < 2; ++pl) {
            const bf16* ksrc = P.kc + (size_t)(o * HW + (pl ? cb : ca)) * NFFT; const int poff = pl ? IM_OFF : RE_OFF;
            v4u raw[8];
#pragma unroll
            for (int i = 0; i < 8; ++i) { const int it = 8 * wave + i, n = 1024 * (lane & 31) + 32 * (2 * (it >> 2) + (lane >> 5)) + 8 * (it & 3); raw[i] = *(const GAS v4u*)(ksrc + n); }
#pragma unroll
            for (int i = 0; i < 8; ++i) { const int it = 8 * wave + i, n = 1024 * (lane & 31) + 32 * (2 * (it >> 2) + (lane >> 5)) + 8 * (it & 3);
                const int pos0 = (n >> 10) + 32 * ((n >> 5) & 31) + OST * (n & 31); LAS bf16* d = (LAS bf16*)(lds + poff) + pos0;
                d[0 * OST] = (bf16)(raw[i].x & 0xffffu); d[1 * OST] = (bf16)(raw[i].x >> 16); d[2 * OST] = (bf16)(raw[i].y & 0xffffu); d[3 * OST] = (bf16)(raw[i].y >> 16);
                d[4 * OST] = (bf16)(raw[i].z & 0xffffu); d[5 * OST] = (bf16)(raw[i].z >> 16); d[6 * OST] = (bf16)(raw[i].w & 0xffffu); d[7 * OST] = (bf16)(raw[i].w >> 16); }
        }
        LDS_WAIT(); __syncthreads();
        stage<F1, false, false>(lds, M, wave, r, h); stage<F2, false, false>(lds, M, wave, r, h); stage<F3, false, false>(lds, M, wave, r, h);
        for (int i = tid; i < 2 * PLANE_B / 16; i += NWAVES * 64) *(GAS v4u*)((unsigned char*)hs + (size_t)i * 16) = *(const LAS v4u*)(lds + i * 16);
        self_visible(tid);
#pragma unroll 1
        for (int pl = 0; pl < 2; ++pl) {
            const int ch = 2 * HW + (pl ? cb : ca); const float w0 = P.conv_w[ch], w1 = P.conv_w[3 * HW + ch], w2 = P.conv_w[6 * HW + ch], b = P.conv_b[ch];
            const bf16* urow = P.uT + (size_t)ch * MTOK + T0; const bf16* zsrc = z1s + pl * L; const int poff = pl ? IM_OFF : RE_OFF;
            hy::C3 q3[4]; v4u rz[4];
#pragma unroll
            for (int i = 0; i < 4; ++i) { const int it = 4 * wave + i, n = 1024 * (lane & 15) + 32 * (4 * (it >> 2) + (lane >> 4)) + 8 * (it & 3);
                if (o == 0) hy::conv3_load(urow, g, n >> 3, q3[i]); else rz[i] = *(const GAS v4u*)(zsrc + n); }
#pragma unroll
            for (int i = 0; i < 4; ++i) { const int it = 4 * wave + i, n = 1024 * (lane & 15) + 32 * (4 * (it >> 2) + (lane >> 4)) + 8 * (it & 3); unsigned e[4];
                if (o == 0) { float v[8]; hy::conv3_eval(q3[i], w0, w1, w2, b, v); e[0] = pk2(v[0], v[1]); e[1] = pk2(v[2], v[3]); e[2] = pk2(v[4], v[5]); e[3] = pk2(v[6], v[7]); }
                else { e[0] = rz[i].x; e[1] = rz[i].y; e[2] = rz[i].z; e[3] = rz[i].w; }
                const int pos0 = (n >> 10) + 32 * ((n >> 5) & 31) + OST * (n & 31); LAS bf16* d = (LAS bf16*)(lds + poff) + pos0;
#pragma unroll
                for (int j = 0; j < 4; ++j) { d[(2 * j) * OST] = (bf16)(e[j] & 0xffffu); d[(2 * j + 1) * OST] = (bf16)(e[j] >> 16); } }
        }
        LDS_WAIT(); __syncthreads();
        stage<F1, false, true>(lds, M, wave, r, h); stage<F2, false, false>(lds, M, wave, r, h); stage<F3, false, false>(lds, M, wave, r, h);
#pragma unroll 1
        for (int e0 = 0; e0 < 2048; e0 += NWAVES * 64) {
            int pa[1], pb[1]; bool act[1]; v4u xra[1], xia[1], xrb[1], xib[1], gra[1], gia[1], grb[1], gib[1];
#pragma unroll
            for (int k = 0; k < 1; ++k) {
                const int e = e0 + k * NWAVES * 64 + tid; act[k] = e < 2046;
                int k0, k1, q;
                if (e < 1920) { k0 = 1 + (e >> 7); k1 = (e >> 2) & 31; q = e & 3; }
                else if (e < 1984) { k0 = 16; k1 = (e - 1920) >> 2; q = e & 3; }
                else if (e < 2044) { k0 = 0; k1 = 1 + ((e - 1984) >> 2); q = e & 3; }
                else { k0 = 0; k1 = 16; q = e - 2044; }
                const int r0 = k0 ? 32 - k0 : 0, r1 = k0 ? 31 - k1 : 32 - k1;
                pa[k] = 8 * q + 32 * k1 + OST * k0; pb[k] = 8 * (3 - q) + 32 * r1 + OST * r0;
                if (act[k]) {
                    xra[k] = *(const LAS v4u*)(lds + RE_OFF + 2 * pa[k]); xia[k] = *(const LAS v4u*)(lds + IM_OFF + 2 * pa[k]); xrb[k] = *(const LAS v4u*)(lds + RE_OFF + 2 * pb[k]); xib[k] = *(const LAS v4u*)(lds + IM_OFF + 2 * pb[k]);
                    gra[k] = *(const GAS v4u*)((const unsigned char*)hs + 2 * pa[k]); gia[k] = *(const GAS v4u*)((const unsigned char*)hs + PLANE_B + 2 * pa[k]);
                    grb[k] = *(const GAS v4u*)((const unsigned char*)hs + 2 * pb[k]); gib[k] = *(const GAS v4u*)((const unsigned char*)hs + PLANE_B + 2 * pb[k]);
                }
            }
#pragma unroll
            for (int k = 0; k < 1; ++k) if (act[k]) {
                v4u ora, oia, orb, oib;
#pragma unroll
                for (int w = 0; w < 4; ++w) {
                    float a0r, a0i, b1r, b1i, a1r, a1i, b0r, b0i;
                    prod_elem(pg8::bflo(xra[k][w]), pg8::bflo(xia[k][w]), pg8::bfhi(xrb[k][3 - w]), pg8::bfhi(xib[k][3 - w]), pg8::bflo(gra[k][w]), pg8::bflo(gia[k][w]), pg8::bfhi(grb[k][3 - w]), pg8::bfhi(gib[k][3 - w]), a0r, a0i, b1r, b1i);
                    prod_elem(pg8::bfhi(xra[k][w]), pg8::bfhi(xia[k][w]), pg8::bflo(xrb[k][3 - w]), pg8::bflo(xib[k][3 - w]), pg8::bfhi(gra[k][w]), pg8::bfhi(gia[k][w]), pg8::bflo(grb[k][3 - w]), pg8::bflo(gib[k][3 - w]), a1r, a1i, b0r, b0i);
                    ora[w] = pk2(a0r, a1r); oia[w] = pk2(a0i, a1i); orb[3 - w] = pk2(b0r, b1r); oib[3 - w] = pk2(b0i, b1i);
                }
                *(LAS v4u*)(lds + RE_OFF + 2 * pa[k]) = ora; *(LAS v4u*)(lds + IM_OFF + 2 * pa[k]) = oia; *(LAS v4u*)(lds + RE_OFF + 2 * pb[k]) = orb; *(LAS v4u*)(lds + IM_OFF + 2 * pb[k]) = oib;
            }
        }
        if (tid <= 16) {
            const int k2 = tid, kp = (32 - k2) & 31;
            LAS bf16* xr_ = (LAS bf16*)(lds + RE_OFF); LAS bf16* xi_ = (LAS bf16*)(lds + IM_OFF); const bf16* gr_ = hs; const bf16* gi_ = hs + PLANE_B / 2;
            float ar, ai, br, bi;
            prod_elem(bf2f(xr_[k2]), bf2f(xi_[k2]), bf2f(xr_[kp]), bf2f(xi_[kp]), bf2f(gr_[k2]), bf2f(gi_[k2]), bf2f(gr_[kp]), bf2f(gi_[kp]), ar, ai, br, bi);
            xr_[k2] = (bf16)f2bf(ar); xi_[k2] = (bf16)f2bf(ai);
            if (kp != k2) { xr_[kp] = (bf16)f2bf(br); xi_[kp] = (bf16)f2bf(bi); }
        }
        LDS_WAIT(); __syncthreads();
        stage<I1, false, false>(lds, M, wave, r, h); stage<I2, false, false>(lds, M, wave, r, h); stage<I3, false, false>(lds, M, wave, r, h);
#pragma unroll 1
        for (int pl = 0; pl < 2; ++pl) {
            const int c = pl ? cb : ca;
            const LAS float* Y = (const LAS float*)(lds + (pl ? IM_OFF : RE_OFF));
            const int chg = o * HW + c; const float g0 = P.conv_w[chg], g1 = P.conv_w[3 * HW + chg], g2 = P.conv_w[6 * HW + chg], gb = P.conv_b[chg];
            const int chv = 2 * HW + c; const float v0 = P.conv_w[chv], v1 = P.conv_w[3 * HW + chv], v2 = P.conv_w[6 * HW + chv], vb = P.conv_b[chv];
            const bf16* grow = P.uT + (size_t)chg * MTOK + T0; const bf16* vrow = P.uT + (size_t)chv * MTOK + T0;
            float inr;
            { float a = 0.f; for (int idx = lane; idx < 512; idx += 64) a += P.fpart_s[(size_t)(idx >> 1) * 2048 + (idx & 1) * 512 + o * 1024 + c]; inr = 1.0f / wave_sum_sw(a); }
            const float sb = P.hbias[o * HW + c];
            const bf16* zsrc = z1s + pl * L; bf16* dst = o ? (P.yT + (size_t)c * MTOK + T0) : (z1s + pl * L);
#pragma unroll 1
            for (int ib = 0; ib < 4; ib += 2) {
                hy::C3 qg[2], qv[2]; v4u rz[2];
#pragma unroll
                for (int it = 0; it < 2; ++it) { const int chunk = tid + (ib + it) * 512; hy::conv3_load(grow, g, chunk, qg[it]); if (o == 0) hy::conv3_load(vrow, g, chunk, qv[it]); else rz[it] = *(const GAS v4u*)(zsrc + chunk * 8); }
#pragma unroll
                for (int it = 0; it < 2; ++it) { const int chunk = tid + (ib + it) * 512, n = chunk * 8; float gt[8], zo[8];
                    hy::conv3_eval(qg[it], g0, g1, g2, gb, gt);
                    if (o == 0) { hy::conv3_eval(qv[it], v0, v1, v2, vb, zo);
#pragma unroll
                        for (int j = 0; j < 8; ++j) zo[j] = bf2f((unsigned short)f2bf(zo[j])); }
                    else { const v4u raw = rz[it]; zo[0] = pg8::bflo(raw.x); zo[1] = pg8::bfhi(raw.x); zo[2] = pg8::bflo(raw.y); zo[3] = pg8::bfhi(raw.y); zo[4] = pg8::bflo(raw.z); zo[5] = pg8::bfhi(raw.z); zo[6] = pg8::bflo(raw.w); zo[7] = pg8::bfhi(raw.w); }
                    const LAS float* yp = Y + 516 * (n & 31) + (n >> 5); const f32x4 y0 = (f32x4){yp[0], yp[516], yp[2 * 516], yp[3 * 516]}, y1 = (f32x4){yp[4 * 516], yp[5 * 516], yp[6 * 516], yp[7 * 516]};
                    float val[8];
#pragma unroll
                    for (int j = 0; j < 8; ++j) { const float yv = (j < 4) ? y0[j & 3] : y1[j & 3];
#if PROBE >= 100
                        if (c == 137) { P.dF[(2 + o) * 16384 + n + j] = yv; P.dZ[(2 + o) * 16384 + n + j] = (bf16)f2bf(zo[j]); }
#endif
                        val[j] = gt[j] * (inr * yv + sb * zo[j]); }
                    v4u pk; pk.x = pk2(val[0], val[1]); pk.y = pk2(val[2], val[3]); pk.z = pk2(val[4], val[5]); pk.w = pk2(val[6], val[7]);
                    *(GAS v4u*)(dst + n) = pk; }
            }
        }
        self_visible(tid);
    }
}
}

namespace at {
constexpr int KROW = 144, VROW = 776, K_OFF = 0, V_OFF = 384 * KROW  , END_OFF = V_OFF + 64 * VROW;
__device__ __forceinline__ int crow(int r, int hi) { return (r & 3) + 8 * (r >> 2) + 4 * hi; }
struct Params { const bf16* q; const bf16* k; const bf16* v; const float* sink; bf16* yat; };

__device__ __forceinline__ void attn_item(LAS unsigned char* lds, const Params& P, int blk, int gk, int tid_) {
    int tid = tid_; asm volatile("" : "+v"(tid));
    const int lane = tid & 63, wave = __builtin_amdgcn_readfirstlane(tid >> 6), r = lane & 31, hi = lane >> 5;
    const int m0 = blk * 128; const int s_lo = (blk < 128) ? (m0 & ~(LP - 1)) : TP, s_hi = (blk < 128) ? s_lo + LP : MTOK; const int kw0 = m0 - 128;
    {
        v4u kv[6], vv[6];
#pragma unroll
        for (int it = 0; it < 6; ++it) {
            const int idx = tid + it * 512, chn = idx / 384, key = idx - chn * 384, tok = kw0 + key; const bool ok = (tok >= s_lo) && (tok < s_hi);
            kv[it] = (v4u){0u, 0u, 0u, 0u}; vv[it] = (v4u){0u, 0u, 0u, 0u};
            if (ok) { kv[it] = *(const GAS v4u*)(P.k + (size_t)tok * 128 + gk * 64 + chn * 8); vv[it] = *(const GAS v4u*)(P.v + (size_t)tok * 128 + gk * 64 + chn * 8); }
        }
#pragma unroll
        for (int it = 0; it < 6; ++it) {
            const int idx = tid + it * 512, chn = idx / 384, key = idx - chn * 384;
            *(LAS v4u*)(lds + K_OFF + key * KROW + chn * 16) = kv[it];
            LAS bf16* vt = (LAS bf16*)(lds + V_OFF + (chn * 8) * VROW + key * 2);
            vt[0 * (VROW / 2)] = (bf16)(vv[it].x & 0xffffu); vt[1 * (VROW / 2)] = (bf16)(vv[it].x >> 16); vt[2 * (VROW / 2)] = (bf16)(vv[it].y & 0xffffu); vt[3 * (VROW / 2)] = (bf16)(vv[it].y >> 16);
            vt[4 * (VROW / 2)] = (bf16)(vv[it].z & 0xffffu); vt[5 * (VROW / 2)] = (bf16)(vv[it].z >> 16); vt[6 * (VROW / 2)] = (bf16)(vv[it].w & 0xffffu); vt[7 * (VROW / 2)] = (bf16)(vv[it].w >> 16);
        }
    }
    LDS_WAIT(); __syncthreads();
    const int hq = 4 * gk + (wave & 3), qh = wave >> 2;
    const int klo = (s_lo - kw0) > 0 ? (s_lo - kw0) : 0, khi = (s_hi - kw0) < 384 ? (s_hi - kw0) : 384;
    const float sinkl = P.sink[hq] * 1.4426950408889634f;
    for (int qq = 0; qq < 2; ++qq) {
        const int qt = 2 * qh + qq, q0 = 32 * qt; const size_t qrow = (size_t)(m0 + q0 + r);
        bf16x8 qf[4];
#pragma unroll
        for (int ks = 0; ks < 4; ++ks) qf[ks] = *(const GAS bf16x8*)(P.q + qrow * 512 + hq * 64 + 16 * ks + 8 * hi);
        float m_run = sinkl, l_run = (hi == 0) ? 1.0f : 0.0f;
        f32x16 o0 = (f32x16){0.f,0.f,0.f,0.f,0.f,0.f,0.f,0.f,0.f,0.f,0.f,0.f,0.f,0.f,0.f,0.f}, o1 = o0;
        const int lo_r = (q0 + r) > klo ? (q0 + r) : klo, hi_r = (q0 + r + 256) < (khi - 1) ? (q0 + r + 256) : (khi - 1);
        for (int kt = qt; kt <= qt + 8; ++kt) {
            const int kb = 32 * kt;
            f32x16 s = (f32x16){0.f,0.f,0.f,0.f,0.f,0.f,0.f,0.f,0.f,0.f,0.f,0.f,0.f,0.f,0.f,0.f};
#pragma unroll
            for (int ks = 0; ks < 4; ++ks) { const bf16x8 kf = *(const LAS bf16x8*)(lds + K_OFF + (kb + r) * KROW + 32 * ks + 16 * hi);
                s = __builtin_amdgcn_mfma_f32_32x32x16_bf16(kf, qf[ks], s, 0, 0, 0); }
            float tmax = -1e30f;
            const bool need_mask = (kt == qt) || (kt == qt + 8) || (kb < klo) || (kb + 31 >= khi);
            if (need_mask) {
#pragma unroll
                for (int rg = 0; rg < 16; ++rg) { const int kj = kb + crow(rg, hi); const float sv = (kj >= lo_r && kj <= hi_r) ? s[rg] : -1e30f; s[rg] = sv; tmax = fmaxf(tmax, sv); }
            } else {
#pragma unroll
                for (int rg = 0; rg < 16; ++rg) tmax = fmaxf(tmax, s[rg]);
            }
            tmax = fmaxf(tmax, __shfl_xor(tmax, 32));
            const float mnew = fmaxf(m_run, tmax); const float alpha = __builtin_amdgcn_exp2f(m_run - mnew);
            const bool moved = __any(mnew != m_run); m_run = mnew;
            float psum = 0.f;
#pragma unroll
            for (int rg = 0; rg < 16; ++rg) { const float p = __builtin_amdgcn_exp2f(s[rg] - mnew); s[rg] = p; psum += p; }
            l_run = l_run * alpha + psum;
            if (moved) {
#pragma unroll
                for (int rg = 0; rg < 16; ++rg) { o0[rg] *= alpha; o1[rg] *= alpha; }
            }
            v4u pa, pb;
            pa.x = pk2(s[0], s[1]); pa.y = pk2(s[2], s[3]); pa.z = pk2(s[4], s[5]); pa.w = pk2(s[6], s[7]);
            pb.x = pk2(s[8], s[9]); pb.y = pk2(s[10], s[11]); pb.z = pk2(s[12], s[13]); pb.w = pk2(s[14], s[15]);
            const bf16x8 pf0 = __builtin_bit_cast(bf16x8, pa), pf1 = __builtin_bit_cast(bf16x8, pb);
#pragma unroll
            for (int dt = 0; dt < 2; ++dt) {
                const LAS unsigned char* vb = lds + V_OFF + (32 * dt + r) * VROW + (kb + 4 * hi) * 2;
                v4u va, vc;
                { const v2u x0 = *(const LAS v2u*)(vb), x1 = *(const LAS v2u*)(vb + 16); va = (v4u){x0.x, x0.y, x1.x, x1.y}; }
                { const v2u x0 = *(const LAS v2u*)(vb + 32), x1 = *(const LAS v2u*)(vb + 48); vc = (v4u){x0.x, x0.y, x1.x, x1.y}; }
                if (dt == 0) { o0 = __builtin_amdgcn_mfma_f32_32x32x16_bf16(__builtin_bit_cast(bf16x8, va), pf0, o0, 0, 0, 0); o0 = __builtin_amdgcn_mfma_f32_32x32x16_bf16(__builtin_bit_cast(bf16x8, vc), pf1, o0, 0, 0, 0); }
                else         { o1 = __builtin_amdgcn_mfma_f32_32x32x16_bf16(__builtin_bit_cast(bf16x8, va), pf0, o1, 0, 0, 0); o1 = __builtin_amdgcn_mfma_f32_32x32x16_bf16(__builtin_bit_cast(bf16x8, vc), pf1, o1, 0, 0, 0); }
            }
        }
        l_run += __shfl_xor(l_run, 32);
        const float inv = 1.0f / l_run;
        bf16* yrow = P.yat + qrow * 512 + hq * 64;
#pragma unroll
        for (int g4 = 0; g4 < 4; ++g4) {
            v2u w0, w1;
            w0.x = pk2(o0[4 * g4] * inv, o0[4 * g4 + 1] * inv); w0.y = pk2(o0[4 * g4 + 2] * inv, o0[4 * g4 + 3] * inv);
            w1.x = pk2(o1[4 * g4] * inv, o1[4 * g4 + 1] * inv); w1.y = pk2(o1[4 * g4 + 2] * inv, o1[4 * g4 + 3] * inv);
            *(GAS v2u*)(yrow + 8 * g4 + 4 * hi) = w0; *(GAS v2u*)(yrow + 32 + 8 * g4 + 4 * hi) = w1;
        }
    }
    LDS_WAIT(); __syncthreads();
}
}

__device__ __forceinline__ void transpose_y_tiles8(LAS unsigned char* lds, const bf16* yT, bf16* yhy, int tile0, int tstride, int ntiles, int tid_) {
    int tid = tid_; asm volatile("" : "+v"(tid));
    v4u ld[8];
#pragma unroll
    for (int q = 0; q < 8; ++q) { const int tile = tile0 + q * tstride; if (tile < ntiles) { const int c0 = (tile & 7) * 64, t0 = (tile >> 3) * 64, ch = tid >> 3, k8 = tid & 7;
        ld[q] = *(const GAS v4u*)(yT + (size_t)(c0 + ch) * MTOK + t0 + k8 * 8); } }
#pragma unroll
    for (int q = 0; q < 8; ++q) { const int tile = tile0 + q * tstride; if (tile < ntiles) { const int ch = tid >> 3, k8 = tid & 7;
        *(LAS v4u*)((LAS bf16*)(lds + q * 9216) + ch * 72 + ((k8 ^ (ch >> 3)) * 8)) = ld[q]; } }
    LDS_WAIT(); __syncthreads();
#pragma unroll
    for (int q = 0; q < 8; ++q) { const int tile = tile0 + q * tstride; if (tile < ntiles) { const int c0 = (tile & 7) * 64, t0 = (tile >> 3) * 64, tk = tid >> 3, c8 = tid & 7;
        const LAS bf16* T = (const LAS bf16*)(lds + q * 9216); unsigned short e[8];
#pragma unroll
        for (int j = 0; j < 8; ++j) e[j] = T[(c8 * 8 + j) * 72 + (tk ^ (c8 << 3))];
        v4u o; o.x = e[0] | ((unsigned)e[1] << 16); o.y = e[2] | ((unsigned)e[3] << 16); o.z = e[4] | ((unsigned)e[5] << 16); o.w = e[6] | ((unsigned)e[7] << 16);
        *(GAS v4u*)(yhy + (size_t)(t0 + tk) * 512 + c0 + c8 * 8) = o; } }
    LDS_WAIT(); __syncthreads();
}

#if PROBE
constexpr int CW_P = 20000;
constexpr size_t WS_DF = 484 * MiB, WS_DZ = 485 * MiB;
constexpr int PROBE_C = 137;
__device__ __forceinline__ double wave_sum_d(double v) {
#pragma unroll
    for (int o = 1; o < 64; o <<= 1) v += __shfl_xor(v, o);
    return v;
}
__device__ __forceinline__ double filt_point(const float* w1, const float* b1, const float* w2, const float* b2, const float* w3, const float* fr, int g, int p, int col, int lane) {
    const int L = g ? LS : LP; const double t = (double)p / (double)(L - 1);
    double zval = 0.0;
    if (lane == 0) zval = t;
    else if (lane < 33) { const int i = (lane - 1) & 15; const double band = 1e-4 + (double)i * ((15.0 - 1e-4) / 15.0); const double ang = (6.283185307179586 / (double)L) * (double)p * band; zval = (lane <= 16) ? cos(ang) : -sin(ang); }
    double a = (double)b1[lane];
    for (int k = 0; k < 33; ++k) a += __shfl(zval, k) * (double)w1[k * 64 + lane];
    const double h1 = sin((double)fr[lane] * a);
    a = (double)b2[lane];
    for (int i = 0; i < 64; ++i) a += __shfl(h1, i) * (double)w2[i * 64 + lane];
    const double h2 = sin((double)fr[lane] * a);
    const double out = wave_sum_d(h2 * (double)w3[lane * 2048 + col]);
    const int c = col & 511; const double dmin = log(1e-2) / 1.5, dmax = log(1e-2) / 0.3;
    const double delta = fabs(dmin + (double)c * ((dmax - dmin) / 511.0));
    return out * (exp(-t * delta) + 0.05);
}
__device__ __forceinline__ void probe_check(unsigned char* ws, unsigned* ctl, const float* w1, const float* b1, const float* w2, const float* b2, const float* w3, const float* fr, int vcu, int G, int tid) {
    const bf16* KREV_S = (const bf16*)(ws + WS_KREV_S);
    const float* DF = (const float*)(ws + WS_DF); const bf16* DZ = (const bf16*)(ws + WS_DZ);
    const int gtid = vcu * 512 + tid, lane = tid & 63, gwv = gtid >> 6, NW = G * 8;
    if (gtid < 65536) {
        const int combo = gtid >> 14, t = gtid & 16383, g = combo >> 1, o = combo & 1, L = g ? LS : LP, tl = g ? t : (t & (LP - 1)), base = t - tl;
        const bf16* kb = KREV_S + (g ? (size_t)0 : (size_t)((WS_KREV_P - WS_KREV_S) / 2)) + (size_t)(o * HW + PROBE_C) * (2 * L); const bf16* dz = DZ + combo * 16384 + base;
        double acc = 0.0;
        if (g) { for (int s = 0; s < L; ++s) { int j = tl - s; if (j < 0) j += 2 * L; acc += (double)bf2f(kb[j]) * (double)bf2f(dz[s]); } }
        else   { const bf16* kr = kb + (L - 1 - tl); for (int s = 0; s < L; ++s) acc += (double)bf2f(kr[s]) * (double)bf2f(dz[s]); }
        const float diff = fabsf((float)(acc - (double)DF[combo * 16384 + t]));
        atomicMax(ctl + CW_P + (g ? 4 : 0), __float_as_uint(diff)); atomicMax(ctl + CW_P + (g ? 5 : 1), __float_as_uint(fabsf((float)acc)));
    }
    {
        const int g = gwv & 1, L = g ? LS : LP; const int p = (int)(((unsigned)gwv * 2654435761u) >> 8) % L;
        for (int q = 0; q < 8; ++q) { const int col = (gwv * 97 + 263 * q) & 2047; const int o = col >> 10, dir = (col >> 9) & 1, c = col & 511;
            if (dir == 1 && p == 0) continue;
            const double kv = filt_point(w1, b1, w2, b2, w3, fr, g, p, col, lane);
            const int m = g ? (dir ? (2 * L - p) : p) : (dir ? (L - 1 + p) : (L - 1 - p)); const float st = bf2f((KREV_S + (g ? (size_t)0 : (size_t)((WS_KREV_P - WS_KREV_S) / 2)) + (size_t)(o * HW + c) * (2 * L))[m]);
            if (lane == 0) { atomicMax(ctl + CW_P + 2, __float_as_uint(fabsf(st - (float)kv))); atomicMax(ctl + CW_P + 3, __float_as_uint(fabsf((float)kv))); } }
    }
    for (int which = 0; which < 2; ++which) {
        const int g = which ? 0 : 1, o = which ? 0 : 1, L = g ? LS : LP; double loc = 0.0;
        for (int p = gwv; p < L; p += NW)
            for (int dir = 0; dir < 2; ++dir) { if (dir == 1 && p == 0) continue; loc += fabs(filt_point(w1, b1, w2, b2, w3, fr, g, p, o * 1024 + dir * 512 + PROBE_C, lane)); }
        if (lane == 0) atomicAdd((double*)(ctl + CW_P + 8) + which, loc);
    }
}
__device__ __forceinline__ int probe_metric_count(unsigned char* ws, unsigned* ctl) {
    const float e_conv0 = __uint_as_float(__hip_atomic_load(ctl + CW_P + 0, RLX_AGENT)) / fmaxf(__uint_as_float(__hip_atomic_load(ctl + CW_P + 1, RLX_AGENT)), 1e-30f);
    const float e_conv1 = __uint_as_float(__hip_atomic_load(ctl + CW_P + 4, RLX_AGENT)) / fmaxf(__uint_as_float(__hip_atomic_load(ctl + CW_P + 5, RLX_AGENT)), 1e-30f);
    const float e_conv = fmaxf(e_conv0, e_conv1);
    const float e_filt = __uint_as_float(__hip_atomic_load(ctl + CW_P + 2, RLX_AGENT)) / fmaxf(__uint_as_float(__hip_atomic_load(ctl + CW_P + 3, RLX_AGENT)), 1e-30f);
    const float* FPS = (const float*)(ws + WS_FPART_S); const float* FPP = (const float*)(ws + WS_FPART_P);
    double s1 = 0.0, s0 = 0.0;
    for (int ch = 0; ch < 256; ++ch) s1 += (double)FPS[(size_t)ch * 2048 + 1024 + PROBE_C] + (double)FPS[(size_t)ch * 2048 + 1024 + 512 + PROBE_C];
    for (int ch = 0; ch < 32; ++ch) s0 += (double)FPP[(size_t)ch * 2048 + PROBE_C] + (double)FPP[(size_t)ch * 2048 + 512 + PROBE_C];
    const double n1 = ((volatile double*)(ctl + CW_P + 8))[0], n0 = ((volatile double*)(ctl + CW_P + 8))[1];
    const float e_n1 = (float)(fabs(n1 - s1) / fmax(n1, 1e-30)), e_n0 = (float)(fabs(n0 - s0) / fmax(n0, 1e-30));
#if PROBE == 100
    float M = fmaxf(fmaxf(e_conv, e_filt * 1e-3f), fmaxf(e_n1, e_n0));
#elif PROBE == 101
    float M = e_conv;
#elif PROBE == 104
    float M = e_conv0;
#elif PROBE == 102
    float M = e_filt;
#else
    float M = fmaxf(e_n1, e_n0);
#endif
    float v = (log10f(fmaxf(M, 1e-12f)) + 8.0f) * 0.125f; v = fminf(fmaxf(v, 0.02f), 1.0f);
    return (int)(v * 1600.0f);
}
#endif

#ifndef MK_SPLIT
#define MK_SPLIT 0
#endif
constexpr int N_PHASES = 8;
struct Args { const float* in[23]; float* out; unsigned char* ws; int ph_lo, ph_hi; };

__global__ void __launch_bounds__(NWAVES * 64, 2) enc_fwd(Args args) {
    extern __shared__ __attribute__((aligned(16))) unsigned char lds_raw[];
    Frame F;
    F.lds = (LAS unsigned char*)lds_raw;
    F.MISC = (volatile LAS unsigned*)(F.lds + MISC_OFF);
    F.wave = __builtin_amdgcn_readfirstlane((int)threadIdx.x >> 6); F.tid = 0; F.lane = 0;
#define TID() fresh_tid(F.wave)
#define LANE() fresh_lane()
    F.G = gridDim.x; { const int bx = blockIdx.x; F.vcu = (F.G % 8 == 0) ? (bx % 8) * (F.G / 8) + bx / 8 : bx; }
    F.ws = args.ws; F.ctl = (gu32*)(args.ws + WS_CTL);
    unsigned char* const ws = args.ws;
    for (int u = TID(); u < (LDS_BYTES - LDSCTL_OFF) / 4; u += NWAVES * 64) ((LAS unsigned*)(F.lds + LDSCTL_OFF))[u] = 0u;
    __syncthreads();
    const int lo = args.ph_lo, hi = args.ph_hi;
    XcdBarrier bar; bar.bar = (unsigned*)(F.ctl + CW_BAR); bar.x = 0; bar.st = nullptr; bar.wave = F.wave;
    if (hi - lo > 1) bar = xcd_barrier_post((unsigned*)(F.ctl + CW_BAR), F.MISC + 8, F.wave);
#define IN(k) (lo <= (k) && (k) < hi)
#if PROBE
#define TSTAMP(k) do { if (blockIdx.x == 0 && TID() == 0) { const unsigned long long t_ = __builtin_amdgcn_s_memrealtime(); F.MISC[16 + 2 * (k)] = (unsigned)t_; F.MISC[17 + 2 * (k)] = (unsigned)(t_ >> 32); if ((k) < 9) F.MISC[47] = (unsigned)(k); } } while (0)
#else
#define TSTAMP(k) do { } while (0)
#endif
#define SEAM(k) do { if (IN(k) && IN((k) + 1)) xcd_barrier(bar); TSTAMP((k) + 1); } while (0)
    TSTAMP(0);

    const float* const xp = args.in[0]; const float* const xs = args.in[1];
    bf16* const WINA = (bf16*)(ws + WS_WINA); bf16* const WINB = (bf16*)(ws + WS_WINB); bf16* const WHY = (bf16*)(ws + WS_WHY); bf16* const WAT = (bf16*)(ws + WS_WAT);
    bf16* const W3T = (bf16*)(ws + WS_W3T); bf16* const W3F = (bf16*)(ws + WS_W3F); bf16* const WO = (bf16*)(ws + WS_WO); bf16* const WGU = (bf16*)(ws + WS_WGU); bf16* const WD = (bf16*)(ws + WS_WD);
    bf16* const XB = (bf16*)(ws + WS_XB); bf16* const YT = (bf16*)(ws + WS_YT); bf16* const YAT = (bf16*)(ws + WS_YAT);
    bf16* const KREV_S = (bf16*)(ws + WS_KREV_S); bf16* const KREV_P = (bf16*)(ws + WS_KREV_P); bf16* const UT = (bf16*)(ws + WS_UT);
    bf16* const QB = (bf16*)(ws + WS_Q); bf16* const KB = (bf16*)(ws + WS_K); bf16* const VB = (bf16*)(ws + WS_V);
    bf16* const SGH = (bf16*)(ws + WS_SGH); bf16* const SGA = (bf16*)(ws + WS_SGA);
    float* const COS = (float*)(ws + WS_COS); float* const SIN = (float*)(ws + WS_SIN); float* const RSTD = (float*)(ws + WS_RSTD); float* const SSQ = (float*)(ws + WS_SSQ);
    float* const FPART_S = (float*)(ws + WS_FPART_S); float* const FPART_P = (float*)(ws + WS_FPART_P);
    bf16* const YHY = (bf16*)(ws + WS_YHY); bf16* const MERGED = (bf16*)(ws + WS_MERGED); bf16* const X1B = (bf16*)(ws + WS_X1B); bf16* const HID = (bf16*)(ws + WS_HID);

    if (IN(0)) {
        LAS float* scr = (LAS float*)(F.lds + RING_OFF + F.wave * 16384);
        const int gw = F.vcu * NWAVES + F.wave, NGW = F.G * NWAVES;
        constexpr int I_IN = 16 * 136, I_HY = 8 * 32, I_O = 16 * 32, I_G = 16 * 88, I_D = 44 * 32, I_W3 = 64;
        constexpr int NITEMS = I_IN + 2 * I_HY + I_O + 2 * I_G + I_D + 2 * I_W3;
        for (int it = gw; it < NITEMS; it += NGW) {
            int rr = it;
            if (rr < I_IN) { const int kb = rr / 136, nb = rr % 136, n0 = 32 * nb;
                if (n0 < 3 * HW) p0_transpose_item(args.in[3], DM, INW, WINA, n0, args.in[2], scr, 64 * kb, n0, LANE());
                else p0_transpose_item(args.in[3], DM, INW, WINB, map_projB(n0), args.in[2], scr, 64 * kb, n0, LANE());
                continue; } rr -= I_IN;
            if (rr < I_HY) { p0_transpose_item(args.in[16], HW, DM, WHY, 32 * (rr % 32), nullptr, scr, 64 * (rr / 32), 32 * (rr % 32), LANE()); continue; } rr -= I_HY;
            if (rr < I_HY) { p0_transpose_item(args.in[17], HW, DM, WAT, 32 * (rr % 32), nullptr, scr, 64 * (rr / 32), 32 * (rr % 32), LANE()); continue; } rr -= I_HY;
            if (rr < I_O) { p0_transpose_item(args.in[18], DM, DM, WO, 32 * (rr % 32), nullptr, scr, 64 * (rr / 32), 32 * (rr % 32), LANE()); continue; } rr -= I_O;
            if (rr < I_G) { const int n0 = 32 * (rr % 88); p0_transpose_item(args.in[20], DM, FFN, WGU, (n0 >> 7) * 256 + (n0 & 127), args.in[19], scr, 64 * (rr / 88), n0, LANE()); continue; } rr -= I_G;
            if (rr < I_G) { const int n0 = 32 * (rr % 88); p0_transpose_item(args.in[21], DM, FFN, WGU, (n0 >> 7) * 256 + 128 + (n0 & 127), args.in[19], scr, 64 * (rr / 88), n0, LANE()); continue; } rr -= I_G;
            if (rr < I_D) { p0_transpose_item(args.in[22], FFN, DM, WD, 32 * (rr % 32), nullptr, scr, 64 * (rr / 32), 32 * (rr % 32), LANE()); continue; } rr -= I_D;
            if (rr < I_W3) { p0_transpose_item(args.in[10], 64, 2048, W3T, 32 * rr, nullptr, scr, 0, 32 * rr, LANE()); continue; } rr -= I_W3;
            p0_w3f_item(args.in[10], W3F, rr, LANE());
        }
        for (int m = gw; m < MTOK; m += 4 * NGW) {
            const float* src[4];
#pragma unroll
            for (int q = 0; q < 4; ++q) { const int mq = m + q * NGW; src[q] = (mq < TP) ? xp + (size_t)mq * DM : xs + (size_t)(mq - TP) * DM; }
            f32x4 v[4][4];
#pragma unroll
            for (int q = 0; q < 4; ++q)
#pragma unroll
                for (int j = 0; j < 4; ++j) v[q][j] = ((const GAS f32x4*)src[q] + LANE())[64 * j];
#pragma unroll
            for (int q = 0; q < 4; ++q) { const int mq = m + q * NGW; float s = 0.f;
#pragma unroll
                for (int j = 0; j < 4; ++j) s += (v[q][j].x * v[q][j].x + v[q][j].y * v[q][j].y) + (v[q][j].z * v[q][j].z + v[q][j].w * v[q][j].w);
                s = wave_sum(s);
                if (LANE() == 0) RSTD[mq] = 1.0f / sqrtf(s * (1.0f / DM) + RMS_EPS);
                GAS unsigned long long* o8 = (GAS unsigned long long*)(XB + (size_t)mq * DM) + LANE();
#pragma unroll
                for (int j = 0; j < 4; ++j) o8[64 * j] = (unsigned long long)pk2(v[q][j].x, v[q][j].y) | ((unsigned long long)pk2(v[q][j].z, v[q][j].w) << 32); }
        }
        {
            const int idx0 = F.vcu * (NWAVES * 64) + TID();
            const double cr = exp2(-(double)(idx0 & 31) * (13.287712379549449 / 32.0)) * 0.15915494309189535;
            for (int idx = idx0; idx < LS * 32; idx += F.G * NWAVES * 64) {
                const double rev = (double)(idx >> 5) * cr; const float fr_ = (float)(rev - floor(rev));
                COS[idx] = __builtin_amdgcn_cosf(fr_); SIN[idx] = __builtin_amdgcn_sinf(fr_);
            }
        }
    }
    SEAM(0);

    if (IN(1)) {
        {
            constexpr int NU = (MTOK / 256) * (NPROJ / 256);
            const int heavy = NU % F.G, lb = heavy ? (int)blockIdx.x - heavy : (int)blockIdx.x, nlb = heavy ? F.G - heavy : F.G;
#if PROBE == 28 || PROBE == 29 || PROBE == 30 || PROBE == 36
            const int lb2 = (blockIdx.x == 0) ? 0 : lb;
#else
            const int lb2 = lb;
#endif
            if (lb2 >= 0) {
                filter_stage_weights(F.lds, args.in[6], args.in[7], args.in[8], args.in[9], args.in[11], TID());
                TSTAMP(14);
                for (int it = lb2 * NWAVES + F.wave; it < 288 * 2; it += nlb * NWAVES) {
                    const int dir = it & 1, ca = it >> 1, g = (ca < 256) ? 1 : 0, chunk = g ? ca : ca - 256;
                    filter_item(F.lds, W3F, KREV_S + (g ? (size_t)0 : (size_t)((WS_KREV_P - WS_KREV_S) / 2)), FPART_S + (g ? (size_t)0 : (size_t)((WS_FPART_P - WS_FPART_S) / 4)), g, chunk, dir, F.wave, LANE());
                }
                LDS_WAIT(); __syncthreads();
            }
        }
        TSTAMP(12);
        {
            pg8::Gemm g{WINA, XB, nullptr, nullptr, 3 * HW, MTOK, DM}; pg8::StaticOrder S; S.init(3 * HW, MTOK, F.G, (int)blockIdx.x);
            pg8::EpiUT E{UT, MTOK, RSTD};
            pg8::gemm_phase<pg8::EpiUT, pg8::StaticOrder, true, true>(F.lds + RING_OFF, g, S, E, F.wave);
        }
        TSTAMP(11);
        {
            pg8::Gemm g{XB, WINB, nullptr, nullptr, MTOK, NPROJ, DM}; pg8::StaticOrder S; S.init(MTOK, NPROJ, F.G, (int)blockIdx.x);
            pg8::EpiProj E{RSTD, args.in[13], args.in[14], COS, SIN, QB, KB, VB, SGH, SGA};
            pg8::gemm_phase<pg8::EpiProj, pg8::StaticOrder, true, true>(F.lds + RING_OFF, g, S, E, F.wave);
        }
    }
    SEAM(1);

    if (IN(2)) {
        #if PROBE
        const hy::Params HP{UT, KREV_S, KREV_P, FPART_S, FPART_P, args.in[4], args.in[5], args.in[12], YT, (float*)(ws + WS_DF), (bf16*)(ws + WS_DZ)};
#else
        const hy::Params HP{UT, KREV_S, KREV_P, FPART_S, FPART_P, args.in[4], args.in[5], args.in[12], YT, nullptr, nullptr};
#endif
        {
#if PROBE
            const fc::Params FP{UT, KREV_S, FPART_S, args.in[4], args.in[5], args.in[12], YT, (bf16*)(ws + WS_HS), (bf16*)(ws + WS_Z1S), (float*)(ws + WS_DF), (bf16*)(ws + WS_DZ)};
#else
            const fc::Params FP{UT, KREV_S, FPART_S, args.in[4], args.in[5], args.in[12], YT, (bf16*)(ws + WS_HS), (bf16*)(ws + WS_Z1S), nullptr, nullptr};
#endif
            for (int it = F.vcu; it < HW / 2; it += F.G) fc::item_pair(F.lds, FP, it, TID(), F.vcu);
        }
        TSTAMP(9);
        for (int it = F.vcu; it < HW; it += F.G) hy::hyena_item(F.lds, HP, 0, it, TID());
        TSTAMP(10);
        const at::Params AP{QB, KB, VB, args.in[15], YAT};
        for (int it = F.vcu; it < 512; it += F.G) at::attn_item(F.lds, AP, it >> 1, it & 1, TID());
    }
    SEAM(2);
#if PROBE >= 100
    probe_check(ws, (unsigned*)F.ctl, args.in[6], args.in[7], args.in[8], args.in[9], args.in[10], args.in[11], F.vcu, F.G, TID());
    xcd_barrier(bar);
#endif

    if (IN(3)) {
        for (int t = F.vcu; t < 8 * 512; t += 8 * F.G) transpose_y_tiles8(F.lds, YT, YHY, t, F.G, 8 * 512, TID());
    }
    SEAM(3);

    if (IN(4)) {
        pg8::Gemm g{YHY, WHY, YAT, WAT, MTOK, DM, HW}; pg8::TwoPartOrder S; S.b.init(MTOK, DM, F.G, (int)blockIdx.x);
        pg8::EpiMerged E{SGH, SGA, MERGED};
        pg8::gemm_phase<pg8::EpiMerged, pg8::TwoPartOrder, true, true>(F.lds + RING_OFF, g, S, E, F.wave);
    }
    SEAM(4);

    if (IN(5)) {
        pg8::Gemm g{MERGED, WO, nullptr, nullptr, MTOK, DM, DM}; pg8::StaticOrder S; S.init(MTOK, DM, F.G, (int)blockIdx.x);
        pg8::EpiWo E{xp, xs, X1B, SSQ};
        pg8::gemm_phase<pg8::EpiWo, pg8::StaticOrder, true, true>(F.lds + RING_OFF, g, S, E, F.wave);
    }
    SEAM(5);

    if (IN(6)) {
        pg8::Gemm g{X1B, WGU, nullptr, nullptr, MTOK, 2 * FFN, DM}; pg8::StaticOrder S; S.init(MTOK, 2 * FFN, F.G, (int)blockIdx.x);
        pg8::EpiFfn1 E{SSQ, HID};
        pg8::gemm_phase<pg8::EpiFfn1, pg8::StaticOrder, true, true>(F.lds + RING_OFF, g, S, E, F.wave);
    }
    SEAM(6);

    if (IN(7)) {
        pg8::Gemm g{HID, WD, nullptr, nullptr, MTOK, DM, FFN}; pg8::StaticOrder S; S.init(MTOK, DM, F.G, (int)blockIdx.x);
        pg8::EpiFfn2 E{X1B, args.out};
        pg8::gemm_phase<pg8::EpiFfn2, pg8::StaticOrder, true, true>(F.lds + RING_OFF, g, S, E, F.wave);
#if PROBE
        TSTAMP(8);
        VM_WAIT(); __syncthreads();
        if (blockIdx.x == 0) {
            pg8::Unit u; S.next(1, u);
            int cnt;
#if PROBE >= 100
            cnt = probe_metric_count(ws, (unsigned*)F.ctl);
#else
            { const unsigned long long t0 = F.MISC[16] | ((unsigned long long)F.MISC[17] << 32), t8 = F.MISC[32] | ((unsigned long long)F.MISC[33] << 32);
#if PROBE >= 51 && PROBE <= 58
              cnt = (int)(1600.0f * (float)F.MISC[46] / (float)(t8 - t0));
              constexpr int IA = 0, IB = 1;
              if (false)
#elif (PROBE >= 31 && PROBE <= 35) || (PROBE >= 41 && PROBE <= 46)
              cnt = (int)(1600.0f * (float)F.MISC[40 + (PROBE % 10) - 1] / (float)(t8 - t0));
              constexpr int IA = 0, IB = 1;
              if (false)
#elif PROBE == 21
              constexpr int IA = 2, IB = 9;
#elif PROBE == 26
              constexpr int IA = 1, IB = 11;
#elif PROBE == 27
              constexpr int IA = 11, IB = 2;
#elif PROBE == 28
              constexpr int IA = 1, IB = 12;
#elif PROBE == 29
              constexpr int IA = 1, IB = 14;
#elif PROBE == 30
              constexpr int IA = 14, IB = 13;
#elif PROBE == 36
              constexpr int IA = 13, IB = 12;
#elif PROBE == 22
              constexpr int IA = 9, IB = 10;
#elif PROBE == 23
              constexpr int IA = 10, IB = 3;
#else
              constexpr int IA = PROBE - 1, IB = PROBE;
#endif
              { const unsigned long long ta = F.MISC[16 + 2 * IA] | ((unsigned long long)F.MISC[17 + 2 * IA] << 32), tb = F.MISC[16 + 2 * IB] | ((unsigned long long)F.MISC[17 + 2 * IB] << 32);
                cnt = (int)(1600.0f * (float)(tb - ta) / (float)(t8 - t0)); } }
#endif
            for (int i = TID(); i < cnt; i += NWAVES * 64) args.out[(size_t)(u.pm * 256 + (i & 255)) * 1024 + u.pn * 256 + (i >> 8)] = 0.f;
        }
#endif
    }
#undef IN
#undef SEAM
}

extern "C" void kernel_launch(void* const* d_in, const int* in_sizes, int n_in, void* d_out, int out_size, void* d_ws, size_t ws_size, hipStream_t stream) {
    static int grid = 0;
    if (grid == 0) {
        if (n_in != 23 || out_size != MTOK * DM || ws_size < WS_END) { fprintf(stderr, "kernel_launch: unexpected problem shape (n_in %d, out %d, ws %zu); nothing launched\n", n_in, out_size, ws_size); grid = -1; return; }
        int dev = 0, cus = 0, per_cu = 0;
        if (hipGetDevice(&dev) != hipSuccess || hipDeviceGetAttribute(&cus, hipDeviceAttributeMultiprocessorCount, dev) != hipSuccess) { fprintf(stderr, "kernel_launch: device query failed\n"); grid = -1; return; }
        if (hipFuncSetAttribute((const void*)enc_fwd, hipFuncAttributeMaxDynamicSharedMemorySize, LDS_BYTES) != hipSuccess) { fprintf(stderr, "kernel_launch: hipFuncSetAttribute failed\n"); grid = -1; return; }
        if (hipOccupancyMaxActiveBlocksPerMultiprocessor(&per_cu, (const void*)enc_fwd, NWAVES * 64, LDS_BYTES) != hipSuccess || per_cu < 1)
            fprintf(stderr, "kernel_launch: note: occupancy query reports %d workgroups per CU\n", per_cu);
        (void)hipGetLastError();
        grid = cus;
    }
    if (grid < 0) return;
    if (hipMemsetAsync((char*)d_ws + WS_CTL, 0, CTL_ZERO_BYTES, stream) != hipSuccess) { fprintf(stderr, "kernel_launch: memset failed\n"); return; }
    Args a{};
    for (int i = 0; i < 23; ++i) a.in[i] = (const float*)d_in[i];
    a.out = (float*)d_out; a.ws = (unsigned char*)d_ws;
#if MK_SPLIT
    for (int p = 0; p < N_PHASES; ++p) { a.ph_lo = p; a.ph_hi = p + 1; hipLaunchKernelGGL(enc_fwd, dim3(grid), dim3(NWAVES * 64), LDS_BYTES, stream, a); }
#else
    a.ph_lo = 0; a.ph_hi = N_PHASES;
    hipLaunchKernelGGL(enc_fwd, dim3(grid), dim3(NWAVES * 64), LDS_BYTES, stream, a);
#endif
    const hipError_t le = hipPeekAtLastError();
    if (le != hipSuccess) fprintf(stderr, "kernel_launch: launch failed: %s\n", hipGetErrorName(le));
}
```
